# Optimizing an MI355X kernel written in HIP

```python
import math
import jax, jax.numpy as jnp
from jax import lax
import numpy as np

D_MODEL = 1024
BATCH = 16
SEQ = 2048
DEPTH = 2

HEAD_DIM = 64
DIL_GROUPS = ((128, 1), (512, 4), (2048, 16))
DIL_HEADS_PER_GROUP = 4
DIL_HEADS = DIL_HEADS_PER_GROUP * len(DIL_GROUPS)
DIL_WIDTH = DIL_HEADS * HEAD_DIM
DIL_OUT = DIL_HEADS_PER_GROUP * HEAD_DIM
HYENA_WIDTH = 512
HYENA_ORDER = 2
HYENA_BANDS = 16
HYENA_EMB = 2 * HYENA_BANDS + 1
HYENA_HIDDEN = 64
HYENA_DECAY_MIN = -math.log(1e-2) / 1.5
HYENA_DECAY_MAX = -math.log(1e-2) / 0.3
SHORT_CONV = 3
HY_IN = (HYENA_ORDER + 1) * HYENA_WIDTH
SWA_Q_HEADS = 8
SWA_KV_HEADS = 2
SWA_RADIUS = 128
SWA_BLOCK = 128
SWA_WIDTH = SWA_Q_HEADS * HEAD_DIM
SWA_IN = (SWA_Q_HEADS + 2 * SWA_KV_HEADS) * HEAD_DIM
N_BRANCHES = 3
GATE_IN = N_BRANCHES * D_MODEL
IN_SPLITS = (3 * DIL_WIDTH, 3 * DIL_WIDTH + HY_IN, 3 * DIL_WIDTH + HY_IN + SWA_IN)
IN_WIDTH = 3 * DIL_WIDTH + HY_IN + SWA_IN + GATE_IN
ROPE_THETA = 10000.0
PEER_HEADS = 8
PEER_KEYS = 128
PEER_EXPERTS = PEER_KEYS * PEER_KEYS
PEER_QUERY = 256
PEER_TOPK = 16
PEER_CHUNK = 128
ALPHA = (2 * DEPTH) ** 0.25
BETA = (8 * DEPTH) ** -0.25
LN_EPS = 1e-5
NEG_INF = -1e30

kernel_name = "hybrid_dilated_hyena_swa_peer_encoder"


def layer_norm(x, g, b):
    xf = x.astype(jnp.float32)
    mu = xf.mean(-1, keepdims=True)
    var = jnp.square(xf - mu).mean(-1, keepdims=True)
    return ((xf - mu) * lax.rsqrt(var + LN_EPS) * g.astype(jnp.float32) + b.astype(jnp.float32)).astype(x.dtype)


def rope_tables(seq):
    pos = jnp.arange(seq, dtype=jnp.float32)
    inv = ROPE_THETA ** (-jnp.arange(0, HEAD_DIM, 2, dtype=jnp.float32) / HEAD_DIM)
    ang = pos[:, None] * inv[None, :]
    return jnp.cos(ang), jnp.sin(ang)


def apply_rope(t, cos, sin):
    t1, t2 = jnp.split(t.astype(jnp.float32), 2, axis=-1)
    return jnp.concatenate([t1 * cos - t2 * sin, t2 * cos + t1 * sin], axis=-1).astype(t.dtype)


def to_heads(t, n):
    b, s, _ = t.shape
    return t.reshape(b, s, n, HEAD_DIM).transpose(0, 2, 1, 3)


def banded_attention(q, k, v, radius, block, sink=None):
    b, hk, g, L, hd = q.shape
    nb = -(-L // block)
    lp = nb * block
    q = jnp.pad(q, ((0, 0), (0, 0), (0, 0), (0, lp - L), (0, 0)))
    kv_pad = ((0, 0), (0, 0), (block, block + lp - L), (0, 0))
    kb = jnp.pad(k, kv_pad).reshape(b, hk, nb + 2, block, hd)
    vb = jnp.pad(v, kv_pad).reshape(b, hk, nb + 2, block, hd)
    kw = jnp.concatenate([kb[:, :, :-2], kb[:, :, 1:-1], kb[:, :, 2:]], axis=3)
    vw = jnp.concatenate([vb[:, :, :-2], vb[:, :, 1:-1], vb[:, :, 2:]], axis=3)
    qb = q.reshape(b, hk, g, nb, block, hd)
    qpos = jnp.arange(lp).reshape(nb, block)
    kpos = jnp.arange(nb)[:, None] * block + jnp.arange(-block, 2 * block)[None, :]
    mask = ((jnp.abs(qpos[:, :, None] - kpos[:, None, :]) <= radius)
            & (kpos >= 0)[:, None, :] & (kpos < L)[:, None, :])
    s = jnp.einsum('bhgnqd,bhnkd->bhgnqk', qb, kw).astype(jnp.float32) * (hd ** -0.5)
    s = jnp.where(mask, s, NEG_INF)
    m = s.max(-1, keepdims=True)
    if sink is not None:
        sk = sink.astype(jnp.float32)[None, :, :, None, None, None]
        m = jnp.maximum(m, sk)
    p = jnp.exp(s - m)
    denom = p.sum(-1, keepdims=True)
    if sink is not None:
        denom = denom + jnp.exp(sk - m)
    out = jnp.einsum('bhgnqk,bhnkd->bhgnqd', (p / denom).astype(v.dtype), vw)
    lse = (m + jnp.log(denom))[..., 0]
    return out.reshape(b, hk, g, lp, hd)[:, :, :, :L], lse.reshape(b, hk, g, lp)[..., :L]


def dilated_attention(q, k, v, dilation, radius):
    b, h, s, hd = q.shape
    ls = s // dilation

    def split(t):
        return t.reshape(b, h, ls, dilation, hd).transpose(0, 1, 3, 2, 4).reshape(b, h * dilation, ls, hd)

    out, lse = banded_attention(split(q)[:, :, None], split(k), split(v), radius, radius)
    out = out[:, :, 0].reshape(b, h, dilation, ls, hd).transpose(0, 1, 3, 2, 4).reshape(b, h, s, hd)
    lse = lse[:, :, 0].reshape(b, h, dilation, ls).transpose(0, 1, 3, 2).reshape(b, h, s)
    return out, lse


def short_conv(t, w, bias):
    half = SHORT_CONV // 2
    s = t.shape[1]
    tp = jnp.pad(t, ((0, 0), (half, half), (0, 0)))
    out = bias
    for i in range(SHORT_CONV):
        out = out + tp[:, i:i + s] * w[i]
    return out


def hyena_filter_spectrum(L, w1, b1, w2, b2, w3, freq, log_decay):
    f32 = jnp.float32
    idx = jnp.arange(L, dtype=f32)
    t = idx / max(L - 1, 1)
    w = 2.0 * math.pi * idx / L
    bands = jnp.linspace(1e-4, HYENA_BANDS - 1, HYENA_BANDS, dtype=f32)
    ang = w[:, None] * bands[None, :]
    z = jnp.concatenate([t[:, None], jnp.cos(ang), -jnp.sin(ang)], axis=-1)
    freq = freq.astype(f32)
    h = jnp.sin(freq[0] * (z @ w1.astype(f32) + b1.astype(f32)))
    h = jnp.sin(freq[1] * (h @ w2.astype(f32) + b2.astype(f32)))
    h = (h @ w3.astype(f32)) * jnp.exp(-t[:, None] * jnp.exp(log_decay.astype(f32))[None, :])
    h = h.reshape(L, 2, HYENA_ORDER, HYENA_WIDTH)
    filt = jnp.concatenate([h[:, 0], jnp.zeros((1, HYENA_ORDER, HYENA_WIDTH), f32), h[1:, 1][::-1]], axis=0)
    filt = filt * lax.rsqrt(jnp.sum(jnp.square(filt), axis=0, keepdims=True) + 1e-12)
    return jnp.fft.rfft(filt, axis=0)


def fft_conv(z, filt_f):
    L = z.shape[1]
    zf = jnp.fft.rfft(z.astype(jnp.float32), n=2 * L, axis=1)
    return jnp.fft.irfft(zf * filt_f[None], n=2 * L, axis=1)[:, :L].astype(z.dtype)


def hybrid_mixer(u, cos, sin, w_in, conv_w, conv_b, hy_w1, hy_b1, hy_w2, hy_b2, hy_w3, hy_freq,
                 hy_log_decay, hy_bias, attn_sink, w_branch_a, w_branch_b, w_branch_c, w_out):
    b, s, _ = u.shape
    proj = u @ w_in
    qkv_a, hy_in, qkv_c, gate_logits = jnp.split(proj, IN_SPLITS, axis=-1)

    qa, ka, va = [to_heads(t, DIL_HEADS) for t in jnp.split(qkv_a, 3, axis=-1)]
    qa, ka = apply_rope(qa, cos, sin), apply_rope(ka, cos, sin)
    outs, lses = [], []
    for gi, (window, dil) in enumerate(DIL_GROUPS):
        hs = slice(gi * DIL_HEADS_PER_GROUP, (gi + 1) * DIL_HEADS_PER_GROUP)
        o, lse = dilated_attention(qa[:, hs], ka[:, hs], va[:, hs], dil, window // (2 * dil))
        outs.append(o)
        lses.append(lse)
    wts = jax.nn.softmax(jnp.stack(lses, axis=0), axis=0)
    ya = jnp.einsum('gbhs,gbhsd->bshd', wts.astype(u.dtype), jnp.stack(outs, axis=0)).reshape(b, s, DIL_OUT)

    hy = short_conv(hy_in, conv_w, conv_b)
    hy_parts = jnp.split(hy, HYENA_ORDER + 1, axis=-1)
    filt_f = hyena_filter_spectrum(s, hy_w1, hy_b1, hy_w2, hy_b2, hy_w3, hy_freq, hy_log_decay)
    z = hy_parts[0]
    for o in range(HYENA_ORDER):
        z = hy_parts[o + 1] * (fft_conv(z, filt_f[:, o]) + hy_bias[o] * z)
    yb = z

    qc, kc, vc = jnp.split(qkv_c, (SWA_WIDTH, SWA_WIDTH + SWA_KV_HEADS * HEAD_DIM), axis=-1)
    qc = apply_rope(to_heads(qc, SWA_Q_HEADS), cos, sin)
    kc = apply_rope(to_heads(kc, SWA_KV_HEADS), cos, sin)
    vc = to_heads(vc, SWA_KV_HEADS)
    grp = SWA_Q_HEADS // SWA_KV_HEADS
    qc = qc.reshape(b, SWA_KV_HEADS, grp, s, HEAD_DIM)
    oc, _ = banded_attention(qc, kc, vc, SWA_RADIUS, SWA_BLOCK, attn_sink.reshape(SWA_KV_HEADS, grp))
    yc = oc.reshape(b, SWA_Q_HEADS, s, HEAD_DIM).transpose(0, 2, 1, 3).reshape(b, s, SWA_WIDTH)

    ga, gb, gc = jnp.split(jax.nn.sigmoid(gate_logits.astype(jnp.float32)).astype(u.dtype), N_BRANCHES, axis=-1)
    merged = ga * (ya @ w_branch_a) + gb * (yb @ w_branch_b) + gc * (yc @ w_branch_c)
    return merged @ w_out


def peer_ffn(x, w_query, sub_keys, expert_u, expert_v):
    b, s, d = x.shape
    xt = x.reshape(-1, PEER_CHUNK, d)

    def chunk(xc):
        q = (xc @ w_query).reshape(PEER_CHUNK, PEER_HEADS, 2, PEER_QUERY // 2)
        sc = jnp.einsum('thpc,hpnc->thpn', q, sub_keys).astype(jnp.float32)
        s1, i1 = lax.top_k(sc[:, :, 0], PEER_TOPK)
        s2, i2 = lax.top_k(sc[:, :, 1], PEER_TOPK)
        cand = (s1[..., :, None] + s2[..., None, :]).reshape(PEER_CHUNK, PEER_HEADS, PEER_TOPK * PEER_TOPK)
        best, ci = lax.top_k(cand, PEER_TOPK)
        e = (jnp.take_along_axis(i1, ci // PEER_TOPK, axis=-1) * PEER_KEYS
             + jnp.take_along_axis(i2, ci % PEER_TOPK, axis=-1))
        gate = jax.nn.softmax(best, axis=-1)
        act = jax.nn.gelu(jnp.einsum('thkd,td->thk', expert_u[e], xc), approximate=False)
        wgt = (gate * act.astype(jnp.float32)).astype(xc.dtype)
        return jnp.einsum('thk,thkd->td', wgt, expert_v[e])

    return lax.map(chunk, xt).reshape(b, s, d)


def setup_inputs(seed: int = 0) -> dict:
    key = jax.random.key(seed)
    ks = jax.random.split(key, 32)
    f32 = jnp.float32

    def nrm(k, shape, scale):
        return jax.random.normal(k, shape, f32) * scale

    hy_out = 2 * HYENA_ORDER * HYENA_WIDTH
    return {
        "x": nrm(ks[0], (BATCH, SEQ, D_MODEL), 1.0),
        "c": nrm(ks[1], (BATCH, D_MODEL), 1.0),
        "w_ada": nrm(ks[2], (DEPTH, D_MODEL, 6 * D_MODEL), 0.5 * D_MODEL ** -0.5),
        "b_ada": nrm(ks[3], (DEPTH, 6 * D_MODEL), 0.02),
        "w_in": nrm(ks[4], (DEPTH, D_MODEL, IN_WIDTH), D_MODEL ** -0.5),
        "conv_w": nrm(ks[5], (DEPTH, SHORT_CONV, HY_IN), SHORT_CONV ** -0.5),
        "conv_b": nrm(ks[6], (DEPTH, HY_IN), 0.02),
        "hy_w1": nrm(ks[7], (DEPTH, HYENA_EMB, HYENA_HIDDEN), HYENA_EMB ** -0.5),
        "hy_b1": nrm(ks[8], (DEPTH, HYENA_HIDDEN), 0.02),
        "hy_w2": nrm(ks[9], (DEPTH, HYENA_HIDDEN, HYENA_HIDDEN), HYENA_HIDDEN ** -0.5),
        "hy_b2": nrm(ks[10], (DEPTH, HYENA_HIDDEN), 0.02),
        "hy_w3": nrm(ks[11], (DEPTH, HYENA_HIDDEN, hy_out), HYENA_HIDDEN ** -0.5),
        "hy_freq": 1.0 + nrm(ks[12], (DEPTH, 2, HYENA_HIDDEN), 0.02),
        "hy_log_decay": jax.random.uniform(ks[13], (DEPTH, hy_out), f32,
                                           math.log(HYENA_DECAY_MIN), math.log(HYENA_DECAY_MAX)),
        "hy_bias": nrm(ks[14], (DEPTH, HYENA_ORDER, HYENA_WIDTH), 0.5),
        "attn_sink": nrm(ks[15], (DEPTH, SWA_Q_HEADS), 0.5),
        "w_branch_a": nrm(ks[16], (DEPTH, DIL_OUT, D_MODEL), BETA * DIL_OUT ** -0.5),
        "w_branch_b": nrm(ks[17], (DEPTH, HYENA_WIDTH, D_MODEL), BETA * HYENA_WIDTH ** -0.5),
        "w_branch_c": nrm(ks[18], (DEPTH, SWA_WIDTH, D_MODEL), BETA * SWA_WIDTH ** -0.5),
        "w_out": nrm(ks[19], (DEPTH, D_MODEL, D_MODEL), BETA * D_MODEL ** -0.5),
        "ln_g": 1.0 + nrm(ks[20], (DEPTH, 2, D_MODEL), 0.02),
        "ln_b": nrm(ks[21], (DEPTH, 2, D_MODEL), 0.02),
        "peer_wq": nrm(ks[22], (DEPTH, D_MODEL, PEER_HEADS * PEER_QUERY), D_MODEL ** -0.5),
        "peer_keys": nrm(ks[23], (DEPTH, PEER_HEADS, 2, PEER_KEYS, PEER_QUERY // 2), (PEER_QUERY // 2) ** -0.5),
        "peer_u": nrm(ks[24], (DEPTH, PEER_EXPERTS, D_MODEL), D_MODEL ** -0.5),
        "peer_v": nrm(ks[25], (DEPTH, PEER_EXPERTS, D_MODEL), BETA),
    }


def reference(x, c, w_ada, b_ada, w_in, conv_w, conv_b, hy_w1, hy_b1, hy_w2, hy_b2, hy_w3, hy_freq,
              hy_log_decay, hy_bias, attn_sink, w_branch_a, w_branch_b, w_branch_c, w_out, ln_g, ln_b,
              peer_wq, peer_keys, peer_u, peer_v):
    s = x.shape[1]
    cos, sin = rope_tables(s)
    cond = jax.nn.silu(c)
    for l in range(DEPTH):
        ada = cond @ w_ada[l] + b_ada[l]
        sh1, sc1, g1, sh2, sc2, g2 = [a[:, None, :] for a in jnp.split(ada, 6, axis=-1)]
        u = x * (1.0 + sc1) + sh1
        mix = hybrid_mixer(u, cos, sin, w_in[l], conv_w[l], conv_b[l], hy_w1[l], hy_b1[l], hy_w2[l],
                           hy_b2[l], hy_w3[l], hy_freq[l], hy_log_decay[l], hy_bias[l], attn_sink[l],
                           w_branch_a[l], w_branch_b[l], w_branch_c[l], w_out[l])
        x = layer_norm(ALPHA * x + g1 * mix, ln_g[l, 0], ln_b[l, 0])
        u = x * (1.0 + sc2) + sh2
        ffn = peer_ffn(u, peer_wq[l], peer_keys[l], peer_u[l], peer_v[l])
        x = layer_norm(ALPHA * x + g2 * ffn, ln_g[l, 1], ln_b[l, 1])
    return x
```

```cpp
#include <hip/hip_runtime.h>
#include <stdint.h>
#include <stdio.h>

#define DEV __device__ __forceinline__
typedef unsigned short bf16_t;

constexpr int D_ = 1024, B_ = 16, S_ = 2048, T_ = B_ * S_;
constexpr float ALPHA_ = 1.41421356237309515f;
constexpr float LOG2E_ = 1.4426950408889634f;
constexpr float QSCALE_ = 0.125f * 1.4426950408889634f;
constexpr float LN_EPS_ = 1e-5f;
constexpr int PW_ = 3072;
constexpr int YW_ = 1280;

constexpr size_t MB_ = 1024 * 1024;
constexpr size_t OFF_ADA = 0, OFF_ROPE = 1 * MB_, OFF_GR = 2 * MB_, OFF_LSE = 18 * MB_, OFF_WINT = 20 * MB_, OFF_WBRT = 50 * MB_,
                 OFF_WOUTT = 55 * MB_, OFF_WQT = 59 * MB_, OFF_KEYS = 67 * MB_, OFF_UBUF = 68 * MB_, OFF_P = 132 * MB_, OFF_HYT = 324 * MB_,
                 OFF_Y = 420 * MB_, OFF_Z1T = 420 * MB_  , WS_NEED = 500 * MB_;

DEV float bf2f(bf16_t v) { return __uint_as_float(((unsigned)v) << 16); }
DEV bf16_t f2bf(float f) { unsigned u = __float_as_uint(f); u += 0x7FFFu + ((u >> 16) & 1u); return (bf16_t)(u >> 16); }

__global__ void __launch_bounds__(256) k_ada(const float* __restrict__ c, const float* __restrict__ w_ada, const float* __restrict__ b_ada, float* __restrict__ ada) {
    const int idx = blockIdx.x * 256 + threadIdx.x; const int l = idx / 6144, n = idx % 6144;
    __shared__ float cond[16][64];
    float acc[16];
#pragma unroll
    for (int b = 0; b < 16; ++b) acc[b] = b_ada[l * 6144 + n];
    for (int k0 = 0; k0 < 1024; k0 += 64) {
        for (int i = threadIdx.x; i < 1024; i += 256) { const int b = i >> 6, kk = i & 63; const float v = c[b * 1024 + k0 + kk]; cond[b][kk] = v / (1.f + expf(-v)); }
        __syncthreads();
        for (int kk = 0; kk < 64; ++kk) { const float w = w_ada[((size_t)l * 1024 + k0 + kk) * 6144 + n];
#pragma unroll
            for (int b = 0; b < 16; ++b) acc[b] += cond[b][kk] * w; }
        __syncthreads();
    }
#pragma unroll
    for (int b = 0; b < 16; ++b) ada[((size_t)l * 16 + b) * 6144 + n] = acc[b];
}

__global__ void __launch_bounds__(256) k_rope(float2* __restrict__ rope) {
    const int idx = blockIdx.x * 256 + threadIdx.x; const int s = idx >> 5, i = idx & 31;
    const float inv = powf(10000.f, -(float)i / 32.f); const float ang = (float)s * inv;
    rope[idx] = make_float2(cosf(ang), sinf(ang));
}

__global__ void __launch_bounds__(64) k_filt_h2(const float* __restrict__ w1, const float* __restrict__ b1, const float* __restrict__ w2, const float* __restrict__ b2,
                                                const float* __restrict__ freq, float* __restrict__ h2) {
    const int l = blockIdx.x / 2048, t = blockIdx.x % 2048, j = threadIdx.x;
    __shared__ float z[33], h1[64];
    if (j < 33) {
        const float idx = (float)t, tn = idx / 2047.f, w = 6.283185307179586f * idx / 2048.f;
        if (j == 0) z[0] = tn;
        else { const int k = (j <= 16) ? (j - 1) : (j - 17); const float band = 1e-4f + (float)k * ((15.f - 1e-4f) / 15.f); const float ang = w * band;
            z[j] = (j <= 16) ? cosf(ang) : -sinf(ang); }
    }
    __syncthreads();
    float a = b1[l * 64 + j];
    for (int e = 0; e < 33; ++e) a += z[e] * w1[(l * 33 + e) * 64 + j];
    h1[j] = sinf(freq[(l * 2 + 0) * 64 + j] * a);
    __syncthreads();
    float a2 = b2[l * 64 + j];
    for (int i = 0; i < 64; ++i) a2 += h1[i] * w2[(l * 64 + i) * 64 + j];
    h2[((size_t)l * 2048 + t) * 64 + j] = sinf(freq[(l * 2 + 1) * 64 + j] * a2);
}

__global__ void __launch_bounds__(256) k_filt_full(const float* __restrict__ h2, const float* __restrict__ w3, const float* __restrict__ log_decay, float* __restrict__ hf) {
    const size_t idx = (size_t)blockIdx.x * 256 + threadIdx.x; const int col = (int)(idx & 2047), t = (int)((idx >> 11) & 2047), l = (int)(idx >> 22);
    const float* hr = h2 + ((size_t)l * 2048 + t) * 64; float a = 0.f;
    for (int j = 0; j < 64; ++j) a += hr[j] * w3[((size_t)l * 64 + j) * 2048 + col];
    const float tn = (float)t / 2047.f;
    hf[idx] = a * expf(-tn * expf(log_decay[l * 2048 + col]));
}

__global__ void __launch_bounds__(256) k_filt_norm(const float* __restrict__ hf, bf16_t* __restrict__ Gr) {
    const int blk = blockIdx.x; const int c = blk & 511, o = (blk >> 9) & 1, l = blk >> 10;
    const float* base = hf + (size_t)l * 2048 * 2048; const int colf = o * 512 + c, colb = 1024 + o * 512 + c;
    float ss = 0.f;
    for (int t = threadIdx.x; t < 2048; t += 256) { const float a = base[(size_t)t * 2048 + colf]; ss += a * a; if (t >= 1) { const float bb = base[(size_t)t * 2048 + colb]; ss += bb * bb; } }
    __shared__ float red[256]; red[threadIdx.x] = ss; __syncthreads();
    for (int st = 128; st > 0; st >>= 1) { if (threadIdx.x < st) red[threadIdx.x] += red[threadIdx.x + st]; __syncthreads(); }
    const float scale = rsqrtf(red[0] + 1e-12f);
    bf16_t* g = Gr + (size_t)blk * 4096;
    for (int n = threadIdx.x; n < 4096; n += 256) { const int lag = 2047 - n; float v = 0.f;
        if (n < 4095) v = (lag >= 0) ? base[(size_t)lag * 2048 + colf] : base[(size_t)(-lag) * 2048 + colb];
        g[n] = f2bf(v * scale); }
}

__global__ void __launch_bounds__(256) k_modulate(const float* __restrict__ x, const float* __restrict__ ada_l, int off_sh, int off_sc, bf16_t* __restrict__ ubuf) {
    const size_t idx = (size_t)blockIdx.x * 256 + threadIdx.x; const int d = (int)(idx & 1023); const int b = (int)(idx >> 21);
    const float* a = ada_l + (size_t)b * 6144;
    ubuf[idx] = f2bf(x[idx] * (1.f + a[off_sc + d]) + a[off_sh + d]);
}

template <class AL, class WL, class EP>
__global__ void __launch_bounds__(256) k_gemm_naive(int K, AL al, WL wl, EP ep) {
    __shared__ float As[16][65];
    __shared__ float Ws[16][65];
    const int tx = threadIdx.x & 15, ty = threadIdx.x >> 4;
    const int m0 = blockIdx.y * 64, n0 = blockIdx.x * 64;
    float acc[4][4];
#pragma unroll
    for (int i = 0; i < 4; ++i)
#pragma unroll
        for (int j = 0; j < 4; ++j) acc[i][j] = 0.f;
    for (int k0 = 0; k0 < K; k0 += 16) {
#pragma unroll
        for (int r = 0; r < 4; ++r) { const int i = threadIdx.x + r * 256; const int mm = i >> 4, kk = i & 15; As[kk][mm] = al(m0 + mm, k0 + kk); }
#pragma unroll
        for (int r = 0; r < 4; ++r) { const int i = threadIdx.x + r * 256; const int kk = i >> 6, nn = i & 63; Ws[kk][nn] = wl(k0 + kk, n0 + nn); }
        __syncthreads();
#pragma unroll
        for (int kk = 0; kk < 16; ++kk) {
            float a[4], w[4];
#pragma unroll
            for (int i = 0; i < 4; ++i) { a[i] = As[kk][ty + 16 * i]; w[i] = Ws[kk][tx + 16 * i]; }
#pragma unroll
            for (int i = 0; i < 4; ++i)
#pragma unroll
                for (int j = 0; j < 4; ++j) acc[i][j] += a[i] * w[j];
        }
        __syncthreads();
    }
    ep(m0, n0, ty, tx, acc);
}

struct ALbf { const bf16_t* A; int lda; int pad; DEV float operator()(int m, int k) const { return bf2f(A[(size_t)m * lda + k]); } };
struct WLf { const float* W; int ldw; int coff; DEV float operator()(int k, int n) const { return W[(size_t)k * ldw + coff + n]; } };
struct WLinP { const float* W; DEV float operator()(int k, int n) const { return W[(size_t)k * 7680 + (n < 2304 ? n : n + 1536)]; } };

struct EpP { bf16_t* P; const float2* rope;
    DEV void operator()(int m0, int n0, int ty, int tx, float (&acc)[4][4]) const {
        const int head = n0 >> 6; const bool rp = (head < 24) || (head >= 36 && head < 46); const bool qs = (head < 12) || (head >= 36 && head < 44);
#pragma unroll
        for (int i = 0; i < 4; ++i) { const int m = m0 + ty + 16 * i; const int s = m & 2047; bf16_t* row = P + (size_t)m * PW_ + n0;
            if (rp) {
#pragma unroll
                for (int jj = 0; jj < 2; ++jj) { const int d = tx + 16 * jj; const float x1 = acc[i][jj], x2 = acc[i][jj + 2]; const float2 cs = rope[s * 32 + d];
                    float o1 = x1 * cs.x - x2 * cs.y, o2 = x2 * cs.x + x1 * cs.y; if (qs) { o1 *= QSCALE_; o2 *= QSCALE_; }
                    const int p1 = 8 * (d >> 2) + (d & 3); row[p1] = f2bf(o1); row[p1 + 4] = f2bf(o2); }
            } else {
#pragma unroll
                for (int j = 0; j < 4; ++j) row[tx + 16 * j] = f2bf(acc[i][j]);
            } }
    } };
struct EpHyT { bf16_t* hyT;
    DEV void operator()(int m0, int n0, int ty, int tx, float (&acc)[4][4]) const {
#pragma unroll
        for (int i = 0; i < 4; ++i)
#pragma unroll
            for (int j = 0; j < 4; ++j) hyT[(size_t)(n0 + tx + 16 * j) * T_ + m0 + ty + 16 * i] = f2bf(acc[i][j]);
    } };
struct EpGate { bf16_t* tmp;
    DEV void operator()(int m0, int n0, int ty, int tx, float (&acc)[4][4]) const {
#pragma unroll
        for (int i = 0; i < 4; ++i)
#pragma unroll
            for (int j = 0; j < 4; ++j) tmp[(size_t)(m0 + ty + 16 * i) * 1024 + n0 + tx + 16 * j] = f2bf(1.f / (1.f + expf(-acc[i][j])));
    } };
struct EpMerge { const bf16_t* tmp; bf16_t* merged; int first; int pad;
    DEV void operator()(int m0, int n0, int ty, int tx, float (&acc)[4][4]) const {
#pragma unroll
        for (int i = 0; i < 4; ++i)
#pragma unroll
            for (int j = 0; j < 4; ++j) { const size_t o = (size_t)(m0 + ty + 16 * i) * 1024 + n0 + tx + 16 * j; float v = bf2f(tmp[o]) * acc[i][j]; if (!first) v += bf2f(merged[o]); merged[o] = f2bf(v); }
    } };
struct EpOut { const float* xin; float* h; const float* ada_l; int off_g; int pad;
    DEV void operator()(int m0, int n0, int ty, int tx, float (&acc)[4][4]) const {
#pragma unroll
        for (int i = 0; i < 4; ++i)
#pragma unroll
            for (int j = 0; j < 4; ++j) { const int m = m0 + ty + 16 * i, n = n0 + tx + 16 * j; const size_t o = (size_t)m * 1024 + n;
                h[o] = ALPHA_ * xin[o] + ada_l[(size_t)(m >> 11) * 6144 + off_g + n] * acc[i][j]; }
    } };
struct EpQ2 { bf16_t* Q2;
    DEV void operator()(int m0, int n0, int ty, int tx, float (&acc)[4][4]) const {
#pragma unroll
        for (int i = 0; i < 4; ++i)
#pragma unroll
            for (int j = 0; j < 4; ++j) Q2[(size_t)(m0 + ty + 16 * i) * 2048 + n0 + tx + 16 * j] = f2bf(acc[i][j]);
    } };

__global__ void __launch_bounds__(256) k_attnA(bf16_t* __restrict__ P, float* __restrict__ lse2) {
    const int idx = blockIdx.x * 256 + threadIdx.x; const int s = idx & 2047, head = (idx >> 11) % 12, b = idx / (2048 * 12);
    const int gi = head >> 2; const int dil = gi == 0 ? 1 : (gi == 1 ? 4 : 16); const int ls = 2048 / dil; const int r = s % dil, p = s / dil;
    bf16_t* qrow = P + (size_t)(b * 2048 + s) * PW_ + head * 64;
    float q[64], o[64];
#pragma unroll
    for (int d = 0; d < 64; ++d) { q[d] = bf2f(qrow[d]); o[d] = 0.f; }
    float m = -1e30f, l = 0.f;
    const int lo = max(0, p - 64), hi = min(ls - 1, p + 64);
    for (int pp = lo; pp <= hi; ++pp) {
        const bf16_t* krow = P + (size_t)(b * 2048 + pp * dil + r) * PW_ + 768 + head * 64; const bf16_t* vrow = krow + 768;
        float sc = 0.f;
#pragma unroll
        for (int d = 0; d < 64; ++d) sc += q[d] * bf2f(krow[d]);
        const float mn = fmaxf(m, sc), corr = exp2f(m - mn), pw = exp2f(sc - mn);
        l = l * corr + pw;
#pragma unroll
        for (int d = 0; d < 64; ++d) o[d] = o[d] * corr + pw * bf2f(vrow[d]);
        m = mn;
    }
    const float inv = 1.f / l;
#pragma unroll
    for (int d = 0; d < 64; ++d) qrow[d] = f2bf(o[d] * inv);
    lse2[(size_t)(b * 2048 + s) * 12 + head] = m + log2f(l);
}

__global__ void __launch_bounds__(256) k_attnC(const bf16_t* __restrict__ P, const float* __restrict__ sink_l, bf16_t* __restrict__ Y) {
    const int idx = blockIdx.x * 256 + threadIdx.x; const int s = idx & 2047, qh = (idx >> 11) & 7, b = idx >> 14; const int kvh = qh >> 2;
    const bf16_t* qrow = P + (size_t)(b * 2048 + s) * PW_ + 2304 + qh * 64;
    float q[64], o[64];
#pragma unroll
    for (int d = 0; d < 64; ++d) { q[d] = bf2f(qrow[d]); o[d] = 0.f; }
    float m = -1e30f, l = 0.f;
    const int lo = max(0, s - 128), hi = min(2047, s + 128);
    for (int pp = lo; pp <= hi; ++pp) {
        const bf16_t* krow = P + (size_t)(b * 2048 + pp) * PW_ + 2816 + kvh * 64; const bf16_t* vrow = krow + 128;
        float sc = 0.f;
#pragma unroll
        for (int d = 0; d < 64; ++d) sc += q[d] * bf2f(krow[d]);
        const float mn = fmaxf(m, sc), corr = exp2f(m - mn), pw = exp2f(sc - mn);
        l = l * corr + pw;
#pragma unroll
        for (int d = 0; d < 64; ++d) o[d] = o[d] * corr + pw * bf2f(vrow[d]);
        m = mn;
    }
    const float sk = sink_l[qh] * LOG2E_; const float mf = fmaxf(m, sk); const float corr = exp2f(m - mf);
    l = l * corr + exp2f(sk - mf); const float inv = corr / l;
    bf16_t* yrow = Y + (size_t)(b * 2048 + s) * YW_ + 768 + qh * 64;
#pragma unroll
    for (int d = 0; d < 64; ++d) yrow[d] = f2bf(o[d] * inv);
}

__global__ void __launch_bounds__(256) k_combineA(const bf16_t* __restrict__ P, const float* __restrict__ lse2, bf16_t* __restrict__ Y) {
    const size_t idx = (size_t)blockIdx.x * 256 + threadIdx.x; const int cc = (int)(idx & 255); const size_t tok = idx >> 8; const int hh = cc >> 6, d = cc & 63;
    const float l0 = lse2[tok * 12 + hh], l1 = lse2[tok * 12 + 4 + hh], l2 = lse2[tok * 12 + 8 + hh]; const float mx = fmaxf(l0, fmaxf(l1, l2));
    const float w0 = exp2f(l0 - mx), w1 = exp2f(l1 - mx), w2 = exp2f(l2 - mx);
    const bf16_t* pr = P + tok * PW_ + hh * 64 + d;
    Y[tok * YW_ + cc] = f2bf((w0 * bf2f(pr[0]) + w1 * bf2f(pr[256]) + w2 * bf2f(pr[512])) / (w0 + w1 + w2));
}

__global__ void __launch_bounds__(256) k_hyena(int pass, bf16_t* __restrict__ hyT, bf16_t* __restrict__ z1T, const bf16_t* __restrict__ Gr_l, const float* __restrict__ conv_w,
                                                const float* __restrict__ conv_b, const float* __restrict__ hy_bias) {
    const size_t idx = (size_t)blockIdx.x * 256 + threadIdx.x; const int i = (int)(idx & 2047); const int b = (int)((idx >> 11) & 15); const int c = (int)(idx >> 15);
    const bf16_t* G = Gr_l + ((size_t)pass * 512 + c) * 4096 + (2047 - i);
    float acc = 0.f, zi = 0.f;
    if (pass == 0) {
        const bf16_t* in = hyT + (size_t)c * T_ + b * 2048; const float w0 = conv_w[c], w1 = conv_w[1536 + c], w2 = conv_w[3072 + c], cb = conv_b[c];
        float prev = 0.f, cur = bf2f(in[0]);
        for (int j = 0; j < 2048; ++j) { const float nxt = (j < 2047) ? bf2f(in[j + 1]) : 0.f; const float z = cb + w0 * prev + w1 * cur + w2 * nxt;
            acc += bf2f(G[j]) * z; if (j == i) zi = z; prev = cur; cur = nxt; }
    } else {
        const bf16_t* in = z1T + (size_t)c * T_ + b * 2048;
        for (int j = 0; j < 2048; ++j) { const float z = bf2f(in[j]); acc += bf2f(G[j]) * z; if (j == i) zi = z; }
    }
    const int xc = (pass == 0 ? 512 : 1024) + c;
    const bf16_t* xin = hyT + (size_t)xc * T_ + b * 2048;
    const float xm = (i > 0) ? bf2f(xin[i - 1]) : 0.f, x0 = bf2f(xin[i]), xp = (i < 2047) ? bf2f(xin[i + 1]) : 0.f;
    const float xv = conv_b[xc] + conv_w[xc] * xm + conv_w[1536 + xc] * x0 + conv_w[3072 + xc] * xp;
    const float outv = xv * (acc + hy_bias[pass * 512 + c] * zi);
    if (pass == 0) z1T[(size_t)c * T_ + b * 2048 + i] = f2bf(outv); else hyT[(size_t)c * T_ + b * 2048 + i] = f2bf(outv);
}

__global__ void __launch_bounds__(256) k_transY(const bf16_t* __restrict__ hyT, bf16_t* __restrict__ Y) {
    const size_t idx = (size_t)blockIdx.x * 256 + threadIdx.x; const int c = (int)(idx & 511); const size_t tok = idx >> 9;
    Y[tok * YW_ + 256 + c] = hyT[(size_t)c * T_ + tok];
}

__global__ void __launch_bounds__(256) k_ln_mod(float* __restrict__ h, const float* __restrict__ g, const float* __restrict__ bta, const float* __restrict__ ada_l, int off_sh, int off_sc,
                                                bf16_t* __restrict__ ubuf) {
    const int tok = blockIdx.x, t = threadIdx.x; float v[4]; float s = 0.f;
#pragma unroll
    for (int k = 0; k < 4; ++k) { v[k] = h[(size_t)tok * 1024 + t + 256 * k]; s += v[k]; }
    __shared__ float red[256]; red[t] = s; __syncthreads();
    for (int st = 128; st > 0; st >>= 1) { if (t < st) red[t] += red[t + st]; __syncthreads(); }
    const float mu = red[0] * (1.f / 1024.f); __syncthreads();
    float q = 0.f;
#pragma unroll
    for (int k = 0; k < 4; ++k) { const float dd = v[k] - mu; q += dd * dd; }
    red[t] = q; __syncthreads();
    for (int st = 128; st > 0; st >>= 1) { if (t < st) red[t] += red[t + st]; __syncthreads(); }
    const float rstd = rsqrtf(red[0] * (1.f / 1024.f) + LN_EPS_);
    const float* a = ada_l + (size_t)(tok >> 11) * 6144;
#pragma unroll
    for (int k = 0; k < 4; ++k) { const int d = t + 256 * k; const float y = (v[k] - mu) * rstd * g[d] + bta[d]; h[(size_t)tok * 1024 + d] = y;
        if (ubuf) ubuf[(size_t)tok * 1024 + d] = f2bf(y * (1.f + a[off_sc + d]) + a[off_sh + d]); }
}

__global__ void __launch_bounds__(128) k_peer_topk(const bf16_t* __restrict__ Q2, const float* __restrict__ keys_l, int* __restrict__ eidx, float* __restrict__ egate) {
    const int tok = blockIdx.x >> 3, h = blockIdx.x & 7, t = threadIdx.x;
    __shared__ float qs[256], s1[128], s2[128], t1v[16], t2v[16], cand[256], bestv[16];
    __shared__ int t1i[16], t2i[16], besti[16];
    qs[t] = bf2f(Q2[(size_t)tok * 2048 + h * 256 + t]); qs[t + 128] = bf2f(Q2[(size_t)tok * 2048 + h * 256 + 128 + t]);
    __syncthreads();
    { const float* k1 = keys_l + ((size_t)(h * 2 + 0) * 128 + t) * 128; const float* k2 = keys_l + ((size_t)(h * 2 + 1) * 128 + t) * 128; float a = 0.f, bsum = 0.f;
        for (int c = 0; c < 128; ++c) { a += qs[c] * k1[c]; bsum += qs[128 + c] * k2[c]; }
        s1[t] = a; s2[t] = bsum; }
    __syncthreads();
    { const float a = s1[t], bb = s2[t]; int r1 = 0, r2 = 0;
        for (int m = 0; m < 128; ++m) { const float x = s1[m], y = s2[m]; r1 += (x > a || (x == a && m < t)) ? 1 : 0; r2 += (y > bb || (y == bb && m < t)) ? 1 : 0; }
        if (r1 < 16) { t1v[r1] = a; t1i[r1] = t; } if (r2 < 16) { t2v[r2] = bb; t2i[r2] = t; } }
    __syncthreads();
    cand[t] = t1v[t >> 4] + t2v[t & 15]; cand[t + 128] = t1v[(t + 128) >> 4] + t2v[t & 15];
    __syncthreads();
#pragma unroll
    for (int rr = 0; rr < 2; ++rr) { const int ci = t + 128 * rr; const float a = cand[ci]; int r = 0;
        for (int m = 0; m < 256; ++m) { const float x = cand[m]; r += (x > a || (x == a && m < ci)) ? 1 : 0; }
        if (r < 16) { bestv[r] = a; besti[r] = ci; } }
    __syncthreads();
    if (t < 16) { const float mx = bestv[0]; float sum = 0.f;
        for (int k = 0; k < 16; ++k) sum += expf(bestv[k] - mx);
        const int ci = besti[t]; const size_t o = ((size_t)tok * 8 + h) * 16 + t;
        eidx[o] = ((t1i[(ci >> 4) & 15] & 127) * 128 + (t2i[ci & 15] & 127)); egate[o] = expf(bestv[t] - mx) / sum; }
}

__global__ void __launch_bounds__(256) k_peer(float* __restrict__ xio, const float* __restrict__ ada_l, const int* __restrict__ eidx, const float* __restrict__ egate,
                                              const float* __restrict__ pu, const float* __restrict__ pv, const float* __restrict__ g, const float* __restrict__ bta,
                                              const float* __restrict__ ada_next, bf16_t* __restrict__ ubuf) {
    const int tok = blockIdx.x, t = threadIdx.x, lane = t & 63, w = t >> 6;
    __shared__ float xs[1024], wv[128], red[256]; __shared__ int es[128];
    const float* a = ada_l + (size_t)(tok >> 11) * 6144; float x1[4];
#pragma unroll
    for (int k = 0; k < 4; ++k) { const int d = t + 256 * k; x1[k] = xio[(size_t)tok * 1024 + d]; xs[d] = x1[k] * (1.f + a[4096 + d]) + a[3072 + d]; }
    if (t < 128) es[t] = eidx[(size_t)tok * 128 + t];
    __syncthreads();
    for (int i = w; i < 128; i += 4) { const float* ur = pu + (size_t)es[i] * 1024; float dsum = 0.f;
#pragma unroll
        for (int k = 0; k < 16; ++k) dsum += ur[lane + 64 * k] * xs[lane + 64 * k];
#pragma unroll
        for (int off = 32; off > 0; off >>= 1) dsum += __shfl_xor(dsum, off);
        if (lane == 0) wv[i] = egate[(size_t)tok * 128 + i] * 0.5f * dsum * (1.f + erff(dsum * 0.70710678118654752f)); }
    __syncthreads();
    float acc[4] = {0.f, 0.f, 0.f, 0.f};
    for (int i = 0; i < 128; ++i) { const float* vr = pv + (size_t)es[i] * 1024; const float wi = wv[i];
#pragma unroll
        for (int k = 0; k < 4; ++k) acc[k] += wi * vr[t + 256 * k]; }
    float v[4]; float s = 0.f;
#pragma unroll
    for (int k = 0; k < 4; ++k) { v[k] = ALPHA_ * x1[k] + a[5120 + t + 256 * k] * acc[k]; s += v[k]; }
    red[t] = s; __syncthreads();
    for (int st = 128; st > 0; st >>= 1) { if (t < st) red[t] += red[t + st]; __syncthreads(); }
    const float mu = red[0] * (1.f / 1024.f); __syncthreads();
    float q = 0.f;
#pragma unroll
    for (int k = 0; k < 4; ++k) { const float dd = v[k] - mu; q += dd * dd; }
    red[t] = q; __syncthreads();
    for (int st = 128; st > 0; st >>= 1) { if (t < st) red[t] += red[t + st]; __syncthreads(); }
    const float rstd = rsqrtf(red[0] * (1.f / 1024.f) + LN_EPS_);
    const float* an = ada_next ? ada_next + (size_t)(tok >> 11) * 6144 : nullptr;
#pragma unroll
    for (int k = 0; k < 4; ++k) { const int d = t + 256 * k; const float y = (v[k] - mu) * rstd * g[d] + bta[d]; xio[(size_t)tok * 1024 + d] = y;
        if (an) ubuf[(size_t)tok * 1024 + d] = f2bf(y * (1.f + an[1024 + d]) + an[d]); }
}

extern "C" void kernel_launch(void* const* d_in, const int* in_sizes, int n_in, void* d_out, int out_size, void* d_ws, size_t ws_size, hipStream_t stream) {
    if (ws_size < WS_NEED) { fprintf(stderr, "workspace too small: %zu < %zu\n", ws_size, (size_t)WS_NEED); return; }
    const float* x = (const float*)d_in[0]; const float* c = (const float*)d_in[1]; const float* w_ada = (const float*)d_in[2]; const float* b_ada = (const float*)d_in[3];
    const float* w_in = (const float*)d_in[4]; const float* conv_w = (const float*)d_in[5]; const float* conv_b = (const float*)d_in[6];
    const float* hy_w1 = (const float*)d_in[7]; const float* hy_b1 = (const float*)d_in[8]; const float* hy_w2 = (const float*)d_in[9]; const float* hy_b2 = (const float*)d_in[10];
    const float* hy_w3 = (const float*)d_in[11]; const float* hy_freq = (const float*)d_in[12]; const float* hy_ld = (const float*)d_in[13]; const float* hy_bias = (const float*)d_in[14];
    const float* attn_sink = (const float*)d_in[15]; const float* wba = (const float*)d_in[16]; const float* wbb = (const float*)d_in[17]; const float* wbc = (const float*)d_in[18];
    const float* w_out = (const float*)d_in[19]; const float* ln_g = (const float*)d_in[20]; const float* ln_b = (const float*)d_in[21]; const float* peer_wq = (const float*)d_in[22];
    const float* peer_keys = (const float*)d_in[23]; const float* peer_u = (const float*)d_in[24]; const float* peer_v = (const float*)d_in[25];
    float* out = (float*)d_out; char* ws = (char*)d_ws;
    float* ada = (float*)(ws + OFF_ADA); float2* rope = (float2*)(ws + OFF_ROPE); bf16_t* Gr = (bf16_t*)(ws + OFF_GR); float* lse2 = (float*)(ws + OFF_LSE);
    bf16_t* ubuf = (bf16_t*)(ws + OFF_UBUF); bf16_t* P = (bf16_t*)(ws + OFF_P); bf16_t* hyT = (bf16_t*)(ws + OFF_HYT); bf16_t* Y = (bf16_t*)(ws + OFF_Y); bf16_t* z1T = (bf16_t*)(ws + OFF_Z1T);
    float* h2 = (float*)(ws + OFF_P); float* hf = (float*)(ws + OFF_P + 2 * MB_);
    bf16_t* merged = (bf16_t*)(ws + OFF_P); bf16_t* gtmp = (bf16_t*)(ws + OFF_P + 64 * MB_); bf16_t* Q2 = (bf16_t*)(ws + OFF_P);
    int* eidx = (int*)(ws + OFF_HYT); float* egate = (float*)(ws + OFF_HYT + 16 * MB_);

    k_ada<<<48, 256, 0, stream>>>(c, w_ada, b_ada, ada);
    k_rope<<<256, 256, 0, stream>>>(rope);
    k_filt_h2<<<4096, 64, 0, stream>>>(hy_w1, hy_b1, hy_w2, hy_b2, hy_freq, h2);
    k_filt_full<<<32768, 256, 0, stream>>>(h2, hy_w3, hy_ld, hf);
    k_filt_norm<<<2048, 256, 0, stream>>>(hf, Gr);
    k_modulate<<<T_ * 1024 / 256, 256, 0, stream>>>(x, ada, 0, 1024, ubuf);
    for (int l = 0; l < 2; ++l) {
        const float* ada_l = ada + (size_t)l * 16 * 6144; const float* w_in_l = w_in + (size_t)l * 1024 * 7680;
        const float* xin = (l == 0) ? x : out;
        k_gemm_naive<<<dim3(PW_ / 64, T_ / 64), 256, 0, stream>>>(1024, ALbf{ubuf, 1024, 0}, WLinP{w_in_l}, EpP{P, rope});
        k_gemm_naive<<<dim3(1536 / 64, T_ / 64), 256, 0, stream>>>(1024, ALbf{ubuf, 1024, 0}, WLf{w_in_l, 7680, 2304}, EpHyT{hyT});
        for (int pass = 0; pass < 2; ++pass)
            k_hyena<<<512 * T_ / 256, 256, 0, stream>>>(pass, hyT, z1T, Gr + (size_t)l * 2 * 512 * 4096, conv_w + (size_t)l * 3 * 1536, conv_b + (size_t)l * 1536, hy_bias + (size_t)l * 1024);
        k_attnA<<<T_ * 12 / 256, 256, 0, stream>>>(P, lse2);
        k_attnC<<<T_ * 8 / 256, 256, 0, stream>>>(P, attn_sink + l * 8, Y);
        k_combineA<<<T_, 256, 0, stream>>>(P, lse2, Y);
        k_transY<<<T_ * 512 / 256, 256, 0, stream>>>(hyT, Y);
        const float* wbr[3] = {wba + (size_t)l * 256 * 1024, wbb + (size_t)l * 512 * 1024, wbc + (size_t)l * 512 * 1024}; const int kb[3] = {256, 512, 512}, koff[3] = {0, 256, 768};
        for (int br = 0; br < 3; ++br) {
            k_gemm_naive<<<dim3(1024 / 64, T_ / 64), 256, 0, stream>>>(1024, ALbf{ubuf, 1024, 0}, WLf{w_in_l, 7680, 4608 + br * 1024}, EpGate{gtmp});
            k_gemm_naive<<<dim3(1024 / 64, T_ / 64), 256, 0, stream>>>(kb[br], ALbf{Y + koff[br], YW_, 0}, WLf{wbr[br], 1024, 0}, EpMerge{gtmp, merged, br == 0 ? 1 : 0, 0});
        }
        k_gemm_naive<<<dim3(1024 / 64, T_ / 64), 256, 0, stream>>>(1024, ALbf{merged, 1024, 0}, WLf{w_out + (size_t)l * 1024 * 1024, 1024, 0}, EpOut{xin, out, ada_l, 2048, 0});
        k_ln_mod<<<T_, 256, 0, stream>>>(out, ln_g + (size_t)(l * 2 + 0) * 1024, ln_b + (size_t)(l * 2 + 0) * 1024, ada_l, 3072, 4096, ubuf);
        k_gemm_naive<<<dim3(2048 / 64, T_ / 64), 256, 0, stream>>>(1024, ALbf{ubuf, 1024, 0}, WLf{peer_wq + (size_t)l * 1024 * 2048, 2048, 0}, EpQ2{Q2});
        k_peer_topk<<<T_ * 8, 128, 0, stream>>>(Q2, peer_keys + (size_t)l * 8 * 2 * 128 * 128, eidx, egate);
        k_peer<<<T_, 256, 0, stream>>>(out, ada_l, eidx, egate, peer_u + (size_t)l * 16384 * 1024, peer_v + (size_t)l * 16384 * 1024,
                                       ln_g + (size_t)(l * 2 + 1) * 1024, ln_b + (size_t)(l * 2 + 1) * 1024, (l == 0) ? ada + (size_t)16 * 6144 : nullptr, ubuf);
    }
}
```

```cpp
#include <hip/hip_runtime.h>
#include <hip/hip_cooperative_groups.h>
namespace cg = cooperative_groups;
#include <stdint.h>
#include <stdio.h>

#define DEV __device__ __forceinline__
typedef unsigned short bf16_t;

constexpr int D_ = 1024, B_ = 16, S_ = 2048, T_ = B_ * S_;
constexpr float ALPHA_ = 1.41421356237309515f;
constexpr float LOG2E_ = 1.4426950408889634f;
constexpr float QSCALE_ = 0.125f * 1.4426950408889634f;
constexpr float LN_EPS_ = 1e-5f;
constexpr int PW_ = 3072;
constexpr int YW_ = 1280;

constexpr size_t MB_ = 1024 * 1024;
constexpr size_t OFF_ADA = 0, OFF_ROPE = 1 * MB_, OFF_GR = 2 * MB_, OFF_LSE = 18 * MB_, OFF_WINT = 20 * MB_, OFF_WBRT = 50 * MB_,
                 OFF_WOUTT = 55 * MB_, OFF_WQT = 59 * MB_, OFF_KEYS = 67 * MB_, OFF_UBUF = 68 * MB_, OFF_P = 132 * MB_, OFF_HYT = 324 * MB_,
                 OFF_Y = 420 * MB_, OFF_Z1T = 420 * MB_  , WS_NEED = 500 * MB_;

DEV float bf2f(bf16_t v) { return __uint_as_float(((unsigned)v) << 16); }
DEV bf16_t f2bf(float f) { unsigned u = __float_as_uint(f); u += 0x7FFFu + ((u >> 16) & 1u); return (bf16_t)(u >> 16); }

DEV void nb_ada(int vb, int t, unsigned char* sm, const float* __restrict__ c, const float* __restrict__ w_ada, const float* __restrict__ b_ada, float* __restrict__ ada) {
    const int idx = vb * 256 + t; const int l = idx / 6144, n = idx % 6144;
    float (*cond)[64] = (float (*)[64])sm;
    float acc[16];
#pragma unroll
    for (int b = 0; b < 16; ++b) acc[b] = b_ada[l * 6144 + n];
    for (int k0 = 0; k0 < 1024; k0 += 64) {
        for (int i = t; i < 1024; i += 256) { const int b = i >> 6, kk = i & 63; const float v = c[b * 1024 + k0 + kk]; cond[b][kk] = v / (1.f + expf(-v)); }
        __syncthreads();
        for (int kk = 0; kk < 64; ++kk) { const float w = w_ada[((size_t)l * 1024 + k0 + kk) * 6144 + n];
#pragma unroll
            for (int b = 0; b < 16; ++b) acc[b] += cond[b][kk] * w; }
        __syncthreads();
    }
#pragma unroll
    for (int b = 0; b < 16; ++b) ada[((size_t)l * 16 + b) * 6144 + n] = acc[b];
}

DEV void nb_rope(int vb, int t, unsigned char* sm, float2* __restrict__ rope) {
    const int idx = vb * 256 + t; const int s = idx >> 5, i = idx & 31;
    const float inv = powf(10000.f, -(float)i / 32.f); const float ang = (float)s * inv;
    rope[idx] = make_float2(cosf(ang), sinf(ang));
}

DEV void nb_filt_h2(int vb, int t, unsigned char* sm, const float* __restrict__ w1, const float* __restrict__ b1, const float* __restrict__ w2, const float* __restrict__ b2,
                                                const float* __restrict__ freq, float* __restrict__ h2) {
    const int grp = t >> 6, j = t & 63; const int lt = vb * 4 + grp; const int l = lt / 2048, tt = lt % 2048;
    float* z = (float*)sm + grp * 128; float* h1 = z + 64;
    if (j < 33) {
        const float idx = (float)tt, tn = idx / 2047.f, w = 6.283185307179586f * idx / 2048.f;
        if (j == 0) z[0] = tn;
        else { const int k = (j <= 16) ? (j - 1) : (j - 17); const float band = 1e-4f + (float)k * ((15.f - 1e-4f) / 15.f); const float ang = w * band;
            z[j] = (j <= 16) ? cosf(ang) : -sinf(ang); }
    }
    __syncthreads();
    float a = b1[l * 64 + j];
    for (int e = 0; e < 33; ++e) a += z[e] * w1[(l * 33 + e) * 64 + j];
    h1[j] = sinf(freq[(l * 2 + 0) * 64 + j] * a);
    __syncthreads();
    float a2 = b2[l * 64 + j];
    for (int i = 0; i < 64; ++i) a2 += h1[i] * w2[(l * 64 + i) * 64 + j];
    h2[((size_t)l * 2048 + tt) * 64 + j] = sinf(freq[(l * 2 + 1) * 64 + j] * a2);
}

DEV void nb_filt_full(int vb, int t, unsigned char* sm, const float* __restrict__ h2, const float* __restrict__ w3, const float* __restrict__ log_decay, float* __restrict__ hf) {
    const size_t idx = (size_t)vb * 256 + t; const int col = (int)(idx & 2047), tt = (int)((idx >> 11) & 2047), l = (int)(idx >> 22);
    const float* hr = h2 + ((size_t)l * 2048 + tt) * 64; float a = 0.f;
    for (int j = 0; j < 64; ++j) a += hr[j] * w3[((size_t)l * 64 + j) * 2048 + col];
    const float tn = (float)tt / 2047.f;
    hf[idx] = a * expf(-tn * expf(log_decay[l * 2048 + col]));
}

DEV void nb_filt_norm(int vb, int t, unsigned char* sm, const float* __restrict__ hf, bf16_t* __restrict__ Gr) {
    const int blk = vb; const int c = blk & 511, o = (blk >> 9) & 1, l = blk >> 10;
    const float* base = hf + (size_t)l * 2048 * 2048; const int colf = o * 512 + c, colb = 1024 + o * 512 + c;
    float ss = 0.f;
    for (int tt = t; tt < 2048; tt += 256) { const float a = base[(size_t)tt * 2048 + colf]; ss += a * a; if (tt >= 1) { const float bb = base[(size_t)tt * 2048 + colb]; ss += bb * bb; } }
    float* red = (float*)sm; red[t] = ss; __syncthreads();
    for (int st = 128; st > 0; st >>= 1) { if (t < st) red[t] += red[t + st]; __syncthreads(); }
    const float scale = rsqrtf(red[0] + 1e-12f); __syncthreads();
    bf16_t* g = Gr + (size_t)blk * 4096;
    for (int n = t; n < 4096; n += 256) { const int lag = 2047 - n; float v = 0.f;
        if (n < 4095) v = (lag >= 0) ? base[(size_t)lag * 2048 + colf] : base[(size_t)(-lag) * 2048 + colb];
        g[n] = f2bf(v * scale); }
}

DEV void nb_modulate(int vb, int t, unsigned char* sm, const float* __restrict__ x, const float* __restrict__ ada_l, int off_sh, int off_sc, bf16_t* __restrict__ ubuf) {
    const size_t idx = (size_t)vb * 256 + t; const int d = (int)(idx & 1023); const int b = (int)(idx >> 21);
    const float* a = ada_l + (size_t)b * 6144;
    ubuf[idx] = f2bf(x[idx] * (1.f + a[off_sc + d]) + a[off_sh + d]);
}

template <class AL, class WL, class EP>
DEV void nb_gemm(int vb, int t, unsigned char* sm, int nbx, int K, AL al, WL wl, EP ep) {
    float (*As)[65] = (float (*)[65])sm;
    float (*Ws)[65] = (float (*)[65])(sm + 16 * 65 * 4);
    const int tx = t & 15, ty = t >> 4;
    const int m0 = (vb / nbx) * 64, n0 = (vb % nbx) * 64;
    float acc[4][4];
#pragma unroll
    for (int i = 0; i < 4; ++i)
#pragma unroll
        for (int j = 0; j < 4; ++j) acc[i][j] = 0.f;
    for (int k0 = 0; k0 < K; k0 += 16) {
#pragma unroll
        for (int r = 0; r < 4; ++r) { const int i = t + r * 256; const int mm = i >> 4, kk = i & 15; As[kk][mm] = al(m0 + mm, k0 + kk); }
#pragma unroll
        for (int r = 0; r < 4; ++r) { const int i = t + r * 256; const int kk = i >> 6, nn = i & 63; Ws[kk][nn] = wl(k0 + kk, n0 + nn); }
        __syncthreads();
#pragma unroll
        for (int kk = 0; kk < 16; ++kk) {
            float a[4], w[4];
#pragma unroll
            for (int i = 0; i < 4; ++i) { a[i] = As[kk][ty + 16 * i]; w[i] = Ws[kk][tx + 16 * i]; }
#pragma unroll
            for (int i = 0; i < 4; ++i)
#pragma unroll
                for (int j = 0; j < 4; ++j) acc[i][j] += a[i] * w[j];
        }
        __syncthreads();
    }
    ep(m0, n0, ty, tx, acc);
}

struct ALbf { const bf16_t* A; int lda; int pad; DEV float operator()(int m, int k) const { return bf2f(A[(size_t)m * lda + k]); } };
struct WLf { const float* W; int ldw; int coff; DEV float operator()(int k, int n) const { return W[(size_t)k * ldw + coff + n]; } };
struct WLinP { const float* W; DEV float operator()(int k, int n) const { return W[(size_t)k * 7680 + (n < 2304 ? n : n + 1536)]; } };

struct EpP { bf16_t* P; const float2* rope;
    DEV void operator()(int m0, int n0, int ty, int tx, float (&acc)[4][4]) const {
        const int head = n0 >> 6; const bool rp = (head < 24) || (head >= 36 && head < 46); const bool qs = (head < 12) || (head >= 36 && head < 44);
#pragma unroll
        for (int i = 0; i < 4; ++i) { const int m = m0 + ty + 16 * i; const int s = m & 2047; bf16_t* row = P + (size_t)m * PW_ + n0;
            if (rp) {
#pragma unroll
                for (int jj = 0; jj < 2; ++jj) { const int d = tx + 16 * jj; const float x1 = acc[i][jj], x2 = acc[i][jj + 2]; const float2 cs = rope[s * 32 + d];
                    float o1 = x1 * cs.x - x2 * cs.y, o2 = x2 * cs.x + x1 * cs.y; if (qs) { o1 *= QSCALE_; o2 *= QSCALE_; }
                    const int p1 = 8 * (d >> 2) + (d & 3); row[p1] = f2bf(o1); row[p1 + 4] = f2bf(o2); }
            } else {
#pragma unroll
                for (int j = 0; j < 4; ++j) row[tx + 16 * j] = f2bf(acc[i][j]);
            } }
    } };
struct EpHyT { bf16_t* hyT;
    DEV void operator()(int m0, int n0, int ty, int tx, float (&acc)[4][4]) const {
#pragma unroll
        for (int i = 0; i < 4; ++i)
#pragma unroll
            for (int j = 0; j < 4; ++j) hyT[(size_t)(n0 + tx + 16 * j) * T_ + m0 + ty + 16 * i] = f2bf(acc[i][j]);
    } };
struct EpGate { bf16_t* tmp;
    DEV void operator()(int m0, int n0, int ty, int tx, float (&acc)[4][4]) const {
#pragma unroll
        for (int i = 0; i < 4; ++i)
#pragma unroll
            for (int j = 0; j < 4; ++j) tmp[(size_t)(m0 + ty + 16 * i) * 1024 + n0 + tx + 16 * j] = f2bf(1.f / (1.f + expf(-acc[i][j])));
    } };
struct EpMerge { const bf16_t* tmp; bf16_t* merged; int first; int pad;
    DEV void operator()(int m0, int n0, int ty, int tx, float (&acc)[4][4]) const {
#pragma unroll
        for (int i = 0; i < 4; ++i)
#pragma unroll
            for (int j = 0; j < 4; ++j) { const size_t o = (size_t)(m0 + ty + 16 * i) * 1024 + n0 + tx + 16 * j; float v = bf2f(tmp[o]) * acc[i][j]; if (!first) v += bf2f(merged[o]); merged[o] = f2bf(v); }
    } };
struct EpOut { const float* xin; float* h; const float* ada_l; int off_g; int pad;
    DEV void operator()(int m0, int n0, int ty, int tx, float (&acc)[4][4]) const {
#pragma unroll
        for (int i = 0; i < 4; ++i)
#pragma unroll
            for (int j = 0; j < 4; ++j) { const int m = m0 + ty + 16 * i, n = n0 + tx + 16 * j; const size_t o = (size_t)m * 1024 + n;
                h[o] = ALPHA_ * xin[o] + ada_l[(size_t)(m >> 11) * 6144 + off_g + n] * acc[i][j]; }
    } };
struct EpQ2 { bf16_t* Q2;
    DEV void operator()(int m0, int n0, int ty, int tx, float (&acc)[4][4]) const {
#pragma unroll
        for (int i = 0; i < 4; ++i)
#pragma unroll
            for (int j = 0; j < 4; ++j) Q2[(size_t)(m0 + ty + 16 * i) * 2048 + n0 + tx + 16 * j] = f2bf(acc[i][j]);
    } };

DEV void nb_attnA(int vb, int t, unsigned char* sm, bf16_t* __restrict__ P, float* __restrict__ lse2) {
    const int idx = vb * 256 + t; const int s = idx & 2047, head = (idx >> 11) % 12, b = idx / (2048 * 12);
    const int gi = head >> 2; const int dil = gi == 0 ? 1 : (gi == 1 ? 4 : 16); const int ls = 2048 / dil; const int r = s % dil, p = s / dil;
    bf16_t* qrow = P + (size_t)(b * 2048 + s) * PW_ + head * 64;
    float q[64], o[64];
#pragma unroll
    for (int d = 0; d < 64; ++d) { q[d] = bf2f(qrow[d]); o[d] = 0.f; }
    float m = -1e30f, l = 0.f;
    const int lo = max(0, p - 64), hi = min(ls - 1, p + 64);
    for (int pp = lo; pp <= hi; ++pp) {
        const bf16_t* krow = P + (size_t)(b * 2048 + pp * dil + r) * PW_ + 768 + head * 64; const bf16_t* vrow = krow + 768;
        float sc = 0.f;
#pragma unroll
        for (int d = 0; d < 64; ++d) sc += q[d] * bf2f(krow[d]);
        const float mn = fmaxf(m, sc), corr = exp2f(m - mn), pw = exp2f(sc - mn);
        l = l * corr + pw;
#pragma unroll
        for (int d = 0; d < 64; ++d) o[d] = o[d] * corr + pw * bf2f(vrow[d]);
        m = mn;
    }
    const float inv = 1.f / l;
#pragma unroll
    for (int d = 0; d < 64; ++d) qrow[d] = f2bf(o[d] * inv);
    lse2[(size_t)(b * 2048 + s) * 12 + head] = m + log2f(l);
}

DEV void nb_attnC(int vb, int t, unsigned char* sm, const bf16_t* __restrict__ P, const float* __restrict__ sink_l, bf16_t* __restrict__ Y) {
    const int idx = vb * 256 + t; const int s = idx & 2047, qh = (idx >> 11) & 7, b = idx >> 14; const int kvh = qh >> 2;
    const bf16_t* qrow = P + (size_t)(b * 2048 + s) * PW_ + 2304 + qh * 64;
    float q[64], o[64];
#pragma unroll
    for (int d = 0; d < 64; ++d) { q[d] = bf2f(qrow[d]); o[d] = 0.f; }
    float m = -1e30f, l = 0.f;
    const int lo = max(0, s - 128), hi = min(2047, s + 128);
    for (int pp = lo; pp <= hi; ++pp) {
        const bf16_t* krow = P + (size_t)(b * 2048 + pp) * PW_ + 2816 + kvh * 64; const bf16_t* vrow = krow + 128;
        float sc = 0.f;
#pragma unroll
        for (int d = 0; d < 64; ++d) sc += q[d] * bf2f(krow[d]);
        const float mn = fmaxf(m, sc), corr = exp2f(m - mn), pw = exp2f(sc - mn);
        l = l * corr + pw;
#pragma unroll
        for (int d = 0; d < 64; ++d) o[d] = o[d] * corr + pw * bf2f(vrow[d]);
        m = mn;
    }
    const float sk = sink_l[qh] * LOG2E_; const float mf = fmaxf(m, sk); const float corr = exp2f(m - mf);
    l = l * corr + exp2f(sk - mf); const float inv = corr / l;
    bf16_t* yrow = Y + (size_t)(b * 2048 + s) * YW_ + 768 + qh * 64;
#pragma unroll
    for (int d = 0; d < 64; ++d) yrow[d] = f2bf(o[d] * inv);
}

DEV void nb_combineA(int vb, int t, unsigned char* sm, const bf16_t* __restrict__ P, const float* __restrict__ lse2, bf16_t* __restrict__ Y) {
    const size_t idx = (size_t)vb * 256 + t; const int cc = (int)(idx & 255); const size_t tok = idx >> 8; const int hh = cc >> 6, d = cc & 63;
    const float l0 = lse2[tok * 12 + hh], l1 = lse2[tok * 12 + 4 + hh], l2 = lse2[tok * 12 + 8 + hh]; const float mx = fmaxf(l0, fmaxf(l1, l2));
    const float w0 = exp2f(l0 - mx), w1 = exp2f(l1 - mx), w2 = exp2f(l2 - mx);
    const bf16_t* pr = P + tok * PW_ + hh * 64 + d;
    Y[tok * YW_ + cc] = f2bf((w0 * bf2f(pr[0]) + w1 * bf2f(pr[256]) + w2 * bf2f(pr[512])) / (w0 + w1 + w2));
}

DEV void nb_hyena(int vb, int t, unsigned char* sm, int pass, bf16_t* __restrict__ hyT, bf16_t* __restrict__ z1T, const bf16_t* __restrict__ Gr_l, const float* __restrict__ conv_w,
                                                const float* __restrict__ conv_b, const float* __restrict__ hy_bias) {
    const size_t idx = (size_t)vb * 256 + t; const int i = (int)(idx & 2047); const int b = (int)((idx >> 11) & 15); const int c = (int)(idx >> 15);
    const bf16_t* G = Gr_l + ((size_t)pass * 512 + c) * 4096 + (2047 - i);
    float acc = 0.f, zi = 0.f;
    if (pass == 0) {
        const bf16_t* in = hyT + (size_t)c * T_ + b * 2048; const float w0 = conv_w[c], w1 = conv_w[1536 + c], w2 = conv_w[3072 + c], cb = conv_b[c];
        float prev = 0.f, cur = bf2f(in[0]);
        for (int j = 0; j < 2048; ++j) { const float nxt = (j < 2047) ? bf2f(in[j + 1]) : 0.f; const float z = cb + w0 * prev + w1 * cur + w2 * nxt;
            acc += bf2f(G[j]) * z; if (j == i) zi = z; prev = cur; cur = nxt; }
    } else {
        const bf16_t* in = z1T + (size_t)c * T_ + b * 2048;
        for (int j = 0; j < 2048; ++j) { const float z = bf2f(in[j]); acc += bf2f(G[j]) * z; if (j == i) zi = z; }
    }
    const int xc = (pass == 0 ? 512 : 1024) + c;
    const bf16_t* xin = hyT + (size_t)xc * T_ + b * 2048;
    const float xm = (i > 0) ? bf2f(xin[i - 1]) : 0.f, x0 = bf2f(xin[i]), xp = (i < 2047) ? bf2f(xin[i + 1]) : 0.f;
    const float xv = conv_b[xc] + conv_w[xc] * xm + conv_w[1536 + xc] * x0 + conv_w[3072 + xc] * xp;
    const float outv = xv * (acc + hy_bias[pass * 512 + c] * zi);
    if (pass == 0) z1T[(size_t)c * T_ + b * 2048 + i] = f2bf(outv); else hyT[(size_t)c * T_ + b * 2048 + i] = f2bf(outv);
}

DEV void nb_transY(int vb, int t, unsigned char* sm, const bf16_t* __restrict__ hyT, bf16_t* __restrict__ Y) {
    const size_t idx = (size_t)vb * 256 + t; const int c = (int)(idx & 511); const size_t tok = idx >> 9;
    Y[tok * YW_ + 256 + c] = hyT[(size_t)c * T_ + tok];
}

DEV void nb_ln_mod(int vb, int t, unsigned char* sm, float* __restrict__ h, const float* __restrict__ g, const float* __restrict__ bta, const float* __restrict__ ada_l, int off_sh, int off_sc,
                                                bf16_t* __restrict__ ubuf) {
    const int tok = vb; float v[4]; float s = 0.f;
#pragma unroll
    for (int k = 0; k < 4; ++k) { v[k] = h[(size_t)tok * 1024 + t + 256 * k]; s += v[k]; }
    float* red = (float*)sm; red[t] = s; __syncthreads();
    for (int st = 128; st > 0; st >>= 1) { if (t < st) red[t] += red[t + st]; __syncthreads(); }
    const float mu = red[0] * (1.f / 1024.f); __syncthreads();
    float q = 0.f;
#pragma unroll
    for (int k = 0; k < 4; ++k) { const float dd = v[k] - mu; q += dd * dd; }
    red[t] = q; __syncthreads();
    for (int st = 128; st > 0; st >>= 1) { if (t < st) red[t] += red[t + st]; __syncthreads(); }
    const float rstd = rsqrtf(red[0] * (1.f / 1024.f) + LN_EPS_);
    const float* a = ada_l + (size_t)(tok >> 11) * 6144;
#pragma unroll
    for (int k = 0; k < 4; ++k) { const int d = t + 256 * k; const float y = (v[k] - mu) * rstd * g[d] + bta[d]; h[(size_t)tok * 1024 + d] = y;
        if (ubuf) ubuf[(size_t)tok * 1024 + d] = f2bf(y * (1.f + a[off_sc + d]) + a[off_sh + d]); }
}

DEV void nb_peer_topk(int vb, int t, unsigned char* sm, const bf16_t* __restrict__ Q2, const float* __restrict__ keys_l, int* __restrict__ eidx, float* __restrict__ egate) {
    const int grp = t >> 7; const int th = vb * 2 + grp; const int tok = th >> 3, h = th & 7; t &= 127;
    float* qs = (float*)sm + grp * 1024; float* s1 = qs + 256; float* s2 = s1 + 128; float* t1v = s2 + 128; float* t2v = t1v + 16; float* cand = t2v + 16; float* bestv = cand + 256;
    int* t1i = (int*)(bestv + 16); int* t2i = t1i + 16; int* besti = t2i + 16;
    qs[t] = bf2f(Q2[(size_t)tok * 2048 + h * 256 + t]); qs[t + 128] = bf2f(Q2[(size_t)tok * 2048 + h * 256 + 128 + t]);
    __syncthreads();
    { const float* k1 = keys_l + ((size_t)(h * 2 + 0) * 128 + t) * 128; const float* k2 = keys_l + ((size_t)(h * 2 + 1) * 128 + t) * 128; float a = 0.f, bsum = 0.f;
        for (int c = 0; c < 128; ++c) { a += qs[c] * k1[c]; bsum += qs[128 + c] * k2[c]; }
        s1[t] = a; s2[t] = bsum; }
    __syncthreads();
    { const float a = s1[t], bb = s2[t]; int r1 = 0, r2 = 0;
        for (int m = 0; m < 128; ++m) { const float x = s1[m], y = s2[m]; r1 += (x > a || (x == a && m < t)) ? 1 : 0; r2 += (y > bb || (y == bb && m < t)) ? 1 : 0; }
        if (r1 < 16) { t1v[r1] = a; t1i[r1] = t; } if (r2 < 16) { t2v[r2] = bb; t2i[r2] = t; } }
    __syncthreads();
    cand[t] = t1v[t >> 4] + t2v[t & 15]; cand[t + 128] = t1v[(t + 128) >> 4] + t2v[t & 15];
    __syncthreads();
#pragma unroll
    for (int rr = 0; rr < 2; ++rr) { const int ci = t + 128 * rr; const float a = cand[ci]; int r = 0;
        for (int m = 0; m < 256; ++m) { const float x = cand[m]; r += (x > a || (x == a && m < ci)) ? 1 : 0; }
        if (r < 16) { bestv[r] = a; besti[r] = ci; } }
    __syncthreads();
    if (t < 16) { const float mx = bestv[0]; float sum = 0.f;
        for (int k = 0; k < 16; ++k) sum += expf(bestv[k] - mx);
        const int ci = besti[t]; const size_t o = ((size_t)tok * 8 + h) * 16 + t;
        eidx[o] = ((t1i[(ci >> 4) & 15] & 127) * 128 + (t2i[ci & 15] & 127)); egate[o] = expf(bestv[t] - mx) / sum; }
}

DEV void nb_peer(int vb, int t, unsigned char* sm, float* __restrict__ xio, const float* __restrict__ ada_l, const int* __restrict__ eidx, const float* __restrict__ egate,
                                              const float* __restrict__ pu, const float* __restrict__ pv, const float* __restrict__ g, const float* __restrict__ bta,
                                              const float* __restrict__ ada_next, bf16_t* __restrict__ ubuf) {
    const int tok = vb, lane = t & 63, w = t >> 6;
    float* xs = (float*)sm; float* wv = xs + 1024; float* red = wv + 128; int* es = (int*)(red + 256);
    const float* a = ada_l + (size_t)(tok >> 11) * 6144; float x1[4];
#pragma unroll
    for (int k = 0; k < 4; ++k) { const int d = t + 256 * k; x1[k] = xio[(size_t)tok * 1024 + d]; xs[d] = x1[k] * (1.f + a[4096 + d]) + a[3072 + d]; }
    if (t < 128) es[t] = eidx[(size_t)tok * 128 + t];
    __syncthreads();
    for (int i = w; i < 128; i += 4) { const float* ur = pu + (size_t)es[i] * 1024; float dsum = 0.f;
#pragma unroll
        for (int k = 0; k < 16; ++k) dsum += ur[lane + 64 * k] * xs[lane + 64 * k];
#pragma unroll
        for (int off = 32; off > 0; off >>= 1) dsum += __shfl_xor(dsum, off);
        if (lane == 0) wv[i] = egate[(size_t)tok * 128 + i] * 0.5f * dsum * (1.f + erff(dsum * 0.70710678118654752f)); }
    __syncthreads();
    float acc[4] = {0.f, 0.f, 0.f, 0.f};
    for (int i = 0; i < 128; ++i) { const float* vr = pv + (size_t)es[i] * 1024; const float wi = wv[i];
#pragma unroll
        for (int k = 0; k < 4; ++k) acc[k] += wi * vr[t + 256 * k]; }
    float v[4]; float s = 0.f;
#pragma unroll
    for (int k = 0; k < 4; ++k) { v[k] = ALPHA_ * x1[k] + a[5120 + t + 256 * k] * acc[k]; s += v[k]; }
    red[t] = s; __syncthreads();
    for (int st = 128; st > 0; st >>= 1) { if (t < st) red[t] += red[t + st]; __syncthreads(); }
    const float mu = red[0] * (1.f / 1024.f); __syncthreads();
    float q = 0.f;
#pragma unroll
    for (int k = 0; k < 4; ++k) { const float dd = v[k] - mu; q += dd * dd; }
    red[t] = q; __syncthreads();
    for (int st = 128; st > 0; st >>= 1) { if (t < st) red[t] += red[t + st]; __syncthreads(); }
    const float rstd = rsqrtf(red[0] * (1.f / 1024.f) + LN_EPS_);
    const float* an = ada_next ? ada_next + (size_t)(tok >> 11) * 6144 : nullptr;
#pragma unroll
    for (int k = 0; k < 4; ++k) { const int d = t + 256 * k; const float y = (v[k] - mu) * rstd * g[d] + bta[d]; xio[(size_t)tok * 1024 + d] = y;
        if (an) ubuf[(size_t)tok * 1024 + d] = f2bf(y * (1.f + an[1024 + d]) + an[d]); }
}

struct Params {
    const float *x, *c, *w_ada, *b_ada, *w_in, *conv_w, *conv_b, *hy_w1, *hy_b1, *hy_w2, *hy_b2, *hy_w3, *hy_freq, *hy_ld, *hy_bias, *attn_sink, *wba, *wbb, *wbc, *w_out, *ln_g, *ln_b,
        *peer_wq, *peer_keys, *peer_u, *peer_v;
    float* out; char* ws;
};
constexpr int LDS_BYTES = 32 * 1024;

#define RUN(nvb, call) do { int tid_ = threadIdx.x; asm volatile("" : "+v"(tid_)); const int t = tid_ & 255, sub = tid_ >> 8; unsigned char* sm = lds + sub * 16384; \
        for (int vb = (int)blockIdx.x * 2 + sub; vb < (nvb); vb += (int)gridDim.x * 2) { call; __syncthreads(); } } while (0)
#define GSYNC() do { __builtin_amdgcn_sched_barrier(0); grid.sync(); __builtin_amdgcn_sched_barrier(0); } while (0)

__global__ void __launch_bounds__(512, 2) mega(Params p) {
    extern __shared__ __attribute__((aligned(16))) unsigned char lds[];
    cg::grid_group grid = cg::this_grid();
    char* ws = p.ws; float* out = p.out;
    float* ada = (float*)(ws + OFF_ADA); float2* rope = (float2*)(ws + OFF_ROPE); bf16_t* Gr = (bf16_t*)(ws + OFF_GR); float* lse2 = (float*)(ws + OFF_LSE);
    bf16_t* ubuf = (bf16_t*)(ws + OFF_UBUF); bf16_t* P = (bf16_t*)(ws + OFF_P); bf16_t* hyT = (bf16_t*)(ws + OFF_HYT); bf16_t* Y = (bf16_t*)(ws + OFF_Y); bf16_t* z1T = (bf16_t*)(ws + OFF_Z1T);
    float* h2 = (float*)(ws + OFF_P); float* hf = (float*)(ws + OFF_P + 2 * MB_);
    bf16_t* merged = (bf16_t*)(ws + OFF_P); bf16_t* gtmp = (bf16_t*)(ws + OFF_P + 64 * MB_); bf16_t* Q2 = (bf16_t*)(ws + OFF_P);
    int* eidx = (int*)(ws + OFF_HYT); float* egate = (float*)(ws + OFF_HYT + 16 * MB_);

    RUN(48, nb_ada(vb, t, sm, p.c, p.w_ada, p.b_ada, ada));
    RUN(256, nb_rope(vb, t, sm, rope));
    RUN(1024, nb_filt_h2(vb, t, sm, p.hy_w1, p.hy_b1, p.hy_w2, p.hy_b2, p.hy_freq, h2));
    GSYNC();
    RUN(32768, nb_filt_full(vb, t, sm, h2, p.hy_w3, p.hy_ld, hf));
    RUN(T_ * 4, nb_modulate(vb, t, sm, p.x, ada, 0, 1024, ubuf));
    GSYNC();
    RUN(2048, nb_filt_norm(vb, t, sm, hf, Gr));
    GSYNC();
#pragma unroll 1
    for (int l = 0; l < 2; ++l) {
        const float* ada_l = ada + (size_t)l * 16 * 6144; const float* w_in_l = p.w_in + (size_t)l * 1024 * 7680;
        const float* xin = (l == 0) ? p.x : out;
        RUN(48 * 512, nb_gemm(vb, t, sm, 48, 1024, ALbf{ubuf, 1024, 0}, WLinP{w_in_l}, EpP{P, rope}));
        RUN(24 * 512, nb_gemm(vb, t, sm, 24, 1024, ALbf{ubuf, 1024, 0}, WLf{w_in_l, 7680, 2304}, EpHyT{hyT}));
        GSYNC();
        RUN(65536, nb_hyena(vb, t, sm, 0, hyT, z1T, Gr + (size_t)l * 2 * 512 * 4096, p.conv_w + (size_t)l * 3 * 1536, p.conv_b + (size_t)l * 1536, p.hy_bias + (size_t)l * 1024));
        RUN(1536, nb_attnA(vb, t, sm, P, lse2));
        GSYNC();
        RUN(65536, nb_hyena(vb, t, sm, 1, hyT, z1T, Gr + (size_t)l * 2 * 512 * 4096, p.conv_w + (size_t)l * 3 * 1536, p.conv_b + (size_t)l * 1536, p.hy_bias + (size_t)l * 1024));
        GSYNC();
        RUN(1024, nb_attnC(vb, t, sm, P, p.attn_sink + l * 8, Y));
        RUN(32768, nb_combineA(vb, t, sm, P, lse2, Y));
        RUN(65536, nb_transY(vb, t, sm, hyT, Y));
        GSYNC();
#pragma unroll 1
        for (int br = 0; br < 3; ++br) {
            const float* wbr = br == 0 ? p.wba + (size_t)l * 256 * 1024 : (br == 1 ? p.wbb + (size_t)l * 512 * 1024 : p.wbc + (size_t)l * 512 * 1024);
            const int kb = br == 0 ? 256 : 512, koff = br == 0 ? 0 : (br == 1 ? 256 : 768);
            RUN(16 * 512, nb_gemm(vb, t, sm, 16, 1024, ALbf{ubuf, 1024, 0}, WLf{w_in_l, 7680, 4608 + br * 1024}, EpGate{gtmp}));
            GSYNC();
            RUN(16 * 512, nb_gemm(vb, t, sm, 16, kb, ALbf{Y + koff, YW_, 0}, WLf{wbr, 1024, 0}, EpMerge{gtmp, merged, br == 0 ? 1 : 0, 0}));
            GSYNC();
        }
        RUN(16 * 512, nb_gemm(vb, t, sm, 16, 1024, ALbf{merged, 1024, 0}, WLf{p.w_out + (size_t)l * 1024 * 1024, 1024, 0}, EpOut{xin, out, ada_l, 2048, 0}));
        GSYNC();
        RUN(T_, nb_ln_mod(vb, t, sm, out, p.ln_g + (size_t)(l * 2 + 0) * 1024, p.ln_b + (size_t)(l * 2 + 0) * 1024, ada_l, 3072, 4096, ubuf));
        GSYNC();
        RUN(32 * 512, nb_gemm(vb, t, sm, 32, 1024, ALbf{ubuf, 1024, 0}, WLf{p.peer_wq + (size_t)l * 1024 * 2048, 2048, 0}, EpQ2{Q2}));
        GSYNC();
        RUN(T_ * 4, nb_peer_topk(vb, t, sm, Q2, p.peer_keys + (size_t)l * 8 * 2 * 128 * 128, eidx, egate));
        GSYNC();
        RUN(T_, nb_peer(vb, t, sm, out, ada_l, eidx, egate, p.peer_u + (size_t)l * 16384 * 1024, p.peer_v + (size_t)l * 16384 * 1024,
                        p.ln_g + (size_t)(l * 2 + 1) * 1024, p.ln_b + (size_t)(l * 2 + 1) * 1024, (l == 0) ? ada + (size_t)16 * 6144 : (const float*)nullptr, ubuf));
        if (l == 0) GSYNC();
    }
}

extern "C" void kernel_launch(void* const* d_in, const int* in_sizes, int n_in, void* d_out, int out_size, void* d_ws, size_t ws_size, hipStream_t stream) {
    static int grid = 0;
    if (grid == 0) {
        if (ws_size < WS_NEED || n_in != 26) { fprintf(stderr, "kernel_launch: workspace %zu < %zu or n_in %d != 26\n", ws_size, (size_t)WS_NEED, n_in); grid = -1; return; }
        int dev = 0, cus = 0, per_cu = 0;
        (void)hipGetDevice(&dev); (void)hipDeviceGetAttribute(&cus, hipDeviceAttributeMultiprocessorCount, dev);
        (void)hipFuncSetAttribute((const void*)mega, hipFuncAttributeMaxDynamicSharedMemorySize, LDS_BYTES);
        (void)hipOccupancyMaxActiveBlocksPerMultiprocessor(&per_cu, (const void*)mega, 512, LDS_BYTES);
        if (per_cu < 1) { fprintf(stderr, "kernel_launch: occupancy query says %d blocks per CU\n", per_cu); grid = -1; return; }
        grid = cus;
    }
    if (grid < 0) return;
    Params p{};
    const float** pp = (const float**)&p;
    for (int i = 0; i < 26; ++i) pp[i] = (const float*)d_in[i];
    p.out = (float*)d_out; p.ws = (char*)d_ws;
    void* args[] = {&p};
    hipError_t e = hipLaunchCooperativeKernel((const void*)mega, dim3(grid), dim3(512), args, LDS_BYTES, stream);
    if (e != hipSuccess) fprintf(stderr, "cooperative launch failed: %s (grid %d)\n", hipGetErrorString(e), grid);
}
```

```cpp
#include <hip/hip_runtime.h>
#include <hip/hip_cooperative_groups.h>
namespace cg = cooperative_groups;
#include <stdint.h>
#include <stdio.h>

#define DEV __device__ __forceinline__
typedef unsigned short bf16_t;

constexpr int D_ = 1024, B_ = 16, S_ = 2048, T_ = B_ * S_;
constexpr float ALPHA_ = 1.41421356237309515f;
constexpr float LOG2E_ = 1.4426950408889634f;
constexpr float QSCALE_ = 0.125f * 1.4426950408889634f;
constexpr float LN_EPS_ = 1e-5f;
constexpr int PW_ = 3072;
constexpr int UYW_ = 2304;
constexpr int WMW_ = 4352;

constexpr size_t MB_ = 1024 * 1024;
constexpr size_t OFF_ADA = 0, OFF_ROPE = 1 * MB_, OFF_GR = 2 * MB_, OFF_LSE = 18 * MB_, OFF_WINT = 20 * MB_, OFF_WMT = 50 * MB_,
                 OFF_WOUTT = 68 * MB_, OFF_WQT = 72 * MB_, OFF_KEYS = 80 * MB_, OFF_UY = 82 * MB_, OFF_P = 226 * MB_, OFF_HYT = 418 * MB_,
                 OFF_Z1T = OFF_P  , WS_NEED = 514 * MB_;

DEV float bf2f(bf16_t v) { return __uint_as_float(((unsigned)v) << 16); }
DEV bf16_t f2bf(float f) { unsigned u = __float_as_uint(f); u += 0x7FFFu + ((u >> 16) & 1u); return (bf16_t)(u >> 16); }

DEV void nb_ada(int vb, int t, unsigned char* sm, const float* __restrict__ c, const float* __restrict__ w_ada, const float* __restrict__ b_ada, float* __restrict__ ada) {
    const int idx = vb * 256 + t; const int l = idx / 6144, n = idx % 6144;
    float (*cond)[64] = (float (*)[64])sm;
    float acc[16];
#pragma unroll
    for (int b = 0; b < 16; ++b) acc[b] = b_ada[l * 6144 + n];
    for (int k0 = 0; k0 < 1024; k0 += 64) {
        for (int i = t; i < 1024; i += 256) { const int b = i >> 6, kk = i & 63; const float v = c[b * 1024 + k0 + kk]; cond[b][kk] = v / (1.f + expf(-v)); }
        __syncthreads();
        for (int kk = 0; kk < 64; ++kk) { const float w = w_ada[((size_t)l * 1024 + k0 + kk) * 6144 + n];
#pragma unroll
            for (int b = 0; b < 16; ++b) acc[b] += cond[b][kk] * w; }
        __syncthreads();
    }
#pragma unroll
    for (int b = 0; b < 16; ++b) ada[((size_t)l * 16 + b) * 6144 + n] = acc[b];
}

DEV void nb_rope(int vb, int t, unsigned char* sm, float2* __restrict__ rope) {
    const int idx = vb * 256 + t; const int s = idx >> 5, i = idx & 31;
    const float inv = powf(10000.f, -(float)i / 32.f); const float ang = (float)s * inv;
    rope[idx] = make_float2(cosf(ang), sinf(ang));
}

DEV void nb_filt_h2(int vb, int t, unsigned char* sm, const float* __restrict__ w1, const float* __restrict__ b1, const float* __restrict__ w2, const float* __restrict__ b2,
                                                const float* __restrict__ freq, float* __restrict__ h2) {
    const int grp = t >> 6, j = t & 63; const int lt = vb * 4 + grp; const int l = lt / 2048, tt = lt % 2048;
    float* z = (float*)sm + grp * 128; float* h1 = z + 64;
    if (j < 33) {
        const float idx = (float)tt, tn = idx / 2047.f, w = 6.283185307179586f * idx / 2048.f;
        if (j == 0) z[0] = tn;
        else { const int k = (j <= 16) ? (j - 1) : (j - 17); const float band = 1e-4f + (float)k * ((15.f - 1e-4f) / 15.f); const float ang = w * band;
            z[j] = (j <= 16) ? cosf(ang) : -sinf(ang); }
    }
    __syncthreads();
    float a = b1[l * 64 + j];
    for (int e = 0; e < 33; ++e) a += z[e] * w1[(l * 33 + e) * 64 + j];
    h1[j] = sinf(freq[(l * 2 + 0) * 64 + j] * a);
    __syncthreads();
    float a2 = b2[l * 64 + j];
    for (int i = 0; i < 64; ++i) a2 += h1[i] * w2[(l * 64 + i) * 64 + j];
    h2[((size_t)l * 2048 + tt) * 64 + j] = sinf(freq[(l * 2 + 1) * 64 + j] * a2);
}

DEV void nb_filt_full(int vb, int t, unsigned char* sm, const float* __restrict__ h2, const float* __restrict__ w3, const float* __restrict__ log_decay, float* __restrict__ hf) {
    const size_t idx = (size_t)vb * 256 + t; const int col = (int)(idx & 2047), tt = (int)((idx >> 11) & 2047), l = (int)(idx >> 22);
    const float* hr = h2 + ((size_t)l * 2048 + tt) * 64; float a = 0.f;
    for (int j = 0; j < 64; ++j) a += hr[j] * w3[((size_t)l * 64 + j) * 2048 + col];
    const float tn = (float)tt / 2047.f;
    hf[idx] = a * expf(-tn * expf(log_decay[l * 2048 + col]));
}

DEV void nb_filt_norm(int vb, int t, unsigned char* sm, const float* __restrict__ hf, bf16_t* __restrict__ Gr) {
    const int blk = vb; const int c = blk & 511, o = (blk >> 9) & 1, l = blk >> 10;
    const float* base = hf + (size_t)l * 2048 * 2048; const int colf = o * 512 + c, colb = 1024 + o * 512 + c;
    float ss = 0.f;
    for (int tt = t; tt < 2048; tt += 256) { const float a = base[(size_t)tt * 2048 + colf]; ss += a * a; if (tt >= 1) { const float bb = base[(size_t)tt * 2048 + colb]; ss += bb * bb; } }
    float* red = (float*)sm; red[t] = ss; __syncthreads();
    for (int st = 128; st > 0; st >>= 1) { if (t < st) red[t] += red[t + st]; __syncthreads(); }
    const float scale = rsqrtf(red[0] + 1e-12f); __syncthreads();
    bf16_t* g = Gr + (size_t)blk * 4096;
    for (int n = t; n < 4096; n += 256) { const int lag = 2047 - n; float v = 0.f;
        if (n < 4095) v = (lag >= 0) ? base[(size_t)lag * 2048 + colf] : base[(size_t)(-lag) * 2048 + colb];
        g[n] = f2bf(v * scale); }
}

DEV void nb_modulate(int vb, int t, unsigned char* sm, const float* __restrict__ x, const float* __restrict__ ada_l, int off_sh, int off_sc, bf16_t* __restrict__ ubuf) {
    const size_t idx = (size_t)vb * 256 + t; const int d = (int)(idx & 1023); const int b = (int)(idx >> 21);
    const float* a = ada_l + (size_t)b * 6144;
    ubuf[(idx >> 10) * UYW_ + d] = f2bf(x[idx] * (1.f + a[off_sc + d]) + a[off_sh + d]);
}

template <class AL, class WL, class EP>
DEV void nb_gemm(int vb, int t, unsigned char* sm, int nbx, int K, AL al, WL wl, EP ep) {
    float (*As)[65] = (float (*)[65])sm;
    float (*Ws)[65] = (float (*)[65])(sm + 16 * 65 * 4);
    const int tx = t & 15, ty = t >> 4;
    const int m0 = (vb / nbx) * 64, n0 = (vb % nbx) * 64;
    float acc[4][4];
#pragma unroll
    for (int i = 0; i < 4; ++i)
#pragma unroll
        for (int j = 0; j < 4; ++j) acc[i][j] = 0.f;
    for (int k0 = 0; k0 < K; k0 += 16) {
#pragma unroll
        for (int r = 0; r < 4; ++r) { const int i = t + r * 256; const int mm = i >> 4, kk = i & 15; As[kk][mm] = al(m0 + mm, k0 + kk); }
#pragma unroll
        for (int r = 0; r < 4; ++r) { const int i = t + r * 256; const int kk = i >> 6, nn = i & 63; Ws[kk][nn] = wl(k0 + kk, n0 + nn); }
        __syncthreads();
#pragma unroll
        for (int kk = 0; kk < 16; ++kk) {
            float a[4], w[4];
#pragma unroll
            for (int i = 0; i < 4; ++i) { a[i] = As[kk][ty + 16 * i]; w[i] = Ws[kk][tx + 16 * i]; }
#pragma unroll
            for (int i = 0; i < 4; ++i)
#pragma unroll
                for (int j = 0; j < 4; ++j) acc[i][j] += a[i] * w[j];
        }
        __syncthreads();
    }
    ep(m0, n0, ty, tx, acc);
}

struct ALbf { const bf16_t* A; int lda; int pad; DEV float operator()(int m, int k) const { return bf2f(A[(size_t)m * lda + k]); } };
struct WLf { const float* W; int ldw; int coff; DEV float operator()(int k, int n) const { return W[(size_t)k * ldw + coff + n]; } };
struct WLinP { const float* W; DEV float operator()(int k, int n) const { return W[(size_t)k * 7680 + (n < 2304 ? n : n + 1536)]; } };

struct EpP { bf16_t* P; const float2* rope;
    DEV void operator()(int m0, int n0, int ty, int tx, float (&acc)[4][4]) const {
        const int head = n0 >> 6; const bool rp = (head < 24) || (head >= 36 && head < 46); const bool qs = (head < 12) || (head >= 36 && head < 44);
#pragma unroll
        for (int i = 0; i < 4; ++i) { const int m = m0 + ty + 16 * i; const int s = m & 2047; bf16_t* row = P + (size_t)m * PW_ + n0;
            if (rp) {
#pragma unroll
                for (int jj = 0; jj < 2; ++jj) { const int d = tx + 16 * jj; const float x1 = acc[i][jj], x2 = acc[i][jj + 2]; const float2 cs = rope[s * 32 + d];
                    float o1 = x1 * cs.x - x2 * cs.y, o2 = x2 * cs.x + x1 * cs.y; if (qs) { o1 *= QSCALE_; o2 *= QSCALE_; }
                    const int p1 = 8 * (d >> 2) + (d & 3); row[p1] = f2bf(o1); row[p1 + 4] = f2bf(o2); }
            } else {
#pragma unroll
                for (int j = 0; j < 4; ++j) row[tx + 16 * j] = f2bf(acc[i][j]);
            } }
    } };
struct EpHyT { bf16_t* hyT;
    DEV void operator()(int m0, int n0, int ty, int tx, float (&acc)[4][4]) const {
#pragma unroll
        for (int i = 0; i < 4; ++i)
#pragma unroll
            for (int j = 0; j < 4; ++j) hyT[(size_t)(n0 + tx + 16 * j) * T_ + m0 + ty + 16 * i] = f2bf(acc[i][j]);
    } };
struct EpGate { bf16_t* tmp;
    DEV void operator()(int m0, int n0, int ty, int tx, float (&acc)[4][4]) const {
#pragma unroll
        for (int i = 0; i < 4; ++i)
#pragma unroll
            for (int j = 0; j < 4; ++j) tmp[(size_t)(m0 + ty + 16 * i) * 1024 + n0 + tx + 16 * j] = f2bf(1.f / (1.f + expf(-acc[i][j])));
    } };
struct EpMerge { const bf16_t* tmp; bf16_t* merged; int first; int pad;
    DEV void operator()(int m0, int n0, int ty, int tx, float (&acc)[4][4]) const {
#pragma unroll
        for (int i = 0; i < 4; ++i)
#pragma unroll
            for (int j = 0; j < 4; ++j) { const size_t o = (size_t)(m0 + ty + 16 * i) * 1024 + n0 + tx + 16 * j; float v = bf2f(tmp[o]) * acc[i][j]; if (!first) v += bf2f(merged[o]); merged[o] = f2bf(v); }
    } };
struct EpOut { const float* xin; float* h; const float* ada_l; int off_g; int pad;
    DEV void operator()(int m0, int n0, int ty, int tx, float (&acc)[4][4]) const {
#pragma unroll
        for (int i = 0; i < 4; ++i)
#pragma unroll
            for (int j = 0; j < 4; ++j) { const int m = m0 + ty + 16 * i, n = n0 + tx + 16 * j; const size_t o = (size_t)m * 1024 + n;
                h[o] = ALPHA_ * xin[o] + ada_l[(size_t)(m >> 11) * 6144 + off_g + n] * acc[i][j]; }
    } };
struct EpQ2 { bf16_t* Q2;
    DEV void operator()(int m0, int n0, int ty, int tx, float (&acc)[4][4]) const {
#pragma unroll
        for (int i = 0; i < 4; ++i)
#pragma unroll
            for (int j = 0; j < 4; ++j) Q2[(size_t)(m0 + ty + 16 * i) * 2048 + n0 + tx + 16 * j] = f2bf(acc[i][j]);
    } };

DEV void nb_attnA(int vb, int t, unsigned char* sm, bf16_t* __restrict__ P, float* __restrict__ lse2) {
    const int idx = vb * 256 + t; const int s = idx & 2047, head = (idx >> 11) % 12, b = idx / (2048 * 12);
    const int gi = head >> 2; const int dil = gi == 0 ? 1 : (gi == 1 ? 4 : 16); const int ls = 2048 / dil; const int r = s % dil, p = s / dil;
    bf16_t* qrow = P + (size_t)(b * 2048 + s) * PW_ + head * 64;
    float q[64], o[64];
#pragma unroll
    for (int d = 0; d < 64; ++d) { q[d] = bf2f(qrow[d]); o[d] = 0.f; }
    float m = -1e30f, l = 0.f;
    const int lo = max(0, p - 64), hi = min(ls - 1, p + 64);
    for (int pp = lo; pp <= hi; ++pp) {
        const bf16_t* krow = P + (size_t)(b * 2048 + pp * dil + r) * PW_ + 768 + head * 64; const bf16_t* vrow = krow + 768;
        float sc = 0.f;
#pragma unroll
        for (int d = 0; d < 64; ++d) sc += q[d] * bf2f(krow[d]);
        const float mn = fmaxf(m, sc), corr = exp2f(m - mn), pw = exp2f(sc - mn);
        l = l * corr + pw;
#pragma unroll
        for (int d = 0; d < 64; ++d) o[d] = o[d] * corr + pw * bf2f(vrow[d]);
        m = mn;
    }
    const float inv = 1.f / l;
#pragma unroll
    for (int d = 0; d < 64; ++d) qrow[d] = f2bf(o[d] * inv);
    lse2[(size_t)(b * 2048 + s) * 12 + head] = m + log2f(l);
}

DEV void nb_attnC(int vb, int t, unsigned char* sm, const bf16_t* __restrict__ P, const float* __restrict__ sink_l, bf16_t* __restrict__ Y) {
    const int idx = vb * 256 + t; const int s = idx & 2047, qh = (idx >> 11) & 7, b = idx >> 14; const int kvh = qh >> 2;
    const bf16_t* qrow = P + (size_t)(b * 2048 + s) * PW_ + 2304 + qh * 64;
    float q[64], o[64];
#pragma unroll
    for (int d = 0; d < 64; ++d) { q[d] = bf2f(qrow[d]); o[d] = 0.f; }
    float m = -1e30f, l = 0.f;
    const int lo = max(0, s - 128), hi = min(2047, s + 128);
    for (int pp = lo; pp <= hi; ++pp) {
        const bf16_t* krow = P + (size_t)(b * 2048 + pp) * PW_ + 2816 + kvh * 64; const bf16_t* vrow = krow + 128;
        float sc = 0.f;
#pragma unroll
        for (int d = 0; d < 64; ++d) sc += q[d] * bf2f(krow[d]);
        const float mn = fmaxf(m, sc), corr = exp2f(m - mn), pw = exp2f(sc - mn);
        l = l * corr + pw;
#pragma unroll
        for (int d = 0; d < 64; ++d) o[d] = o[d] * corr + pw * bf2f(vrow[d]);
        m = mn;
    }
    const float sk = sink_l[qh] * LOG2E_; const float mf = fmaxf(m, sk); const float corr = exp2f(m - mf);
    l = l * corr + exp2f(sk - mf); const float inv = corr / l;
    bf16_t* yrow = Y + (size_t)(b * 2048 + s) * UYW_ + 768 + qh * 64;
#pragma unroll
    for (int d = 0; d < 64; ++d) yrow[d] = f2bf(o[d] * inv);
}

DEV void nb_combineA(int vb, int t, unsigned char* sm, const bf16_t* __restrict__ P, const float* __restrict__ lse2, bf16_t* __restrict__ Y) {
    const size_t idx = (size_t)vb * 256 + t; const int cc = (int)(idx & 255); const size_t tok = idx >> 8; const int hh = cc >> 6, d = cc & 63;
    const float l0 = lse2[tok * 12 + hh], l1 = lse2[tok * 12 + 4 + hh], l2 = lse2[tok * 12 + 8 + hh]; const float mx = fmaxf(l0, fmaxf(l1, l2));
    const float w0 = exp2f(l0 - mx), w1 = exp2f(l1 - mx), w2 = exp2f(l2 - mx);
    const bf16_t* pr = P + tok * PW_ + hh * 64 + d;
    Y[tok * UYW_ + cc] = f2bf((w0 * bf2f(pr[0]) + w1 * bf2f(pr[256]) + w2 * bf2f(pr[512])) / (w0 + w1 + w2));
}

DEV void nb_hyena(int vb, int t, unsigned char* sm, int pass, bf16_t* __restrict__ hyT, bf16_t* __restrict__ z1T, const bf16_t* __restrict__ Gr_l, const float* __restrict__ conv_w,
                                                const float* __restrict__ conv_b, const float* __restrict__ hy_bias) {
    const size_t idx = (size_t)vb * 256 + t; const int i = (int)(idx & 2047); const int b = (int)((idx >> 11) & 15); const int c = (int)(idx >> 15);
    const bf16_t* G = Gr_l + ((size_t)pass * 512 + c) * 4096 + (2047 - i);
    float acc = 0.f, zi = 0.f;
    if (pass == 0) {
        const bf16_t* in = hyT + (size_t)c * T_ + b * 2048; const float w0 = conv_w[c], w1 = conv_w[1536 + c], w2 = conv_w[3072 + c], cb = conv_b[c];
        float prev = 0.f, cur = bf2f(in[0]);
        for (int j = 0; j < 2048; ++j) { const float nxt = (j < 2047) ? bf2f(in[j + 1]) : 0.f; const float z = cb + w0 * prev + w1 * cur + w2 * nxt;
            acc += bf2f(G[j]) * z; if (j == i) zi = z; prev = cur; cur = nxt; }
    } else {
        const bf16_t* in = z1T + (size_t)c * T_ + b * 2048;
        for (int j = 0; j < 2048; ++j) { const float z = bf2f(in[j]); acc += bf2f(G[j]) * z; if (j == i) zi = z; }
    }
    const int xc = (pass == 0 ? 512 : 1024) + c;
    const bf16_t* xin = hyT + (size_t)xc * T_ + b * 2048;
    const float xm = (i > 0) ? bf2f(xin[i - 1]) : 0.f, x0 = bf2f(xin[i]), xp = (i < 2047) ? bf2f(xin[i + 1]) : 0.f;
    const float xv = conv_b[xc] + conv_w[xc] * xm + conv_w[1536 + xc] * x0 + conv_w[3072 + xc] * xp;
    const float outv = xv * (acc + hy_bias[pass * 512 + c] * zi);
    if (pass == 0) z1T[(size_t)c * T_ + b * 2048 + i] = f2bf(outv); else hyT[(size_t)c * T_ + b * 2048 + i] = f2bf(outv);
}

DEV void nb_transY(int vb, int t, unsigned char* sm, const bf16_t* __restrict__ hyT, bf16_t* __restrict__ Y) {
    const size_t idx = (size_t)vb * 256 + t; const int c = (int)(idx & 511); const size_t tok = idx >> 9;
    Y[tok * UYW_ + 256 + c] = hyT[(size_t)c * T_ + tok];
}

DEV void nb_ln_mod(int vb, int t, unsigned char* sm, float* __restrict__ h, const float* __restrict__ g, const float* __restrict__ bta, const float* __restrict__ ada_l, int off_sh, int off_sc,
                                                bf16_t* __restrict__ ubuf) {
    const int tok = vb; float v[4]; float s = 0.f;
#pragma unroll
    for (int k = 0; k < 4; ++k) { v[k] = h[(size_t)tok * 1024 + t + 256 * k]; s += v[k]; }
    float* red = (float*)sm; red[t] = s; __syncthreads();
    for (int st = 128; st > 0; st >>= 1) { if (t < st) red[t] += red[t + st]; __syncthreads(); }
    const float mu = red[0] * (1.f / 1024.f); __syncthreads();
    float q = 0.f;
#pragma unroll
    for (int k = 0; k < 4; ++k) { const float dd = v[k] - mu; q += dd * dd; }
    red[t] = q; __syncthreads();
    for (int st = 128; st > 0; st >>= 1) { if (t < st) red[t] += red[t + st]; __syncthreads(); }
    const float rstd = rsqrtf(red[0] * (1.f / 1024.f) + LN_EPS_);
    const float* a = ada_l + (size_t)(tok >> 11) * 6144;
#pragma unroll
    for (int k = 0; k < 4; ++k) { const int d = t + 256 * k; const float y = (v[k] - mu) * rstd * g[d] + bta[d]; h[(size_t)tok * 1024 + d] = y;
        if (ubuf) ubuf[(size_t)tok * UYW_ + d] = f2bf(y * (1.f + a[off_sc + d]) + a[off_sh + d]); }
}

DEV void nb_peer_topk(int vb, int t, unsigned char* sm, const bf16_t* __restrict__ Q2, const float* __restrict__ keys_l, int* __restrict__ eidx, float* __restrict__ egate) {
    const int grp = t >> 7; const int th = vb * 2 + grp; const int tok = th >> 3, h = th & 7; t &= 127;
    float* qs = (float*)sm + grp * 1024; float* s1 = qs + 256; float* s2 = s1 + 128; float* t1v = s2 + 128; float* t2v = t1v + 16; float* cand = t2v + 16; float* bestv = cand + 256;
    int* t1i = (int*)(bestv + 16); int* t2i = t1i + 16; int* besti = t2i + 16;
    qs[t] = bf2f(Q2[(size_t)tok * 2048 + h * 256 + t]); qs[t + 128] = bf2f(Q2[(size_t)tok * 2048 + h * 256 + 128 + t]);
    __syncthreads();
    { const float* k1 = keys_l + ((size_t)(h * 2 + 0) * 128 + t) * 128; const float* k2 = keys_l + ((size_t)(h * 2 + 1) * 128 + t) * 128; float a = 0.f, bsum = 0.f;
        for (int c = 0; c < 128; ++c) { a += qs[c] * k1[c]; bsum += qs[128 + c] * k2[c]; }
        s1[t] = a; s2[t] = bsum; }
    __syncthreads();
    { const float a = s1[t], bb = s2[t]; int r1 = 0, r2 = 0;
        for (int m = 0; m < 128; ++m) { const float x = s1[m], y = s2[m]; r1 += (x > a || (x == a && m < t)) ? 1 : 0; r2 += (y > bb || (y == bb && m < t)) ? 1 : 0; }
        if (r1 < 16) { t1v[r1] = a; t1i[r1] = t; } if (r2 < 16) { t2v[r2] = bb; t2i[r2] = t; } }
    __syncthreads();
    cand[t] = t1v[t >> 4] + t2v[t & 15]; cand[t + 128] = t1v[(t + 128) >> 4] + t2v[t & 15];
    __syncthreads();
#pragma unroll
    for (int rr = 0; rr < 2; ++rr) { const int ci = t + 128 * rr; const float a = cand[ci]; int r = 0;
        for (int m = 0; m < 256; ++m) { const float x = cand[m]; r += (x > a || (x == a && m < ci)) ? 1 : 0; }
        if (r < 16) { bestv[r] = a; besti[r] = ci; } }
    __syncthreads();
    if (t < 16) { const float mx = bestv[0]; float sum = 0.f;
        for (int k = 0; k < 16; ++k) sum += expf(bestv[k] - mx);
        const int ci = besti[t]; const size_t o = ((size_t)tok * 8 + h) * 16 + t;
        eidx[o] = ((t1i[(ci >> 4) & 15] & 127) * 128 + (t2i[ci & 15] & 127)); egate[o] = expf(bestv[t] - mx) / sum; }
}

DEV void nb_peer(int vb, int t, unsigned char* sm, float* __restrict__ xio, const float* __restrict__ ada_l, const int* __restrict__ eidx, const float* __restrict__ egate,
                                              const float* __restrict__ pu, const float* __restrict__ pv, const float* __restrict__ g, const float* __restrict__ bta,
                                              const float* __restrict__ ada_next, bf16_t* __restrict__ ubuf) {
    const int tok = vb, lane = t & 63, w = t >> 6;
    float* xs = (float*)sm; float* wv = xs + 1024; float* red = wv + 128; int* es = (int*)(red + 256);
    const float* a = ada_l + (size_t)(tok >> 11) * 6144; float x1[4];
#pragma unroll
    for (int k = 0; k < 4; ++k) { const int d = t + 256 * k; x1[k] = xio[(size_t)tok * 1024 + d]; xs[d] = x1[k] * (1.f + a[4096 + d]) + a[3072 + d]; }
    if (t < 128) es[t] = eidx[(size_t)tok * 128 + t];
    __syncthreads();
    for (int i = w; i < 128; i += 4) { const float* ur = pu + (size_t)es[i] * 1024; float dsum = 0.f;
#pragma unroll
        for (int k = 0; k < 16; ++k) dsum += ur[lane + 64 * k] * xs[lane + 64 * k];
#pragma unroll
        for (int off = 32; off > 0; off >>= 1) dsum += __shfl_xor(dsum, off);
        if (lane == 0) wv[i] = egate[(size_t)tok * 128 + i] * 0.5f * dsum * (1.f + erff(dsum * 0.70710678118654752f)); }
    __syncthreads();
    float acc[4] = {0.f, 0.f, 0.f, 0.f};
    for (int i = 0; i < 128; ++i) { const float* vr = pv + (size_t)es[i] * 1024; const float wi = wv[i];
#pragma unroll
        for (int k = 0; k < 4; ++k) acc[k] += wi * vr[t + 256 * k]; }
    float v[4]; float s = 0.f;
#pragma unroll
    for (int k = 0; k < 4; ++k) { v[k] = ALPHA_ * x1[k] + a[5120 + t + 256 * k] * acc[k]; s += v[k]; }
    red[t] = s; __syncthreads();
    for (int st = 128; st > 0; st >>= 1) { if (t < st) red[t] += red[t + st]; __syncthreads(); }
    const float mu = red[0] * (1.f / 1024.f); __syncthreads();
    float q = 0.f;
#pragma unroll
    for (int k = 0; k < 4; ++k) { const float dd = v[k] - mu; q += dd * dd; }
    red[t] = q; __syncthreads();
    for (int st = 128; st > 0; st >>= 1) { if (t < st) red[t] += red[t + st]; __syncthreads(); }
    const float rstd = rsqrtf(red[0] * (1.f / 1024.f) + LN_EPS_);
    const float* an = ada_next ? ada_next + (size_t)(tok >> 11) * 6144 : nullptr;
#pragma unroll
    for (int k = 0; k < 4; ++k) { const int d = t + 256 * k; const float y = (v[k] - mu) * rstd * g[d] + bta[d]; xio[(size_t)tok * 1024 + d] = y;
        if (an) ubuf[(size_t)tok * UYW_ + d] = f2bf(y * (1.f + an[1024 + d]) + an[d]); }
}

#define LAS __attribute__((address_space(3)))
typedef short bf16x8 __attribute__((ext_vector_type(8)));
typedef float f32x4 __attribute__((ext_vector_type(4)));
typedef float f32x2 __attribute__((ext_vector_type(2)));
typedef unsigned u32x4 __attribute__((ext_vector_type(4)));
typedef unsigned u32x2 __attribute__((ext_vector_type(2)));
namespace pg8 {
constexpr int BM = 256, BK = 64, HALF = 128, HTB = HALF * BK * 2, STAGE_BYTES = 8 * HTB, NXCD = 8, WGM = 8;
DEV int lds_byte(int r, int c) { const int st = (r >> 4) * 2 + (c >> 5), rr = r & 15, cc = c & 31, ob = rr * 64 + cc * 2; return st * 1024 + (ob ^ (((ob >> 9) & 1) << 5)); }
DEV void stage_rc(int b, int& R, int& C) { const int st = b / 1024, sb = b % 1024, swz = sb ^ (((sb >> 9) & 1) << 5); R = (st >> 1) * 16 + swz / 64; C = (st & 1) * 32 + (swz % 64) / 2; }
DEV int perm32(int rho) { const int n = rho >> 4, i = rho & 15; return 8 * (i >> 2) + 4 * n + (i & 3); }
DEV unsigned cvt_pk_bf16(float lo, float hi) { unsigned r; asm volatile("v_cvt_pk_bf16_f32 %0, %1, %2" : "=v"(r) : "v"(lo), "v"(hi)); return r; }

struct Unit { int pm, pn, tag, nt; const char* a; const char* b; };
DEV void tile_of(int L, int nM, int nN, int& pm, int& pn) {
    const int nwg = nM * nN; int wgid = L; { const int q = nwg / NXCD, r = nwg % NXCD, xcd = wgid % NXCD, off = wgid / NXCD; wgid = (xcd < r ? xcd * (q + 1) : r * (q + 1) + (xcd - r) * q) + off; }
    const int nig = WGM * nN, gid = wgid / nig, fm = gid * WGM, gsz = (nM - fm) < WGM ? (nM - fm) : WGM;
    pm = fm + ((wgid % nig) % gsz); pn = (wgid % nig) / gsz;
}
struct PlainSched { const bf16_t* A; const bf16_t* Bt; int lda, ldb, nM, nN, nt, G, c;
    DEV bool next(int i, Unit& u) const { const long L = (long)i * G + c; if (L >= (long)nM * nN) return false; tile_of((int)L, nM, nN, u.pm, u.pn); u.tag = 0; u.nt = nt;
        u.a = (const char*)(A + (size_t)u.pm * BM * lda); u.b = (const char*)(Bt + (size_t)u.pn * BM * ldb); return true; } };

template <class Epi, class Sched>
DEV void gemm_phase(LAS unsigned char* lds, const int lda, const int ldb, const Sched& S, const Epi& E) {
    int tid_ = threadIdx.x; asm volatile("" : "+v"(tid_));
    const int tid = tid_, wid = __builtin_amdgcn_readfirstlane(tid >> 6), lane = tid & 63, wr = wid >> 2, wc = wid & 3, fr = lane & 15, fq = lane >> 4;
    unsigned voffA[2], voffB[2];
#pragma unroll
    for (int i = 0; i < 2; ++i) { int R, C; stage_rc(tid * 16 + i * 8192, R, C); const int Rb = Epi::PERM ? ((R & ~31) + perm32(R & 31)) : R;
        voffA[i] = (unsigned)(R * lda + C) * 2u; voffB[i] = (unsigned)(Rb * ldb + C) * 2u; }
    const size_t kstep = (size_t)(BK * 2);
    const size_t hstepA = (size_t)HALF * lda * 2, hstepB = (size_t)HALF * ldb * 2;
    const unsigned ldsw = (unsigned)wid * 1024u;
    const int aoff = lds_byte(wr * 64 + fr, fq * 8), boff = lds_byte(wc * 32 + fr, fq * 8);
#define PG8_SA(b, h) (((b) * 2 + (h)) * HTB)
#define PG8_SB(b, h) ((4 + (b) * 2 + (h)) * HTB)
#define PG8_STAGE(bufoff, gbase, voff) do { _Pragma("unroll") for (int _i = 0; _i < 2; ++_i) \
        __builtin_amdgcn_global_load_lds((const unsigned*)((const char*)(gbase) + (voff)[_i]), (LAS unsigned*)(lds + (bufoff) + ldsw + _i * 8192), 16, 0, 0); } while (0)
#define PG8_LDA(dst, b, h) do { _Pragma("unroll") for (int m = 0; m < 4; ++m) _Pragma("unroll") for (int k = 0; k < 2; ++k) dst[m][k] = *(const LAS bf16x8*)(lds + PG8_SA(b, h) + aoff + m * 2048 + k * 1024); } while (0)
#define PG8_LDB(dst, b, h) do { _Pragma("unroll") for (int n = 0; n < 2; ++n) _Pragma("unroll") for (int k = 0; k < 2; ++k) dst[n][k] = *(const LAS bf16x8*)(lds + PG8_SB(b, h) + boff + n * 2048 + k * 1024); } while (0)
#define PG8_MMA(ai, bj, At, Bt) do { __builtin_amdgcn_s_setprio(1); _Pragma("unroll") for (int m = 0; m < 4; ++m) _Pragma("unroll") for (int n = 0; n < 2; ++n) _Pragma("unroll") for (int k = 0; k < 2; ++k) \
        acc[ai][bj][m][n] = __builtin_amdgcn_mfma_f32_16x16x32_bf16(Bt[n][k], At[m][k], acc[ai][bj][m][n], 0, 0, 0); __builtin_amdgcn_s_setprio(0); } while (0)
#define PG8_WAIT_V(n) asm volatile("s_waitcnt vmcnt(" #n ")" ::: "memory")
#define PG8_WAIT_L(n) asm volatile("s_waitcnt lgkmcnt(" #n ")" ::: "memory")
#define PG8_BAR __builtin_amdgcn_s_barrier()
#define PG8_SCHED __builtin_amdgcn_sched_barrier(0)
    Unit cur, nxt; int ui = 0;
    if (!S.next(0, cur)) return;
    f32x4 acc[2][2][4][2];
#pragma unroll
    for (int a = 0; a < 2; ++a)
#pragma unroll
        for (int b = 0; b < 2; ++b)
#pragma unroll
            for (int m = 0; m < 4; ++m)
#pragma unroll
                for (int n = 0; n < 2; ++n) acc[a][b][m][n] = (f32x4){0.f, 0.f, 0.f, 0.f};
    bf16x8 At[4][2], B0[2][2], B1[2][2];
    const char* cA = cur.a; const char* cB = cur.b;
    PG8_STAGE(PG8_SB(0, 0), cB, voffB); PG8_STAGE(PG8_SA(0, 0), cA, voffA); PG8_STAGE(PG8_SB(0, 1), cB + hstepB, voffB); PG8_STAGE(PG8_SA(0, 1), cA + hstepA, voffA);
    if (wr == 1) PG8_BAR;
    PG8_WAIT_V(4); PG8_BAR;
    PG8_STAGE(PG8_SB(1, 0), cB + kstep, voffB); PG8_STAGE(PG8_SA(1, 0), cA + kstep, voffA); PG8_STAGE(PG8_SB(1, 1), cB + hstepB + kstep, voffB);
    PG8_WAIT_V(6); PG8_BAR;
    for (;;) {
        const bool has_next = S.next(ui + 1, nxt);
        const char* nA = has_next ? nxt.a : cA; const char* nB = has_next ? nxt.b : cB;
        const int nt = cur.nt;
        for (int t = 0; t < nt; t += 2) {
            const bool last = (t == nt - 2);
            const char* a1 = cA + (size_t)(t + 1) * kstep;
            const char* a2 = last ? nA : cA + (size_t)(t + 2) * kstep; const char* b2 = last ? nB : cB + (size_t)(t + 2) * kstep;
            const char* a3 = a2 + kstep; const char* b3 = b2 + kstep;
            PG8_LDB(B0, 0, 0); PG8_SCHED; PG8_LDA(At, 0, 0); PG8_STAGE(PG8_SA(1, 1), a1 + hstepA, voffA);
            PG8_WAIT_L(8); PG8_BAR; PG8_WAIT_L(0); PG8_MMA(0, 0, At, B0); PG8_BAR; PG8_SCHED;
            PG8_LDB(B1, 0, 1); PG8_STAGE(PG8_SB(0, 0), b2, voffB);
            PG8_BAR; PG8_WAIT_L(0); PG8_MMA(0, 1, At, B1); PG8_BAR;
            PG8_LDA(At, 0, 1); PG8_STAGE(PG8_SA(0, 0), a2, voffA);
            PG8_BAR; PG8_WAIT_L(0); PG8_MMA(1, 0, At, B0); PG8_BAR; PG8_SCHED;
            PG8_STAGE(PG8_SB(0, 1), b2 + hstepB, voffB);
            PG8_WAIT_V(6); PG8_BAR; PG8_MMA(1, 1, At, B1); PG8_BAR;
            PG8_LDB(B0, 1, 0); PG8_SCHED; PG8_LDA(At, 1, 0); PG8_STAGE(PG8_SA(0, 1), a2 + hstepA, voffA);
            PG8_WAIT_L(8); PG8_BAR; PG8_WAIT_L(0); PG8_MMA(0, 0, At, B0); PG8_BAR; PG8_SCHED;
            PG8_LDB(B1, 1, 1); PG8_STAGE(PG8_SB(1, 0), b3, voffB);
            PG8_BAR; PG8_WAIT_L(0); PG8_MMA(0, 1, At, B1); PG8_BAR;
            PG8_LDA(At, 1, 1); PG8_STAGE(PG8_SA(1, 0), a3, voffA);
            PG8_BAR; PG8_WAIT_L(0); PG8_MMA(1, 0, At, B0); PG8_BAR; PG8_SCHED;
            PG8_STAGE(PG8_SB(1, 1), b3 + hstepB, voffB);
            PG8_WAIT_V(6); PG8_BAR; PG8_MMA(1, 1, At, B1); PG8_BAR;
        }
        E(acc, cur, wr, wc, fr, fq);
        if (!has_next) break;
#pragma unroll
        for (int a = 0; a < 2; ++a)
#pragma unroll
            for (int b = 0; b < 2; ++b)
#pragma unroll
                for (int m = 0; m < 4; ++m)
#pragma unroll
                    for (int n = 0; n < 2; ++n) acc[a][b][m][n] = (f32x4){0.f, 0.f, 0.f, 0.f};
        cur = nxt; cA = nA; cB = nB; ++ui;
    }
    PG8_WAIT_V(0);
    if (wr == 0) PG8_BAR;
    PG8_BAR;
#undef PG8_SA
#undef PG8_SB
#undef PG8_STAGE
#undef PG8_LDA
#undef PG8_LDB
#undef PG8_MMA
#undef PG8_WAIT_V
#undef PG8_WAIT_L
#undef PG8_BAR
#undef PG8_SCHED
}
struct EpiBf { static constexpr bool PERM = true; bf16_t* O; int ldc; int pad;
    DEV void operator()(const f32x4 (&acc)[2][2][4][2], const Unit& u, int wr, int wc, int fr, int fq) const {
        const int row0 = u.pm * BM + wr * 64 + fr, col0 = u.pn * BM + wc * 32 + 8 * fq;
#pragma unroll
        for (int ai = 0; ai < 2; ++ai)
#pragma unroll
            for (int m = 0; m < 4; ++m) { bf16_t* rowp = O + (size_t)(row0 + ai * HALF + m * 16) * ldc + col0;
#pragma unroll
                for (int bj = 0; bj < 2; ++bj) { const f32x4 v0 = acc[ai][bj][m][0], v1 = acc[ai][bj][m][1];
                    u32x4 w; w.x = cvt_pk_bf16(v0[0], v0[1]); w.y = cvt_pk_bf16(v0[2], v0[3]); w.z = cvt_pk_bf16(v1[0], v1[1]); w.w = cvt_pk_bf16(v1[2], v1[3]);
                    *(u32x4*)(rowp + bj * HALF) = w; } }
    } };
struct EpiP { static constexpr bool PERM = true; bf16_t* P; const float2* rope;
    DEV void operator()(const f32x4 (&acc)[2][2][4][2], const Unit& u, int wr, int wc, int fr, int fq) const {
        const int row0 = u.pm * BM + wr * 64 + fr, col0 = u.pn * BM + wc * 32 + 8 * fq; const int g = (wc & 1) * 4 + fq; const int pn = u.pn;
        const bool qs = (pn < 3) || (pn == 9) || (pn == 10);
#pragma unroll
        for (int ai = 0; ai < 2; ++ai)
#pragma unroll
            for (int m = 0; m < 4; ++m) { const int row = row0 + ai * HALF + m * 16; bf16_t* rowp = P + (size_t)row * PW_ + col0;
                const float4* rp = (const float4*)(rope + (size_t)(row & 2047) * 32 + 4 * g); const float4 cs0 = rp[0], cs1 = rp[1];
                const float cc[4] = {cs0.x, cs0.z, cs1.x, cs1.z}, ss[4] = {cs0.y, cs0.w, cs1.y, cs1.w};
#pragma unroll
                for (int bj = 0; bj < 2; ++bj) { f32x4 v0 = acc[ai][bj][m][0], v1 = acc[ai][bj][m][1];
                    const bool rp_ = (pn < 6) || (pn == 9) || (pn == 10) || (pn == 11 && bj == 0);
                    if (rp_) {
#pragma unroll
                        for (int j = 0; j < 4; ++j) { const float x1 = v0[j], x2 = v1[j]; float o1 = x1 * cc[j] - x2 * ss[j], o2 = x2 * cc[j] + x1 * ss[j];
                            if (qs) { o1 *= QSCALE_; o2 *= QSCALE_; } v0[j] = o1; v1[j] = o2; } }
                    u32x4 w; w.x = cvt_pk_bf16(v0[0], v0[1]); w.y = cvt_pk_bf16(v0[2], v0[3]); w.z = cvt_pk_bf16(v1[0], v1[1]); w.w = cvt_pk_bf16(v1[2], v1[3]);
                    *(u32x4*)(rowp + bj * HALF) = w; } }
    } };
struct EpiMergeAll { static constexpr bool PERM = true; bf16_t* gtmp; bf16_t* merged;
    DEV void operator()(const f32x4 (&acc)[2][2][4][2], const Unit& u, int wr, int wc, int fr, int fq) const {
        const int row0 = u.pm * BM + wr * 64 + fr, col0 = u.pn * BM + wc * 32 + 8 * fq; const int tag = u.tag;
#pragma unroll
        for (int ai = 0; ai < 2; ++ai)
#pragma unroll
            for (int m = 0; m < 4; ++m) { const size_t ro = (size_t)(row0 + ai * HALF + m * 16) * 1024 + col0;
#pragma unroll
                for (int bj = 0; bj < 2; ++bj) { f32x4 v0 = acc[ai][bj][m][0], v1 = acc[ai][bj][m][1]; const size_t o = ro + bj * HALF;
                    if ((tag & 1) == 0) {
#pragma unroll
                        for (int j = 0; j < 4; ++j) { v0[j] = 1.f / (1.f + __expf(-v0[j])); v1[j] = 1.f / (1.f + __expf(-v1[j])); }
                        u32x4 w; w.x = cvt_pk_bf16(v0[0], v0[1]); w.y = cvt_pk_bf16(v0[2], v0[3]); w.z = cvt_pk_bf16(v1[0], v1[1]); w.w = cvt_pk_bf16(v1[2], v1[3]);
                        *(u32x4*)(gtmp + o) = w;
                    } else {
                        const u32x4 gq = *(const u32x4*)(gtmp + o);
                        float gg[8] = {__uint_as_float(gq.x << 16), __uint_as_float(gq.x & 0xffff0000u), __uint_as_float(gq.y << 16), __uint_as_float(gq.y & 0xffff0000u),
                                       __uint_as_float(gq.z << 16), __uint_as_float(gq.z & 0xffff0000u), __uint_as_float(gq.w << 16), __uint_as_float(gq.w & 0xffff0000u)};
#pragma unroll
                        for (int j = 0; j < 4; ++j) { v0[j] *= gg[j]; v1[j] *= gg[4 + j]; }
                        if (tag != 1) { const u32x4 mq = *(const u32x4*)(merged + o);
                            float mm[8] = {__uint_as_float(mq.x << 16), __uint_as_float(mq.x & 0xffff0000u), __uint_as_float(mq.y << 16), __uint_as_float(mq.y & 0xffff0000u),
                                           __uint_as_float(mq.z << 16), __uint_as_float(mq.z & 0xffff0000u), __uint_as_float(mq.w << 16), __uint_as_float(mq.w & 0xffff0000u)};
#pragma unroll
                            for (int j = 0; j < 4; ++j) { v0[j] += mm[j]; v1[j] += mm[4 + j]; } }
                        u32x4 w; w.x = cvt_pk_bf16(v0[0], v0[1]); w.y = cvt_pk_bf16(v0[2], v0[3]); w.z = cvt_pk_bf16(v1[0], v1[1]); w.w = cvt_pk_bf16(v1[2], v1[3]);
                        *(u32x4*)(merged + o) = w;
                    } } }
    } };
struct EpiOut { static constexpr bool PERM = false; const float* xin; float* h; const float* ada_g;
    DEV void operator()(const f32x4 (&acc)[2][2][4][2], const Unit& u, int wr, int wc, int fr, int fq) const {
        const int row0 = u.pm * BM + wr * 64 + fr, col0 = u.pn * BM + wc * 32 + 4 * fq; const float* gv = ada_g + (size_t)(u.pm >> 3) * 6144 + col0;
        f32x4 g[2][2];
#pragma unroll
        for (int bj = 0; bj < 2; ++bj)
#pragma unroll
            for (int n = 0; n < 2; ++n) g[bj][n] = *(const f32x4*)(gv + bj * HALF + n * 16);
#pragma unroll
        for (int ai = 0; ai < 2; ++ai)
#pragma unroll
            for (int m = 0; m < 4; ++m) { const size_t ro = (size_t)(row0 + ai * HALF + m * 16) * 1024 + col0;
#pragma unroll
                for (int bj = 0; bj < 2; ++bj)
#pragma unroll
                    for (int n = 0; n < 2; ++n) { const size_t o = ro + bj * HALF + n * 16; const f32x4 xv = *(const f32x4*)(xin + o); *(f32x4*)(h + o) = ALPHA_ * xv + g[bj][n] * acc[ai][bj][m][n]; } }
    } };
struct MergeSched { const bf16_t* UY; const bf16_t* WmT; int G, c;
    DEV bool next(int i, Unit& u) const { const int ti = i / 6, ps = i - ti * 6; const long L = (long)ti * G + c; if (L >= 128 * 4) return false; tile_of((int)L, 128, 4, u.pm, u.pn); u.tag = ps;
        const int br = ps >> 1; const bf16_t* ar = UY + (size_t)u.pm * BM * UYW_; const bf16_t* brow = WmT + (size_t)u.pn * BM * WMW_;
        if ((ps & 1) == 0) { u.nt = 16; u.a = (const char*)ar; u.b = (const char*)(brow + br * 1024); }
        else { const int koff = br == 0 ? 0 : (br == 1 ? 256 : 768); u.nt = br == 0 ? 4 : 8; u.a = (const char*)(ar + 1024 + koff); u.b = (const char*)(brow + 3072 + koff); }
        return true; } };
}

DEV int win_orig_col(int n) {
    if (n >= 3072) return n < 4608 ? (n - 3072 + 2304) : n;
    const int head = n >> 6, p = n & 63; const bool rp = (head < 24) || (head >= 36 && head < 46);
    const int d = rp ? ((p & 4) ? 32 + 4 * (p >> 3) + (p & 3) : 4 * (p >> 3) + (p & 3)) : p;
    return ((n < 2304) ? head * 64 : 3840 + (head - 36) * 64) + d;
}
struct WPrep { const float *w_in, *wba, *wbb, *wbc, *w_out, *peer_wq; bf16_t *WinT, *WmT, *WoutT, *WqT; };
DEV void nb_wprep(int vb, int t, unsigned char* sm, const WPrep& q) {
    const int l = vb / 3008; int r = vb - l * 3008; const float* W; int ldw; bf16_t* Wt; int ldt, koff = 0, ntk = 16, mode = 0, nsub = 0;
    if (r < 1920) { W = q.w_in + (size_t)l * 1024 * 7680; ldw = 7680; mode = 1;
        if (r < 72 * 16) { Wt = q.WinT + (size_t)l * 7680 * 1024; ldt = 1024; }
        else { const int br = (r / 16 - 72) / 16; Wt = q.WmT + (size_t)l * 1024 * WMW_; ldt = WMW_; koff = br * 1024; nsub = 4608 + br * 1024; } }
    else if (r < 1984) { r -= 1920; W = q.wba + (size_t)l * 256 * 1024; ldw = 1024; Wt = q.WmT + (size_t)l * 1024 * WMW_; ldt = WMW_; koff = 3072; ntk = 4; }
    else if (r < 2112) { r -= 1984; W = q.wbb + (size_t)l * 512 * 1024; ldw = 1024; Wt = q.WmT + (size_t)l * 1024 * WMW_; ldt = WMW_; koff = 3072 + 256; ntk = 8; }
    else if (r < 2240) { r -= 2112; W = q.wbc + (size_t)l * 512 * 1024; ldw = 1024; Wt = q.WmT + (size_t)l * 1024 * WMW_; ldt = WMW_; koff = 3072 + 768; ntk = 8; }
    else if (r < 2496) { r -= 2240; W = q.w_out + (size_t)l * 1024 * 1024; ldw = 1024; Wt = q.WoutT + (size_t)l * 1024 * 1024; ldt = 1024; }
    else { r -= 2496; W = q.peer_wq + (size_t)l * 1024 * 2048; ldw = 2048; Wt = q.WqT + (size_t)l * 2048 * 1024; ldt = 1024; }
    const int n0 = (r / ntk) * 64, k0 = (r % ntk) * 64; const int c0 = mode ? (win_orig_col(n0) & ~63) : n0;
    bf16_t* tile = (bf16_t*)sm;
    { const int kk = t >> 2, cs = (t & 3) * 16; const float* src = W + (size_t)(k0 + kk) * ldw + c0 + cs;
#pragma unroll
        for (int i = 0; i < 16; i += 4) { const float4 v = *(const float4*)(src + i); tile[kk * 66 + cs + i] = f2bf(v.x); tile[kk * 66 + cs + i + 1] = f2bf(v.y); tile[kk * 66 + cs + i + 2] = f2bf(v.z); tile[kk * 66 + cs + i + 3] = f2bf(v.w); } }
    __syncthreads();
    { const int nn = t >> 2, ks = (t & 3) * 16; const int dl = mode ? (win_orig_col(n0 + nn) - c0) : nn; bf16_t* dst = Wt + (size_t)(n0 + nn - nsub) * ldt + koff + k0 + ks;
        unsigned w[8];
#pragma unroll
        for (int i = 0; i < 8; ++i) w[i] = (unsigned)tile[(ks + 2 * i) * 66 + dl] | ((unsigned)tile[(ks + 2 * i + 1) * 66 + dl] << 16);
        *(u32x4*)dst = (u32x4){w[0], w[1], w[2], w[3]}; *(u32x4*)(dst + 8) = (u32x4){w[4], w[5], w[6], w[7]}; }
}

namespace hy {
constexpr int ZS = 2064;
constexpr int G0_OFF = 0, G1_OFF = 8192, Z0_OFF = 16384, Z1_OFF = Z0_OFF + 16 * ZS * 2, LDS_END = Z1_OFF + 16 * ZS * 2;
DEV bf16x8 load_frag(LAS const unsigned char* lane_base, int d) {
    const LAS unsigned* p = (const LAS unsigned*)(lane_base + 32 * d); u32x4 w; w.x = p[0]; w.y = p[1]; w.z = p[2]; w.w = p[3];
    return __builtin_bit_cast(bf16x8, w);
}
DEV void load_filter(LAS unsigned char* lds, const bf16_t* g, int tid) {
    const u32x4 c = *(const u32x4*)(g + tid * 8); const unsigned nx = (tid < 511) ? (unsigned)g[tid * 8 + 8] : 0u;
    *(LAS u32x4*)(lds + G0_OFF + tid * 16) = c;
    u32x4 s; s.x = (c.x >> 16) | (c.y << 16); s.y = (c.y >> 16) | (c.z << 16); s.z = (c.z >> 16) | (c.w << 16); s.w = (c.w >> 16) | (nx << 16);
    *(LAS u32x4*)(lds + G1_OFF + tid * 16) = s;
}
DEV float bflo(unsigned w) { return __uint_as_float(w << 16); }
DEV float bfhi(unsigned w) { return __uint_as_float(w & 0xffff0000u); }
DEV void conv_rows(LAS const unsigned char* lds, int zoff, int w, int lane, f32x4 (&D)[16]) {
    const int r = lane & 15, q = lane >> 4;
    LAS const unsigned char* abase = lds + ((r & 1) ? (G0_OFF + 2 * (8 * q - r + 2047)) : (G1_OFF + 2 * (8 * q - r + 2046)));
    LAS const unsigned char* bbase = lds + zoff + (r * ZS + 8 * q) * 2;
    bf16x8 ring[16];
#pragma unroll
    for (int rb = 0; rb < 16; ++rb) D[rb] = (f32x4){0.f, 0.f, 0.f, 0.f};
#pragma unroll
    for (int rb = 2; rb < 16; ++rb) ring[rb] = load_frag(abase, -16 * w - rb);
#pragma unroll 1
    for (int jb0 = 0; jb0 < 64; jb0 += 8) {
#pragma unroll
        for (int u = 0; u < 8; ++u) { const int jb = jb0 + u;
            ring[(16 - 2 * u) & 15] = load_frag(abase, 2 * jb - 16 * w);
            ring[(17 - 2 * u) & 15] = load_frag(abase, 2 * jb - 16 * w - 1);
            const bf16x8 bf = *(const LAS bf16x8*)(bbase + 64 * jb);
#pragma unroll
            for (int rb = 0; rb < 16; ++rb) D[rb] = __builtin_amdgcn_mfma_f32_16x16x32_bf16(ring[(rb - 2 * u) & 15], bf, D[rb], 0, 0, 0);
        }
    }
}
DEV void sconv4(const bf16_t* in, int i, float w0, float w1, float w2, float cb, float (&o)[4]) {
    const u32x2 v = *(const u32x2*)(in + i); const float pm = (i > 0) ? bf2f(in[i - 1]) : 0.f, pn = (i + 4 < 2048) ? bf2f(in[i + 4]) : 0.f;
    const float x0 = bflo(v.x), x1 = bfhi(v.x), x2 = bflo(v.y), x3 = bfhi(v.y);
    o[0] = cb + w0 * pm + w1 * x0 + w2 * x1; o[1] = cb + w0 * x0 + w1 * x1 + w2 * x2; o[2] = cb + w0 * x1 + w1 * x2 + w2 * x3; o[3] = cb + w0 * x2 + w1 * x3 + w2 * pn;
}
DEV void hyena_phase(LAS unsigned char* lds, bf16_t* hyT, const bf16_t* Gr_l, const float* conv_w, const float* conv_b, const float* hy_bias, int G, int cblk) {
    int tid_ = threadIdx.x; asm volatile("" : "+v"(tid_));
    const int tid = tid_, w = __builtin_amdgcn_readfirstlane(tid >> 6), lane = tid & 63, q = lane >> 4, b = lane & 15;
#pragma unroll 1
    for (int c = cblk; c < 512; c += G) {
        __syncthreads();
        load_filter(lds, Gr_l + (size_t)c * 4096, tid);
        { const float w0 = conv_w[c], w1 = conv_w[1536 + c], w2 = conv_w[3072 + c], cb = conv_b[c]; const bf16_t* row = hyT + (size_t)c * T_;
#pragma unroll 2
            for (int k = 0; k < 8; ++k) { const int pos = (k * 512 + tid) * 8; const int s = pos & 2047, bb = pos >> 11;
                const u32x4 v = *(const u32x4*)(row + pos); const float pm = (s > 0) ? bf2f(row[pos - 1]) : 0.f, pn = (s + 8 < 2048) ? bf2f(row[pos + 8]) : 0.f;
                const float x[10] = {pm, bflo(v.x), bfhi(v.x), bflo(v.y), bfhi(v.y), bflo(v.z), bfhi(v.z), bflo(v.w), bfhi(v.w), pn};
                float z[8];
#pragma unroll
                for (int e = 0; e < 8; ++e) z[e] = cb + w0 * x[e] + w1 * x[e + 1] + w2 * x[e + 2];
                u32x4 o; o.x = pg8::cvt_pk_bf16(z[0], z[1]); o.y = pg8::cvt_pk_bf16(z[2], z[3]); o.z = pg8::cvt_pk_bf16(z[4], z[5]); o.w = pg8::cvt_pk_bf16(z[6], z[7]);
                *(LAS u32x4*)(lds + Z0_OFF + (bb * ZS + s) * 2) = o; } }
        __syncthreads();
        f32x4 D[16];
        conv_rows(lds, Z0_OFF, w, lane, D);
        { const int xc = 512 + c; const float w0 = conv_w[xc], w1 = conv_w[1536 + xc], w2 = conv_w[3072 + xc], cb = conv_b[xc], bias = hy_bias[c]; const bf16_t* xin = hyT + (size_t)xc * T_ + b * 2048;
#pragma unroll
            for (int rb = 0; rb < 16; ++rb) { const int i = 256 * w + 16 * rb + 4 * q; float xv[4]; sconv4(xin, i, w0, w1, w2, cb, xv);
                const u32x2 zq = *(const LAS u32x2*)(lds + Z0_OFF + (b * ZS + i) * 2); const float zv[4] = {bflo(zq.x), bfhi(zq.x), bflo(zq.y), bfhi(zq.y)};
                float o[4];
#pragma unroll
                for (int e = 0; e < 4; ++e) o[e] = xv[e] * (D[rb][e] + bias * zv[e]);
                u32x2 pk; pk.x = pg8::cvt_pk_bf16(o[0], o[1]); pk.y = pg8::cvt_pk_bf16(o[2], o[3]);
                *(LAS u32x2*)(lds + Z1_OFF + (b * ZS + i) * 2) = pk; } }
        __syncthreads();
        load_filter(lds, Gr_l + (size_t)(512 + c) * 4096, tid);
        __syncthreads();
        conv_rows(lds, Z1_OFF, w, lane, D);
        { const int xc = 1024 + c; const float w0 = conv_w[xc], w1 = conv_w[1536 + xc], w2 = conv_w[3072 + xc], cb = conv_b[xc], bias = hy_bias[512 + c]; const bf16_t* xin = hyT + (size_t)xc * T_ + b * 2048;
            bf16_t* yout = hyT + (size_t)c * T_ + b * 2048;
#pragma unroll
            for (int rb = 0; rb < 16; ++rb) { const int i = 256 * w + 16 * rb + 4 * q; float xv[4]; sconv4(xin, i, w0, w1, w2, cb, xv);
                const u32x2 zq = *(const LAS u32x2*)(lds + Z1_OFF + (b * ZS + i) * 2); const float zv[4] = {bflo(zq.x), bfhi(zq.x), bflo(zq.y), bfhi(zq.y)};
                float o[4];
#pragma unroll
                for (int e = 0; e < 4; ++e) o[e] = xv[e] * (D[rb][e] + bias * zv[e]);
                u32x2 pk; pk.x = pg8::cvt_pk_bf16(o[0], o[1]); pk.y = pg8::cvt_pk_bf16(o[2], o[3]);
                *(u32x2*)(yout + i) = pk; } }
    }
    __syncthreads();
}
}

namespace peer {
typedef __attribute__((ext_vector_type(4))) float float4v;
DEV void nb_cvt_tables(int vb, int t, const float* __restrict__ pu, const float* __restrict__ pv, bf16_t* __restrict__ Ub, bf16_t* __restrict__ Vb) {
    const size_t i = ((size_t)vb * 256 + t) * 8;
    { const float4 a = *(const float4*)(pu + i), b = *(const float4*)(pu + i + 4); u32x4 o; o.x = pg8::cvt_pk_bf16(a.x, a.y); o.y = pg8::cvt_pk_bf16(a.z, a.w); o.z = pg8::cvt_pk_bf16(b.x, b.y); o.w = pg8::cvt_pk_bf16(b.z, b.w); *(u32x4*)(Ub + i) = o; }
    { const float4 a = *(const float4*)(pv + i), b = *(const float4*)(pv + i + 4); u32x4 o; o.x = pg8::cvt_pk_bf16(a.x, a.y); o.y = pg8::cvt_pk_bf16(a.z, a.w); o.z = pg8::cvt_pk_bf16(b.x, b.y); o.w = pg8::cvt_pk_bf16(b.z, b.w); *(u32x4*)(Vb + i) = o; }
}
DEV float wave_sum(float v) {
#pragma unroll
    for (int off = 32; off > 0; off >>= 1) v += __shfl_xor(v, off);
    return v;
}
DEV void peer_phase(LAS unsigned char* lds, float* xio, const float* ada_l, const int* __restrict__ eidx, const float* __restrict__ egate, const bf16_t* __restrict__ Ub, const bf16_t* __restrict__ Vb,
                    const float* __restrict__ g, const float* __restrict__ bta, const float* ada_next, bf16_t* UY, int G, int cblk) {
    int tid_ = threadIdx.x; asm volatile("" : "+v"(tid_));
    const int tid = tid_, w = __builtin_amdgcn_readfirstlane(tid >> 6), lane = tid & 63, q = lane >> 4, n = lane & 15;
    LAS unsigned char* urow_l = lds + w * 2048;
    const int c0 = 8 * lane, c1 = 512 + 8 * lane;
#pragma unroll 1
    for (int tok = cblk * 8 + w; tok < T_; tok += G * 8) {
        const float* a = ada_l + (size_t)(tok >> 11) * 6144; float* xr = xio + (size_t)tok * 1024;
        float x1[16];
        { const float4 v0 = *(const float4*)(xr + c0), v1 = *(const float4*)(xr + c0 + 4), v2 = *(const float4*)(xr + c1), v3 = *(const float4*)(xr + c1 + 4);
            x1[0] = v0.x; x1[1] = v0.y; x1[2] = v0.z; x1[3] = v0.w; x1[4] = v1.x; x1[5] = v1.y; x1[6] = v1.z; x1[7] = v1.w;
            x1[8] = v2.x; x1[9] = v2.y; x1[10] = v2.z; x1[11] = v2.w; x1[12] = v3.x; x1[13] = v3.y; x1[14] = v3.z; x1[15] = v3.w; }
        { float u[16];
#pragma unroll
            for (int hh = 0; hh < 2; ++hh)
#pragma unroll
                for (int j = 0; j < 8; j += 4) { const int d = (hh ? c1 : c0) + j; const float4 sc = *(const float4*)(a + 4096 + d), sh = *(const float4*)(a + 3072 + d);
                    u[hh * 8 + j] = x1[hh * 8 + j] * (1.f + sc.x) + sh.x; u[hh * 8 + j + 1] = x1[hh * 8 + j + 1] * (1.f + sc.y) + sh.y;
                    u[hh * 8 + j + 2] = x1[hh * 8 + j + 2] * (1.f + sc.z) + sh.z; u[hh * 8 + j + 3] = x1[hh * 8 + j + 3] * (1.f + sc.w) + sh.w; }
            u32x4 p0, p1; p0.x = pg8::cvt_pk_bf16(u[0], u[1]); p0.y = pg8::cvt_pk_bf16(u[2], u[3]); p0.z = pg8::cvt_pk_bf16(u[4], u[5]); p0.w = pg8::cvt_pk_bf16(u[6], u[7]);
            p1.x = pg8::cvt_pk_bf16(u[8], u[9]); p1.y = pg8::cvt_pk_bf16(u[10], u[11]); p1.z = pg8::cvt_pk_bf16(u[12], u[13]); p1.w = pg8::cvt_pk_bf16(u[14], u[15]);
            *(LAS u32x4*)(urow_l + c0 * 2) = p0; *(LAS u32x4*)(urow_l + c1 * 2) = p1; }
        int E[8]; float Gt[8], wg[8];
#pragma unroll
        for (int gi = 0; gi < 8; ++gi) { E[gi] = eidx[(size_t)tok * 128 + gi * 16 + n]; Gt[gi] = egate[(size_t)tok * 128 + gi * 16 + n]; }
        asm volatile("s_waitcnt lgkmcnt(0)" ::: "memory");
#pragma unroll 2
        for (int gi = 0; gi < 8; ++gi) { const bf16_t* ur = Ub + (size_t)E[gi] * 1024 + 8 * q; f32x4 acc = (f32x4){0.f, 0.f, 0.f, 0.f};
#pragma unroll 16
            for (int ks = 0; ks < 32; ++ks) { const bf16x8 bf = *(const bf16x8*)(ur + 32 * ks); const bf16x8 af = *(const LAS bf16x8*)(urow_l + (32 * ks + 8 * q) * 2);
                acc = __builtin_amdgcn_mfma_f32_16x16x32_bf16(af, bf, acc, 0, 0, 0); }
            const float dsum = acc[0]; wg[gi] = Gt[gi] * 0.5f * dsum * (1.f + erff(dsum * 0.70710678118654752f)); }
        float o[16];
#pragma unroll
        for (int j = 0; j < 16; ++j) o[j] = 0.f;
#pragma unroll
        for (int gi = 0; gi < 8; ++gi) {
#pragma unroll 8
            for (int n2 = 0; n2 < 16; ++n2) { const int e = __builtin_amdgcn_readlane(E[gi], n2); const float wt = __builtin_bit_cast(float, __builtin_amdgcn_readlane(__builtin_bit_cast(int, wg[gi]), n2));
                const bf16_t* vr = Vb + (size_t)e * 1024; const u32x4 v0 = *(const u32x4*)(vr + c0), v1 = *(const u32x4*)(vr + c1);
                o[0] += wt * __uint_as_float(v0.x << 16); o[1] += wt * __uint_as_float(v0.x & 0xffff0000u); o[2] += wt * __uint_as_float(v0.y << 16); o[3] += wt * __uint_as_float(v0.y & 0xffff0000u);
                o[4] += wt * __uint_as_float(v0.z << 16); o[5] += wt * __uint_as_float(v0.z & 0xffff0000u); o[6] += wt * __uint_as_float(v0.w << 16); o[7] += wt * __uint_as_float(v0.w & 0xffff0000u);
                o[8] += wt * __uint_as_float(v1.x << 16); o[9] += wt * __uint_as_float(v1.x & 0xffff0000u); o[10] += wt * __uint_as_float(v1.y << 16); o[11] += wt * __uint_as_float(v1.y & 0xffff0000u);
                o[12] += wt * __uint_as_float(v1.z << 16); o[13] += wt * __uint_as_float(v1.z & 0xffff0000u); o[14] += wt * __uint_as_float(v1.w << 16); o[15] += wt * __uint_as_float(v1.w & 0xffff0000u); }
        }
        float hv[16]; float s = 0.f;
#pragma unroll
        for (int hh = 0; hh < 2; ++hh)
#pragma unroll
            for (int j = 0; j < 8; j += 4) { const int d = (hh ? c1 : c0) + j; const float4 g2 = *(const float4*)(a + 5120 + d); const int k = hh * 8 + j;
                hv[k] = ALPHA_ * x1[k] + g2.x * o[k]; hv[k + 1] = ALPHA_ * x1[k + 1] + g2.y * o[k + 1]; hv[k + 2] = ALPHA_ * x1[k + 2] + g2.z * o[k + 2]; hv[k + 3] = ALPHA_ * x1[k + 3] + g2.w * o[k + 3];
                s += (hv[k] + hv[k + 1]) + (hv[k + 2] + hv[k + 3]); }
        const float mu = wave_sum(s) * (1.f / 1024.f); float qq = 0.f;
#pragma unroll
        for (int j = 0; j < 16; ++j) { const float dd = hv[j] - mu; qq += dd * dd; }
        const float rstd = rsqrtf(wave_sum(qq) * (1.f / 1024.f) + LN_EPS_);
        const float* an = ada_next ? ada_next + (size_t)(tok >> 11) * 6144 : nullptr;
#pragma unroll
        for (int hh = 0; hh < 2; ++hh) { const int d0 = hh ? c1 : c0; float y[8];
#pragma unroll
            for (int j = 0; j < 8; j += 4) { const float4 gg = *(const float4*)(g + d0 + j), bb = *(const float4*)(bta + d0 + j); const int k = hh * 8 + j;
                y[j] = (hv[k] - mu) * rstd * gg.x + bb.x; y[j + 1] = (hv[k + 1] - mu) * rstd * gg.y + bb.y; y[j + 2] = (hv[k + 2] - mu) * rstd * gg.z + bb.z; y[j + 3] = (hv[k + 3] - mu) * rstd * gg.w + bb.w;
                *(float4*)(xr + d0 + j) = make_float4(y[j], y[j + 1], y[j + 2], y[j + 3]); }
            if (an) { float uu[8];
#pragma unroll
                for (int j = 0; j < 8; j += 4) { const float4 sc = *(const float4*)(an + 1024 + d0 + j), sh = *(const float4*)(an + d0 + j);
                    uu[j] = y[j] * (1.f + sc.x) + sh.x; uu[j + 1] = y[j + 1] * (1.f + sc.y) + sh.y; uu[j + 2] = y[j + 2] * (1.f + sc.z) + sh.z; uu[j + 3] = y[j + 3] * (1.f + sc.w) + sh.w; }
                u32x4 pk; pk.x = pg8::cvt_pk_bf16(uu[0], uu[1]); pk.y = pg8::cvt_pk_bf16(uu[2], uu[3]); pk.z = pg8::cvt_pk_bf16(uu[4], uu[5]); pk.w = pg8::cvt_pk_bf16(uu[6], uu[7]);
                *(u32x4*)(UY + (size_t)tok * UYW_ + d0) = pk; } }
    }
    __syncthreads();
}
}

namespace tk {
typedef float f32x16 __attribute__((ext_vector_type(16)));
constexpr int KROW = 272;
DEV unsigned sortable(float v) { const unsigned u = __float_as_uint(v); return u ^ ((unsigned)((int)u >> 31) | 0x80000000u); }
DEV float unsortable(unsigned k) { return __uint_as_float(k ^ ((~(unsigned)((int)k >> 31)) | 0x80000000u)); }
DEV unsigned umax_(unsigned a, unsigned b) { return a > b ? a : b; }
DEV unsigned umin_(unsigned a, unsigned b) { return a < b ? a : b; }
#define CE(x, y) { const unsigned hi_ = umax_(a[x], a[y]), lo_ = umin_(a[x], a[y]); a[x] = hi_; a[y] = lo_; }
DEV void sort16(unsigned (&a)[16]) {
    CE(0, 1); CE(3, 2); CE(4, 5); CE(7, 6); CE(8, 9); CE(11, 10); CE(12, 13); CE(15, 14); CE(0, 2); CE(1, 3); CE(6, 4); CE(7, 5); CE(8, 10); CE(9, 11); CE(14, 12); CE(15, 13); CE(0, 1); CE(2, 3); CE(5, 4); CE(7, 6); CE(8, 9); CE(10, 11); CE(13, 12); CE(15, 14); CE(0, 4); CE(1, 5); CE(2, 6); CE(3, 7); CE(12, 8); CE(13, 9); CE(14, 10); CE(15, 11); CE(0, 2); CE(1, 3); CE(4, 6); CE(5, 7); CE(10, 8); CE(11, 9); CE(14, 12); CE(15, 13); CE(0, 1); CE(2, 3); CE(4, 5); CE(6, 7); CE(9, 8); CE(11, 10); CE(13, 12); CE(15, 14); CE(0, 8); CE(1, 9); CE(2, 10); CE(3, 11); CE(4, 12); CE(5, 13); CE(6, 14); CE(7, 15); CE(0, 4); CE(1, 5); CE(2, 6); CE(3, 7); CE(8, 12); CE(9, 13); CE(10, 14); CE(11, 15); CE(0, 2); CE(1, 3); CE(4, 6); CE(5, 7); CE(8, 10); CE(9, 11); CE(12, 14); CE(13, 15); CE(0, 1); CE(2, 3); CE(4, 5); CE(6, 7); CE(8, 9); CE(10, 11); CE(12, 13); CE(14, 15);
}
DEV void bmerge16(unsigned (&a)[16]) {
    CE(0, 8); CE(1, 9); CE(2, 10); CE(3, 11); CE(4, 12); CE(5, 13); CE(6, 14); CE(7, 15); CE(0, 4); CE(1, 5); CE(2, 6); CE(3, 7); CE(8, 12); CE(9, 13); CE(10, 14); CE(11, 15); CE(0, 2); CE(1, 3); CE(4, 6); CE(5, 7); CE(8, 10); CE(9, 11); CE(12, 14); CE(13, 15); CE(0, 1); CE(2, 3); CE(4, 5); CE(6, 7); CE(8, 9); CE(10, 11); CE(12, 13); CE(14, 15);
}
#undef CE
DEV void top_merge(unsigned (&a)[16], const unsigned (&b)[16]) {
#pragma unroll
    for (int i = 0; i < 16; ++i) a[i] = umax_(a[i], b[15 - i]);
    bmerge16(a);
}
DEV void xlane_merge(unsigned (&a)[16]) {
    unsigned b[16];
#pragma unroll
    for (int i = 0; i < 16; ++i) b[i] = (unsigned)__shfl_xor((int)a[i], 32);
    top_merge(a, b);
}
DEV unsigned lookup_idx(unsigned long long lo, unsigned long long hi, int a) { const unsigned long long wv = (a < 8) ? lo : hi; return (unsigned)(wv >> ((a & 7) * 8)) & 127u; }
DEV unsigned blendu(unsigned m, unsigned a, unsigned b) { return (a & ~m) | (b & m); }
DEV float blendf(unsigned m, float a, float b) { return __uint_as_float((__float_as_uint(a) & ~m) | (__float_as_uint(b) & m)); }

DEV void topk_phase(LAS unsigned char* lds, const bf16_t* __restrict__ Q2, const float* __restrict__ keys_l, int* __restrict__ eidx, float* __restrict__ egate, int G, int cblk) {
    int tid_ = threadIdx.x; asm volatile("" : "+v"(tid_));
    const int tid = tid_, w = __builtin_amdgcn_readfirstlane(tid >> 6), lane = tid & 63, tl = lane & 31, hh = lane >> 5;
    asm volatile("" : "+s"(G));
    const bool by_head = (G & 7) == 0;
#pragma unroll 1
    for (int h = 0; h < 8; ++h) {
        if (by_head && h != (cblk & 7)) continue;
        __syncthreads();
        {
            const int r = tid >> 1, c0 = (tid & 1) * 64; const float* src = keys_l + ((size_t)h * 256 + r) * 128 + c0; LAS unsigned char* dst = lds + r * KROW + c0 * 2;
#pragma unroll
            for (int j = 0; j < 64; j += 8) { const float4 a = *(const float4*)(src + j), b = *(const float4*)(src + j + 4);
                u32x4 o; o.x = pg8::cvt_pk_bf16(a.x, a.y); o.y = pg8::cvt_pk_bf16(a.z, a.w); o.z = pg8::cvt_pk_bf16(b.x, b.y); o.w = pg8::cvt_pk_bf16(b.z, b.w); *(LAS u32x4*)(dst + j * 2) = o; }
        }
        __syncthreads();
        const int first = by_head ? (cblk >> 3) * 8 + w : cblk * 8 + w, stride = by_head ? (G >> 3) * 8 : G * 8;
#pragma unroll 1
        for (int blk = first; blk < T_ / 32; blk += stride) {
            const int tok = blk * 32 + tl; const bf16_t* qrow = Q2 + (size_t)tok * 2048 + h * 256 + 8 * hh;
            unsigned L[2][16];
#pragma unroll
            for (int p = 0; p < 2; ++p) {
                bf16x8 bq[8];
#pragma unroll
                for (int ks = 0; ks < 8; ++ks) bq[ks] = *(const bf16x8*)(qrow + p * 128 + 16 * ks);
#pragma unroll
                for (int t = 0; t < 4; ++t) {
                    f32x16 acc;
#pragma unroll
                    for (int e = 0; e < 16; ++e) acc[e] = 0.f;
#pragma unroll
                    for (int ks = 0; ks < 8; ++ks) { const bf16x8 ak = *(const LAS bf16x8*)(lds + (p * 128 + 32 * t + tl) * KROW + (16 * ks + 8 * hh) * 2);
                        acc = __builtin_amdgcn_mfma_f32_32x32x16_bf16(ak, bq[ks], acc, 0, 0, 0); }
                    unsigned K[16];
#pragma unroll
                    for (int e = 0; e < 16; ++e) K[e] = (sortable(acc[e]) & ~127u) | (unsigned)((127 - 32 * t - (e & 3) - 8 * (e >> 2)) - 4 * hh);
                    sort16(K);
                    if (t == 0) {
#pragma unroll
                        for (int e = 0; e < 16; ++e) L[p][e] = K[e];
                    } else top_merge(L[p], K);
                    __builtin_amdgcn_sched_barrier(0);
                }
                xlane_merge(L[p]);
                __builtin_amdgcn_sched_barrier(0);
            }
            float f1[16], f2[16];
#pragma unroll
            for (int e = 0; e < 16; ++e) { f1[e] = unsortable(L[0][e] & ~127u); f2[e] = unsortable(L[1][e] & ~127u); }
            unsigned hm = 0u - (unsigned)hh; asm volatile("" : "+v"(hm));
            unsigned C[2][16];
            C[0][0] = (sortable(blendf(hm, f1[0], f1[2]) + blendf(hm, f2[0], f2[1])) & ~255u) | (255u - blendu(hm, 0u, 33u));
            C[0][1] = (sortable(blendf(hm, f1[0], f1[2]) + blendf(hm, f2[1], f2[2])) & ~255u) | (255u - blendu(hm, 1u, 34u));
            C[0][2] = (sortable(blendf(hm, f1[0], f1[2]) + blendf(hm, f2[2], f2[3])) & ~255u) | (255u - blendu(hm, 2u, 35u));
            C[0][3] = (sortable(blendf(hm, f1[0], f1[2]) + blendf(hm, f2[3], f2[4])) & ~255u) | (255u - blendu(hm, 3u, 36u));
            C[0][4] = (sortable(blendf(hm, f1[0], f1[3]) + blendf(hm, f2[4], f2[0])) & ~255u) | (255u - blendu(hm, 4u, 48u));
            C[0][5] = (sortable(blendf(hm, f1[0], f1[3]) + blendf(hm, f2[5], f2[1])) & ~255u) | (255u - blendu(hm, 5u, 49u));
            C[0][6] = (sortable(blendf(hm, f1[0], f1[3]) + blendf(hm, f2[6], f2[2])) & ~255u) | (255u - blendu(hm, 6u, 50u));
            C[0][7] = (sortable(blendf(hm, f1[0], f1[3]) + blendf(hm, f2[7], f2[3])) & ~255u) | (255u - blendu(hm, 7u, 51u));
            C[0][8] = (sortable(blendf(hm, f1[0], f1[4]) + blendf(hm, f2[8], f2[0])) & ~255u) | (255u - blendu(hm, 8u, 64u));
            C[0][9] = (sortable(blendf(hm, f1[0], f1[4]) + blendf(hm, f2[9], f2[1])) & ~255u) | (255u - blendu(hm, 9u, 65u));
            C[0][10] = (sortable(blendf(hm, f1[0], f1[4]) + blendf(hm, f2[10], f2[2])) & ~255u) | (255u - blendu(hm, 10u, 66u));
            C[0][11] = (sortable(blendf(hm, f1[0], f1[5]) + blendf(hm, f2[11], f2[0])) & ~255u) | (255u - blendu(hm, 11u, 80u));
            C[0][12] = (sortable(blendf(hm, f1[0], f1[5]) + blendf(hm, f2[12], f2[1])) & ~255u) | (255u - blendu(hm, 12u, 81u));
            C[0][13] = (sortable(blendf(hm, f1[0], f1[6]) + blendf(hm, f2[13], f2[0])) & ~255u) | (255u - blendu(hm, 13u, 96u));
            C[0][14] = (sortable(blendf(hm, f1[0], f1[6]) + blendf(hm, f2[14], f2[1])) & ~255u) | (255u - blendu(hm, 14u, 97u));
            C[0][15] = (sortable(blendf(hm, f1[0], f1[7]) + blendf(hm, f2[15], f2[0])) & ~255u) | (255u - blendu(hm, 15u, 112u));
            C[1][0] = (sortable(blendf(hm, f1[1], f1[7]) + blendf(hm, f2[0], f2[1])) & ~255u) | (255u - blendu(hm, 16u, 113u));
            C[1][1] = (sortable(blendf(hm, f1[1], f1[8]) + blendf(hm, f2[1], f2[0])) & ~255u) | (255u - blendu(hm, 17u, 128u));
            C[1][2] = (sortable(blendf(hm, f1[1], f1[9]) + blendf(hm, f2[2], f2[0])) & ~255u) | (255u - blendu(hm, 18u, 144u));
            C[1][3] = (sortable(blendf(hm, f1[1], f1[10]) + blendf(hm, f2[3], f2[0])) & ~255u) | (255u - blendu(hm, 19u, 160u));
            C[1][4] = (sortable(blendf(hm, f1[1], f1[11]) + blendf(hm, f2[4], f2[0])) & ~255u) | (255u - blendu(hm, 20u, 176u));
            C[1][5] = (sortable(blendf(hm, f1[1], f1[12]) + blendf(hm, f2[5], f2[0])) & ~255u) | (255u - blendu(hm, 21u, 192u));
            C[1][6] = (sortable(blendf(hm, f1[1], f1[13]) + blendf(hm, f2[6], f2[0])) & ~255u) | (255u - blendu(hm, 22u, 208u));
            C[1][7] = (sortable(blendf(hm, f1[1], f1[14]) + blendf(hm, f2[7], f2[0])) & ~255u) | (255u - blendu(hm, 23u, 224u));
            C[1][8] = (sortable(blendf(hm, f1[2], f1[15]) + blendf(hm, f2[0], f2[0])) & ~255u) | (255u - blendu(hm, 32u, 240u));
            C[1][9] = 0u;
            C[1][10] = 0u;
            C[1][11] = 0u;
            C[1][12] = 0u;
            C[1][13] = 0u;
            C[1][14] = 0u;
            C[1][15] = 0u;
            sort16(C[0]); sort16(C[1]); top_merge(C[0], C[1]); xlane_merge(C[0]);
            unsigned long long p1lo = 0ull, p1hi = 0ull, p2lo = 0ull, p2hi = 0ull;
#pragma unroll
            for (int m = 0; m < 8; ++m) { p1lo |= (unsigned long long)(127u - (L[0][m] & 127u)) << (8 * m); p1hi |= (unsigned long long)(127u - (L[0][8 + m] & 127u)) << (8 * m);
                p2lo |= (unsigned long long)(127u - (L[1][m] & 127u)) << (8 * m); p2hi |= (unsigned long long)(127u - (L[1][8 + m] & 127u)) << (8 * m); }
            float val[16]; unsigned ex[16]; float sum = 0.f;
#pragma unroll
            for (int k = 0; k < 16; ++k) { const unsigned flat = 255u - (C[0][k] & 255u); const int a = (int)(flat >> 4), b = (int)(flat & 15u);
                val[k] = unsortable(C[0][k] & ~255u); ex[k] = lookup_idx(p1lo, p1hi, a) * 128u + lookup_idx(p2lo, p2hi, b); }
            const float mx = val[0];
#pragma unroll
            for (int k = 0; k < 16; ++k) { val[k] = __expf(val[k] - mx); sum += val[k]; }
            const float inv = 1.f / sum;
            int eo[8]; float go[8];
#pragma unroll
            for (int k = 0; k < 8; ++k) { eo[k] = (int)blendu(hm, ex[k], ex[8 + k]); go[k] = blendf(hm, val[k], val[8 + k]) * inv; }
            const size_t ob = ((size_t)tok * 8 + h) * 16 + 8 * hh;
            *(int4*)(eidx + ob) = make_int4(eo[0], eo[1], eo[2], eo[3]); *(int4*)(eidx + ob + 4) = make_int4(eo[4], eo[5], eo[6], eo[7]);
            *(float4*)(egate + ob) = make_float4(go[0], go[1], go[2], go[3]); *(float4*)(egate + ob + 4) = make_float4(go[4], go[5], go[6], go[7]);
        }
    }
    __syncthreads();
}
}

struct Params {
    const float *x, *c, *w_ada, *b_ada, *w_in, *conv_w, *conv_b, *hy_w1, *hy_b1, *hy_w2, *hy_b2, *hy_w3, *hy_freq, *hy_ld, *hy_bias, *attn_sink, *wba, *wbb, *wbc, *w_out, *ln_g, *ln_b,
        *peer_wq, *peer_keys, *peer_u, *peer_v;
    float* out; char* ws;
};
constexpr int LDS_BYTES = 148480;

#define RUN(nvb, call) do { int tid_ = threadIdx.x; asm volatile("" : "+v"(tid_)); const int t = tid_ & 255, sub = tid_ >> 8; unsigned char* sm = lds + sub * 16384; \
        for (int vb = (int)blockIdx.x * 2 + sub; vb < (nvb); vb += (int)gridDim.x * 2) { call; __syncthreads(); } } while (0)
#define GSYNC() do { __builtin_amdgcn_sched_barrier(0); grid.sync(); __builtin_amdgcn_sched_barrier(0); } while (0)

__global__ void __launch_bounds__(512, 2) mega(Params p) {
    extern __shared__ __attribute__((aligned(16))) unsigned char lds[];
    cg::grid_group grid = cg::this_grid();
    LAS unsigned char* ldsl = (LAS unsigned char*)lds;
    const int G = gridDim.x, cblk = blockIdx.x;
    float* out = p.out; (void)out;
    {
    char* ws = p.ws;
    float* ada = (float*)(ws + OFF_ADA); float2* rope = (float2*)(ws + OFF_ROPE); bf16_t* Gr = (bf16_t*)(ws + OFF_GR); float* lse2 = (float*)(ws + OFF_LSE);
    bf16_t* WinT = (bf16_t*)(ws + OFF_WINT); bf16_t* WmT = (bf16_t*)(ws + OFF_WMT); bf16_t* WoutT = (bf16_t*)(ws + OFF_WOUTT); bf16_t* WqT = (bf16_t*)(ws + OFF_WQT);
    bf16_t* UY = (bf16_t*)(ws + OFF_UY); bf16_t* Y = UY + 1024; bf16_t* P = (bf16_t*)(ws + OFF_P); bf16_t* hyT = (bf16_t*)(ws + OFF_HYT);
    bf16_t* merged = (bf16_t*)(ws + OFF_P); bf16_t* gtmp = (bf16_t*)(ws + OFF_P + 64 * MB_); bf16_t* Q2 = (bf16_t*)(ws + OFF_P);
    int* eidx = (int*)(ws + OFF_HYT); float* egate = (float*)(ws + OFF_HYT + 16 * MB_); bf16_t* Ub = (bf16_t*)(ws + OFF_HYT + 32 * MB_); bf16_t* Vb = (bf16_t*)(ws + OFF_HYT + 64 * MB_);
    float* h2 = (float*)(ws + OFF_P); float* hf = (float*)(ws + OFF_P + 2 * MB_);
    (void)lse2; (void)P; (void)hyT; (void)merged; (void)gtmp; (void)Q2; (void)eidx; (void)egate; (void)Ub; (void)Vb; (void)Y;

    RUN(48, nb_ada(vb, t, sm, p.c, p.w_ada, p.b_ada, ada));
    RUN(256, nb_rope(vb, t, sm, rope));
    RUN(1024, nb_filt_h2(vb, t, sm, p.hy_w1, p.hy_b1, p.hy_w2, p.hy_b2, p.hy_freq, h2));
    { const WPrep wq{p.w_in, p.wba, p.wbb, p.wbc, p.w_out, p.peer_wq, WinT, WmT, WoutT, WqT}; RUN(6016, nb_wprep(vb, t, sm, wq)); }
    GSYNC();
    RUN(32768, nb_filt_full(vb, t, sm, h2, p.hy_w3, p.hy_ld, hf));
    RUN(T_ * 4, nb_modulate(vb, t, sm, p.x, ada, 0, 1024, UY));
    GSYNC();
    RUN(2048, nb_filt_norm(vb, t, sm, hf, Gr));
    GSYNC();
    }
#pragma unroll 1
    for (int l = 0; l < 2; ++l) {
        char* ws = p.ws; asm volatile("" : "+s"(ws));
        float* out = p.out; asm volatile("" : "+s"(out));
        int Gl = gridDim.x, cl = blockIdx.x; asm volatile("" : "+s"(Gl), "+s"(cl));
        float* ada = (float*)(ws + OFF_ADA); float2* rope = (float2*)(ws + OFF_ROPE); bf16_t* Gr = (bf16_t*)(ws + OFF_GR); float* lse2 = (float*)(ws + OFF_LSE);
        bf16_t* WinT = (bf16_t*)(ws + OFF_WINT); bf16_t* WmT = (bf16_t*)(ws + OFF_WMT); bf16_t* WoutT = (bf16_t*)(ws + OFF_WOUTT); bf16_t* WqT = (bf16_t*)(ws + OFF_WQT);
        bf16_t* UY = (bf16_t*)(ws + OFF_UY); bf16_t* Y = UY + 1024; bf16_t* P = (bf16_t*)(ws + OFF_P); bf16_t* hyT = (bf16_t*)(ws + OFF_HYT);
        bf16_t* merged = (bf16_t*)(ws + OFF_P); bf16_t* gtmp = (bf16_t*)(ws + OFF_P + 64 * MB_); bf16_t* Q2 = (bf16_t*)(ws + OFF_P);
        int* eidx = (int*)(ws + OFF_HYT); float* egate = (float*)(ws + OFF_HYT + 16 * MB_); bf16_t* Ub = (bf16_t*)(ws + OFF_HYT + 32 * MB_); bf16_t* Vb = (bf16_t*)(ws + OFF_HYT + 64 * MB_);
        const float* ada_l = ada + (size_t)l * 16 * 6144;
        const float* xin = (l == 0) ? p.x : out;
        const bf16_t* WinT_l = WinT + (size_t)l * 7680 * 1024;
        {
            const pg8::PlainSched S1{UY, WinT_l, UYW_, 1024, 128, 12, 16, Gl, cl}; const pg8::EpiP E1{P, rope};
            pg8::gemm_phase(ldsl, UYW_, 1024, S1, E1);
            const pg8::PlainSched S2{WinT_l + (size_t)3072 * 1024, UY, 1024, UYW_, 6, 128, 16, Gl, cl}; const pg8::EpiBf E2{hyT, T_, 0};
            pg8::gemm_phase(ldsl, 1024, UYW_, S2, E2);
        }
        GSYNC();
        RUN(1536, nb_attnA(vb, t, sm, P, lse2));
        RUN(1024, nb_attnC(vb, t, sm, P, p.attn_sink + l * 8, Y));
        GSYNC();
        RUN(32768, nb_combineA(vb, t, sm, P, lse2, Y));
        hy::hyena_phase(ldsl, hyT, Gr + (size_t)l * 2 * 512 * 4096, p.conv_w + (size_t)l * 3 * 1536, p.conv_b + (size_t)l * 1536, p.hy_bias + (size_t)l * 1024, Gl, cl);
        GSYNC();
        RUN(65536, nb_transY(vb, t, sm, hyT, Y));
        GSYNC();
        {
            const pg8::MergeSched S{UY, WmT + (size_t)l * 1024 * WMW_, Gl, cl}; const pg8::EpiMergeAll E{gtmp, merged};
            pg8::gemm_phase(ldsl, UYW_, WMW_, S, E);
        }
        GSYNC();
        {
            const pg8::PlainSched S{merged, WoutT + (size_t)l * 1024 * 1024, 1024, 1024, 128, 4, 16, Gl, cl}; const pg8::EpiOut E{xin, out, ada_l + 2048};
            pg8::gemm_phase(ldsl, 1024, 1024, S, E);
        }
        GSYNC();
        RUN(T_, nb_ln_mod(vb, t, sm, out, p.ln_g + (size_t)(l * 2 + 0) * 1024, p.ln_b + (size_t)(l * 2 + 0) * 1024, ada_l, 3072, 4096, UY));
        RUN(8192, peer::nb_cvt_tables(vb, t, p.peer_u + (size_t)l * 16384 * 1024, p.peer_v + (size_t)l * 16384 * 1024, Ub, Vb));
        GSYNC();
        {
            const pg8::PlainSched S{UY, WqT + (size_t)l * 2048 * 1024, UYW_, 1024, 128, 8, 16, Gl, cl}; const pg8::EpiBf E{Q2, 2048, 0};
            pg8::gemm_phase(ldsl, UYW_, 1024, S, E);
        }
        GSYNC();
        tk::topk_phase(ldsl, Q2, p.peer_keys + (size_t)l * 8 * 2 * 128 * 128, eidx, egate, Gl, cl);
        GSYNC();
        peer::peer_phase(ldsl, out, ada_l, eidx, egate, Ub, Vb, p.ln_g + (size_t)(l * 2 + 1) * 1024, p.ln_b + (size_t)(l * 2 + 1) * 1024,
                         (l == 0) ? ada + (size_t)16 * 6144 : (const float*)nullptr, UY, Gl, cl);
        if (l == 0) GSYNC();
    }
}

extern "C" void kernel_launch(void* const* d_in, const int* in_sizes, int n_in, void* d_out, int out_size, void* d_ws, size_t ws_size, hipStream_t stream) {
    static int grid = 0;
    if (grid == 0) {
        if (ws_size < WS_NEED || n_in != 26) { fprintf(stderr, "kernel_launch: workspace %zu < %zu or n_in %d != 26\n", ws_size, (size_t)WS_NEED, n_in); grid = -1; return; }
        int dev = 0, cus = 0, per_cu = 0;
        (void)hipGetDevice(&dev); (void)hipDeviceGetAttribute(&cus, hipDeviceAttributeMultiprocessorCount, dev);
        (void)hipFuncSetAttribute((const void*)mega, hipFuncAttributeMaxDynamicSharedMemorySize, LDS_BYTES);
        (void)hipOccupancyMaxActiveBlocksPerMultiprocessor(&per_cu, (const void*)mega, 512, LDS_BYTES);
        if (per_cu < 1) { fprintf(stderr, "kernel_launch: occupancy query says %d blocks per CU\n", per_cu); grid = -1; return; }
        grid = cus;
    }
    if (grid < 0) return;
    Params p{};
    const float** pp = (const float**)&p;
    for (int i = 0; i < 26; ++i) pp[i] = (const float*)d_in[i];
    p.out = (float*)d_out; p.ws = (char*)d_ws;
    void* args[] = {&p};
    hipError_t e = hipLaunchCooperativeKernel((const void*)mega, dim3(grid), dim3(512), args, LDS_BYTES, stream);
    if (e != hipSuccess) fprintf(stderr, "cooperative launch failed: %s (grid %d)\n", hipGetErrorString(e), grid);
}
```

```cpp
#include <hip/hip_runtime.h>
#include <hip/hip_cooperative_groups.h>
namespace cg = cooperative_groups;
#include <stdint.h>
#include <stdio.h>

#define DEV __device__ __forceinline__
typedef unsigned short bf16_t;

constexpr int D_ = 1024, B_ = 16, S_ = 2048, T_ = B_ * S_;
constexpr float ALPHA_ = 1.41421356237309515f;
constexpr float LOG2E_ = 1.4426950408889634f;
constexpr float QSCALE_ = 0.125f * 1.4426950408889634f;
constexpr float LN_EPS_ = 1e-5f;
constexpr int PW_ = 3072;
constexpr int UYW_ = 2304;
constexpr int WMW_ = 4352;

constexpr size_t MB_ = 1024 * 1024;
constexpr size_t OFF_ADA = 0, OFF_ROPE = 1 * MB_, OFF_GR = 2 * MB_, OFF_LSE = 18 * MB_, OFF_WINT = 20 * MB_, OFF_WMT = 50 * MB_,
                 OFF_WOUTT = 68 * MB_, OFF_WQT = 72 * MB_, OFF_KEYS = 80 * MB_, OFF_UY = 82 * MB_, OFF_P = 226 * MB_, OFF_HYT = 418 * MB_,
                 OFF_Z1T = OFF_P  , WS_NEED = 514 * MB_;

DEV float bf2f(bf16_t v) { return __uint_as_float(((unsigned)v) << 16); }
DEV bf16_t f2bf(float f) { unsigned u = __float_as_uint(f); u += 0x7FFFu + ((u >> 16) & 1u); return (bf16_t)(u >> 16); }

DEV void nb_ada(int vb, int t, unsigned char* sm, const float* __restrict__ c, const float* __restrict__ w_ada, const float* __restrict__ b_ada, float* __restrict__ ada) {
    const int idx = vb * 256 + t; const int l = idx / 6144, n = idx % 6144;
    float (*cond)[64] = (float (*)[64])sm;
    float acc[16];
#pragma unroll
    for (int b = 0; b < 16; ++b) acc[b] = b_ada[l * 6144 + n];
    for (int k0 = 0; k0 < 1024; k0 += 64) {
        for (int i = t; i < 1024; i += 256) { const int b = i >> 6, kk = i & 63; const float v = c[b * 1024 + k0 + kk]; cond[b][kk] = v / (1.f + expf(-v)); }
        __syncthreads();
        for (int kk = 0; kk < 64; ++kk) { const float w = w_ada[((size_t)l * 1024 + k0 + kk) * 6144 + n];
#pragma unroll
            for (int b = 0; b < 16; ++b) acc[b] += cond[b][kk] * w; }
        __syncthreads();
    }
#pragma unroll
    for (int b = 0; b < 16; ++b) ada[((size_t)l * 16 + b) * 6144 + n] = acc[b];
}

DEV void nb_rope(int vb, int t, unsigned char* sm, float2* __restrict__ rope) {
    const int idx = vb * 256 + t; const int s = idx >> 5, i = idx & 31;
    const float inv = powf(10000.f, -(float)i / 32.f); const float ang = (float)s * inv;
    rope[idx] = make_float2(cosf(ang), sinf(ang));
}

DEV void nb_filt_h2(int vb, int t, unsigned char* sm, const float* __restrict__ w1, const float* __restrict__ b1, const float* __restrict__ w2, const float* __restrict__ b2,
                                                const float* __restrict__ freq, float* __restrict__ h2) {
    const int grp = t >> 6, j = t & 63; const int lt = vb * 4 + grp; const int l = lt / 2048, tt = lt % 2048;
    float* z = (float*)sm + grp * 128; float* h1 = z + 64;
    if (j < 33) {
        const float idx = (float)tt, tn = idx / 2047.f, w = 6.283185307179586f * idx / 2048.f;
        if (j == 0) z[0] = tn;
        else { const int k = (j <= 16) ? (j - 1) : (j - 17); const float band = 1e-4f + (float)k * ((15.f - 1e-4f) / 15.f); const float ang = w * band;
            z[j] = (j <= 16) ? cosf(ang) : -sinf(ang); }
    }
    __syncthreads();
    float a = b1[l * 64 + j];
    for (int e = 0; e < 33; ++e) a += z[e] * w1[(l * 33 + e) * 64 + j];
    h1[j] = sinf(freq[(l * 2 + 0) * 64 + j] * a);
    __syncthreads();
    float a2 = b2[l * 64 + j];
    for (int i = 0; i < 64; ++i) a2 += h1[i] * w2[(l * 64 + i) * 64 + j];
    h2[((size_t)l * 2048 + tt) * 64 + j] = sinf(freq[(l * 2 + 1) * 64 + j] * a2);
}

DEV void nb_filt_full(int vb, int t, unsigned char* sm, const float* __restrict__ h2, const float* __restrict__ w3, const float* __restrict__ log_decay, float* __restrict__ hf) {
    const size_t idx = (size_t)vb * 256 + t; const int col = (int)(idx & 2047), tt = (int)((idx >> 11) & 2047), l = (int)(idx >> 22);
    const float* hr = h2 + ((size_t)l * 2048 + tt) * 64; float a = 0.f;
    for (int j = 0; j < 64; ++j) a += hr[j] * w3[((size_t)l * 64 + j) * 2048 + col];
    const float tn = (float)tt / 2047.f;
    hf[idx] = a * expf(-tn * expf(log_decay[l * 2048 + col]));
}

DEV void nb_filt_norm(int vb, int t, unsigned char* sm, const float* __restrict__ hf, bf16_t* __restrict__ Gr) {
    const int blk = vb; const int c = blk & 511, o = (blk >> 9) & 1, l = blk >> 10;
    const float* base = hf + (size_t)l * 2048 * 2048; const int colf = o * 512 + c, colb = 1024 + o * 512 + c;
    float ss = 0.f;
    for (int tt = t; tt < 2048; tt += 256) { const float a = base[(size_t)tt * 2048 + colf]; ss += a * a; if (tt >= 1) { const float bb = base[(size_t)tt * 2048 + colb]; ss += bb * bb; } }
    float* red = (float*)sm; red[t] = ss; __syncthreads();
    for (int st = 128; st > 0; st >>= 1) { if (t < st) red[t] += red[t + st]; __syncthreads(); }
    const float scale = rsqrtf(red[0] + 1e-12f); __syncthreads();
    bf16_t* g = Gr + (size_t)blk * 4096;
    for (int n = t; n < 4096; n += 256) { const int lag = 2047 - n; float v = 0.f;
        if (n < 4095) v = (lag >= 0) ? base[(size_t)lag * 2048 + colf] : base[(size_t)(-lag) * 2048 + colb];
        g[n] = f2bf(v * scale); }
}

DEV void nb_modulate(int vb, int t, unsigned char* sm, const float* __restrict__ x, const float* __restrict__ ada_l, int off_sh, int off_sc, bf16_t* __restrict__ ubuf) {
    const size_t idx = (size_t)vb * 256 + t; const int d = (int)(idx & 1023); const int b = (int)(idx >> 21);
    const float* a = ada_l + (size_t)b * 6144;
    ubuf[(idx >> 10) * UYW_ + d] = f2bf(x[idx] * (1.f + a[off_sc + d]) + a[off_sh + d]);
}

template <class AL, class WL, class EP>
DEV void nb_gemm(int vb, int t, unsigned char* sm, int nbx, int K, AL al, WL wl, EP ep) {
    float (*As)[65] = (float (*)[65])sm;
    float (*Ws)[65] = (float (*)[65])(sm + 16 * 65 * 4);
    const int tx = t & 15, ty = t >> 4;
    const int m0 = (vb / nbx) * 64, n0 = (vb % nbx) * 64;
    float acc[4][4];
#pragma unroll
    for (int i = 0; i < 4; ++i)
#pragma unroll
        for (int j = 0; j < 4; ++j) acc[i][j] = 0.f;
    for (int k0 = 0; k0 < K; k0 += 16) {
#pragma unroll
        for (int r = 0; r < 4; ++r) { const int i = t + r * 256; const int mm = i >> 4, kk = i & 15; As[kk][mm] = al(m0 + mm, k0 + kk); }
#pragma unroll
        for (int r = 0; r < 4; ++r) { const int i = t + r * 256; const int kk = i >> 6, nn = i & 63; Ws[kk][nn] = wl(k0 + kk, n0 + nn); }
        __syncthreads();
#pragma unroll
        for (int kk = 0; kk < 16; ++kk) {
            float a[4], w[4];
#pragma unroll
            for (int i = 0; i < 4; ++i) { a[i] = As[kk][ty + 16 * i]; w[i] = Ws[kk][tx + 16 * i]; }
#pragma unroll
            for (int i = 0; i < 4; ++i)
#pragma unroll
                for (int j = 0; j < 4; ++j) acc[i][j] += a[i] * w[j];
        }
        __syncthreads();
    }
    ep(m0, n0, ty, tx, acc);
}

struct ALbf { const bf16_t* A; int lda; int pad; DEV float operator()(int m, int k) const { return bf2f(A[(size_t)m * lda + k]); } };
struct WLf { const float* W; int ldw; int coff; DEV float operator()(int k, int n) const { return W[(size_t)k * ldw + coff + n]; } };
struct WLinP { const float* W; DEV float operator()(int k, int n) const { return W[(size_t)k * 7680 + (n < 2304 ? n : n + 1536)]; } };

struct EpP { bf16_t* P; const float2* rope;
    DEV void operator()(int m0, int n0, int ty, int tx, float (&acc)[4][4]) const {
        const int head = n0 >> 6; const bool rp = (head < 24) || (head >= 36 && head < 46); const bool qs = (head < 12) || (head >= 36 && head < 44);
#pragma unroll
        for (int i = 0; i < 4; ++i) { const int m = m0 + ty + 16 * i; const int s = m & 2047; bf16_t* row = P + (size_t)m * PW_ + n0;
            if (rp) {
#pragma unroll
                for (int jj = 0; jj < 2; ++jj) { const int d = tx + 16 * jj; const float x1 = acc[i][jj], x2 = acc[i][jj + 2]; const float2 cs = rope[s * 32 + d];
                    float o1 = x1 * cs.x - x2 * cs.y, o2 = x2 * cs.x + x1 * cs.y; if (qs) { o1 *= QSCALE_; o2 *= QSCALE_; }
                    const int p1 = 8 * (d >> 2) + (d & 3); row[p1] = f2bf(o1); row[p1 + 4] = f2bf(o2); }
            } else {
#pragma unroll
                for (int j = 0; j < 4; ++j) row[tx + 16 * j] = f2bf(acc[i][j]);
            } }
    } };
struct EpHyT { bf16_t* hyT;
    DEV void operator()(int m0, int n0, int ty, int tx, float (&acc)[4][4]) const {
#pragma unroll
        for (int i = 0; i < 4; ++i)
#pragma unroll
            for (int j = 0; j < 4; ++j) hyT[(size_t)(n0 + tx + 16 * j) * T_ + m0 + ty + 16 * i] = f2bf(acc[i][j]);
    } };
struct EpGate { bf16_t* tmp;
    DEV void operator()(int m0, int n0, int ty, int tx, float (&acc)[4][4]) const {
#pragma unroll
        for (int i = 0; i < 4; ++i)
#pragma unroll
            for (int j = 0; j < 4; ++j) tmp[(size_t)(m0 + ty + 16 * i) * 1024 + n0 + tx + 16 * j] = f2bf(1.f / (1.f + expf(-acc[i][j])));
    } };
struct EpMerge { const bf16_t* tmp; bf16_t* merged; int first; int pad;
    DEV void operator()(int m0, int n0, int ty, int tx, float (&acc)[4][4]) const {
#pragma unroll
        for (int i = 0; i < 4; ++i)
#pragma unroll
            for (int j = 0; j < 4; ++j) { const size_t o = (size_t)(m0 + ty + 16 * i) * 1024 + n0 + tx + 16 * j; float v = bf2f(tmp[o]) * acc[i][j]; if (!first) v += bf2f(merged[o]); merged[o] = f2bf(v); }
    } };
struct EpOut { const float* xin; float* h; const float* ada_l; int off_g; int pad;
    DEV void operator()(int m0, int n0, int ty, int tx, float (&acc)[4][4]) const {
#pragma unroll
        for (int i = 0; i < 4; ++i)
#pragma unroll
            for (int j = 0; j < 4; ++j) { const int m = m0 + ty + 16 * i, n = n0 + tx + 16 * j; const size_t o = (size_t)m * 1024 + n;
                h[o] = ALPHA_ * xin[o] + ada_l[(size_t)(m >> 11) * 6144 + off_g + n] * acc[i][j]; }
    } };
struct EpQ2 { bf16_t* Q2;
    DEV void operator()(int m0, int n0, int ty, int tx, float (&acc)[4][4]) const {
#pragma unroll
        for (int i = 0; i < 4; ++i)
#pragma unroll
            for (int j = 0; j < 4; ++j) Q2[(size_t)(m0 + ty + 16 * i) * 2048 + n0 + tx + 16 * j] = f2bf(acc[i][j]);
    } };

DEV void nb_attnA(int vb, int t, unsigned char* sm, bf16_t* __restrict__ P, float* __restrict__ lse2) {
    const int idx = vb * 256 + t; const int s = idx & 2047, head = (idx >> 11) % 12, b = idx / (2048 * 12);
    const int gi = head >> 2; const int dil = gi == 0 ? 1 : (gi == 1 ? 4 : 16); const int ls = 2048 / dil; const int r = s % dil, p = s / dil;
    bf16_t* qrow = P + (size_t)(b * 2048 + s) * PW_ + head * 64;
    float q[64], o[64];
#pragma unroll
    for (int d = 0; d < 64; ++d) { q[d] = bf2f(qrow[d]); o[d] = 0.f; }
    float m = -1e30f, l = 0.f;
    const int lo = max(0, p - 64), hi = min(ls - 1, p + 64);
    for (int pp = lo; pp <= hi; ++pp) {
        const bf16_t* krow = P + (size_t)(b * 2048 + pp * dil + r) * PW_ + 768 + head * 64; const bf16_t* vrow = krow + 768;
        float sc = 0.f;
#pragma unroll
        for (int d = 0; d < 64; ++d) sc += q[d] * bf2f(krow[d]);
        const float mn = fmaxf(m, sc), corr = exp2f(m - mn), pw = exp2f(sc - mn);
        l = l * corr + pw;
#pragma unroll
        for (int d = 0; d < 64; ++d) o[d] = o[d] * corr + pw * bf2f(vrow[d]);
        m = mn;
    }
    const float inv = 1.f / l;
#pragma unroll
    for (int d = 0; d < 64; ++d) qrow[d] = f2bf(o[d] * inv);
    lse2[(size_t)(b * 2048 + s) * 12 + head] = m + log2f(l);
}

DEV void nb_attnC(int vb, int t, unsigned char* sm, const bf16_t* __restrict__ P, const float* __restrict__ sink_l, bf16_t* __restrict__ Y) {
    const int idx = vb * 256 + t; const int s = idx & 2047, qh = (idx >> 11) & 7, b = idx >> 14; const int kvh = qh >> 2;
    const bf16_t* qrow = P + (size_t)(b * 2048 + s) * PW_ + 2304 + qh * 64;
    float q[64], o[64];
#pragma unroll
    for (int d = 0; d < 64; ++d) { q[d] = bf2f(qrow[d]); o[d] = 0.f; }
    float m = -1e30f, l = 0.f;
    const int lo = max(0, s - 128), hi = min(2047, s + 128);
    for (int pp = lo; pp <= hi; ++pp) {
        const bf16_t* krow = P + (size_t)(b * 2048 + pp) * PW_ + 2816 + kvh * 64; const bf16_t* vrow = krow + 128;
        float sc = 0.f;
#pragma unroll
        for (int d = 0; d < 64; ++d) sc += q[d] * bf2f(krow[d]);
        const float mn = fmaxf(m, sc), corr = exp2f(m - mn), pw = exp2f(sc - mn);
        l = l * corr + pw;
#pragma unroll
        for (int d = 0; d < 64; ++d) o[d] = o[d] * corr + pw * bf2f(vrow[d]);
        m = mn;
    }
    const float sk = sink_l[qh] * LOG2E_; const float mf = fmaxf(m, sk); const float corr = exp2f(m - mf);
    l = l * corr + exp2f(sk - mf); const float inv = corr / l;
    bf16_t* yrow = Y + (size_t)(b * 2048 + s) * UYW_ + 768 + qh * 64;
#pragma unroll
    for (int d = 0; d < 64; ++d) yrow[d] = f2bf(o[d] * inv);
}

DEV void nb_combineA(int vb, int t, unsigned char* sm, const bf16_t* __restrict__ P, const float* __restrict__ lse2, bf16_t* __restrict__ Y) {
    const size_t idx = (size_t)vb * 256 + t; const int cc = (int)(idx & 255); const size_t tok = idx >> 8; const int hh = cc >> 6, d = cc & 63;
    const float l0 = lse2[tok * 12 + hh], l1 = lse2[tok * 12 + 4 + hh], l2 = lse2[tok * 12 + 8 + hh]; const float mx = fmaxf(l0, fmaxf(l1, l2));
    const float w0 = exp2f(l0 - mx), w1 = exp2f(l1 - mx), w2 = exp2f(l2 - mx);
    const bf16_t* pr = P + tok * PW_ + hh * 64 + d;
    Y[tok * UYW_ + cc] = f2bf((w0 * bf2f(pr[0]) + w1 * bf2f(pr[256]) + w2 * bf2f(pr[512])) / (w0 + w1 + w2));
}

DEV void nb_hyena(int vb, int t, unsigned char* sm, int pass, bf16_t* __restrict__ hyT, bf16_t* __restrict__ z1T, const bf16_t* __restrict__ Gr_l, const float* __restrict__ conv_w,
                                                const float* __restrict__ conv_b, const float* __restrict__ hy_bias) {
    const size_t idx = (size_t)vb * 256 + t; const int i = (int)(idx & 2047); const int b = (int)((idx >> 11) & 15); const int c = (int)(idx >> 15);
    const bf16_t* G = Gr_l + ((size_t)pass * 512 + c) * 4096 + (2047 - i);
    float acc = 0.f, zi = 0.f;
    if (pass == 0) {
        const bf16_t* in = hyT + (size_t)c * T_ + b * 2048; const float w0 = conv_w[c], w1 = conv_w[1536 + c], w2 = conv_w[3072 + c], cb = conv_b[c];
        float prev = 0.f, cur = bf2f(in[0]);
        for (int j = 0; j < 2048; ++j) { const float nxt = (j < 2047) ? bf2f(in[j + 1]) : 0.f; const float z = cb + w0 * prev + w1 * cur + w2 * nxt;
            acc += bf2f(G[j]) * z; if (j == i) zi = z; prev = cur; cur = nxt; }
    } else {
        const bf16_t* in = z1T + (size_t)c * T_ + b * 2048;
        for (int j = 0; j < 2048; ++j) { const float z = bf2f(in[j]); acc += bf2f(G[j]) * z; if (j == i) zi = z; }
    }
    const int xc = (pass == 0 ? 512 : 1024) + c;
    const bf16_t* xin = hyT + (size_t)xc * T_ + b * 2048;
    const float xm = (i > 0) ? bf2f(xin[i - 1]) : 0.f, x0 = bf2f(xin[i]), xp = (i < 2047) ? bf2f(xin[i + 1]) : 0.f;
    const float xv = conv_b[xc] + conv_w[xc] * xm + conv_w[1536 + xc] * x0 + conv_w[3072 + xc] * xp;
    const float outv = xv * (acc + hy_bias[pass * 512 + c] * zi);
    if (pass == 0) z1T[(size_t)c * T_ + b * 2048 + i] = f2bf(outv); else hyT[(size_t)c * T_ + b * 2048 + i] = f2bf(outv);
}

DEV void nb_transY(int vb, int t, unsigned char* sm, const bf16_t* __restrict__ hyT, bf16_t* __restrict__ Y) {
    const size_t idx = (size_t)vb * 256 + t; const int c = (int)(idx & 511); const size_t tok = idx >> 9;
    Y[tok * UYW_ + 256 + c] = hyT[(size_t)c * T_ + tok];
}

DEV void nb_ln_mod(int vb, int t, unsigned char* sm, float* __restrict__ h, const float* __restrict__ g, const float* __restrict__ bta, const float* __restrict__ ada_l, int off_sh, int off_sc,
                                                bf16_t* __restrict__ ubuf) {
    const int tok = vb; float v[4]; float s = 0.f;
#pragma unroll
    for (int k = 0; k < 4; ++k) { v[k] = h[(size_t)tok * 1024 + t + 256 * k]; s += v[k]; }
    float* red = (float*)sm; red[t] = s; __syncthreads();
    for (int st = 128; st > 0; st >>= 1) { if (t < st) red[t] += red[t + st]; __syncthreads(); }
    const float mu = red[0] * (1.f / 1024.f); __syncthreads();
    float q = 0.f;
#pragma unroll
    for (int k = 0; k < 4; ++k) { const float dd = v[k] - mu; q += dd * dd; }
    red[t] = q; __syncthreads();
    for (int st = 128; st > 0; st >>= 1) { if (t < st) red[t] += red[t + st]; __syncthreads(); }
    const float rstd = rsqrtf(red[0] * (1.f / 1024.f) + LN_EPS_);
    const float* a = ada_l + (size_t)(tok >> 11) * 6144;
#pragma unroll
    for (int k = 0; k < 4; ++k) { const int d = t + 256 * k; const float y = (v[k] - mu) * rstd * g[d] + bta[d]; h[(size_t)tok * 1024 + d] = y;
        if (ubuf) ubuf[(size_t)tok * UYW_ + d] = f2bf(y * (1.f + a[off_sc + d]) + a[off_sh + d]); }
}

DEV void nb_peer_topk(int vb, int t, unsigned char* sm, const bf16_t* __restrict__ Q2, const float* __restrict__ keys_l, int* __restrict__ eidx, float* __restrict__ egate) {
    const int grp = t >> 7; const int th = vb * 2 + grp; const int tok = th >> 3, h = th & 7; t &= 127;
    float* qs = (float*)sm + grp * 1024; float* s1 = qs + 256; float* s2 = s1 + 128; float* t1v = s2 + 128; float* t2v = t1v + 16; float* cand = t2v + 16; float* bestv = cand + 256;
    int* t1i = (int*)(bestv + 16); int* t2i = t1i + 16; int* besti = t2i + 16;
    qs[t] = bf2f(Q2[(size_t)tok * 2048 + h * 256 + t]); qs[t + 128] = bf2f(Q2[(size_t)tok * 2048 + h * 256 + 128 + t]);
    __syncthreads();
    { const float* k1 = keys_l + ((size_t)(h * 2 + 0) * 128 + t) * 128; const float* k2 = keys_l + ((size_t)(h * 2 + 1) * 128 + t) * 128; float a = 0.f, bsum = 0.f;
        for (int c = 0; c < 128; ++c) { a += qs[c] * k1[c]; bsum += qs[128 + c] * k2[c]; }
        s1[t] = a; s2[t] = bsum; }
    __syncthreads();
    { const float a = s1[t], bb = s2[t]; int r1 = 0, r2 = 0;
        for (int m = 0; m < 128; ++m) { const float x = s1[m], y = s2[m]; r1 += (x > a || (x == a && m < t)) ? 1 : 0; r2 += (y > bb || (y == bb && m < t)) ? 1 : 0; }
        if (r1 < 16) { t1v[r1] = a; t1i[r1] = t; } if (r2 < 16) { t2v[r2] = bb; t2i[r2] = t; } }
    __syncthreads();
    cand[t] = t1v[t >> 4] + t2v[t & 15]; cand[t + 128] = t1v[(t + 128) >> 4] + t2v[t & 15];
    __syncthreads();
#pragma unroll
    for (int rr = 0; rr < 2; ++rr) { const int ci = t + 128 * rr; const float a = cand[ci]; int r = 0;
        for (int m = 0; m < 256; ++m) { const float x = cand[m]; r += (x > a || (x == a && m < ci)) ? 1 : 0; }
        if (r < 16) { bestv[r] = a; besti[r] = ci; } }
    __syncthreads();
    if (t < 16) { const float mx = bestv[0]; float sum = 0.f;
        for (int k = 0; k < 16; ++k) sum += expf(bestv[k] - mx);
        const int ci = besti[t]; const size_t o = ((size_t)tok * 8 + h) * 16 + t;
        eidx[o] = ((t1i[(ci >> 4) & 15] & 127) * 128 + (t2i[ci & 15] & 127)); egate[o] = expf(bestv[t] - mx) / sum; }
}

DEV void nb_peer(int vb, int t, unsigned char* sm, float* __restrict__ xio, const float* __restrict__ ada_l, const int* __restrict__ eidx, const float* __restrict__ egate,
                                              const float* __restrict__ pu, const float* __restrict__ pv, const float* __restrict__ g, const float* __restrict__ bta,
                                              const float* __restrict__ ada_next, bf16_t* __restrict__ ubuf) {
    const int tok = vb, lane = t & 63, w = t >> 6;
    float* xs = (float*)sm; float* wv = xs + 1024; float* red = wv + 128; int* es = (int*)(red + 256);
    const float* a = ada_l + (size_t)(tok >> 11) * 6144; float x1[4];
#pragma unroll
    for (int k = 0; k < 4; ++k) { const int d = t + 256 * k; x1[k] = xio[(size_t)tok * 1024 + d]; xs[d] = x1[k] * (1.f + a[4096 + d]) + a[3072 + d]; }
    if (t < 128) es[t] = eidx[(size_t)tok * 128 + t];
    __syncthreads();
    for (int i = w; i < 128; i += 4) { const float* ur = pu + (size_t)es[i] * 1024; float dsum = 0.f;
#pragma unroll
        for (int k = 0; k < 16; ++k) dsum += ur[lane + 64 * k] * xs[lane + 64 * k];
#pragma unroll
        for (int off = 32; off > 0; off >>= 1) dsum += __shfl_xor(dsum, off);
        if (lane == 0) wv[i] = egate[(size_t)tok * 128 + i] * 0.5f * dsum * (1.f + erff(dsum * 0.70710678118654752f)); }
    __syncthreads();
    float acc[4] = {0.f, 0.f, 0.f, 0.f};
    for (int i = 0; i < 128; ++i) { const float* vr = pv + (size_t)es[i] * 1024; const float wi = wv[i];
#pragma unroll
        for (int k = 0; k < 4; ++k) acc[k] += wi * vr[t + 256 * k]; }
    float v[4]; float s = 0.f;
#pragma unroll
    for (int k = 0; k < 4; ++k) { v[k] = ALPHA_ * x1[k] + a[5120 + t + 256 * k] * acc[k]; s += v[k]; }
    red[t] = s; __syncthreads();
    for (int st = 128; st > 0; st >>= 1) { if (t < st) red[t] += red[t + st]; __syncthreads(); }
    const float mu = red[0] * (1.f / 1024.f); __syncthreads();
    float q = 0.f;
#pragma unroll
    for (int k = 0; k < 4; ++k) { const float dd = v[k] - mu; q += dd * dd; }
    red[t] = q; __syncthreads();
    for (int st = 128; st > 0; st >>= 1) { if (t < st) red[t] += red[t + st]; __syncthreads(); }
    const float rstd = rsqrtf(red[0] * (1.f / 1024.f) + LN_EPS_);
    const float* an = ada_next ? ada_next + (size_t)(tok >> 11) * 6144 : nullptr;
#pragma unroll
    for (int k = 0; k < 4; ++k) { const int d = t + 256 * k; const float y = (v[k] - mu) * rstd * g[d] + bta[d]; xio[(size_t)tok * 1024 + d] = y;
        if (an) ubuf[(size_t)tok * UYW_ + d] = f2bf(y * (1.f + an[1024 + d]) + an[d]); }
}

#define LAS __attribute__((address_space(3)))
typedef short bf16x8 __attribute__((ext_vector_type(8)));
typedef float f32x4 __attribute__((ext_vector_type(4)));
typedef float f32x2 __attribute__((ext_vector_type(2)));
typedef unsigned u32x4 __attribute__((ext_vector_type(4)));
typedef unsigned u32x2 __attribute__((ext_vector_type(2)));
namespace pg8 {
constexpr int BM = 256, BK = 64, HALF = 128, HTB = HALF * BK * 2, STAGE_BYTES = 8 * HTB, NXCD = 8, WGM = 8;
DEV int lds_byte(int r, int c) { const int st = (r >> 4) * 2 + (c >> 5), rr = r & 15, cc = c & 31, ob = rr * 64 + cc * 2; return st * 1024 + (ob ^ (((ob >> 9) & 1) << 5)); }
DEV void stage_rc(int b, int& R, int& C) { const int st = b / 1024, sb = b % 1024, swz = sb ^ (((sb >> 9) & 1) << 5); R = (st >> 1) * 16 + swz / 64; C = (st & 1) * 32 + (swz % 64) / 2; }
DEV int perm32(int rho) { const int n = rho >> 4, i = rho & 15; return 8 * (i >> 2) + 4 * n + (i & 3); }
DEV unsigned cvt_pk_bf16(float lo, float hi) { unsigned r; asm volatile("v_cvt_pk_bf16_f32 %0, %1, %2" : "=v"(r) : "v"(lo), "v"(hi)); return r; }

struct Unit { int pm, pn, tag, nt; const char* a; const char* b; };
DEV void tile_of(int L, int nM, int nN, int& pm, int& pn) {
    const int nwg = nM * nN; int wgid = L; { const int q = nwg / NXCD, r = nwg % NXCD, xcd = wgid % NXCD, off = wgid / NXCD; wgid = (xcd < r ? xcd * (q + 1) : r * (q + 1) + (xcd - r) * q) + off; }
    const int nig = WGM * nN, gid = wgid / nig, fm = gid * WGM, gsz = (nM - fm) < WGM ? (nM - fm) : WGM;
    pm = fm + ((wgid % nig) % gsz); pn = (wgid % nig) / gsz;
}
struct PlainSched { const bf16_t* A; const bf16_t* Bt; int lda, ldb, nM, nN, nt, G, c;
    DEV bool next(int i, Unit& u) const { const long L = (long)i * G + c; if (L >= (long)nM * nN) return false; tile_of((int)L, nM, nN, u.pm, u.pn); u.tag = 0; u.nt = nt;
        u.a = (const char*)(A + (size_t)u.pm * BM * lda); u.b = (const char*)(Bt + (size_t)u.pn * BM * ldb); return true; } };

template <class Epi, class Sched>
DEV void gemm_phase(LAS unsigned char* lds, const int lda, const int ldb, const Sched& S, const Epi& E) {
    int tid_ = threadIdx.x; asm volatile("" : "+v"(tid_));
    const int tid = tid_, wid = __builtin_amdgcn_readfirstlane(tid >> 6), lane = tid & 63, wr = wid >> 2, wc = wid & 3, fr = lane & 15, fq = lane >> 4;
    unsigned voffA[2], voffB[2];
#pragma unroll
    for (int i = 0; i < 2; ++i) { int R, C; stage_rc(tid * 16 + i * 8192, R, C); const int Rb = Epi::PERM ? ((R & ~31) + perm32(R & 31)) : R;
        voffA[i] = (unsigned)(R * lda + C) * 2u; voffB[i] = (unsigned)(Rb * ldb + C) * 2u; }
    const size_t kstep = (size_t)(BK * 2);
    const size_t hstepA = (size_t)HALF * lda * 2, hstepB = (size_t)HALF * ldb * 2;
    const unsigned ldsw = (unsigned)wid * 1024u;
    const int aoff = lds_byte(wr * 64 + fr, fq * 8), boff = lds_byte(wc * 32 + fr, fq * 8);
#define PG8_SA(b, h) (((b) * 2 + (h)) * HTB)
#define PG8_SB(b, h) ((4 + (b) * 2 + (h)) * HTB)
#define PG8_STAGE(bufoff, gbase, voff) do { _Pragma("unroll") for (int _i = 0; _i < 2; ++_i) \
        __builtin_amdgcn_global_load_lds((const unsigned*)((const char*)(gbase) + (voff)[_i]), (LAS unsigned*)(lds + (bufoff) + ldsw + _i * 8192), 16, 0, 0); } while (0)
#define PG8_LDA(dst, b, h) do { _Pragma("unroll") for (int m = 0; m < 4; ++m) _Pragma("unroll") for (int k = 0; k < 2; ++k) dst[m][k] = *(const LAS bf16x8*)(lds + PG8_SA(b, h) + aoff + m * 2048 + k * 1024); } while (0)
#define PG8_LDB(dst, b, h) do { _Pragma("unroll") for (int n = 0; n < 2; ++n) _Pragma("unroll") for (int k = 0; k < 2; ++k) dst[n][k] = *(const LAS bf16x8*)(lds + PG8_SB(b, h) + boff + n * 2048 + k * 1024); } while (0)
#define PG8_MMA(ai, bj, At, Bt) do { __builtin_amdgcn_s_setprio(1); _Pragma("unroll") for (int m = 0; m < 4; ++m) _Pragma("unroll") for (int n = 0; n < 2; ++n) _Pragma("unroll") for (int k = 0; k < 2; ++k) \
        acc[ai][bj][m][n] = __builtin_amdgcn_mfma_f32_16x16x32_bf16(Bt[n][k], At[m][k], acc[ai][bj][m][n], 0, 0, 0); __builtin_amdgcn_s_setprio(0); } while (0)
#define PG8_WAIT_V(n) asm volatile("s_waitcnt vmcnt(" #n ")" ::: "memory")
#define PG8_WAIT_L(n) asm volatile("s_waitcnt lgkmcnt(" #n ")" ::: "memory")
#define PG8_BAR __builtin_amdgcn_s_barrier()
#define PG8_SCHED __builtin_amdgcn_sched_barrier(0)
    Unit cur, nxt; int ui = 0;
    if (!S.next(0, cur)) return;
    f32x4 acc[2][2][4][2];
#pragma unroll
    for (int a = 0; a < 2; ++a)
#pragma unroll
        for (int b = 0; b < 2; ++b)
#pragma unroll
            for (int m = 0; m < 4; ++m)
#pragma unroll
                for (int n = 0; n < 2; ++n) acc[a][b][m][n] = (f32x4){0.f, 0.f, 0.f, 0.f};
    bf16x8 At[4][2], B0[2][2], B1[2][2];
    const char* cA = cur.a; const char* cB = cur.b;
    PG8_STAGE(PG8_SB(0, 0), cB, voffB); PG8_STAGE(PG8_SA(0, 0), cA, voffA); PG8_STAGE(PG8_SB(0, 1), cB + hstepB, voffB); PG8_STAGE(PG8_SA(0, 1), cA + hstepA, voffA);
    if (wr == 1) PG8_BAR;
    PG8_WAIT_V(4); PG8_BAR;
    PG8_STAGE(PG8_SB(1, 0), cB + kstep, voffB); PG8_STAGE(PG8_SA(1, 0), cA + kstep, voffA); PG8_STAGE(PG8_SB(1, 1), cB + hstepB + kstep, voffB);
    PG8_WAIT_V(6); PG8_BAR;
    for (;;) {
        const bool has_next = S.next(ui + 1, nxt);
        const char* nA = has_next ? nxt.a : cA; const char* nB = has_next ? nxt.b : cB;
        const int nt = cur.nt;
        for (int t = 0; t < nt; t += 2) {
            const bool last = (t == nt - 2);
            const char* a1 = cA + (size_t)(t + 1) * kstep;
            const char* a2 = last ? nA : cA + (size_t)(t + 2) * kstep; const char* b2 = last ? nB : cB + (size_t)(t + 2) * kstep;
            const char* a3 = a2 + kstep; const char* b3 = b2 + kstep;
            PG8_LDB(B0, 0, 0); PG8_SCHED; PG8_LDA(At, 0, 0); PG8_STAGE(PG8_SA(1, 1), a1 + hstepA, voffA);
            PG8_WAIT_L(8); PG8_BAR; PG8_WAIT_L(0); PG8_MMA(0, 0, At, B0); PG8_BAR; PG8_SCHED;
            PG8_LDB(B1, 0, 1); PG8_STAGE(PG8_SB(0, 0), b2, voffB);
            PG8_BAR; PG8_WAIT_L(0); PG8_MMA(0, 1, At, B1); PG8_BAR;
            PG8_LDA(At, 0, 1); PG8_STAGE(PG8_SA(0, 0), a2, voffA);
            PG8_BAR; PG8_WAIT_L(0); PG8_MMA(1, 0, At, B0); PG8_BAR; PG8_SCHED;
            PG8_STAGE(PG8_SB(0, 1), b2 + hstepB, voffB);
            PG8_WAIT_V(6); PG8_BAR; PG8_MMA(1, 1, At, B1); PG8_BAR;
            PG8_LDB(B0, 1, 0); PG8_SCHED; PG8_LDA(At, 1, 0); PG8_STAGE(PG8_SA(0, 1), a2 + hstepA, voffA);
            PG8_WAIT_L(8); PG8_BAR; PG8_WAIT_L(0); PG8_MMA(0, 0, At, B0); PG8_BAR; PG8_SCHED;
            PG8_LDB(B1, 1, 1); PG8_STAGE(PG8_SB(1, 0), b3, voffB);
            PG8_BAR; PG8_WAIT_L(0); PG8_MMA(0, 1, At, B1); PG8_BAR;
            PG8_LDA(At, 1, 1); PG8_STAGE(PG8_SA(1, 0), a3, voffA);
            PG8_BAR; PG8_WAIT_L(0); PG8_MMA(1, 0, At, B0); PG8_BAR; PG8_SCHED;
            PG8_STAGE(PG8_SB(1, 1), b3 + hstepB, voffB);
            PG8_WAIT_V(6); PG8_BAR; PG8_MMA(1, 1, At, B1); PG8_BAR;
        }
        E(acc, cur, wr, wc, fr, fq);
        if (!has_next) break;
#pragma unroll
        for (int a = 0; a < 2; ++a)
#pragma unroll
            for (int b = 0; b < 2; ++b)
#pragma unroll
                for (int m = 0; m < 4; ++m)
#pragma unroll
                    for (int n = 0; n < 2; ++n) acc[a][b][m][n] = (f32x4){0.f, 0.f, 0.f, 0.f};
        cur = nxt; cA = nA; cB = nB; ++ui;
    }
    PG8_WAIT_V(0);
    if (wr == 0) PG8_BAR;
    PG8_BAR;
#undef PG8_SA
#undef PG8_SB
#undef PG8_STAGE
#undef PG8_LDA
#undef PG8_LDB
#undef PG8_MMA
#undef PG8_WAIT_V
#undef PG8_WAIT_L
#undef PG8_BAR
#undef PG8_SCHED
}
struct EpiBf { static constexpr bool PERM = true; bf16_t* O; int ldc; int pad;
    DEV void operator()(const f32x4 (&acc)[2][2][4][2], const Unit& u, int wr, int wc, int fr, int fq) const {
        const int row0 = u.pm * BM + wr * 64 + fr, col0 = u.pn * BM + wc * 32 + 8 * fq;
#pragma unroll
        for (int ai = 0; ai < 2; ++ai)
#pragma unroll
            for (int m = 0; m < 4; ++m) { bf16_t* rowp = O + (size_t)(row0 + ai * HALF + m * 16) * ldc + col0;
#pragma unroll
                for (int bj = 0; bj < 2; ++bj) { const f32x4 v0 = acc[ai][bj][m][0], v1 = acc[ai][bj][m][1];
                    u32x4 w; w.x = cvt_pk_bf16(v0[0], v0[1]); w.y = cvt_pk_bf16(v0[2], v0[3]); w.z = cvt_pk_bf16(v1[0], v1[1]); w.w = cvt_pk_bf16(v1[2], v1[3]);
                    *(u32x4*)(rowp + bj * HALF) = w; } }
    } };
struct EpiP { static constexpr bool PERM = true; bf16_t* P; const float2* rope;
    DEV void operator()(const f32x4 (&acc)[2][2][4][2], const Unit& u, int wr, int wc, int fr, int fq) const {
        const int row0 = u.pm * BM + wr * 64 + fr, col0 = u.pn * BM + wc * 32 + 8 * fq; const int g = (wc & 1) * 4 + fq; const int pn = u.pn;
        const bool qs = (pn < 3) || (pn == 9) || (pn == 10);
#pragma unroll
        for (int ai = 0; ai < 2; ++ai)
#pragma unroll
            for (int m = 0; m < 4; ++m) { const int row = row0 + ai * HALF + m * 16; bf16_t* rowp = P + (size_t)row * PW_ + col0;
                const float4* rp = (const float4*)(rope + (size_t)(row & 2047) * 32 + 4 * g); const float4 cs0 = rp[0], cs1 = rp[1];
                const float cc[4] = {cs0.x, cs0.z, cs1.x, cs1.z}, ss[4] = {cs0.y, cs0.w, cs1.y, cs1.w};
#pragma unroll
                for (int bj = 0; bj < 2; ++bj) { f32x4 v0 = acc[ai][bj][m][0], v1 = acc[ai][bj][m][1];
                    const bool rp_ = (pn < 6) || (pn == 9) || (pn == 10) || (pn == 11 && bj == 0);
                    if (rp_) {
#pragma unroll
                        for (int j = 0; j < 4; ++j) { const float x1 = v0[j], x2 = v1[j]; float o1 = x1 * cc[j] - x2 * ss[j], o2 = x2 * cc[j] + x1 * ss[j];
                            if (qs) { o1 *= QSCALE_; o2 *= QSCALE_; } v0[j] = o1; v1[j] = o2; } }
                    u32x4 w; w.x = cvt_pk_bf16(v0[0], v0[1]); w.y = cvt_pk_bf16(v0[2], v0[3]); w.z = cvt_pk_bf16(v1[0], v1[1]); w.w = cvt_pk_bf16(v1[2], v1[3]);
                    *(u32x4*)(rowp + bj * HALF) = w; } }
    } };
struct EpiMergeAll { static constexpr bool PERM = true; bf16_t* gtmp; bf16_t* merged;
    DEV void operator()(const f32x4 (&acc)[2][2][4][2], const Unit& u, int wr, int wc, int fr, int fq) const {
        const int row0 = u.pm * BM + wr * 64 + fr, col0 = u.pn * BM + wc * 32 + 8 * fq; const int tag = u.tag;
#pragma unroll
        for (int ai = 0; ai < 2; ++ai)
#pragma unroll
            for (int m = 0; m < 4; ++m) { const size_t ro = (size_t)(row0 + ai * HALF + m * 16) * 1024 + col0;
#pragma unroll
                for (int bj = 0; bj < 2; ++bj) { f32x4 v0 = acc[ai][bj][m][0], v1 = acc[ai][bj][m][1]; const size_t o = ro + bj * HALF;
                    if ((tag & 1) == 0) {
#pragma unroll
                        for (int j = 0; j < 4; ++j) { v0[j] = 1.f / (1.f + __expf(-v0[j])); v1[j] = 1.f / (1.f + __expf(-v1[j])); }
                        u32x4 w; w.x = cvt_pk_bf16(v0[0], v0[1]); w.y = cvt_pk_bf16(v0[2], v0[3]); w.z = cvt_pk_bf16(v1[0], v1[1]); w.w = cvt_pk_bf16(v1[2], v1[3]);
                        *(u32x4*)(gtmp + o) = w;
                    } else {
                        const u32x4 gq = *(const u32x4*)(gtmp + o);
                        float gg[8] = {__uint_as_float(gq.x << 16), __uint_as_float(gq.x & 0xffff0000u), __uint_as_float(gq.y << 16), __uint_as_float(gq.y & 0xffff0000u),
                                       __uint_as_float(gq.z << 16), __uint_as_float(gq.z & 0xffff0000u), __uint_as_float(gq.w << 16), __uint_as_float(gq.w & 0xffff0000u)};
#pragma unroll
                        for (int j = 0; j < 4; ++j) { v0[j] *= gg[j]; v1[j] *= gg[4 + j]; }
                        if (tag != 1) { const u32x4 mq = *(const u32x4*)(merged + o);
                            float mm[8] = {__uint_as_float(mq.x << 16), __uint_as_float(mq.x & 0xffff0000u), __uint_as_float(mq.y << 16), __uint_as_float(mq.y & 0xffff0000u),
                                           __uint_as_float(mq.z << 16), __uint_as_float(mq.z & 0xffff0000u), __uint_as_float(mq.w << 16), __uint_as_float(mq.w & 0xffff0000u)};
#pragma unroll
                            for (int j = 0; j < 4; ++j) { v0[j] += mm[j]; v1[j] += mm[4 + j]; } }
                        u32x4 w; w.x = cvt_pk_bf16(v0[0], v0[1]); w.y = cvt_pk_bf16(v0[2], v0[3]); w.z = cvt_pk_bf16(v1[0], v1[1]); w.w = cvt_pk_bf16(v1[2], v1[3]);
                        *(u32x4*)(merged + o) = w;
                    } } }
    } };
struct EpiOut { static constexpr bool PERM = false; const float* xin; float* h; const float* ada_g;
    DEV void operator()(const f32x4 (&acc)[2][2][4][2], const Unit& u, int wr, int wc, int fr, int fq) const {
        const int row0 = u.pm * BM + wr * 64 + fr, col0 = u.pn * BM + wc * 32 + 4 * fq; const float* gv = ada_g + (size_t)(u.pm >> 3) * 6144 + col0;
        f32x4 g[2][2];
#pragma unroll
        for (int bj = 0; bj < 2; ++bj)
#pragma unroll
            for (int n = 0; n < 2; ++n) g[bj][n] = *(const f32x4*)(gv + bj * HALF + n * 16);
#pragma unroll
        for (int ai = 0; ai < 2; ++ai)
#pragma unroll
            for (int m = 0; m < 4; ++m) { const size_t ro = (size_t)(row0 + ai * HALF + m * 16) * 1024 + col0;
#pragma unroll
                for (int bj = 0; bj < 2; ++bj)
#pragma unroll
                    for (int n = 0; n < 2; ++n) { const size_t o = ro + bj * HALF + n * 16; const f32x4 xv = *(const f32x4*)(xin + o); *(f32x4*)(h + o) = ALPHA_ * xv + g[bj][n] * acc[ai][bj][m][n]; } }
    } };
struct MergeSched { const bf16_t* UY; const bf16_t* WmT; int G, c;
    DEV bool next(int i, Unit& u) const { const int ti = i / 6, ps = i - ti * 6; const long L = (long)ti * G + c; if (L >= 128 * 4) return false; tile_of((int)L, 128, 4, u.pm, u.pn); u.tag = ps;
        const int br = ps >> 1; const bf16_t* ar = UY + (size_t)u.pm * BM * UYW_; const bf16_t* brow = WmT + (size_t)u.pn * BM * WMW_;
        if ((ps & 1) == 0) { u.nt = 16; u.a = (const char*)ar; u.b = (const char*)(brow + br * 1024); }
        else { const int koff = br == 0 ? 0 : (br == 1 ? 256 : 768); u.nt = br == 0 ? 4 : 8; u.a = (const char*)(ar + 1024 + koff); u.b = (const char*)(brow + 3072 + koff); }
        return true; } };
}

DEV int win_orig_col(int n) {
    if (n >= 3072) return n < 4608 ? (n - 3072 + 2304) : n;
    const int head = n >> 6, p = n & 63; const bool rp = (head < 24) || (head >= 36 && head < 46);
    const int d = rp ? ((p & 4) ? 32 + 4 * (p >> 3) + (p & 3) : 4 * (p >> 3) + (p & 3)) : p;
    return ((n < 2304) ? head * 64 : 3840 + (head - 36) * 64) + d;
}
struct WPrep { const float *w_in, *wba, *wbb, *wbc, *w_out, *peer_wq; bf16_t *WinT, *WmT, *WoutT, *WqT; };
DEV void nb_wprep(int vb, int t, unsigned char* sm, const WPrep& q) {
    const int l = vb / 3008; int r = vb - l * 3008; const float* W; int ldw; bf16_t* Wt; int ldt, koff = 0, ntk = 16, mode = 0, nsub = 0;
    if (r < 1920) { W = q.w_in + (size_t)l * 1024 * 7680; ldw = 7680; mode = 1;
        if (r < 72 * 16) { Wt = q.WinT + (size_t)l * 7680 * 1024; ldt = 1024; }
        else { const int br = (r / 16 - 72) / 16; Wt = q.WmT + (size_t)l * 1024 * WMW_; ldt = WMW_; koff = br * 1024; nsub = 4608 + br * 1024; } }
    else if (r < 1984) { r -= 1920; W = q.wba + (size_t)l * 256 * 1024; ldw = 1024; Wt = q.WmT + (size_t)l * 1024 * WMW_; ldt = WMW_; koff = 3072; ntk = 4; }
    else if (r < 2112) { r -= 1984; W = q.wbb + (size_t)l * 512 * 1024; ldw = 1024; Wt = q.WmT + (size_t)l * 1024 * WMW_; ldt = WMW_; koff = 3072 + 256; ntk = 8; }
    else if (r < 2240) { r -= 2112; W = q.wbc + (size_t)l * 512 * 1024; ldw = 1024; Wt = q.WmT + (size_t)l * 1024 * WMW_; ldt = WMW_; koff = 3072 + 768; ntk = 8; }
    else if (r < 2496) { r -= 2240; W = q.w_out + (size_t)l * 1024 * 1024; ldw = 1024; Wt = q.WoutT + (size_t)l * 1024 * 1024; ldt = 1024; }
    else { r -= 2496; W = q.peer_wq + (size_t)l * 1024 * 2048; ldw = 2048; Wt = q.WqT + (size_t)l * 2048 * 1024; ldt = 1024; }
    const int n0 = (r / ntk) * 64, k0 = (r % ntk) * 64; const int c0 = mode ? (win_orig_col(n0) & ~63) : n0;
    bf16_t* tile = (bf16_t*)sm;
    { const int kk = t >> 2, cs = (t & 3) * 16; const float* src = W + (size_t)(k0 + kk) * ldw + c0 + cs;
#pragma unroll
        for (int i = 0; i < 16; i += 4) { const float4 v = *(const float4*)(src + i); tile[kk * 66 + cs + i] = f2bf(v.x); tile[kk * 66 + cs + i + 1] = f2bf(v.y); tile[kk * 66 + cs + i + 2] = f2bf(v.z); tile[kk * 66 + cs + i + 3] = f2bf(v.w); } }
    __syncthreads();
    { const int nn = t >> 2, ks = (t & 3) * 16; const int dl = mode ? (win_orig_col(n0 + nn) - c0) : nn; bf16_t* dst = Wt + (size_t)(n0 + nn - nsub) * ldt + koff + k0 + ks;
        unsigned w[8];
#pragma unroll
        for (int i = 0; i < 8; ++i) w[i] = (unsigned)tile[(ks + 2 * i) * 66 + dl] | ((unsigned)tile[(ks + 2 * i + 1) * 66 + dl] << 16);
        *(u32x4*)dst = (u32x4){w[0], w[1], w[2], w[3]}; *(u32x4*)(dst + 8) = (u32x4){w[4], w[5], w[6], w[7]}; }
}

namespace hy {
constexpr int ZS = 2064;
constexpr int G0_OFF = 0, G1_OFF = 8192, Z0_OFF = 16384, Z1_OFF = Z0_OFF + 16 * ZS * 2, LDS_END = Z1_OFF + 16 * ZS * 2;
DEV bf16x8 load_frag(LAS const unsigned char* lane_base, int d) {
    const LAS unsigned* p = (const LAS unsigned*)(lane_base + 32 * d); u32x4 w; w.x = p[0]; w.y = p[1]; w.z = p[2]; w.w = p[3];
    return __builtin_bit_cast(bf16x8, w);
}
DEV void load_filter(LAS unsigned char* lds, const bf16_t* g, int tid) {
    const u32x4 c = *(const u32x4*)(g + tid * 8); const unsigned nx = (tid < 511) ? (unsigned)g[tid * 8 + 8] : 0u;
    *(LAS u32x4*)(lds + G0_OFF + tid * 16) = c;
    u32x4 s; s.x = (c.x >> 16) | (c.y << 16); s.y = (c.y >> 16) | (c.z << 16); s.z = (c.z >> 16) | (c.w << 16); s.w = (c.w >> 16) | (nx << 16);
    *(LAS u32x4*)(lds + G1_OFF + tid * 16) = s;
}
DEV float bflo(unsigned w) { return __uint_as_float(w << 16); }
DEV float bfhi(unsigned w) { return __uint_as_float(w & 0xffff0000u); }
DEV void conv_rows(LAS const unsigned char* lds, int zoff, int w, int lane, f32x4 (&D)[16]) {
    const int r = lane & 15, q = lane >> 4;
    LAS const unsigned char* abase = lds + ((r & 1) ? (G0_OFF + 2 * (8 * q - r + 2047)) : (G1_OFF + 2 * (8 * q - r + 2046)));
    LAS const unsigned char* bbase = lds + zoff + (r * ZS + 8 * q) * 2;
    bf16x8 ring[16];
#pragma unroll
    for (int rb = 0; rb < 16; ++rb) D[rb] = (f32x4){0.f, 0.f, 0.f, 0.f};
#pragma unroll
    for (int rb = 2; rb < 16; ++rb) ring[rb] = load_frag(abase, -16 * w - rb);
#pragma unroll 1
    for (int jb0 = 0; jb0 < 64; jb0 += 8) {
#pragma unroll
        for (int u = 0; u < 8; ++u) { const int jb = jb0 + u;
            ring[(16 - 2 * u) & 15] = load_frag(abase, 2 * jb - 16 * w);
            ring[(17 - 2 * u) & 15] = load_frag(abase, 2 * jb - 16 * w - 1);
            const bf16x8 bf = *(const LAS bf16x8*)(bbase + 64 * jb);
#pragma unroll
            for (int rb = 0; rb < 16; ++rb) D[rb] = __builtin_amdgcn_mfma_f32_16x16x32_bf16(ring[(rb - 2 * u) & 15], bf, D[rb], 0, 0, 0);
        }
    }
}
DEV void sconv4(const bf16_t* in, int i, float w0, float w1, float w2, float cb, float (&o)[4]) {
    const u32x2 v = *(const u32x2*)(in + i); const float pm = (i > 0) ? bf2f(in[i - 1]) : 0.f, pn = (i + 4 < 2048) ? bf2f(in[i + 4]) : 0.f;
    const float x0 = bflo(v.x), x1 = bfhi(v.x), x2 = bflo(v.y), x3 = bfhi(v.y);
    o[0] = cb + w0 * pm + w1 * x0 + w2 * x1; o[1] = cb + w0 * x0 + w1 * x1 + w2 * x2; o[2] = cb + w0 * x1 + w1 * x2 + w2 * x3; o[3] = cb + w0 * x2 + w1 * x3 + w2 * pn;
}
DEV void hyena_phase(LAS unsigned char* lds, bf16_t* hyT, const bf16_t* Gr_l, const float* conv_w, const float* conv_b, const float* hy_bias, int G, int cblk) {
    int tid_ = threadIdx.x; asm volatile("" : "+v"(tid_));
    const int tid = tid_, w = __builtin_amdgcn_readfirstlane(tid >> 6), lane = tid & 63, q = lane >> 4, b = lane & 15;
#pragma unroll 1
    for (int c = cblk; c < 512; c += G) {
        __syncthreads();
        load_filter(lds, Gr_l + (size_t)c * 4096, tid);
        { const float w0 = conv_w[c], w1 = conv_w[1536 + c], w2 = conv_w[3072 + c], cb = conv_b[c]; const bf16_t* row = hyT + (size_t)c * T_;
#pragma unroll 2
            for (int k = 0; k < 8; ++k) { const int pos = (k * 512 + tid) * 8; const int s = pos & 2047, bb = pos >> 11;
                const u32x4 v = *(const u32x4*)(row + pos); const float pm = (s > 0) ? bf2f(row[pos - 1]) : 0.f, pn = (s + 8 < 2048) ? bf2f(row[pos + 8]) : 0.f;
                const float x[10] = {pm, bflo(v.x), bfhi(v.x), bflo(v.y), bfhi(v.y), bflo(v.z), bfhi(v.z), bflo(v.w), bfhi(v.w), pn};
                float z[8];
#pragma unroll
                for (int e = 0; e < 8; ++e) z[e] = cb + w0 * x[e] + w1 * x[e + 1] + w2 * x[e + 2];
                u32x4 o; o.x = pg8::cvt_pk_bf16(z[0], z[1]); o.y = pg8::cvt_pk_bf16(z[2], z[3]); o.z = pg8::cvt_pk_bf16(z[4], z[5]); o.w = pg8::cvt_pk_bf16(z[6], z[7]);
                *(LAS u32x4*)(lds + Z0_OFF + (bb * ZS + s) * 2) = o; } }
        __syncthreads();
        f32x4 D[16];
        conv_rows(lds, Z0_OFF, w, lane, D);
        { const int xc = 512 + c; const float w0 = conv_w[xc], w1 = conv_w[1536 + xc], w2 = conv_w[3072 + xc], cb = conv_b[xc], bias = hy_bias[c]; const bf16_t* xin = hyT + (size_t)xc * T_ + b * 2048;
#pragma unroll
            for (int rb = 0; rb < 16; ++rb) { const int i = 256 * w + 16 * rb + 4 * q; float xv[4]; sconv4(xin, i, w0, w1, w2, cb, xv);
                const u32x2 zq = *(const LAS u32x2*)(lds + Z0_OFF + (b * ZS + i) * 2); const float zv[4] = {bflo(zq.x), bfhi(zq.x), bflo(zq.y), bfhi(zq.y)};
                float o[4];
#pragma unroll
                for (int e = 0; e < 4; ++e) o[e] = xv[e] * (D[rb][e] + bias * zv[e]);
                u32x2 pk; pk.x = pg8::cvt_pk_bf16(o[0], o[1]); pk.y = pg8::cvt_pk_bf16(o[2], o[3]);
                *(LAS u32x2*)(lds + Z1_OFF + (b * ZS + i) * 2) = pk; } }
        __syncthreads();
        load_filter(lds, Gr_l + (size_t)(512 + c) * 4096, tid);
        __syncthreads();
        conv_rows(lds, Z1_OFF, w, lane, D);
        { const int xc = 1024 + c; const float w0 = conv_w[xc], w1 = conv_w[1536 + xc], w2 = conv_w[3072 + xc], cb = conv_b[xc], bias = hy_bias[512 + c]; const bf16_t* xin = hyT + (size_t)xc * T_ + b * 2048;
            bf16_t* yout = hyT + (size_t)c * T_ + b * 2048;
#pragma unroll
            for (int rb = 0; rb < 16; ++rb) { const int i = 256 * w + 16 * rb + 4 * q; float xv[4]; sconv4(xin, i, w0, w1, w2, cb, xv);
                const u32x2 zq = *(const LAS u32x2*)(lds + Z1_OFF + (b * ZS + i) * 2); const float zv[4] = {bflo(zq.x), bfhi(zq.x), bflo(zq.y), bfhi(zq.y)};
                float o[4];
#pragma unroll
                for (int e = 0; e < 4; ++e) o[e] = xv[e] * (D[rb][e] + bias * zv[e]);
                u32x2 pk; pk.x = pg8::cvt_pk_bf16(o[0], o[1]); pk.y = pg8::cvt_pk_bf16(o[2], o[3]);
                *(u32x2*)(yout + i) = pk; } }
    }
    __syncthreads();
}
}

namespace peer {
typedef __attribute__((ext_vector_type(4))) float float4v;
DEV void nb_cvt_tables(int vb, int t, const float* __restrict__ pu, const float* __restrict__ pv, bf16_t* __restrict__ Ub, bf16_t* __restrict__ Vb) {
    const size_t i = ((size_t)vb * 256 + t) * 8;
    { const float4 a = *(const float4*)(pu + i), b = *(const float4*)(pu + i + 4); u32x4 o; o.x = pg8::cvt_pk_bf16(a.x, a.y); o.y = pg8::cvt_pk_bf16(a.z, a.w); o.z = pg8::cvt_pk_bf16(b.x, b.y); o.w = pg8::cvt_pk_bf16(b.z, b.w); *(u32x4*)(Ub + i) = o; }
    { const float4 a = *(const float4*)(pv + i), b = *(const float4*)(pv + i + 4); u32x4 o; o.x = pg8::cvt_pk_bf16(a.x, a.y); o.y = pg8::cvt_pk_bf16(a.z, a.w); o.z = pg8::cvt_pk_bf16(b.x, b.y); o.w = pg8::cvt_pk_bf16(b.z, b.w); *(u32x4*)(Vb + i) = o; }
}
DEV float wave_sum(float v) {
#pragma unroll
    for (int off = 32; off > 0; off >>= 1) v += __shfl_xor(v, off);
    return v;
}
DEV void peer_phase(LAS unsigned char* lds, float* xio, const float* ada_l, const int* __restrict__ eidx, const float* __restrict__ egate, const bf16_t* __restrict__ Ub, const bf16_t* __restrict__ Vb,
                    const float* __restrict__ g, const float* __restrict__ bta, const float* ada_next, bf16_t* UY, int G, int cblk) {
    int tid_ = threadIdx.x; asm volatile("" : "+v"(tid_));
    const int tid = tid_, w = __builtin_amdgcn_readfirstlane(tid >> 6), lane = tid & 63, q = lane >> 4, n = lane & 15;
    LAS unsigned char* urow_l = lds + w * 2048;
    const int c0 = 8 * lane, c1 = 512 + 8 * lane;
#pragma unroll 1
    for (int tok = cblk * 8 + w; tok < T_; tok += G * 8) {
        const float* a = ada_l + (size_t)(tok >> 11) * 6144; float* xr = xio + (size_t)tok * 1024;
        float x1[16];
        { const float4 v0 = *(const float4*)(xr + c0), v1 = *(const float4*)(xr + c0 + 4), v2 = *(const float4*)(xr + c1), v3 = *(const float4*)(xr + c1 + 4);
            x1[0] = v0.x; x1[1] = v0.y; x1[2] = v0.z; x1[3] = v0.w; x1[4] = v1.x; x1[5] = v1.y; x1[6] = v1.z; x1[7] = v1.w;
            x1[8] = v2.x; x1[9] = v2.y; x1[10] = v2.z; x1[11] = v2.w; x1[12] = v3.x; x1[13] = v3.y; x1[14] = v3.z; x1[15] = v3.w; }
        { float u[16];
#pragma unroll
            for (int hh = 0; hh < 2; ++hh)
#pragma unroll
                for (int j = 0; j < 8; j += 4) { const int d = (hh ? c1 : c0) + j; const float4 sc = *(const float4*)(a + 4096 + d), sh = *(const float4*)(a + 3072 + d);
                    u[hh * 8 + j] = x1[hh * 8 + j] * (1.f + sc.x) + sh.x; u[hh * 8 + j + 1] = x1[hh * 8 + j + 1] * (1.f + sc.y) + sh.y;
                    u[hh * 8 + j + 2] = x1[hh * 8 + j + 2] * (1.f + sc.z) + sh.z; u[hh * 8 + j + 3] = x1[hh * 8 + j + 3] * (1.f + sc.w) + sh.w; }
            u32x4 p0, p1; p0.x = pg8::cvt_pk_bf16(u[0], u[1]); p0.y = pg8::cvt_pk_bf16(u[2], u[3]); p0.z = pg8::cvt_pk_bf16(u[4], u[5]); p0.w = pg8::cvt_pk_bf16(u[6], u[7]);
            p1.x = pg8::cvt_pk_bf16(u[8], u[9]); p1.y = pg8::cvt_pk_bf16(u[10], u[11]); p1.z = pg8::cvt_pk_bf16(u[12], u[13]); p1.w = pg8::cvt_pk_bf16(u[14], u[15]);
            *(LAS u32x4*)(urow_l + c0 * 2) = p0; *(LAS u32x4*)(urow_l + c1 * 2) = p1; }
        int E[8]; float Gt[8], wg[8];
#pragma unroll
        for (int gi = 0; gi < 8; ++gi) { E[gi] = eidx[(size_t)tok * 128 + gi * 16 + n]; Gt[gi] = egate[(size_t)tok * 128 + gi * 16 + n]; }
        asm volatile("s_waitcnt lgkmcnt(0)" ::: "memory");
#pragma unroll 2
        for (int gi = 0; gi < 8; ++gi) { const bf16_t* ur = Ub + (size_t)E[gi] * 1024 + 8 * q; f32x4 acc = (f32x4){0.f, 0.f, 0.f, 0.f};
#pragma unroll 16
            for (int ks = 0; ks < 32; ++ks) { const bf16x8 bf = *(const bf16x8*)(ur + 32 * ks); const bf16x8 af = *(const LAS bf16x8*)(urow_l + (32 * ks + 8 * q) * 2);
                acc = __builtin_amdgcn_mfma_f32_16x16x32_bf16(af, bf, acc, 0, 0, 0); }
            const float dsum = acc[0]; wg[gi] = Gt[gi] * 0.5f * dsum * (1.f + erff(dsum * 0.70710678118654752f)); }
        float o[16];
#pragma unroll
        for (int j = 0; j < 16; ++j) o[j] = 0.f;
#pragma unroll
        for (int gi = 0; gi < 8; ++gi) {
#pragma unroll 8
            for (int n2 = 0; n2 < 16; ++n2) { const int e = __builtin_amdgcn_readlane(E[gi], n2); const float wt = __builtin_bit_cast(float, __builtin_amdgcn_readlane(__builtin_bit_cast(int, wg[gi]), n2));
                const bf16_t* vr = Vb + (size_t)e * 1024; const u32x4 v0 = *(const u32x4*)(vr + c0), v1 = *(const u32x4*)(vr + c1);
                o[0] += wt * __uint_as_float(v0.x << 16); o[1] += wt * __uint_as_float(v0.x & 0xffff0000u); o[2] += wt * __uint_as_float(v0.y << 16); o[3] += wt * __uint_as_float(v0.y & 0xffff0000u);
                o[4] += wt * __uint_as_float(v0.z << 16); o[5] += wt * __uint_as_float(v0.z & 0xffff0000u); o[6] += wt * __uint_as_float(v0.w << 16); o[7] += wt * __uint_as_float(v0.w & 0xffff0000u);
                o[8] += wt * __uint_as_float(v1.x << 16); o[9] += wt * __uint_as_float(v1.x & 0xffff0000u); o[10] += wt * __uint_as_float(v1.y << 16); o[11] += wt * __uint_as_float(v1.y & 0xffff0000u);
                o[12] += wt * __uint_as_float(v1.z << 16); o[13] += wt * __uint_as_float(v1.z & 0xffff0000u); o[14] += wt * __uint_as_float(v1.w << 16); o[15] += wt * __uint_as_float(v1.w & 0xffff0000u); }
        }
        float hv[16]; float s = 0.f;
#pragma unroll
        for (int hh = 0; hh < 2; ++hh)
#pragma unroll
            for (int j = 0; j < 8; j += 4) { const int d = (hh ? c1 : c0) + j; const float4 g2 = *(const float4*)(a + 5120 + d); const int k = hh * 8 + j;
                hv[k] = ALPHA_ * x1[k] + g2.x * o[k]; hv[k + 1] = ALPHA_ * x1[k + 1] + g2.y * o[k + 1]; hv[k + 2] = ALPHA_ * x1[k + 2] + g2.z * o[k + 2]; hv[k + 3] = ALPHA_ * x1[k + 3] + g2.w * o[k + 3];
                s += (hv[k] + hv[k + 1]) + (hv[k + 2] + hv[k + 3]); }
        const float mu = wave_sum(s) * (1.f / 1024.f); float qq = 0.f;
#pragma unroll
        for (int j = 0; j < 16; ++j) { const float dd = hv[j] - mu; qq += dd * dd; }
        const float rstd = rsqrtf(wave_sum(qq) * (1.f / 1024.f) + LN_EPS_);
        const float* an = ada_next ? ada_next + (size_t)(tok >> 11) * 6144 : nullptr;
#pragma unroll
        for (int hh = 0; hh < 2; ++hh) { const int d0 = hh ? c1 : c0; float y[8];
#pragma unroll
            for (int j = 0; j < 8; j += 4) { const float4 gg = *(const float4*)(g + d0 + j), bb = *(const float4*)(bta + d0 + j); const int k = hh * 8 + j;
                y[j] = (hv[k] - mu) * rstd * gg.x + bb.x; y[j + 1] = (hv[k + 1] - mu) * rstd * gg.y + bb.y; y[j + 2] = (hv[k + 2] - mu) * rstd * gg.z + bb.z; y[j + 3] = (hv[k + 3] - mu) * rstd * gg.w + bb.w;
                *(float4*)(xr + d0 + j) = make_float4(y[j], y[j + 1], y[j + 2], y[j + 3]); }
            if (an) { float uu[8];
#pragma unroll
                for (int j = 0; j < 8; j += 4) { const float4 sc = *(const float4*)(an + 1024 + d0 + j), sh = *(const float4*)(an + d0 + j);
                    uu[j] = y[j] * (1.f + sc.x) + sh.x; uu[j + 1] = y[j + 1] * (1.f + sc.y) + sh.y; uu[j + 2] = y[j + 2] * (1.f + sc.z) + sh.z; uu[j + 3] = y[j + 3] * (1.f + sc.w) + sh.w; }
                u32x4 pk; pk.x = pg8::cvt_pk_bf16(uu[0], uu[1]); pk.y = pg8::cvt_pk_bf16(uu[2], uu[3]); pk.z = pg8::cvt_pk_bf16(uu[4], uu[5]); pk.w = pg8::cvt_pk_bf16(uu[6], uu[7]);
                *(u32x4*)(UY + (size_t)tok * UYW_ + d0) = pk; } }
    }
    __syncthreads();
}
}

namespace tk {
typedef float f32x16 __attribute__((ext_vector_type(16)));
constexpr int KROW = 272;
DEV unsigned sortable(float v) { const unsigned u = __float_as_uint(v); return u ^ ((unsigned)((int)u >> 31) | 0x80000000u); }
DEV float unsortable(unsigned k) { return __uint_as_float(k ^ ((~(unsigned)((int)k >> 31)) | 0x80000000u)); }
DEV unsigned umax_(unsigned a, unsigned b) { return a > b ? a : b; }
DEV unsigned umin_(unsigned a, unsigned b) { return a < b ? a : b; }
#define CE(x, y) { const unsigned hi_ = umax_(a[x], a[y]), lo_ = umin_(a[x], a[y]); a[x] = hi_; a[y] = lo_; }
DEV void sort16(unsigned (&a)[16]) {
    CE(0, 1); CE(3, 2); CE(4, 5); CE(7, 6); CE(8, 9); CE(11, 10); CE(12, 13); CE(15, 14); CE(0, 2); CE(1, 3); CE(6, 4); CE(7, 5); CE(8, 10); CE(9, 11); CE(14, 12); CE(15, 13); CE(0, 1); CE(2, 3); CE(5, 4); CE(7, 6); CE(8, 9); CE(10, 11); CE(13, 12); CE(15, 14); CE(0, 4); CE(1, 5); CE(2, 6); CE(3, 7); CE(12, 8); CE(13, 9); CE(14, 10); CE(15, 11); CE(0, 2); CE(1, 3); CE(4, 6); CE(5, 7); CE(10, 8); CE(11, 9); CE(14, 12); CE(15, 13); CE(0, 1); CE(2, 3); CE(4, 5); CE(6, 7); CE(9, 8); CE(11, 10); CE(13, 12); CE(15, 14); CE(0, 8); CE(1, 9); CE(2, 10); CE(3, 11); CE(4, 12); CE(5, 13); CE(6, 14); CE(7, 15); CE(0, 4); CE(1, 5); CE(2, 6); CE(3, 7); CE(8, 12); CE(9, 13); CE(10, 14); CE(11, 15); CE(0, 2); CE(1, 3); CE(4, 6); CE(5, 7); CE(8, 10); CE(9, 11); CE(12, 14); CE(13, 15); CE(0, 1); CE(2, 3); CE(4, 5); CE(6, 7); CE(8, 9); CE(10, 11); CE(12, 13); CE(14, 15);
}
DEV void bmerge16(unsigned (&a)[16]) {
    CE(0, 8); CE(1, 9); CE(2, 10); CE(3, 11); CE(4, 12); CE(5, 13); CE(6, 14); CE(7, 15); CE(0, 4); CE(1, 5); CE(2, 6); CE(3, 7); CE(8, 12); CE(9, 13); CE(10, 14); CE(11, 15); CE(0, 2); CE(1, 3); CE(4, 6); CE(5, 7); CE(8, 10); CE(9, 11); CE(12, 14); CE(13, 15); CE(0, 1); CE(2, 3); CE(4, 5); CE(6, 7); CE(8, 9); CE(10, 11); CE(12, 13); CE(14, 15);
}
#undef CE
DEV void top_merge(unsigned (&a)[16], const unsigned (&b)[16]) {
#pragma unroll
    for (int i = 0; i < 16; ++i) a[i] = umax_(a[i], b[15 - i]);
    bmerge16(a);
}
DEV void xlane_merge(unsigned (&a)[16]) {
    unsigned b[16];
#pragma unroll
    for (int i = 0; i < 16; ++i) b[i] = (unsigned)__shfl_xor((int)a[i], 32);
    top_merge(a, b);
}
DEV unsigned lookup_idx(unsigned long long lo, unsigned long long hi, int a) { const unsigned long long wv = (a < 8) ? lo : hi; return (unsigned)(wv >> ((a & 7) * 8)) & 127u; }
DEV unsigned blendu(unsigned m, unsigned a, unsigned b) { return (a & ~m) | (b & m); }
DEV float blendf(unsigned m, float a, float b) { return __uint_as_float((__float_as_uint(a) & ~m) | (__float_as_uint(b) & m)); }

DEV void topk_phase(LAS unsigned char* lds, const bf16_t* __restrict__ Q2, const float* __restrict__ keys_l, int* __restrict__ eidx, float* __restrict__ egate, int G, int cblk) {
    int tid_ = threadIdx.x; asm volatile("" : "+v"(tid_));
    const int tid = tid_, w = __builtin_amdgcn_readfirstlane(tid >> 6), lane = tid & 63, tl = lane & 31, hh = lane >> 5;
    asm volatile("" : "+s"(G));
    const bool by_head = (G & 7) == 0;
#pragma unroll 1
    for (int h = 0; h < 8; ++h) {
        if (by_head && h != (cblk & 7)) continue;
        __syncthreads();
        {
            const int r = tid >> 1, c0 = (tid & 1) * 64; const float* src = keys_l + ((size_t)h * 256 + r) * 128 + c0; LAS unsigned char* dst = lds + r * KROW + c0 * 2;
#pragma unroll
            for (int j = 0; j < 64; j += 8) { const float4 a = *(const float4*)(src + j), b = *(const float4*)(src + j + 4);
                u32x4 o; o.x = pg8::cvt_pk_bf16(a.x, a.y); o.y = pg8::cvt_pk_bf16(a.z, a.w); o.z = pg8::cvt_pk_bf16(b.x, b.y); o.w = pg8::cvt_pk_bf16(b.z, b.w); *(LAS u32x4*)(dst + j * 2) = o; }
        }
        __syncthreads();
        const int first = by_head ? (cblk >> 3) * 8 + w : cblk * 8 + w, stride = by_head ? (G >> 3) * 8 : G * 8;
#pragma unroll 1
        for (int blk = first; blk < T_ / 32; blk += stride) {
            const int tok = blk * 32 + tl; const bf16_t* qrow = Q2 + (size_t)tok * 2048 + h * 256 + 8 * hh;
            unsigned L[2][16];
#pragma unroll
            for (int p = 0; p < 2; ++p) {
                bf16x8 bq[8];
#pragma unroll
                for (int ks = 0; ks < 8; ++ks) bq[ks] = *(const bf16x8*)(qrow + p * 128 + 16 * ks);
#pragma unroll
                for (int t = 0; t < 4; ++t) {
                    f32x16 acc;
#pragma unroll
                    for (int e = 0; e < 16; ++e) acc[e] = 0.f;
#pragma unroll
                    for (int ks = 0; ks < 8; ++ks) { const bf16x8 ak = *(const LAS bf16x8*)(lds + (p * 128 + 32 * t + tl) * KROW + (16 * ks + 8 * hh) * 2);
                        acc = __builtin_amdgcn_mfma_f32_32x32x16_bf16(ak, bq[ks], acc, 0, 0, 0); }
                    unsigned K[16];
#pragma unroll
                    for (int e = 0; e < 16; ++e) K[e] = (sortable(acc[e]) & ~127u) | (unsigned)((127 - 32 * t - (e & 3) - 8 * (e >> 2)) - 4 * hh);
                    sort16(K);
                    if (t == 0) {
#pragma unroll
                        for (int e = 0; e < 16; ++e) L[p][e] = K[e];
                    } else top_merge(L[p], K);
                    __builtin_amdgcn_sched_barrier(0);
                }
                xlane_merge(L[p]);
                __builtin_amdgcn_sched_barrier(0);
            }
            float f1[16], f2[16];
#pragma unroll
            for (int e = 0; e < 16; ++e) { f1[e] = unsortable(L[0][e] & ~127u); f2[e] = unsortable(L[1][e] & ~127u); }
            unsigned hm = 0u - (unsigned)hh; asm volatile("" : "+v"(hm));
            unsigned C[2][16];
            C[0][0] = (sortable(blendf(hm, f1[0], f1[2]) + blendf(hm, f2[0], f2[1])) & ~255u) | (255u - blendu(hm, 0u, 33u));
            C[0][1] = (sortable(blendf(hm, f1[0], f1[2]) + blendf(hm, f2[1], f2[2])) & ~255u) | (255u - blendu(hm, 1u, 34u));
            C[0][2] = (sortable(blendf(hm, f1[0], f1[2]) + blendf(hm, f2[2], f2[3])) & ~255u) | (255u - blendu(hm, 2u, 35u));
            C[0][3] = (sortable(blendf(hm, f1[0], f1[2]) + blendf(hm, f2[3], f2[4])) & ~255u) | (255u - blendu(hm, 3u, 36u));
            C[0][4] = (sortable(blendf(hm, f1[0], f1[3]) + blendf(hm, f2[4], f2[0])) & ~255u) | (255u - blendu(hm, 4u, 48u));
            C[0][5] = (sortable(blendf(hm, f1[0], f1[3]) + blendf(hm, f2[5], f2[1])) & ~255u) | (255u - blendu(hm, 5u, 49u));
            C[0][6] = (sortable(blendf(hm, f1[0], f1[3]) + blendf(hm, f2[6], f2[2])) & ~255u) | (255u - blendu(hm, 6u, 50u));
            C[0][7] = (sortable(blendf(hm, f1[0], f1[3]) + blendf(hm, f2[7], f2[3])) & ~255u) | (255u - blendu(hm, 7u, 51u));
            C[0][8] = (sortable(blendf(hm, f1[0], f1[4]) + blendf(hm, f2[8], f2[0])) & ~255u) | (255u - blendu(hm, 8u, 64u));
            C[0][9] = (sortable(blendf(hm, f1[0], f1[4]) + blendf(hm, f2[9], f2[1])) & ~255u) | (255u - blendu(hm, 9u, 65u));
            C[0][10] = (sortable(blendf(hm, f1[0], f1[4]) + blendf(hm, f2[10], f2[2])) & ~255u) | (255u - blendu(hm, 10u, 66u));
            C[0][11] = (sortable(blendf(hm, f1[0], f1[5]) + blendf(hm, f2[11], f2[0])) & ~255u) | (255u - blendu(hm, 11u, 80u));
            C[0][12] = (sortable(blendf(hm, f1[0], f1[5]) + blendf(hm, f2[12], f2[1])) & ~255u) | (255u - blendu(hm, 12u, 81u));
            C[0][13] = (sortable(blendf(hm, f1[0], f1[6]) + blendf(hm, f2[13], f2[0])) & ~255u) | (255u - blendu(hm, 13u, 96u));
            C[0][14] = (sortable(blendf(hm, f1[0], f1[6]) + blendf(hm, f2[14], f2[1])) & ~255u) | (255u - blendu(hm, 14u, 97u));
            C[0][15] = (sortable(blendf(hm, f1[0], f1[7]) + blendf(hm, f2[15], f2[0])) & ~255u) | (255u - blendu(hm, 15u, 112u));
            C[1][0] = (sortable(blendf(hm, f1[1], f1[7]) + blendf(hm, f2[0], f2[1])) & ~255u) | (255u - blendu(hm, 16u, 113u));
            C[1][1] = (sortable(blendf(hm, f1[1], f1[8]) + blendf(hm, f2[1], f2[0])) & ~255u) | (255u - blendu(hm, 17u, 128u));
            C[1][2] = (sortable(blendf(hm, f1[1], f1[9]) + blendf(hm, f2[2], f2[0])) & ~255u) | (255u - blendu(hm, 18u, 144u));
            C[1][3] = (sortable(blendf(hm, f1[1], f1[10]) + blendf(hm, f2[3], f2[0])) & ~255u) | (255u - blendu(hm, 19u, 160u));
            C[1][4] = (sortable(blendf(hm, f1[1], f1[11]) + blendf(hm, f2[4], f2[0])) & ~255u) | (255u - blendu(hm, 20u, 176u));
            C[1][5] = (sortable(blendf(hm, f1[1], f1[12]) + blendf(hm, f2[5], f2[0])) & ~255u) | (255u - blendu(hm, 21u, 192u));
            C[1][6] = (sortable(blendf(hm, f1[1], f1[13]) + blendf(hm, f2[6], f2[0])) & ~255u) | (255u - blendu(hm, 22u, 208u));
            C[1][7] = (sortable(blendf(hm, f1[1], f1[14]) + blendf(hm, f2[7], f2[0])) & ~255u) | (255u - blendu(hm, 23u, 224u));
            C[1][8] = (sortable(blendf(hm, f1[2], f1[15]) + blendf(hm, f2[0], f2[0])) & ~255u) | (255u - blendu(hm, 32u, 240u));
            C[1][9] = 0u;
            C[1][10] = 0u;
            C[1][11] = 0u;
            C[1][12] = 0u;
            C[1][13] = 0u;
            C[1][14] = 0u;
            C[1][15] = 0u;
            sort16(C[0]); sort16(C[1]); top_merge(C[0], C[1]); xlane_merge(C[0]);
            unsigned long long p1lo = 0ull, p1hi = 0ull, p2lo = 0ull, p2hi = 0ull;
#pragma unroll
            for (int m = 0; m < 8; ++m) { p1lo |= (unsigned long long)(127u - (L[0][m] & 127u)) << (8 * m); p1hi |= (unsigned long long)(127u - (L[0][8 + m] & 127u)) << (8 * m);
                p2lo |= (unsigned long long)(127u - (L[1][m] & 127u)) << (8 * m); p2hi |= (unsigned long long)(127u - (L[1][8 + m] & 127u)) << (8 * m); }
            float val[16]; unsigned ex[16]; float sum = 0.f;
#pragma unroll
            for (int k = 0; k < 16; ++k) { const unsigned flat = 255u - (C[0][k] & 255u); const int a = (int)(flat >> 4), b = (int)(flat & 15u);
                val[k] = unsortable(C[0][k] & ~255u); ex[k] = lookup_idx(p1lo, p1hi, a) * 128u + lookup_idx(p2lo, p2hi, b); }
            const float mx = val[0];
#pragma unroll
            for (int k = 0; k < 16; ++k) { val[k] = __expf(val[k] - mx); sum += val[k]; }
            const float inv = 1.f / sum;
            int eo[8]; float go[8];
#pragma unroll
            for (int k = 0; k < 8; ++k) { eo[k] = (int)blendu(hm, ex[k], ex[8 + k]); go[k] = blendf(hm, val[k], val[8 + k]) * inv; }
            const size_t ob = ((size_t)tok * 8 + h) * 16 + 8 * hh;
            *(int4*)(eidx + ob) = make_int4(eo[0], eo[1], eo[2], eo[3]); *(int4*)(eidx + ob + 4) = make_int4(eo[4], eo[5], eo[6], eo[7]);
            *(float4*)(egate + ob) = make_float4(go[0], go[1], go[2], go[3]); *(float4*)(egate + ob + 4) = make_float4(go[4], go[5], go[6], go[7]);
        }
    }
    __syncthreads();
}
}

namespace at {
typedef float f32x16 __attribute__((ext_vector_type(16)));
constexpr int KROWB = 144, VROWB = 776, K_OFF = 0, V_OFF = 384 * KROWB, LDS_END = V_OFF + 64 * VROWB;
constexpr int N_ITEMS_A = 16 * 12 * 8, N_ITEMS_C = 16 * 2 * 16 * 2;

struct Band { int p_w, ls, R, slot_base; };
DEV void chunk(LAS const unsigned char* lds, const Band& bd, int c, const bf16x8 (&qf)[4], int tl, int hh, f32x16 (&O)[2], float& m, float& l) {
    const int kp0 = bd.p_w - bd.R + 32 * c;
    if (kp0 + 31 < 0 || kp0 >= bd.ls) return;
    const int s0 = kp0 + bd.slot_base;
    f32x16 S;
#pragma unroll
    for (int e = 0; e < 16; ++e) S[e] = 0.f;
#pragma unroll
    for (int ks = 0; ks < 4; ++ks) { const bf16x8 ak = *(const LAS bf16x8*)(lds + K_OFF + (s0 + tl) * KROWB + (16 * ks + 8 * hh) * 2); S = __builtin_amdgcn_mfma_f32_32x32x16_bf16(ak, qf[ks], S, 0, 0, 0); }
    const int dbase = (32 * c - bd.R) - tl + 4 * hh;
    const int kb = kp0 + 4 * hh;
    float cmax = -1e30f;
#pragma unroll
    for (int e = 0; e < 16; ++e) { const int ro = (e & 3) + 8 * (e >> 2); const int diff = dbase + ro, kp = kb + ro;
        const bool ok = (diff <= bd.R) && (diff >= -bd.R) && (kp >= 0) && (kp < bd.ls); S[e] = ok ? S[e] : -1e30f; cmax = fmaxf(cmax, S[e]); }
    cmax = fmaxf(cmax, __shfl_xor(cmax, 32));
    const float mn = fmaxf(m, cmax), alpha = exp2f(m - mn); m = mn;
    float psum = 0.f;
#pragma unroll
    for (int e = 0; e < 16; ++e) { S[e] = exp2f(S[e] - mn); psum += S[e]; }
    l = l * alpha + psum;
#pragma unroll
    for (int e = 0; e < 16; ++e) { O[0][e] *= alpha; O[1][e] *= alpha; }
#pragma unroll
    for (int sx = 0; sx < 2; ++sx) {
        u32x4 pw; pw.x = pg8::cvt_pk_bf16(S[8 * sx + 0], S[8 * sx + 1]); pw.y = pg8::cvt_pk_bf16(S[8 * sx + 2], S[8 * sx + 3]); pw.z = pg8::cvt_pk_bf16(S[8 * sx + 4], S[8 * sx + 5]); pw.w = pg8::cvt_pk_bf16(S[8 * sx + 6], S[8 * sx + 7]);
        const bf16x8 pb = __builtin_bit_cast(bf16x8, pw);
#pragma unroll
        for (int dt = 0; dt < 2; ++dt) { LAS const unsigned char* vp = lds + V_OFF + (32 * dt + tl) * VROWB + (s0 + 16 * sx + 4 * hh) * 2;
            const u32x2 lo = *(const LAS u32x2*)vp, hi = *(const LAS u32x2*)(vp + 16); const u32x4 vw = (u32x4){lo.x, lo.y, hi.x, hi.y};
            O[dt] = __builtin_amdgcn_mfma_f32_32x32x16_bf16(__builtin_bit_cast(bf16x8, vw), pb, O[dt], 0, 0, 0); }
    }
}
DEV void attn_phase(LAS unsigned char* lds, bf16_t* P, float* lse2, bf16_t* Y, const float* sink_l, int G, int cblk) {
    int tid_ = threadIdx.x; asm volatile("" : "+v"(tid_));
    const int tid = tid_, w = __builtin_amdgcn_readfirstlane(tid >> 6), lane = tid & 63, tl = lane & 31, hh = lane >> 5;
#pragma unroll 1
    for (int item = cblk; item < N_ITEMS_A + N_ITEMS_C; item += G) {
        int b, dil, ls, r, klo, nsl, R, kcol, vcol, qcol, two = 0, rp = 0, sb = 0, head = 0, isC = 0, nb = 0, qh0 = 0;
        if (item < N_ITEMS_A) { b = item / 96; const int rem = item - b * 96; head = rem >> 3; const int sub = rem & 7, g = head >> 2; R = 64;
            kcol = 768 + head * 64; vcol = 1536 + head * 64; qcol = head * 64;
            if (g == 0) { dil = 1; ls = 2048; r = 0; sb = sub; klo = 256 * sb - 64; nsl = 384; }
            else if (g == 1) { dil = 4; ls = 512; r = sub >> 1; sb = sub & 1; klo = 256 * sb - 64; nsl = 384; }
            else { dil = 16; ls = 128; r = 0; rp = sub; klo = 0; nsl = 256; two = 1; } }
        else { const int it = item - N_ITEMS_A; b = it >> 6; const int rem = it & 63; const int kvh = rem >> 5; nb = (rem & 31) >> 1; const int hp = rem & 1; isC = 1; R = 128;
            dil = 1; ls = 2048; r = 0; klo = 128 * nb - 128; nsl = 384; kcol = 2816 + kvh * 64; vcol = 2944 + kvh * 64; qh0 = kvh * 4 + hp * 2; qcol = 2304 + qh0 * 64; }
        __syncthreads();
        for (int i = tid; i < nsl * 8; i += 512) { const int slot = i >> 3, part = i & 7; int kpos, rr;
            if (two) { kpos = slot & 127; rr = 2 * rp + (slot >> 7); } else { kpos = klo + slot; rr = r; }
            u32x4 kv = (u32x4){0u, 0u, 0u, 0u}, vv = kv;
            if (kpos >= 0 && kpos < ls) { const bf16_t* rowp = P + (size_t)(b * 2048 + kpos * dil + rr) * PW_; kv = *(const u32x4*)(rowp + kcol + part * 8); vv = *(const u32x4*)(rowp + vcol + part * 8); }
            *(LAS u32x4*)(lds + K_OFF + slot * KROWB + part * 16) = kv;
            LAS unsigned short* vt = (LAS unsigned short*)(lds + V_OFF + (part * 8) * VROWB + slot * 2);
            vt[0 * (VROWB / 2)] = (unsigned short)(vv.x & 0xffffu); vt[1 * (VROWB / 2)] = (unsigned short)(vv.x >> 16); vt[2 * (VROWB / 2)] = (unsigned short)(vv.y & 0xffffu); vt[3 * (VROWB / 2)] = (unsigned short)(vv.y >> 16);
            vt[4 * (VROWB / 2)] = (unsigned short)(vv.z & 0xffffu); vt[5 * (VROWB / 2)] = (unsigned short)(vv.z >> 16); vt[6 * (VROWB / 2)] = (unsigned short)(vv.w & 0xffffu); vt[7 * (VROWB / 2)] = (unsigned short)(vv.w >> 16); }
        __syncthreads();
        Band bd; int qtok, rr = r; bd.ls = ls; bd.R = R;
        if (two) { const int half = w >> 2; bd.p_w = 32 * (w & 3); rr = 2 * rp + half; bd.slot_base = half * 128; }
        else if (isC) { bd.p_w = 128 * nb + 32 * (w & 3); bd.slot_base = -klo; }
        else { bd.p_w = 256 * sb + 32 * w; bd.slot_base = -klo; }
        qtok = b * 2048 + (bd.p_w + tl) * dil + rr;
        const int qc = isC ? (qcol + (w >> 2) * 64) : qcol;
        const bf16_t* qp = P + (size_t)qtok * PW_ + qc + 8 * hh;
        bf16x8 qf[4];
#pragma unroll
        for (int ks = 0; ks < 4; ++ks) qf[ks] = *(const bf16x8*)(qp + 16 * ks);
        f32x16 O[2];
#pragma unroll
        for (int e = 0; e < 16; ++e) { O[0][e] = 0.f; O[1][e] = 0.f; }
        float m = -1e30f, l = 0.f;
        const int nch = R / 16 + 1, cd = R / 32;
        chunk(lds, bd, cd, qf, tl, hh, O, m, l);
#pragma unroll 1
        for (int c = 0; c < nch; ++c) { if (c != cd) chunk(lds, bd, c, qf, tl, hh, O, m, l); }
        float lt = l + __shfl_xor(l, 32), scale;
        if (isC) { const float sk = sink_l[qh0 + (w >> 2)] * LOG2E_; const float mf = fmaxf(m, sk), corr = exp2f(m - mf); lt = lt * corr + exp2f(sk - mf); scale = corr / lt; }
        else { scale = 1.f / lt; if (hh == 0) lse2[(size_t)qtok * 12 + head] = m + log2f(lt); }
        bf16_t* op = isC ? (Y + (size_t)qtok * UYW_ + 768 + (qh0 + (w >> 2)) * 64) : (P + (size_t)qtok * PW_ + qcol);
#pragma unroll
        for (int dt = 0; dt < 2; ++dt)
#pragma unroll
            for (int g4 = 0; g4 < 4; ++g4) { u32x2 pk; pk.x = pg8::cvt_pk_bf16(O[dt][4 * g4] * scale, O[dt][4 * g4 + 1] * scale); pk.y = pg8::cvt_pk_bf16(O[dt][4 * g4 + 2] * scale, O[dt][4 * g4 + 3] * scale);
                *(u32x2*)(op + 32 * dt + 8 * g4 + 4 * hh) = pk; }
    }
    __syncthreads();
}
}

struct Params {
    const float *x, *c, *w_ada, *b_ada, *w_in, *conv_w, *conv_b, *hy_w1, *hy_b1, *hy_w2, *hy_b2, *hy_w3, *hy_freq, *hy_ld, *hy_bias, *attn_sink, *wba, *wbb, *wbc, *w_out, *ln_g, *ln_b,
        *peer_wq, *peer_keys, *peer_u, *peer_v;
    float* out; char* ws;
};
constexpr int LDS_BYTES = 148480;

#define RUN(nvb, call) do { int tid_ = threadIdx.x; asm volatile("" : "+v"(tid_)); const int t = tid_ & 255, sub = tid_ >> 8; unsigned char* sm = lds + sub * 16384; \
        for (int vb = (int)blockIdx.x * 2 + sub; vb < (nvb); vb += (int)gridDim.x * 2) { call; __syncthreads(); } } while (0)
#define GSYNC() do { __builtin_amdgcn_sched_barrier(0); grid.sync(); __builtin_amdgcn_sched_barrier(0); } while (0)

__global__ void __launch_bounds__(512, 2) mega(Params p) {
    extern __shared__ __attribute__((aligned(16))) unsigned char lds[];
    cg::grid_group grid = cg::this_grid();
    LAS unsigned char* ldsl = (LAS unsigned char*)lds;
    const int G = gridDim.x, cblk = blockIdx.x;
    float* out = p.out; (void)out;
    {
    char* ws = p.ws;
    float* ada = (float*)(ws + OFF_ADA); float2* rope = (float2*)(ws + OFF_ROPE); bf16_t* Gr = (bf16_t*)(ws + OFF_GR); float* lse2 = (float*)(ws + OFF_LSE);
    bf16_t* WinT = (bf16_t*)(ws + OFF_WINT); bf16_t* WmT = (bf16_t*)(ws + OFF_WMT); bf16_t* WoutT = (bf16_t*)(ws + OFF_WOUTT); bf16_t* WqT = (bf16_t*)(ws + OFF_WQT);
    bf16_t* UY = (bf16_t*)(ws + OFF_UY); bf16_t* Y = UY + 1024; bf16_t* P = (bf16_t*)(ws + OFF_P); bf16_t* hyT = (bf16_t*)(ws + OFF_HYT);
    bf16_t* merged = (bf16_t*)(ws + OFF_P); bf16_t* gtmp = (bf16_t*)(ws + OFF_P + 64 * MB_); bf16_t* Q2 = (bf16_t*)(ws + OFF_P);
    int* eidx = (int*)(ws + OFF_HYT); float* egate = (float*)(ws + OFF_HYT + 16 * MB_); bf16_t* Ub = (bf16_t*)(ws + OFF_HYT + 32 * MB_); bf16_t* Vb = (bf16_t*)(ws + OFF_HYT + 64 * MB_);
    float* h2 = (float*)(ws + OFF_P); float* hf = (float*)(ws + OFF_P + 2 * MB_);
    (void)lse2; (void)P; (void)hyT; (void)merged; (void)gtmp; (void)Q2; (void)eidx; (void)egate; (void)Ub; (void)Vb; (void)Y;

    RUN(48, nb_ada(vb, t, sm, p.c, p.w_ada, p.b_ada, ada));
    RUN(256, nb_rope(vb, t, sm, rope));
    RUN(1024, nb_filt_h2(vb, t, sm, p.hy_w1, p.hy_b1, p.hy_w2, p.hy_b2, p.hy_freq, h2));
    { const WPrep wq{p.w_in, p.wba, p.wbb, p.wbc, p.w_out, p.peer_wq, WinT, WmT, WoutT, WqT}; RUN(6016, nb_wprep(vb, t, sm, wq)); }
    GSYNC();
    RUN(32768, nb_filt_full(vb, t, sm, h2, p.hy_w3, p.hy_ld, hf));
    RUN(T_ * 4, nb_modulate(vb, t, sm, p.x, ada, 0, 1024, UY));
    GSYNC();
    RUN(2048, nb_filt_norm(vb, t, sm, hf, Gr));
    GSYNC();
    }
#pragma unroll 1
    for (int l = 0; l < 2; ++l) {
        char* ws = p.ws; asm volatile("" : "+s"(ws));
        float* out = p.out; asm volatile("" : "+s"(out));
        int Gl = gridDim.x, cl = blockIdx.x; asm volatile("" : "+s"(Gl), "+s"(cl));
        float* ada = (float*)(ws + OFF_ADA); float2* rope = (float2*)(ws + OFF_ROPE); bf16_t* Gr = (bf16_t*)(ws + OFF_GR); float* lse2 = (float*)(ws + OFF_LSE);
        bf16_t* WinT = (bf16_t*)(ws + OFF_WINT); bf16_t* WmT = (bf16_t*)(ws + OFF_WMT); bf16_t* WoutT = (bf16_t*)(ws + OFF_WOUTT); bf16_t* WqT = (bf16_t*)(ws + OFF_WQT);
        bf16_t* UY = (bf16_t*)(ws + OFF_UY); bf16_t* Y = UY + 1024; bf16_t* P = (bf16_t*)(ws + OFF_P); bf16_t* hyT = (bf16_t*)(ws + OFF_HYT);
        bf16_t* merged = (bf16_t*)(ws + OFF_P); bf16_t* gtmp = (bf16_t*)(ws + OFF_P + 64 * MB_); bf16_t* Q2 = (bf16_t*)(ws + OFF_P);
        int* eidx = (int*)(ws + OFF_HYT); float* egate = (float*)(ws + OFF_HYT + 16 * MB_); bf16_t* Ub = (bf16_t*)(ws + OFF_HYT + 32 * MB_); bf16_t* Vb = (bf16_t*)(ws + OFF_HYT + 64 * MB_);
        const float* ada_l = ada + (size_t)l * 16 * 6144;
        const float* xin = (l == 0) ? p.x : out;
        const bf16_t* WinT_l = WinT + (size_t)l * 7680 * 1024;
        {
            const pg8::PlainSched S1{UY, WinT_l, UYW_, 1024, 128, 12, 16, Gl, cl}; const pg8::EpiP E1{P, rope};
            pg8::gemm_phase(ldsl, UYW_, 1024, S1, E1);
            const pg8::PlainSched S2{WinT_l + (size_t)3072 * 1024, UY, 1024, UYW_, 6, 128, 16, Gl, cl}; const pg8::EpiBf E2{hyT, T_, 0};
            pg8::gemm_phase(ldsl, 1024, UYW_, S2, E2);
        }
        GSYNC();
        at::attn_phase(ldsl, P, lse2, Y, p.attn_sink + l * 8, Gl, cl);
        GSYNC();
        RUN(32768, nb_combineA(vb, t, sm, P, lse2, Y));
        hy::hyena_phase(ldsl, hyT, Gr + (size_t)l * 2 * 512 * 4096, p.conv_w + (size_t)l * 3 * 1536, p.conv_b + (size_t)l * 1536, p.hy_bias + (size_t)l * 1024, Gl, cl);
        GSYNC();
        RUN(65536, nb_transY(vb, t, sm, hyT, Y));
        GSYNC();
        {
            const pg8::MergeSched S{UY, WmT + (size_t)l * 1024 * WMW_, Gl, cl}; const pg8::EpiMergeAll E{gtmp, merged};
            pg8::gemm_phase(ldsl, UYW_, WMW_, S, E);
        }
        GSYNC();
        {
            const pg8::PlainSched S{merged, WoutT + (size_t)l * 1024 * 1024, 1024, 1024, 128, 4, 16, Gl, cl}; const pg8::EpiOut E{xin, out, ada_l + 2048};
            pg8::gemm_phase(ldsl, 1024, 1024, S, E);
        }
        GSYNC();
        RUN(T_, nb_ln_mod(vb, t, sm, out, p.ln_g + (size_t)(l * 2 + 0) * 1024, p.ln_b + (size_t)(l * 2 + 0) * 1024, ada_l, 3072, 4096, UY));
        RUN(8192, peer::nb_cvt_tables(vb, t, p.peer_u + (size_t)l * 16384 * 1024, p.peer_v + (size_t)l * 16384 * 1024, Ub, Vb));
        GSYNC();
        {
            const pg8::PlainSched S{UY, WqT + (size_t)l * 2048 * 1024, UYW_, 1024, 128, 8, 16, Gl, cl}; const pg8::EpiBf E{Q2, 2048, 0};
            pg8::gemm_phase(ldsl, UYW_, 1024, S, E);
        }
        GSYNC();
        tk::topk_phase(ldsl, Q2, p.peer_keys + (size_t)l * 8 * 2 * 128 * 128, eidx, egate, Gl, cl);
        GSYNC();
        peer::peer_phase(ldsl, out, ada_l, eidx, egate, Ub, Vb, p.ln_g + (size_t)(l * 2 + 1) * 1024, p.ln_b + (size_t)(l * 2 + 1) * 1024,
                         (l == 0) ? ada + (size_t)16 * 6144 : (const float*)nullptr, UY, Gl, cl);
        if (l == 0) GSYNC();
    }
}

extern "C" void kernel_launch(void* const* d_in, const int* in_sizes, int n_in, void* d_out, int out_size, void* d_ws, size_t ws_size, hipStream_t stream) {
    static int grid = 0;
    if (grid == 0) {
        if (ws_size < WS_NEED || n_in != 26) { fprintf(stderr, "kernel_launch: workspace %zu < %zu or n_in %d != 26\n", ws_size, (size_t)WS_NEED, n_in); grid = -1; return; }
        int dev = 0, cus = 0, per_cu = 0;
        (void)hipGetDevice(&dev); (void)hipDeviceGetAttribute(&cus, hipDeviceAttributeMultiprocessorCount, dev);
        (void)hipFuncSetAttribute((const void*)mega, hipFuncAttributeMaxDynamicSharedMemorySize, LDS_BYTES);
        (void)hipOccupancyMaxActiveBlocksPerMultiprocessor(&per_cu, (const void*)mega, 512, LDS_BYTES);
        if (per_cu < 1) { fprintf(stderr, "kernel_launch: occupancy query says %d blocks per CU\n", per_cu); grid = -1; return; }
        grid = cus;
    }
    if (grid < 0) return;
    Params p{};
    const float** pp = (const float**)&p;
    for (int i = 0; i < 26; ++i) pp[i] = (const float*)d_in[i];
    p.out = (float*)d_out; p.ws = (char*)d_ws;
    void* args[] = {&p};
    hipError_t e = hipLaunchCooperativeKernel((const void*)mega, dim3(grid), dim3(512), args, LDS_BYTES, stream);
    if (e != hipSuccess) fprintf(stderr, "cooperative launch failed: %s (grid %d)\n", hipGetErrorString(e), grid);
}
```

```cpp
#include <hip/hip_runtime.h>
#include <hip/hip_cooperative_groups.h>
namespace cg = cooperative_groups;
#include <stdint.h>
#include <stdio.h>

#define DEV __device__ __forceinline__
typedef unsigned short bf16_t;

constexpr int D_ = 1024, B_ = 16, S_ = 2048, T_ = B_ * S_;
constexpr float ALPHA_ = 1.41421356237309515f;
constexpr float LOG2E_ = 1.4426950408889634f;
constexpr float QSCALE_ = 0.125f * 1.4426950408889634f;
constexpr float LN_EPS_ = 1e-5f;
constexpr int PW_ = 3072;
constexpr int UYW_ = 2304;
constexpr int WMW_ = 4352;

constexpr size_t MB_ = 1024 * 1024;
constexpr size_t OFF_ADA = 0, OFF_ROPE = 1 * MB_, OFF_GR = 2 * MB_, OFF_LSE = 18 * MB_, OFF_WINT = 20 * MB_, OFF_WMT = 50 * MB_,
                 OFF_WOUTT = 68 * MB_, OFF_WQT = 72 * MB_, OFF_KEYS = 80 * MB_, OFF_UY = 82 * MB_, OFF_P = 226 * MB_, OFF_HYT = 418 * MB_,
                 OFF_Z1T = OFF_P  , WS_NEED = 514 * MB_;

DEV float bf2f(bf16_t v) { return __uint_as_float(((unsigned)v) << 16); }
DEV bf16_t f2bf(float f) { unsigned u = __float_as_uint(f); u += 0x7FFFu + ((u >> 16) & 1u); return (bf16_t)(u >> 16); }

DEV void nb_ada(int vb, int t, unsigned char* sm, const float* __restrict__ c, const float* __restrict__ w_ada, const float* __restrict__ b_ada, float* __restrict__ ada) {
    const int idx = vb * 256 + t; const int l = idx / 6144, n = idx % 6144;
    float (*cond)[64] = (float (*)[64])sm;
    float acc[16];
#pragma unroll
    for (int b = 0; b < 16; ++b) acc[b] = b_ada[l * 6144 + n];
    for (int k0 = 0; k0 < 1024; k0 += 64) {
        for (int i = t; i < 1024; i += 256) { const int b = i >> 6, kk = i & 63; const float v = c[b * 1024 + k0 + kk]; cond[b][kk] = v / (1.f + expf(-v)); }
        __syncthreads();
        for (int kk = 0; kk < 64; ++kk) { const float w = w_ada[((size_t)l * 1024 + k0 + kk) * 6144 + n];
#pragma unroll
            for (int b = 0; b < 16; ++b) acc[b] += cond[b][kk] * w; }
        __syncthreads();
    }
#pragma unroll
    for (int b = 0; b < 16; ++b) ada[((size_t)l * 16 + b) * 6144 + n] = acc[b];
}

DEV void nb_rope(int vb, int t, unsigned char* sm, float2* __restrict__ rope) {
    const int idx = vb * 256 + t; const int s = idx >> 5, i = idx & 31;
    const float inv = powf(10000.f, -(float)i / 32.f); const float ang = (float)s * inv;
    rope[idx] = make_float2(cosf(ang), sinf(ang));
}

DEV void nb_filt_h2(int vb, int t, unsigned char* sm, const float* __restrict__ w1, const float* __restrict__ b1, const float* __restrict__ w2, const float* __restrict__ b2,
                                                const float* __restrict__ freq, float* __restrict__ h2) {
    const int grp = t >> 6, j = t & 63; const int lt = vb * 4 + grp; const int l = lt / 2048, tt = lt % 2048;
    float* z = (float*)sm + grp * 128; float* h1 = z + 64;
    if (j < 33) {
        const float idx = (float)tt, tn = idx / 2047.f, w = 6.283185307179586f * idx / 2048.f;
        if (j == 0) z[0] = tn;
        else { const int k = (j <= 16) ? (j - 1) : (j - 17); const float band = 1e-4f + (float)k * ((15.f - 1e-4f) / 15.f); const float ang = w * band;
            z[j] = (j <= 16) ? cosf(ang) : -sinf(ang); }
    }
    __syncthreads();
    float a = b1[l * 64 + j];
    for (int e = 0; e < 33; ++e) a += z[e] * w1[(l * 33 + e) * 64 + j];
    h1[j] = sinf(freq[(l * 2 + 0) * 64 + j] * a);
    __syncthreads();
    float a2 = b2[l * 64 + j];
    for (int i = 0; i < 64; ++i) a2 += h1[i] * w2[(l * 64 + i) * 64 + j];
    h2[((size_t)l * 2048 + tt) * 64 + j] = sinf(freq[(l * 2 + 1) * 64 + j] * a2);
}

DEV void nb_filt_full(int vb, int t, unsigned char* sm, const float* __restrict__ h2, const float* __restrict__ w3, const float* __restrict__ log_decay, float* __restrict__ hf) {
    const size_t idx = (size_t)vb * 256 + t; const int col = (int)(idx & 2047), tt = (int)((idx >> 11) & 2047), l = (int)(idx >> 22);
    const float* hr = h2 + ((size_t)l * 2048 + tt) * 64; float a = 0.f;
    for (int j = 0; j < 64; ++j) a += hr[j] * w3[((size_t)l * 64 + j) * 2048 + col];
    const float tn = (float)tt / 2047.f;
    hf[idx] = a * expf(-tn * expf(log_decay[l * 2048 + col]));
}

DEV void nb_filt_norm(int vb, int t, unsigned char* sm, const float* __restrict__ hf, bf16_t* __restrict__ Gr) {
    const int blk = vb; const int c = blk & 511, o = (blk >> 9) & 1, l = blk >> 10;
    const float* base = hf + (size_t)l * 2048 * 2048; const int colf = o * 512 + c, colb = 1024 + o * 512 + c;
    float ss = 0.f;
    for (int tt = t; tt < 2048; tt += 256) { const float a = base[(size_t)tt * 2048 + colf]; ss += a * a; if (tt >= 1) { const float bb = base[(size_t)tt * 2048 + colb]; ss += bb * bb; } }
    float* red = (float*)sm; red[t] = ss; __syncthreads();
    for (int st = 128; st > 0; st >>= 1) { if (t < st) red[t] += red[t + st]; __syncthreads(); }
    const float scale = rsqrtf(red[0] + 1e-12f); __syncthreads();
    bf16_t* g = Gr + (size_t)blk * 4096;
    for (int n = t; n < 4096; n += 256) { const int lag = 2047 - n; float v = 0.f;
        if (n < 4095) v = (lag >= 0) ? base[(size_t)lag * 2048 + colf] : base[(size_t)(-lag) * 2048 + colb];
        g[n] = f2bf(v * scale); }
}

DEV void nb_modulate(int vb, int t, unsigned char* sm, const float* __restrict__ x, const float* __restrict__ ada_l, int off_sh, int off_sc, bf16_t* __restrict__ ubuf) {
    const size_t idx = (size_t)vb * 256 + t; const int d = (int)(idx & 1023); const int b = (int)(idx >> 21);
    const float* a = ada_l + (size_t)b * 6144;
    ubuf[(idx >> 10) * UYW_ + d] = f2bf(x[idx] * (1.f + a[off_sc + d]) + a[off_sh + d]);
}

template <class AL, class WL, class EP>
DEV void nb_gemm(int vb, int t, unsigned char* sm, int nbx, int K, AL al, WL wl, EP ep) {
    float (*As)[65] = (float (*)[65])sm;
    float (*Ws)[65] = (float (*)[65])(sm + 16 * 65 * 4);
    const int tx = t & 15, ty = t >> 4;
    const int m0 = (vb / nbx) * 64, n0 = (vb % nbx) * 64;
    float acc[4][4];
#pragma unroll
    for (int i = 0; i < 4; ++i)
#pragma unroll
        for (int j = 0; j < 4; ++j) acc[i][j] = 0.f;
    for (int k0 = 0; k0 < K; k0 += 16) {
#pragma unroll
        for (int r = 0; r < 4; ++r) { const int i = t + r * 256; const int mm = i >> 4, kk = i & 15; As[kk][mm] = al(m0 + mm, k0 + kk); }
#pragma unroll
        for (int r = 0; r < 4; ++r) { const int i = t + r * 256; const int kk = i >> 6, nn = i & 63; Ws[kk][nn] = wl(k0 + kk, n0 + nn); }
        __syncthreads();
#pragma unroll
        for (int kk = 0; kk < 16; ++kk) {
            float a[4], w[4];
#pragma unroll
            for (int i = 0; i < 4; ++i) { a[i] = As[kk][ty + 16 * i]; w[i] = Ws[kk][tx + 16 * i]; }
#pragma unroll
            for (int i = 0; i < 4; ++i)
#pragma unroll
                for (int j = 0; j < 4; ++j) acc[i][j] += a[i] * w[j];
        }
        __syncthreads();
    }
    ep(m0, n0, ty, tx, acc);
}

struct ALbf { const bf16_t* A; int lda; int pad; DEV float operator()(int m, int k) const { return bf2f(A[(size_t)m * lda + k]); } };
struct WLf { const float* W; int ldw; int coff; DEV float operator()(int k, int n) const { return W[(size_t)k * ldw + coff + n]; } };
struct WLinP { const float* W; DEV float operator()(int k, int n) const { return W[(size_t)k * 7680 + (n < 2304 ? n : n + 1536)]; } };

struct EpP { bf16_t* P; const float2* rope;
    DEV void operator()(int m0, int n0, int ty, int tx, float (&acc)[4][4]) const {
        const int head = n0 >> 6; const bool rp = (head < 24) || (head >= 36 && head < 46); const bool qs = (head < 12) || (head >= 36 && head < 44);
#pragma unroll
        for (int i = 0; i < 4; ++i) { const int m = m0 + ty + 16 * i; const int s = m & 2047; bf16_t* row = P + (size_t)m * PW_ + n0;
            if (rp) {
#pragma unroll
                for (int jj = 0; jj < 2; ++jj) { const int d = tx + 16 * jj; const float x1 = acc[i][jj], x2 = acc[i][jj + 2]; const float2 cs = rope[s * 32 + d];
                    float o1 = x1 * cs.x - x2 * cs.y, o2 = x2 * cs.x + x1 * cs.y; if (qs) { o1 *= QSCALE_; o2 *= QSCALE_; }
                    const int p1 = 8 * (d >> 2) + (d & 3); row[p1] = f2bf(o1); row[p1 + 4] = f2bf(o2); }
            } else {
#pragma unroll
                for (int j = 0; j < 4; ++j) row[tx + 16 * j] = f2bf(acc[i][j]);
            } }
    } };
struct EpHyT { bf16_t* hyT;
    DEV void operator()(int m0, int n0, int ty, int tx, float (&acc)[4][4]) const {
#pragma unroll
        for (int i = 0; i < 4; ++i)
#pragma unroll
            for (int j = 0; j < 4; ++j) hyT[(size_t)(n0 + tx + 16 * j) * T_ + m0 + ty + 16 * i] = f2bf(acc[i][j]);
    } };
struct EpGate { bf16_t* tmp;
    DEV void operator()(int m0, int n0, int ty, int tx, float (&acc)[4][4]) const {
#pragma unroll
        for (int i = 0; i < 4; ++i)
#pragma unroll
            for (int j = 0; j < 4; ++j) tmp[(size_t)(m0 + ty + 16 * i) * 1024 + n0 + tx + 16 * j] = f2bf(1.f / (1.f + expf(-acc[i][j])));
    } };
struct EpMerge { const bf16_t* tmp; bf16_t* merged; int first; int pad;
    DEV void operator()(int m0, int n0, int ty, int tx, float (&acc)[4][4]) const {
#pragma unroll
        for (int i = 0; i < 4; ++i)
#pragma unroll
            for (int j = 0; j < 4; ++j) { const size_t o = (size_t)(m0 + ty + 16 * i) * 1024 + n0 + tx + 16 * j; float v = bf2f(tmp[o]) * acc[i][j]; if (!first) v += bf2f(merged[o]); merged[o] = f2bf(v); }
    } };
struct EpOut { const float* xin; float* h; const float* ada_l; int off_g; int pad;
    DEV void operator()(int m0, int n0, int ty, int tx, float (&acc)[4][4]) const {
#pragma unroll
        for (int i = 0; i < 4; ++i)
#pragma unroll
            for (int j = 0; j < 4; ++j) { const int m = m0 + ty + 16 * i, n = n0 + tx + 16 * j; const size_t o = (size_t)m * 1024 + n;
                h[o] = ALPHA_ * xin[o] + ada_l[(size_t)(m >> 11) * 6144 + off_g + n] * acc[i][j]; }
    } };
struct EpQ2 { bf16_t* Q2;
    DEV void operator()(int m0, int n0, int ty, int tx, float (&acc)[4][4]) const {
#pragma unroll
        for (int i = 0; i < 4; ++i)
#pragma unroll
            for (int j = 0; j < 4; ++j) Q2[(size_t)(m0 + ty + 16 * i) * 2048 + n0 + tx + 16 * j] = f2bf(acc[i][j]);
    } };

DEV void nb_attnA(int vb, int t, unsigned char* sm, bf16_t* __restrict__ P, float* __restrict__ lse2) {
    const int idx = vb * 256 + t; const int s = idx & 2047, head = (idx >> 11) % 12, b = idx / (2048 * 12);
    const int gi = head >> 2; const int dil = gi == 0 ? 1 : (gi == 1 ? 4 : 16); const int ls = 2048 / dil; const int r = s % dil, p = s / dil;
    bf16_t* qrow = P + (size_t)(b * 2048 + s) * PW_ + head * 64;
    float q[64], o[64];
#pragma unroll
    for (int d = 0; d < 64; ++d) { q[d] = bf2f(qrow[d]); o[d] = 0.f; }
    float m = -1e30f, l = 0.f;
    const int lo = max(0, p - 64), hi = min(ls - 1, p + 64);
    for (int pp = lo; pp <= hi; ++pp) {
        const bf16_t* krow = P + (size_t)(b * 2048 + pp * dil + r) * PW_ + 768 + head * 64; const bf16_t* vrow = krow + 768;
        float sc = 0.f;
#pragma unroll
        for (int d = 0; d < 64; ++d) sc += q[d] * bf2f(krow[d]);
        const float mn = fmaxf(m, sc), corr = exp2f(m - mn), pw = exp2f(sc - mn);
        l = l * corr + pw;
#pragma unroll
        for (int d = 0; d < 64; ++d) o[d] = o[d] * corr + pw * bf2f(vrow[d]);
        m = mn;
    }
    const float inv = 1.f / l;
#pragma unroll
    for (int d = 0; d < 64; ++d) qrow[d] = f2bf(o[d] * inv);
    lse2[(size_t)(b * 2048 + s) * 12 + head] = m + log2f(l);
}

DEV void nb_attnC(int vb, int t, unsigned char* sm, const bf16_t* __restrict__ P, const float* __restrict__ sink_l, bf16_t* __restrict__ Y) {
    const int idx = vb * 256 + t; const int s = idx & 2047, qh = (idx >> 11) & 7, b = idx >> 14; const int kvh = qh >> 2;
    const bf16_t* qrow = P + (size_t)(b * 2048 + s) * PW_ + 2304 + qh * 64;
    float q[64], o[64];
#pragma unroll
    for (int d = 0; d < 64; ++d) { q[d] = bf2f(qrow[d]); o[d] = 0.f; }
    float m = -1e30f, l = 0.f;
    const int lo = max(0, s - 128), hi = min(2047, s + 128);
    for (int pp = lo; pp <= hi; ++pp) {
        const bf16_t* krow = P + (size_t)(b * 2048 + pp) * PW_ + 2816 + kvh * 64; const bf16_t* vrow = krow + 128;
        float sc = 0.f;
#pragma unroll
        for (int d = 0; d < 64; ++d) sc += q[d] * bf2f(krow[d]);
        const float mn = fmaxf(m, sc), corr = exp2f(m - mn), pw = exp2f(sc - mn);
        l = l * corr + pw;
#pragma unroll
        for (int d = 0; d < 64; ++d) o[d] = o[d] * corr + pw * bf2f(vrow[d]);
        m = mn;
    }
    const float sk = sink_l[qh] * LOG2E_; const float mf = fmaxf(m, sk); const float corr = exp2f(m - mf);
    l = l * corr + exp2f(sk - mf); const float inv = corr / l;
    bf16_t* yrow = Y + (size_t)(b * 2048 + s) * UYW_ + 768 + qh * 64;
#pragma unroll
    for (int d = 0; d < 64; ++d) yrow[d] = f2bf(o[d] * inv);
}

DEV void nb_combineA(int vb, int t, unsigned char* sm, const bf16_t* __restrict__ P, const float* __restrict__ lse2, bf16_t* __restrict__ Y) {
    const size_t idx = (size_t)vb * 256 + t; const int cc = (int)(idx & 255); const size_t tok = idx >> 8; const int hh = cc >> 6, d = cc & 63;
    const float l0 = lse2[tok * 12 + hh], l1 = lse2[tok * 12 + 4 + hh], l2 = lse2[tok * 12 + 8 + hh]; const float mx = fmaxf(l0, fmaxf(l1, l2));
    const float w0 = exp2f(l0 - mx), w1 = exp2f(l1 - mx), w2 = exp2f(l2 - mx);
    const bf16_t* pr = P + tok * PW_ + hh * 64 + d;
    Y[tok * UYW_ + cc] = f2bf((w0 * bf2f(pr[0]) + w1 * bf2f(pr[256]) + w2 * bf2f(pr[512])) / (w0 + w1 + w2));
}

DEV void nb_hyena(int vb, int t, unsigned char* sm, int pass, bf16_t* __restrict__ hyT, bf16_t* __restrict__ z1T, const bf16_t* __restrict__ Gr_l, const float* __restrict__ conv_w,
                                                const float* __restrict__ conv_b, const float* __restrict__ hy_bias) {
    const size_t idx = (size_t)vb * 256 + t; const int i = (int)(idx & 2047); const int b = (int)((idx >> 11) & 15); const int c = (int)(idx >> 15);
    const bf16_t* G = Gr_l + ((size_t)pass * 512 + c) * 4096 + (2047 - i);
    float acc = 0.f, zi = 0.f;
    if (pass == 0) {
        const bf16_t* in = hyT + (size_t)c * T_ + b * 2048; const float w0 = conv_w[c], w1 = conv_w[1536 + c], w2 = conv_w[3072 + c], cb = conv_b[c];
        float prev = 0.f, cur = bf2f(in[0]);
        for (int j = 0; j < 2048; ++j) { const float nxt = (j < 2047) ? bf2f(in[j + 1]) : 0.f; const float z = cb + w0 * prev + w1 * cur + w2 * nxt;
            acc += bf2f(G[j]) * z; if (j == i) zi = z; prev = cur; cur = nxt; }
    } else {
        const bf16_t* in = z1T + (size_t)c * T_ + b * 2048;
        for (int j = 0; j < 2048; ++j) { const float z = bf2f(in[j]); acc += bf2f(G[j]) * z; if (j == i) zi = z; }
    }
    const int xc = (pass == 0 ? 512 : 1024) + c;
    const bf16_t* xin = hyT + (size_t)xc * T_ + b * 2048;
    const float xm = (i > 0) ? bf2f(xin[i - 1]) : 0.f, x0 = bf2f(xin[i]), xp = (i < 2047) ? bf2f(xin[i + 1]) : 0.f;
    const float xv = conv_b[xc] + conv_w[xc] * xm + conv_w[1536 + xc] * x0 + conv_w[3072 + xc] * xp;
    const float outv = xv * (acc + hy_bias[pass * 512 + c] * zi);
    if (pass == 0) z1T[(size_t)c * T_ + b * 2048 + i] = f2bf(outv); else hyT[(size_t)c * T_ + b * 2048 + i] = f2bf(outv);
}

DEV void nb_transY(int vb, int t, unsigned char* sm, const bf16_t* __restrict__ hyT, bf16_t* __restrict__ Y) {
    const size_t idx = (size_t)vb * 256 + t; const int c = (int)(idx & 511); const size_t tok = idx >> 9;
    Y[tok * UYW_ + 256 + c] = hyT[(size_t)c * T_ + tok];
}

DEV void nb_ln_mod(int vb, int t, unsigned char* sm, float* __restrict__ h, const float* __restrict__ g, const float* __restrict__ bta, const float* __restrict__ ada_l, int off_sh, int off_sc,
                                                bf16_t* __restrict__ ubuf) {
    const int tok = vb; float v[4]; float s = 0.f;
#pragma unroll
    for (int k = 0; k < 4; ++k) { v[k] = h[(size_t)tok * 1024 + t + 256 * k]; s += v[k]; }
    float* red = (float*)sm; red[t] = s; __syncthreads();
    for (int st = 128; st > 0; st >>= 1) { if (t < st) red[t] += red[t + st]; __syncthreads(); }
    const float mu = red[0] * (1.f / 1024.f); __syncthreads();
    float q = 0.f;
#pragma unroll
    for (int k = 0; k < 4; ++k) { const float dd = v[k] - mu; q += dd * dd; }
    red[t] = q; __syncthreads();
    for (int st = 128; st > 0; st >>= 1) { if (t < st) red[t] += red[t + st]; __syncthreads(); }
    const float rstd = rsqrtf(red[0] * (1.f / 1024.f) + LN_EPS_);
    const float* a = ada_l + (size_t)(tok >> 11) * 6144;
#pragma unroll
    for (int k = 0; k < 4; ++k) { const int d = t + 256 * k; const float y = (v[k] - mu) * rstd * g[d] + bta[d]; h[(size_t)tok * 1024 + d] = y;
        if (ubuf) ubuf[(size_t)tok * UYW_ + d] = f2bf(y * (1.f + a[off_sc + d]) + a[off_sh + d]); }
}

DEV void nb_peer_topk(int vb, int t, unsigned char* sm, const bf16_t* __restrict__ Q2, const float* __restrict__ keys_l, int* __restrict__ eidx, float* __restrict__ egate) {
    const int grp = t >> 7; const int th = vb * 2 + grp; const int tok = th >> 3, h = th & 7; t &= 127;
    float* qs = (float*)sm + grp * 1024; float* s1 = qs + 256; float* s2 = s1 + 128; float* t1v = s2 + 128; float* t2v = t1v + 16; float* cand = t2v + 16; float* bestv = cand + 256;
    int* t1i = (int*)(bestv + 16); int* t2i = t1i + 16; int* besti = t2i + 16;
    qs[t] = bf2f(Q2[(size_t)tok * 2048 + h * 256 + t]); qs[t + 128] = bf2f(Q2[(size_t)tok * 2048 + h * 256 + 128 + t]);
    __syncthreads();
    { const float* k1 = keys_l + ((size_t)(h * 2 + 0) * 128 + t) * 128; const float* k2 = keys_l + ((size_t)(h * 2 + 1) * 128 + t) * 128; float a = 0.f, bsum = 0.f;
        for (int c = 0; c < 128; ++c) { a += qs[c] * k1[c]; bsum += qs[128 + c] * k2[c]; }
        s1[t] = a; s2[t] = bsum; }
    __syncthreads();
    { const float a = s1[t], bb = s2[t]; int r1 = 0, r2 = 0;
        for (int m = 0; m < 128; ++m) { const float x = s1[m], y = s2[m]; r1 += (x > a || (x == a && m < t)) ? 1 : 0; r2 += (y > bb || (y == bb && m < t)) ? 1 : 0; }
        if (r1 < 16) { t1v[r1] = a; t1i[r1] = t; } if (r2 < 16) { t2v[r2] = bb; t2i[r2] = t; } }
    __syncthreads();
    cand[t] = t1v[t >> 4] + t2v[t & 15]; cand[t + 128] = t1v[(t + 128) >> 4] + t2v[t & 15];
    __syncthreads();
#pragma unroll
    for (int rr = 0; rr < 2; ++rr) { const int ci = t + 128 * rr; const float a = cand[ci]; int r = 0;
        for (int m = 0; m < 256; ++m) { const float x = cand[m]; r += (x > a || (x == a && m < ci)) ? 1 : 0; }
        if (r < 16) { bestv[r] = a; besti[r] = ci; } }
    __syncthreads();
    if (t < 16) { const float mx = bestv[0]; float sum = 0.f;
        for (int k = 0; k < 16; ++k) sum += expf(bestv[k] - mx);
        const int ci = besti[t]; const size_t o = ((size_t)tok * 8 + h) * 16 + t;
        eidx[o] = ((t1i[(ci >> 4) & 15] & 127) * 128 + (t2i[ci & 15] & 127)); egate[o] = expf(bestv[t] - mx) / sum; }
}

DEV void nb_peer(int vb, int t, unsigned char* sm, float* __restrict__ xio, const float* __restrict__ ada_l, const int* __restrict__ eidx, const float* __restrict__ egate,
                                              const float* __restrict__ pu, const float* __restrict__ pv, const float* __restrict__ g, const float* __restrict__ bta,
                                              const float* __restrict__ ada_next, bf16_t* __restrict__ ubuf) {
    const int tok = vb, lane = t & 63, w = t >> 6;
    float* xs = (float*)sm; float* wv = xs + 1024; float* red = wv + 128; int* es = (int*)(red + 256);
    const float* a = ada_l + (size_t)(tok >> 11) * 6144; float x1[4];
#pragma unroll
    for (int k = 0; k < 4; ++k) { const int d = t + 256 * k; x1[k] = xio[(size_t)tok * 1024 + d]; xs[d] = x1[k] * (1.f + a[4096 + d]) + a[3072 + d]; }
    if (t < 128) es[t] = eidx[(size_t)tok * 128 + t];
    __syncthreads();
    for (int i = w; i < 128; i += 4) { const float* ur = pu + (size_t)es[i] * 1024; float dsum = 0.f;
#pragma unroll
        for (int k = 0; k < 16; ++k) dsum += ur[lane + 64 * k] * xs[lane + 64 * k];
#pragma unroll
        for (int off = 32; off > 0; off >>= 1) dsum += __shfl_xor(dsum, off);
        if (lane == 0) wv[i] = egate[(size_t)tok * 128 + i] * 0.5f * dsum * (1.f + erff(dsum * 0.70710678118654752f)); }
    __syncthreads();
    float acc[4] = {0.f, 0.f, 0.f, 0.f};
    for (int i = 0; i < 128; ++i) { const float* vr = pv + (size_t)es[i] * 1024; const float wi = wv[i];
#pragma unroll
        for (int k = 0; k < 4; ++k) acc[k] += wi * vr[t + 256 * k]; }
    float v[4]; float s = 0.f;
#pragma unroll
    for (int k = 0; k < 4; ++k) { v[k] = ALPHA_ * x1[k] + a[5120 + t + 256 * k] * acc[k]; s += v[k]; }
    red[t] = s; __syncthreads();
    for (int st = 128; st > 0; st >>= 1) { if (t < st) red[t] += red[t + st]; __syncthreads(); }
    const float mu = red[0] * (1.f / 1024.f); __syncthreads();
    float q = 0.f;
#pragma unroll
    for (int k = 0; k < 4; ++k) { const float dd = v[k] - mu; q += dd * dd; }
    red[t] = q; __syncthreads();
    for (int st = 128; st > 0; st >>= 1) { if (t < st) red[t] += red[t + st]; __syncthreads(); }
    const float rstd = rsqrtf(red[0] * (1.f / 1024.f) + LN_EPS_);
    const float* an = ada_next ? ada_next + (size_t)(tok >> 11) * 6144 : nullptr;
#pragma unroll
    for (int k = 0; k < 4; ++k) { const int d = t + 256 * k; const float y = (v[k] - mu) * rstd * g[d] + bta[d]; xio[(size_t)tok * 1024 + d] = y;
        if (an) ubuf[(size_t)tok * UYW_ + d] = f2bf(y * (1.f + an[1024 + d]) + an[d]); }
}

#define LAS __attribute__((address_space(3)))
typedef short bf16x8 __attribute__((ext_vector_type(8)));
typedef float f32x4 __attribute__((ext_vector_type(4)));
typedef float f32x2 __attribute__((ext_vector_type(2)));
typedef unsigned u32x4 __attribute__((ext_vector_type(4)));
typedef unsigned u32x2 __attribute__((ext_vector_type(2)));
namespace pg8 {
constexpr int BM = 256, BK = 64, HALF = 128, HTB = HALF * BK * 2, STAGE_BYTES = 8 * HTB, NXCD = 8, WGM = 8;
DEV int lds_byte(int r, int c) { const int st = (r >> 4) * 2 + (c >> 5), rr = r & 15, cc = c & 31, ob = rr * 64 + cc * 2; return st * 1024 + (ob ^ (((ob >> 9) & 1) << 5)); }
DEV void stage_rc(int b, int& R, int& C) { const int st = b / 1024, sb = b % 1024, swz = sb ^ (((sb >> 9) & 1) << 5); R = (st >> 1) * 16 + swz / 64; C = (st & 1) * 32 + (swz % 64) / 2; }
DEV int perm32(int rho) { const int n = rho >> 4, i = rho & 15; return 8 * (i >> 2) + 4 * n + (i & 3); }
DEV unsigned cvt_pk_bf16(float lo, float hi) { unsigned r; asm volatile("v_cvt_pk_bf16_f32 %0, %1, %2" : "=v"(r) : "v"(lo), "v"(hi)); return r; }

struct Unit { int pm, pn, tag, nt; const char* a; const char* b; };
DEV void tile_of(int L, int nM, int nN, int& pm, int& pn) {
    const int nwg = nM * nN; int wgid = L; { const int q = nwg / NXCD, r = nwg % NXCD, xcd = wgid % NXCD, off = wgid / NXCD; wgid = (xcd < r ? xcd * (q + 1) : r * (q + 1) + (xcd - r) * q) + off; }
    const int nig = WGM * nN, gid = wgid / nig, fm = gid * WGM, gsz = (nM - fm) < WGM ? (nM - fm) : WGM;
    pm = fm + ((wgid % nig) % gsz); pn = (wgid % nig) / gsz;
}
struct PlainSched { const bf16_t* A; const bf16_t* Bt; int lda, ldb, nM, nN, nt, G, c;
    DEV bool next(int i, Unit& u) const { const long L = (long)i * G + c; if (L >= (long)nM * nN) return false; tile_of((int)L, nM, nN, u.pm, u.pn); u.tag = 0; u.nt = nt;
        u.a = (const char*)(A + (size_t)u.pm * BM * lda); u.b = (const char*)(Bt + (size_t)u.pn * BM * ldb); return true; } };

template <class Epi, class Sched>
DEV void gemm_phase(LAS unsigned char* lds, const int lda, const int ldb, const Sched& S, const Epi& E) {
    int tid_ = threadIdx.x; asm volatile("" : "+v"(tid_));
    const int tid = tid_, wid = __builtin_amdgcn_readfirstlane(tid >> 6), lane = tid & 63, wr = wid >> 2, wc = wid & 3, fr = lane & 15, fq = lane >> 4;
    unsigned voffA[2], voffB[2];
#pragma unroll
    for (int i = 0; i < 2; ++i) { int R, C; stage_rc(tid * 16 + i * 8192, R, C); const int Rb = Epi::PERM ? ((R & ~31) + perm32(R & 31)) : R;
        voffA[i] = (unsigned)(R * lda + C) * 2u; voffB[i] = (unsigned)(Rb * ldb + C) * 2u; }
    const size_t kstep = (size_t)(BK * 2);
    const size_t hstepA = (size_t)HALF * lda * 2, hstepB = (size_t)HALF * ldb * 2;
    const unsigned ldsw = (unsigned)wid * 1024u;
    const int aoff = lds_byte(wr * 64 + fr, fq * 8), boff = lds_byte(wc * 32 + fr, fq * 8);
#define PG8_SA(b, h) (((b) * 2 + (h)) * HTB)
#define PG8_SB(b, h) ((4 + (b) * 2 + (h)) * HTB)
#define PG8_STAGE(bufoff, gbase, voff) do { _Pragma("unroll") for (int _i = 0; _i < 2; ++_i) \
        __builtin_amdgcn_global_load_lds((const unsigned*)((const char*)(gbase) + (voff)[_i]), (LAS unsigned*)(lds + (bufoff) + ldsw + _i * 8192), 16, 0, 0); } while (0)
#define PG8_LDA(dst, b, h) do { _Pragma("unroll") for (int m = 0; m < 4; ++m) _Pragma("unroll") for (int k = 0; k < 2; ++k) dst[m][k] = *(const LAS bf16x8*)(lds + PG8_SA(b, h) + aoff + m * 2048 + k * 1024); } while (0)
#define PG8_LDB(dst, b, h) do { _Pragma("unroll") for (int n = 0; n < 2; ++n) _Pragma("unroll") for (int k = 0; k < 2; ++k) dst[n][k] = *(const LAS bf16x8*)(lds + PG8_SB(b, h) + boff + n * 2048 + k * 1024); } while (0)
#define PG8_MMA(ai, bj, At, Bt) do { __builtin_amdgcn_s_setprio(1); _Pragma("unroll") for (int m = 0; m < 4; ++m) _Pragma("unroll") for (int n = 0; n < 2; ++n) _Pragma("unroll") for (int k = 0; k < 2; ++k) \
        acc[ai][bj][m][n] = __builtin_amdgcn_mfma_f32_16x16x32_bf16(Bt[n][k], At[m][k], acc[ai][bj][m][n], 0, 0, 0); __builtin_amdgcn_s_setprio(0); } while (0)
#define PG8_WAIT_V(n) asm volatile("s_waitcnt vmcnt(" #n ")" ::: "memory")
#define PG8_WAIT_L(n) asm volatile("s_waitcnt lgkmcnt(" #n ")" ::: "memory")
#define PG8_BAR __builtin_amdgcn_s_barrier()
#define PG8_SCHED __builtin_amdgcn_sched_barrier(0)
    Unit cur, nxt; int ui = 0;
    if (!S.next(0, cur)) return;
    f32x4 acc[2][2][4][2];
#pragma unroll
    for (int a = 0; a < 2; ++a)
#pragma unroll
        for (int b = 0; b < 2; ++b)
#pragma unroll
            for (int m = 0; m < 4; ++m)
#pragma unroll
                for (int n = 0; n < 2; ++n) acc[a][b][m][n] = (f32x4){0.f, 0.f, 0.f, 0.f};
    bf16x8 At[4][2], B0[2][2], B1[2][2];
    const char* cA = cur.a; const char* cB = cur.b;
    PG8_STAGE(PG8_SB(0, 0), cB, voffB); PG8_STAGE(PG8_SA(0, 0), cA, voffA); PG8_STAGE(PG8_SB(0, 1), cB + hstepB, voffB); PG8_STAGE(PG8_SA(0, 1), cA + hstepA, voffA);
    if (wr == 1) PG8_BAR;
    PG8_WAIT_V(4); PG8_BAR;
    PG8_STAGE(PG8_SB(1, 0), cB + kstep, voffB); PG8_STAGE(PG8_SA(1, 0), cA + kstep, voffA); PG8_STAGE(PG8_SB(1, 1), cB + hstepB + kstep, voffB);
    PG8_WAIT_V(6); PG8_BAR;
    for (;;) {
        const bool has_next = S.next(ui + 1, nxt);
        const char* nA = has_next ? nxt.a : cA; const char* nB = has_next ? nxt.b : cB;
        const int nt = cur.nt;
        for (int t = 0; t < nt; t += 2) {
            const bool last = (t == nt - 2);
            const char* a1 = cA + (size_t)(t + 1) * kstep;
            const char* a2 = last ? nA : cA + (size_t)(t + 2) * kstep; const char* b2 = last ? nB : cB + (size_t)(t + 2) * kstep;
            const char* a3 = a2 + kstep; const char* b3 = b2 + kstep;
            PG8_LDB(B0, 0, 0); PG8_SCHED; PG8_LDA(At, 0, 0); PG8_STAGE(PG8_SA(1, 1), a1 + hstepA, voffA);
            PG8_WAIT_L(8); PG8_BAR; PG8_WAIT_L(0); PG8_MMA(0, 0, At, B0); PG8_BAR; PG8_SCHED;
            PG8_LDB(B1, 0, 1); PG8_STAGE(PG8_SB(0, 0), b2, voffB);
            PG8_BAR; PG8_WAIT_L(0); PG8_MMA(0, 1, At, B1); PG8_BAR;
            PG8_LDA(At, 0, 1); PG8_STAGE(PG8_SA(0, 0), a2, voffA);
            PG8_BAR; PG8_WAIT_L(0); PG8_MMA(1, 0, At, B0); PG8_BAR; PG8_SCHED;
            PG8_STAGE(PG8_SB(0, 1), b2 + hstepB, voffB);
            PG8_WAIT_V(6); PG8_BAR; PG8_MMA(1, 1, At, B1); PG8_BAR;
            PG8_LDB(B0, 1, 0); PG8_SCHED; PG8_LDA(At, 1, 0); PG8_STAGE(PG8_SA(0, 1), a2 + hstepA, voffA);
            PG8_WAIT_L(8); PG8_BAR; PG8_WAIT_L(0); PG8_MMA(0, 0, At, B0); PG8_BAR; PG8_SCHED;
            PG8_LDB(B1, 1, 1); PG8_STAGE(PG8_SB(1, 0), b3, voffB);
            PG8_BAR; PG8_WAIT_L(0); PG8_MMA(0, 1, At, B1); PG8_BAR;
            PG8_LDA(At, 1, 1); PG8_STAGE(PG8_SA(1, 0), a3, voffA);
            PG8_BAR; PG8_WAIT_L(0); PG8_MMA(1, 0, At, B0); PG8_BAR; PG8_SCHED;
            PG8_STAGE(PG8_SB(1, 1), b3 + hstepB, voffB);
            PG8_WAIT_V(6); PG8_BAR; PG8_MMA(1, 1, At, B1); PG8_BAR;
        }
        E(acc, cur, wr, wc, fr, fq);
        if (!has_next) break;
#pragma unroll
        for (int a = 0; a < 2; ++a)
#pragma unroll
            for (int b = 0; b < 2; ++b)
#pragma unroll
                for (int m = 0; m < 4; ++m)
#pragma unroll
                    for (int n = 0; n < 2; ++n) acc[a][b][m][n] = (f32x4){0.f, 0.f, 0.f, 0.f};
        cur = nxt; cA = nA; cB = nB; ++ui;
    }
    PG8_WAIT_V(0);
    if (wr == 0) PG8_BAR;
    PG8_BAR;
#undef PG8_SA
#undef PG8_SB
#undef PG8_STAGE
#undef PG8_LDA
#undef PG8_LDB
#undef PG8_MMA
#undef PG8_WAIT_V
#undef PG8_WAIT_L
#undef PG8_BAR
#undef PG8_SCHED
}
struct EpiBf { static constexpr bool PERM = true; bf16_t* O; int ldc; int pad;
    DEV void operator()(const f32x4 (&acc)[2][2][4][2], const Unit& u, int wr, int wc, int fr, int fq) const {
        const int row0 = u.pm * BM + wr * 64 + fr, col0 = u.pn * BM + wc * 32 + 8 * fq;
#pragma unroll
        for (int ai = 0; ai < 2; ++ai)
#pragma unroll
            for (int m = 0; m < 4; ++m) { bf16_t* rowp = O + (size_t)(row0 + ai * HALF + m * 16) * ldc + col0;
#pragma unroll
                for (int bj = 0; bj < 2; ++bj) { const f32x4 v0 = acc[ai][bj][m][0], v1 = acc[ai][bj][m][1];
                    u32x4 w; w.x = cvt_pk_bf16(v0[0], v0[1]); w.y = cvt_pk_bf16(v0[2], v0[3]); w.z = cvt_pk_bf16(v1[0], v1[1]); w.w = cvt_pk_bf16(v1[2], v1[3]);
                    *(u32x4*)(rowp + bj * HALF) = w; } }
    } };
struct EpiP { static constexpr bool PERM = true; bf16_t* P; const float2* rope;
    DEV void operator()(const f32x4 (&acc)[2][2][4][2], const Unit& u, int wr, int wc, int fr, int fq) const {
        const int row0 = u.pm * BM + wr * 64 + fr, col0 = u.pn * BM + wc * 32 + 8 * fq; const int g = (wc & 1) * 4 + fq; const int pn = u.pn;
        const bool qs = (pn < 3) || (pn == 9) || (pn == 10);
#pragma unroll
        for (int ai = 0; ai < 2; ++ai)
#pragma unroll
            for (int m = 0; m < 4; ++m) { const int row = row0 + ai * HALF + m * 16; bf16_t* rowp = P + (size_t)row * PW_ + col0;
                const float4* rp = (const float4*)(rope + (size_t)(row & 2047) * 32 + 4 * g); const float4 cs0 = rp[0], cs1 = rp[1];
                const float cc[4] = {cs0.x, cs0.z, cs1.x, cs1.z}, ss[4] = {cs0.y, cs0.w, cs1.y, cs1.w};
#pragma unroll
                for (int bj = 0; bj < 2; ++bj) { f32x4 v0 = acc[ai][bj][m][0], v1 = acc[ai][bj][m][1];
                    const bool rp_ = (pn < 6) || (pn == 9) || (pn == 10) || (pn == 11 && bj == 0);
                    if (rp_) {
#pragma unroll
                        for (int j = 0; j < 4; ++j) { const float x1 = v0[j], x2 = v1[j]; float o1 = x1 * cc[j] - x2 * ss[j], o2 = x2 * cc[j] + x1 * ss[j];
                            if (qs) { o1 *= QSCALE_; o2 *= QSCALE_; } v0[j] = o1; v1[j] = o2; } }
                    u32x4 w; w.x = cvt_pk_bf16(v0[0], v0[1]); w.y = cvt_pk_bf16(v0[2], v0[3]); w.z = cvt_pk_bf16(v1[0], v1[1]); w.w = cvt_pk_bf16(v1[2], v1[3]);
                    *(u32x4*)(rowp + bj * HALF) = w; } }
    } };
struct EpiMergeAll { static constexpr bool PERM = true; bf16_t* gtmp; bf16_t* merged;
    DEV void operator()(const f32x4 (&acc)[2][2][4][2], const Unit& u, int wr, int wc, int fr, int fq) const {
        const int row0 = u.pm * BM + wr * 64 + fr, col0 = u.pn * BM + wc * 32 + 8 * fq; const int tag = u.tag;
#pragma unroll
        for (int ai = 0; ai < 2; ++ai)
#pragma unroll
            for (int m = 0; m < 4; ++m) { const size_t ro = (size_t)(row0 + ai * HALF + m * 16) * 1024 + col0;
#pragma unroll
                for (int bj = 0; bj < 2; ++bj) { f32x4 v0 = acc[ai][bj][m][0], v1 = acc[ai][bj][m][1]; const size_t o = ro + bj * HALF;
                    if ((tag & 1) == 0) {
#pragma unroll
                        for (int j = 0; j < 4; ++j) { v0[j] = 1.f / (1.f + __expf(-v0[j])); v1[j] = 1.f / (1.f + __expf(-v1[j])); }
                        u32x4 w; w.x = cvt_pk_bf16(v0[0], v0[1]); w.y = cvt_pk_bf16(v0[2], v0[3]); w.z = cvt_pk_bf16(v1[0], v1[1]); w.w = cvt_pk_bf16(v1[2], v1[3]);
                        *(u32x4*)(gtmp + o) = w;
                    } else {
                        const u32x4 gq = *(const u32x4*)(gtmp + o);
                        float gg[8] = {__uint_as_float(gq.x << 16), __uint_as_float(gq.x & 0xffff0000u), __uint_as_float(gq.y << 16), __uint_as_float(gq.y & 0xffff0000u),
                                       __uint_as_float(gq.z << 16), __uint_as_float(gq.z & 0xffff0000u), __uint_as_float(gq.w << 16), __uint_as_float(gq.w & 0xffff0000u)};
#pragma unroll
                        for (int j = 0; j < 4; ++j) { v0[j] *= gg[j]; v1[j] *= gg[4 + j]; }
                        if (tag != 1) { const u32x4 mq = *(const u32x4*)(merged + o);
                            float mm[8] = {__uint_as_float(mq.x << 16), __uint_as_float(mq.x & 0xffff0000u), __uint_as_float(mq.y << 16), __uint_as_float(mq.y & 0xffff0000u),
                                           __uint_as_float(mq.z << 16), __uint_as_float(mq.z & 0xffff0000u), __uint_as_float(mq.w << 16), __uint_as_float(mq.w & 0xffff0000u)};
#pragma unroll
                            for (int j = 0; j < 4; ++j) { v0[j] += mm[j]; v1[j] += mm[4 + j]; } }
                        u32x4 w; w.x = cvt_pk_bf16(v0[0], v0[1]); w.y = cvt_pk_bf16(v0[2], v0[3]); w.z = cvt_pk_bf16(v1[0], v1[1]); w.w = cvt_pk_bf16(v1[2], v1[3]);
                        *(u32x4*)(merged + o) = w;
                    } } }
    } };
struct EpiOut { static constexpr bool PERM = false; const float* xin; float* h; const float* ada_g;
    DEV void operator()(const f32x4 (&acc)[2][2][4][2], const Unit& u, int wr, int wc, int fr, int fq) const {
        const int row0 = u.pm * BM + wr * 64 + fr, col0 = u.pn * BM + wc * 32 + 4 * fq; const float* gv = ada_g + (size_t)(u.pm >> 3) * 6144 + col0;
        f32x4 g[2][2];
#pragma unroll
        for (int bj = 0; bj < 2; ++bj)
#pragma unroll
            for (int n = 0; n < 2; ++n) g[bj][n] = *(const f32x4*)(gv + bj * HALF + n * 16);
#pragma unroll
        for (int ai = 0; ai < 2; ++ai)
#pragma unroll
            for (int m = 0; m < 4; ++m) { const size_t ro = (size_t)(row0 + ai * HALF + m * 16) * 1024 + col0;
#pragma unroll
                for (int bj = 0; bj < 2; ++bj)
#pragma unroll
                    for (int n = 0; n < 2; ++n) { const size_t o = ro + bj * HALF + n * 16; const f32x4 xv = *(const f32x4*)(xin + o); *(f32x4*)(h + o) = ALPHA_ * xv + g[bj][n] * acc[ai][bj][m][n]; } }
    } };
struct MergeSched { const bf16_t* UY; const bf16_t* WmT; int G, c;
    DEV bool next(int i, Unit& u) const { const int ti = i / 6, ps = i - ti * 6; const long L = (long)ti * G + c; if (L >= 128 * 4) return false; tile_of((int)L, 128, 4, u.pm, u.pn); u.tag = ps;
        const int br = ps >> 1; const bf16_t* ar = UY + (size_t)u.pm * BM * UYW_; const bf16_t* brow = WmT + (size_t)u.pn * BM * WMW_;
        if ((ps & 1) == 0) { u.nt = 16; u.a = (const char*)ar; u.b = (const char*)(brow + br * 1024); }
        else { const int koff = br == 0 ? 0 : (br == 1 ? 256 : 768); u.nt = br == 0 ? 4 : 8; u.a = (const char*)(ar + 1024 + koff); u.b = (const char*)(brow + 3072 + koff); }
        return true; } };
}

DEV int win_orig_col(int n) {
    if (n >= 3072) return n < 4608 ? (n - 3072 + 2304) : n;
    const int head = n >> 6, p = n & 63; const bool rp = (head < 24) || (head >= 36 && head < 46);
    const int d = rp ? ((p & 4) ? 32 + 4 * (p >> 3) + (p & 3) : 4 * (p >> 3) + (p & 3)) : p;
    return ((n < 2304) ? head * 64 : 3840 + (head - 36) * 64) + d;
}
struct WPrep { const float *w_in, *wba, *wbb, *wbc, *w_out, *peer_wq; bf16_t *WinT, *WmT, *WoutT, *WqT; };
DEV void nb_wprep(int vb, int t, unsigned char* sm, const WPrep& q) {
    const int l = vb / 3008; int r = vb - l * 3008; const float* W; int ldw; bf16_t* Wt; int ldt, koff = 0, ntk = 16, mode = 0, nsub = 0;
    if (r < 1920) { W = q.w_in + (size_t)l * 1024 * 7680; ldw = 7680; mode = 1;
        if (r < 72 * 16) { Wt = q.WinT + (size_t)l * 7680 * 1024; ldt = 1024; }
        else { const int br = (r / 16 - 72) / 16; Wt = q.WmT + (size_t)l * 1024 * WMW_; ldt = WMW_; koff = br * 1024; nsub = 4608 + br * 1024; } }
    else if (r < 1984) { r -= 1920; W = q.wba + (size_t)l * 256 * 1024; ldw = 1024; Wt = q.WmT + (size_t)l * 1024 * WMW_; ldt = WMW_; koff = 3072; ntk = 4; }
    else if (r < 2112) { r -= 1984; W = q.wbb + (size_t)l * 512 * 1024; ldw = 1024; Wt = q.WmT + (size_t)l * 1024 * WMW_; ldt = WMW_; koff = 3072 + 256; ntk = 8; }
    else if (r < 2240) { r -= 2112; W = q.wbc + (size_t)l * 512 * 1024; ldw = 1024; Wt = q.WmT + (size_t)l * 1024 * WMW_; ldt = WMW_; koff = 3072 + 768; ntk = 8; }
    else if (r < 2496) { r -= 2240; W = q.w_out + (size_t)l * 1024 * 1024; ldw = 1024; Wt = q.WoutT + (size_t)l * 1024 * 1024; ldt = 1024; }
    else { r -= 2496; W = q.peer_wq + (size_t)l * 1024 * 2048; ldw = 2048; Wt = q.WqT + (size_t)l * 2048 * 1024; ldt = 1024; }
    const int n0 = (r / ntk) * 64, k0 = (r % ntk) * 64; const int c0 = mode ? (win_orig_col(n0) & ~63) : n0;
    bf16_t* tile = (bf16_t*)sm;
    { const int kk = t >> 2, cs = (t & 3) * 16; const float* src = W + (size_t)(k0 + kk) * ldw + c0 + cs;
#pragma unroll
        for (int i = 0; i < 16; i += 4) { const float4 v = *(const float4*)(src + i); tile[kk * 66 + cs + i] = f2bf(v.x); tile[kk * 66 + cs + i + 1] = f2bf(v.y); tile[kk * 66 + cs + i + 2] = f2bf(v.z); tile[kk * 66 + cs + i + 3] = f2bf(v.w); } }
    __syncthreads();
    { const int nn = t >> 2, ks = (t & 3) * 16; const int dl = mode ? (win_orig_col(n0 + nn) - c0) : nn; bf16_t* dst = Wt + (size_t)(n0 + nn - nsub) * ldt + koff + k0 + ks;
        unsigned w[8];
#pragma unroll
        for (int i = 0; i < 8; ++i) w[i] = (unsigned)tile[(ks + 2 * i) * 66 + dl] | ((unsigned)tile[(ks + 2 * i + 1) * 66 + dl] << 16);
        *(u32x4*)dst = (u32x4){w[0], w[1], w[2], w[3]}; *(u32x4*)(dst + 8) = (u32x4){w[4], w[5], w[6], w[7]}; }
}

namespace hy {
constexpr int ZS = 2064;
constexpr int G0_OFF = 0, G1_OFF = 8192, Z0_OFF = 16384, Z1_OFF = Z0_OFF + 16 * ZS * 2, LDS_END = Z1_OFF + 16 * ZS * 2;
DEV bf16x8 load_frag(LAS const unsigned char* lane_base, int d) {
    const LAS unsigned* p = (const LAS unsigned*)(lane_base + 32 * d); u32x4 w; w.x = p[0]; w.y = p[1]; w.z = p[2]; w.w = p[3];
    return __builtin_bit_cast(bf16x8, w);
}
DEV void load_filter(LAS unsigned char* lds, const bf16_t* g, int tid) {
    const u32x4 c = *(const u32x4*)(g + tid * 8); const unsigned nx = (tid < 511) ? (unsigned)g[tid * 8 + 8] : 0u;
    *(LAS u32x4*)(lds + G0_OFF + tid * 16) = c;
    u32x4 s; s.x = (c.x >> 16) | (c.y << 16); s.y = (c.y >> 16) | (c.z << 16); s.z = (c.z >> 16) | (c.w << 16); s.w = (c.w >> 16) | (nx << 16);
    *(LAS u32x4*)(lds + G1_OFF + tid * 16) = s;
}
DEV float bflo(unsigned w) { return __uint_as_float(w << 16); }
DEV float bfhi(unsigned w) { return __uint_as_float(w & 0xffff0000u); }
DEV void conv_rows(LAS const unsigned char* lds, int zoff, int w, int lane, f32x4 (&D)[16]) {
    const int r = lane & 15, q = lane >> 4;
    LAS const unsigned char* abase = lds + ((r & 1) ? (G0_OFF + 2 * (8 * q - r + 2047)) : (G1_OFF + 2 * (8 * q - r + 2046)));
    LAS const unsigned char* bbase = lds + zoff + (r * ZS + 8 * q) * 2;
    bf16x8 ring[16];
#pragma unroll
    for (int rb = 0; rb < 16; ++rb) D[rb] = (f32x4){0.f, 0.f, 0.f, 0.f};
#pragma unroll
    for (int rb = 2; rb < 16; ++rb) ring[rb] = load_frag(abase, -16 * w - rb);
#pragma unroll 1
    for (int jb0 = 0; jb0 < 64; jb0 += 8) {
#pragma unroll
        for (int u = 0; u < 8; ++u) { const int jb = jb0 + u;
            ring[(16 - 2 * u) & 15] = load_frag(abase, 2 * jb - 16 * w);
            ring[(17 - 2 * u) & 15] = load_frag(abase, 2 * jb - 16 * w - 1);
            const bf16x8 bf = *(const LAS bf16x8*)(bbase + 64 * jb);
#pragma unroll
            for (int rb = 0; rb < 16; ++rb) D[rb] = __builtin_amdgcn_mfma_f32_16x16x32_bf16(ring[(rb - 2 * u) & 15], bf, D[rb], 0, 0, 0);
        }
    }
}
DEV void sconv4(const bf16_t* in, int i, float w0, float w1, float w2, float cb, float (&o)[4]) {
    const u32x2 v = *(const u32x2*)(in + i); const float pm = (i > 0) ? bf2f(in[i - 1]) : 0.f, pn = (i + 4 < 2048) ? bf2f(in[i + 4]) : 0.f;
    const float x0 = bflo(v.x), x1 = bfhi(v.x), x2 = bflo(v.y), x3 = bfhi(v.y);
    o[0] = cb + w0 * pm + w1 * x0 + w2 * x1; o[1] = cb + w0 * x0 + w1 * x1 + w2 * x2; o[2] = cb + w0 * x1 + w1 * x2 + w2 * x3; o[3] = cb + w0 * x2 + w1 * x3 + w2 * pn;
}
DEV void hyena_phase(LAS unsigned char* lds, bf16_t* hyT, const bf16_t* Gr_l, const float* conv_w, const float* conv_b, const float* hy_bias, int G, int cblk) {
    int tid_ = threadIdx.x; asm volatile("" : "+v"(tid_));
    const int tid = tid_, w = __builtin_amdgcn_readfirstlane(tid >> 6), lane = tid & 63, q = lane >> 4, b = lane & 15;
#pragma unroll 1
    for (int c = cblk; c < 512; c += G) {
        __syncthreads();
        load_filter(lds, Gr_l + (size_t)c * 4096, tid);
        { const float w0 = conv_w[c], w1 = conv_w[1536 + c], w2 = conv_w[3072 + c], cb = conv_b[c]; const bf16_t* row = hyT + (size_t)c * T_;
#pragma unroll 2
            for (int k = 0; k < 8; ++k) { const int pos = (k * 512 + tid) * 8; const int s = pos & 2047, bb = pos >> 11;
                const u32x4 v = *(const u32x4*)(row + pos); const float pm = (s > 0) ? bf2f(row[pos - 1]) : 0.f, pn = (s + 8 < 2048) ? bf2f(row[pos + 8]) : 0.f;
                const float x[10] = {pm, bflo(v.x), bfhi(v.x), bflo(v.y), bfhi(v.y), bflo(v.z), bfhi(v.z), bflo(v.w), bfhi(v.w), pn};
                float z[8];
#pragma unroll
                for (int e = 0; e < 8; ++e) z[e] = cb + w0 * x[e] + w1 * x[e + 1] + w2 * x[e + 2];
                u32x4 o; o.x = pg8::cvt_pk_bf16(z[0], z[1]); o.y = pg8::cvt_pk_bf16(z[2], z[3]); o.z = pg8::cvt_pk_bf16(z[4], z[5]); o.w = pg8::cvt_pk_bf16(z[6], z[7]);
                *(LAS u32x4*)(lds + Z0_OFF + (bb * ZS + s) * 2) = o; } }
        __syncthreads();
        f32x4 D[16];
        conv_rows(lds, Z0_OFF, w, lane, D);
        { const int xc = 512 + c; const float w0 = conv_w[xc], w1 = conv_w[1536 + xc], w2 = conv_w[3072 + xc], cb = conv_b[xc], bias = hy_bias[c]; const bf16_t* xin = hyT + (size_t)xc * T_ + b * 2048;
#pragma unroll
            for (int rb = 0; rb < 16; ++rb) { const int i = 256 * w + 16 * rb + 4 * q; float xv[4]; sconv4(xin, i, w0, w1, w2, cb, xv);
                const u32x2 zq = *(const LAS u32x2*)(lds + Z0_OFF + (b * ZS + i) * 2); const float zv[4] = {bflo(zq.x), bfhi(zq.x), bflo(zq.y), bfhi(zq.y)};
                float o[4];
#pragma unroll
                for (int e = 0; e < 4; ++e) o[e] = xv[e] * (D[rb][e] + bias * zv[e]);
                u32x2 pk; pk.x = pg8::cvt_pk_bf16(o[0], o[1]); pk.y = pg8::cvt_pk_bf16(o[2], o[3]);
                *(LAS u32x2*)(lds + Z1_OFF + (b * ZS + i) * 2) = pk; } }
        __syncthreads();
        load_filter(lds, Gr_l + (size_t)(512 + c) * 4096, tid);
        __syncthreads();
        conv_rows(lds, Z1_OFF, w, lane, D);
        { const int xc = 1024 + c; const float w0 = conv_w[xc], w1 = conv_w[1536 + xc], w2 = conv_w[3072 + xc], cb = conv_b[xc], bias = hy_bias[512 + c]; const bf16_t* xin = hyT + (size_t)xc * T_ + b * 2048;
            bf16_t* yout = hyT + (size_t)c * T_ + b * 2048;
#pragma unroll
            for (int rb = 0; rb < 16; ++rb) { const int i = 256 * w + 16 * rb + 4 * q; float xv[4]; sconv4(xin, i, w0, w1, w2, cb, xv);
                const u32x2 zq = *(const LAS u32x2*)(lds + Z1_OFF + (b * ZS + i) * 2); const float zv[4] = {bflo(zq.x), bfhi(zq.x), bflo(zq.y), bfhi(zq.y)};
                float o[4];
#pragma unroll
                for (int e = 0; e < 4; ++e) o[e] = xv[e] * (D[rb][e] + bias * zv[e]);
                u32x2 pk; pk.x = pg8::cvt_pk_bf16(o[0], o[1]); pk.y = pg8::cvt_pk_bf16(o[2], o[3]);
                *(u32x2*)(yout + i) = pk; } }
    }
    __syncthreads();
}
}

namespace peer {
DEV float wave_sum(float v) {
#pragma unroll
    for (int off = 32; off > 0; off >>= 1) v += __shfl_xor(v, off);
    return v;
}
DEV float wave_max(float v) {
#pragma unroll
    for (int off = 32; off > 0; off >>= 1) v = fmaxf(v, __shfl_xor(v, off));
    return v;
}
DEV unsigned pk4_fp8(float a, float b, float c, float d) { int w = __builtin_amdgcn_cvt_pk_fp8_f32(a, b, 0, false); w = __builtin_amdgcn_cvt_pk_fp8_f32(c, d, w, true); return (unsigned)w; }
DEV void nb_quant_tables(int vb, int t, const float* __restrict__ pu, const float* __restrict__ pv, unsigned char* __restrict__ U8, unsigned char* __restrict__ V8, float* __restrict__ sinv) {
    const int row = vb * 4 + (t >> 6), lane = t & 63; const float* src = (row < 16384) ? pu + (size_t)row * 1024 : pv + (size_t)(row - 16384) * 1024;
    const float4 a = *(const float4*)(src + 16 * lane), b = *(const float4*)(src + 16 * lane + 4), c = *(const float4*)(src + 16 * lane + 8), d = *(const float4*)(src + 16 * lane + 12);
    float mx = fmaxf(fmaxf(fmaxf(fabsf(a.x), fabsf(a.y)), fmaxf(fabsf(a.z), fabsf(a.w))), fmaxf(fmaxf(fabsf(b.x), fabsf(b.y)), fmaxf(fabsf(b.z), fabsf(b.w))));
    mx = fmaxf(mx, fmaxf(fmaxf(fmaxf(fabsf(c.x), fabsf(c.y)), fmaxf(fabsf(c.z), fabsf(c.w))), fmaxf(fmaxf(fabsf(d.x), fabsf(d.y)), fmaxf(fabsf(d.z), fabsf(d.w)))));
    mx = wave_max(mx); const float sc = (mx > 0.f) ? 224.f / mx : 1.f;
    u32x4 o; o.x = pk4_fp8(a.x * sc, a.y * sc, a.z * sc, a.w * sc); o.y = pk4_fp8(b.x * sc, b.y * sc, b.z * sc, b.w * sc); o.z = pk4_fp8(c.x * sc, c.y * sc, c.z * sc, c.w * sc); o.w = pk4_fp8(d.x * sc, d.y * sc, d.z * sc, d.w * sc);
    unsigned char* dst = (row < 16384) ? U8 + (size_t)row * 1024 : V8 + (size_t)(row - 16384) * 1024;
    *(u32x4*)(dst + 16 * lane) = o;
    if (lane == 0) sinv[row] = (mx > 0.f) ? mx * (1.f / 224.f) : 1.f;
}
DEV void peer_phase(LAS unsigned char* lds, float* xio, const float* ada_l, const int* __restrict__ eidx, const float* __restrict__ egate, const unsigned char* __restrict__ U8, const unsigned char* __restrict__ V8,
                    const float* __restrict__ sinv, const float* __restrict__ g, const float* __restrict__ bta, const float* ada_next, bf16_t* UY, int G, int cblk) {
    int tid_ = threadIdx.x; asm volatile("" : "+v"(tid_));
    const int tid = tid_, w = __builtin_amdgcn_readfirstlane(tid >> 6), lane = tid & 63, q = lane >> 4, n = lane & 15;
    LAS unsigned char* urow_l = lds + w * 1024;
    const int d0 = 16 * lane;
#pragma unroll 1
    for (int tok = cblk * 8 + w; tok < T_; tok += G * 8) {
        const float* a = ada_l + (size_t)(tok >> 11) * 6144; float* xr = xio + (size_t)tok * 1024 + d0;
        float x1[16];
#pragma unroll
        for (int j = 0; j < 16; j += 4) { const float4 v = *(const float4*)(xr + j); x1[j] = v.x; x1[j + 1] = v.y; x1[j + 2] = v.z; x1[j + 3] = v.w; }
        float stinv;
        { float u[16]; float um = 0.f;
#pragma unroll
            for (int j = 0; j < 16; j += 4) { const float4 sc = *(const float4*)(a + 4096 + d0 + j), sh = *(const float4*)(a + 3072 + d0 + j);
                u[j] = x1[j] * (1.f + sc.x) + sh.x; u[j + 1] = x1[j + 1] * (1.f + sc.y) + sh.y; u[j + 2] = x1[j + 2] * (1.f + sc.z) + sh.z; u[j + 3] = x1[j + 3] * (1.f + sc.w) + sh.w;
                um = fmaxf(um, fmaxf(fmaxf(fabsf(u[j]), fabsf(u[j + 1])), fmaxf(fabsf(u[j + 2]), fabsf(u[j + 3])))); }
            um = wave_max(um); const float st = (um > 0.f) ? 224.f / um : 1.f; stinv = (um > 0.f) ? um * (1.f / 224.f) : 1.f;
            u32x4 pq; pq.x = pk4_fp8(u[0] * st, u[1] * st, u[2] * st, u[3] * st); pq.y = pk4_fp8(u[4] * st, u[5] * st, u[6] * st, u[7] * st);
            pq.z = pk4_fp8(u[8] * st, u[9] * st, u[10] * st, u[11] * st); pq.w = pk4_fp8(u[12] * st, u[13] * st, u[14] * st, u[15] * st);
            *(LAS u32x4*)(urow_l + d0) = pq; }
        int E[8]; float wg[8];
#pragma unroll
        for (int gi = 0; gi < 8; ++gi) { E[gi] = eidx[(size_t)tok * 128 + gi * 16 + n]; wg[gi] = egate[(size_t)tok * 128 + gi * 16 + n]; }
        asm volatile("s_waitcnt lgkmcnt(0)" ::: "memory");
#pragma unroll 2
        for (int gi = 0; gi < 8; ++gi) { const unsigned char* ur = U8 + (size_t)E[gi] * 1024 + 16 * q; const float su = sinv[E[gi]], sv = sinv[16384 + E[gi]]; f32x4 acc = (f32x4){0.f, 0.f, 0.f, 0.f};
#pragma unroll
            for (int k2 = 0; k2 < 16; ++k2) { const u32x4 bw = *(const u32x4*)(ur + 64 * k2); const u32x4 aw = *(const LAS u32x4*)(urow_l + 64 * k2 + 16 * q);
                const long a0 = (long)(((unsigned long long)aw.y << 32) | aw.x), a1 = (long)(((unsigned long long)aw.w << 32) | aw.z);
                const long b0 = (long)(((unsigned long long)bw.y << 32) | bw.x), b1 = (long)(((unsigned long long)bw.w << 32) | bw.z);
                acc = __builtin_amdgcn_mfma_f32_16x16x32_fp8_fp8(a0, b0, acc, 0, 0, 0); acc = __builtin_amdgcn_mfma_f32_16x16x32_fp8_fp8(a1, b1, acc, 0, 0, 0); }
            const float dsum = acc[0] * (su * stinv); wg[gi] = wg[gi] * 0.5f * dsum * (1.f + erff(dsum * 0.70710678118654752f)) * sv; }
        float o[16];
#pragma unroll
        for (int j = 0; j < 16; ++j) o[j] = 0.f;
#pragma unroll
        for (int gi = 0; gi < 8; ++gi) {
#pragma unroll 8
            for (int n2 = 0; n2 < 16; ++n2) { const int e = __builtin_amdgcn_readlane(E[gi], n2); const float wt = __builtin_bit_cast(float, __builtin_amdgcn_readlane(__builtin_bit_cast(int, wg[gi]), n2));
                const u32x4 v = *(const u32x4*)(V8 + (size_t)e * 1024 + d0);
                const f32x2 f0 = __builtin_amdgcn_cvt_pk_f32_fp8((int)v.x, false), f1 = __builtin_amdgcn_cvt_pk_f32_fp8((int)v.x, true), f2 = __builtin_amdgcn_cvt_pk_f32_fp8((int)v.y, false), f3 = __builtin_amdgcn_cvt_pk_f32_fp8((int)v.y, true);
                const f32x2 f4 = __builtin_amdgcn_cvt_pk_f32_fp8((int)v.z, false), f5 = __builtin_amdgcn_cvt_pk_f32_fp8((int)v.z, true), f6 = __builtin_amdgcn_cvt_pk_f32_fp8((int)v.w, false), f7 = __builtin_amdgcn_cvt_pk_f32_fp8((int)v.w, true);
                o[0] += wt * f0[0]; o[1] += wt * f0[1]; o[2] += wt * f1[0]; o[3] += wt * f1[1]; o[4] += wt * f2[0]; o[5] += wt * f2[1]; o[6] += wt * f3[0]; o[7] += wt * f3[1];
                o[8] += wt * f4[0]; o[9] += wt * f4[1]; o[10] += wt * f5[0]; o[11] += wt * f5[1]; o[12] += wt * f6[0]; o[13] += wt * f6[1]; o[14] += wt * f7[0]; o[15] += wt * f7[1]; }
        }
        float hv[16]; float s = 0.f;
#pragma unroll
        for (int j = 0; j < 16; j += 4) { const float4 g2 = *(const float4*)(a + 5120 + d0 + j);
            hv[j] = ALPHA_ * x1[j] + g2.x * o[j]; hv[j + 1] = ALPHA_ * x1[j + 1] + g2.y * o[j + 1]; hv[j + 2] = ALPHA_ * x1[j + 2] + g2.z * o[j + 2]; hv[j + 3] = ALPHA_ * x1[j + 3] + g2.w * o[j + 3];
            s += (hv[j] + hv[j + 1]) + (hv[j + 2] + hv[j + 3]); }
        const float mu = wave_sum(s) * (1.f / 1024.f); float qq = 0.f;
#pragma unroll
        for (int j = 0; j < 16; ++j) { const float dd = hv[j] - mu; qq += dd * dd; }
        const float rstd = rsqrtf(wave_sum(qq) * (1.f / 1024.f) + LN_EPS_);
        const float* an = ada_next ? ada_next + (size_t)(tok >> 11) * 6144 : nullptr;
        float y[16];
#pragma unroll
        for (int j = 0; j < 16; j += 4) { const float4 gg = *(const float4*)(g + d0 + j), bb = *(const float4*)(bta + d0 + j);
            y[j] = (hv[j] - mu) * rstd * gg.x + bb.x; y[j + 1] = (hv[j + 1] - mu) * rstd * gg.y + bb.y; y[j + 2] = (hv[j + 2] - mu) * rstd * gg.z + bb.z; y[j + 3] = (hv[j + 3] - mu) * rstd * gg.w + bb.w;
            *(float4*)(xr + j) = make_float4(y[j], y[j + 1], y[j + 2], y[j + 3]); }
        if (an) { float uu[16];
#pragma unroll
            for (int j = 0; j < 16; j += 4) { const float4 sc = *(const float4*)(an + 1024 + d0 + j), sh = *(const float4*)(an + d0 + j);
                uu[j] = y[j] * (1.f + sc.x) + sh.x; uu[j + 1] = y[j + 1] * (1.f + sc.y) + sh.y; uu[j + 2] = y[j + 2] * (1.f + sc.z) + sh.z; uu[j + 3] = y[j + 3] * (1.f + sc.w) + sh.w; }
            u32x4 p0, p1; p0.x = pg8::cvt_pk_bf16(uu[0], uu[1]); p0.y = pg8::cvt_pk_bf16(uu[2], uu[3]); p0.z = pg8::cvt_pk_bf16(uu[4], uu[5]); p0.w = pg8::cvt_pk_bf16(uu[6], uu[7]);
            p1.x = pg8::cvt_pk_bf16(uu[8], uu[9]); p1.y = pg8::cvt_pk_bf16(uu[10], uu[11]); p1.z = pg8::cvt_pk_bf16(uu[12], uu[13]); p1.w = pg8::cvt_pk_bf16(uu[14], uu[15]);
            bf16_t* up = UY + (size_t)tok * UYW_ + d0; *(u32x4*)up = p0; *(u32x4*)(up + 8) = p1; }
    }
    __syncthreads();
}
}

namespace tk {
typedef float f32x16 __attribute__((ext_vector_type(16)));
constexpr int KROW = 272;
DEV unsigned sortable(float v) { const unsigned u = __float_as_uint(v); return u ^ ((unsigned)((int)u >> 31) | 0x80000000u); }
DEV float unsortable(unsigned k) { return __uint_as_float(k ^ ((~(unsigned)((int)k >> 31)) | 0x80000000u)); }
DEV unsigned umax_(unsigned a, unsigned b) { return a > b ? a : b; }
DEV unsigned umin_(unsigned a, unsigned b) { return a < b ? a : b; }
#define CE(x, y) { const unsigned hi_ = umax_(a[x], a[y]), lo_ = umin_(a[x], a[y]); a[x] = hi_; a[y] = lo_; }
DEV void sort16(unsigned (&a)[16]) {
    CE(0, 1); CE(3, 2); CE(4, 5); CE(7, 6); CE(8, 9); CE(11, 10); CE(12, 13); CE(15, 14); CE(0, 2); CE(1, 3); CE(6, 4); CE(7, 5); CE(8, 10); CE(9, 11); CE(14, 12); CE(15, 13); CE(0, 1); CE(2, 3); CE(5, 4); CE(7, 6); CE(8, 9); CE(10, 11); CE(13, 12); CE(15, 14); CE(0, 4); CE(1, 5); CE(2, 6); CE(3, 7); CE(12, 8); CE(13, 9); CE(14, 10); CE(15, 11); CE(0, 2); CE(1, 3); CE(4, 6); CE(5, 7); CE(10, 8); CE(11, 9); CE(14, 12); CE(15, 13); CE(0, 1); CE(2, 3); CE(4, 5); CE(6, 7); CE(9, 8); CE(11, 10); CE(13, 12); CE(15, 14); CE(0, 8); CE(1, 9); CE(2, 10); CE(3, 11); CE(4, 12); CE(5, 13); CE(6, 14); CE(7, 15); CE(0, 4); CE(1, 5); CE(2, 6); CE(3, 7); CE(8, 12); CE(9, 13); CE(10, 14); CE(11, 15); CE(0, 2); CE(1, 3); CE(4, 6); CE(5, 7); CE(8, 10); CE(9, 11); CE(12, 14); CE(13, 15); CE(0, 1); CE(2, 3); CE(4, 5); CE(6, 7); CE(8, 9); CE(10, 11); CE(12, 13); CE(14, 15);
}
DEV void bmerge16(unsigned (&a)[16]) {
    CE(0, 8); CE(1, 9); CE(2, 10); CE(3, 11); CE(4, 12); CE(5, 13); CE(6, 14); CE(7, 15); CE(0, 4); CE(1, 5); CE(2, 6); CE(3, 7); CE(8, 12); CE(9, 13); CE(10, 14); CE(11, 15); CE(0, 2); CE(1, 3); CE(4, 6); CE(5, 7); CE(8, 10); CE(9, 11); CE(12, 14); CE(13, 15); CE(0, 1); CE(2, 3); CE(4, 5); CE(6, 7); CE(8, 9); CE(10, 11); CE(12, 13); CE(14, 15);
}
#undef CE
DEV void top_merge(unsigned (&a)[16], const unsigned (&b)[16]) {
#pragma unroll
    for (int i = 0; i < 16; ++i) a[i] = umax_(a[i], b[15 - i]);
    bmerge16(a);
}
DEV void xlane_merge(unsigned (&a)[16]) {
    unsigned b[16];
#pragma unroll
    for (int i = 0; i < 16; ++i) b[i] = (unsigned)__shfl_xor((int)a[i], 32);
    top_merge(a, b);
}
DEV unsigned lookup_idx(unsigned long long lo, unsigned long long hi, int a) { const unsigned long long wv = (a < 8) ? lo : hi; return (unsigned)(wv >> ((a & 7) * 8)) & 127u; }
DEV unsigned blendu(unsigned m, unsigned a, unsigned b) { return (a & ~m) | (b & m); }
DEV float blendf(unsigned m, float a, float b) { return __uint_as_float((__float_as_uint(a) & ~m) | (__float_as_uint(b) & m)); }

DEV void topk_phase(LAS unsigned char* lds, const bf16_t* __restrict__ Q2, const float* __restrict__ keys_l, int* __restrict__ eidx, float* __restrict__ egate, int G, int cblk) {
    int tid_ = threadIdx.x; asm volatile("" : "+v"(tid_));
    const int tid = tid_, w = __builtin_amdgcn_readfirstlane(tid >> 6), lane = tid & 63, tl = lane & 31, hh = lane >> 5;
    asm volatile("" : "+s"(G));
    const bool by_head = (G & 7) == 0;
#pragma unroll 1
    for (int h = 0; h < 8; ++h) {
        if (by_head && h != (cblk & 7)) continue;
        __syncthreads();
        {
            const int r = tid >> 1, c0 = (tid & 1) * 64; const float* src = keys_l + ((size_t)h * 256 + r) * 128 + c0; LAS unsigned char* dst = lds + r * KROW + c0 * 2;
#pragma unroll
            for (int j = 0; j < 64; j += 8) { const float4 a = *(const float4*)(src + j), b = *(const float4*)(src + j + 4);
                u32x4 o; o.x = pg8::cvt_pk_bf16(a.x, a.y); o.y = pg8::cvt_pk_bf16(a.z, a.w); o.z = pg8::cvt_pk_bf16(b.x, b.y); o.w = pg8::cvt_pk_bf16(b.z, b.w); *(LAS u32x4*)(dst + j * 2) = o; }
        }
        __syncthreads();
        const int first = by_head ? (cblk >> 3) * 8 + w : cblk * 8 + w, stride = by_head ? (G >> 3) * 8 : G * 8;
#pragma unroll 1
        for (int blk = first; blk < T_ / 32; blk += stride) {
            const int tok = blk * 32 + tl; const bf16_t* qrow = Q2 + (size_t)tok * 2048 + h * 256 + 8 * hh;
            unsigned L[2][16];
#pragma unroll
            for (int p = 0; p < 2; ++p) {
                bf16x8 bq[8];
#pragma unroll
                for (int ks = 0; ks < 8; ++ks) bq[ks] = *(const bf16x8*)(qrow + p * 128 + 16 * ks);
#pragma unroll
                for (int t = 0; t < 4; ++t) {
                    f32x16 acc;
#pragma unroll
                    for (int e = 0; e < 16; ++e) acc[e] = 0.f;
#pragma unroll
                    for (int ks = 0; ks < 8; ++ks) { const bf16x8 ak = *(const LAS bf16x8*)(lds + (p * 128 + 32 * t + tl) * KROW + (16 * ks + 8 * hh) * 2);
                        acc = __builtin_amdgcn_mfma_f32_32x32x16_bf16(ak, bq[ks], acc, 0, 0, 0); }
                    unsigned K[16];
#pragma unroll
                    for (int e = 0; e < 16; ++e) K[e] = (sortable(acc[e]) & ~127u) | (unsigned)((127 - 32 * t - (e & 3) - 8 * (e >> 2)) - 4 * hh);
                    sort16(K);
                    if (t == 0) {
#pragma unroll
                        for (int e = 0; e < 16; ++e) L[p][e] = K[e];
                    } else top_merge(L[p], K);
                    __builtin_amdgcn_sched_barrier(0);
                }
                xlane_merge(L[p]);
                __builtin_amdgcn_sched_barrier(0);
            }
            float f1[16], f2[16];
#pragma unroll
            for (int e = 0; e < 16; ++e) { f1[e] = unsortable(L[0][e] & ~127u); f2[e] = unsortable(L[1][e] & ~127u); }
            unsigned hm = 0u - (unsigned)hh; asm volatile("" : "+v"(hm));
            unsigned C[2][16];
            C[0][0] = (sortable(blendf(hm, f1[0], f1[2]) + blendf(hm, f2[0], f2[1])) & ~255u) | (255u - blendu(hm, 0u, 33u));
            C[0][1] = (sortable(blendf(hm, f1[0], f1[2]) + blendf(hm, f2[1], f2[2])) & ~255u) | (255u - blendu(hm, 1u, 34u));
            C[0][2] = (sortable(blendf(hm, f1[0], f1[2]) + blendf(hm, f2[2], f2[3])) & ~255u) | (255u - blendu(hm, 2u, 35u));
            C[0][3] = (sortable(blendf(hm, f1[0], f1[2]) + blendf(hm, f2[3], f2[4])) & ~255u) | (255u - blendu(hm, 3u, 36u));
            C[0][4] = (sortable(blendf(hm, f1[0], f1[3]) + blendf(hm, f2[4], f2[0])) & ~255u) | (255u - blendu(hm, 4u, 48u));
            C[0][5] = (sortable(blendf(hm, f1[0], f1[3]) + blendf(hm, f2[5], f2[1])) & ~255u) | (255u - blendu(hm, 5u, 49u));
            C[0][6] = (sortable(blendf(hm, f1[0], f1[3]) + blendf(hm, f2[6], f2[2])) & ~255u) | (255u - blendu(hm, 6u, 50u));
            C[0][7] = (sortable(blendf(hm, f1[0], f1[3]) + blendf(hm, f2[7], f2[3])) & ~255u) | (255u - blendu(hm, 7u, 51u));
            C[0][8] = (sortable(blendf(hm, f1[0], f1[4]) + blendf(hm, f2[8], f2[0])) & ~255u) | (255u - blendu(hm, 8u, 64u));
            C[0][9] = (sortable(blendf(hm, f1[0], f1[4]) + blendf(hm, f2[9], f2[1])) & ~255u) | (255u - blendu(hm, 9u, 65u));
            C[0][10] = (sortable(blendf(hm, f1[0], f1[4]) + blendf(hm, f2[10], f2[2])) & ~255u) | (255u - blendu(hm, 10u, 66u));
            C[0][11] = (sortable(blendf(hm, f1[0], f1[5]) + blendf(hm, f2[11], f2[0])) & ~255u) | (255u - blendu(hm, 11u, 80u));
            C[0][12] = (sortable(blendf(hm, f1[0], f1[5]) + blendf(hm, f2[12], f2[1])) & ~255u) | (255u - blendu(hm, 12u, 81u));
            C[0][13] = (sortable(blendf(hm, f1[0], f1[6]) + blendf(hm, f2[13], f2[0])) & ~255u) | (255u - blendu(hm, 13u, 96u));
            C[0][14] = (sortable(blendf(hm, f1[0], f1[6]) + blendf(hm, f2[14], f2[1])) & ~255u) | (255u - blendu(hm, 14u, 97u));
            C[0][15] = (sortable(blendf(hm, f1[0], f1[7]) + blendf(hm, f2[15], f2[0])) & ~255u) | (255u - blendu(hm, 15u, 112u));
            C[1][0] = (sortable(blendf(hm, f1[1], f1[7]) + blendf(hm, f2[0], f2[1])) & ~255u) | (255u - blendu(hm, 16u, 113u));
            C[1][1] = (sortable(blendf(hm, f1[1], f1[8]) + blendf(hm, f2[1], f2[0])) & ~255u) | (255u - blendu(hm, 17u, 128u));
            C[1][2] = (sortable(blendf(hm, f1[1], f1[9]) + blendf(hm, f2[2], f2[0])) & ~255u) | (255u - blendu(hm, 18u, 144u));
            C[1][3] = (sortable(blendf(hm, f1[1], f1[10]) + blendf(hm, f2[3], f2[0])) & ~255u) | (255u - blendu(hm, 19u, 160u));
            C[1][4] = (sortable(blendf(hm, f1[1], f1[11]) + blendf(hm, f2[4], f2[0])) & ~255u) | (255u - blendu(hm, 20u, 176u));
            C[1][5] = (sortable(blendf(hm, f1[1], f1[12]) + blendf(hm, f2[5], f2[0])) & ~255u) | (255u - blendu(hm, 21u, 192u));
            C[1][6] = (sortable(blendf(hm, f1[1], f1[13]) + blendf(hm, f2[6], f2[0])) & ~255u) | (255u - blendu(hm, 22u, 208u));
            C[1][7] = (sortable(blendf(hm, f1[1], f1[14]) + blendf(hm, f2[7], f2[0])) & ~255u) | (255u - blendu(hm, 23u, 224u));
            C[1][8] = (sortable(blendf(hm, f1[2], f1[15]) + blendf(hm, f2[0], f2[0])) & ~255u) | (255u - blendu(hm, 32u, 240u));
            C[1][9] = 0u;
            C[1][10] = 0u;
            C[1][11] = 0u;
            C[1][12] = 0u;
            C[1][13] = 0u;
            C[1][14] = 0u;
            C[1][15] = 0u;
            sort16(C[0]); sort16(C[1]); top_merge(C[0], C[1]); xlane_merge(C[0]);
            unsigned long long p1lo = 0ull, p1hi = 0ull, p2lo = 0ull, p2hi = 0ull;
#pragma unroll
            for (int m = 0; m < 8; ++m) { p1lo |= (unsigned long long)(127u - (L[0][m] & 127u)) << (8 * m); p1hi |= (unsigned long long)(127u - (L[0][8 + m] & 127u)) << (8 * m);
                p2lo |= (unsigned long long)(127u - (L[1][m] & 127u)) << (8 * m); p2hi |= (unsigned long long)(127u - (L[1][8 + m] & 127u)) << (8 * m); }
            float val[16]; unsigned ex[16]; float sum = 0.f;
#pragma unroll
            for (int k = 0; k < 16; ++k) { const unsigned flat = 255u - (C[0][k] & 255u); const int a = (int)(flat >> 4), b = (int)(flat & 15u);
                val[k] = unsortable(C[0][k] & ~255u); ex[k] = lookup_idx(p1lo, p1hi, a) * 128u + lookup_idx(p2lo, p2hi, b); }
            const float mx = val[0];
#pragma unroll
            for (int k = 0; k < 16; ++k) { val[k] = __expf(val[k] - mx); sum += val[k]; }
            const float inv = 1.f / sum;
            int eo[8]; float go[8];
#pragma unroll
            for (int k = 0; k < 8; ++k) { eo[k] = (int)blendu(hm, ex[k], ex[8 + k]); go[k] = blendf(hm, val[k], val[8 + k]) * inv; }
            const size_t ob = ((size_t)tok * 8 + h) * 16 + 8 * hh;
            *(int4*)(eidx + ob) = make_int4(eo[0], eo[1], eo[2], eo[3]); *(int4*)(eidx + ob + 4) = make_int4(eo[4], eo[5], eo[6], eo[7]);
            *(float4*)(egate + ob) = make_float4(go[0], go[1], go[2], go[3]); *(float4*)(egate + ob + 4) = make_float4(go[4], go[5], go[6], go[7]);
        }
    }
    __syncthreads();
}
}

namespace at {
typedef float f32x16 __attribute__((ext_vector_type(16)));
constexpr int KROWB = 144, VROWB = 776, K_OFF = 0, V_OFF = 384 * KROWB, LDS_END = V_OFF + 64 * VROWB;
constexpr int N_ITEMS_A = 16 * 12 * 8, N_ITEMS_C = 16 * 2 * 16 * 2;

struct Band { int p_w, ls, R, slot_base; };
DEV void chunk(LAS const unsigned char* lds, const Band& bd, int c, const bf16x8 (&qf)[4], int tl, int hh, f32x16 (&O)[2], float& m, float& l) {
    const int kp0 = bd.p_w - bd.R + 32 * c;
    if (kp0 + 31 < 0 || kp0 >= bd.ls) return;
    const int s0 = kp0 + bd.slot_base;
    f32x16 S;
#pragma unroll
    for (int e = 0; e < 16; ++e) S[e] = 0.f;
#pragma unroll
    for (int ks = 0; ks < 4; ++ks) { const bf16x8 ak = *(const LAS bf16x8*)(lds + K_OFF + (s0 + tl) * KROWB + (16 * ks + 8 * hh) * 2); S = __builtin_amdgcn_mfma_f32_32x32x16_bf16(ak, qf[ks], S, 0, 0, 0); }
    const int dbase = (32 * c - bd.R) - tl + 4 * hh;
    const int kb = kp0 + 4 * hh;
    float cmax = -1e30f;
#pragma unroll
    for (int e = 0; e < 16; ++e) { const int ro = (e & 3) + 8 * (e >> 2); const int diff = dbase + ro, kp = kb + ro;
        const bool ok = (diff <= bd.R) && (diff >= -bd.R) && (kp >= 0) && (kp < bd.ls); S[e] = ok ? S[e] : -1e30f; cmax = fmaxf(cmax, S[e]); }
    cmax = fmaxf(cmax, __shfl_xor(cmax, 32));
    const float mn = fmaxf(m, cmax), alpha = exp2f(m - mn); m = mn;
    float psum = 0.f;
#pragma unroll
    for (int e = 0; e < 16; ++e) { S[e] = exp2f(S[e] - mn); psum += S[e]; }
    l = l * alpha + psum;
#pragma unroll
    for (int e = 0; e < 16; ++e) { O[0][e] *= alpha; O[1][e] *= alpha; }
#pragma unroll
    for (int sx = 0; sx < 2; ++sx) {
        u32x4 pw; pw.x = pg8::cvt_pk_bf16(S[8 * sx + 0], S[8 * sx + 1]); pw.y = pg8::cvt_pk_bf16(S[8 * sx + 2], S[8 * sx + 3]); pw.z = pg8::cvt_pk_bf16(S[8 * sx + 4], S[8 * sx + 5]); pw.w = pg8::cvt_pk_bf16(S[8 * sx + 6], S[8 * sx + 7]);
        const bf16x8 pb = __builtin_bit_cast(bf16x8, pw);
#pragma unroll
        for (int dt = 0; dt < 2; ++dt) { LAS const unsigned char* vp = lds + V_OFF + (32 * dt + tl) * VROWB + (s0 + 16 * sx + 4 * hh) * 2;
            const u32x2 lo = *(const LAS u32x2*)vp, hi = *(const LAS u32x2*)(vp + 16); const u32x4 vw = (u32x4){lo.x, lo.y, hi.x, hi.y};
            O[dt] = __builtin_amdgcn_mfma_f32_32x32x16_bf16(__builtin_bit_cast(bf16x8, vw), pb, O[dt], 0, 0, 0); }
    }
}
DEV void attn_phase(LAS unsigned char* lds, bf16_t* P, float* lse2, bf16_t* Y, const float* sink_l, int G, int cblk) {
    int tid_ = threadIdx.x; asm volatile("" : "+v"(tid_));
    const int tid = tid_, w = __builtin_amdgcn_readfirstlane(tid >> 6), lane = tid & 63, tl = lane & 31, hh = lane >> 5;
#pragma unroll 1
    for (int item = cblk; item < N_ITEMS_A + N_ITEMS_C; item += G) {
        int b, dil, ls, r, klo, nsl, R, kcol, vcol, qcol, two = 0, rp = 0, sb = 0, head = 0, isC = 0, nb = 0, qh0 = 0;
        if (item < N_ITEMS_A) { b = item / 96; const int rem = item - b * 96; head = rem >> 3; const int sub = rem & 7, g = head >> 2; R = 64;
            kcol = 768 + head * 64; vcol = 1536 + head * 64; qcol = head * 64;
            if (g == 0) { dil = 1; ls = 2048; r = 0; sb = sub; klo = 256 * sb - 64; nsl = 384; }
            else if (g == 1) { dil = 4; ls = 512; r = sub >> 1; sb = sub & 1; klo = 256 * sb - 64; nsl = 384; }
            else { dil = 16; ls = 128; r = 0; rp = sub; klo = 0; nsl = 256; two = 1; } }
        else { const int it = item - N_ITEMS_A; b = it >> 6; const int rem = it & 63; const int kvh = rem >> 5; nb = (rem & 31) >> 1; const int hp = rem & 1; isC = 1; R = 128;
            dil = 1; ls = 2048; r = 0; klo = 128 * nb - 128; nsl = 384; kcol = 2816 + kvh * 64; vcol = 2944 + kvh * 64; qh0 = kvh * 4 + hp * 2; qcol = 2304 + qh0 * 64; }
        __syncthreads();
        for (int i = tid; i < nsl * 8; i += 512) { const int slot = i >> 3, part = i & 7; int kpos, rr;
            if (two) { kpos = slot & 127; rr = 2 * rp + (slot >> 7); } else { kpos = klo + slot; rr = r; }
            u32x4 kv = (u32x4){0u, 0u, 0u, 0u}, vv = kv;
            if (kpos >= 0 && kpos < ls) { const bf16_t* rowp = P + (size_t)(b * 2048 + kpos * dil + rr) * PW_; kv = *(const u32x4*)(rowp + kcol + part * 8); vv = *(const u32x4*)(rowp + vcol + part * 8); }
            *(LAS u32x4*)(lds + K_OFF + slot * KROWB + part * 16) = kv;
            LAS unsigned short* vt = (LAS unsigned short*)(lds + V_OFF + (part * 8) * VROWB + slot * 2);
            vt[0 * (VROWB / 2)] = (unsigned short)(vv.x & 0xffffu); vt[1 * (VROWB / 2)] = (unsigned short)(vv.x >> 16); vt[2 * (VROWB / 2)] = (unsigned short)(vv.y & 0xffffu); vt[3 * (VROWB / 2)] = (unsigned short)(vv.y >> 16);
            vt[4 * (VROWB / 2)] = (unsigned short)(vv.z & 0xffffu); vt[5 * (VROWB / 2)] = (unsigned short)(vv.z >> 16); vt[6 * (VROWB / 2)] = (unsigned short)(vv.w & 0xffffu); vt[7 * (VROWB / 2)] = (unsigned short)(vv.w >> 16); }
        __syncthreads();
        Band bd; int qtok, rr = r; bd.ls = ls; bd.R = R;
        if (two) { const int half = w >> 2; bd.p_w = 32 * (w & 3); rr = 2 * rp + half; bd.slot_base = half * 128; }
        else if (isC) { bd.p_w = 128 * nb + 32 * (w & 3); bd.slot_base = -klo; }
        else { bd.p_w = 256 * sb + 32 * w; bd.slot_base = -klo; }
        qtok = b * 2048 + (bd.p_w + tl) * dil + rr;
        const int qc = isC ? (qcol + (w >> 2) * 64) : qcol;
        const bf16_t* qp = P + (size_t)qtok * PW_ + qc + 8 * hh;
        bf16x8 qf[4];
#pragma unroll
        for (int ks = 0; ks < 4; ++ks) qf[ks] = *(const bf16x8*)(qp + 16 * ks);
        f32x16 O[2];
#pragma unroll
        for (int e = 0; e < 16; ++e) { O[0][e] = 0.f; O[1][e] = 0.f; }
        float m = -1e30f, l = 0.f;
        const int nch = R / 16 + 1, cd = R / 32;
        chunk(lds, bd, cd, qf, tl, hh, O, m, l);
#pragma unroll 1
        for (int c = 0; c < nch; ++c) { if (c != cd) chunk(lds, bd, c, qf, tl, hh, O, m, l); }
        float lt = l + __shfl_xor(l, 32), scale;
        if (isC) { const float sk = sink_l[qh0 + (w >> 2)] * LOG2E_; const float mf = fmaxf(m, sk), corr = exp2f(m - mf); lt = lt * corr + exp2f(sk - mf); scale = corr / lt; }
        else { scale = 1.f / lt; if (hh == 0) lse2[(size_t)qtok * 12 + head] = m + log2f(lt); }
        bf16_t* op = isC ? (Y + (size_t)qtok * UYW_ + 768 + (qh0 + (w >> 2)) * 64) : (P + (size_t)qtok * PW_ + qcol);
#pragma unroll
        for (int dt = 0; dt < 2; ++dt)
#pragma unroll
            for (int g4 = 0; g4 < 4; ++g4) { u32x2 pk; pk.x = pg8::cvt_pk_bf16(O[dt][4 * g4] * scale, O[dt][4 * g4 + 1] * scale); pk.y = pg8::cvt_pk_bf16(O[dt][4 * g4 + 2] * scale, O[dt][4 * g4 + 3] * scale);
                *(u32x2*)(op + 32 * dt + 8 * g4 + 4 * hh) = pk; }
    }
    __syncthreads();
}
}

namespace xb {
constexpr int XB_TMO = 128, XB_TOP = 3328, XB_TOPGEN = 3392, XCD_BAR_WORDS = 3456; constexpr unsigned XB_SPIN_CAP = 1u << 22;
DEV constexpr int XB_XCNT(int j) { return 256 + 64 * j; }
DEV constexpr int XB_XSUB(int j) { return 1280 + 64 * j; }
DEV constexpr int XB_XGEN(int j) { return 2304 + 64 * j; }
DEV unsigned xb_ld(unsigned* p) { return __hip_atomic_load(p, __ATOMIC_RELAXED, __HIP_MEMORY_SCOPE_AGENT); }
DEV unsigned xb_add(unsigned* p, unsigned v) { return __hip_atomic_fetch_add(p, v, __ATOMIC_RELAXED, __HIP_MEMORY_SCOPE_AGENT); }
DEV unsigned xb_xcc_id() { return (unsigned)__builtin_amdgcn_s_getreg((3 << 11) | 20) & 0xFu; }
#define XB_SPIN(cond, bar) do { unsigned _sp = 0; while (cond) { __builtin_amdgcn_s_sleep(1); \
    if ((++_sp & 255u) == 0u) { if (xb_ld(&(bar)[XB_TMO])) break; if (_sp > XB_SPIN_CAP) { atomicAdd(&(bar)[XB_TMO], 1u); break; } } } } while (0)
struct XcdBarrier { unsigned* bar; unsigned x; volatile LAS unsigned* st; };
DEV XcdBarrier xcd_barrier_post(unsigned* bar, volatile LAS unsigned* st) { XcdBarrier b; b.bar = bar; b.x = xb_xcc_id(); b.st = st; if (threadIdx.x == 0) (void)xb_add(&bar[XB_XCNT(b.x)], 1u); return b; }
DEV void xcd_barrier_complete(unsigned* bar, unsigned x, unsigned& nloc, unsigned& nx) {
    const unsigned G = gridDim.x * gridDim.y * gridDim.z; unsigned sum, cnt, mine, sp = 0u;
    for (;;) { sum = 0u; cnt = 0u; mine = 0u;
#pragma unroll
        for (unsigned j = 0; j < 16; ++j) { const unsigned c = xb_ld(&bar[XB_XCNT(j)]); sum += c; cnt += (c > 0u) ? 1u : 0u; mine = (j == x) ? c : mine; }
        if (sum == G) break;
        __builtin_amdgcn_s_sleep(1);
        if ((++sp & 255u) == 0u) { if (xb_ld(&bar[XB_TMO])) break; if (sp > XB_SPIN_CAP) { atomicAdd(&bar[XB_TMO], 1u); break; } } }
    nloc = mine > 0u ? mine : 1u; nx = cnt > 0u ? cnt : 1u;
}
DEV void xcd_barrier(const XcdBarrier& b) {
    asm volatile("s_waitcnt vmcnt(0)" ::: "memory");
    __syncthreads();
    if (threadIdx.x == 0) {
        unsigned* bar = b.bar; asm volatile("" : "+s"(bar));
        unsigned bx = xb_xcc_id(); asm volatile("" : "+s"(bx));
        __builtin_amdgcn_s_waitcnt(0);
        unsigned nloc = b.st[0], nx = b.st[1];
        if (nloc == 0u) { xcd_barrier_complete(bar, bx, nloc, nx); b.st[0] = nloc; b.st[1] = nx; }
        const unsigned old = xb_add(&bar[XB_XSUB(bx)], 1u); const unsigned gen = old / nloc;
        if (old + 1u == (gen + 1u) * nloc) {
            __builtin_amdgcn_fence(__ATOMIC_RELEASE, "agent");
            asm volatile("s_waitcnt vmcnt(0)" ::: "memory");
            const unsigned og = xb_add(&bar[XB_TOP], 1u); const unsigned tg = og / nx;
            if (og + 1u == (tg + 1u) * nx) xb_add(&bar[XB_TOPGEN], 1u);
            else XB_SPIN(xb_ld(&bar[XB_TOPGEN]) == tg, bar);
            __builtin_amdgcn_fence(__ATOMIC_ACQUIRE, "agent");
            xb_add(&bar[XB_XGEN(bx)], 1u);
            asm volatile("s_waitcnt vmcnt(0)" ::: "memory");
        } else {
            XB_SPIN(xb_ld(&bar[XB_XGEN(bx)]) == gen, bar);
            __builtin_amdgcn_fence(__ATOMIC_ACQUIRE, "agent");
            asm volatile("s_waitcnt vmcnt(0)" ::: "memory");
        }
    }
    __syncthreads();
}
}

namespace misc {
DEV void ada_phase(LAS unsigned char* lds, const float* __restrict__ c, const float* __restrict__ w_ada, const float* __restrict__ b_ada, float* __restrict__ ada, int G, int cblk) {
    int tid_ = threadIdx.x; asm volatile("" : "+v"(tid_)); const int tid = tid_, col = tid & 63, kg = tid >> 6;
    LAS float* cond = (LAS float*)lds;
    LAS float* part = (LAS float*)(lds + 65536);
    for (int i = tid; i < 16384; i += 512) { const float v = c[i]; cond[i] = v / (1.f + __expf(-v)); }
    __syncthreads();
#pragma unroll 1
    for (int item = cblk; item < 192; item += G) { const int l = item / 96, n0 = (item - l * 96) * 64;
        float acc[16];
#pragma unroll
        for (int b = 0; b < 16; ++b) acc[b] = 0.f;
        const float* wp = w_ada + ((size_t)l * 1024 + kg * 128) * 6144 + n0 + col;
#pragma unroll 4
        for (int kk = 0; kk < 128; ++kk) { const float wv = wp[(size_t)kk * 6144];
#pragma unroll
            for (int b = 0; b < 16; ++b) acc[b] += cond[b * 1024 + kg * 128 + kk] * wv; }
#pragma unroll
        for (int b = 0; b < 16; ++b) part[(kg * 16 + b) * 64 + col] = acc[b];
        __syncthreads();
        for (int o = tid; o < 1024; o += 512) { const int b = o >> 6, cc = o & 63; float sacc = b_ada[l * 6144 + n0 + cc];
#pragma unroll
            for (int g8 = 0; g8 < 8; ++g8) sacc += part[(g8 * 16 + b) * 64 + cc];
            ada[((size_t)l * 16 + b) * 6144 + n0 + cc] = sacc; }
        __syncthreads();
    }
}
DEV void ln_phase(float* xio, const float* __restrict__ g, const float* __restrict__ bta, const float* ada_l, bf16_t* UY, int G, int cblk) {
    int tid_ = threadIdx.x; asm volatile("" : "+v"(tid_)); const int tid = tid_, w = __builtin_amdgcn_readfirstlane(tid >> 6), lane = tid & 63; const int d0 = 16 * lane;
#pragma unroll 1
    for (int tok = cblk * 8 + w; tok < T_; tok += G * 8) { const float* a = ada_l + (size_t)(tok >> 11) * 6144; float* xr = xio + (size_t)tok * 1024 + d0;
        float hv[16]; float s = 0.f;
#pragma unroll
        for (int j = 0; j < 16; j += 4) { const float4 v = *(const float4*)(xr + j); hv[j] = v.x; hv[j + 1] = v.y; hv[j + 2] = v.z; hv[j + 3] = v.w; s += (v.x + v.y) + (v.z + v.w); }
        const float mu = peer::wave_sum(s) * (1.f / 1024.f); float qq = 0.f;
#pragma unroll
        for (int j = 0; j < 16; ++j) { const float dd = hv[j] - mu; qq += dd * dd; }
        const float rstd = rsqrtf(peer::wave_sum(qq) * (1.f / 1024.f) + LN_EPS_);
        float uu[16];
#pragma unroll
        for (int j = 0; j < 16; j += 4) { const float4 gg = *(const float4*)(g + d0 + j), bb = *(const float4*)(bta + d0 + j), sc = *(const float4*)(a + 4096 + d0 + j), sh = *(const float4*)(a + 3072 + d0 + j);
            const float y0 = (hv[j] - mu) * rstd * gg.x + bb.x, y1 = (hv[j + 1] - mu) * rstd * gg.y + bb.y, y2 = (hv[j + 2] - mu) * rstd * gg.z + bb.z, y3 = (hv[j + 3] - mu) * rstd * gg.w + bb.w;
            *(float4*)(xr + j) = make_float4(y0, y1, y2, y3);
            uu[j] = y0 * (1.f + sc.x) + sh.x; uu[j + 1] = y1 * (1.f + sc.y) + sh.y; uu[j + 2] = y2 * (1.f + sc.z) + sh.z; uu[j + 3] = y3 * (1.f + sc.w) + sh.w; }
        u32x4 p0, p1; p0.x = pg8::cvt_pk_bf16(uu[0], uu[1]); p0.y = pg8::cvt_pk_bf16(uu[2], uu[3]); p0.z = pg8::cvt_pk_bf16(uu[4], uu[5]); p0.w = pg8::cvt_pk_bf16(uu[6], uu[7]);
        p1.x = pg8::cvt_pk_bf16(uu[8], uu[9]); p1.y = pg8::cvt_pk_bf16(uu[10], uu[11]); p1.z = pg8::cvt_pk_bf16(uu[12], uu[13]); p1.w = pg8::cvt_pk_bf16(uu[14], uu[15]);
        bf16_t* up = UY + (size_t)tok * UYW_ + d0; *(u32x4*)up = p0; *(u32x4*)(up + 8) = p1; }
}
DEV void yprep_phase(LAS unsigned char* lds, const bf16_t* __restrict__ hyT, const bf16_t* P, const float* __restrict__ lse2, bf16_t* Y, int G, int cblk) {
    int tid_ = threadIdx.x; asm volatile("" : "+v"(tid_)); const int tid = tid_;
    LAS unsigned short* tile = (LAS unsigned short*)lds;
#pragma unroll 1
    for (int it = cblk; it < 4096; it += G) { const int t0 = (it >> 3) * 64, c0 = (it & 7) * 64;
        __syncthreads();
        { const int cc = tid >> 3, seg = (tid & 7) * 8; const u32x4 v = *(const u32x4*)(hyT + (size_t)(c0 + cc) * T_ + t0 + seg); *(LAS u32x4*)(tile + cc * 72 + seg) = v; }
        __syncthreads();
        { const int tt = tid >> 3, seg = (tid & 7) * 8; unsigned wv[4];
#pragma unroll
            for (int e = 0; e < 4; ++e) wv[e] = (unsigned)tile[(seg + 2 * e) * 72 + tt] | ((unsigned)tile[(seg + 2 * e + 1) * 72 + tt] << 16);
            *(u32x4*)(Y + (size_t)(t0 + tt) * UYW_ + 256 + c0 + seg) = (u32x4){wv[0], wv[1], wv[2], wv[3]}; }
    }
#pragma unroll 1
    for (size_t idx = (size_t)cblk * 512 + tid; idx < (size_t)T_ * 32; idx += (size_t)G * 512) { const size_t tok = idx >> 5; const int c8 = (int)(idx & 31) * 8, hh = c8 >> 6;
        const float l0 = lse2[tok * 12 + hh], l1 = lse2[tok * 12 + 4 + hh], l2 = lse2[tok * 12 + 8 + hh]; const float mx = fmaxf(l0, fmaxf(l1, l2));
        float w0 = exp2f(l0 - mx), w1 = exp2f(l1 - mx), w2 = exp2f(l2 - mx); const float inv = 1.f / (w0 + w1 + w2); w0 *= inv; w1 *= inv; w2 *= inv;
        const bf16_t* pr = P + tok * PW_ + c8; const u32x4 a = *(const u32x4*)pr, b = *(const u32x4*)(pr + 256), c = *(const u32x4*)(pr + 512);
        const unsigned aw[4] = {a.x, a.y, a.z, a.w}, bw[4] = {b.x, b.y, b.z, b.w}, cw[4] = {c.x, c.y, c.z, c.w}; unsigned o[4];
#pragma unroll
        for (int e = 0; e < 4; ++e) { const float lo = w0 * __uint_as_float(aw[e] << 16) + w1 * __uint_as_float(bw[e] << 16) + w2 * __uint_as_float(cw[e] << 16);
            const float hi = w0 * __uint_as_float(aw[e] & 0xffff0000u) + w1 * __uint_as_float(bw[e] & 0xffff0000u) + w2 * __uint_as_float(cw[e] & 0xffff0000u); o[e] = pg8::cvt_pk_bf16(lo, hi); }
        *(u32x4*)(Y + tok * UYW_ + c8) = (u32x4){o[0], o[1], o[2], o[3]}; }
    __syncthreads();
}
}

struct Params {
    const float *x, *c, *w_ada, *b_ada, *w_in, *conv_w, *conv_b, *hy_w1, *hy_b1, *hy_w2, *hy_b2, *hy_w3, *hy_freq, *hy_ld, *hy_bias, *attn_sink, *wba, *wbb, *wbc, *w_out, *ln_g, *ln_b,
        *peer_wq, *peer_keys, *peer_u, *peer_v;
    float* out; char* ws;
};
constexpr int LDS_PHASE = 148480;
constexpr int LDS_BYTES = LDS_PHASE + 16;
constexpr size_t OFF_BAR = OFF_LSE + 1792 * 1024;

#define RUN(nvb, call) do { int tid_ = threadIdx.x; asm volatile("" : "+v"(tid_)); const int t = tid_ & 255, sub = tid_ >> 8; unsigned char* sm = lds + sub * 16384; \
        for (int vb = (int)blockIdx.x * 2 + sub; vb < (nvb); vb += (int)gridDim.x * 2) { call; __syncthreads(); } } while (0)
#define GSYNC_CG() do { __builtin_amdgcn_sched_barrier(0); grid.sync(); __builtin_amdgcn_sched_barrier(0); } while (0)
#define GSYNC() do { __builtin_amdgcn_sched_barrier(0); xb::xcd_barrier(xbar); __builtin_amdgcn_sched_barrier(0); } while (0)

__global__ void __launch_bounds__(512, 2) mega(Params p) {
    extern __shared__ __attribute__((aligned(16))) unsigned char lds[];
    cg::grid_group grid = cg::this_grid();
    LAS unsigned char* ldsl = (LAS unsigned char*)lds;
    const int G = gridDim.x, cblk = blockIdx.x;
    float* out = p.out; (void)out;
    if (threadIdx.x < 4) ((LAS unsigned*)(ldsl + LDS_PHASE))[threadIdx.x] = 0u;
    __syncthreads();
    const xb::XcdBarrier xbar = xb::xcd_barrier_post((unsigned*)(p.ws + OFF_BAR), (volatile LAS unsigned*)(ldsl + LDS_PHASE));
    {
    char* ws = p.ws;
    float* ada = (float*)(ws + OFF_ADA); float2* rope = (float2*)(ws + OFF_ROPE); bf16_t* Gr = (bf16_t*)(ws + OFF_GR); float* lse2 = (float*)(ws + OFF_LSE);
    bf16_t* WinT = (bf16_t*)(ws + OFF_WINT); bf16_t* WmT = (bf16_t*)(ws + OFF_WMT); bf16_t* WoutT = (bf16_t*)(ws + OFF_WOUTT); bf16_t* WqT = (bf16_t*)(ws + OFF_WQT);
    bf16_t* UY = (bf16_t*)(ws + OFF_UY); bf16_t* Y = UY + 1024; bf16_t* P = (bf16_t*)(ws + OFF_P); bf16_t* hyT = (bf16_t*)(ws + OFF_HYT);
    bf16_t* merged = (bf16_t*)(ws + OFF_P); bf16_t* gtmp = (bf16_t*)(ws + OFF_P + 64 * MB_); bf16_t* Q2 = (bf16_t*)(ws + OFF_P);
    int* eidx = (int*)(ws + OFF_HYT); float* egate = (float*)(ws + OFF_HYT + 16 * MB_); unsigned char* U8 = (unsigned char*)(ws + OFF_HYT + 32 * MB_); unsigned char* V8 = (unsigned char*)(ws + OFF_HYT + 48 * MB_); float* sinv = (float*)(ws + OFF_HYT + 64 * MB_);
    float* h2 = (float*)(ws + OFF_P); float* hf = (float*)(ws + OFF_P + 2 * MB_);
    (void)lse2; (void)P; (void)hyT; (void)merged; (void)gtmp; (void)Q2; (void)eidx; (void)egate; (void)U8; (void)V8; (void)sinv; (void)Y;

    misc::ada_phase(ldsl, p.c, p.w_ada, p.b_ada, ada, G, cblk);
    RUN(256, nb_rope(vb, t, sm, rope));
    RUN(1024, nb_filt_h2(vb, t, sm, p.hy_w1, p.hy_b1, p.hy_w2, p.hy_b2, p.hy_freq, h2));
    { const WPrep wq{p.w_in, p.wba, p.wbb, p.wbc, p.w_out, p.peer_wq, WinT, WmT, WoutT, WqT}; RUN(6016, nb_wprep(vb, t, sm, wq)); }
    GSYNC_CG();
    RUN(32768, nb_filt_full(vb, t, sm, h2, p.hy_w3, p.hy_ld, hf));
    RUN(T_ * 4, nb_modulate(vb, t, sm, p.x, ada, 0, 1024, UY));
    GSYNC();
    RUN(2048, nb_filt_norm(vb, t, sm, hf, Gr));
    GSYNC();
    }
#pragma unroll 1
    for (int l = 0; l < 2; ++l) {
        char* ws = p.ws; asm volatile("" : "+s"(ws));
        float* out = p.out; asm volatile("" : "+s"(out));
        int Gl = gridDim.x, cl = blockIdx.x; asm volatile("" : "+s"(Gl), "+s"(cl));
        float* ada = (float*)(ws + OFF_ADA); float2* rope = (float2*)(ws + OFF_ROPE); bf16_t* Gr = (bf16_t*)(ws + OFF_GR); float* lse2 = (float*)(ws + OFF_LSE);
        bf16_t* WinT = (bf16_t*)(ws + OFF_WINT); bf16_t* WmT = (bf16_t*)(ws + OFF_WMT); bf16_t* WoutT = (bf16_t*)(ws + OFF_WOUTT); bf16_t* WqT = (bf16_t*)(ws + OFF_WQT);
        bf16_t* UY = (bf16_t*)(ws + OFF_UY); bf16_t* Y = UY + 1024; bf16_t* P = (bf16_t*)(ws + OFF_P); bf16_t* hyT = (bf16_t*)(ws + OFF_HYT);
        bf16_t* merged = (bf16_t*)(ws + OFF_P); bf16_t* gtmp = (bf16_t*)(ws + OFF_P + 64 * MB_); bf16_t* Q2 = (bf16_t*)(ws + OFF_P);
        int* eidx = (int*)(ws + OFF_HYT); float* egate = (float*)(ws + OFF_HYT + 16 * MB_); unsigned char* U8 = (unsigned char*)(ws + OFF_HYT + 32 * MB_); unsigned char* V8 = (unsigned char*)(ws + OFF_HYT + 48 * MB_); float* sinv = (float*)(ws + OFF_HYT + 64 * MB_);
        const float* ada_l = ada + (size_t)l * 16 * 6144;
        const float* xin = (l == 0) ? p.x : out;
        const bf16_t* WinT_l = WinT + (size_t)l * 7680 * 1024;
        {
            const pg8::PlainSched S1{UY, WinT_l, UYW_, 1024, 128, 12, 16, Gl, cl}; const pg8::EpiP E1{P, rope};
            pg8::gemm_phase(ldsl, UYW_, 1024, S1, E1);
            const pg8::PlainSched S2{WinT_l + (size_t)3072 * 1024, UY, 1024, UYW_, 6, 128, 16, Gl, cl}; const pg8::EpiBf E2{hyT, T_, 0};
            pg8::gemm_phase(ldsl, 1024, UYW_, S2, E2);
        }
        GSYNC();
        at::attn_phase(ldsl, P, lse2, Y, p.attn_sink + l * 8, Gl, cl);
        GSYNC();
        hy::hyena_phase(ldsl, hyT, Gr + (size_t)l * 2 * 512 * 4096, p.conv_w + (size_t)l * 3 * 1536, p.conv_b + (size_t)l * 1536, p.hy_bias + (size_t)l * 1024, Gl, cl);
        GSYNC();
        misc::yprep_phase(ldsl, hyT, P, lse2, Y, Gl, cl);
        GSYNC();
        {
            const pg8::MergeSched S{UY, WmT + (size_t)l * 1024 * WMW_, Gl, cl}; const pg8::EpiMergeAll E{gtmp, merged};
            pg8::gemm_phase(ldsl, UYW_, WMW_, S, E);
        }
        GSYNC();
        {
            const pg8::PlainSched S{merged, WoutT + (size_t)l * 1024 * 1024, 1024, 1024, 128, 4, 16, Gl, cl}; const pg8::EpiOut E{xin, out, ada_l + 2048};
            pg8::gemm_phase(ldsl, 1024, 1024, S, E);
        }
        GSYNC();
        misc::ln_phase(out, p.ln_g + (size_t)(l * 2 + 0) * 1024, p.ln_b + (size_t)(l * 2 + 0) * 1024, ada_l, UY, Gl, cl);
        RUN(8192, peer::nb_quant_tables(vb, t, p.peer_u + (size_t)l * 16384 * 1024, p.peer_v + (size_t)l * 16384 * 1024, U8, V8, sinv));
        GSYNC();
        {
            const pg8::PlainSched S{UY, WqT + (size_t)l * 2048 * 1024, UYW_, 1024, 128, 8, 16, Gl, cl}; const pg8::EpiBf E{Q2, 2048, 0};
            pg8::gemm_phase(ldsl, UYW_, 1024, S, E);
        }
        GSYNC();
        tk::topk_phase(ldsl, Q2, p.peer_keys + (size_t)l * 8 * 2 * 128 * 128, eidx, egate, Gl, cl);
        GSYNC();
        peer::peer_phase(ldsl, out, ada_l, eidx, egate, U8, V8, sinv, p.ln_g + (size_t)(l * 2 + 1) * 1024, p.ln_b + (size_t)(l * 2 + 1) * 1024,
                         (l == 0) ? ada + (size_t)16 * 6144 : (const float*)nullptr, UY, Gl, cl);
        if (l == 0) GSYNC();
    }
}

extern "C" void kernel_launch(void* const* d_in, const int* in_sizes, int n_in, void* d_out, int out_size, void* d_ws, size_t ws_size, hipStream_t stream) {
    static int grid = 0;
    if (grid == 0) {
        if (ws_size < WS_NEED || n_in != 26) { fprintf(stderr, "kernel_launch: workspace %zu < %zu or n_in %d != 26\n", ws_size, (size_t)WS_NEED, n_in); grid = -1; return; }
        int dev = 0, cus = 0, per_cu = 0;
        (void)hipGetDevice(&dev); (void)hipDeviceGetAttribute(&cus, hipDeviceAttributeMultiprocessorCount, dev);
        (void)hipFuncSetAttribute((const void*)mega, hipFuncAttributeMaxDynamicSharedMemorySize, LDS_BYTES);
        (void)hipOccupancyMaxActiveBlocksPerMultiprocessor(&per_cu, (const void*)mega, 512, LDS_BYTES);
        if (per_cu < 1) { fprintf(stderr, "kernel_launch: occupancy query says %d blocks per CU\n", per_cu); grid = -1; return; }
        grid = cus;
    }
    if (grid < 0) return;
    Params p{};
    const float** pp = (const float**)&p;
    for (int i = 0; i < 26; ++i) pp[i] = (const float*)d_in[i];
    p.out = (float*)d_out; p.ws = (char*)d_ws;
    (void)hipMemsetAsync((char*)d_ws + OFF_BAR, 0, xb::XCD_BAR_WORDS * sizeof(unsigned), stream);
    void* args[] = {&p};
    hipError_t e = hipLaunchCooperativeKernel((const void*)mega, dim3(grid), dim3(512), args, LDS_BYTES, stream);
    if (e != hipSuccess) fprintf(stderr, "cooperative launch failed: %s (grid %d)\n", hipGetErrorString(e), grid);
}
```

```cpp
#include <hip/hip_runtime.h>
#include <hip/hip_cooperative_groups.h>
namespace cg = cooperative_groups;
#include <stdint.h>
#include <stdio.h>

#define DEV __device__ __forceinline__
typedef unsigned short bf16_t;

constexpr int D_ = 1024, B_ = 16, S_ = 2048, T_ = B_ * S_;
constexpr float ALPHA_ = 1.41421356237309515f;
constexpr float LOG2E_ = 1.4426950408889634f;
constexpr float QSCALE_ = 0.125f * 1.4426950408889634f;
constexpr float LN_EPS_ = 1e-5f;
constexpr int PW_ = 3072;
constexpr int UYW_ = 2304;
constexpr int WMW_ = 4352;

constexpr size_t MB_ = 1024 * 1024;
constexpr size_t OFF_ADA = 0, OFF_ROPE = 1 * MB_, OFF_GR = 2 * MB_, OFF_LSE = 18 * MB_, OFF_WINT = 20 * MB_, OFF_WMT = 50 * MB_,
                 OFF_WOUTT = 68 * MB_, OFF_WQT = 72 * MB_, OFF_KEYS = 80 * MB_, OFF_UY = 82 * MB_, OFF_P = 226 * MB_, OFF_HYT = 418 * MB_,
                 OFF_Z1T = OFF_P  , WS_NEED = 514 * MB_;

DEV int xor_i(int v, int off, int lane) { return __builtin_amdgcn_ds_bpermute((lane ^ off) << 2, v); }
DEV float xor_f(float v, int off, int lane) { return __int_as_float(__builtin_amdgcn_ds_bpermute((lane ^ off) << 2, __float_as_int(v))); }
DEV float bf2f(bf16_t v) { return __uint_as_float(((unsigned)v) << 16); }
DEV bf16_t f2bf(float f) { unsigned u = __float_as_uint(f); u += 0x7FFFu + ((u >> 16) & 1u); return (bf16_t)(u >> 16); }

DEV void nb_ada(int vb, int t, unsigned char* sm, const float* __restrict__ c, const float* __restrict__ w_ada, const float* __restrict__ b_ada, float* __restrict__ ada) {
    const int idx = vb * 256 + t; const int l = idx / 6144, n = idx % 6144;
    float (*cond)[64] = (float (*)[64])sm;
    float acc[16];
#pragma unroll
    for (int b = 0; b < 16; ++b) acc[b] = b_ada[l * 6144 + n];
    for (int k0 = 0; k0 < 1024; k0 += 64) {
        for (int i = t; i < 1024; i += 256) { const int b = i >> 6, kk = i & 63; const float v = c[b * 1024 + k0 + kk]; cond[b][kk] = v / (1.f + expf(-v)); }
        __syncthreads();
        for (int kk = 0; kk < 64; ++kk) { const float w = w_ada[((size_t)l * 1024 + k0 + kk) * 6144 + n];
#pragma unroll
            for (int b = 0; b < 16; ++b) acc[b] += cond[b][kk] * w; }
        __syncthreads();
    }
#pragma unroll
    for (int b = 0; b < 16; ++b) ada[((size_t)l * 16 + b) * 6144 + n] = acc[b];
}

DEV void nb_rope(int vb, int t, unsigned char* sm, float2* __restrict__ rope) {
    const int idx = vb * 256 + t; const int s = idx >> 5, i = idx & 31;
    const float inv = powf(10000.f, -(float)i / 32.f); const float ang = (float)s * inv;
    rope[idx] = make_float2(cosf(ang), sinf(ang));
}

DEV void nb_filt_h2(int vb, int t, unsigned char* sm, const float* __restrict__ w1, const float* __restrict__ b1, const float* __restrict__ w2, const float* __restrict__ b2,
                                                const float* __restrict__ freq, float* __restrict__ h2) {
    const int grp = t >> 6, j = t & 63; const int lt = vb * 4 + grp; const int l = lt / 2048, tt = lt % 2048;
    float* z = (float*)sm + grp * 128; float* h1 = z + 64;
    if (j < 33) {
        const float idx = (float)tt, tn = idx / 2047.f, w = 6.283185307179586f * idx / 2048.f;
        if (j == 0) z[0] = tn;
        else { const int k = (j <= 16) ? (j - 1) : (j - 17); const float band = 1e-4f + (float)k * ((15.f - 1e-4f) / 15.f); const float ang = w * band;
            z[j] = (j <= 16) ? cosf(ang) : -sinf(ang); }
    }
    __syncthreads();
    float a = b1[l * 64 + j];
    for (int e = 0; e < 33; ++e) a += z[e] * w1[(l * 33 + e) * 64 + j];
    h1[j] = sinf(freq[(l * 2 + 0) * 64 + j] * a);
    __syncthreads();
    float a2 = b2[l * 64 + j];
    for (int i = 0; i < 64; ++i) a2 += h1[i] * w2[(l * 64 + i) * 64 + j];
    h2[((size_t)l * 2048 + tt) * 64 + j] = sinf(freq[(l * 2 + 1) * 64 + j] * a2);
}

DEV void nb_filt_full(int vb, int t, unsigned char* sm, const float* __restrict__ h2, const float* __restrict__ w3, const float* __restrict__ log_decay, float* __restrict__ hf) {
    const size_t idx = (size_t)vb * 256 + t; const int col = (int)(idx & 2047), tt = (int)((idx >> 11) & 2047), l = (int)(idx >> 22);
    const float* hr = h2 + ((size_t)l * 2048 + tt) * 64; float a = 0.f;
    for (int j = 0; j < 64; ++j) a += hr[j] * w3[((size_t)l * 64 + j) * 2048 + col];
    const float tn = (float)tt / 2047.f;
    hf[idx] = a * expf(-tn * expf(log_decay[l * 2048 + col]));
}

DEV void nb_filt_norm(int vb, int t, unsigned char* sm, const float* __restrict__ hf, bf16_t* __restrict__ Gr) {
    const int blk = vb; const int c = blk & 511, o = (blk >> 9) & 1, l = blk >> 10;
    const float* base = hf + (size_t)l * 2048 * 2048; const int colf = o * 512 + c, colb = 1024 + o * 512 + c;
    float ss = 0.f;
    for (int tt = t; tt < 2048; tt += 256) { const float a = base[(size_t)tt * 2048 + colf]; ss += a * a; if (tt >= 1) { const float bb = base[(size_t)tt * 2048 + colb]; ss += bb * bb; } }
    float* red = (float*)sm; red[t] = ss; __syncthreads();
    for (int st = 128; st > 0; st >>= 1) { if (t < st) red[t] += red[t + st]; __syncthreads(); }
    const float scale = rsqrtf(red[0] + 1e-12f); __syncthreads();
    bf16_t* g = Gr + (size_t)blk * 4096;
    for (int n = t; n < 4096; n += 256) { const int lag = 2047 - n; float v = 0.f;
        if (n < 4095) v = (lag >= 0) ? base[(size_t)lag * 2048 + colf] : base[(size_t)(-lag) * 2048 + colb];
        g[n] = f2bf(v * scale); }
}

DEV void nb_modulate(int vb, int t, unsigned char* sm, const float* __restrict__ x, const float* __restrict__ ada_l, int off_sh, int off_sc, bf16_t* __restrict__ ubuf) {
    const size_t idx = (size_t)vb * 256 + t; const int d = (int)(idx & 1023); const int b = (int)(idx >> 21);
    const float* a = ada_l + (size_t)b * 6144;
    ubuf[(idx >> 10) * UYW_ + d] = f2bf(x[idx] * (1.f + a[off_sc + d]) + a[off_sh + d]);
}

template <class AL, class WL, class EP>
DEV void nb_gemm(int vb, int t, unsigned char* sm, int nbx, int K, AL al, WL wl, EP ep) {
    float (*As)[65] = (float (*)[65])sm;
    float (*Ws)[65] = (float (*)[65])(sm + 16 * 65 * 4);
    const int tx = t & 15, ty = t >> 4;
    const int m0 = (vb / nbx) * 64, n0 = (vb % nbx) * 64;
    float acc[4][4];
#pragma unroll
    for (int i = 0; i < 4; ++i)
#pragma unroll
        for (int j = 0; j < 4; ++j) acc[i][j] = 0.f;
    for (int k0 = 0; k0 < K; k0 += 16) {
#pragma unroll
        for (int r = 0; r < 4; ++r) { const int i = t + r * 256; const int mm = i >> 4, kk = i & 15; As[kk][mm] = al(m0 + mm, k0 + kk); }
#pragma unroll
        for (int r = 0; r < 4; ++r) { const int i = t + r * 256; const int kk = i >> 6, nn = i & 63; Ws[kk][nn] = wl(k0 + kk, n0 + nn); }
        __syncthreads();
#pragma unroll
        for (int kk = 0; kk < 16; ++kk) {
            float a[4], w[4];
#pragma unroll
            for (int i = 0; i < 4; ++i) { a[i] = As[kk][ty + 16 * i]; w[i] = Ws[kk][tx + 16 * i]; }
#pragma unroll
            for (int i = 0; i < 4; ++i)
#pragma unroll
                for (int j = 0; j < 4; ++j) acc[i][j] += a[i] * w[j];
        }
        __syncthreads();
    }
    ep(m0, n0, ty, tx, acc);
}

struct ALbf { const bf16_t* A; int lda; int pad; DEV float operator()(int m, int k) const { return bf2f(A[(size_t)m * lda + k]); } };
struct WLf { const float* W; int ldw; int coff; DEV float operator()(int k, int n) const { return W[(size_t)k * ldw + coff + n]; } };
struct WLinP { const float* W; DEV float operator()(int k, int n) const { return W[(size_t)k * 7680 + (n < 2304 ? n : n + 1536)]; } };

struct EpP { bf16_t* P; const float2* rope;
    DEV void operator()(int m0, int n0, int ty, int tx, float (&acc)[4][4]) const {
        const int head = n0 >> 6; const bool rp = (head < 24) || (head >= 36 && head < 46); const bool qs = (head < 12) || (head >= 36 && head < 44);
#pragma unroll
        for (int i = 0; i < 4; ++i) { const int m = m0 + ty + 16 * i; const int s = m & 2047; bf16_t* row = P + (size_t)m * PW_ + n0;
            if (rp) {
#pragma unroll
                for (int jj = 0; jj < 2; ++jj) { const int d = tx + 16 * jj; const float x1 = acc[i][jj], x2 = acc[i][jj + 2]; const float2 cs = rope[s * 32 + d];
                    float o1 = x1 * cs.x - x2 * cs.y, o2 = x2 * cs.x + x1 * cs.y; if (qs) { o1 *= QSCALE_; o2 *= QSCALE_; }
                    const int p1 = 8 * (d >> 2) + (d & 3); row[p1] = f2bf(o1); row[p1 + 4] = f2bf(o2); }
            } else {
#pragma unroll
                for (int j = 0; j < 4; ++j) row[tx + 16 * j] = f2bf(acc[i][j]);
            } }
    } };
struct EpHyT { bf16_t* hyT;
    DEV void operator()(int m0, int n0, int ty, int tx, float (&acc)[4][4]) const {
#pragma unroll
        for (int i = 0; i < 4; ++i)
#pragma unroll
            for (int j = 0; j < 4; ++j) hyT[(size_t)(n0 + tx + 16 * j) * T_ + m0 + ty + 16 * i] = f2bf(acc[i][j]);
    } };
struct EpGate { bf16_t* tmp;
    DEV void operator()(int m0, int n0, int ty, int tx, float (&acc)[4][4]) const {
#pragma unroll
        for (int i = 0; i < 4; ++i)
#pragma unroll
            for (int j = 0; j < 4; ++j) tmp[(size_t)(m0 + ty + 16 * i) * 1024 + n0 + tx + 16 * j] = f2bf(1.f / (1.f + expf(-acc[i][j])));
    } };
struct EpMerge { const bf16_t* tmp; bf16_t* merged; int first; int pad;
    DEV void operator()(int m0, int n0, int ty, int tx, float (&acc)[4][4]) const {
#pragma unroll
        for (int i = 0; i < 4; ++i)
#pragma unroll
            for (int j = 0; j < 4; ++j) { const size_t o = (size_t)(m0 + ty + 16 * i) * 1024 + n0 + tx + 16 * j; float v = bf2f(tmp[o]) * acc[i][j]; if (!first) v += bf2f(merged[o]); merged[o] = f2bf(v); }
    } };
struct EpOut { const float* xin; float* h; const float* ada_l; int off_g; int pad;
    DEV void operator()(int m0, int n0, int ty, int tx, float (&acc)[4][4]) const {
#pragma unroll
        for (int i = 0; i < 4; ++i)
#pragma unroll
            for (int j = 0; j < 4; ++j) { const int m = m0 + ty + 16 * i, n = n0 + tx + 16 * j; const size_t o = (size_t)m * 1024 + n;
                h[o] = ALPHA_ * xin[o] + ada_l[(size_t)(m >> 11) * 6144 + off_g + n] * acc[i][j]; }
    } };
struct EpQ2 { bf16_t* Q2;
    DEV void operator()(int m0, int n0, int ty, int tx, float (&acc)[4][4]) const {
#pragma unroll
        for (int i = 0; i < 4; ++i)
#pragma unroll
            for (int j = 0; j < 4; ++j) Q2[(size_t)(m0 + ty + 16 * i) * 2048 + n0 + tx + 16 * j] = f2bf(acc[i][j]);
    } };

DEV void nb_attnA(int vb, int t, unsigned char* sm, bf16_t* __restrict__ P, float* __restrict__ lse2) {
    const int idx = vb * 256 + t; const int s = idx & 2047, head = (idx >> 11) % 12, b = idx / (2048 * 12);
    const int gi = head >> 2; const int dil = gi == 0 ? 1 : (gi == 1 ? 4 : 16); const int ls = 2048 / dil; const int r = s % dil, p = s / dil;
    bf16_t* qrow = P + (size_t)(b * 2048 + s) * PW_ + head * 64;
    float q[64], o[64];
#pragma unroll
    for (int d = 0; d < 64; ++d) { q[d] = bf2f(qrow[d]); o[d] = 0.f; }
    float m = -1e30f, l = 0.f;
    const int lo = max(0, p - 64), hi = min(ls - 1, p + 64);
    for (int pp = lo; pp <= hi; ++pp) {
        const bf16_t* krow = P + (size_t)(b * 2048 + pp * dil + r) * PW_ + 768 + head * 64; const bf16_t* vrow = krow + 768;
        float sc = 0.f;
#pragma unroll
        for (int d = 0; d < 64; ++d) sc += q[d] * bf2f(krow[d]);
        const float mn = fmaxf(m, sc), corr = exp2f(m - mn), pw = exp2f(sc - mn);
        l = l * corr + pw;
#pragma unroll
        for (int d = 0; d < 64; ++d) o[d] = o[d] * corr + pw * bf2f(vrow[d]);
        m = mn;
    }
    const float inv = 1.f / l;
#pragma unroll
    for (int d = 0; d < 64; ++d) qrow[d] = f2bf(o[d] * inv);
    lse2[(size_t)(b * 2048 + s) * 12 + head] = m + log2f(l);
}

DEV void nb_attnC(int vb, int t, unsigned char* sm, const bf16_t* __restrict__ P, const float* __restrict__ sink_l, bf16_t* __restrict__ Y) {
    const int idx = vb * 256 + t; const int s = idx & 2047, qh = (idx >> 11) & 7, b = idx >> 14; const int kvh = qh >> 2;
    const bf16_t* qrow = P + (size_t)(b * 2048 + s) * PW_ + 2304 + qh * 64;
    float q[64], o[64];
#pragma unroll
    for (int d = 0; d < 64; ++d) { q[d] = bf2f(qrow[d]); o[d] = 0.f; }
    float m = -1e30f, l = 0.f;
    const int lo = max(0, s - 128), hi = min(2047, s + 128);
    for (int pp = lo; pp <= hi; ++pp) {
        const bf16_t* krow = P + (size_t)(b * 2048 + pp) * PW_ + 2816 + kvh * 64; const bf16_t* vrow = krow + 128;
        float sc = 0.f;
#pragma unroll
        for (int d = 0; d < 64; ++d) sc += q[d] * bf2f(krow[d]);
        const float mn = fmaxf(m, sc), corr = exp2f(m - mn), pw = exp2f(sc - mn);
        l = l * corr + pw;
#pragma unroll
        for (int d = 0; d < 64; ++d) o[d] = o[d] * corr + pw * bf2f(vrow[d]);
        m = mn;
    }
    const float sk = sink_l[qh] * LOG2E_; const float mf = fmaxf(m, sk); const float corr = exp2f(m - mf);
    l = l * corr + exp2f(sk - mf); const float inv = corr / l;
    bf16_t* yrow = Y + (size_t)(b * 2048 + s) * UYW_ + 768 + qh * 64;
#pragma unroll
    for (int d = 0; d < 64; ++d) yrow[d] = f2bf(o[d] * inv);
}

DEV void nb_combineA(int vb, int t, unsigned char* sm, const bf16_t* __restrict__ P, const float* __restrict__ lse2, bf16_t* __restrict__ Y) {
    const size_t idx = (size_t)vb * 256 + t; const int cc = (int)(idx & 255); const size_t tok = idx >> 8; const int hh = cc >> 6, d = cc & 63;
    const float l0 = lse2[tok * 12 + hh], l1 = lse2[tok * 12 + 4 + hh], l2 = lse2[tok * 12 + 8 + hh]; const float mx = fmaxf(l0, fmaxf(l1, l2));
    const float w0 = exp2f(l0 - mx), w1 = exp2f(l1 - mx), w2 = exp2f(l2 - mx);
    const bf16_t* pr = P + tok * PW_ + hh * 64 + d;
    Y[tok * UYW_ + cc] = f2bf((w0 * bf2f(pr[0]) + w1 * bf2f(pr[256]) + w2 * bf2f(pr[512])) / (w0 + w1 + w2));
}

DEV void nb_hyena(int vb, int t, unsigned char* sm, int pass, bf16_t* __restrict__ hyT, bf16_t* __restrict__ z1T, const bf16_t* __restrict__ Gr_l, const float* __restrict__ conv_w,
                                                const float* __restrict__ conv_b, const float* __restrict__ hy_bias) {
    const size_t idx = (size_t)vb * 256 + t; const int i = (int)(idx & 2047); const int b = (int)((idx >> 11) & 15); const int c = (int)(idx >> 15);
    const bf16_t* G = Gr_l + ((size_t)pass * 512 + c) * 4096 + (2047 - i);
    float acc = 0.f, zi = 0.f;
    if (pass == 0) {
        const bf16_t* in = hyT + (size_t)c * T_ + b * 2048; const float w0 = conv_w[c], w1 = conv_w[1536 + c], w2 = conv_w[3072 + c], cb = conv_b[c];
        float prev = 0.f, cur = bf2f(in[0]);
        for (int j = 0; j < 2048; ++j) { const float nxt = (j < 2047) ? bf2f(in[j + 1]) : 0.f; const float z = cb + w0 * prev + w1 * cur + w2 * nxt;
            acc += bf2f(G[j]) * z; if (j == i) zi = z; prev = cur; cur = nxt; }
    } else {
        const bf16_t* in = z1T + (size_t)c * T_ + b * 2048;
        for (int j = 0; j < 2048; ++j) { const float z = bf2f(in[j]); acc += bf2f(G[j]) * z; if (j == i) zi = z; }
    }
    const int xc = (pass == 0 ? 512 : 1024) + c;
    const bf16_t* xin = hyT + (size_t)xc * T_ + b * 2048;
    const float xm = (i > 0) ? bf2f(xin[i - 1]) : 0.f, x0 = bf2f(xin[i]), xp = (i < 2047) ? bf2f(xin[i + 1]) : 0.f;
    const float xv = conv_b[xc] + conv_w[xc] * xm + conv_w[1536 + xc] * x0 + conv_w[3072 + xc] * xp;
    const float outv = xv * (acc + hy_bias[pass * 512 + c] * zi);
    if (pass == 0) z1T[(size_t)c * T_ + b * 2048 + i] = f2bf(outv); else hyT[(size_t)c * T_ + b * 2048 + i] = f2bf(outv);
}

DEV void nb_transY(int vb, int t, unsigned char* sm, const bf16_t* __restrict__ hyT, bf16_t* __restrict__ Y) {
    const size_t idx = (size_t)vb * 256 + t; const int c = (int)(idx & 511); const size_t tok = idx >> 9;
    Y[tok * UYW_ + 256 + c] = hyT[(size_t)c * T_ + tok];
}

DEV void nb_ln_mod(int vb, int t, unsigned char* sm, float* __restrict__ h, const float* __restrict__ g, const float* __restrict__ bta, const float* __restrict__ ada_l, int off_sh, int off_sc,
                                                bf16_t* __restrict__ ubuf) {
    const int tok = vb; float v[4]; float s = 0.f;
#pragma unroll
    for (int k = 0; k < 4; ++k) { v[k] = h[(size_t)tok * 1024 + t + 256 * k]; s += v[k]; }
    float* red = (float*)sm; red[t] = s; __syncthreads();
    for (int st = 128; st > 0; st >>= 1) { if (t < st) red[t] += red[t + st]; __syncthreads(); }
    const float mu = red[0] * (1.f / 1024.f); __syncthreads();
    float q = 0.f;
#pragma unroll
    for (int k = 0; k < 4; ++k) { const float dd = v[k] - mu; q += dd * dd; }
    red[t] = q; __syncthreads();
    for (int st = 128; st > 0; st >>= 1) { if (t < st) red[t] += red[t + st]; __syncthreads(); }
    const float rstd = rsqrtf(red[0] * (1.f / 1024.f) + LN_EPS_);
    const float* a = ada_l + (size_t)(tok >> 11) * 6144;
#pragma unroll
    for (int k = 0; k < 4; ++k) { const int d = t + 256 * k; const float y = (v[k] - mu) * rstd * g[d] + bta[d]; h[(size_t)tok * 1024 + d] = y;
        if (ubuf) ubuf[(size_t)tok * UYW_ + d] = f2bf(y * (1.f + a[off_sc + d]) + a[off_sh + d]); }
}

DEV void nb_peer_topk(int vb, int t, unsigned char* sm, const bf16_t* __restrict__ Q2, const float* __restrict__ keys_l, int* __restrict__ eidx, float* __restrict__ egate) {
    const int grp = t >> 7; const int th = vb * 2 + grp; const int tok = th >> 3, h = th & 7; t &= 127;
    float* qs = (float*)sm + grp * 1024; float* s1 = qs + 256; float* s2 = s1 + 128; float* t1v = s2 + 128; float* t2v = t1v + 16; float* cand = t2v + 16; float* bestv = cand + 256;
    int* t1i = (int*)(bestv + 16); int* t2i = t1i + 16; int* besti = t2i + 16;
    qs[t] = bf2f(Q2[(size_t)tok * 2048 + h * 256 + t]); qs[t + 128] = bf2f(Q2[(size_t)tok * 2048 + h * 256 + 128 + t]);
    __syncthreads();
    { const float* k1 = keys_l + ((size_t)(h * 2 + 0) * 128 + t) * 128; const float* k2 = keys_l + ((size_t)(h * 2 + 1) * 128 + t) * 128; float a = 0.f, bsum = 0.f;
        for (int c = 0; c < 128; ++c) { a += qs[c] * k1[c]; bsum += qs[128 + c] * k2[c]; }
        s1[t] = a; s2[t] = bsum; }
    __syncthreads();
    { const float a = s1[t], bb = s2[t]; int r1 = 0, r2 = 0;
        for (int m = 0; m < 128; ++m) { const float x = s1[m], y = s2[m]; r1 += (x > a || (x == a && m < t)) ? 1 : 0; r2 += (y > bb || (y == bb && m < t)) ? 1 : 0; }
        if (r1 < 16) { t1v[r1] = a; t1i[r1] = t; } if (r2 < 16) { t2v[r2] = bb; t2i[r2] = t; } }
    __syncthreads();
    cand[t] = t1v[t >> 4] + t2v[t & 15]; cand[t + 128] = t1v[(t + 128) >> 4] + t2v[t & 15];
    __syncthreads();
#pragma unroll
    for (int rr = 0; rr < 2; ++rr) { const int ci = t + 128 * rr; const float a = cand[ci]; int r = 0;
        for (int m = 0; m < 256; ++m) { const float x = cand[m]; r += (x > a || (x == a && m < ci)) ? 1 : 0; }
        if (r < 16) { bestv[r] = a; besti[r] = ci; } }
    __syncthreads();
    if (t < 16) { const float mx = bestv[0]; float sum = 0.f;
        for (int k = 0; k < 16; ++k) sum += expf(bestv[k] - mx);
        const int ci = besti[t]; const size_t o = ((size_t)tok * 8 + h) * 16 + t;
        eidx[o] = ((t1i[(ci >> 4) & 15] & 127) * 128 + (t2i[ci & 15] & 127)); egate[o] = expf(bestv[t] - mx) / sum; }
}

DEV void nb_peer(int vb, int t, unsigned char* sm, float* __restrict__ xio, const float* __restrict__ ada_l, const int* __restrict__ eidx, const float* __restrict__ egate,
                                              const float* __restrict__ pu, const float* __restrict__ pv, const float* __restrict__ g, const float* __restrict__ bta,
                                              const float* __restrict__ ada_next, bf16_t* __restrict__ ubuf) {
    const int tok = vb, lane = t & 63, w = t >> 6;
    float* xs = (float*)sm; float* wv = xs + 1024; float* red = wv + 128; int* es = (int*)(red + 256);
    const float* a = ada_l + (size_t)(tok >> 11) * 6144; float x1[4];
#pragma unroll
    for (int k = 0; k < 4; ++k) { const int d = t + 256 * k; x1[k] = xio[(size_t)tok * 1024 + d]; xs[d] = x1[k] * (1.f + a[4096 + d]) + a[3072 + d]; }
    if (t < 128) es[t] = eidx[(size_t)tok * 128 + t];
    __syncthreads();
    for (int i = w; i < 128; i += 4) { const float* ur = pu + (size_t)es[i] * 1024; float dsum = 0.f;
#pragma unroll
        for (int k = 0; k < 16; ++k) dsum += ur[lane + 64 * k] * xs[lane + 64 * k];
#pragma unroll
        for (int off = 32; off > 0; off >>= 1) dsum += __shfl_xor(dsum, off);
        if (lane == 0) wv[i] = egate[(size_t)tok * 128 + i] * 0.5f * dsum * (1.f + erff(dsum * 0.70710678118654752f)); }
    __syncthreads();
    float acc[4] = {0.f, 0.f, 0.f, 0.f};
    for (int i = 0; i < 128; ++i) { const float* vr = pv + (size_t)es[i] * 1024; const float wi = wv[i];
#pragma unroll
        for (int k = 0; k < 4; ++k) acc[k] += wi * vr[t + 256 * k]; }
    float v[4]; float s = 0.f;
#pragma unroll
    for (int k = 0; k < 4; ++k) { v[k] = ALPHA_ * x1[k] + a[5120 + t + 256 * k] * acc[k]; s += v[k]; }
    red[t] = s; __syncthreads();
    for (int st = 128; st > 0; st >>= 1) { if (t < st) red[t] += red[t + st]; __syncthreads(); }
    const float mu = red[0] * (1.f / 1024.f); __syncthreads();
    float q = 0.f;
#pragma unroll
    for (int k = 0; k < 4; ++k) { const float dd = v[k] - mu; q += dd * dd; }
    red[t] = q; __syncthreads();
    for (int st = 128; st > 0; st >>= 1) { if (t < st) red[t] += red[t + st]; __syncthreads(); }
    const float rstd = rsqrtf(red[0] * (1.f / 1024.f) + LN_EPS_);
    const float* an = ada_next ? ada_next + (size_t)(tok >> 11) * 6144 : nullptr;
#pragma unroll
    for (int k = 0; k < 4; ++k) { const int d = t + 256 * k; const float y = (v[k] - mu) * rstd * g[d] + bta[d]; xio[(size_t)tok * 1024 + d] = y;
        if (an) ubuf[(size_t)tok * UYW_ + d] = f2bf(y * (1.f + an[1024 + d]) + an[d]); }
}

#define LAS __attribute__((address_space(3)))
typedef short bf16x8 __attribute__((ext_vector_type(8)));
typedef float f32x4 __attribute__((ext_vector_type(4)));
typedef float f32x2 __attribute__((ext_vector_type(2)));
typedef unsigned u32x4 __attribute__((ext_vector_type(4)));
typedef unsigned u32x2 __attribute__((ext_vector_type(2)));
namespace pg8 {
constexpr int BM = 256, BK = 64, HALF = 128, HTB = HALF * BK * 2, STAGE_BYTES = 8 * HTB, NXCD = 8, WGM = 8;
DEV int lds_byte(int r, int c) { const int st = (r >> 4) * 2 + (c >> 5), rr = r & 15, cc = c & 31, ob = rr * 64 + cc * 2; return st * 1024 + (ob ^ (((ob >> 9) & 1) << 5)); }
DEV void stage_rc(int b, int& R, int& C) { const int st = b / 1024, sb = b % 1024, swz = sb ^ (((sb >> 9) & 1) << 5); R = (st >> 1) * 16 + swz / 64; C = (st & 1) * 32 + (swz % 64) / 2; }
DEV int perm32(int rho) { const int n = rho >> 4, i = rho & 15; return 8 * (i >> 2) + 4 * n + (i & 3); }
DEV unsigned cvt_pk_bf16(float lo, float hi) { unsigned r; asm volatile("v_cvt_pk_bf16_f32 %0, %1, %2" : "=v"(r) : "v"(lo), "v"(hi)); return r; }

struct Unit { int pm, pn, tag, nt; const char* a; const char* b; };
DEV void tile_of(int L, int nM, int nN, int& pm, int& pn) {
    const int nwg = nM * nN; int wgid = L; { const int q = nwg / NXCD, r = nwg % NXCD, xcd = wgid % NXCD, off = wgid / NXCD; wgid = (xcd < r ? xcd * (q + 1) : r * (q + 1) + (xcd - r) * q) + off; }
    const int nig = WGM * nN, gid = wgid / nig, fm = gid * WGM, gsz = (nM - fm) < WGM ? (nM - fm) : WGM;
    pm = fm + ((wgid % nig) % gsz); pn = (wgid % nig) / gsz;
}
struct PlainSched { const bf16_t* A; const bf16_t* Bt; int lda, ldb, nM, nN, nt, G, c;
    DEV bool next(int i, Unit& u) const { const long L = (long)i * G + c; if (L >= (long)nM * nN) return false; tile_of((int)L, nM, nN, u.pm, u.pn); u.tag = 0; u.nt = nt;
        u.a = (const char*)(A + (size_t)u.pm * BM * lda); u.b = (const char*)(Bt + (size_t)u.pn * BM * ldb); return true; } };

template <class Epi, class Sched>
DEV void gemm_phase(LAS unsigned char* lds, const int lda, const int ldb, const Sched& S, const Epi& E, const int wv) {
    int wv_ = wv, ln_; asm volatile("v_mbcnt_lo_u32_b32 %1, -1, 0\n\tv_mbcnt_hi_u32_b32 %1, -1, %1" : "+s"(wv_), "=v"(ln_)); int tid_ = (wv_ << 6) | ln_;
    const int tid = tid_, wid = __builtin_amdgcn_readfirstlane(tid >> 6), lane = tid & 63, wr = wid >> 2, wc = wid & 3, fr = lane & 15, fq = lane >> 4;
    unsigned voffA[2], voffB[2];
#pragma unroll
    for (int i = 0; i < 2; ++i) { int R, C; stage_rc(tid * 16 + i * 8192, R, C); const int Rb = Epi::PERM ? ((R & ~31) + perm32(R & 31)) : R;
        voffA[i] = (unsigned)(R * lda + C) * 2u; voffB[i] = (unsigned)(Rb * ldb + C) * 2u; }
    const size_t kstep = (size_t)(BK * 2);
    const size_t hstepA = (size_t)HALF * lda * 2, hstepB = (size_t)HALF * ldb * 2;
    const unsigned ldsw = (unsigned)wid * 1024u;
    const int aoff = lds_byte(wr * 64 + fr, fq * 8), boff = lds_byte(wc * 32 + fr, fq * 8);
#define PG8_SA(b, h) (((b) * 2 + (h)) * HTB)
#define PG8_SB(b, h) ((4 + (b) * 2 + (h)) * HTB)
#define PG8_STAGE(bufoff, gbase, voff) do { _Pragma("unroll") for (int _i = 0; _i < 2; ++_i) \
        __builtin_amdgcn_global_load_lds((const unsigned*)((const char*)(gbase) + (voff)[_i]), (LAS unsigned*)(lds + (bufoff) + ldsw + _i * 8192), 16, 0, 0); } while (0)
#define PG8_LDA(dst, b, h) do { _Pragma("unroll") for (int m = 0; m < 4; ++m) _Pragma("unroll") for (int k = 0; k < 2; ++k) dst[m][k] = *(const LAS bf16x8*)(lds + PG8_SA(b, h) + aoff + m * 2048 + k * 1024); } while (0)
#define PG8_LDB(dst, b, h) do { _Pragma("unroll") for (int n = 0; n < 2; ++n) _Pragma("unroll") for (int k = 0; k < 2; ++k) dst[n][k] = *(const LAS bf16x8*)(lds + PG8_SB(b, h) + boff + n * 2048 + k * 1024); } while (0)
#define PG8_MMA(ai, bj, At, Bt) do { __builtin_amdgcn_s_setprio(1); _Pragma("unroll") for (int m = 0; m < 4; ++m) _Pragma("unroll") for (int n = 0; n < 2; ++n) _Pragma("unroll") for (int k = 0; k < 2; ++k) \
        acc[ai][bj][m][n] = __builtin_amdgcn_mfma_f32_16x16x32_bf16(Bt[n][k], At[m][k], acc[ai][bj][m][n], 0, 0, 0); __builtin_amdgcn_s_setprio(0); } while (0)
#define PG8_WAIT_V(n) asm volatile("s_waitcnt vmcnt(" #n ")" ::: "memory")
#define PG8_WAIT_L(n) asm volatile("s_waitcnt lgkmcnt(" #n ")" ::: "memory")
#define PG8_BAR __builtin_amdgcn_s_barrier()
#define PG8_SCHED __builtin_amdgcn_sched_barrier(0)
    Unit cur, nxt; int ui = 0;
    if (!S.next(0, cur)) return;
    f32x4 acc[2][2][4][2];
#pragma unroll
    for (int a = 0; a < 2; ++a)
#pragma unroll
        for (int b = 0; b < 2; ++b)
#pragma unroll
            for (int m = 0; m < 4; ++m)
#pragma unroll
                for (int n = 0; n < 2; ++n) acc[a][b][m][n] = (f32x4){0.f, 0.f, 0.f, 0.f};
    bf16x8 At[4][2], B0[2][2], B1[2][2];
    const char* cA = cur.a; const char* cB = cur.b;
    PG8_STAGE(PG8_SB(0, 0), cB, voffB); PG8_STAGE(PG8_SA(0, 0), cA, voffA); PG8_STAGE(PG8_SB(0, 1), cB + hstepB, voffB); PG8_STAGE(PG8_SA(0, 1), cA + hstepA, voffA);
    if (wr == 1) PG8_BAR;
    PG8_WAIT_V(4); PG8_BAR;
    PG8_STAGE(PG8_SB(1, 0), cB + kstep, voffB); PG8_STAGE(PG8_SA(1, 0), cA + kstep, voffA); PG8_STAGE(PG8_SB(1, 1), cB + hstepB + kstep, voffB);
    PG8_WAIT_V(6); PG8_BAR;
    for (;;) {
        const bool has_next = S.next(ui + 1, nxt);
        const char* nA = has_next ? nxt.a : cA; const char* nB = has_next ? nxt.b : cB;
        const int nt = cur.nt;
        for (int t = 0; t < nt; t += 2) {
            const bool last = (t == nt - 2);
            const char* a1 = cA + (size_t)(t + 1) * kstep;
            const char* a2 = last ? nA : cA + (size_t)(t + 2) * kstep; const char* b2 = last ? nB : cB + (size_t)(t + 2) * kstep;
            const char* a3 = a2 + kstep; const char* b3 = b2 + kstep;
            PG8_LDB(B0, 0, 0); PG8_SCHED; PG8_LDA(At, 0, 0); PG8_STAGE(PG8_SA(1, 1), a1 + hstepA, voffA);
            PG8_WAIT_L(8); PG8_BAR; PG8_WAIT_L(0); PG8_MMA(0, 0, At, B0); PG8_BAR; PG8_SCHED;
            PG8_LDB(B1, 0, 1); PG8_STAGE(PG8_SB(0, 0), b2, voffB);
            PG8_BAR; PG8_WAIT_L(0); PG8_MMA(0, 1, At, B1); PG8_BAR;
            PG8_LDA(At, 0, 1); PG8_STAGE(PG8_SA(0, 0), a2, voffA);
            PG8_BAR; PG8_WAIT_L(0); PG8_MMA(1, 0, At, B0); PG8_BAR; PG8_SCHED;
            PG8_STAGE(PG8_SB(0, 1), b2 + hstepB, voffB);
            PG8_WAIT_V(6); PG8_BAR; PG8_MMA(1, 1, At, B1); PG8_BAR;
            PG8_LDB(B0, 1, 0); PG8_SCHED; PG8_LDA(At, 1, 0); PG8_STAGE(PG8_SA(0, 1), a2 + hstepA, voffA);
            PG8_WAIT_L(8); PG8_BAR; PG8_WAIT_L(0); PG8_MMA(0, 0, At, B0); PG8_BAR; PG8_SCHED;
            PG8_LDB(B1, 1, 1); PG8_STAGE(PG8_SB(1, 0), b3, voffB);
            PG8_BAR; PG8_WAIT_L(0); PG8_MMA(0, 1, At, B1); PG8_BAR;
            PG8_LDA(At, 1, 1); PG8_STAGE(PG8_SA(1, 0), a3, voffA);
            PG8_BAR; PG8_WAIT_L(0); PG8_MMA(1, 0, At, B0); PG8_BAR; PG8_SCHED;
            PG8_STAGE(PG8_SB(1, 1), b3 + hstepB, voffB);
            PG8_WAIT_V(6); PG8_BAR; PG8_MMA(1, 1, At, B1); PG8_BAR;
        }
        E(acc, cur, wr, wc, fr, fq);
        if (!has_next) break;
#pragma unroll
        for (int a = 0; a < 2; ++a)
#pragma unroll
            for (int b = 0; b < 2; ++b)
#pragma unroll
                for (int m = 0; m < 4; ++m)
#pragma unroll
                    for (int n = 0; n < 2; ++n) acc[a][b][m][n] = (f32x4){0.f, 0.f, 0.f, 0.f};
        cur = nxt; cA = nA; cB = nB; ++ui;
    }
    PG8_WAIT_V(0);
    if (wr == 0) PG8_BAR;
    PG8_BAR;
#undef PG8_SA
#undef PG8_SB
#undef PG8_STAGE
#undef PG8_LDA
#undef PG8_LDB
#undef PG8_MMA
#undef PG8_WAIT_V
#undef PG8_WAIT_L
#undef PG8_BAR
#undef PG8_SCHED
}
struct EpiBf { static constexpr bool PERM = true; bf16_t* O; int ldc; int pad;
    DEV void operator()(const f32x4 (&acc)[2][2][4][2], const Unit& u, int wr, int wc, int fr, int fq) const {
        const int row0 = u.pm * BM + wr * 64 + fr, col0 = u.pn * BM + wc * 32 + 8 * fq;
#pragma unroll
        for (int ai = 0; ai < 2; ++ai)
#pragma unroll
            for (int m = 0; m < 4; ++m) { bf16_t* rowp = O + (size_t)(row0 + ai * HALF + m * 16) * ldc + col0;
#pragma unroll
                for (int bj = 0; bj < 2; ++bj) { const f32x4 v0 = acc[ai][bj][m][0], v1 = acc[ai][bj][m][1];
                    u32x4 w; w.x = cvt_pk_bf16(v0[0], v0[1]); w.y = cvt_pk_bf16(v0[2], v0[3]); w.z = cvt_pk_bf16(v1[0], v1[1]); w.w = cvt_pk_bf16(v1[2], v1[3]);
                    *(u32x4*)(rowp + bj * HALF) = w; } }
    } };
struct EpiP { static constexpr bool PERM = true; bf16_t* P; const float2* rope;
    DEV void operator()(const f32x4 (&acc)[2][2][4][2], const Unit& u, int wr, int wc, int fr, int fq) const {
        const int row0 = u.pm * BM + wr * 64 + fr, col0 = u.pn * BM + wc * 32 + 8 * fq; const int g = (wc & 1) * 4 + fq; const int pn = u.pn;
        const bool qs = (pn < 3) || (pn == 9) || (pn == 10);
#pragma unroll
        for (int ai = 0; ai < 2; ++ai)
#pragma unroll
            for (int m = 0; m < 4; ++m) { const int row = row0 + ai * HALF + m * 16; bf16_t* rowp = P + (size_t)row * PW_ + col0;
                const float4* rp = (const float4*)(rope + (size_t)(row & 2047) * 32 + 4 * g); const float4 cs0 = rp[0], cs1 = rp[1];
                const float cc[4] = {cs0.x, cs0.z, cs1.x, cs1.z}, ss[4] = {cs0.y, cs0.w, cs1.y, cs1.w};
#pragma unroll
                for (int bj = 0; bj < 2; ++bj) { f32x4 v0 = acc[ai][bj][m][0], v1 = acc[ai][bj][m][1];
                    const bool rp_ = (pn < 6) || (pn == 9) || (pn == 10) || (pn == 11 && bj == 0);
                    if (rp_) {
#pragma unroll
                        for (int j = 0; j < 4; ++j) { const float x1 = v0[j], x2 = v1[j]; float o1 = x1 * cc[j] - x2 * ss[j], o2 = x2 * cc[j] + x1 * ss[j];
                            if (qs) { o1 *= QSCALE_; o2 *= QSCALE_; } v0[j] = o1; v1[j] = o2; } }
                    u32x4 w; w.x = cvt_pk_bf16(v0[0], v0[1]); w.y = cvt_pk_bf16(v0[2], v0[3]); w.z = cvt_pk_bf16(v1[0], v1[1]); w.w = cvt_pk_bf16(v1[2], v1[3]);
                    *(u32x4*)(rowp + bj * HALF) = w; } }
    } };
struct EpiMergeAll { static constexpr bool PERM = true; bf16_t* gtmp; bf16_t* merged;
    DEV void operator()(const f32x4 (&acc)[2][2][4][2], const Unit& u, int wr, int wc, int fr, int fq) const {
        const int row0 = u.pm * BM + wr * 64 + fr, col0 = u.pn * BM + wc * 32 + 8 * fq; const int tag = u.tag;
#pragma unroll
        for (int ai = 0; ai < 2; ++ai)
#pragma unroll
            for (int m = 0; m < 4; ++m) { const size_t ro = (size_t)(row0 + ai * HALF + m * 16) * 1024 + col0;
#pragma unroll
                for (int bj = 0; bj < 2; ++bj) { f32x4 v0 = acc[ai][bj][m][0], v1 = acc[ai][bj][m][1]; const size_t o = ro + bj * HALF;
                    if ((tag & 1) == 0) {
#pragma unroll
                        for (int j = 0; j < 4; ++j) { v0[j] = 1.f / (1.f + __expf(-v0[j])); v1[j] = 1.f / (1.f + __expf(-v1[j])); }
                        u32x4 w; w.x = cvt_pk_bf16(v0[0], v0[1]); w.y = cvt_pk_bf16(v0[2], v0[3]); w.z = cvt_pk_bf16(v1[0], v1[1]); w.w = cvt_pk_bf16(v1[2], v1[3]);
                        *(u32x4*)(gtmp + o) = w;
                    } else {
                        const u32x4 gq = *(const u32x4*)(gtmp + o);
                        float gg[8] = {__uint_as_float(gq.x << 16), __uint_as_float(gq.x & 0xffff0000u), __uint_as_float(gq.y << 16), __uint_as_float(gq.y & 0xffff0000u),
                                       __uint_as_float(gq.z << 16), __uint_as_float(gq.z & 0xffff0000u), __uint_as_float(gq.w << 16), __uint_as_float(gq.w & 0xffff0000u)};
#pragma unroll
                        for (int j = 0; j < 4; ++j) { v0[j] *= gg[j]; v1[j] *= gg[4 + j]; }
                        if (tag != 1) { const u32x4 mq = *(const u32x4*)(merged + o);
                            float mm[8] = {__uint_as_float(mq.x << 16), __uint_as_float(mq.x & 0xffff0000u), __uint_as_float(mq.y << 16), __uint_as_float(mq.y & 0xffff0000u),
                                           __uint_as_float(mq.z << 16), __uint_as_float(mq.z & 0xffff0000u), __uint_as_float(mq.w << 16), __uint_as_float(mq.w & 0xffff0000u)};
#pragma unroll
                            for (int j = 0; j < 4; ++j) { v0[j] += mm[j]; v1[j] += mm[4 + j]; } }
                        u32x4 w; w.x = cvt_pk_bf16(v0[0], v0[1]); w.y = cvt_pk_bf16(v0[2], v0[3]); w.z = cvt_pk_bf16(v1[0], v1[1]); w.w = cvt_pk_bf16(v1[2], v1[3]);
                        *(u32x4*)(merged + o) = w;
                    } } }
    } };
struct EpiOut { static constexpr bool PERM = false; const float* xin; float* h; const float* ada_g;
    DEV void operator()(const f32x4 (&acc)[2][2][4][2], const Unit& u, int wr, int wc, int fr, int fq) const {
        const int row0 = u.pm * BM + wr * 64 + fr, col0 = u.pn * BM + wc * 32 + 4 * fq; const float* gv = ada_g + (size_t)(u.pm >> 3) * 6144 + col0;
        f32x4 g[2][2];
#pragma unroll
        for (int bj = 0; bj < 2; ++bj)
#pragma unroll
            for (int n = 0; n < 2; ++n) g[bj][n] = *(const f32x4*)(gv + bj * HALF + n * 16);
#pragma unroll
        for (int ai = 0; ai < 2; ++ai)
#pragma unroll
            for (int m = 0; m < 4; ++m) { const size_t ro = (size_t)(row0 + ai * HALF + m * 16) * 1024 + col0;
#pragma unroll
                for (int bj = 0; bj < 2; ++bj)
#pragma unroll
                    for (int n = 0; n < 2; ++n) { const size_t o = ro + bj * HALF + n * 16; const f32x4 xv = *(const f32x4*)(xin + o); *(f32x4*)(h + o) = ALPHA_ * xv + g[bj][n] * acc[ai][bj][m][n]; } }
    } };
struct MergeSched { const bf16_t* UY; const bf16_t* WmT; int G, c;
    DEV bool next(int i, Unit& u) const { const int ti = i / 6, ps = i - ti * 6; const long L = (long)ti * G + c; if (L >= 128 * 4) return false; tile_of((int)L, 128, 4, u.pm, u.pn); u.tag = ps;
        const int br = ps >> 1; const bf16_t* ar = UY + (size_t)u.pm * BM * UYW_; const bf16_t* brow = WmT + (size_t)u.pn * BM * WMW_;
        if ((ps & 1) == 0) { u.nt = 16; u.a = (const char*)ar; u.b = (const char*)(brow + br * 1024); }
        else { const int koff = br == 0 ? 0 : (br == 1 ? 256 : 768); u.nt = br == 0 ? 4 : 8; u.a = (const char*)(ar + 1024 + koff); u.b = (const char*)(brow + 3072 + koff); }
        return true; } };
}

DEV int win_orig_col(int n) {
    if (n >= 3072) return n < 4608 ? (n - 3072 + 2304) : n;
    const int head = n >> 6, p = n & 63; const bool rp = (head < 24) || (head >= 36 && head < 46);
    const int d = rp ? ((p & 4) ? 32 + 4 * (p >> 3) + (p & 3) : 4 * (p >> 3) + (p & 3)) : p;
    return ((n < 2304) ? head * 64 : 3840 + (head - 36) * 64) + d;
}
struct WPrep { const float *w_in, *wba, *wbb, *wbc, *w_out, *peer_wq; bf16_t *WinT, *WmT, *WoutT, *WqT; };
DEV void nb_wprep(int vb, int t, unsigned char* sm, const WPrep& q) {
    const int l = vb / 3008; int r = vb - l * 3008; const float* W; int ldw; bf16_t* Wt; int ldt, koff = 0, ntk = 16, mode = 0, nsub = 0;
    if (r < 1920) { W = q.w_in + (size_t)l * 1024 * 7680; ldw = 7680; mode = 1;
        if (r < 72 * 16) { Wt = q.WinT + (size_t)l * 7680 * 1024; ldt = 1024; }
        else { const int br = (r / 16 - 72) / 16; Wt = q.WmT + (size_t)l * 1024 * WMW_; ldt = WMW_; koff = br * 1024; nsub = 4608 + br * 1024; } }
    else if (r < 1984) { r -= 1920; W = q.wba + (size_t)l * 256 * 1024; ldw = 1024; Wt = q.WmT + (size_t)l * 1024 * WMW_; ldt = WMW_; koff = 3072; ntk = 4; }
    else if (r < 2112) { r -= 1984; W = q.wbb + (size_t)l * 512 * 1024; ldw = 1024; Wt = q.WmT + (size_t)l * 1024 * WMW_; ldt = WMW_; koff = 3072 + 256; ntk = 8; }
    else if (r < 2240) { r -= 2112; W = q.wbc + (size_t)l * 512 * 1024; ldw = 1024; Wt = q.WmT + (size_t)l * 1024 * WMW_; ldt = WMW_; koff = 3072 + 768; ntk = 8; }
    else if (r < 2496) { r -= 2240; W = q.w_out + (size_t)l * 1024 * 1024; ldw = 1024; Wt = q.WoutT + (size_t)l * 1024 * 1024; ldt = 1024; }
    else { r -= 2496; W = q.peer_wq + (size_t)l * 1024 * 2048; ldw = 2048; Wt = q.WqT + (size_t)l * 2048 * 1024; ldt = 1024; }
    const int n0 = (r / ntk) * 64, k0 = (r % ntk) * 64; const int c0 = mode ? (win_orig_col(n0) & ~63) : n0;
    bf16_t* tile = (bf16_t*)sm;
    { const int kk = t >> 2, cs = (t & 3) * 16; const float* src = W + (size_t)(k0 + kk) * ldw + c0 + cs;
#pragma unroll
        for (int i = 0; i < 16; i += 4) { const float4 v = *(const float4*)(src + i); tile[kk * 66 + cs + i] = f2bf(v.x); tile[kk * 66 + cs + i + 1] = f2bf(v.y); tile[kk * 66 + cs + i + 2] = f2bf(v.z); tile[kk * 66 + cs + i + 3] = f2bf(v.w); } }
    __syncthreads();
    { const int nn = t >> 2, ks = (t & 3) * 16; const int dl = mode ? (win_orig_col(n0 + nn) - c0) : nn; bf16_t* dst = Wt + (size_t)(n0 + nn - nsub) * ldt + koff + k0 + ks;
        unsigned w[8];
#pragma unroll
        for (int i = 0; i < 8; ++i) w[i] = (unsigned)tile[(ks + 2 * i) * 66 + dl] | ((unsigned)tile[(ks + 2 * i + 1) * 66 + dl] << 16);
        *(u32x4*)dst = (u32x4){w[0], w[1], w[2], w[3]}; *(u32x4*)(dst + 8) = (u32x4){w[4], w[5], w[6], w[7]}; }
}

namespace hy {
constexpr int ZS = 2064;
constexpr int G0_OFF = 0, G1_OFF = 8192, Z0_OFF = 16384, Z1_OFF = Z0_OFF + 16 * ZS * 2, LDS_END = Z1_OFF + 16 * ZS * 2;
DEV bf16x8 load_frag(LAS const unsigned char* lane_base, int d) {
    const LAS unsigned* p = (const LAS unsigned*)(lane_base + 32 * d); u32x4 w; w.x = p[0]; w.y = p[1]; w.z = p[2]; w.w = p[3];
    return __builtin_bit_cast(bf16x8, w);
}
DEV void load_filter(LAS unsigned char* lds, const bf16_t* g, int tid) {
    const u32x4 c = *(const u32x4*)(g + tid * 8); const unsigned nx = (tid < 511) ? (unsigned)g[tid * 8 + 8] : 0u;
    *(LAS u32x4*)(lds + G0_OFF + tid * 16) = c;
    u32x4 s; s.x = (c.x >> 16) | (c.y << 16); s.y = (c.y >> 16) | (c.z << 16); s.z = (c.z >> 16) | (c.w << 16); s.w = (c.w >> 16) | (nx << 16);
    *(LAS u32x4*)(lds + G1_OFF + tid * 16) = s;
}
DEV float bflo(unsigned w) { return __uint_as_float(w << 16); }
DEV float bfhi(unsigned w) { return __uint_as_float(w & 0xffff0000u); }
DEV void conv_rows(LAS const unsigned char* lds, int zoff, int w, int lane, f32x4 (&D)[16]) {
    const int r = lane & 15, q = lane >> 4;
    LAS const unsigned char* abase = lds + ((r & 1) ? (G0_OFF + 2 * (8 * q - r + 2047)) : (G1_OFF + 2 * (8 * q - r + 2046)));
    LAS const unsigned char* bbase = lds + zoff + (r * ZS + 8 * q) * 2;
    bf16x8 ring[16];
#pragma unroll
    for (int rb = 0; rb < 16; ++rb) D[rb] = (f32x4){0.f, 0.f, 0.f, 0.f};
#pragma unroll
    for (int rb = 2; rb < 16; ++rb) ring[rb] = load_frag(abase, -16 * w - rb);
#pragma unroll 1
    for (int jb0 = 0; jb0 < 64; jb0 += 8) {
#pragma unroll
        for (int u = 0; u < 8; ++u) { const int jb = jb0 + u;
            ring[(16 - 2 * u) & 15] = load_frag(abase, 2 * jb - 16 * w);
            ring[(17 - 2 * u) & 15] = load_frag(abase, 2 * jb - 16 * w - 1);
            const bf16x8 bf = *(const LAS bf16x8*)(bbase + 64 * jb);
#pragma unroll
            for (int rb = 0; rb < 16; ++rb) D[rb] = __builtin_amdgcn_mfma_f32_16x16x32_bf16(ring[(rb - 2 * u) & 15], bf, D[rb], 0, 0, 0);
        }
    }
}
DEV void sconv4(const bf16_t* in, int i, float w0, float w1, float w2, float cb, float (&o)[4]) {
    const u32x2 v = *(const u32x2*)(in + i); const float pm = (i > 0) ? bf2f(in[i - 1]) : 0.f, pn = (i + 4 < 2048) ? bf2f(in[i + 4]) : 0.f;
    const float x0 = bflo(v.x), x1 = bfhi(v.x), x2 = bflo(v.y), x3 = bfhi(v.y);
    o[0] = cb + w0 * pm + w1 * x0 + w2 * x1; o[1] = cb + w0 * x0 + w1 * x1 + w2 * x2; o[2] = cb + w0 * x1 + w1 * x2 + w2 * x3; o[3] = cb + w0 * x2 + w1 * x3 + w2 * pn;
}
DEV void hyena_phase(LAS unsigned char* lds, bf16_t* hyT, const bf16_t* Gr_l, const float* conv_w, const float* conv_b, const float* hy_bias, int G, int cblk, int wv) {
    int wv_ = wv, ln_; asm volatile("v_mbcnt_lo_u32_b32 %1, -1, 0\n\tv_mbcnt_hi_u32_b32 %1, -1, %1" : "+s"(wv_), "=v"(ln_)); int tid_ = (wv_ << 6) | ln_;
    const int tid = tid_, w = __builtin_amdgcn_readfirstlane(tid >> 6), lane = tid & 63, q = lane >> 4, b = lane & 15;
#pragma unroll 1
    for (int c = cblk; c < 512; c += G) {
        __syncthreads();
        load_filter(lds, Gr_l + (size_t)c * 4096, tid);
        { const float w0 = conv_w[c], w1 = conv_w[1536 + c], w2 = conv_w[3072 + c], cb = conv_b[c]; const bf16_t* row = hyT + (size_t)c * T_;
#pragma unroll 2
            for (int k = 0; k < 8; ++k) { const int pos = (k * 512 + tid) * 8; const int s = pos & 2047, bb = pos >> 11;
                const u32x4 v = *(const u32x4*)(row + pos); const float pm = (s > 0) ? bf2f(row[pos - 1]) : 0.f, pn = (s + 8 < 2048) ? bf2f(row[pos + 8]) : 0.f;
                const float x[10] = {pm, bflo(v.x), bfhi(v.x), bflo(v.y), bfhi(v.y), bflo(v.z), bfhi(v.z), bflo(v.w), bfhi(v.w), pn};
                float z[8];
#pragma unroll
                for (int e = 0; e < 8; ++e) z[e] = cb + w0 * x[e] + w1 * x[e + 1] + w2 * x[e + 2];
                u32x4 o; o.x = pg8::cvt_pk_bf16(z[0], z[1]); o.y = pg8::cvt_pk_bf16(z[2], z[3]); o.z = pg8::cvt_pk_bf16(z[4], z[5]); o.w = pg8::cvt_pk_bf16(z[6], z[7]);
                *(LAS u32x4*)(lds + Z0_OFF + (bb * ZS + s) * 2) = o; } }
        __syncthreads();
        f32x4 D[16];
        conv_rows(lds, Z0_OFF, w, lane, D);
        { const int xc = 512 + c; const float w0 = conv_w[xc], w1 = conv_w[1536 + xc], w2 = conv_w[3072 + xc], cb = conv_b[xc], bias = hy_bias[c]; const bf16_t* xin = hyT + (size_t)xc * T_ + b * 2048;
#pragma unroll
            for (int rb = 0; rb < 16; ++rb) { const int i = 256 * w + 16 * rb + 4 * q; float xv[4]; sconv4(xin, i, w0, w1, w2, cb, xv);
                const u32x2 zq = *(const LAS u32x2*)(lds + Z0_OFF + (b * ZS + i) * 2); const float zv[4] = {bflo(zq.x), bfhi(zq.x), bflo(zq.y), bfhi(zq.y)};
                float o[4];
#pragma unroll
                for (int e = 0; e < 4; ++e) o[e] = xv[e] * (D[rb][e] + bias * zv[e]);
                u32x2 pk; pk.x = pg8::cvt_pk_bf16(o[0], o[1]); pk.y = pg8::cvt_pk_bf16(o[2], o[3]);
                *(LAS u32x2*)(lds + Z1_OFF + (b * ZS + i) * 2) = pk; } }
        __syncthreads();
        load_filter(lds, Gr_l + (size_t)(512 + c) * 4096, tid);
        __syncthreads();
        conv_rows(lds, Z1_OFF, w, lane, D);
        { const int xc = 1024 + c; const float w0 = conv_w[xc], w1 = conv_w[1536 + xc], w2 = conv_w[3072 + xc], cb = conv_b[xc], bias = hy_bias[512 + c]; const bf16_t* xin = hyT + (size_t)xc * T_ + b * 2048;
            bf16_t* yout = hyT + (size_t)c * T_ + b * 2048;
#pragma unroll
            for (int rb = 0; rb < 16; ++rb) { const int i = 256 * w + 16 * rb + 4 * q; float xv[4]; sconv4(xin, i, w0, w1, w2, cb, xv);
                const u32x2 zq = *(const LAS u32x2*)(lds + Z1_OFF + (b * ZS + i) * 2); const float zv[4] = {bflo(zq.x), bfhi(zq.x), bflo(zq.y), bfhi(zq.y)};
                float o[4];
#pragma unroll
                for (int e = 0; e < 4; ++e) o[e] = xv[e] * (D[rb][e] + bias * zv[e]);
                u32x2 pk; pk.x = pg8::cvt_pk_bf16(o[0], o[1]); pk.y = pg8::cvt_pk_bf16(o[2], o[3]);
                *(u32x2*)(yout + i) = pk; } }
    }
    __syncthreads();
}
}

namespace peer {
DEV float wave_sum(float v, int lane) {
#pragma unroll
    for (int off = 32; off > 0; off >>= 1) v += xor_f(v, off, lane);
    return v;
}
DEV float wave_max(float v, int lane) {
#pragma unroll
    for (int off = 32; off > 0; off >>= 1) v = fmaxf(v, xor_f(v, off, lane));
    return v;
}
DEV unsigned pk4_fp8(float a, float b, float c, float d) { int w = __builtin_amdgcn_cvt_pk_fp8_f32(a, b, 0, false); w = __builtin_amdgcn_cvt_pk_fp8_f32(c, d, w, true); return (unsigned)w; }
DEV void nb_quant_tables(int vb, int t, const float* __restrict__ pu, const float* __restrict__ pv, unsigned char* __restrict__ U8, unsigned char* __restrict__ V8, float* __restrict__ sinv) {
    const int row = vb * 4 + (t >> 6), lane = t & 63; const float* src = (row < 16384) ? pu + (size_t)row * 1024 : pv + (size_t)(row - 16384) * 1024;
    const float4 a = *(const float4*)(src + 16 * lane), b = *(const float4*)(src + 16 * lane + 4), c = *(const float4*)(src + 16 * lane + 8), d = *(const float4*)(src + 16 * lane + 12);
    float mx = fmaxf(fmaxf(fmaxf(fabsf(a.x), fabsf(a.y)), fmaxf(fabsf(a.z), fabsf(a.w))), fmaxf(fmaxf(fabsf(b.x), fabsf(b.y)), fmaxf(fabsf(b.z), fabsf(b.w))));
    mx = fmaxf(mx, fmaxf(fmaxf(fmaxf(fabsf(c.x), fabsf(c.y)), fmaxf(fabsf(c.z), fabsf(c.w))), fmaxf(fmaxf(fabsf(d.x), fabsf(d.y)), fmaxf(fabsf(d.z), fabsf(d.w)))));
    mx = wave_max(mx, lane); const float sc = (mx > 0.f) ? 224.f / mx : 1.f;
    u32x4 o; o.x = pk4_fp8(a.x * sc, a.y * sc, a.z * sc, a.w * sc); o.y = pk4_fp8(b.x * sc, b.y * sc, b.z * sc, b.w * sc); o.z = pk4_fp8(c.x * sc, c.y * sc, c.z * sc, c.w * sc); o.w = pk4_fp8(d.x * sc, d.y * sc, d.z * sc, d.w * sc);
    unsigned char* dst = (row < 16384) ? U8 + (size_t)row * 1024 : V8 + (size_t)(row - 16384) * 1024;
    *(u32x4*)(dst + 16 * lane) = o;
    if (lane == 0) sinv[row] = (mx > 0.f) ? mx * (1.f / 224.f) : 1.f;
}
DEV void peer_phase(LAS unsigned char* lds, float* xio, const float* ada_l, const int* __restrict__ eidx, const float* __restrict__ egate, const unsigned char* __restrict__ U8, const unsigned char* __restrict__ V8,
                    const float* __restrict__ sinv, const float* __restrict__ g, const float* __restrict__ bta, const float* ada_next, bf16_t* UY, int G, int cblk, int wv) {
    int wv_ = wv, ln_; asm volatile("v_mbcnt_lo_u32_b32 %1, -1, 0\n\tv_mbcnt_hi_u32_b32 %1, -1, %1" : "+s"(wv_), "=v"(ln_)); int tid_ = (wv_ << 6) | ln_;
    const int tid = tid_, w = __builtin_amdgcn_readfirstlane(tid >> 6), lane = tid & 63, q = lane >> 4, n = lane & 15;
    LAS unsigned char* urow_l = lds + w * 3072; LAS int* E_l = (LAS int*)(urow_l + 1024); LAS float* W_l = (LAS float*)(urow_l + 1536); LAS float* SU_l = (LAS float*)(urow_l + 2048); LAS float* SV_l = (LAS float*)(urow_l + 2560);
    const int d0 = 16 * lane;
#define PEER_SB __builtin_amdgcn_sched_barrier(0)
#define PEER_ISSUE_U(buf, gi, hf) do { const int e_ = E_l[(gi) * 16 + n]; const unsigned char* ur_ = U8 + (size_t)e_ * 1024 + 16 * q + 512 * (hf); _Pragma("unroll") for (int k2 = 0; k2 < 8; ++k2) buf[k2] = *(const u32x4*)(ur_ + 64 * k2); } while (0)
#define PEER_ISSUE_V(buf, gi, hf) do { _Pragma("unroll") for (int n2 = 0; n2 < 8; ++n2) { const int e_ = E_l[(gi) * 16 + 8 * (hf) + n2]; buf[n2] = *(const u32x4*)(V8 + (size_t)e_ * 1024 + d0); } } while (0)
#define PEER_COMP_U(buf, hf) do { _Pragma("unroll") for (int k2 = 0; k2 < 8; ++k2) { const u32x4 bw = buf[k2]; const u32x4 aw = *(const LAS u32x4*)(urow_l + 512 * (hf) + 64 * k2 + 16 * q); \
            const long a0 = (long)(((unsigned long long)aw.y << 32) | aw.x), a1 = (long)(((unsigned long long)aw.w << 32) | aw.z); \
            const long b0 = (long)(((unsigned long long)bw.y << 32) | bw.x), b1 = (long)(((unsigned long long)bw.w << 32) | bw.z); \
            acc = __builtin_amdgcn_mfma_f32_16x16x32_fp8_fp8(a0, b0, acc, 0, 0, 0); acc = __builtin_amdgcn_mfma_f32_16x16x32_fp8_fp8(a1, b1, acc, 0, 0, 0); } } while (0)
#define PEER_COMP_V(buf, gi, hf) do { _Pragma("unroll") for (int n2 = 0; n2 < 8; ++n2) { const float wt = W_l[(gi) * 16 + 8 * (hf) + n2]; const u32x4 v = buf[n2]; \
            const f32x2 f0 = __builtin_amdgcn_cvt_pk_f32_fp8((int)v.x, false), f1 = __builtin_amdgcn_cvt_pk_f32_fp8((int)v.x, true), f2 = __builtin_amdgcn_cvt_pk_f32_fp8((int)v.y, false), f3 = __builtin_amdgcn_cvt_pk_f32_fp8((int)v.y, true); \
            const f32x2 f4 = __builtin_amdgcn_cvt_pk_f32_fp8((int)v.z, false), f5 = __builtin_amdgcn_cvt_pk_f32_fp8((int)v.z, true), f6 = __builtin_amdgcn_cvt_pk_f32_fp8((int)v.w, false), f7 = __builtin_amdgcn_cvt_pk_f32_fp8((int)v.w, true); \
            o[0] += wt * f0[0]; o[1] += wt * f0[1]; o[2] += wt * f1[0]; o[3] += wt * f1[1]; o[4] += wt * f2[0]; o[5] += wt * f2[1]; o[6] += wt * f3[0]; o[7] += wt * f3[1]; \
            o[8] += wt * f4[0]; o[9] += wt * f4[1]; o[10] += wt * f5[0]; o[11] += wt * f5[1]; o[12] += wt * f6[0]; o[13] += wt * f6[1]; o[14] += wt * f7[0]; o[15] += wt * f7[1]; } } while (0)
#pragma unroll 1
    for (int tok = cblk * 8 + w; tok < T_; tok += G * 8) {
        const float* a = ada_l + (size_t)(tok >> 11) * 6144; float* xr = xio + (size_t)tok * 1024 + d0;
        float stinv;
        {
            const int e0 = eidx[(size_t)tok * 128 + lane], e1 = eidx[(size_t)tok * 128 + 64 + lane];
            const float g0 = egate[(size_t)tok * 128 + lane], g1 = egate[(size_t)tok * 128 + 64 + lane];
            float x1[16];
#pragma unroll
            for (int j = 0; j < 16; j += 4) { const float4 v = *(const float4*)(xr + j); x1[j] = v.x; x1[j + 1] = v.y; x1[j + 2] = v.z; x1[j + 3] = v.w; }
            E_l[lane] = e0; E_l[64 + lane] = e1; W_l[lane] = g0; W_l[64 + lane] = g1;
            SU_l[lane] = sinv[e0]; SU_l[64 + lane] = sinv[e1]; SV_l[lane] = sinv[16384 + e0]; SV_l[64 + lane] = sinv[16384 + e1];
            float u[16]; float um = 0.f;
#pragma unroll
            for (int j = 0; j < 16; j += 4) { const float4 sc = *(const float4*)(a + 4096 + d0 + j), sh = *(const float4*)(a + 3072 + d0 + j);
                u[j] = x1[j] * (1.f + sc.x) + sh.x; u[j + 1] = x1[j + 1] * (1.f + sc.y) + sh.y; u[j + 2] = x1[j + 2] * (1.f + sc.z) + sh.z; u[j + 3] = x1[j + 3] * (1.f + sc.w) + sh.w;
                um = fmaxf(um, fmaxf(fmaxf(fabsf(u[j]), fabsf(u[j + 1])), fmaxf(fabsf(u[j + 2]), fabsf(u[j + 3])))); }
            um = wave_max(um, lane); const float st = (um > 0.f) ? 224.f / um : 1.f; stinv = (um > 0.f) ? um * (1.f / 224.f) : 1.f;
            u32x4 pq; pq.x = pk4_fp8(u[0] * st, u[1] * st, u[2] * st, u[3] * st); pq.y = pk4_fp8(u[4] * st, u[5] * st, u[6] * st, u[7] * st);
            pq.z = pk4_fp8(u[8] * st, u[9] * st, u[10] * st, u[11] * st); pq.w = pk4_fp8(u[12] * st, u[13] * st, u[14] * st, u[15] * st);
            *(LAS u32x4*)(urow_l + d0) = pq; }
        asm volatile("s_waitcnt lgkmcnt(0)" ::: "memory");
        u32x4 bufA[8], bufB[8];
        PEER_ISSUE_U(bufA, 0, 0); PEER_SB;
#pragma unroll 1
        for (int gi = 0; gi < 8; ++gi) { f32x4 acc = (f32x4){0.f, 0.f, 0.f, 0.f};
            PEER_ISSUE_U(bufB, gi, 1); PEER_SB; PEER_COMP_U(bufA, 0); PEER_SB;
            if (gi < 7) PEER_ISSUE_U(bufA, gi + 1, 0); else PEER_ISSUE_V(bufA, 0, 0);
            PEER_SB; PEER_COMP_U(bufB, 1);
            const float ds_ = acc[0] * (SU_l[gi * 16 + n] * stinv); const float wv_ = W_l[gi * 16 + n] * 0.5f * ds_ * (1.f + erff(ds_ * 0.70710678118654752f)) * SV_l[gi * 16 + n];
            if (q == 0) W_l[gi * 16 + n] = wv_;
            PEER_SB; }
        asm volatile("s_waitcnt lgkmcnt(0)" ::: "memory");
        float o[16];
#pragma unroll
        for (int j = 0; j < 16; ++j) o[j] = 0.f;
#pragma unroll 1
        for (int gi = 0; gi < 8; ++gi) {
            PEER_ISSUE_V(bufB, gi, 1); PEER_SB; PEER_COMP_V(bufA, gi, 0); PEER_SB;
            if (gi < 7) PEER_ISSUE_V(bufA, gi + 1, 0);
            PEER_SB; PEER_COMP_V(bufB, gi, 1); PEER_SB; }
        float hv[16]; float s = 0.f;
#pragma unroll
        for (int j = 0; j < 16; j += 4) { const float4 g2 = *(const float4*)(a + 5120 + d0 + j); const float4 xv = *(const float4*)(xr + j);
            hv[j] = ALPHA_ * xv.x + g2.x * o[j]; hv[j + 1] = ALPHA_ * xv.y + g2.y * o[j + 1]; hv[j + 2] = ALPHA_ * xv.z + g2.z * o[j + 2]; hv[j + 3] = ALPHA_ * xv.w + g2.w * o[j + 3];
            s += (hv[j] + hv[j + 1]) + (hv[j + 2] + hv[j + 3]); }
        const float mu = wave_sum(s, lane) * (1.f / 1024.f); float qq = 0.f;
#pragma unroll
        for (int j = 0; j < 16; ++j) { const float dd = hv[j] - mu; qq += dd * dd; }
        const float rstd = rsqrtf(wave_sum(qq, lane) * (1.f / 1024.f) + LN_EPS_);
        const float* an = ada_next ? ada_next + (size_t)(tok >> 11) * 6144 : nullptr;
        float y[16];
#pragma unroll
        for (int j = 0; j < 16; j += 4) { const float4 gg = *(const float4*)(g + d0 + j), bb = *(const float4*)(bta + d0 + j);
            y[j] = (hv[j] - mu) * rstd * gg.x + bb.x; y[j + 1] = (hv[j + 1] - mu) * rstd * gg.y + bb.y; y[j + 2] = (hv[j + 2] - mu) * rstd * gg.z + bb.z; y[j + 3] = (hv[j + 3] - mu) * rstd * gg.w + bb.w;
            *(float4*)(xr + j) = make_float4(y[j], y[j + 1], y[j + 2], y[j + 3]); }
        if (an) { float uu[16];
#pragma unroll
            for (int j = 0; j < 16; j += 4) { const float4 sc = *(const float4*)(an + 1024 + d0 + j), sh = *(const float4*)(an + d0 + j);
                uu[j] = y[j] * (1.f + sc.x) + sh.x; uu[j + 1] = y[j + 1] * (1.f + sc.y) + sh.y; uu[j + 2] = y[j + 2] * (1.f + sc.z) + sh.z; uu[j + 3] = y[j + 3] * (1.f + sc.w) + sh.w; }
            u32x4 p0, p1; p0.x = pg8::cvt_pk_bf16(uu[0], uu[1]); p0.y = pg8::cvt_pk_bf16(uu[2], uu[3]); p0.z = pg8::cvt_pk_bf16(uu[4], uu[5]); p0.w = pg8::cvt_pk_bf16(uu[6], uu[7]);
            p1.x = pg8::cvt_pk_bf16(uu[8], uu[9]); p1.y = pg8::cvt_pk_bf16(uu[10], uu[11]); p1.z = pg8::cvt_pk_bf16(uu[12], uu[13]); p1.w = pg8::cvt_pk_bf16(uu[14], uu[15]);
            bf16_t* up = UY + (size_t)tok * UYW_ + d0; *(u32x4*)up = p0; *(u32x4*)(up + 8) = p1; }
        asm volatile("s_waitcnt lgkmcnt(0)" ::: "memory");
    }
#undef PEER_SB
#undef PEER_ISSUE_U
#undef PEER_ISSUE_V
#undef PEER_COMP_U
#undef PEER_COMP_V
    __syncthreads();
}
}

namespace tk {
typedef float f32x16 __attribute__((ext_vector_type(16)));
constexpr int KROW = 272;
DEV unsigned sortable(float v) { const unsigned u = __float_as_uint(v); return u ^ ((unsigned)((int)u >> 31) | 0x80000000u); }
DEV float unsortable(unsigned k) { return __uint_as_float(k ^ ((~(unsigned)((int)k >> 31)) | 0x80000000u)); }
DEV unsigned umax_(unsigned a, unsigned b) { return a > b ? a : b; }
DEV unsigned umin_(unsigned a, unsigned b) { return a < b ? a : b; }
#define CE(x, y) { const unsigned hi_ = umax_(a[x], a[y]), lo_ = umin_(a[x], a[y]); a[x] = hi_; a[y] = lo_; }
DEV void sort16(unsigned (&a)[16]) {
    CE(0, 1); CE(3, 2); CE(4, 5); CE(7, 6); CE(8, 9); CE(11, 10); CE(12, 13); CE(15, 14); CE(0, 2); CE(1, 3); CE(6, 4); CE(7, 5); CE(8, 10); CE(9, 11); CE(14, 12); CE(15, 13); CE(0, 1); CE(2, 3); CE(5, 4); CE(7, 6); CE(8, 9); CE(10, 11); CE(13, 12); CE(15, 14); CE(0, 4); CE(1, 5); CE(2, 6); CE(3, 7); CE(12, 8); CE(13, 9); CE(14, 10); CE(15, 11); CE(0, 2); CE(1, 3); CE(4, 6); CE(5, 7); CE(10, 8); CE(11, 9); CE(14, 12); CE(15, 13); CE(0, 1); CE(2, 3); CE(4, 5); CE(6, 7); CE(9, 8); CE(11, 10); CE(13, 12); CE(15, 14); CE(0, 8); CE(1, 9); CE(2, 10); CE(3, 11); CE(4, 12); CE(5, 13); CE(6, 14); CE(7, 15); CE(0, 4); CE(1, 5); CE(2, 6); CE(3, 7); CE(8, 12); CE(9, 13); CE(10, 14); CE(11, 15); CE(0, 2); CE(1, 3); CE(4, 6); CE(5, 7); CE(8, 10); CE(9, 11); CE(12, 14); CE(13, 15); CE(0, 1); CE(2, 3); CE(4, 5); CE(6, 7); CE(8, 9); CE(10, 11); CE(12, 13); CE(14, 15);
}
DEV void bmerge16(unsigned (&a)[16]) {
    CE(0, 8); CE(1, 9); CE(2, 10); CE(3, 11); CE(4, 12); CE(5, 13); CE(6, 14); CE(7, 15); CE(0, 4); CE(1, 5); CE(2, 6); CE(3, 7); CE(8, 12); CE(9, 13); CE(10, 14); CE(11, 15); CE(0, 2); CE(1, 3); CE(4, 6); CE(5, 7); CE(8, 10); CE(9, 11); CE(12, 14); CE(13, 15); CE(0, 1); CE(2, 3); CE(4, 5); CE(6, 7); CE(8, 9); CE(10, 11); CE(12, 13); CE(14, 15);
}
#undef CE
DEV void top_merge(unsigned (&a)[16], const unsigned (&b)[16]) {
#pragma unroll
    for (int i = 0; i < 16; ++i) a[i] = umax_(a[i], b[15 - i]);
    bmerge16(a);
}
DEV void xlane_merge(unsigned (&a)[16], int lane) {
    unsigned b[16];
#pragma unroll
    for (int i = 0; i < 16; ++i) b[i] = (unsigned)xor_i((int)a[i], 32, lane);
    top_merge(a, b);
}
DEV unsigned lookup_idx(unsigned long long lo, unsigned long long hi, int a) { const unsigned long long wv = (a < 8) ? lo : hi; return (unsigned)(wv >> ((a & 7) * 8)) & 127u; }
DEV unsigned blendu(unsigned m, unsigned a, unsigned b) { return (a & ~m) | (b & m); }
DEV float blendf(unsigned m, float a, float b) { return __uint_as_float((__float_as_uint(a) & ~m) | (__float_as_uint(b) & m)); }

DEV void topk_phase(LAS unsigned char* lds, const bf16_t* __restrict__ Q2, const float* __restrict__ keys_l, int* __restrict__ eidx, float* __restrict__ egate, int G, int cblk, int wv) {
    int wv_ = wv, ln_; asm volatile("v_mbcnt_lo_u32_b32 %1, -1, 0\n\tv_mbcnt_hi_u32_b32 %1, -1, %1" : "+s"(wv_), "=v"(ln_)); int tid_ = (wv_ << 6) | ln_;
    const int tid = tid_, w = __builtin_amdgcn_readfirstlane(tid >> 6), lane = tid & 63, tl = lane & 31, hh = lane >> 5;
    asm volatile("" : "+s"(G));
    const bool by_head = (G & 7) == 0;
#pragma unroll 1
    for (int h = 0; h < 8; ++h) {
        if (by_head && h != (cblk & 7)) continue;
        __syncthreads();
        {
            const int r = tid >> 1, c0 = (tid & 1) * 64; const float* src = keys_l + ((size_t)h * 256 + r) * 128 + c0; LAS unsigned char* dst = lds + r * KROW + c0 * 2;
#pragma unroll
            for (int j = 0; j < 64; j += 8) { const float4 a = *(const float4*)(src + j), b = *(const float4*)(src + j + 4);
                u32x4 o; o.x = pg8::cvt_pk_bf16(a.x, a.y); o.y = pg8::cvt_pk_bf16(a.z, a.w); o.z = pg8::cvt_pk_bf16(b.x, b.y); o.w = pg8::cvt_pk_bf16(b.z, b.w); *(LAS u32x4*)(dst + j * 2) = o; }
        }
        __syncthreads();
        const int first = by_head ? (cblk >> 3) * 8 + w : cblk * 8 + w, stride = by_head ? (G >> 3) * 8 : G * 8;
#pragma unroll 1
        for (int blk = first; blk < T_ / 32; blk += stride) {
            const int tok = blk * 32 + tl; const bf16_t* qrow = Q2 + (size_t)tok * 2048 + h * 256 + 8 * hh;
            unsigned L[2][16];
#pragma unroll
            for (int p = 0; p < 2; ++p) {
                bf16x8 bq[8];
#pragma unroll
                for (int ks = 0; ks < 8; ++ks) bq[ks] = *(const bf16x8*)(qrow + p * 128 + 16 * ks);
#pragma unroll
                for (int t = 0; t < 4; ++t) {
                    f32x16 acc;
#pragma unroll
                    for (int e = 0; e < 16; ++e) acc[e] = 0.f;
#pragma unroll
                    for (int ks = 0; ks < 8; ++ks) { const bf16x8 ak = *(const LAS bf16x8*)(lds + (p * 128 + 32 * t + tl) * KROW + (16 * ks + 8 * hh) * 2);
                        acc = __builtin_amdgcn_mfma_f32_32x32x16_bf16(ak, bq[ks], acc, 0, 0, 0); }
                    unsigned K[16];
#pragma unroll
                    for (int e = 0; e < 16; ++e) K[e] = (sortable(acc[e]) & ~127u) | (unsigned)((127 - 32 * t - (e & 3) - 8 * (e >> 2)) - 4 * hh);
                    sort16(K);
                    if (t == 0) {
#pragma unroll
                        for (int e = 0; e < 16; ++e) L[p][e] = K[e];
                    } else top_merge(L[p], K);
                    __builtin_amdgcn_sched_barrier(0);
                }
                xlane_merge(L[p], lane);
                __builtin_amdgcn_sched_barrier(0);
            }
            float f1[16], f2[16];
#pragma unroll
            for (int e = 0; e < 16; ++e) { f1[e] = unsortable(L[0][e] & ~127u); f2[e] = unsortable(L[1][e] & ~127u); }
            unsigned hm = 0u - (unsigned)hh; asm volatile("" : "+v"(hm));
            unsigned C[2][16];
            C[0][0] = (sortable(blendf(hm, f1[0], f1[2]) + blendf(hm, f2[0], f2[1])) & ~255u) | (255u - blendu(hm, 0u, 33u));
            C[0][1] = (sortable(blendf(hm, f1[0], f1[2]) + blendf(hm, f2[1], f2[2])) & ~255u) | (255u - blendu(hm, 1u, 34u));
            C[0][2] = (sortable(blendf(hm, f1[0], f1[2]) + blendf(hm, f2[2], f2[3])) & ~255u) | (255u - blendu(hm, 2u, 35u));
            C[0][3] = (sortable(blendf(hm, f1[0], f1[2]) + blendf(hm, f2[3], f2[4])) & ~255u) | (255u - blendu(hm, 3u, 36u));
            C[0][4] = (sortable(blendf(hm, f1[0], f1[3]) + blendf(hm, f2[4], f2[0])) & ~255u) | (255u - blendu(hm, 4u, 48u));
            C[0][5] = (sortable(blendf(hm, f1[0], f1[3]) + blendf(hm, f2[5], f2[1])) & ~255u) | (255u - blendu(hm, 5u, 49u));
            C[0][6] = (sortable(blendf(hm, f1[0], f1[3]) + blendf(hm, f2[6], f2[2])) & ~255u) | (255u - blendu(hm, 6u, 50u));
            C[0][7] = (sortable(blendf(hm, f1[0], f1[3]) + blendf(hm, f2[7], f2[3])) & ~255u) | (255u - blendu(hm, 7u, 51u));
            C[0][8] = (sortable(blendf(hm, f1[0], f1[4]) + blendf(hm, f2[8], f2[0])) & ~255u) | (255u - blendu(hm, 8u, 64u));
            C[0][9] = (sortable(blendf(hm, f1[0], f1[4]) + blendf(hm, f2[9], f2[1])) & ~255u) | (255u - blendu(hm, 9u, 65u));
            C[0][10] = (sortable(blendf(hm, f1[0], f1[4]) + blendf(hm, f2[10], f2[2])) & ~255u) | (255u - blendu(hm, 10u, 66u));
            C[0][11] = (sortable(blendf(hm, f1[0], f1[5]) + blendf(hm, f2[11], f2[0])) & ~255u) | (255u - blendu(hm, 11u, 80u));
            C[0][12] = (sortable(blendf(hm, f1[0], f1[5]) + blendf(hm, f2[12], f2[1])) & ~255u) | (255u - blendu(hm, 12u, 81u));
            C[0][13] = (sortable(blendf(hm, f1[0], f1[6]) + blendf(hm, f2[13], f2[0])) & ~255u) | (255u - blendu(hm, 13u, 96u));
            C[0][14] = (sortable(blendf(hm, f1[0], f1[6]) + blendf(hm, f2[14], f2[1])) & ~255u) | (255u - blendu(hm, 14u, 97u));
            C[0][15] = (sortable(blendf(hm, f1[0], f1[7]) + blendf(hm, f2[15], f2[0])) & ~255u) | (255u - blendu(hm, 15u, 112u));
            C[1][0] = (sortable(blendf(hm, f1[1], f1[7]) + blendf(hm, f2[0], f2[1])) & ~255u) | (255u - blendu(hm, 16u, 113u));
            C[1][1] = (sortable(blendf(hm, f1[1], f1[8]) + blendf(hm, f2[1], f2[0])) & ~255u) | (255u - blendu(hm, 17u, 128u));
            C[1][2] = (sortable(blendf(hm, f1[1], f1[9]) + blendf(hm, f2[2], f2[0])) & ~255u) | (255u - blendu(hm, 18u, 144u));
            C[1][3] = (sortable(blendf(hm, f1[1], f1[10]) + blendf(hm, f2[3], f2[0])) & ~255u) | (255u - blendu(hm, 19u, 160u));
            C[1][4] = (sortable(blendf(hm, f1[1], f1[11]) + blendf(hm, f2[4], f2[0])) & ~255u) | (255u - blendu(hm, 20u, 176u));
            C[1][5] = (sortable(blendf(hm, f1[1], f1[12]) + blendf(hm, f2[5], f2[0])) & ~255u) | (255u - blendu(hm, 21u, 192u));
            C[1][6] = (sortable(blendf(hm, f1[1], f1[13]) + blendf(hm, f2[6], f2[0])) & ~255u) | (255u - blendu(hm, 22u, 208u));
            C[1][7] = (sortable(blendf(hm, f1[1], f1[14]) + blendf(hm, f2[7], f2[0])) & ~255u) | (255u - blendu(hm, 23u, 224u));
            C[1][8] = (sortable(blendf(hm, f1[2], f1[15]) + blendf(hm, f2[0], f2[0])) & ~255u) | (255u - blendu(hm, 32u, 240u));
            C[1][9] = 0u;
            C[1][10] = 0u;
            C[1][11] = 0u;
            C[1][12] = 0u;
            C[1][13] = 0u;
            C[1][14] = 0u;
            C[1][15] = 0u;
            sort16(C[0]); sort16(C[1]); top_merge(C[0], C[1]); xlane_merge(C[0], lane);
            unsigned long long p1lo = 0ull, p1hi = 0ull, p2lo = 0ull, p2hi = 0ull;
#pragma unroll
            for (int m = 0; m < 8; ++m) { p1lo |= (unsigned long long)(127u - (L[0][m] & 127u)) << (8 * m); p1hi |= (unsigned long long)(127u - (L[0][8 + m] & 127u)) << (8 * m);
                p2lo |= (unsigned long long)(127u - (L[1][m] & 127u)) << (8 * m); p2hi |= (unsigned long long)(127u - (L[1][8 + m] & 127u)) << (8 * m); }
            float val[16]; unsigned ex[16]; float sum = 0.f;
#pragma unroll
            for (int k = 0; k < 16; ++k) { const unsigned flat = 255u - (C[0][k] & 255u); const int a = (int)(flat >> 4), b = (int)(flat & 15u);
                val[k] = unsortable(C[0][k] & ~255u); ex[k] = lookup_idx(p1lo, p1hi, a) * 128u + lookup_idx(p2lo, p2hi, b); }
            const float mx = val[0];
#pragma unroll
            for (int k = 0; k < 16; ++k) { val[k] = __expf(val[k] - mx); sum += val[k]; }
            const float inv = 1.f / sum;
            int eo[8]; float go[8];
#pragma unroll
            for (int k = 0; k < 8; ++k) { eo[k] = (int)blendu(hm, ex[k], ex[8 + k]); go[k] = blendf(hm, val[k], val[8 + k]) * inv; }
            const size_t ob = ((size_t)tok * 8 + h) * 16 + 8 * hh;
            *(int4*)(eidx + ob) = make_int4(eo[0], eo[1], eo[2], eo[3]); *(int4*)(eidx + ob + 4) = make_int4(eo[4], eo[5], eo[6], eo[7]);
            *(float4*)(egate + ob) = make_float4(go[0], go[1], go[2], go[3]); *(float4*)(egate + ob + 4) = make_float4(go[4], go[5], go[6], go[7]);
        }
    }
    __syncthreads();
}
}

namespace at {
typedef float f32x16 __attribute__((ext_vector_type(16)));
constexpr int KROWB = 144, VROWB = 776, K_OFF = 0, V_OFF = 384 * KROWB, LDS_END = V_OFF + 64 * VROWB;
constexpr int N_ITEMS_A = 16 * 12 * 8, N_ITEMS_C = 16 * 2 * 16 * 2;

struct Band { int p_w, ls, R, slot_base; };
DEV void chunk(LAS const unsigned char* lds, const Band& bd, int c, const bf16x8 (&qf)[4], int tl, int hh, f32x16 (&O)[2], float& m, float& l) {
    const int kp0 = bd.p_w - bd.R + 32 * c;
    if (kp0 + 31 < 0 || kp0 >= bd.ls) return;
    const int s0 = kp0 + bd.slot_base;
    f32x16 S;
#pragma unroll
    for (int e = 0; e < 16; ++e) S[e] = 0.f;
#pragma unroll
    for (int ks = 0; ks < 4; ++ks) { const bf16x8 ak = *(const LAS bf16x8*)(lds + K_OFF + (s0 + tl) * KROWB + (16 * ks + 8 * hh) * 2); S = __builtin_amdgcn_mfma_f32_32x32x16_bf16(ak, qf[ks], S, 0, 0, 0); }
    const int dbase = (32 * c - bd.R) - tl + 4 * hh;
    const int kb = kp0 + 4 * hh;
    float cmax = -1e30f;
#pragma unroll
    for (int e = 0; e < 16; ++e) { const int ro = (e & 3) + 8 * (e >> 2); const int diff = dbase + ro, kp = kb + ro;
        const bool ok = (diff <= bd.R) && (diff >= -bd.R) && (kp >= 0) && (kp < bd.ls); S[e] = ok ? S[e] : -1e30f; cmax = fmaxf(cmax, S[e]); }
    cmax = fmaxf(cmax, xor_f(cmax, 32, tl + 32 * hh));
    const float mn = fmaxf(m, cmax), alpha = exp2f(m - mn); m = mn;
    float psum = 0.f;
#pragma unroll
    for (int e = 0; e < 16; ++e) { S[e] = exp2f(S[e] - mn); psum += S[e]; }
    l = l * alpha + psum;
#pragma unroll
    for (int e = 0; e < 16; ++e) { O[0][e] *= alpha; O[1][e] *= alpha; }
#pragma unroll
    for (int sx = 0; sx < 2; ++sx) {
        u32x4 pw; pw.x = pg8::cvt_pk_bf16(S[8 * sx + 0], S[8 * sx + 1]); pw.y = pg8::cvt_pk_bf16(S[8 * sx + 2], S[8 * sx + 3]); pw.z = pg8::cvt_pk_bf16(S[8 * sx + 4], S[8 * sx + 5]); pw.w = pg8::cvt_pk_bf16(S[8 * sx + 6], S[8 * sx + 7]);
        const bf16x8 pb = __builtin_bit_cast(bf16x8, pw);
#pragma unroll
        for (int dt = 0; dt < 2; ++dt) { LAS const unsigned char* vp = lds + V_OFF + (32 * dt + tl) * VROWB + (s0 + 16 * sx + 4 * hh) * 2;
            const u32x2 lo = *(const LAS u32x2*)vp, hi = *(const LAS u32x2*)(vp + 16); const u32x4 vw = (u32x4){lo.x, lo.y, hi.x, hi.y};
            O[dt] = __builtin_amdgcn_mfma_f32_32x32x16_bf16(__builtin_bit_cast(bf16x8, vw), pb, O[dt], 0, 0, 0); }
    }
}
DEV void attn_phase(LAS unsigned char* lds, bf16_t* P, float* lse2, bf16_t* Y, const float* sink_l, int G, int cblk, int wv) {
    int wv_ = wv, ln_; asm volatile("v_mbcnt_lo_u32_b32 %1, -1, 0\n\tv_mbcnt_hi_u32_b32 %1, -1, %1" : "+s"(wv_), "=v"(ln_)); int tid_ = (wv_ << 6) | ln_;
    const int tid = tid_, w = __builtin_amdgcn_readfirstlane(tid >> 6), lane = tid & 63, tl = lane & 31, hh = lane >> 5;
#pragma unroll 1
    for (int item = cblk; item < N_ITEMS_A + N_ITEMS_C; item += G) {
        int b, dil, ls, r, klo, nsl, R, kcol, vcol, qcol, two = 0, rp = 0, sb = 0, head = 0, isC = 0, nb = 0, qh0 = 0;
        if (item < N_ITEMS_A) { b = item / 96; const int rem = item - b * 96; head = rem >> 3; const int sub = rem & 7, g = head >> 2; R = 64;
            kcol = 768 + head * 64; vcol = 1536 + head * 64; qcol = head * 64;
            if (g == 0) { dil = 1; ls = 2048; r = 0; sb = sub; klo = 256 * sb - 64; nsl = 384; }
            else if (g == 1) { dil = 4; ls = 512; r = sub >> 1; sb = sub & 1; klo = 256 * sb - 64; nsl = 384; }
            else { dil = 16; ls = 128; r = 0; rp = sub; klo = 0; nsl = 256; two = 1; } }
        else { const int it = item - N_ITEMS_A; b = it >> 6; const int rem = it & 63; const int kvh = rem >> 5; nb = (rem & 31) >> 1; const int hp = rem & 1; isC = 1; R = 128;
            dil = 1; ls = 2048; r = 0; klo = 128 * nb - 128; nsl = 384; kcol = 2816 + kvh * 64; vcol = 2944 + kvh * 64; qh0 = kvh * 4 + hp * 2; qcol = 2304 + qh0 * 64; }
        __syncthreads();
        for (int i = tid; i < nsl * 8; i += 512) { const int slot = i >> 3, part = i & 7; int kpos, rr;
            if (two) { kpos = slot & 127; rr = 2 * rp + (slot >> 7); } else { kpos = klo + slot; rr = r; }
            u32x4 kv = (u32x4){0u, 0u, 0u, 0u}, vv = kv;
            if (kpos >= 0 && kpos < ls) { const bf16_t* rowp = P + (size_t)(b * 2048 + kpos * dil + rr) * PW_; kv = *(const u32x4*)(rowp + kcol + part * 8); vv = *(const u32x4*)(rowp + vcol + part * 8); }
            *(LAS u32x4*)(lds + K_OFF + slot * KROWB + part * 16) = kv;
            LAS unsigned short* vt = (LAS unsigned short*)(lds + V_OFF + (part * 8) * VROWB + slot * 2);
            vt[0 * (VROWB / 2)] = (unsigned short)(vv.x & 0xffffu); vt[1 * (VROWB / 2)] = (unsigned short)(vv.x >> 16); vt[2 * (VROWB / 2)] = (unsigned short)(vv.y & 0xffffu); vt[3 * (VROWB / 2)] = (unsigned short)(vv.y >> 16);
            vt[4 * (VROWB / 2)] = (unsigned short)(vv.z & 0xffffu); vt[5 * (VROWB / 2)] = (unsigned short)(vv.z >> 16); vt[6 * (VROWB / 2)] = (unsigned short)(vv.w & 0xffffu); vt[7 * (VROWB / 2)] = (unsigned short)(vv.w >> 16); }
        __syncthreads();
        Band bd; int qtok, rr = r; bd.ls = ls; bd.R = R;
        if (two) { const int half = w >> 2; bd.p_w = 32 * (w & 3); rr = 2 * rp + half; bd.slot_base = half * 128; }
        else if (isC) { bd.p_w = 128 * nb + 32 * (w & 3); bd.slot_base = -klo; }
        else { bd.p_w = 256 * sb + 32 * w; bd.slot_base = -klo; }
        qtok = b * 2048 + (bd.p_w + tl) * dil + rr;
        const int qc = isC ? (qcol + (w >> 2) * 64) : qcol;
        const bf16_t* qp = P + (size_t)qtok * PW_ + qc + 8 * hh;
        bf16x8 qf[4];
#pragma unroll
        for (int ks = 0; ks < 4; ++ks) qf[ks] = *(const bf16x8*)(qp + 16 * ks);
        f32x16 O[2];
#pragma unroll
        for (int e = 0; e < 16; ++e) { O[0][e] = 0.f; O[1][e] = 0.f; }
        float m = -1e30f, l = 0.f;
        const int nch = R / 16 + 1, cd = R / 32;
        chunk(lds, bd, cd, qf, tl, hh, O, m, l);
#pragma unroll 1
        for (int c = 0; c < nch; ++c) { if (c != cd) chunk(lds, bd, c, qf, tl, hh, O, m, l); }
        float lt = l + xor_f(l, 32, lane), scale;
        if (isC) { const float sk = sink_l[qh0 + (w >> 2)] * LOG2E_; const float mf = fmaxf(m, sk), corr = exp2f(m - mf); lt = lt * corr + exp2f(sk - mf); scale = corr / lt; }
        else { scale = 1.f / lt; if (hh == 0) lse2[(size_t)qtok * 12 + head] = m + log2f(lt); }
        bf16_t* op = isC ? (Y + (size_t)qtok * UYW_ + 768 + (qh0 + (w >> 2)) * 64) : (P + (size_t)qtok * PW_ + qcol);
#pragma unroll
        for (int dt = 0; dt < 2; ++dt)
#pragma unroll
            for (int g4 = 0; g4 < 4; ++g4) { u32x2 pk; pk.x = pg8::cvt_pk_bf16(O[dt][4 * g4] * scale, O[dt][4 * g4 + 1] * scale); pk.y = pg8::cvt_pk_bf16(O[dt][4 * g4 + 2] * scale, O[dt][4 * g4 + 3] * scale);
                *(u32x2*)(op + 32 * dt + 8 * g4 + 4 * hh) = pk; }
    }
    __syncthreads();
}
}

namespace xb {
constexpr int XB_TMO = 128, XB_TOP = 3328, XB_TOPGEN = 3392, XCD_BAR_WORDS = 3456; constexpr unsigned XB_SPIN_CAP = 1u << 22;
DEV constexpr int XB_XCNT(int j) { return 256 + 64 * j; }
DEV constexpr int XB_XSUB(int j) { return 1280 + 64 * j; }
DEV constexpr int XB_XGEN(int j) { return 2304 + 64 * j; }
DEV unsigned xb_ld(unsigned* p) { return __hip_atomic_load(p, __ATOMIC_RELAXED, __HIP_MEMORY_SCOPE_AGENT); }
DEV unsigned xb_add(unsigned* p, unsigned v) { return __hip_atomic_fetch_add(p, v, __ATOMIC_RELAXED, __HIP_MEMORY_SCOPE_AGENT); }
DEV unsigned xb_xcc_id() { return (unsigned)__builtin_amdgcn_s_getreg((3 << 11) | 20) & 0xFu; }
#define XB_SPIN(cond, bar) do { unsigned _sp = 0; while (cond) { __builtin_amdgcn_s_sleep(1); \
    if ((++_sp & 255u) == 0u) { if (xb_ld(&(bar)[XB_TMO])) break; if (_sp > XB_SPIN_CAP) { atomicAdd(&(bar)[XB_TMO], 1u); break; } } } } while (0)
struct XcdBarrier { unsigned* bar; unsigned x; volatile LAS unsigned* st; };
DEV XcdBarrier xcd_barrier_post(unsigned* bar, volatile LAS unsigned* st) { XcdBarrier b; b.bar = bar; b.x = xb_xcc_id(); b.st = st; if (threadIdx.x == 0) (void)xb_add(&bar[XB_XCNT(b.x)], 1u); return b; }
DEV void xcd_barrier_complete(unsigned* bar, unsigned x, unsigned& nloc, unsigned& nx) {
    const unsigned G = gridDim.x * gridDim.y * gridDim.z; unsigned sum, cnt, mine, sp = 0u;
    for (;;) { sum = 0u; cnt = 0u; mine = 0u;
#pragma unroll
        for (unsigned j = 0; j < 16; ++j) { const unsigned c = xb_ld(&bar[XB_XCNT(j)]); sum += c; cnt += (c > 0u) ? 1u : 0u; mine = (j == x) ? c : mine; }
        if (sum == G) break;
        __builtin_amdgcn_s_sleep(1);
        if ((++sp & 255u) == 0u) { if (xb_ld(&bar[XB_TMO])) break; if (sp > XB_SPIN_CAP) { atomicAdd(&bar[XB_TMO], 1u); break; } } }
    nloc = mine > 0u ? mine : 1u; nx = cnt > 0u ? cnt : 1u;
}
DEV void xcd_barrier(const XcdBarrier& b, int wv) {
    asm volatile("s_waitcnt vmcnt(0)" ::: "memory");
    __syncthreads();
    int ln0_; asm volatile("v_mbcnt_lo_u32_b32 %0, -1, 0\n\tv_mbcnt_hi_u32_b32 %0, -1, %0" : "=v"(ln0_));
    if (wv == 0 && ln0_ == 0) {
        unsigned* bar = b.bar; asm volatile("" : "+s"(bar));
        unsigned bx = xb_xcc_id(); asm volatile("" : "+s"(bx));
        __builtin_amdgcn_s_waitcnt(0);
        unsigned nloc = b.st[0], nx = b.st[1];
        if (nloc == 0u) { xcd_barrier_complete(bar, bx, nloc, nx); b.st[0] = nloc; b.st[1] = nx; }
        const unsigned old = xb_add(&bar[XB_XSUB(bx)], 1u); const unsigned gen = old / nloc;
        if (old + 1u == (gen + 1u) * nloc) {
            __builtin_amdgcn_fence(__ATOMIC_RELEASE, "agent");
            asm volatile("s_waitcnt vmcnt(0)" ::: "memory");
            const unsigned og = xb_add(&bar[XB_TOP], 1u); const unsigned tg = og / nx;
            if (og + 1u == (tg + 1u) * nx) xb_add(&bar[XB_TOPGEN], 1u);
            else XB_SPIN(xb_ld(&bar[XB_TOPGEN]) == tg, bar);
            __builtin_amdgcn_fence(__ATOMIC_ACQUIRE, "agent");
            xb_add(&bar[XB_XGEN(bx)], 1u);
            asm volatile("s_waitcnt vmcnt(0)" ::: "memory");
        } else {
            XB_SPIN(xb_ld(&bar[XB_XGEN(bx)]) == gen, bar);
            __builtin_amdgcn_fence(__ATOMIC_ACQUIRE, "agent");
            asm volatile("s_waitcnt vmcnt(0)" ::: "memory");
        }
    }
    __syncthreads();
}
}

namespace misc {
DEV void ada_phase(LAS unsigned char* lds, const float* __restrict__ c, const float* __restrict__ w_ada, const float* __restrict__ b_ada, float* __restrict__ ada, int G, int cblk, int wv) {
    int wv_ = wv, ln_; asm volatile("v_mbcnt_lo_u32_b32 %1, -1, 0\n\tv_mbcnt_hi_u32_b32 %1, -1, %1" : "+s"(wv_), "=v"(ln_)); int tid_ = (wv_ << 6) | ln_; const int tid = tid_, col = tid & 63, kg = tid >> 6;
    LAS float* cond = (LAS float*)lds;
    LAS float* part = (LAS float*)(lds + 65536);
    for (int i = tid; i < 16384; i += 512) { const float v = c[i]; cond[i] = v / (1.f + __expf(-v)); }
    __syncthreads();
#pragma unroll 1
    for (int item = cblk; item < 192; item += G) { const int l = item / 96, n0 = (item - l * 96) * 64;
        float acc[16];
#pragma unroll
        for (int b = 0; b < 16; ++b) acc[b] = 0.f;
        const float* wp = w_ada + ((size_t)l * 1024 + kg * 128) * 6144 + n0 + col;
#pragma unroll 4
        for (int kk = 0; kk < 128; ++kk) { const float wv = wp[(size_t)kk * 6144];
#pragma unroll
            for (int b = 0; b < 16; ++b) acc[b] += cond[b * 1024 + kg * 128 + kk] * wv; }
#pragma unroll
        for (int b = 0; b < 16; ++b) part[(kg * 16 + b) * 64 + col] = acc[b];
        __syncthreads();
        for (int o = tid; o < 1024; o += 512) { const int b = o >> 6, cc = o & 63; float sacc = b_ada[l * 6144 + n0 + cc];
#pragma unroll
            for (int g8 = 0; g8 < 8; ++g8) sacc += part[(g8 * 16 + b) * 64 + cc];
            ada[((size_t)l * 16 + b) * 6144 + n0 + cc] = sacc; }
        __syncthreads();
    }
}
DEV void ln_phase(float* xio, const float* __restrict__ g, const float* __restrict__ bta, const float* ada_l, bf16_t* UY, int G, int cblk, int wv) {
    int wv_ = wv, ln_; asm volatile("v_mbcnt_lo_u32_b32 %1, -1, 0\n\tv_mbcnt_hi_u32_b32 %1, -1, %1" : "+s"(wv_), "=v"(ln_)); int tid_ = (wv_ << 6) | ln_; const int tid = tid_, w = __builtin_amdgcn_readfirstlane(tid >> 6), lane = tid & 63; const int d0 = 16 * lane;
#pragma unroll 1
    for (int tok = cblk * 8 + w; tok < T_; tok += G * 8) { const float* a = ada_l + (size_t)(tok >> 11) * 6144; float* xr = xio + (size_t)tok * 1024 + d0;
        float hv[16]; float s = 0.f;
#pragma unroll
        for (int j = 0; j < 16; j += 4) { const float4 v = *(const float4*)(xr + j); hv[j] = v.x; hv[j + 1] = v.y; hv[j + 2] = v.z; hv[j + 3] = v.w; s += (v.x + v.y) + (v.z + v.w); }
        const float mu = peer::wave_sum(s, lane) * (1.f / 1024.f); float qq = 0.f;
#pragma unroll
        for (int j = 0; j < 16; ++j) { const float dd = hv[j] - mu; qq += dd * dd; }
        const float rstd = rsqrtf(peer::wave_sum(qq, lane) * (1.f / 1024.f) + LN_EPS_);
        float uu[16];
#pragma unroll
        for (int j = 0; j < 16; j += 4) { const float4 gg = *(const float4*)(g + d0 + j), bb = *(const float4*)(bta + d0 + j), sc = *(const float4*)(a + 4096 + d0 + j), sh = *(const float4*)(a + 3072 + d0 + j);
            const float y0 = (hv[j] - mu) * rstd * gg.x + bb.x, y1 = (hv[j + 1] - mu) * rstd * gg.y + bb.y, y2 = (hv[j + 2] - mu) * rstd * gg.z + bb.z, y3 = (hv[j + 3] - mu) * rstd * gg.w + bb.w;
            *(float4*)(xr + j) = make_float4(y0, y1, y2, y3);
            uu[j] = y0 * (1.f + sc.x) + sh.x; uu[j + 1] = y1 * (1.f + sc.y) + sh.y; uu[j + 2] = y2 * (1.f + sc.z) + sh.z; uu[j + 3] = y3 * (1.f + sc.w) + sh.w; }
        u32x4 p0, p1; p0.x = pg8::cvt_pk_bf16(uu[0], uu[1]); p0.y = pg8::cvt_pk_bf16(uu[2], uu[3]); p0.z = pg8::cvt_pk_bf16(uu[4], uu[5]); p0.w = pg8::cvt_pk_bf16(uu[6], uu[7]);
        p1.x = pg8::cvt_pk_bf16(uu[8], uu[9]); p1.y = pg8::cvt_pk_bf16(uu[10], uu[11]); p1.z = pg8::cvt_pk_bf16(uu[12], uu[13]); p1.w = pg8::cvt_pk_bf16(uu[14], uu[15]);
        bf16_t* up = UY + (size_t)tok * UYW_ + d0; *(u32x4*)up = p0; *(u32x4*)(up + 8) = p1; }
}
DEV void yprep_phase(LAS unsigned char* lds, const bf16_t* __restrict__ hyT, const bf16_t* P, const float* __restrict__ lse2, bf16_t* Y, int G, int cblk, int wv) {
    int wv_ = wv, ln_; asm volatile("v_mbcnt_lo_u32_b32 %1, -1, 0\n\tv_mbcnt_hi_u32_b32 %1, -1, %1" : "+s"(wv_), "=v"(ln_)); int tid_ = (wv_ << 6) | ln_; const int tid = tid_;
    LAS unsigned short* tile = (LAS unsigned short*)lds;
#pragma unroll 1
    for (int it = cblk; it < 4096; it += G) { const int t0 = (it >> 3) * 64, c0 = (it & 7) * 64;
        __syncthreads();
        { const int cc = tid >> 3, seg = (tid & 7) * 8; const u32x4 v = *(const u32x4*)(hyT + (size_t)(c0 + cc) * T_ + t0 + seg); *(LAS u32x4*)(tile + cc * 72 + seg) = v; }
        __syncthreads();
        { const int tt = tid >> 3, seg = (tid & 7) * 8; unsigned wv[4];
#pragma unroll
            for (int e = 0; e < 4; ++e) wv[e] = (unsigned)tile[(seg + 2 * e) * 72 + tt] | ((unsigned)tile[(seg + 2 * e + 1) * 72 + tt] << 16);
            *(u32x4*)(Y + (size_t)(t0 + tt) * UYW_ + 256 + c0 + seg) = (u32x4){wv[0], wv[1], wv[2], wv[3]}; }
    }
#pragma unroll 1
    for (size_t idx = (size_t)cblk * 512 + tid; idx < (size_t)T_ * 32; idx += (size_t)G * 512) { const size_t tok = idx >> 5; const int c8 = (int)(idx & 31) * 8, hh = c8 >> 6;
        const float l0 = lse2[tok * 12 + hh], l1 = lse2[tok * 12 + 4 + hh], l2 = lse2[tok * 12 + 8 + hh]; const float mx = fmaxf(l0, fmaxf(l1, l2));
        float w0 = exp2f(l0 - mx), w1 = exp2f(l1 - mx), w2 = exp2f(l2 - mx); const float inv = 1.f / (w0 + w1 + w2); w0 *= inv; w1 *= inv; w2 *= inv;
        const bf16_t* pr = P + tok * PW_ + c8; const u32x4 a = *(const u32x4*)pr, b = *(const u32x4*)(pr + 256), c = *(const u32x4*)(pr + 512);
        const unsigned aw[4] = {a.x, a.y, a.z, a.w}, bw[4] = {b.x, b.y, b.z, b.w}, cw[4] = {c.x, c.y, c.z, c.w}; unsigned o[4];
#pragma unroll
        for (int e = 0; e < 4; ++e) { const float lo = w0 * __uint_as_float(aw[e] << 16) + w1 * __uint_as_float(bw[e] << 16) + w2 * __uint_as_float(cw[e] << 16);
            const float hi = w0 * __uint_as_float(aw[e] & 0xffff0000u) + w1 * __uint_as_float(bw[e] & 0xffff0000u) + w2 * __uint_as_float(cw[e] & 0xffff0000u); o[e] = pg8::cvt_pk_bf16(lo, hi); }
        *(u32x4*)(Y + tok * UYW_ + c8) = (u32x4){o[0], o[1], o[2], o[3]}; }
    __syncthreads();
}
}

struct Params {
    const float *x, *c, *w_ada, *b_ada, *w_in, *conv_w, *conv_b, *hy_w1, *hy_b1, *hy_w2, *hy_b2, *hy_w3, *hy_freq, *hy_ld, *hy_bias, *attn_sink, *wba, *wbb, *wbc, *w_out, *ln_g, *ln_b,
        *peer_wq, *peer_keys, *peer_u, *peer_v;
    float* out; char* ws;
};
constexpr int LDS_PHASE = 148480;
constexpr int LDS_BYTES = LDS_PHASE + 16;
constexpr size_t OFF_BAR = OFF_LSE + 1792 * 1024;

#define RUN(nvb, call) do { const int wv = wave_s; int wv_ = wv, ln_; asm volatile("v_mbcnt_lo_u32_b32 %1, -1, 0\n\tv_mbcnt_hi_u32_b32 %1, -1, %1" : "+s"(wv_), "=v"(ln_)); int tid_ = (wv_ << 6) | ln_; const int t = tid_ & 255, sub = tid_ >> 8; unsigned char* sm = lds + sub * 16384; \
        for (int vb = (int)blockIdx.x * 2 + sub; vb < (nvb); vb += (int)gridDim.x * 2) { call; __syncthreads(); } } while (0)
#define GSYNC_CG() do { __builtin_amdgcn_sched_barrier(0); grid.sync(); __builtin_amdgcn_sched_barrier(0); } while (0)
#define GSYNC() do { __builtin_amdgcn_sched_barrier(0); xb::xcd_barrier(xbar, wave_s); __builtin_amdgcn_sched_barrier(0); } while (0)

__global__ void __launch_bounds__(512, 2) mega(Params p) {
    extern __shared__ __attribute__((aligned(16))) unsigned char lds[];
    cg::grid_group grid = cg::this_grid();
    LAS unsigned char* ldsl = (LAS unsigned char*)lds;
    const int G = gridDim.x, cblk = blockIdx.x;
    const int wave_s = __builtin_amdgcn_readfirstlane((int)threadIdx.x >> 6);
    float* out = p.out; (void)out;
    if (threadIdx.x < 4) ((LAS unsigned*)(ldsl + LDS_PHASE))[threadIdx.x] = 0u;
    __syncthreads();
    const xb::XcdBarrier xbar = xb::xcd_barrier_post((unsigned*)(p.ws + OFF_BAR), (volatile LAS unsigned*)(ldsl + LDS_PHASE));
    {
    char* ws = p.ws;
    float* ada = (float*)(ws + OFF_ADA); float2* rope = (float2*)(ws + OFF_ROPE); bf16_t* Gr = (bf16_t*)(ws + OFF_GR); float* lse2 = (float*)(ws + OFF_LSE);
    bf16_t* WinT = (bf16_t*)(ws + OFF_WINT); bf16_t* WmT = (bf16_t*)(ws + OFF_WMT); bf16_t* WoutT = (bf16_t*)(ws + OFF_WOUTT); bf16_t* WqT = (bf16_t*)(ws + OFF_WQT);
    bf16_t* UY = (bf16_t*)(ws + OFF_UY); bf16_t* Y = UY + 1024; bf16_t* P = (bf16_t*)(ws + OFF_P); bf16_t* hyT = (bf16_t*)(ws + OFF_HYT);
    bf16_t* merged = (bf16_t*)(ws + OFF_P); bf16_t* gtmp = (bf16_t*)(ws + OFF_P + 64 * MB_); bf16_t* Q2 = (bf16_t*)(ws + OFF_P);
    int* eidx = (int*)(ws + OFF_HYT); float* egate = (float*)(ws + OFF_HYT + 16 * MB_); unsigned char* U8 = (unsigned char*)(ws + OFF_HYT + 32 * MB_); unsigned char* V8 = (unsigned char*)(ws + OFF_HYT + 48 * MB_); float* sinv = (float*)(ws + OFF_HYT + 64 * MB_);
    float* h2 = (float*)(ws + OFF_P); float* hf = (float*)(ws + OFF_P + 2 * MB_);
    (void)lse2; (void)P; (void)hyT; (void)merged; (void)gtmp; (void)Q2; (void)eidx; (void)egate; (void)U8; (void)V8; (void)sinv; (void)Y;

    misc::ada_phase(ldsl, p.c, p.w_ada, p.b_ada, ada, G, cblk, wave_s);
    RUN(256, nb_rope(vb, t, sm, rope));
    RUN(1024, nb_filt_h2(vb, t, sm, p.hy_w1, p.hy_b1, p.hy_w2, p.hy_b2, p.hy_freq, h2));
    { const WPrep wq{p.w_in, p.wba, p.wbb, p.wbc, p.w_out, p.peer_wq, WinT, WmT, WoutT, WqT}; RUN(6016, nb_wprep(vb, t, sm, wq)); }
    GSYNC_CG();
    RUN(32768, nb_filt_full(vb, t, sm, h2, p.hy_w3, p.hy_ld, hf));
    RUN(T_ * 4, nb_modulate(vb, t, sm, p.x, ada, 0, 1024, UY));
    GSYNC();
    RUN(2048, nb_filt_norm(vb, t, sm, hf, Gr));
    GSYNC();
    }
#pragma unroll 1
    for (int l = 0; l < 2; ++l) {
        size_t zoff = 0; asm volatile("" : "+s"(zoff));
        char* ws = p.ws + zoff; float* out = p.out + zoff;
        int Gl = gridDim.x, cl = blockIdx.x; asm volatile("" : "+s"(Gl), "+s"(cl));
        float* ada = (float*)(ws + OFF_ADA); float2* rope = (float2*)(ws + OFF_ROPE); bf16_t* Gr = (bf16_t*)(ws + OFF_GR); float* lse2 = (float*)(ws + OFF_LSE);
        bf16_t* WinT = (bf16_t*)(ws + OFF_WINT); bf16_t* WmT = (bf16_t*)(ws + OFF_WMT); bf16_t* WoutT = (bf16_t*)(ws + OFF_WOUTT); bf16_t* WqT = (bf16_t*)(ws + OFF_WQT);
        bf16_t* UY = (bf16_t*)(ws + OFF_UY); bf16_t* Y = UY + 1024; bf16_t* P = (bf16_t*)(ws + OFF_P); bf16_t* hyT = (bf16_t*)(ws + OFF_HYT);
        bf16_t* merged = (bf16_t*)(ws + OFF_P); bf16_t* gtmp = (bf16_t*)(ws + OFF_P + 64 * MB_); bf16_t* Q2 = (bf16_t*)(ws + OFF_P);
        int* eidx = (int*)(ws + OFF_HYT); float* egate = (float*)(ws + OFF_HYT + 16 * MB_); unsigned char* U8 = (unsigned char*)(ws + OFF_HYT + 32 * MB_); unsigned char* V8 = (unsigned char*)(ws + OFF_HYT + 48 * MB_); float* sinv = (float*)(ws + OFF_HYT + 64 * MB_);
        const float* ada_l = ada + (size_t)l * 16 * 6144;
        const float* xin = (l == 0) ? p.x : out;
        const bf16_t* WinT_l = WinT + (size_t)l * 7680 * 1024;
        {
            const pg8::PlainSched S1{UY, WinT_l, UYW_, 1024, 128, 12, 16, Gl, cl}; const pg8::EpiP E1{P, rope};
            pg8::gemm_phase(ldsl, UYW_, 1024, S1, E1, wave_s);
            const pg8::PlainSched S2{WinT_l + (size_t)3072 * 1024, UY, 1024, UYW_, 6, 128, 16, Gl, cl}; const pg8::EpiBf E2{hyT, T_, 0};
            pg8::gemm_phase(ldsl, 1024, UYW_, S2, E2, wave_s);
        }
        GSYNC();
        at::attn_phase(ldsl, P, lse2, Y, p.attn_sink + l * 8, Gl, cl, wave_s);
        GSYNC();
        hy::hyena_phase(ldsl, hyT, Gr + (size_t)l * 2 * 512 * 4096, p.conv_w + (size_t)l * 3 * 1536, p.conv_b + (size_t)l * 1536, p.hy_bias + (size_t)l * 1024, Gl, cl, wave_s);
        GSYNC();
        misc::yprep_phase(ldsl, hyT, P, lse2, Y, Gl, cl, wave_s);
        GSYNC();
        {
            const pg8::MergeSched S{UY, WmT + (size_t)l * 1024 * WMW_, Gl, cl}; const pg8::EpiMergeAll E{gtmp, merged};
            pg8::gemm_phase(ldsl, UYW_, WMW_, S, E, wave_s);
        }
        GSYNC();
        {
            const pg8::PlainSched S{merged, WoutT + (size_t)l * 1024 * 1024, 1024, 1024, 128, 4, 16, Gl, cl}; const pg8::EpiOut E{xin, out, ada_l + 2048};
            pg8::gemm_phase(ldsl, 1024, 1024, S, E, wave_s);
        }
        GSYNC();
        misc::ln_phase(out, p.ln_g + (size_t)(l * 2 + 0) * 1024, p.ln_b + (size_t)(l * 2 + 0) * 1024, ada_l, UY, Gl, cl, wave_s);
        RUN(8192, peer::nb_quant_tables(vb, t, p.peer_u + (size_t)l * 16384 * 1024, p.peer_v + (size_t)l * 16384 * 1024, U8, V8, sinv));
        GSYNC();
        {
            const pg8::PlainSched S{UY, WqT + (size_t)l * 2048 * 1024, UYW_, 1024, 128, 8, 16, Gl, cl}; const pg8::EpiBf E{Q2, 2048, 0};
            pg8::gemm_phase(ldsl, UYW_, 1024, S, E, wave_s);
        }
        GSYNC();
        tk::topk_phase(ldsl, Q2, p.peer_keys + (size_t)l * 8 * 2 * 128 * 128, eidx, egate, Gl, cl, wave_s);
        GSYNC();
        peer::peer_phase(ldsl, out, ada_l, eidx, egate, U8, V8, sinv, p.ln_g + (size_t)(l * 2 + 1) * 1024, p.ln_b + (size_t)(l * 2 + 1) * 1024,
                         (l == 0) ? ada + (size_t)16 * 6144 : (const float*)nullptr, UY, Gl, cl, wave_s);
        if (l == 0) GSYNC();
    }
}

extern "C" void kernel_launch(void* const* d_in, const int* in_sizes, int n_in, void* d_out, int out_size, void* d_ws, size_t ws_size, hipStream_t stream) {
    static int grid = 0;
    if (grid == 0) {
        if (ws_size < WS_NEED || n_in != 26) { fprintf(stderr, "kernel_launch: workspace %zu < %zu or n_in %d != 26\n", ws_size, (size_t)WS_NEED, n_in); grid = -1; return; }
        int dev = 0, cus = 0, per_cu = 0;
        (void)hipGetDevice(&dev); (void)hipDeviceGetAttribute(&cus, hipDeviceAttributeMultiprocessorCount, dev);
        (void)hipFuncSetAttribute((const void*)mega, hipFuncAttributeMaxDynamicSharedMemorySize, LDS_BYTES);
        (void)hipOccupancyMaxActiveBlocksPerMultiprocessor(&per_cu, (const void*)mega, 512, LDS_BYTES);
        if (per_cu < 1) { fprintf(stderr, "kernel_launch: occupancy query says %d blocks per CU\n", per_cu); grid = -1; return; }
        grid = cus;
    }
    if (grid < 0) return;
    Params p{};
    const float** pp = (const float**)&p;
    for (int i = 0; i < 26; ++i) pp[i] = (const float*)d_in[i];
    p.out = (float*)d_out; p.ws = (char*)d_ws;
    (void)hipMemsetAsync((char*)d_ws + OFF_BAR, 0, xb::XCD_BAR_WORDS * sizeof(unsigned), stream);
    void* args[] = {&p};
    hipError_t e = hipLaunchCooperativeKernel((const void*)mega, dim3(grid), dim3(512), args, LDS_BYTES, stream);
    if (e != hipSuccess) fprintf(stderr, "cooperative launch failed: %s (grid %d)\n", hipGetErrorString(e), grid);
}
```

```cpp
#include <hip/hip_runtime.h>
#include <hip/hip_cooperative_groups.h>
namespace cg = cooperative_groups;
#include <stdint.h>
#include <stdio.h>

#define DEV __device__ __forceinline__
typedef unsigned short bf16_t;

constexpr int D_ = 1024, B_ = 16, S_ = 2048, T_ = B_ * S_;
constexpr float ALPHA_ = 1.41421356237309515f;
constexpr float LOG2E_ = 1.4426950408889634f;
constexpr float QSCALE_ = 0.125f * 1.4426950408889634f;
constexpr float LN_EPS_ = 1e-5f;
constexpr int PW_ = 3072;
constexpr int UYW_ = 2304;
constexpr int WMW_ = 4352;

constexpr size_t MB_ = 1024 * 1024;
constexpr size_t OFF_ADA = 0, OFF_ROPE = 1 * MB_, OFF_GR = 2 * MB_, OFF_LSE = 18 * MB_, OFF_WINT = 20 * MB_, OFF_WMT = 50 * MB_,
                 OFF_WOUTT = 68 * MB_, OFF_WQT = 72 * MB_, OFF_KEYS = 80 * MB_, OFF_UY = 82 * MB_, OFF_P = 226 * MB_, OFF_HYT = 418 * MB_,
                 OFF_Z1T = OFF_P  , WS_NEED = 514 * MB_;

DEV int xor_i(int v, int off, int lane) { return __builtin_amdgcn_ds_bpermute((lane ^ off) << 2, v); }
DEV float xor_f(float v, int off, int lane) { return __int_as_float(__builtin_amdgcn_ds_bpermute((lane ^ off) << 2, __float_as_int(v))); }
DEV float bf2f(bf16_t v) { return __uint_as_float(((unsigned)v) << 16); }
DEV bf16_t f2bf(float f) { unsigned u = __float_as_uint(f); u += 0x7FFFu + ((u >> 16) & 1u); return (bf16_t)(u >> 16); }

DEV void nb_ada(int vb, int t, unsigned char* sm, const float* __restrict__ c, const float* __restrict__ w_ada, const float* __restrict__ b_ada, float* __restrict__ ada) {
    const int idx = vb * 256 + t; const int l = idx / 6144, n = idx % 6144;
    float (*cond)[64] = (float (*)[64])sm;
    float acc[16];
#pragma unroll
    for (int b = 0; b < 16; ++b) acc[b] = b_ada[l * 6144 + n];
    for (int k0 = 0; k0 < 1024; k0 += 64) {
        for (int i = t; i < 1024; i += 256) { const int b = i >> 6, kk = i & 63; const float v = c[b * 1024 + k0 + kk]; cond[b][kk] = v / (1.f + expf(-v)); }
        __syncthreads();
        for (int kk = 0; kk < 64; ++kk) { const float w = w_ada[((size_t)l * 1024 + k0 + kk) * 6144 + n];
#pragma unroll
            for (int b = 0; b < 16; ++b) acc[b] += cond[b][kk] * w; }
        __syncthreads();
    }
#pragma unroll
    for (int b = 0; b < 16; ++b) ada[((size_t)l * 16 + b) * 6144 + n] = acc[b];
}

DEV void nb_rope(int vb, int t, unsigned char* sm, float2* __restrict__ rope) {
    const int idx = vb * 256 + t; const int s = idx >> 5, i = idx & 31;
    const float inv = powf(10000.f, -(float)i / 32.f); const float ang = (float)s * inv;
    rope[idx] = make_float2(cosf(ang), sinf(ang));
}

DEV void nb_filt_h2(int vb, int t, unsigned char* sm, const float* __restrict__ w1, const float* __restrict__ b1, const float* __restrict__ w2, const float* __restrict__ b2,
                                                const float* __restrict__ freq, float* __restrict__ h2) {
    const int grp = t >> 6, j = t & 63; const int lt = vb * 4 + grp; const int l = lt / 2048, tt = lt % 2048;
    float* z = (float*)sm + grp * 128; float* h1 = z + 64;
    if (j < 33) {
        const float idx = (float)tt, tn = idx / 2047.f, w = 6.283185307179586f * idx / 2048.f;
        if (j == 0) z[0] = tn;
        else { const int k = (j <= 16) ? (j - 1) : (j - 17); const float band = 1e-4f + (float)k * ((15.f - 1e-4f) / 15.f); const float ang = w * band;
            z[j] = (j <= 16) ? cosf(ang) : -sinf(ang); }
    }
    __syncthreads();
    float a = b1[l * 64 + j];
    for (int e = 0; e < 33; ++e) a += z[e] * w1[(l * 33 + e) * 64 + j];
    h1[j] = sinf(freq[(l * 2 + 0) * 64 + j] * a);
    __syncthreads();
    float a2 = b2[l * 64 + j];
    for (int i = 0; i < 64; ++i) a2 += h1[i] * w2[(l * 64 + i) * 64 + j];
    h2[((size_t)l * 2048 + tt) * 64 + j] = sinf(freq[(l * 2 + 1) * 64 + j] * a2);
}

DEV void nb_filt_full(int vb, int t, unsigned char* sm, const float* __restrict__ h2, const float* __restrict__ w3, const float* __restrict__ log_decay, float* __restrict__ hf) {
    const size_t idx = (size_t)vb * 256 + t; const int col = (int)(idx & 2047), tt = (int)((idx >> 11) & 2047), l = (int)(idx >> 22);
    const float* hr = h2 + ((size_t)l * 2048 + tt) * 64; float a = 0.f;
    for (int j = 0; j < 64; ++j) a += hr[j] * w3[((size_t)l * 64 + j) * 2048 + col];
    const float tn = (float)tt / 2047.f;
    hf[idx] = a * expf(-tn * expf(log_decay[l * 2048 + col]));
}

DEV void nb_filt_norm(int vb, int t, unsigned char* sm, const float* __restrict__ hf, bf16_t* __restrict__ Gr) {
    const int blk = vb; const int c = blk & 511, o = (blk >> 9) & 1, l = blk >> 10;
    const float* base = hf + (size_t)l * 2048 * 2048; const int colf = o * 512 + c, colb = 1024 + o * 512 + c;
    float ss = 0.f;
    for (int tt = t; tt < 2048; tt += 256) { const float a = base[(size_t)tt * 2048 + colf]; ss += a * a; if (tt >= 1) { const float bb = base[(size_t)tt * 2048 + colb]; ss += bb * bb; } }
    float* red = (float*)sm; red[t] = ss; __syncthreads();
    for (int st = 128; st > 0; st >>= 1) { if (t < st) red[t] += red[t + st]; __syncthreads(); }
    const float scale = rsqrtf(red[0] + 1e-12f); __syncthreads();
    bf16_t* g = Gr + (size_t)blk * 4096;
    for (int n = t; n < 4096; n += 256) { const int lag = 2047 - n; float v = 0.f;
        if (n < 4095) v = (lag >= 0) ? base[(size_t)lag * 2048 + colf] : base[(size_t)(-lag) * 2048 + colb];
        g[n] = f2bf(v * scale); }
}

DEV void nb_modulate(int vb, int t, unsigned char* sm, const float* __restrict__ x, const float* __restrict__ ada_l, int off_sh, int off_sc, bf16_t* __restrict__ ubuf) {
    const size_t idx = (size_t)vb * 256 + t; const int d = (int)(idx & 1023); const int b = (int)(idx >> 21);
    const float* a = ada_l + (size_t)b * 6144;
    ubuf[(idx >> 10) * UYW_ + d] = f2bf(x[idx] * (1.f + a[off_sc + d]) + a[off_sh + d]);
}

template <class AL, class WL, class EP>
DEV void nb_gemm(int vb, int t, unsigned char* sm, int nbx, int K, AL al, WL wl, EP ep) {
    float (*As)[65] = (float (*)[65])sm;
    float (*Ws)[65] = (float (*)[65])(sm + 16 * 65 * 4);
    const int tx = t & 15, ty = t >> 4;
    const int m0 = (vb / nbx) * 64, n0 = (vb % nbx) * 64;
    float acc[4][4];
#pragma unroll
    for (int i = 0; i < 4; ++i)
#pragma unroll
        for (int j = 0; j < 4; ++j) acc[i][j] = 0.f;
    for (int k0 = 0; k0 < K; k0 += 16) {
#pragma unroll
        for (int r = 0; r < 4; ++r) { const int i = t + r * 256; const int mm = i >> 4, kk = i & 15; As[kk][mm] = al(m0 + mm, k0 + kk); }
#pragma unroll
        for (int r = 0; r < 4; ++r) { const int i = t + r * 256; const int kk = i >> 6, nn = i & 63; Ws[kk][nn] = wl(k0 + kk, n0 + nn); }
        __syncthreads();
#pragma unroll
        for (int kk = 0; kk < 16; ++kk) {
            float a[4], w[4];
#pragma unroll
            for (int i = 0; i < 4; ++i) { a[i] = As[kk][ty + 16 * i]; w[i] = Ws[kk][tx + 16 * i]; }
#pragma unroll
            for (int i = 0; i < 4; ++i)
#pragma unroll
                for (int j = 0; j < 4; ++j) acc[i][j] += a[i] * w[j];
        }
        __syncthreads();
    }
    ep(m0, n0, ty, tx, acc);
}

struct ALbf { const bf16_t* A; int lda; int pad; DEV float operator()(int m, int k) const { return bf2f(A[(size_t)m * lda + k]); } };
struct WLf { const float* W; int ldw; int coff; DEV float operator()(int k, int n) const { return W[(size_t)k * ldw + coff + n]; } };
struct WLinP { const float* W; DEV float operator()(int k, int n) const { return W[(size_t)k * 7680 + (n < 2304 ? n : n + 1536)]; } };

struct EpP { bf16_t* P; const float2* rope;
    DEV void operator()(int m0, int n0, int ty, int tx, float (&acc)[4][4]) const {
        const int head = n0 >> 6; const bool rp = (head < 24) || (head >= 36 && head < 46); const bool qs = (head < 12) || (head >= 36 && head < 44);
#pragma unroll
        for (int i = 0; i < 4; ++i) { const int m = m0 + ty + 16 * i; const int s = m & 2047; bf16_t* row = P + (size_t)m * PW_ + n0;
            if (rp) {
#pragma unroll
                for (int jj = 0; jj < 2; ++jj) { const int d = tx + 16 * jj; const float x1 = acc[i][jj], x2 = acc[i][jj + 2]; const float2 cs = rope[s * 32 + d];
                    float o1 = x1 * cs.x - x2 * cs.y, o2 = x2 * cs.x + x1 * cs.y; if (qs) { o1 *= QSCALE_; o2 *= QSCALE_; }
                    const int p1 = 8 * (d >> 2) + (d & 3); row[p1] = f2bf(o1); row[p1 + 4] = f2bf(o2); }
            } else {
#pragma unroll
                for (int j = 0; j < 4; ++j) row[tx + 16 * j] = f2bf(acc[i][j]);
            } }
    } };
struct EpHyT { bf16_t* hyT;
    DEV void operator()(int m0, int n0, int ty, int tx, float (&acc)[4][4]) const {
#pragma unroll
        for (int i = 0; i < 4; ++i)
#pragma unroll
            for (int j = 0; j < 4; ++j) hyT[(size_t)(n0 + tx + 16 * j) * T_ + m0 + ty + 16 * i] = f2bf(acc[i][j]);
    } };
struct EpGate { bf16_t* tmp;
    DEV void operator()(int m0, int n0, int ty, int tx, float (&acc)[4][4]) const {
#pragma unroll
        for (int i = 0; i < 4; ++i)
#pragma unroll
            for (int j = 0; j < 4; ++j) tmp[(size_t)(m0 + ty + 16 * i) * 1024 + n0 + tx + 16 * j] = f2bf(1.f / (1.f + expf(-acc[i][j])));
    } };
struct EpMerge { const bf16_t* tmp; bf16_t* merged; int first; int pad;
    DEV void operator()(int m0, int n0, int ty, int tx, float (&acc)[4][4]) const {
#pragma unroll
        for (int i = 0; i < 4; ++i)
#pragma unroll
            for (int j = 0; j < 4; ++j) { const size_t o = (size_t)(m0 + ty + 16 * i) * 1024 + n0 + tx + 16 * j; float v = bf2f(tmp[o]) * acc[i][j]; if (!first) v += bf2f(merged[o]); merged[o] = f2bf(v); }
    } };
struct EpOut { const float* xin; float* h; const float* ada_l; int off_g; int pad;
    DEV void operator()(int m0, int n0, int ty, int tx, float (&acc)[4][4]) const {
#pragma unroll
        for (int i = 0; i < 4; ++i)
#pragma unroll
            for (int j = 0; j < 4; ++j) { const int m = m0 + ty + 16 * i, n = n0 + tx + 16 * j; const size_t o = (size_t)m * 1024 + n;
                h[o] = ALPHA_ * xin[o] + ada_l[(size_t)(m >> 11) * 6144 + off_g + n] * acc[i][j]; }
    } };
struct EpQ2 { bf16_t* Q2;
    DEV void operator()(int m0, int n0, int ty, int tx, float (&acc)[4][4]) const {
#pragma unroll
        for (int i = 0; i < 4; ++i)
#pragma unroll
            for (int j = 0; j < 4; ++j) Q2[(size_t)(m0 + ty + 16 * i) * 2048 + n0 + tx + 16 * j] = f2bf(acc[i][j]);
    } };

DEV void nb_attnA(int vb, int t, unsigned char* sm, bf16_t* __restrict__ P, float* __restrict__ lse2) {
    const int idx = vb * 256 + t; const int s = idx & 2047, head = (idx >> 11) % 12, b = idx / (2048 * 12);
    const int gi = head >> 2; const int dil = gi == 0 ? 1 : (gi == 1 ? 4 : 16); const int ls = 2048 / dil; const int r = s % dil, p = s / dil;
    bf16_t* qrow = P + (size_t)(b * 2048 + s) * PW_ + head * 64;
    float q[64], o[64];
#pragma unroll
    for (int d = 0; d < 64; ++d) { q[d] = bf2f(qrow[d]); o[d] = 0.f; }
    float m = -1e30f, l = 0.f;
    const int lo = max(0, p - 64), hi = min(ls - 1, p + 64);
    for (int pp = lo; pp <= hi; ++pp) {
        const bf16_t* krow = P + (size_t)(b * 2048 + pp * dil + r) * PW_ + 768 + head * 64; const bf16_t* vrow = krow + 768;
        float sc = 0.f;
#pragma unroll
        for (int d = 0; d < 64; ++d) sc += q[d] * bf2f(krow[d]);
        const float mn = fmaxf(m, sc), corr = exp2f(m - mn), pw = exp2f(sc - mn);
        l = l * corr + pw;
#pragma unroll
        for (int d = 0; d < 64; ++d) o[d] = o[d] * corr + pw * bf2f(vrow[d]);
        m = mn;
    }
    const float inv = 1.f / l;
#pragma unroll
    for (int d = 0; d < 64; ++d) qrow[d] = f2bf(o[d] * inv);
    lse2[(size_t)(b * 2048 + s) * 12 + head] = m + log2f(l);
}

DEV void nb_attnC(int vb, int t, unsigned char* sm, const bf16_t* __restrict__ P, const float* __restrict__ sink_l, bf16_t* __restrict__ Y) {
    const int idx = vb * 256 + t; const int s = idx & 2047, qh = (idx >> 11) & 7, b = idx >> 14; const int kvh = qh >> 2;
    const bf16_t* qrow = P + (size_t)(b * 2048 + s) * PW_ + 2304 + qh * 64;
    float q[64], o[64];
#pragma unroll
    for (int d = 0; d < 64; ++d) { q[d] = bf2f(qrow[d]); o[d] = 0.f; }
    float m = -1e30f, l = 0.f;
    const int lo = max(0, s - 128), hi = min(2047, s + 128);
    for (int pp = lo; pp <= hi; ++pp) {
        const bf16_t* krow = P + (size_t)(b * 2048 + pp) * PW_ + 2816 + kvh * 64; const bf16_t* vrow = krow + 128;
        float sc = 0.f;
#pragma unroll
        for (int d = 0; d < 64; ++d) sc += q[d] * bf2f(krow[d]);
        const float mn = fmaxf(m, sc), corr = exp2f(m - mn), pw = exp2f(sc - mn);
        l = l * corr + pw;
#pragma unroll
        for (int d = 0; d < 64; ++d) o[d] = o[d] * corr + pw * bf2f(vrow[d]);
        m = mn;
    }
    const float sk = sink_l[qh] * LOG2E_; const float mf = fmaxf(m, sk); const float corr = exp2f(m - mf);
    l = l * corr + exp2f(sk - mf); const float inv = corr / l;
    bf16_t* yrow = Y + (size_t)(b * 2048 + s) * UYW_ + 768 + qh * 64;
#pragma unroll
    for (int d = 0; d < 64; ++d) yrow[d] = f2bf(o[d] * inv);
}

DEV void nb_combineA(int vb, int t, unsigned char* sm, const bf16_t* __restrict__ P, const float* __restrict__ lse2, bf16_t* __restrict__ Y) {
    const size_t idx = (size_t)vb * 256 + t; const int cc = (int)(idx & 255); const size_t tok = idx >> 8; const int hh = cc >> 6, d = cc & 63;
    const float l0 = lse2[tok * 12 + hh], l1 = lse2[tok * 12 + 4 + hh], l2 = lse2[tok * 12 + 8 + hh]; const float mx = fmaxf(l0, fmaxf(l1, l2));
    const float w0 = exp2f(l0 - mx), w1 = exp2f(l1 - mx), w2 = exp2f(l2 - mx);
    const bf16_t* pr = P + tok * PW_ + hh * 64 + d;
    Y[tok * UYW_ + cc] = f2bf((w0 * bf2f(pr[0]) + w1 * bf2f(pr[256]) + w2 * bf2f(pr[512])) / (w0 + w1 + w2));
}

DEV void nb_hyena(int vb, int t, unsigned char* sm, int pass, bf16_t* __restrict__ hyT, bf16_t* __restrict__ z1T, const bf16_t* __restrict__ Gr_l, const float* __restrict__ conv_w,
                                                const float* __restrict__ conv_b, const float* __restrict__ hy_bias) {
    const size_t idx = (size_t)vb * 256 + t; const int i = (int)(idx & 2047); const int b = (int)((idx >> 11) & 15); const int c = (int)(idx >> 15);
    const bf16_t* G = Gr_l + ((size_t)pass * 512 + c) * 4096 + (2047 - i);
    float acc = 0.f, zi = 0.f;
    if (pass == 0) {
        const bf16_t* in = hyT + (size_t)c * T_ + b * 2048; const float w0 = conv_w[c], w1 = conv_w[1536 + c], w2 = conv_w[3072 + c], cb = conv_b[c];
        float prev = 0.f, cur = bf2f(in[0]);
        for (int j = 0; j < 2048; ++j) { const float nxt = (j < 2047) ? bf2f(in[j + 1]) : 0.f; const float z = cb + w0 * prev + w1 * cur + w2 * nxt;
            acc += bf2f(G[j]) * z; if (j == i) zi = z; prev = cur; cur = nxt; }
    } else {
        const bf16_t* in = z1T + (size_t)c * T_ + b * 2048;
        for (int j = 0; j < 2048; ++j) { const float z = bf2f(in[j]); acc += bf2f(G[j]) * z; if (j == i) zi = z; }
    }
    const int xc = (pass == 0 ? 512 : 1024) + c;
    const bf16_t* xin = hyT + (size_t)xc * T_ + b * 2048;
    const float xm = (i > 0) ? bf2f(xin[i - 1]) : 0.f, x0 = bf2f(xin[i]), xp = (i < 2047) ? bf2f(xin[i + 1]) : 0.f;
    const float xv = conv_b[xc] + conv_w[xc] * xm + conv_w[1536 + xc] * x0 + conv_w[3072 + xc] * xp;
    const float outv = xv * (acc + hy_bias[pass * 512 + c] * zi);
    if (pass == 0) z1T[(size_t)c * T_ + b * 2048 + i] = f2bf(outv); else hyT[(size_t)c * T_ + b * 2048 + i] = f2bf(outv);
}

DEV void nb_transY(int vb, int t, unsigned char* sm, const bf16_t* __restrict__ hyT, bf16_t* __restrict__ Y) {
    const size_t idx = (size_t)vb * 256 + t; const int c = (int)(idx & 511); const size_t tok = idx >> 9;
    Y[tok * UYW_ + 256 + c] = hyT[(size_t)c * T_ + tok];
}

DEV void nb_ln_mod(int vb, int t, unsigned char* sm, float* __restrict__ h, const float* __restrict__ g, const float* __restrict__ bta, const float* __restrict__ ada_l, int off_sh, int off_sc,
                                                bf16_t* __restrict__ ubuf) {
    const int tok = vb; float v[4]; float s = 0.f;
#pragma unroll
    for (int k = 0; k < 4; ++k) { v[k] = h[(size_t)tok * 1024 + t + 256 * k]; s += v[k]; }
    float* red = (float*)sm; red[t] = s; __syncthreads();
    for (int st = 128; st > 0; st >>= 1) { if (t < st) red[t] += red[t + st]; __syncthreads(); }
    const float mu = red[0] * (1.f / 1024.f); __syncthreads();
    float q = 0.f;
#pragma unroll
    for (int k = 0; k < 4; ++k) { const float dd = v[k] - mu; q += dd * dd; }
    red[t] = q; __syncthreads();
    for (int st = 128; st > 0; st >>= 1) { if (t < st) red[t] += red[t + st]; __syncthreads(); }
    const float rstd = rsqrtf(red[0] * (1.f / 1024.f) + LN_EPS_);
    const float* a = ada_l + (size_t)(tok >> 11) * 6144;
#pragma unroll
    for (int k = 0; k < 4; ++k) { const int d = t + 256 * k; const float y = (v[k] - mu) * rstd * g[d] + bta[d]; h[(size_t)tok * 1024 + d] = y;
        if (ubuf) ubuf[(size_t)tok * UYW_ + d] = f2bf(y * (1.f + a[off_sc + d]) + a[off_sh + d]); }
}

DEV void nb_peer_topk(int vb, int t, unsigned char* sm, const bf16_t* __restrict__ Q2, const float* __restrict__ keys_l, int* __restrict__ eidx, float* __restrict__ egate) {
    const int grp = t >> 7; const int th = vb * 2 + grp; const int tok = th >> 3, h = th & 7; t &= 127;
    float* qs = (float*)sm + grp * 1024; float* s1 = qs + 256; float* s2 = s1 + 128; float* t1v = s2 + 128; float* t2v = t1v + 16; float* cand = t2v + 16; float* bestv = cand + 256;
    int* t1i = (int*)(bestv + 16); int* t2i = t1i + 16; int* besti = t2i + 16;
    qs[t] = bf2f(Q2[(size_t)tok * 2048 + h * 256 + t]); qs[t + 128] = bf2f(Q2[(size_t)tok * 2048 + h * 256 + 128 + t]);
    __syncthreads();
    { const float* k1 = keys_l + ((size_t)(h * 2 + 0) * 128 + t) * 128; const float* k2 = keys_l + ((size_t)(h * 2 + 1) * 128 + t) * 128; float a = 0.f, bsum = 0.f;
        for (int c = 0; c < 128; ++c) { a += qs[c] * k1[c]; bsum += qs[128 + c] * k2[c]; }
        s1[t] = a; s2[t] = bsum; }
    __syncthreads();
    { const float a = s1[t], bb = s2[t]; int r1 = 0, r2 = 0;
        for (int m = 0; m < 128; ++m) { const float x = s1[m], y = s2[m]; r1 += (x > a || (x == a && m < t)) ? 1 : 0; r2 += (y > bb || (y == bb && m < t)) ? 1 : 0; }
        if (r1 < 16) { t1v[r1] = a; t1i[r1] = t; } if (r2 < 16) { t2v[r2] = bb; t2i[r2] = t; } }
    __syncthreads();
    cand[t] = t1v[t >> 4] + t2v[t & 15]; cand[t + 128] = t1v[(t + 128) >> 4] + t2v[t & 15];
    __syncthreads();
#pragma unroll
    for (int rr = 0; rr < 2; ++rr) { const int ci = t + 128 * rr; const float a = cand[ci]; int r = 0;
        for (int m = 0; m < 256; ++m) { const float x = cand[m]; r += (x > a || (x == a && m < ci)) ? 1 : 0; }
        if (r < 16) { bestv[r] = a; besti[r] = ci; } }
    __syncthreads();
    if (t < 16) { const float mx = bestv[0]; float sum = 0.f;
        for (int k = 0; k < 16; ++k) sum += expf(bestv[k] - mx);
        const int ci = besti[t]; const size_t o = ((size_t)tok * 8 + h) * 16 + t;
        eidx[o] = ((t1i[(ci >> 4) & 15] & 127) * 128 + (t2i[ci & 15] & 127)); egate[o] = expf(bestv[t] - mx) / sum; }
}

DEV void nb_peer(int vb, int t, unsigned char* sm, float* __restrict__ xio, const float* __restrict__ ada_l, const int* __restrict__ eidx, const float* __restrict__ egate,
                                              const float* __restrict__ pu, const float* __restrict__ pv, const float* __restrict__ g, const float* __restrict__ bta,
                                              const float* __restrict__ ada_next, bf16_t* __restrict__ ubuf) {
    const int tok = vb, lane = t & 63, w = t >> 6;
    float* xs = (float*)sm; float* wv = xs + 1024; float* red = wv + 128; int* es = (int*)(red + 256);
    const float* a = ada_l + (size_t)(tok >> 11) * 6144; float x1[4];
#pragma unroll
    for (int k = 0; k < 4; ++k) { const int d = t + 256 * k; x1[k] = xio[(size_t)tok * 1024 + d]; xs[d] = x1[k] * (1.f + a[4096 + d]) + a[3072 + d]; }
    if (t < 128) es[t] = eidx[(size_t)tok * 128 + t];
    __syncthreads();
    for (int i = w; i < 128; i += 4) { const float* ur = pu + (size_t)es[i] * 1024; float dsum = 0.f;
#pragma unroll
        for (int k = 0; k < 16; ++k) dsum += ur[lane + 64 * k] * xs[lane + 64 * k];
#pragma unroll
        for (int off = 32; off > 0; off >>= 1) dsum += __shfl_xor(dsum, off);
        if (lane == 0) wv[i] = egate[(size_t)tok * 128 + i] * 0.5f * dsum * (1.f + erff(dsum * 0.70710678118654752f)); }
    __syncthreads();
    float acc[4] = {0.f, 0.f, 0.f, 0.f};
    for (int i = 0; i < 128; ++i) { const float* vr = pv + (size_t)es[i] * 1024; const float wi = wv[i];
#pragma unroll
        for (int k = 0; k < 4; ++k) acc[k] += wi * vr[t + 256 * k]; }
    float v[4]; float s = 0.f;
#pragma unroll
    for (int k = 0; k < 4; ++k) { v[k] = ALPHA_ * x1[k] + a[5120 + t + 256 * k] * acc[k]; s += v[k]; }
    red[t] = s; __syncthreads();
    for (int st = 128; st > 0; st >>= 1) { if (t < st) red[t] += red[t + st]; __syncthreads(); }
    const float mu = red[0] * (1.f / 1024.f); __syncthreads();
    float q = 0.f;
#pragma unroll
    for (int k = 0; k < 4; ++k) { const float dd = v[k] - mu; q += dd * dd; }
    red[t] = q; __syncthreads();
    for (int st = 128; st > 0; st >>= 1) { if (t < st) red[t] += red[t + st]; __syncthreads(); }
    const float rstd = rsqrtf(red[0] * (1.f / 1024.f) + LN_EPS_);
    const float* an = ada_next ? ada_next + (size_t)(tok >> 11) * 6144 : nullptr;
#pragma unroll
    for (int k = 0; k < 4; ++k) { const int d = t + 256 * k; const float y = (v[k] - mu) * rstd * g[d] + bta[d]; xio[(size_t)tok * 1024 + d] = y;
        if (an) ubuf[(size_t)tok * UYW_ + d] = f2bf(y * (1.f + an[1024 + d]) + an[d]); }
}

#define LAS __attribute__((address_space(3)))
typedef short bf16x8 __attribute__((ext_vector_type(8)));
typedef float f32x4 __attribute__((ext_vector_type(4)));
typedef float f32x2 __attribute__((ext_vector_type(2)));
typedef unsigned u32x4 __attribute__((ext_vector_type(4)));
typedef unsigned u32x2 __attribute__((ext_vector_type(2)));
namespace pg8 {
constexpr int BM = 256, BK = 64, HALF = 128, HTB = HALF * BK * 2, STAGE_BYTES = 8 * HTB, NXCD = 8, WGM = 8;
DEV int lds_byte(int r, int c) { const int st = (r >> 4) * 2 + (c >> 5), rr = r & 15, cc = c & 31, ob = rr * 64 + cc * 2; return st * 1024 + (ob ^ (((ob >> 9) & 1) << 5)); }
DEV void stage_rc(int b, int& R, int& C) { const int st = b / 1024, sb = b % 1024, swz = sb ^ (((sb >> 9) & 1) << 5); R = (st >> 1) * 16 + swz / 64; C = (st & 1) * 32 + (swz % 64) / 2; }
DEV int perm32(int rho) { const int n = rho >> 4, i = rho & 15; return 8 * (i >> 2) + 4 * n + (i & 3); }
DEV unsigned cvt_pk_bf16(float lo, float hi) { unsigned r; asm volatile("v_cvt_pk_bf16_f32 %0, %1, %2" : "=v"(r) : "v"(lo), "v"(hi)); return r; }

struct Unit { int pm, pn, tag, nt; const char* a; const char* b; };
DEV void tile_of(int L, int nM, int nN, int& pm, int& pn) {
    const int nwg = nM * nN; int wgid = L; { const int q = nwg / NXCD, r = nwg % NXCD, xcd = wgid % NXCD, off = wgid / NXCD; wgid = (xcd < r ? xcd * (q + 1) : r * (q + 1) + (xcd - r) * q) + off; }
    const int nig = WGM * nN, gid = wgid / nig, fm = gid * WGM, gsz = (nM - fm) < WGM ? (nM - fm) : WGM;
    pm = fm + ((wgid % nig) % gsz); pn = (wgid % nig) / gsz;
}
struct PlainSched { const bf16_t* A; const bf16_t* Bt; int lda, ldb, nM, nN, nt, G, c;
    DEV bool next(int i, Unit& u) const { const long L = (long)i * G + c; if (L >= (long)nM * nN) return false; tile_of((int)L, nM, nN, u.pm, u.pn); u.tag = 0; u.nt = nt;
        u.a = (const char*)(A + (size_t)u.pm * BM * lda); u.b = (const char*)(Bt + (size_t)u.pn * BM * ldb); return true; } };

template <class Epi, class Sched>
DEV void gemm_phase(LAS unsigned char* lds, const int lda, const int ldb, const Sched& S, const Epi& E, const int wv) {
    int wv_ = wv, ln_; asm volatile("v_mbcnt_lo_u32_b32 %1, -1, 0\n\tv_mbcnt_hi_u32_b32 %1, -1, %1" : "+s"(wv_), "=v"(ln_)); int tid_ = (wv_ << 6) | ln_;
    const int tid = tid_, wid = __builtin_amdgcn_readfirstlane(tid >> 6), lane = tid & 63, wr = wid >> 2, wc = wid & 3, fr = lane & 15, fq = lane >> 4;
    unsigned voffA[2], voffB[2];
#pragma unroll
    for (int i = 0; i < 2; ++i) { int R, C; stage_rc(tid * 16 + i * 8192, R, C); const int Rb = Epi::PERM ? ((R & ~31) + perm32(R & 31)) : R;
        voffA[i] = (unsigned)(R * lda + C) * 2u; voffB[i] = (unsigned)(Rb * ldb + C) * 2u; }
    const size_t kstep = (size_t)(BK * 2);
    const size_t hstepA = (size_t)HALF * lda * 2, hstepB = (size_t)HALF * ldb * 2;
    const unsigned ldsw = (unsigned)wid * 1024u;
    const int aoff = lds_byte(wr * 64 + fr, fq * 8), boff = lds_byte(wc * 32 + fr, fq * 8);
#define PG8_SA(b, h) (((b) * 2 + (h)) * HTB)
#define PG8_SB(b, h) ((4 + (b) * 2 + (h)) * HTB)
#define PG8_STAGE(bufoff, gbase, voff) do { _Pragma("unroll") for (int _i = 0; _i < 2; ++_i) \
        __builtin_amdgcn_global_load_lds((const unsigned*)((const char*)(gbase) + (voff)[_i]), (LAS unsigned*)(lds + (bufoff) + ldsw + _i * 8192), 16, 0, 0); } while (0)
#define PG8_LDA(dst, b, h) do { _Pragma("unroll") for (int m = 0; m < 4; ++m) _Pragma("unroll") for (int k = 0; k < 2; ++k) dst[m][k] = *(const LAS bf16x8*)(lds + PG8_SA(b, h) + aoff + m * 2048 + k * 1024); } while (0)
#define PG8_LDB(dst, b, h) do { _Pragma("unroll") for (int n = 0; n < 2; ++n) _Pragma("unroll") for (int k = 0; k < 2; ++k) dst[n][k] = *(const LAS bf16x8*)(lds + PG8_SB(b, h) + boff + n * 2048 + k * 1024); } while (0)
#define PG8_MMA(ai, bj, At, Bt) do { __builtin_amdgcn_s_setprio(1); _Pragma("unroll") for (int m = 0; m < 4; ++m) _Pragma("unroll") for (int n = 0; n < 2; ++n) _Pragma("unroll") for (int k = 0; k < 2; ++k) \
        acc[ai][bj][m][n] = __builtin_amdgcn_mfma_f32_16x16x32_bf16(Bt[n][k], At[m][k], acc[ai][bj][m][n], 0, 0, 0); __builtin_amdgcn_s_setprio(0); } while (0)
#define PG8_WAIT_V(n) asm volatile("s_waitcnt vmcnt(" #n ")" ::: "memory")
#define PG8_WAIT_L(n) asm volatile("s_waitcnt lgkmcnt(" #n ")" ::: "memory")
#define PG8_BAR __builtin_amdgcn_s_barrier()
#define PG8_SCHED __builtin_amdgcn_sched_barrier(0)
    Unit cur, nxt; int ui = 0;
    if (!S.next(0, cur)) return;
    f32x4 acc[2][2][4][2];
#pragma unroll
    for (int a = 0; a < 2; ++a)
#pragma unroll
        for (int b = 0; b < 2; ++b)
#pragma unroll
            for (int m = 0; m < 4; ++m)
#pragma unroll
                for (int n = 0; n < 2; ++n) acc[a][b][m][n] = (f32x4){0.f, 0.f, 0.f, 0.f};
    bf16x8 At[4][2], B0[2][2], B1[2][2];
    const char* cA = cur.a; const char* cB = cur.b;
    PG8_STAGE(PG8_SB(0, 0), cB, voffB); PG8_STAGE(PG8_SA(0, 0), cA, voffA); PG8_STAGE(PG8_SB(0, 1), cB + hstepB, voffB); PG8_STAGE(PG8_SA(0, 1), cA + hstepA, voffA);
    if (wr == 1) PG8_BAR;
    PG8_WAIT_V(4); PG8_BAR;
    PG8_STAGE(PG8_SB(1, 0), cB + kstep, voffB); PG8_STAGE(PG8_SA(1, 0), cA + kstep, voffA); PG8_STAGE(PG8_SB(1, 1), cB + hstepB + kstep, voffB);
    PG8_WAIT_V(6); PG8_BAR;
    for (;;) {
        const bool has_next = S.next(ui + 1, nxt);
        const char* nA = has_next ? nxt.a : cA; const char* nB = has_next ? nxt.b : cB;
        const int nt = cur.nt;
        for (int t = 0; t < nt; t += 2) {
            const bool last = (t == nt - 2);
            const char* a1 = cA + (size_t)(t + 1) * kstep;
            const char* a2 = last ? nA : cA + (size_t)(t + 2) * kstep; const char* b2 = last ? nB : cB + (size_t)(t + 2) * kstep;
            const char* a3 = a2 + kstep; const char* b3 = b2 + kstep;
            PG8_LDB(B0, 0, 0); PG8_SCHED; PG8_LDA(At, 0, 0); PG8_STAGE(PG8_SA(1, 1), a1 + hstepA, voffA);
            PG8_WAIT_L(8); PG8_BAR; PG8_WAIT_L(0); PG8_MMA(0, 0, At, B0); PG8_BAR; PG8_SCHED;
            PG8_LDB(B1, 0, 1); PG8_STAGE(PG8_SB(0, 0), b2, voffB);
            PG8_BAR; PG8_WAIT_L(0); PG8_MMA(0, 1, At, B1); PG8_BAR;
            PG8_LDA(At, 0, 1); PG8_STAGE(PG8_SA(0, 0), a2, voffA);
            PG8_BAR; PG8_WAIT_L(0); PG8_MMA(1, 0, At, B0); PG8_BAR; PG8_SCHED;
            PG8_STAGE(PG8_SB(0, 1), b2 + hstepB, voffB);
            PG8_WAIT_V(6); PG8_BAR; PG8_MMA(1, 1, At, B1); PG8_BAR;
            PG8_LDB(B0, 1, 0); PG8_SCHED; PG8_LDA(At, 1, 0); PG8_STAGE(PG8_SA(0, 1), a2 + hstepA, voffA);
            PG8_WAIT_L(8); PG8_BAR; PG8_WAIT_L(0); PG8_MMA(0, 0, At, B0); PG8_BAR; PG8_SCHED;
            PG8_LDB(B1, 1, 1); PG8_STAGE(PG8_SB(1, 0), b3, voffB);
            PG8_BAR; PG8_WAIT_L(0); PG8_MMA(0, 1, At, B1); PG8_BAR;
            PG8_LDA(At, 1, 1); PG8_STAGE(PG8_SA(1, 0), a3, voffA);
            PG8_BAR; PG8_WAIT_L(0); PG8_MMA(1, 0, At, B0); PG8_BAR; PG8_SCHED;
            PG8_STAGE(PG8_SB(1, 1), b3 + hstepB, voffB);
            PG8_WAIT_V(6); PG8_BAR; PG8_MMA(1, 1, At, B1); PG8_BAR;
        }
        E(acc, cur, wr, wc, fr, fq);
        if (!has_next) break;
#pragma unroll
        for (int a = 0; a < 2; ++a)
#pragma unroll
            for (int b = 0; b < 2; ++b)
#pragma unroll
                for (int m = 0; m < 4; ++m)
#pragma unroll
                    for (int n = 0; n < 2; ++n) acc[a][b][m][n] = (f32x4){0.f, 0.f, 0.f, 0.f};
        cur = nxt; cA = nA; cB = nB; ++ui;
    }
    PG8_WAIT_V(0);
    if (wr == 0) PG8_BAR;
    PG8_BAR;
#undef PG8_SA
#undef PG8_SB
#undef PG8_STAGE
#undef PG8_LDA
#undef PG8_LDB
#undef PG8_MMA
#undef PG8_WAIT_V
#undef PG8_WAIT_L
#undef PG8_BAR
#undef PG8_SCHED
}
struct EpiBf { static constexpr bool PERM = true; bf16_t* O; int ldc; int pad;
    DEV void operator()(const f32x4 (&acc)[2][2][4][2], const Unit& u, int wr, int wc, int fr, int fq) const {
        const int row0 = u.pm * BM + wr * 64 + fr, col0 = u.pn * BM + wc * 32 + 8 * fq;
#pragma unroll
        for (int ai = 0; ai < 2; ++ai)
#pragma unroll
            for (int m = 0; m < 4; ++m) { bf16_t* rowp = O + (size_t)(row0 + ai * HALF + m * 16) * ldc + col0;
#pragma unroll
                for (int bj = 0; bj < 2; ++bj) { const f32x4 v0 = acc[ai][bj][m][0], v1 = acc[ai][bj][m][1];
                    u32x4 w; w.x = cvt_pk_bf16(v0[0], v0[1]); w.y = cvt_pk_bf16(v0[2], v0[3]); w.z = cvt_pk_bf16(v1[0], v1[1]); w.w = cvt_pk_bf16(v1[2], v1[3]);
                    *(u32x4*)(rowp + bj * HALF) = w; } }
    } };
struct EpiP { static constexpr bool PERM = true; bf16_t* P; const float2* rope;
    DEV void operator()(const f32x4 (&acc)[2][2][4][2], const Unit& u, int wr, int wc, int fr, int fq) const {
        const int row0 = u.pm * BM + wr * 64 + fr, col0 = u.pn * BM + wc * 32 + 8 * fq; const int g = (wc & 1) * 4 + fq; const int pn = u.pn;
        const bool qs = (pn < 3) || (pn == 9) || (pn == 10);
#pragma unroll
        for (int ai = 0; ai < 2; ++ai)
#pragma unroll
            for (int m = 0; m < 4; ++m) { const int row = row0 + ai * HALF + m * 16; bf16_t* rowp = P + (size_t)row * PW_ + col0;
                const float4* rp = (const float4*)(rope + (size_t)(row & 2047) * 32 + 4 * g); const float4 cs0 = rp[0], cs1 = rp[1];
                const float cc[4] = {cs0.x, cs0.z, cs1.x, cs1.z}, ss[4] = {cs0.y, cs0.w, cs1.y, cs1.w};
#pragma unroll
                for (int bj = 0; bj < 2; ++bj) { f32x4 v0 = acc[ai][bj][m][0], v1 = acc[ai][bj][m][1];
                    const bool rp_ = (pn < 6) || (pn == 9) || (pn == 10) || (pn == 11 && bj == 0);
                    if (rp_) {
#pragma unroll
                        for (int j = 0; j < 4; ++j) { const float x1 = v0[j], x2 = v1[j]; float o1 = x1 * cc[j] - x2 * ss[j], o2 = x2 * cc[j] + x1 * ss[j];
                            if (qs) { o1 *= QSCALE_; o2 *= QSCALE_; } v0[j] = o1; v1[j] = o2; } }
                    u32x4 w; w.x = cvt_pk_bf16(v0[0], v0[1]); w.y = cvt_pk_bf16(v0[2], v0[3]); w.z = cvt_pk_bf16(v1[0], v1[1]); w.w = cvt_pk_bf16(v1[2], v1[3]);
                    *(u32x4*)(rowp + bj * HALF) = w; } }
    } };
struct EpiMergeAll { static constexpr bool PERM = true; bf16_t* gtmp; bf16_t* merged;
    DEV void operator()(const f32x4 (&acc)[2][2][4][2], const Unit& u, int wr, int wc, int fr, int fq) const {
        const int row0 = u.pm * BM + wr * 64 + fr, col0 = u.pn * BM + wc * 32 + 8 * fq; const int tag = u.tag;
#pragma unroll
        for (int ai = 0; ai < 2; ++ai)
#pragma unroll
            for (int m = 0; m < 4; ++m) { const size_t ro = (size_t)(row0 + ai * HALF + m * 16) * 1024 + col0;
#pragma unroll
                for (int bj = 0; bj < 2; ++bj) { f32x4 v0 = acc[ai][bj][m][0], v1 = acc[ai][bj][m][1]; const size_t o = ro + bj * HALF;
                    if ((tag & 1) == 0) {
#pragma unroll
                        for (int j = 0; j < 4; ++j) { v0[j] = 1.f / (1.f + __expf(-v0[j])); v1[j] = 1.f / (1.f + __expf(-v1[j])); }
                        u32x4 w; w.x = cvt_pk_bf16(v0[0], v0[1]); w.y = cvt_pk_bf16(v0[2], v0[3]); w.z = cvt_pk_bf16(v1[0], v1[1]); w.w = cvt_pk_bf16(v1[2], v1[3]);
                        *(u32x4*)(gtmp + o) = w;
                    } else {
                        const u32x4 gq = *(const u32x4*)(gtmp + o);
                        float gg[8] = {__uint_as_float(gq.x << 16), __uint_as_float(gq.x & 0xffff0000u), __uint_as_float(gq.y << 16), __uint_as_float(gq.y & 0xffff0000u),
                                       __uint_as_float(gq.z << 16), __uint_as_float(gq.z & 0xffff0000u), __uint_as_float(gq.w << 16), __uint_as_float(gq.w & 0xffff0000u)};
#pragma unroll
                        for (int j = 0; j < 4; ++j) { v0[j] *= gg[j]; v1[j] *= gg[4 + j]; }
                        if (tag != 1) { const u32x4 mq = *(const u32x4*)(merged + o);
                            float mm[8] = {__uint_as_float(mq.x << 16), __uint_as_float(mq.x & 0xffff0000u), __uint_as_float(mq.y << 16), __uint_as_float(mq.y & 0xffff0000u),
                                           __uint_as_float(mq.z << 16), __uint_as_float(mq.z & 0xffff0000u), __uint_as_float(mq.w << 16), __uint_as_float(mq.w & 0xffff0000u)};
#pragma unroll
                            for (int j = 0; j < 4; ++j) { v0[j] += mm[j]; v1[j] += mm[4 + j]; } }
                        u32x4 w; w.x = cvt_pk_bf16(v0[0], v0[1]); w.y = cvt_pk_bf16(v0[2], v0[3]); w.z = cvt_pk_bf16(v1[0], v1[1]); w.w = cvt_pk_bf16(v1[2], v1[3]);
                        *(u32x4*)(merged + o) = w;
                    } } }
    } };
struct EpiOut { static constexpr bool PERM = false; const float* xin; float* h; const float* ada_g;
    DEV void operator()(const f32x4 (&acc)[2][2][4][2], const Unit& u, int wr, int wc, int fr, int fq) const {
        const int row0 = u.pm * BM + wr * 64 + fr, col0 = u.pn * BM + wc * 32 + 4 * fq; const float* gv = ada_g + (size_t)(u.pm >> 3) * 6144 + col0;
        f32x4 g[2][2];
#pragma unroll
        for (int bj = 0; bj < 2; ++bj)
#pragma unroll
            for (int n = 0; n < 2; ++n) g[bj][n] = *(const f32x4*)(gv + bj * HALF + n * 16);
#pragma unroll
        for (int ai = 0; ai < 2; ++ai)
#pragma unroll
            for (int m = 0; m < 4; ++m) { const size_t ro = (size_t)(row0 + ai * HALF + m * 16) * 1024 + col0;
#pragma unroll
                for (int bj = 0; bj < 2; ++bj)
#pragma unroll
                    for (int n = 0; n < 2; ++n) { const size_t o = ro + bj * HALF + n * 16; const f32x4 xv = *(const f32x4*)(xin + o); *(f32x4*)(h + o) = ALPHA_ * xv + g[bj][n] * acc[ai][bj][m][n]; } }
    } };
struct MergeSched { const bf16_t* UY; const bf16_t* WmT; int G, c;
    DEV bool next(int i, Unit& u) const { const int ti = i / 6, ps = i - ti * 6; const long L = (long)ti * G + c; if (L >= 128 * 4) return false; tile_of((int)L, 128, 4, u.pm, u.pn); u.tag = ps;
        const int br = ps >> 1; const bf16_t* ar = UY + (size_t)u.pm * BM * UYW_; const bf16_t* brow = WmT + (size_t)u.pn * BM * WMW_;
        if ((ps & 1) == 0) { u.nt = 16; u.a = (const char*)ar; u.b = (const char*)(brow + br * 1024); }
        else { const int koff = br == 0 ? 0 : (br == 1 ? 256 : 768); u.nt = br == 0 ? 4 : 8; u.a = (const char*)(ar + 1024 + koff); u.b = (const char*)(brow + 3072 + koff); }
        return true; } };
}

DEV int win_orig_col(int n) {
    if (n >= 3072) return n < 4608 ? (n - 3072 + 2304) : n;
    const int head = n >> 6, p = n & 63; const bool rp = (head < 24) || (head >= 36 && head < 46);
    const int d = rp ? ((p & 4) ? 32 + 4 * (p >> 3) + (p & 3) : 4 * (p >> 3) + (p & 3)) : p;
    return ((n < 2304) ? head * 64 : 3840 + (head - 36) * 64) + d;
}
struct WPrep { const float *w_in, *wba, *wbb, *wbc, *w_out, *peer_wq; bf16_t *WinT, *WmT, *WoutT, *WqT; };
DEV void nb_wprep(int vb, int t, unsigned char* sm, const WPrep& q) {
    const int l = vb / 3008; int r = vb - l * 3008; const float* W; int ldw; bf16_t* Wt; int ldt, koff = 0, ntk = 16, mode = 0, nsub = 0;
    if (r < 1920) { W = q.w_in + (size_t)l * 1024 * 7680; ldw = 7680; mode = 1;
        if (r < 72 * 16) { Wt = q.WinT + (size_t)l * 7680 * 1024; ldt = 1024; }
        else { const int br = (r / 16 - 72) / 16; Wt = q.WmT + (size_t)l * 1024 * WMW_; ldt = WMW_; koff = br * 1024; nsub = 4608 + br * 1024; } }
    else if (r < 1984) { r -= 1920; W = q.wba + (size_t)l * 256 * 1024; ldw = 1024; Wt = q.WmT + (size_t)l * 1024 * WMW_; ldt = WMW_; koff = 3072; ntk = 4; }
    else if (r < 2112) { r -= 1984; W = q.wbb + (size_t)l * 512 * 1024; ldw = 1024; Wt = q.WmT + (size_t)l * 1024 * WMW_; ldt = WMW_; koff = 3072 + 256; ntk = 8; }
    else if (r < 2240) { r -= 2112; W = q.wbc + (size_t)l * 512 * 1024; ldw = 1024; Wt = q.WmT + (size_t)l * 1024 * WMW_; ldt = WMW_; koff = 3072 + 768; ntk = 8; }
    else if (r < 2496) { r -= 2240; W = q.w_out + (size_t)l * 1024 * 1024; ldw = 1024; Wt = q.WoutT + (size_t)l * 1024 * 1024; ldt = 1024; }
    else { r -= 2496; W = q.peer_wq + (size_t)l * 1024 * 2048; ldw = 2048; Wt = q.WqT + (size_t)l * 2048 * 1024; ldt = 1024; }
    const int n0 = (r / ntk) * 64, k0 = (r % ntk) * 64; const int c0 = mode ? (win_orig_col(n0) & ~63) : n0;
    bf16_t* tile = (bf16_t*)sm;
    { const int kk = t >> 2, cs = (t & 3) * 16; const float* src = W + (size_t)(k0 + kk) * ldw + c0 + cs;
#pragma unroll
        for (int i = 0; i < 16; i += 4) { const float4 v = *(const float4*)(src + i); tile[kk * 66 + cs + i] = f2bf(v.x); tile[kk * 66 + cs + i + 1] = f2bf(v.y); tile[kk * 66 + cs + i + 2] = f2bf(v.z); tile[kk * 66 + cs + i + 3] = f2bf(v.w); } }
    __syncthreads();
    { const int nn = t >> 2, ks = (t & 3) * 16; const int dl = mode ? (win_orig_col(n0 + nn) - c0) : nn; bf16_t* dst = Wt + (size_t)(n0 + nn - nsub) * ldt + koff + k0 + ks;
        unsigned w[8];
#pragma unroll
        for (int i = 0; i < 8; ++i) w[i] = (unsigned)tile[(ks + 2 * i) * 66 + dl] | ((unsigned)tile[(ks + 2 * i + 1) * 66 + dl] << 16);
        *(u32x4*)dst = (u32x4){w[0], w[1], w[2], w[3]}; *(u32x4*)(dst + 8) = (u32x4){w[4], w[5], w[6], w[7]}; }
}

namespace hy {
constexpr int ZS = 2064;
constexpr int G0_OFF = 0, G1_OFF = 8192, Z0_OFF = 16384, Z1_OFF = Z0_OFF + 16 * ZS * 2, LDS_END = Z1_OFF + 16 * ZS * 2;
DEV bf16x8 load_frag(LAS const unsigned char* lane_base, int d) {
    const LAS unsigned* p = (const LAS unsigned*)(lane_base + 32 * d); u32x4 w; w.x = p[0]; w.y = p[1]; w.z = p[2]; w.w = p[3];
    return __builtin_bit_cast(bf16x8, w);
}
DEV void load_filter(LAS unsigned char* lds, const bf16_t* g, int tid) {
    const u32x4 c = *(const u32x4*)(g + tid * 8); const unsigned nx = (tid < 511) ? (unsigned)g[tid * 8 + 8] : 0u;
    *(LAS u32x4*)(lds + G0_OFF + tid * 16) = c;
    u32x4 s; s.x = (c.x >> 16) | (c.y << 16); s.y = (c.y >> 16) | (c.z << 16); s.z = (c.z >> 16) | (c.w << 16); s.w = (c.w >> 16) | (nx << 16);
    *(LAS u32x4*)(lds + G1_OFF + tid * 16) = s;
}
DEV float bflo(unsigned w) { return __uint_as_float(w << 16); }
DEV float bfhi(unsigned w) { return __uint_as_float(w & 0xffff0000u); }
DEV void conv_rows(LAS const unsigned char* lds, int zoff, int w, int lane, f32x4 (&D)[16]) {
    const int r = lane & 15, q = lane >> 4;
    LAS const unsigned char* abase = lds + ((r & 1) ? (G0_OFF + 2 * (8 * q - r + 2047)) : (G1_OFF + 2 * (8 * q - r + 2046)));
    LAS const unsigned char* bbase = lds + zoff + (r * ZS + 8 * q) * 2;
    bf16x8 ring[16];
#pragma unroll
    for (int rb = 0; rb < 16; ++rb) D[rb] = (f32x4){0.f, 0.f, 0.f, 0.f};
#pragma unroll
    for (int rb = 2; rb < 16; ++rb) ring[rb] = load_frag(abase, -16 * w - rb);
#pragma unroll 1
    for (int jb0 = 0; jb0 < 64; jb0 += 8) {
#pragma unroll
        for (int u = 0; u < 8; ++u) { const int jb = jb0 + u;
            ring[(16 - 2 * u) & 15] = load_frag(abase, 2 * jb - 16 * w);
            ring[(17 - 2 * u) & 15] = load_frag(abase, 2 * jb - 16 * w - 1);
            const bf16x8 bf = *(const LAS bf16x8*)(bbase + 64 * jb);
#pragma unroll
            for (int rb = 0; rb < 16; ++rb) D[rb] = __builtin_amdgcn_mfma_f32_16x16x32_bf16(ring[(rb - 2 * u) & 15], bf, D[rb], 0, 0, 0);
        }
    }
}
DEV void sconv4(const bf16_t* in, int i, float w0, float w1, float w2, float cb, float (&o)[4]) {
    const u32x2 v = *(const u32x2*)(in + i); const float pm = (i > 0) ? bf2f(in[i - 1]) : 0.f, pn = (i + 4 < 2048) ? bf2f(in[i + 4]) : 0.f;
    const float x0 = bflo(v.x), x1 = bfhi(v.x), x2 = bflo(v.y), x3 = bfhi(v.y);
    o[0] = cb + w0 * pm + w1 * x0 + w2 * x1; o[1] = cb + w0 * x0 + w1 * x1 + w2 * x2; o[2] = cb + w0 * x1 + w1 * x2 + w2 * x3; o[3] = cb + w0 * x2 + w1 * x3 + w2 * pn;
}
DEV void hyena_phase(LAS unsigned char* lds, bf16_t* hyT, const bf16_t* Gr_l, const float* conv_w, const float* conv_b, const float* hy_bias, int G, int cblk, int wv) {
    int wv_ = wv, ln_; asm volatile("v_mbcnt_lo_u32_b32 %1, -1, 0\n\tv_mbcnt_hi_u32_b32 %1, -1, %1" : "+s"(wv_), "=v"(ln_)); int tid_ = (wv_ << 6) | ln_;
    const int tid = tid_, w = __builtin_amdgcn_readfirstlane(tid >> 6), lane = tid & 63, q = lane >> 4, b = lane & 15;
#pragma unroll 1
    for (int c = cblk; c < 512; c += G) {
        __syncthreads();
        load_filter(lds, Gr_l + (size_t)c * 4096, tid);
        { const float w0 = conv_w[c], w1 = conv_w[1536 + c], w2 = conv_w[3072 + c], cb = conv_b[c]; const bf16_t* row = hyT + (size_t)c * T_;
#pragma unroll 2
            for (int k = 0; k < 8; ++k) { const int pos = (k * 512 + tid) * 8; const int s = pos & 2047, bb = pos >> 11;
                const u32x4 v = *(const u32x4*)(row + pos); const float pm = (s > 0) ? bf2f(row[pos - 1]) : 0.f, pn = (s + 8 < 2048) ? bf2f(row[pos + 8]) : 0.f;
                const float x[10] = {pm, bflo(v.x), bfhi(v.x), bflo(v.y), bfhi(v.y), bflo(v.z), bfhi(v.z), bflo(v.w), bfhi(v.w), pn};
                float z[8];
#pragma unroll
                for (int e = 0; e < 8; ++e) z[e] = cb + w0 * x[e] + w1 * x[e + 1] + w2 * x[e + 2];
                u32x4 o; o.x = pg8::cvt_pk_bf16(z[0], z[1]); o.y = pg8::cvt_pk_bf16(z[2], z[3]); o.z = pg8::cvt_pk_bf16(z[4], z[5]); o.w = pg8::cvt_pk_bf16(z[6], z[7]);
                *(LAS u32x4*)(lds + Z0_OFF + (bb * ZS + s) * 2) = o; } }
        __syncthreads();
        f32x4 D[16];
        conv_rows(lds, Z0_OFF, w, lane, D);
        { const int xc = 512 + c; const float w0 = conv_w[xc], w1 = conv_w[1536 + xc], w2 = conv_w[3072 + xc], cb = conv_b[xc], bias = hy_bias[c]; const bf16_t* xin = hyT + (size_t)xc * T_ + b * 2048;
#pragma unroll
            for (int rb = 0; rb < 16; ++rb) { const int i = 256 * w + 16 * rb + 4 * q; float xv[4]; sconv4(xin, i, w0, w1, w2, cb, xv);
                const u32x2 zq = *(const LAS u32x2*)(lds + Z0_OFF + (b * ZS + i) * 2); const float zv[4] = {bflo(zq.x), bfhi(zq.x), bflo(zq.y), bfhi(zq.y)};
                float o[4];
#pragma unroll
                for (int e = 0; e < 4; ++e) o[e] = xv[e] * (D[rb][e] + bias * zv[e]);
                u32x2 pk; pk.x = pg8::cvt_pk_bf16(o[0], o[1]); pk.y = pg8::cvt_pk_bf16(o[2], o[3]);
                *(LAS u32x2*)(lds + Z1_OFF + (b * ZS + i) * 2) = pk; } }
        __syncthreads();
        load_filter(lds, Gr_l + (size_t)(512 + c) * 4096, tid);
        __syncthreads();
        conv_rows(lds, Z1_OFF, w, lane, D);
        { const int xc = 1024 + c; const float w0 = conv_w[xc], w1 = conv_w[1536 + xc], w2 = conv_w[3072 + xc], cb = conv_b[xc], bias = hy_bias[512 + c]; const bf16_t* xin = hyT + (size_t)xc * T_ + b * 2048;
            bf16_t* yout = hyT + (size_t)c * T_ + b * 2048;
#pragma unroll
            for (int rb = 0; rb < 16; ++rb) { const int i = 256 * w + 16 * rb + 4 * q; float xv[4]; sconv4(xin, i, w0, w1, w2, cb, xv);
                const u32x2 zq = *(const LAS u32x2*)(lds + Z1_OFF + (b * ZS + i) * 2); const float zv[4] = {bflo(zq.x), bfhi(zq.x), bflo(zq.y), bfhi(zq.y)};
                float o[4];
#pragma unroll
                for (int e = 0; e < 4; ++e) o[e] = xv[e] * (D[rb][e] + bias * zv[e]);
                u32x2 pk; pk.x = pg8::cvt_pk_bf16(o[0], o[1]); pk.y = pg8::cvt_pk_bf16(o[2], o[3]);
                *(u32x2*)(yout + i) = pk; } }
    }
    __syncthreads();
}
}

namespace peer {
DEV float wave_sum(float v, int lane) {
#pragma unroll
    for (int off = 32; off > 0; off >>= 1) v += xor_f(v, off, lane);
    return v;
}
DEV float wave_max(float v, int lane) {
#pragma unroll
    for (int off = 32; off > 0; off >>= 1) v = fmaxf(v, xor_f(v, off, lane));
    return v;
}
DEV unsigned pk4_fp8(float a, float b, float c, float d) { int w = __builtin_amdgcn_cvt_pk_fp8_f32(a, b, 0, false); w = __builtin_amdgcn_cvt_pk_fp8_f32(c, d, w, true); return (unsigned)w; }
DEV void nb_quant_tables(int vb, int t, const float* __restrict__ pu, const float* __restrict__ pv, unsigned char* __restrict__ U8, unsigned char* __restrict__ V4, float* __restrict__ sinv) {
    const int row = vb * 4 + (t >> 6), lane = t & 63; const float* src = (row < 16384) ? pu + (size_t)row * 1024 : pv + (size_t)(row - 16384) * 1024;
    const float4 a = *(const float4*)(src + 16 * lane), b = *(const float4*)(src + 16 * lane + 4), c = *(const float4*)(src + 16 * lane + 8), d = *(const float4*)(src + 16 * lane + 12);
    float mx = fmaxf(fmaxf(fmaxf(fabsf(a.x), fabsf(a.y)), fmaxf(fabsf(a.z), fabsf(a.w))), fmaxf(fmaxf(fabsf(b.x), fabsf(b.y)), fmaxf(fabsf(b.z), fabsf(b.w))));
    mx = fmaxf(mx, fmaxf(fmaxf(fmaxf(fabsf(c.x), fabsf(c.y)), fmaxf(fabsf(c.z), fabsf(c.w))), fmaxf(fmaxf(fabsf(d.x), fabsf(d.y)), fmaxf(fabsf(d.z), fabsf(d.w)))));
    mx = wave_max(mx, lane);
    if (row < 16384) {
        const float sc = (mx > 0.f) ? 224.f / mx : 1.f;
        u32x4 o; o.x = pk4_fp8(a.x * sc, a.y * sc, a.z * sc, a.w * sc); o.y = pk4_fp8(b.x * sc, b.y * sc, b.z * sc, b.w * sc); o.z = pk4_fp8(c.x * sc, c.y * sc, c.z * sc, c.w * sc); o.w = pk4_fp8(d.x * sc, d.y * sc, d.z * sc, d.w * sc);
        *(u32x4*)(U8 + (size_t)row * 1024 + 16 * lane) = o;
        if (lane == 0) sinv[row] = (mx > 0.f) ? mx * (1.f / 224.f) : 1.f;
    } else {
        const float sc = (mx > 0.f) ? 6.f / mx : 0.f; unsigned w0 = 0u, w1 = 0u;
        w0 = __builtin_amdgcn_cvt_scalef32_pk_fp4_f32(w0, a.x * sc, a.y * sc, 1.0f, 0); w0 = __builtin_amdgcn_cvt_scalef32_pk_fp4_f32(w0, a.z * sc, a.w * sc, 1.0f, 1);
        w0 = __builtin_amdgcn_cvt_scalef32_pk_fp4_f32(w0, b.x * sc, b.y * sc, 1.0f, 2); w0 = __builtin_amdgcn_cvt_scalef32_pk_fp4_f32(w0, b.z * sc, b.w * sc, 1.0f, 3);
        w1 = __builtin_amdgcn_cvt_scalef32_pk_fp4_f32(w1, c.x * sc, c.y * sc, 1.0f, 0); w1 = __builtin_amdgcn_cvt_scalef32_pk_fp4_f32(w1, c.z * sc, c.w * sc, 1.0f, 1);
        w1 = __builtin_amdgcn_cvt_scalef32_pk_fp4_f32(w1, d.x * sc, d.y * sc, 1.0f, 2); w1 = __builtin_amdgcn_cvt_scalef32_pk_fp4_f32(w1, d.z * sc, d.w * sc, 1.0f, 3);
        *(u32x2*)(V4 + (size_t)(row - 16384) * 512 + 8 * lane) = (u32x2){w0, w1};
        if (lane == 0) sinv[row] = (mx > 0.f) ? mx * (1.f / 6.f) : 0.f;
    }
}
DEV void peer_phase(LAS unsigned char* lds, float* xio, const float* ada_l, const int* __restrict__ eidx, const float* __restrict__ egate, const unsigned char* __restrict__ U8, const unsigned char* __restrict__ V4,
                    const float* __restrict__ sinv, const float* __restrict__ g, const float* __restrict__ bta, const float* ada_next, bf16_t* UY, int G, int cblk, int wv) {
    int wv_ = wv, ln_; asm volatile("v_mbcnt_lo_u32_b32 %1, -1, 0\n\tv_mbcnt_hi_u32_b32 %1, -1, %1" : "+s"(wv_), "=v"(ln_)); int tid_ = (wv_ << 6) | ln_;
    const int tid = tid_, w = __builtin_amdgcn_readfirstlane(tid >> 6), lane = tid & 63;
    LAS unsigned char* urow_l = lds + w * 3072; LAS int* E_l = (LAS int*)(urow_l + 1024); LAS float* W_l = (LAS float*)(urow_l + 1536); LAS float* SU_l = (LAS float*)(urow_l + 2048); LAS float* SV_l = (LAS float*)(urow_l + 2560);
#define PEER_SB __builtin_amdgcn_sched_barrier(0)
#define PEER_ISSUE_U(buf, gi, hf) do { const int e_ = E_l[(gi) * 16 + n]; const unsigned char* ur_ = U8 + (size_t)e_ * 1024 + 16 * q + 512 * (hf); _Pragma("unroll") for (int k2 = 0; k2 < 8; ++k2) buf[k2] = *(const u32x4*)(ur_ + 64 * k2); } while (0)
#define PEER_ISSUE_V(buf, gi) do { _Pragma("unroll") for (int n2 = 0; n2 < 8; ++n2) { const int e_ = E_l[(gi) * 16 + 2 * n2 + hh]; buf[n2] = *(const u32x4*)(V4 + (size_t)e_ * 512 + 16 * r32); } } while (0)
#define PEER_COMP_U(buf, hf) do { _Pragma("unroll") for (int k2 = 0; k2 < 8; ++k2) { const u32x4 bw = buf[k2]; const u32x4 aw = *(const LAS u32x4*)(urow_l + 512 * (hf) + 64 * k2 + 16 * q); \
            const long a0 = (long)(((unsigned long long)aw.y << 32) | aw.x), a1 = (long)(((unsigned long long)aw.w << 32) | aw.z); \
            const long b0 = (long)(((unsigned long long)bw.y << 32) | bw.x), b1 = (long)(((unsigned long long)bw.w << 32) | bw.z); \
            acc = __builtin_amdgcn_mfma_f32_16x16x32_fp8_fp8(a0, b0, acc, 0, 0, 0); acc = __builtin_amdgcn_mfma_f32_16x16x32_fp8_fp8(a1, b1, acc, 0, 0, 0); } } while (0)
#define PEER_UNPK(wd, base) do { const f32x2 p0_ = __builtin_amdgcn_cvt_scalef32_pk_f32_fp4((wd), 1.0f, 0), p1_ = __builtin_amdgcn_cvt_scalef32_pk_f32_fp4((wd), 1.0f, 1), p2_ = __builtin_amdgcn_cvt_scalef32_pk_f32_fp4((wd), 1.0f, 2), p3_ = __builtin_amdgcn_cvt_scalef32_pk_f32_fp4((wd), 1.0f, 3); \
            o[base + 0] += wt * p0_[0]; o[base + 1] += wt * p0_[1]; o[base + 2] += wt * p1_[0]; o[base + 3] += wt * p1_[1]; o[base + 4] += wt * p2_[0]; o[base + 5] += wt * p2_[1]; o[base + 6] += wt * p3_[0]; o[base + 7] += wt * p3_[1]; } while (0)
#define PEER_COMP_V(buf, gi) do { _Pragma("unroll") for (int n2 = 0; n2 < 8; ++n2) { const float wt = W_l[(gi) * 16 + 2 * n2 + hh]; u32x4 v = buf[n2]; \
              \
            asm volatile("" : "+v"(v.x), "+v"(v.y), "+v"(v.z), "+v"(v.w), "+v"(o[0]), "+v"(o[1]), "+v"(o[2]), "+v"(o[3]), "+v"(o[4]), "+v"(o[5]), "+v"(o[6]), "+v"(o[7]), "+v"(o[8]), "+v"(o[9]), "+v"(o[10])); asm volatile("" : "+v"(o[11]), "+v"(o[12]), "+v"(o[13]), "+v"(o[14]), "+v"(o[15]), "+v"(o[16]), "+v"(o[17]), "+v"(o[18]), "+v"(o[19]), "+v"(o[20]), "+v"(o[21])); asm volatile("" : "+v"(o[22]), "+v"(o[23]), "+v"(o[24]), "+v"(o[25]), "+v"(o[26]), "+v"(o[27]), "+v"(o[28]), "+v"(o[29]), "+v"(o[30]), "+v"(o[31])); \
            PEER_UNPK(v.x, 0); PEER_UNPK(v.y, 8); PEER_UNPK(v.z, 16); PEER_UNPK(v.w, 24); } } while (0)
#pragma unroll 1
    for (int tok = cblk * 8 + w; tok < T_; tok += G * 8) {
        int lane_o = lane; asm volatile("" : "+v"(lane_o));
        const int q = lane_o >> 4, n = lane_o & 15, r32 = lane_o & 31, hh = lane_o >> 5; int d0 = 32 * r32 + 16 * hh;
        const float* a = ada_l + (size_t)(tok >> 11) * 6144; float* xr = xio + (size_t)tok * 1024 + d0;
        float stinv;
        {
            const int e0 = eidx[(size_t)tok * 128 + lane_o], e1 = eidx[(size_t)tok * 128 + 64 + lane_o];
            const float g0 = egate[(size_t)tok * 128 + lane_o], g1 = egate[(size_t)tok * 128 + 64 + lane_o];
            float x1[16];
#pragma unroll
            for (int j = 0; j < 16; j += 4) { const float4 v = *(const float4*)(xr + j); x1[j] = v.x; x1[j + 1] = v.y; x1[j + 2] = v.z; x1[j + 3] = v.w; }
            E_l[lane_o] = e0; E_l[64 + lane_o] = e1; W_l[lane_o] = g0; W_l[64 + lane_o] = g1;
            SU_l[lane_o] = sinv[e0]; SU_l[64 + lane_o] = sinv[e1]; SV_l[lane_o] = sinv[16384 + e0]; SV_l[64 + lane_o] = sinv[16384 + e1];
            float u[16]; float um = 0.f;
#pragma unroll
            for (int j = 0; j < 16; j += 4) { const float4 sc = *(const float4*)(a + 4096 + d0 + j), sh = *(const float4*)(a + 3072 + d0 + j);
                u[j] = x1[j] * (1.f + sc.x) + sh.x; u[j + 1] = x1[j + 1] * (1.f + sc.y) + sh.y; u[j + 2] = x1[j + 2] * (1.f + sc.z) + sh.z; u[j + 3] = x1[j + 3] * (1.f + sc.w) + sh.w;
                um = fmaxf(um, fmaxf(fmaxf(fabsf(u[j]), fabsf(u[j + 1])), fmaxf(fabsf(u[j + 2]), fabsf(u[j + 3])))); }
            um = wave_max(um, lane_o); const float st = (um > 0.f) ? 224.f / um : 1.f; stinv = (um > 0.f) ? um * (1.f / 224.f) : 1.f;
            u32x4 pq; pq.x = pk4_fp8(u[0] * st, u[1] * st, u[2] * st, u[3] * st); pq.y = pk4_fp8(u[4] * st, u[5] * st, u[6] * st, u[7] * st);
            pq.z = pk4_fp8(u[8] * st, u[9] * st, u[10] * st, u[11] * st); pq.w = pk4_fp8(u[12] * st, u[13] * st, u[14] * st, u[15] * st);
            *(LAS u32x4*)(urow_l + d0) = pq; }
        asm volatile("s_waitcnt lgkmcnt(0)" ::: "memory");
        u32x4 bufA[8], bufB[8];
        PEER_ISSUE_U(bufA, 0, 0); PEER_SB;
#pragma unroll 1
        for (int gi = 0; gi < 8; ++gi) { f32x4 acc = (f32x4){0.f, 0.f, 0.f, 0.f};
            PEER_ISSUE_U(bufB, gi, 1); PEER_SB; PEER_COMP_U(bufA, 0); PEER_SB;
            if (gi < 7) PEER_ISSUE_U(bufA, gi + 1, 0); else PEER_ISSUE_V(bufA, 0);
            PEER_SB; PEER_COMP_U(bufB, 1);
            const float ds_ = acc[0] * (SU_l[gi * 16 + n] * stinv); const float wv_ = W_l[gi * 16 + n] * 0.5f * ds_ * (1.f + erff(ds_ * 0.70710678118654752f)) * SV_l[gi * 16 + n];
            if (q == 0) W_l[gi * 16 + n] = wv_;
            PEER_SB; }
        asm volatile("s_waitcnt lgkmcnt(0)" ::: "memory");
        float o32[32];
#pragma unroll
        for (int j = 0; j < 32; ++j) o32[j] = 0.f;
        { float (&o)[32] = o32;
#pragma unroll 1
        for (int gi = 0; gi < 8; gi += 2) {
            PEER_ISSUE_V(bufB, gi + 1); PEER_SB; PEER_COMP_V(bufA, gi); PEER_SB;
            if (gi < 6) PEER_ISSUE_V(bufA, gi + 2);
            PEER_SB; PEER_COMP_V(bufB, gi + 1); PEER_SB; } }
        asm volatile("" : "+v"(lane_o)); d0 = 32 * (lane_o & 31) + 16 * (lane_o >> 5); xr = xio + (size_t)tok * 1024 + d0;
        const unsigned hm = 0u - (unsigned)(lane_o >> 5);
        float o[16];
#pragma unroll
        for (int j = 0; j < 16; ++j) { const float lo_ = o32[j], hi_ = o32[16 + j];
            const float keep = __uint_as_float((__float_as_uint(lo_) & ~hm) | (__float_as_uint(hi_) & hm)), send = __uint_as_float((__float_as_uint(hi_) & ~hm) | (__float_as_uint(lo_) & hm));
            o[j] = keep + xor_f(send, 32, lane_o); }
        float hv[16]; float s = 0.f;
#pragma unroll
        for (int j = 0; j < 16; j += 4) { const float4 g2 = *(const float4*)(a + 5120 + d0 + j); const float4 xv = *(const float4*)(xr + j);
            hv[j] = ALPHA_ * xv.x + g2.x * o[j]; hv[j + 1] = ALPHA_ * xv.y + g2.y * o[j + 1]; hv[j + 2] = ALPHA_ * xv.z + g2.z * o[j + 2]; hv[j + 3] = ALPHA_ * xv.w + g2.w * o[j + 3];
            s += (hv[j] + hv[j + 1]) + (hv[j + 2] + hv[j + 3]); }
        const float mu = wave_sum(s, lane_o) * (1.f / 1024.f); float qq = 0.f;
#pragma unroll
        for (int j = 0; j < 16; ++j) { const float dd = hv[j] - mu; qq += dd * dd; }
        const float rstd = rsqrtf(wave_sum(qq, lane_o) * (1.f / 1024.f) + LN_EPS_);
        const float* an = ada_next ? ada_next + (size_t)(tok >> 11) * 6144 : nullptr;
        float y[16];
#pragma unroll
        for (int j = 0; j < 16; j += 4) { const float4 gg = *(const float4*)(g + d0 + j), bb = *(const float4*)(bta + d0 + j);
            y[j] = (hv[j] - mu) * rstd * gg.x + bb.x; y[j + 1] = (hv[j + 1] - mu) * rstd * gg.y + bb.y; y[j + 2] = (hv[j + 2] - mu) * rstd * gg.z + bb.z; y[j + 3] = (hv[j + 3] - mu) * rstd * gg.w + bb.w;
            *(float4*)(xr + j) = make_float4(y[j], y[j + 1], y[j + 2], y[j + 3]); }
        if (an) { float uu[16];
#pragma unroll
            for (int j = 0; j < 16; j += 4) { const float4 sc = *(const float4*)(an + 1024 + d0 + j), sh = *(const float4*)(an + d0 + j);
                uu[j] = y[j] * (1.f + sc.x) + sh.x; uu[j + 1] = y[j + 1] * (1.f + sc.y) + sh.y; uu[j + 2] = y[j + 2] * (1.f + sc.z) + sh.z; uu[j + 3] = y[j + 3] * (1.f + sc.w) + sh.w; }
            u32x4 p0, p1; p0.x = pg8::cvt_pk_bf16(uu[0], uu[1]); p0.y = pg8::cvt_pk_bf16(uu[2], uu[3]); p0.z = pg8::cvt_pk_bf16(uu[4], uu[5]); p0.w = pg8::cvt_pk_bf16(uu[6], uu[7]);
            p1.x = pg8::cvt_pk_bf16(uu[8], uu[9]); p1.y = pg8::cvt_pk_bf16(uu[10], uu[11]); p1.z = pg8::cvt_pk_bf16(uu[12], uu[13]); p1.w = pg8::cvt_pk_bf16(uu[14], uu[15]);
            bf16_t* up = UY + (size_t)tok * UYW_ + d0; *(u32x4*)up = p0; *(u32x4*)(up + 8) = p1; }
        asm volatile("s_waitcnt lgkmcnt(0)" ::: "memory");
    }
#undef PEER_SB
#undef PEER_ISSUE_U
#undef PEER_ISSUE_V
#undef PEER_COMP_U
#undef PEER_COMP_V
#undef PEER_UNPK
    __syncthreads();
}
}

namespace tk {
typedef float f32x16 __attribute__((ext_vector_type(16)));
constexpr int KROW = 272;
DEV unsigned sortable(float v) { const unsigned u = __float_as_uint(v); return u ^ ((unsigned)((int)u >> 31) | 0x80000000u); }
DEV float unsortable(unsigned k) { return __uint_as_float(k ^ ((~(unsigned)((int)k >> 31)) | 0x80000000u)); }
DEV unsigned umax_(unsigned a, unsigned b) { return a > b ? a : b; }
DEV unsigned umin_(unsigned a, unsigned b) { return a < b ? a : b; }
#define CE(x, y) { const unsigned hi_ = umax_(a[x], a[y]), lo_ = umin_(a[x], a[y]); a[x] = hi_; a[y] = lo_; }
DEV void sort16(unsigned (&a)[16]) {
    CE(0, 1); CE(3, 2); CE(4, 5); CE(7, 6); CE(8, 9); CE(11, 10); CE(12, 13); CE(15, 14); CE(0, 2); CE(1, 3); CE(6, 4); CE(7, 5); CE(8, 10); CE(9, 11); CE(14, 12); CE(15, 13); CE(0, 1); CE(2, 3); CE(5, 4); CE(7, 6); CE(8, 9); CE(10, 11); CE(13, 12); CE(15, 14); CE(0, 4); CE(1, 5); CE(2, 6); CE(3, 7); CE(12, 8); CE(13, 9); CE(14, 10); CE(15, 11); CE(0, 2); CE(1, 3); CE(4, 6); CE(5, 7); CE(10, 8); CE(11, 9); CE(14, 12); CE(15, 13); CE(0, 1); CE(2, 3); CE(4, 5); CE(6, 7); CE(9, 8); CE(11, 10); CE(13, 12); CE(15, 14); CE(0, 8); CE(1, 9); CE(2, 10); CE(3, 11); CE(4, 12); CE(5, 13); CE(6, 14); CE(7, 15); CE(0, 4); CE(1, 5); CE(2, 6); CE(3, 7); CE(8, 12); CE(9, 13); CE(10, 14); CE(11, 15); CE(0, 2); CE(1, 3); CE(4, 6); CE(5, 7); CE(8, 10); CE(9, 11); CE(12, 14); CE(13, 15); CE(0, 1); CE(2, 3); CE(4, 5); CE(6, 7); CE(8, 9); CE(10, 11); CE(12, 13); CE(14, 15);
}
DEV void bmerge16(unsigned (&a)[16]) {
    CE(0, 8); CE(1, 9); CE(2, 10); CE(3, 11); CE(4, 12); CE(5, 13); CE(6, 14); CE(7, 15); CE(0, 4); CE(1, 5); CE(2, 6); CE(3, 7); CE(8, 12); CE(9, 13); CE(10, 14); CE(11, 15); CE(0, 2); CE(1, 3); CE(4, 6); CE(5, 7); CE(8, 10); CE(9, 11); CE(12, 14); CE(13, 15); CE(0, 1); CE(2, 3); CE(4, 5); CE(6, 7); CE(8, 9); CE(10, 11); CE(12, 13); CE(14, 15);
}
#undef CE
DEV void top_merge(unsigned (&a)[16], const unsigned (&b)[16]) {
#pragma unroll
    for (int i = 0; i < 16; ++i) a[i] = umax_(a[i], b[15 - i]);
    bmerge16(a);
}
DEV void xlane_merge(unsigned (&a)[16], int lane) {
    unsigned b[16];
#pragma unroll
    for (int i = 0; i < 16; ++i) b[i] = (unsigned)xor_i((int)a[i], 32, lane);
    top_merge(a, b);
}
DEV unsigned lookup_idx(unsigned long long lo, unsigned long long hi, int a) { const unsigned long long wv = (a < 8) ? lo : hi; return (unsigned)(wv >> ((a & 7) * 8)) & 127u; }
DEV unsigned blendu(unsigned m, unsigned a, unsigned b) { return (a & ~m) | (b & m); }
DEV float blendf(unsigned m, float a, float b) { return __uint_as_float((__float_as_uint(a) & ~m) | (__float_as_uint(b) & m)); }

DEV void topk_phase(LAS unsigned char* lds, const bf16_t* __restrict__ Q2, const float* __restrict__ keys_l, int* __restrict__ eidx, float* __restrict__ egate, int G, int cblk, int wv) {
    int wv_ = wv, ln_; asm volatile("v_mbcnt_lo_u32_b32 %1, -1, 0\n\tv_mbcnt_hi_u32_b32 %1, -1, %1" : "+s"(wv_), "=v"(ln_)); int tid_ = (wv_ << 6) | ln_;
    const int tid = tid_, w = __builtin_amdgcn_readfirstlane(tid >> 6), lane = tid & 63, tl = lane & 31, hh = lane >> 5;
    asm volatile("" : "+s"(G));
    const bool by_head = (G & 7) == 0;
#pragma unroll 1
    for (int h = 0; h < 8; ++h) {
        if (by_head && h != (cblk & 7)) continue;
        __syncthreads();
        {
            const int r = tid >> 1, c0 = (tid & 1) * 64; const float* src = keys_l + ((size_t)h * 256 + r) * 128 + c0; LAS unsigned char* dst = lds + r * KROW + c0 * 2;
#pragma unroll
            for (int j = 0; j < 64; j += 8) { const float4 a = *(const float4*)(src + j), b = *(const float4*)(src + j + 4);
                u32x4 o; o.x = pg8::cvt_pk_bf16(a.x, a.y); o.y = pg8::cvt_pk_bf16(a.z, a.w); o.z = pg8::cvt_pk_bf16(b.x, b.y); o.w = pg8::cvt_pk_bf16(b.z, b.w); *(LAS u32x4*)(dst + j * 2) = o; }
        }
        __syncthreads();
        const int first = by_head ? (cblk >> 3) * 8 + w : cblk * 8 + w, stride = by_head ? (G >> 3) * 8 : G * 8;
#pragma unroll 1
        for (int blk = first; blk < T_ / 32; blk += stride) {
            const int tok = blk * 32 + tl; const bf16_t* qrow = Q2 + (size_t)tok * 2048 + h * 256 + 8 * hh;
            unsigned L[2][16];
#pragma unroll
            for (int p = 0; p < 2; ++p) {
                bf16x8 bq[8];
#pragma unroll
                for (int ks = 0; ks < 8; ++ks) bq[ks] = *(const bf16x8*)(qrow + p * 128 + 16 * ks);
#pragma unroll
                for (int t = 0; t < 4; ++t) {
                    f32x16 acc;
#pragma unroll
                    for (int e = 0; e < 16; ++e) acc[e] = 0.f;
#pragma unroll
                    for (int ks = 0; ks < 8; ++ks) { const bf16x8 ak = *(const LAS bf16x8*)(lds + (p * 128 + 32 * t + tl) * KROW + (16 * ks + 8 * hh) * 2);
                        acc = __builtin_amdgcn_mfma_f32_32x32x16_bf16(ak, bq[ks], acc, 0, 0, 0); }
                    unsigned K[16];
#pragma unroll
                    for (int e = 0; e < 16; ++e) K[e] = (sortable(acc[e]) & ~127u) | (unsigned)((127 - 32 * t - (e & 3) - 8 * (e >> 2)) - 4 * hh);
                    sort16(K);
                    if (t == 0) {
#pragma unroll
                        for (int e = 0; e < 16; ++e) L[p][e] = K[e];
                    } else top_merge(L[p], K);
                    __builtin_amdgcn_sched_barrier(0);
                }
                xlane_merge(L[p], lane);
                __builtin_amdgcn_sched_barrier(0);
            }
            float f1[16], f2[16];
#pragma unroll
            for (int e = 0; e < 16; ++e) { f1[e] = unsortable(L[0][e] & ~127u); f2[e] = unsortable(L[1][e] & ~127u); }
            unsigned hm = 0u - (unsigned)hh; asm volatile("" : "+v"(hm));
            unsigned C[2][16];
            C[0][0] = (sortable(blendf(hm, f1[0], f1[2]) + blendf(hm, f2[0], f2[1])) & ~255u) | (255u - blendu(hm, 0u, 33u));
            C[0][1] = (sortable(blendf(hm, f1[0], f1[2]) + blendf(hm, f2[1], f2[2])) & ~255u) | (255u - blendu(hm, 1u, 34u));
            C[0][2] = (sortable(blendf(hm, f1[0], f1[2]) + blendf(hm, f2[2], f2[3])) & ~255u) | (255u - blendu(hm, 2u, 35u));
            C[0][3] = (sortable(blendf(hm, f1[0], f1[2]) + blendf(hm, f2[3], f2[4])) & ~255u) | (255u - blendu(hm, 3u, 36u));
            C[0][4] = (sortable(blendf(hm, f1[0], f1[3]) + blendf(hm, f2[4], f2[0])) & ~255u) | (255u - blendu(hm, 4u, 48u));
            C[0][5] = (sortable(blendf(hm, f1[0], f1[3]) + blendf(hm, f2[5], f2[1])) & ~255u) | (255u - blendu(hm, 5u, 49u));
            C[0][6] = (sortable(blendf(hm, f1[0], f1[3]) + blendf(hm, f2[6], f2[2])) & ~255u) | (255u - blendu(hm, 6u, 50u));
            C[0][7] = (sortable(blendf(hm, f1[0], f1[3]) + blendf(hm, f2[7], f2[3])) & ~255u) | (255u - blendu(hm, 7u, 51u));
            C[0][8] = (sortable(blendf(hm, f1[0], f1[4]) + blendf(hm, f2[8], f2[0])) & ~255u) | (255u - blendu(hm, 8u, 64u));
            C[0][9] = (sortable(blendf(hm, f1[0], f1[4]) + blendf(hm, f2[9], f2[1])) & ~255u) | (255u - blendu(hm, 9u, 65u));
            C[0][10] = (sortable(blendf(hm, f1[0], f1[4]) + blendf(hm, f2[10], f2[2])) & ~255u) | (255u - blendu(hm, 10u, 66u));
            C[0][11] = (sortable(blendf(hm, f1[0], f1[5]) + blendf(hm, f2[11], f2[0])) & ~255u) | (255u - blendu(hm, 11u, 80u));
            C[0][12] = (sortable(blendf(hm, f1[0], f1[5]) + blendf(hm, f2[12], f2[1])) & ~255u) | (255u - blendu(hm, 12u, 81u));
            C[0][13] = (sortable(blendf(hm, f1[0], f1[6]) + blendf(hm, f2[13], f2[0])) & ~255u) | (255u - blendu(hm, 13u, 96u));
            C[0][14] = (sortable(blendf(hm, f1[0], f1[6]) + blendf(hm, f2[14], f2[1])) & ~255u) | (255u - blendu(hm, 14u, 97u));
            C[0][15] = (sortable(blendf(hm, f1[0], f1[7]) + blendf(hm, f2[15], f2[0])) & ~255u) | (255u - blendu(hm, 15u, 112u));
            C[1][0] = (sortable(blendf(hm, f1[1], f1[7]) + blendf(hm, f2[0], f2[1])) & ~255u) | (255u - blendu(hm, 16u, 113u));
            C[1][1] = (sortable(blendf(hm, f1[1], f1[8]) + blendf(hm, f2[1], f2[0])) & ~255u) | (255u - blendu(hm, 17u, 128u));
            C[1][2] = (sortable(blendf(hm, f1[1], f1[9]) + blendf(hm, f2[2], f2[0])) & ~255u) | (255u - blendu(hm, 18u, 144u));
            C[1][3] = (sortable(blendf(hm, f1[1], f1[10]) + blendf(hm, f2[3], f2[0])) & ~255u) | (255u - blendu(hm, 19u, 160u));
            C[1][4] = (sortable(blendf(hm, f1[1], f1[11]) + blendf(hm, f2[4], f2[0])) & ~255u) | (255u - blendu(hm, 20u, 176u));
            C[1][5] = (sortable(blendf(hm, f1[1], f1[12]) + blendf(hm, f2[5], f2[0])) & ~255u) | (255u - blendu(hm, 21u, 192u));
            C[1][6] = (sortable(blendf(hm, f1[1], f1[13]) + blendf(hm, f2[6], f2[0])) & ~255u) | (255u - blendu(hm, 22u, 208u));
            C[1][7] = (sortable(blendf(hm, f1[1], f1[14]) + blendf(hm, f2[7], f2[0])) & ~255u) | (255u - blendu(hm, 23u, 224u));
            C[1][8] = (sortable(blendf(hm, f1[2], f1[15]) + blendf(hm, f2[0], f2[0])) & ~255u) | (255u - blendu(hm, 32u, 240u));
            C[1][9] = 0u;
            C[1][10] = 0u;
            C[1][11] = 0u;
            C[1][12] = 0u;
            C[1][13] = 0u;
            C[1][14] = 0u;
            C[1][15] = 0u;
            sort16(C[0]); sort16(C[1]); top_merge(C[0], C[1]); xlane_merge(C[0], lane);
            unsigned long long p1lo = 0ull, p1hi = 0ull, p2lo = 0ull, p2hi = 0ull;
#pragma unroll
            for (int m = 0; m < 8; ++m) { p1lo |= (unsigned long long)(127u - (L[0][m] & 127u)) << (8 * m); p1hi |= (unsigned long long)(127u - (L[0][8 + m] & 127u)) << (8 * m);
                p2lo |= (unsigned long long)(127u - (L[1][m] & 127u)) << (8 * m); p2hi |= (unsigned long long)(127u - (L[1][8 + m] & 127u)) << (8 * m); }
            float val[16]; unsigned ex[16]; float sum = 0.f;
#pragma unroll
            for (int k = 0; k < 16; ++k) { const unsigned flat = 255u - (C[0][k] & 255u); const int a = (int)(flat >> 4), b = (int)(flat & 15u);
                val[k] = unsortable(C[0][k] & ~255u); ex[k] = lookup_idx(p1lo, p1hi, a) * 128u + lookup_idx(p2lo, p2hi, b); }
            const float mx = val[0];
#pragma unroll
            for (int k = 0; k < 16; ++k) { val[k] = __expf(val[k] - mx); sum += val[k]; }
            const float inv = 1.f / sum;
            int eo[8]; float go[8];
#pragma unroll
            for (int k = 0; k < 8; ++k) { eo[k] = (int)blendu(hm, ex[k], ex[8 + k]); go[k] = blendf(hm, val[k], val[8 + k]) * inv; }
            const size_t ob = ((size_t)tok * 8 + h) * 16 + 8 * hh;
            *(int4*)(eidx + ob) = make_int4(eo[0], eo[1], eo[2], eo[3]); *(int4*)(eidx + ob + 4) = make_int4(eo[4], eo[5], eo[6], eo[7]);
            *(float4*)(egate + ob) = make_float4(go[0], go[1], go[2], go[3]); *(float4*)(egate + ob + 4) = make_float4(go[4], go[5], go[6], go[7]);
        }
    }
    __syncthreads();
}
}

namespace at {
typedef float f32x16 __attribute__((ext_vector_type(16)));
constexpr int KROWB = 144, VROWB = 776, K_OFF = 0, V_OFF = 384 * KROWB, LDS_END = V_OFF + 64 * VROWB;
constexpr int N_ITEMS_A = 16 * 12 * 8, N_ITEMS_C = 16 * 2 * 16 * 2;

struct Band { int p_w, ls, R, slot_base; };
DEV void chunk(LAS const unsigned char* lds, const Band& bd, int c, const bf16x8 (&qf)[4], int tl, int hh, f32x16 (&O)[2], float& m, float& l) {
    const int kp0 = bd.p_w - bd.R + 32 * c;
    if (kp0 + 31 < 0 || kp0 >= bd.ls) return;
    const int s0 = kp0 + bd.slot_base;
    f32x16 S;
#pragma unroll
    for (int e = 0; e < 16; ++e) S[e] = 0.f;
#pragma unroll
    for (int ks = 0; ks < 4; ++ks) { const bf16x8 ak = *(const LAS bf16x8*)(lds + K_OFF + (s0 + tl) * KROWB + (16 * ks + 8 * hh) * 2); S = __builtin_amdgcn_mfma_f32_32x32x16_bf16(ak, qf[ks], S, 0, 0, 0); }
    const int dbase = (32 * c - bd.R) - tl + 4 * hh;
    const int kb = kp0 + 4 * hh;
    float cmax = -1e30f;
#pragma unroll
    for (int e = 0; e < 16; ++e) { const int ro = (e & 3) + 8 * (e >> 2); const int diff = dbase + ro, kp = kb + ro;
        const bool ok = (diff <= bd.R) && (diff >= -bd.R) && (kp >= 0) && (kp < bd.ls); S[e] = ok ? S[e] : -1e30f; cmax = fmaxf(cmax, S[e]); }
    cmax = fmaxf(cmax, xor_f(cmax, 32, tl + 32 * hh));
    const float mn = fmaxf(m, cmax), alpha = exp2f(m - mn); m = mn;
    float psum = 0.f;
#pragma unroll
    for (int e = 0; e < 16; ++e) { S[e] = exp2f(S[e] - mn); psum += S[e]; }
    l = l * alpha + psum;
#pragma unroll
    for (int e = 0; e < 16; ++e) { O[0][e] *= alpha; O[1][e] *= alpha; }
#pragma unroll
    for (int sx = 0; sx < 2; ++sx) {
        u32x4 pw; pw.x = pg8::cvt_pk_bf16(S[8 * sx + 0], S[8 * sx + 1]); pw.y = pg8::cvt_pk_bf16(S[8 * sx + 2], S[8 * sx + 3]); pw.z = pg8::cvt_pk_bf16(S[8 * sx + 4], S[8 * sx + 5]); pw.w = pg8::cvt_pk_bf16(S[8 * sx + 6], S[8 * sx + 7]);
        const bf16x8 pb = __builtin_bit_cast(bf16x8, pw);
#pragma unroll
        for (int dt = 0; dt < 2; ++dt) { LAS const unsigned char* vp = lds + V_OFF + (32 * dt + tl) * VROWB + (s0 + 16 * sx + 4 * hh) * 2;
            const u32x2 lo = *(const LAS u32x2*)vp, hi = *(const LAS u32x2*)(vp + 16); const u32x4 vw = (u32x4){lo.x, lo.y, hi.x, hi.y};
            O[dt] = __builtin_amdgcn_mfma_f32_32x32x16_bf16(__builtin_bit_cast(bf16x8, vw), pb, O[dt], 0, 0, 0); }
    }
}
DEV void attn_phase(LAS unsigned char* lds, bf16_t* P, float* lse2, bf16_t* Y, const float* sink_l, int G, int cblk, int wv) {
    int wv_ = wv, ln_; asm volatile("v_mbcnt_lo_u32_b32 %1, -1, 0\n\tv_mbcnt_hi_u32_b32 %1, -1, %1" : "+s"(wv_), "=v"(ln_)); int tid_ = (wv_ << 6) | ln_;
    const int tid = tid_, w = __builtin_amdgcn_readfirstlane(tid >> 6), lane = tid & 63, tl = lane & 31, hh = lane >> 5;
#pragma unroll 1
    for (int item = cblk; item < N_ITEMS_A + N_ITEMS_C; item += G) {
        int b, dil, ls, r, klo, nsl, R, kcol, vcol, qcol, two = 0, rp = 0, sb = 0, head = 0, isC = 0, nb = 0, qh0 = 0;
        if (item < N_ITEMS_A) { b = item / 96; const int rem = item - b * 96; head = rem >> 3; const int sub = rem & 7, g = head >> 2; R = 64;
            kcol = 768 + head * 64; vcol = 1536 + head * 64; qcol = head * 64;
            if (g == 0) { dil = 1; ls = 2048; r = 0; sb = sub; klo = 256 * sb - 64; nsl = 384; }
            else if (g == 1) { dil = 4; ls = 512; r = sub >> 1; sb = sub & 1; klo = 256 * sb - 64; nsl = 384; }
            else { dil = 16; ls = 128; r = 0; rp = sub; klo = 0; nsl = 256; two = 1; } }
        else { const int it = item - N_ITEMS_A; b = it >> 6; const int rem = it & 63; const int kvh = rem >> 5; nb = (rem & 31) >> 1; const int hp = rem & 1; isC = 1; R = 128;
            dil = 1; ls = 2048; r = 0; klo = 128 * nb - 128; nsl = 384; kcol = 2816 + kvh * 64; vcol = 2944 + kvh * 64; qh0 = kvh * 4 + hp * 2; qcol = 2304 + qh0 * 64; }
        __syncthreads();
        for (int i = tid; i < nsl * 8; i += 512) { const int slot = i >> 3, part = i & 7; int kpos, rr;
            if (two) { kpos = slot & 127; rr = 2 * rp + (slot >> 7); } else { kpos = klo + slot; rr = r; }
            u32x4 kv = (u32x4){0u, 0u, 0u, 0u}, vv = kv;
            if (kpos >= 0 && kpos < ls) { const bf16_t* rowp = P + (size_t)(b * 2048 + kpos * dil + rr) * PW_; kv = *(const u32x4*)(rowp + kcol + part * 8); vv = *(const u32x4*)(rowp + vcol + part * 8); }
            *(LAS u32x4*)(lds + K_OFF + slot * KROWB + part * 16) = kv;
            LAS unsigned short* vt = (LAS unsigned short*)(lds + V_OFF + (part * 8) * VROWB + slot * 2);
            vt[0 * (VROWB / 2)] = (unsigned short)(vv.x & 0xffffu); vt[1 * (VROWB / 2)] = (unsigned short)(vv.x >> 16); vt[2 * (VROWB / 2)] = (unsigned short)(vv.y & 0xffffu); vt[3 * (VROWB / 2)] = (unsigned short)(vv.y >> 16);
            vt[4 * (VROWB / 2)] = (unsigned short)(vv.z & 0xffffu); vt[5 * (VROWB / 2)] = (unsigned short)(vv.z >> 16); vt[6 * (VROWB / 2)] = (unsigned short)(vv.w & 0xffffu); vt[7 * (VROWB / 2)] = (unsigned short)(vv.w >> 16); }
        __syncthreads();
        Band bd; int qtok, rr = r; bd.ls = ls; bd.R = R;
        if (two) { const int half = w >> 2; bd.p_w = 32 * (w & 3); rr = 2 * rp + half; bd.slot_base = half * 128; }
        else if (isC) { bd.p_w = 128 * nb + 32 * (w & 3); bd.slot_base = -klo; }
        else { bd.p_w = 256 * sb + 32 * w; bd.slot_base = -klo; }
        qtok = b * 2048 + (bd.p_w + tl) * dil + rr;
        const int qc = isC ? (qcol + (w >> 2) * 64) : qcol;
        const bf16_t* qp = P + (size_t)qtok * PW_ + qc + 8 * hh;
        bf16x8 qf[4];
#pragma unroll
        for (int ks = 0; ks < 4; ++ks) qf[ks] = *(const bf16x8*)(qp + 16 * ks);
        f32x16 O[2];
#pragma unroll
        for (int e = 0; e < 16; ++e) { O[0][e] = 0.f; O[1][e] = 0.f; }
        float m = -1e30f, l = 0.f;
        const int nch = R / 16 + 1, cd = R / 32;
        chunk(lds, bd, cd, qf, tl, hh, O, m, l);
#pragma unroll 1
        for (int c = 0; c < nch; ++c) { if (c != cd) chunk(lds, bd, c, qf, tl, hh, O, m, l); }
        float lt = l + xor_f(l, 32, lane), scale;
        if (isC) { const float sk = sink_l[qh0 + (w >> 2)] * LOG2E_; const float mf = fmaxf(m, sk), corr = exp2f(m - mf); lt = lt * corr + exp2f(sk - mf); scale = corr / lt; }
        else { scale = 1.f / lt; if (hh == 0) lse2[(size_t)qtok * 12 + head] = m + log2f(lt); }
        bf16_t* op = isC ? (Y + (size_t)qtok * UYW_ + 768 + (qh0 + (w >> 2)) * 64) : (P + (size_t)qtok * PW_ + qcol);
#pragma unroll
        for (int dt = 0; dt < 2; ++dt)
#pragma unroll
            for (int g4 = 0; g4 < 4; ++g4) { u32x2 pk; pk.x = pg8::cvt_pk_bf16(O[dt][4 * g4] * scale, O[dt][4 * g4 + 1] * scale); pk.y = pg8::cvt_pk_bf16(O[dt][4 * g4 + 2] * scale, O[dt][4 * g4 + 3] * scale);
                *(u32x2*)(op + 32 * dt + 8 * g4 + 4 * hh) = pk; }
    }
    __syncthreads();
}
}

namespace xb {
constexpr int XB_TMO = 128, XB_TOP = 3328, XB_TOPGEN = 3392, XCD_BAR_WORDS = 3456; constexpr unsigned XB_SPIN_CAP = 1u << 22;
DEV constexpr int XB_XCNT(int j) { return 256 + 64 * j; }
DEV constexpr int XB_XSUB(int j) { return 1280 + 64 * j; }
DEV constexpr int XB_XGEN(int j) { return 2304 + 64 * j; }
DEV unsigned xb_ld(unsigned* p) { return __hip_atomic_load(p, __ATOMIC_RELAXED, __HIP_MEMORY_SCOPE_AGENT); }
DEV unsigned xb_add(unsigned* p, unsigned v) { return __hip_atomic_fetch_add(p, v, __ATOMIC_RELAXED, __HIP_MEMORY_SCOPE_AGENT); }
DEV unsigned xb_xcc_id() { return (unsigned)__builtin_amdgcn_s_getreg((3 << 11) | 20) & 0xFu; }
#define XB_SPIN(cond, bar) do { unsigned _sp = 0; while (cond) { __builtin_amdgcn_s_sleep(1); \
    if ((++_sp & 255u) == 0u) { if (xb_ld(&(bar)[XB_TMO])) break; if (_sp > XB_SPIN_CAP) { atomicAdd(&(bar)[XB_TMO], 1u); break; } } } } while (0)
struct XcdBarrier { unsigned* bar; unsigned x; volatile LAS unsigned* st; };
DEV XcdBarrier xcd_barrier_post(unsigned* bar, volatile LAS unsigned* st) { XcdBarrier b; b.bar = bar; b.x = xb_xcc_id(); b.st = st; if (threadIdx.x == 0) (void)xb_add(&bar[XB_XCNT(b.x)], 1u); return b; }
DEV void xcd_barrier_complete(unsigned* bar, unsigned x, unsigned& nloc, unsigned& nx) {
    const unsigned G = gridDim.x * gridDim.y * gridDim.z; unsigned sum, cnt, mine, sp = 0u;
    for (;;) { sum = 0u; cnt = 0u; mine = 0u;
#pragma unroll
        for (unsigned j = 0; j < 16; ++j) { const unsigned c = xb_ld(&bar[XB_XCNT(j)]); sum += c; cnt += (c > 0u) ? 1u : 0u; mine = (j == x) ? c : mine; }
        if (sum == G) break;
        __builtin_amdgcn_s_sleep(1);
        if ((++sp & 255u) == 0u) { if (xb_ld(&bar[XB_TMO])) break; if (sp > XB_SPIN_CAP) { atomicAdd(&bar[XB_TMO], 1u); break; } } }
    nloc = mine > 0u ? mine : 1u; nx = cnt > 0u ? cnt : 1u;
}
DEV void xcd_barrier(const XcdBarrier& b, int wv) {
    asm volatile("s_waitcnt vmcnt(0)" ::: "memory");
    __syncthreads();
    int ln0_; asm volatile("v_mbcnt_lo_u32_b32 %0, -1, 0\n\tv_mbcnt_hi_u32_b32 %0, -1, %0" : "=v"(ln0_));
    if (wv == 0 && ln0_ == 0) {
        unsigned* bar = b.bar; asm volatile("" : "+s"(bar));
        unsigned bx = xb_xcc_id(); asm volatile("" : "+s"(bx));
        __builtin_amdgcn_s_waitcnt(0);
        unsigned nloc = b.st[0], nx = b.st[1];
        if (nloc == 0u) { xcd_barrier_complete(bar, bx, nloc, nx); b.st[0] = nloc; b.st[1] = nx; }
        const unsigned old = xb_add(&bar[XB_XSUB(bx)], 1u); const unsigned gen = old / nloc;
        if (old + 1u == (gen + 1u) * nloc) {
            __builtin_amdgcn_fence(__ATOMIC_RELEASE, "agent");
            asm volatile("s_waitcnt vmcnt(0)" ::: "memory");
            const unsigned og = xb_add(&bar[XB_TOP], 1u); const unsigned tg = og / nx;
            if (og + 1u == (tg + 1u) * nx) xb_add(&bar[XB_TOPGEN], 1u);
            else XB_SPIN(xb_ld(&bar[XB_TOPGEN]) == tg, bar);
            __builtin_amdgcn_fence(__ATOMIC_ACQUIRE, "agent");
            xb_add(&bar[XB_XGEN(bx)], 1u);
            asm volatile("s_waitcnt vmcnt(0)" ::: "memory");
        } else {
            XB_SPIN(xb_ld(&bar[XB_XGEN(bx)]) == gen, bar);
            __builtin_amdgcn_fence(__ATOMIC_ACQUIRE, "agent");
            asm volatile("s_waitcnt vmcnt(0)" ::: "memory");
        }
    }
    __syncthreads();
}
}

namespace misc {
DEV void ada_phase(LAS unsigned char* lds, const float* __restrict__ c, const float* __restrict__ w_ada, const float* __restrict__ b_ada, float* __restrict__ ada, int G, int cblk, int wv) {
    int wv_ = wv, ln_; asm volatile("v_mbcnt_lo_u32_b32 %1, -1, 0\n\tv_mbcnt_hi_u32_b32 %1, -1, %1" : "+s"(wv_), "=v"(ln_)); int tid_ = (wv_ << 6) | ln_; const int tid = tid_, col = tid & 63, kg = tid >> 6;
    LAS float* cond = (LAS float*)lds;
    LAS float* part = (LAS float*)(lds + 65536);
    for (int i = tid; i < 16384; i += 512) { const float v = c[i]; cond[i] = v / (1.f + __expf(-v)); }
    __syncthreads();
#pragma unroll 1
    for (int item = cblk; item < 192; item += G) { const int l = item / 96, n0 = (item - l * 96) * 64;
        float acc[16];
#pragma unroll
        for (int b = 0; b < 16; ++b) acc[b] = 0.f;
        const float* wp = w_ada + ((size_t)l * 1024 + kg * 128) * 6144 + n0 + col;
#pragma unroll 4
        for (int kk = 0; kk < 128; ++kk) { const float wv = wp[(size_t)kk * 6144];
#pragma unroll
            for (int b = 0; b < 16; ++b) acc[b] += cond[b * 1024 + kg * 128 + kk] * wv; }
#pragma unroll
        for (int b = 0; b < 16; ++b) part[(kg * 16 + b) * 64 + col] = acc[b];
        __syncthreads();
        for (int o = tid; o < 1024; o += 512) { const int b = o >> 6, cc = o & 63; float sacc = b_ada[l * 6144 + n0 + cc];
#pragma unroll
            for (int g8 = 0; g8 < 8; ++g8) sacc += part[(g8 * 16 + b) * 64 + cc];
            ada[((size_t)l * 16 + b) * 6144 + n0 + cc] = sacc; }
        __syncthreads();
    }
}
DEV void ln_phase(float* xio, const float* __restrict__ g, const float* __restrict__ bta, const float* ada_l, bf16_t* UY, int G, int cblk, int wv) {
    int wv_ = wv, ln_; asm volatile("v_mbcnt_lo_u32_b32 %1, -1, 0\n\tv_mbcnt_hi_u32_b32 %1, -1, %1" : "+s"(wv_), "=v"(ln_)); int tid_ = (wv_ << 6) | ln_; const int tid = tid_, w = __builtin_amdgcn_readfirstlane(tid >> 6), lane = tid & 63; const int d0 = 16 * lane;
#pragma unroll 1
    for (int tok = cblk * 8 + w; tok < T_; tok += G * 8) { const float* a = ada_l + (size_t)(tok >> 11) * 6144; float* xr = xio + (size_t)tok * 1024 + d0;
        float hv[16]; float s = 0.f;
#pragma unroll
        for (int j = 0; j < 16; j += 4) { const float4 v = *(const float4*)(xr + j); hv[j] = v.x; hv[j + 1] = v.y; hv[j + 2] = v.z; hv[j + 3] = v.w; s += (v.x + v.y) + (v.z + v.w); }
        const float mu = peer::wave_sum(s, lane) * (1.f / 1024.f); float qq = 0.f;
#pragma unroll
        for (int j = 0; j < 16; ++j) { const float dd = hv[j] - mu; qq += dd * dd; }
        const float rstd = rsqrtf(peer::wave_sum(qq, lane) * (1.f / 1024.f) + LN_EPS_);
        float uu[16];
#pragma unroll
        for (int j = 0; j < 16; j += 4) { const float4 gg = *(const float4*)(g + d0 + j), bb = *(const float4*)(bta + d0 + j), sc = *(const float4*)(a + 4096 + d0 + j), sh = *(const float4*)(a + 3072 + d0 + j);
            const float y0 = (hv[j] - mu) * rstd * gg.x + bb.x, y1 = (hv[j + 1] - mu) * rstd * gg.y + bb.y, y2 = (hv[j + 2] - mu) * rstd * gg.z + bb.z, y3 = (hv[j + 3] - mu) * rstd * gg.w + bb.w;
            *(float4*)(xr + j) = make_float4(y0, y1, y2, y3);
            uu[j] = y0 * (1.f + sc.x) + sh.x; uu[j + 1] = y1 * (1.f + sc.y) + sh.y; uu[j + 2] = y2 * (1.f + sc.z) + sh.z; uu[j + 3] = y3 * (1.f + sc.w) + sh.w; }
        u32x4 p0, p1; p0.x = pg8::cvt_pk_bf16(uu[0], uu[1]); p0.y = pg8::cvt_pk_bf16(uu[2], uu[3]); p0.z = pg8::cvt_pk_bf16(uu[4], uu[5]); p0.w = pg8::cvt_pk_bf16(uu[6], uu[7]);
        p1.x = pg8::cvt_pk_bf16(uu[8], uu[9]); p1.y = pg8::cvt_pk_bf16(uu[10], uu[11]); p1.z = pg8::cvt_pk_bf16(uu[12], uu[13]); p1.w = pg8::cvt_pk_bf16(uu[14], uu[15]);
        bf16_t* up = UY + (size_t)tok * UYW_ + d0; *(u32x4*)up = p0; *(u32x4*)(up + 8) = p1; }
}
DEV void yprep_phase(LAS unsigned char* lds, const bf16_t* __restrict__ hyT, const bf16_t* P, const float* __restrict__ lse2, bf16_t* Y, int G, int cblk, int wv) {
    int wv_ = wv, ln_; asm volatile("v_mbcnt_lo_u32_b32 %1, -1, 0\n\tv_mbcnt_hi_u32_b32 %1, -1, %1" : "+s"(wv_), "=v"(ln_)); int tid_ = (wv_ << 6) | ln_; const int tid = tid_;
    LAS unsigned short* tile = (LAS unsigned short*)lds;
#pragma unroll 1
    for (int it = cblk; it < 4096; it += G) { const int t0 = (it >> 3) * 64, c0 = (it & 7) * 64;
        __syncthreads();
        { const int cc = tid >> 3, seg = (tid & 7) * 8; const u32x4 v = *(const u32x4*)(hyT + (size_t)(c0 + cc) * T_ + t0 + seg); *(LAS u32x4*)(tile + cc * 72 + seg) = v; }
        __syncthreads();
        { const int tt = tid >> 3, seg = (tid & 7) * 8; unsigned wv[4];
#pragma unroll
            for (int e = 0; e < 4; ++e) wv[e] = (unsigned)tile[(seg + 2 * e) * 72 + tt] | ((unsigned)tile[(seg + 2 * e + 1) * 72 + tt] << 16);
            *(u32x4*)(Y + (size_t)(t0 + tt) * UYW_ + 256 + c0 + seg) = (u32x4){wv[0], wv[1], wv[2], wv[3]}; }
    }
#pragma unroll 1
    for (size_t idx = (size_t)cblk * 512 + tid; idx < (size_t)T_ * 32; idx += (size_t)G * 512) { const size_t tok = idx >> 5; const int c8 = (int)(idx & 31) * 8, hh = c8 >> 6;
        const float l0 = lse2[tok * 12 + hh], l1 = lse2[tok * 12 + 4 + hh], l2 = lse2[tok * 12 + 8 + hh]; const float mx = fmaxf(l0, fmaxf(l1, l2));
        float w0 = exp2f(l0 - mx), w1 = exp2f(l1 - mx), w2 = exp2f(l2 - mx); const float inv = 1.f / (w0 + w1 + w2); w0 *= inv; w1 *= inv; w2 *= inv;
        const bf16_t* pr = P + tok * PW_ + c8; const u32x4 a = *(const u32x4*)pr, b = *(const u32x4*)(pr + 256), c = *(const u32x4*)(pr + 512);
        const unsigned aw[4] = {a.x, a.y, a.z, a.w}, bw[4] = {b.x, b.y, b.z, b.w}, cw[4] = {c.x, c.y, c.z, c.w}; unsigned o[4];
#pragma unroll
        for (int e = 0; e < 4; ++e) { const float lo = w0 * __uint_as_float(aw[e] << 16) + w1 * __uint_as_float(bw[e] << 16) + w2 * __uint_as_float(cw[e] << 16);
            const float hi = w0 * __uint_as_float(aw[e] & 0xffff0000u) + w1 * __uint_as_float(bw[e] & 0xffff0000u) + w2 * __uint_as_float(cw[e] & 0xffff0000u); o[e] = pg8::cvt_pk_bf16(lo, hi); }
        *(u32x4*)(Y + tok * UYW_ + c8) = (u32x4){o[0], o[1], o[2], o[3]}; }
    __syncthreads();
}
DEV void filt_phase(LAS unsigned char* lds, const float* __restrict__ h2, const float* __restrict__ w3, const float* __restrict__ log_decay, bf16_t* __restrict__ Gr, int G, int cblk, int wv) {
    int wv_ = wv, ln_; asm volatile("v_mbcnt_lo_u32_b32 %1, -1, 0\n\tv_mbcnt_hi_u32_b32 %1, -1, %1" : "+s"(wv_), "=v"(ln_)); const int tid = (wv_ << 6) | ln_, lane = ln_;
    LAS float* hrow = (LAS float*)lds;
    LAS float* w3s = (LAS float*)(lds + 512 * 68 * 4);
    LAS float* dec = w3s + 1024;
    LAS float* red = dec + 16;
#pragma unroll 1
    for (int item = cblk; item < 256; item += G) { const int l = item >> 7, o = (item >> 6) & 1, cg = item & 63; const int colf0 = o * 512 + cg * 8;
        __syncthreads();
        for (int i = tid; i < 1024; i += 512) { const int jj = i >> 4, c16 = i & 15; const int col = (c16 < 8) ? colf0 + c16 : 1024 + colf0 + (c16 - 8); w3s[i] = w3[((size_t)l * 64 + jj) * 2048 + col]; }
        if (tid < 16) { const int col = (tid < 8) ? colf0 + tid : 1024 + colf0 + (tid - 8); dec[tid] = __expf(log_decay[l * 2048 + col]); }
        float vals[4][16];
#pragma unroll
        for (int ch = 0; ch < 4; ++ch) {
            __syncthreads();
            { const float* src = h2 + ((size_t)l * 2048 + ch * 512) * 64;
#pragma unroll 4
                for (int k = 0; k < 16; ++k) { const int idx = tid + 512 * k; const int row = idx >> 4, c4 = idx & 15; *(LAS f32x4*)(hrow + row * 68 + c4 * 4) = *(const f32x4*)(src + (size_t)idx * 4); } }
            __syncthreads();
            float acc[16];
#pragma unroll
            for (int c = 0; c < 16; ++c) acc[c] = 0.f;
#pragma unroll 2
            for (int j4 = 0; j4 < 16; ++j4) { const f32x4 hv = *(const LAS f32x4*)(hrow + tid * 68 + j4 * 4); const float hh4[4] = {hv.x, hv.y, hv.z, hv.w};
#pragma unroll
                for (int e = 0; e < 4; ++e) { const LAS f32x4* wr = (const LAS f32x4*)(w3s + (j4 * 4 + e) * 16); const f32x4 w0 = wr[0], w1 = wr[1], w2 = wr[2], w3v = wr[3];
                    acc[0] += hh4[e] * w0.x; acc[1] += hh4[e] * w0.y; acc[2] += hh4[e] * w0.z; acc[3] += hh4[e] * w0.w; acc[4] += hh4[e] * w1.x; acc[5] += hh4[e] * w1.y; acc[6] += hh4[e] * w1.z; acc[7] += hh4[e] * w1.w;
                    acc[8] += hh4[e] * w2.x; acc[9] += hh4[e] * w2.y; acc[10] += hh4[e] * w2.z; acc[11] += hh4[e] * w2.w; acc[12] += hh4[e] * w3v.x; acc[13] += hh4[e] * w3v.y; acc[14] += hh4[e] * w3v.z; acc[15] += hh4[e] * w3v.w; } }
            const float tn = (float)(ch * 512 + tid) * (1.f / 2047.f);
#pragma unroll
            for (int c = 0; c < 16; ++c) vals[ch][c] = acc[c] * __expf(-tn * dec[c]);
        }
        float ss[8];
#pragma unroll
        for (int c = 0; c < 8; ++c) { float a = 0.f;
#pragma unroll
            for (int ch = 0; ch < 4; ++ch) { a += vals[ch][c] * vals[ch][c]; if (ch > 0 || tid > 0) a += vals[ch][8 + c] * vals[ch][8 + c]; }
            ss[c] = peer::wave_sum(a, lane); }
        if (lane == 0) {
#pragma unroll
            for (int c = 0; c < 8; ++c) red[wv_ * 8 + c] = ss[c]; }
        __syncthreads();
        float scale[8];
#pragma unroll
        for (int c = 0; c < 8; ++c) { float a = 0.f;
#pragma unroll
            for (int g8 = 0; g8 < 8; ++g8) a += red[g8 * 8 + c];
            scale[c] = rsqrtf(a + 1e-12f); }
#pragma unroll
        for (int c = 0; c < 8; ++c) { bf16_t* gp = Gr + (((size_t)l * 2 + o) * 512 + cg * 8 + c) * 4096;
#pragma unroll
            for (int ch = 0; ch < 4; ++ch) { const int t = ch * 512 + tid; gp[2047 - t] = f2bf(vals[ch][c] * scale[c]); if (t > 0) gp[2047 + t] = f2bf(vals[ch][8 + c] * scale[c]); }
            if (tid == 0) gp[4095] = 0; }
    }
    __syncthreads();
}
DEV void modulate_phase(const float* __restrict__ x, const float* __restrict__ ada0, bf16_t* UY, int G, int cblk, int wv) {
    int wv_ = wv, ln_; asm volatile("v_mbcnt_lo_u32_b32 %1, -1, 0\n\tv_mbcnt_hi_u32_b32 %1, -1, %1" : "+s"(wv_), "=v"(ln_)); const int tid = (wv_ << 6) | ln_;
#pragma unroll 1
    for (size_t i = (size_t)cblk * 512 + tid; i < (size_t)T_ * 128; i += (size_t)G * 512) { const size_t tok = i >> 7; const int d = (int)(i & 127) * 8; const float* a = ada0 + (tok >> 11) * 6144;
        const float4 x0 = *(const float4*)(x + tok * 1024 + d), x1 = *(const float4*)(x + tok * 1024 + d + 4), s0 = *(const float4*)(a + 1024 + d), s1 = *(const float4*)(a + 1024 + d + 4), h0 = *(const float4*)(a + d), h1 = *(const float4*)(a + d + 4);
        u32x4 o; o.x = pg8::cvt_pk_bf16(x0.x * (1.f + s0.x) + h0.x, x0.y * (1.f + s0.y) + h0.y); o.y = pg8::cvt_pk_bf16(x0.z * (1.f + s0.z) + h0.z, x0.w * (1.f + s0.w) + h0.w);
        o.z = pg8::cvt_pk_bf16(x1.x * (1.f + s1.x) + h1.x, x1.y * (1.f + s1.y) + h1.y); o.w = pg8::cvt_pk_bf16(x1.z * (1.f + s1.z) + h1.z, x1.w * (1.f + s1.w) + h1.w);
        *(u32x4*)(UY + tok * UYW_ + d) = o; }
}
}

struct Params {
    const float *x, *c, *w_ada, *b_ada, *w_in, *conv_w, *conv_b, *hy_w1, *hy_b1, *hy_w2, *hy_b2, *hy_w3, *hy_freq, *hy_ld, *hy_bias, *attn_sink, *wba, *wbb, *wbc, *w_out, *ln_g, *ln_b,
        *peer_wq, *peer_keys, *peer_u, *peer_v;
    float* out; char* ws;
};
constexpr int LDS_PHASE = 148480;
constexpr int LDS_BYTES = LDS_PHASE + 16;
constexpr size_t OFF_BAR = OFF_LSE + 1792 * 1024;

#define RUN(nvb, call) do { const int wv = wave_s; int wv_ = wv, ln_; asm volatile("v_mbcnt_lo_u32_b32 %1, -1, 0\n\tv_mbcnt_hi_u32_b32 %1, -1, %1" : "+s"(wv_), "=v"(ln_)); int tid_ = (wv_ << 6) | ln_; const int t = tid_ & 255, sub = tid_ >> 8; unsigned char* sm = lds + sub * 16384; \
        for (int vb = (int)blockIdx.x * 2 + sub; vb < (nvb); vb += (int)gridDim.x * 2) { call; __syncthreads(); } } while (0)
#define GSYNC_CG() do { __builtin_amdgcn_sched_barrier(0); grid.sync(); __builtin_amdgcn_sched_barrier(0); } while (0)
#define GSYNC() do { __builtin_amdgcn_sched_barrier(0); xb::xcd_barrier(xbar, wave_s); __builtin_amdgcn_sched_barrier(0); } while (0)

__global__ void __launch_bounds__(512, 2) mega(Params p) {
    extern __shared__ __attribute__((aligned(16))) unsigned char lds[];
    cg::grid_group grid = cg::this_grid();
    LAS unsigned char* ldsl = (LAS unsigned char*)lds;
    const int G = gridDim.x, cblk = blockIdx.x;
    const int wave_s = __builtin_amdgcn_readfirstlane((int)threadIdx.x >> 6);
    float* out = p.out; (void)out;
    if (threadIdx.x < 4) ((LAS unsigned*)(ldsl + LDS_PHASE))[threadIdx.x] = 0u;
    __syncthreads();
    const xb::XcdBarrier xbar = xb::xcd_barrier_post((unsigned*)(p.ws + OFF_BAR), (volatile LAS unsigned*)(ldsl + LDS_PHASE));
    {
    char* ws = p.ws;
    float* ada = (float*)(ws + OFF_ADA); float2* rope = (float2*)(ws + OFF_ROPE); bf16_t* Gr = (bf16_t*)(ws + OFF_GR); float* lse2 = (float*)(ws + OFF_LSE);
    bf16_t* WinT = (bf16_t*)(ws + OFF_WINT); bf16_t* WmT = (bf16_t*)(ws + OFF_WMT); bf16_t* WoutT = (bf16_t*)(ws + OFF_WOUTT); bf16_t* WqT = (bf16_t*)(ws + OFF_WQT);
    bf16_t* UY = (bf16_t*)(ws + OFF_UY); bf16_t* Y = UY + 1024; bf16_t* P = (bf16_t*)(ws + OFF_P); bf16_t* hyT = (bf16_t*)(ws + OFF_HYT);
    bf16_t* merged = (bf16_t*)(ws + OFF_P); bf16_t* gtmp = (bf16_t*)(ws + OFF_P + 64 * MB_); bf16_t* Q2 = (bf16_t*)(ws + OFF_P);
    int* eidx = (int*)(ws + OFF_HYT); float* egate = (float*)(ws + OFF_HYT + 16 * MB_); unsigned char* U8 = (unsigned char*)(ws + OFF_HYT + 32 * MB_); unsigned char* V4 = (unsigned char*)(ws + OFF_HYT + 48 * MB_); float* sinv = (float*)(ws + OFF_HYT + 64 * MB_);
    float* h2 = (float*)(ws + OFF_P);
    (void)lse2; (void)P; (void)hyT; (void)merged; (void)gtmp; (void)Q2; (void)eidx; (void)egate; (void)U8; (void)V4; (void)sinv; (void)Y;

    misc::ada_phase(ldsl, p.c, p.w_ada, p.b_ada, ada, G, cblk, wave_s);
    RUN(256, nb_rope(vb, t, sm, rope));
    RUN(1024, nb_filt_h2(vb, t, sm, p.hy_w1, p.hy_b1, p.hy_w2, p.hy_b2, p.hy_freq, h2));
    { const WPrep wq{p.w_in, p.wba, p.wbb, p.wbc, p.w_out, p.peer_wq, WinT, WmT, WoutT, WqT}; RUN(6016, nb_wprep(vb, t, sm, wq)); }
    GSYNC_CG();
    misc::filt_phase(ldsl, h2, p.hy_w3, p.hy_ld, Gr, G, cblk, wave_s);
    misc::modulate_phase(p.x, ada, UY, G, cblk, wave_s);
    GSYNC();
    }
#pragma unroll 1
    for (int l = 0; l < 2; ++l) {
        size_t zoff = 0; asm volatile("" : "+s"(zoff));
        char* ws = p.ws + zoff; float* out = p.out + zoff;
        int Gl = gridDim.x, cl = blockIdx.x; asm volatile("" : "+s"(Gl), "+s"(cl));
        float* ada = (float*)(ws + OFF_ADA); float2* rope = (float2*)(ws + OFF_ROPE); bf16_t* Gr = (bf16_t*)(ws + OFF_GR); float* lse2 = (float*)(ws + OFF_LSE);
        bf16_t* WinT = (bf16_t*)(ws + OFF_WINT); bf16_t* WmT = (bf16_t*)(ws + OFF_WMT); bf16_t* WoutT = (bf16_t*)(ws + OFF_WOUTT); bf16_t* WqT = (bf16_t*)(ws + OFF_WQT);
        bf16_t* UY = (bf16_t*)(ws + OFF_UY); bf16_t* Y = UY + 1024; bf16_t* P = (bf16_t*)(ws + OFF_P); bf16_t* hyT = (bf16_t*)(ws + OFF_HYT);
        bf16_t* merged = (bf16_t*)(ws + OFF_P); bf16_t* gtmp = (bf16_t*)(ws + OFF_P + 64 * MB_); bf16_t* Q2 = (bf16_t*)(ws + OFF_P);
        int* eidx = (int*)(ws + OFF_HYT); float* egate = (float*)(ws + OFF_HYT + 16 * MB_); unsigned char* U8 = (unsigned char*)(ws + OFF_HYT + 32 * MB_); unsigned char* V4 = (unsigned char*)(ws + OFF_HYT + 48 * MB_); float* sinv = (float*)(ws + OFF_HYT + 64 * MB_);
        const float* ada_l = ada + (size_t)l * 16 * 6144;
        const float* xin = (l == 0) ? p.x : out;
        const bf16_t* WinT_l = WinT + (size_t)l * 7680 * 1024;
        {
            const pg8::PlainSched S1{UY, WinT_l, UYW_, 1024, 128, 12, 16, Gl, cl}; const pg8::EpiP E1{P, rope};
            pg8::gemm_phase(ldsl, UYW_, 1024, S1, E1, wave_s);
            const pg8::PlainSched S2{WinT_l + (size_t)3072 * 1024, UY, 1024, UYW_, 6, 128, 16, Gl, cl}; const pg8::EpiBf E2{hyT, T_, 0};
            pg8::gemm_phase(ldsl, 1024, UYW_, S2, E2, wave_s);
        }
        GSYNC();
        at::attn_phase(ldsl, P, lse2, Y, p.attn_sink + l * 8, Gl, cl, wave_s);
        hy::hyena_phase(ldsl, hyT, Gr + (size_t)l * 2 * 512 * 4096, p.conv_w + (size_t)l * 3 * 1536, p.conv_b + (size_t)l * 1536, p.hy_bias + (size_t)l * 1024, Gl, cl, wave_s);
        GSYNC();
        misc::yprep_phase(ldsl, hyT, P, lse2, Y, Gl, cl, wave_s);
        GSYNC();
        {
            const pg8::MergeSched S{UY, WmT + (size_t)l * 1024 * WMW_, Gl, cl}; const pg8::EpiMergeAll E{gtmp, merged};
            pg8::gemm_phase(ldsl, UYW_, WMW_, S, E, wave_s);
        }
        GSYNC();
        {
            const pg8::PlainSched S{merged, WoutT + (size_t)l * 1024 * 1024, 1024, 1024, 128, 4, 16, Gl, cl}; const pg8::EpiOut E{xin, out, ada_l + 2048};
            pg8::gemm_phase(ldsl, 1024, 1024, S, E, wave_s);
        }
        GSYNC();
        misc::ln_phase(out, p.ln_g + (size_t)(l * 2 + 0) * 1024, p.ln_b + (size_t)(l * 2 + 0) * 1024, ada_l, UY, Gl, cl, wave_s);
        RUN(8192, peer::nb_quant_tables(vb, t, p.peer_u + (size_t)l * 16384 * 1024, p.peer_v + (size_t)l * 16384 * 1024, U8, V4, sinv));
        GSYNC();
        {
            const pg8::PlainSched S{UY, WqT + (size_t)l * 2048 * 1024, UYW_, 1024, 128, 8, 16, Gl, cl}; const pg8::EpiBf E{Q2, 2048, 0};
            pg8::gemm_phase(ldsl, UYW_, 1024, S, E, wave_s);
        }
        GSYNC();
        tk::topk_phase(ldsl, Q2, p.peer_keys + (size_t)l * 8 * 2 * 128 * 128, eidx, egate, Gl, cl, wave_s);
        GSYNC();
        peer::peer_phase(ldsl, out, ada_l, eidx, egate, U8, V4, sinv, p.ln_g + (size_t)(l * 2 + 1) * 1024, p.ln_b + (size_t)(l * 2 + 1) * 1024,
                         (l == 0) ? ada + (size_t)16 * 6144 : (const float*)nullptr, UY, Gl, cl, wave_s);
        if (l == 0) GSYNC();
    }
}

extern "C" void kernel_launch(void* const* d_in, const int* in_sizes, int n_in, void* d_out, int out_size, void* d_ws, size_t ws_size, hipStream_t stream) {
    static int grid = 0;
    if (grid == 0) {
        if (ws_size < WS_NEED || n_in != 26) { fprintf(stderr, "kernel_launch: workspace %zu < %zu or n_in %d != 26\n", ws_size, (size_t)WS_NEED, n_in); grid = -1; return; }
        int dev = 0, cus = 0, per_cu = 0;
        (void)hipGetDevice(&dev); (void)hipDeviceGetAttribute(&cus, hipDeviceAttributeMultiprocessorCount, dev);
        (void)hipFuncSetAttribute((const void*)mega, hipFuncAttributeMaxDynamicSharedMemorySize, LDS_BYTES);
        (void)hipOccupancyMaxActiveBlocksPerMultiprocessor(&per_cu, (const void*)mega, 512, LDS_BYTES);
        if (per_cu < 1) { fprintf(stderr, "kernel_launch: occupancy query says %d blocks per CU\n", per_cu); grid = -1; return; }
        grid = cus;
    }
    if (grid < 0) return;
    Params p{};
    const float** pp = (const float**)&p;
    for (int i = 0; i < 26; ++i) pp[i] = (const float*)d_in[i];
    p.out = (float*)d_out; p.ws = (char*)d_ws;
    (void)hipMemsetAsync((char*)d_ws + OFF_BAR, 0, xb::XCD_BAR_WORDS * sizeof(unsigned), stream);
    void* args[] = {&p};
    hipError_t e = hipLaunchCooperativeKernel((const void*)mega, dim3(grid), dim3(512), args, LDS_BYTES, stream);
    if (e != hipSuccess) fprintf(stderr, "cooperative launch failed: %s (grid %d)\n", hipGetErrorString(e), grid);
}
```

```cpp
#include <hip/hip_runtime.h>
#include <hip/hip_cooperative_groups.h>
namespace cg = cooperative_groups;
#include <stdint.h>
#include <stdio.h>

#define DEV __device__ __forceinline__
typedef unsigned short bf16_t;

constexpr int D_ = 1024, B_ = 16, S_ = 2048, T_ = B_ * S_;
constexpr float ALPHA_ = 1.41421356237309515f;
constexpr float LOG2E_ = 1.4426950408889634f;
constexpr float QSCALE_ = 0.125f * 1.4426950408889634f;
constexpr float LN_EPS_ = 1e-5f;
constexpr int PW_ = 3072;
constexpr int UYW_ = 2304;
constexpr int WMW_ = 4352;

constexpr size_t MB_ = 1024 * 1024;
constexpr size_t OFF_ADA = 0, OFF_ROPE = 1 * MB_, OFF_GR = 2 * MB_, OFF_LSE = 18 * MB_, OFF_WINT = 20 * MB_, OFF_WMT = 50 * MB_,
                 OFF_WOUTT = 68 * MB_, OFF_WQT = 72 * MB_, OFF_KEYS = 80 * MB_, OFF_UY = 82 * MB_, OFF_P = 226 * MB_, OFF_HYT = 418 * MB_,
                 OFF_Z1T = OFF_P  , WS_NEED = 514 * MB_;

DEV int xor_i(int v, int off, int lane) { return __builtin_amdgcn_ds_bpermute((lane ^ off) << 2, v); }
DEV float xor_f(float v, int off, int lane) { return __int_as_float(__builtin_amdgcn_ds_bpermute((lane ^ off) << 2, __float_as_int(v))); }
DEV float bf2f(bf16_t v) { return __uint_as_float(((unsigned)v) << 16); }
DEV bf16_t f2bf(float f) { unsigned u = __float_as_uint(f); u += 0x7FFFu + ((u >> 16) & 1u); return (bf16_t)(u >> 16); }

DEV void nb_ada(int vb, int t, unsigned char* sm, const float* __restrict__ c, const float* __restrict__ w_ada, const float* __restrict__ b_ada, float* __restrict__ ada) {
    const int idx = vb * 256 + t; const int l = idx / 6144, n = idx % 6144;
    float (*cond)[64] = (float (*)[64])sm;
    float acc[16];
#pragma unroll
    for (int b = 0; b < 16; ++b) acc[b] = b_ada[l * 6144 + n];
    for (int k0 = 0; k0 < 1024; k0 += 64) {
        for (int i = t; i < 1024; i += 256) { const int b = i >> 6, kk = i & 63; const float v = c[b * 1024 + k0 + kk]; cond[b][kk] = v / (1.f + expf(-v)); }
        __syncthreads();
        for (int kk = 0; kk < 64; ++kk) { const float w = w_ada[((size_t)l * 1024 + k0 + kk) * 6144 + n];
#pragma unroll
            for (int b = 0; b < 16; ++b) acc[b] += cond[b][kk] * w; }
        __syncthreads();
    }
#pragma unroll
    for (int b = 0; b < 16; ++b) ada[((size_t)l * 16 + b) * 6144 + n] = acc[b];
}

DEV void nb_rope(int vb, int t, unsigned char* sm, float2* __restrict__ rope) {
    const int idx = vb * 256 + t; const int s = idx >> 5, i = idx & 31;
    const float inv = powf(10000.f, -(float)i / 32.f); const float ang = (float)s * inv;
    rope[idx] = make_float2(cosf(ang), sinf(ang));
}

DEV void nb_filt_h2(int vb, int t, unsigned char* sm, const float* __restrict__ w1, const float* __restrict__ b1, const float* __restrict__ w2, const float* __restrict__ b2,
                                                const float* __restrict__ freq, float* __restrict__ h2) {
    const int grp = t >> 6, j = t & 63; const int lt = vb * 4 + grp; const int l = lt / 2048, tt = lt % 2048;
    float* z = (float*)sm + grp * 128; float* h1 = z + 64;
    if (j < 33) {
        const float idx = (float)tt, tn = idx / 2047.f, w = 6.283185307179586f * idx / 2048.f;
        if (j == 0) z[0] = tn;
        else { const int k = (j <= 16) ? (j - 1) : (j - 17); const float band = 1e-4f + (float)k * ((15.f - 1e-4f) / 15.f); const float ang = w * band;
            z[j] = (j <= 16) ? cosf(ang) : -sinf(ang); }
    }
    __syncthreads();
    float a = b1[l * 64 + j];
    for (int e = 0; e < 33; ++e) a += z[e] * w1[(l * 33 + e) * 64 + j];
    h1[j] = sinf(freq[(l * 2 + 0) * 64 + j] * a);
    __syncthreads();
    float a2 = b2[l * 64 + j];
    for (int i = 0; i < 64; ++i) a2 += h1[i] * w2[(l * 64 + i) * 64 + j];
    h2[((size_t)l * 2048 + tt) * 64 + j] = sinf(freq[(l * 2 + 1) * 64 + j] * a2);
}

DEV void nb_filt_full(int vb, int t, unsigned char* sm, const float* __restrict__ h2, const float* __restrict__ w3, const float* __restrict__ log_decay, float* __restrict__ hf) {
    const size_t idx = (size_t)vb * 256 + t; const int col = (int)(idx & 2047), tt = (int)((idx >> 11) & 2047), l = (int)(idx >> 22);
    const float* hr = h2 + ((size_t)l * 2048 + tt) * 64; float a = 0.f;
    for (int j = 0; j < 64; ++j) a += hr[j] * w3[((size_t)l * 64 + j) * 2048 + col];
    const float tn = (float)tt / 2047.f;
    hf[idx] = a * expf(-tn * expf(log_decay[l * 2048 + col]));
}

DEV void nb_filt_norm(int vb, int t, unsigned char* sm, const float* __restrict__ hf, bf16_t* __restrict__ Gr) {
    const int blk = vb; const int c = blk & 511, o = (blk >> 9) & 1, l = blk >> 10;
    const float* base = hf + (size_t)l * 2048 * 2048; const int colf = o * 512 + c, colb = 1024 + o * 512 + c;
    float ss = 0.f;
    for (int tt = t; tt < 2048; tt += 256) { const float a = base[(size_t)tt * 2048 + colf]; ss += a * a; if (tt >= 1) { const float bb = base[(size_t)tt * 2048 + colb]; ss += bb * bb; } }
    float* red = (float*)sm; red[t] = ss; __syncthreads();
    for (int st = 128; st > 0; st >>= 1) { if (t < st) red[t] += red[t + st]; __syncthreads(); }
    const float scale = rsqrtf(red[0] + 1e-12f); __syncthreads();
    bf16_t* g = Gr + (size_t)blk * 4096;
    for (int n = t; n < 4096; n += 256) { const int lag = 2047 - n; float v = 0.f;
        if (n < 4095) v = (lag >= 0) ? base[(size_t)lag * 2048 + colf] : base[(size_t)(-lag) * 2048 + colb];
        g[n] = f2bf(v * scale); }
}

DEV void nb_modulate(int vb, int t, unsigned char* sm, const float* __restrict__ x, const float* __restrict__ ada_l, int off_sh, int off_sc, bf16_t* __restrict__ ubuf) {
    const size_t idx = (size_t)vb * 256 + t; const int d = (int)(idx & 1023); const int b = (int)(idx >> 21);
    const float* a = ada_l + (size_t)b * 6144;
    ubuf[(idx >> 10) * UYW_ + d] = f2bf(x[idx] * (1.f + a[off_sc + d]) + a[off_sh + d]);
}

template <class AL, class WL, class EP>
DEV void nb_gemm(int vb, int t, unsigned char* sm, int nbx, int K, AL al, WL wl, EP ep) {
    float (*As)[65] = (float (*)[65])sm;
    float (*Ws)[65] = (float (*)[65])(sm + 16 * 65 * 4);
    const int tx = t & 15, ty = t >> 4;
    const int m0 = (vb / nbx) * 64, n0 = (vb % nbx) * 64;
    float acc[4][4];
#pragma unroll
    for (int i = 0; i < 4; ++i)
#pragma unroll
        for (int j = 0; j < 4; ++j) acc[i][j] = 0.f;
    for (int k0 = 0; k0 < K; k0 += 16) {
#pragma unroll
        for (int r = 0; r < 4; ++r) { const int i = t + r * 256; const int mm = i >> 4, kk = i & 15; As[kk][mm] = al(m0 + mm, k0 + kk); }
#pragma unroll
        for (int r = 0; r < 4; ++r) { const int i = t + r * 256; const int kk = i >> 6, nn = i & 63; Ws[kk][nn] = wl(k0 + kk, n0 + nn); }
        __syncthreads();
#pragma unroll
        for (int kk = 0; kk < 16; ++kk) {
            float a[4], w[4];
#pragma unroll
            for (int i = 0; i < 4; ++i) { a[i] = As[kk][ty + 16 * i]; w[i] = Ws[kk][tx + 16 * i]; }
#pragma unroll
            for (int i = 0; i < 4; ++i)
#pragma unroll
                for (int j = 0; j < 4; ++j) acc[i][j] += a[i] * w[j];
        }
        __syncthreads();
    }
    ep(m0, n0, ty, tx, acc);
}

struct ALbf { const bf16_t* A; int lda; int pad; DEV float operator()(int m, int k) const { return bf2f(A[(size_t)m * lda + k]); } };
struct WLf { const float* W; int ldw; int coff; DEV float operator()(int k, int n) const { return W[(size_t)k * ldw + coff + n]; } };
struct WLinP { const float* W; DEV float operator()(int k, int n) const { return W[(size_t)k * 7680 + (n < 2304 ? n : n + 1536)]; } };

struct EpP { bf16_t* P; const float2* rope;
    DEV void operator()(int m0, int n0, int ty, int tx, float (&acc)[4][4]) const {
        const int head = n0 >> 6; const bool rp = (head < 24) || (head >= 36 && head < 46); const bool qs = (head < 12) || (head >= 36 && head < 44);
#pragma unroll
        for (int i = 0; i < 4; ++i) { const int m = m0 + ty + 16 * i; const int s = m & 2047; bf16_t* row = P + (size_t)m * PW_ + n0;
            if (rp) {
#pragma unroll
                for (int jj = 0; jj < 2; ++jj) { const int d = tx + 16 * jj; const float x1 = acc[i][jj], x2 = acc[i][jj + 2]; const float2 cs = rope[s * 32 + d];
                    float o1 = x1 * cs.x - x2 * cs.y, o2 = x2 * cs.x + x1 * cs.y; if (qs) { o1 *= QSCALE_; o2 *= QSCALE_; }
                    const int p1 = 8 * (d >> 2) + (d & 3); row[p1] = f2bf(o1); row[p1 + 4] = f2bf(o2); }
            } else {
#pragma unroll
                for (int j = 0; j < 4; ++j) row[tx + 16 * j] = f2bf(acc[i][j]);
            } }
    } };
struct EpHyT { bf16_t* hyT;
    DEV void operator()(int m0, int n0, int ty, int tx, float (&acc)[4][4]) const {
#pragma unroll
        for (int i = 0; i < 4; ++i)
#pragma unroll
            for (int j = 0; j < 4; ++j) hyT[(size_t)(n0 + tx + 16 * j) * T_ + m0 + ty + 16 * i] = f2bf(acc[i][j]);
    } };
struct EpGate { bf16_t* tmp;
    DEV void operator()(int m0, int n0, int ty, int tx, float (&acc)[4][4]) const {
#pragma unroll
        for (int i = 0; i < 4; ++i)
#pragma unroll
            for (int j = 0; j < 4; ++j) tmp[(size_t)(m0 + ty + 16 * i) * 1024 + n0 + tx + 16 * j] = f2bf(1.f / (1.f + expf(-acc[i][j])));
    } };
struct EpMerge { const bf16_t* tmp; bf16_t* merged; int first; int pad;
    DEV void operator()(int m0, int n0, int ty, int tx, float (&acc)[4][4]) const {
#pragma unroll
        for (int i = 0; i < 4; ++i)
#pragma unroll
            for (int j = 0; j < 4; ++j) { const size_t o = (size_t)(m0 + ty + 16 * i) * 1024 + n0 + tx + 16 * j; float v = bf2f(tmp[o]) * acc[i][j]; if (!first) v += bf2f(merged[o]); merged[o] = f2bf(v); }
    } };
struct EpOut { const float* xin; float* h; const float* ada_l; int off_g; int pad;
    DEV void operator()(int m0, int n0, int ty, int tx, float (&acc)[4][4]) const {
#pragma unroll
        for (int i = 0; i < 4; ++i)
#pragma unroll
            for (int j = 0; j < 4; ++j) { const int m = m0 + ty + 16 * i, n = n0 + tx + 16 * j; const size_t o = (size_t)m * 1024 + n;
                h[o] = ALPHA_ * xin[o] + ada_l[(size_t)(m >> 11) * 6144 + off_g + n] * acc[i][j]; }
    } };
struct EpQ2 { bf16_t* Q2;
    DEV void operator()(int m0, int n0, int ty, int tx, float (&acc)[4][4]) const {
#pragma unroll
        for (int i = 0; i < 4; ++i)
#pragma unroll
            for (int j = 0; j < 4; ++j) Q2[(size_t)(m0 + ty + 16 * i) * 2048 + n0 + tx + 16 * j] = f2bf(acc[i][j]);
    } };

DEV void nb_attnA(int vb, int t, unsigned char* sm, bf16_t* __restrict__ P, float* __restrict__ lse2) {
    const int idx = vb * 256 + t; const int s = idx & 2047, head = (idx >> 11) % 12, b = idx / (2048 * 12);
    const int gi = head >> 2; const int dil = gi == 0 ? 1 : (gi == 1 ? 4 : 16); const int ls = 2048 / dil; const int r = s % dil, p = s / dil;
    bf16_t* qrow = P + (size_t)(b * 2048 + s) * PW_ + head * 64;
    float q[64], o[64];
#pragma unroll
    for (int d = 0; d < 64; ++d) { q[d] = bf2f(qrow[d]); o[d] = 0.f; }
    float m = -1e30f, l = 0.f;
    const int lo = max(0, p - 64), hi = min(ls - 1, p + 64);
    for (int pp = lo; pp <= hi; ++pp) {
        const bf16_t* krow = P + (size_t)(b * 2048 + pp * dil + r) * PW_ + 768 + head * 64; const bf16_t* vrow = krow + 768;
        float sc = 0.f;
#pragma unroll
        for (int d = 0; d < 64; ++d) sc += q[d] * bf2f(krow[d]);
        const float mn = fmaxf(m, sc), corr = exp2f(m - mn), pw = exp2f(sc - mn);
        l = l * corr + pw;
#pragma unroll
        for (int d = 0; d < 64; ++d) o[d] = o[d] * corr + pw * bf2f(vrow[d]);
        m = mn;
    }
    const float inv = 1.f / l;
#pragma unroll
    for (int d = 0; d < 64; ++d) qrow[d] = f2bf(o[d] * inv);
    lse2[(size_t)(b * 2048 + s) * 12 + head] = m + log2f(l);
}

DEV void nb_attnC(int vb, int t, unsigned char* sm, const bf16_t* __restrict__ P, const float* __restrict__ sink_l, bf16_t* __restrict__ Y) {
    const int idx = vb * 256 + t; const int s = idx & 2047, qh = (idx >> 11) & 7, b = idx >> 14; const int kvh = qh >> 2;
    const bf16_t* qrow = P + (size_t)(b * 2048 + s) * PW_ + 2304 + qh * 64;
    float q[64], o[64];
#pragma unroll
    for (int d = 0; d < 64; ++d) { q[d] = bf2f(qrow[d]); o[d] = 0.f; }
    float m = -1e30f, l = 0.f;
    const int lo = max(0, s - 128), hi = min(2047, s + 128);
    for (int pp = lo; pp <= hi; ++pp) {
        const bf16_t* krow = P + (size_t)(b * 2048 + pp) * PW_ + 2816 + kvh * 64; const bf16_t* vrow = krow + 128;
        float sc = 0.f;
#pragma unroll
        for (int d = 0; d < 64; ++d) sc += q[d] * bf2f(krow[d]);
        const float mn = fmaxf(m, sc), corr = exp2f(m - mn), pw = exp2f(sc - mn);
        l = l * corr + pw;
#pragma unroll
        for (int d = 0; d < 64; ++d) o[d] = o[d] * corr + pw * bf2f(vrow[d]);
        m = mn;
    }
    const float sk = sink_l[qh] * LOG2E_; const float mf = fmaxf(m, sk); const float corr = exp2f(m - mf);
    l = l * corr + exp2f(sk - mf); const float inv = corr / l;
    bf16_t* yrow = Y + (size_t)(b * 2048 + s) * UYW_ + 768 + qh * 64;
#pragma unroll
    for (int d = 0; d < 64; ++d) yrow[d] = f2bf(o[d] * inv);
}

DEV void nb_combineA(int vb, int t, unsigned char* sm, const bf16_t* __restrict__ P, const float* __restrict__ lse2, bf16_t* __restrict__ Y) {
    const size_t idx = (size_t)vb * 256 + t; const int cc = (int)(idx & 255); const size_t tok = idx >> 8; const int hh = cc >> 6, d = cc & 63;
    const float l0 = lse2[tok * 12 + hh], l1 = lse2[tok * 12 + 4 + hh], l2 = lse2[tok * 12 + 8 + hh]; const float mx = fmaxf(l0, fmaxf(l1, l2));
    const float w0 = exp2f(l0 - mx), w1 = exp2f(l1 - mx), w2 = exp2f(l2 - mx);
    const bf16_t* pr = P + tok * PW_ + hh * 64 + d;
    Y[tok * UYW_ + cc] = f2bf((w0 * bf2f(pr[0]) + w1 * bf2f(pr[256]) + w2 * bf2f(pr[512])) / (w0 + w1 + w2));
}

DEV void nb_hyena(int vb, int t, unsigned char* sm, int pass, bf16_t* __restrict__ hyT, bf16_t* __restrict__ z1T, const bf16_t* __restrict__ Gr_l, const float* __restrict__ conv_w,
                                                const float* __restrict__ conv_b, const float* __restrict__ hy_bias) {
    const size_t idx = (size_t)vb * 256 + t; const int i = (int)(idx & 2047); const int b = (int)((idx >> 11) & 15); const int c = (int)(idx >> 15);
    const bf16_t* G = Gr_l + ((size_t)pass * 512 + c) * 4096 + (2047 - i);
    float acc = 0.f, zi = 0.f;
    if (pass == 0) {
        const bf16_t* in = hyT + (size_t)c * T_ + b * 2048; const float w0 = conv_w[c], w1 = conv_w[1536 + c], w2 = conv_w[3072 + c], cb = conv_b[c];
        float prev = 0.f, cur = bf2f(in[0]);
        for (int j = 0; j < 2048; ++j) { const float nxt = (j < 2047) ? bf2f(in[j + 1]) : 0.f; const float z = cb + w0 * prev + w1 * cur + w2 * nxt;
            acc += bf2f(G[j]) * z; if (j == i) zi = z; prev = cur; cur = nxt; }
    } else {
        const bf16_t* in = z1T + (size_t)c * T_ + b * 2048;
        for (int j = 0; j < 2048; ++j) { const float z = bf2f(in[j]); acc += bf2f(G[j]) * z; if (j == i) zi = z; }
    }
    const int xc = (pass == 0 ? 512 : 1024) + c;
    const bf16_t* xin = hyT + (size_t)xc * T_ + b * 2048;
    const float xm = (i > 0) ? bf2f(xin[i - 1]) : 0.f, x0 = bf2f(xin[i]), xp = (i < 2047) ? bf2f(xin[i + 1]) : 0.f;
    const float xv = conv_b[xc] + conv_w[xc] * xm + conv_w[1536 + xc] * x0 + conv_w[3072 + xc] * xp;
    const float outv = xv * (acc + hy_bias[pass * 512 + c] * zi);
    if (pass == 0) z1T[(size_t)c * T_ + b * 2048 + i] = f2bf(outv); else hyT[(size_t)c * T_ + b * 2048 + i] = f2bf(outv);
}

DEV void nb_transY(int vb, int t, unsigned char* sm, const bf16_t* __restrict__ hyT, bf16_t* __restrict__ Y) {
    const size_t idx = (size_t)vb * 256 + t; const int c = (int)(idx & 511); const size_t tok = idx >> 9;
    Y[tok * UYW_ + 256 + c] = hyT[(size_t)c * T_ + tok];
}

DEV void nb_ln_mod(int vb, int t, unsigned char* sm, float* __restrict__ h, const float* __restrict__ g, const float* __restrict__ bta, const float* __restrict__ ada_l, int off_sh, int off_sc,
                                                bf16_t* __restrict__ ubuf) {
    const int tok = vb; float v[4]; float s = 0.f;
#pragma unroll
    for (int k = 0; k < 4; ++k) { v[k] = h[(size_t)tok * 1024 + t + 256 * k]; s += v[k]; }
    float* red = (float*)sm; red[t] = s; __syncthreads();
    for (int st = 128; st > 0; st >>= 1) { if (t < st) red[t] += red[t + st]; __syncthreads(); }
    const float mu = red[0] * (1.f / 1024.f); __syncthreads();
    float q = 0.f;
#pragma unroll
    for (int k = 0; k < 4; ++k) { const float dd = v[k] - mu; q += dd * dd; }
    red[t] = q; __syncthreads();
    for (int st = 128; st > 0; st >>= 1) { if (t < st) red[t] += red[t + st]; __syncthreads(); }
    const float rstd = rsqrtf(red[0] * (1.f / 1024.f) + LN_EPS_);
    const float* a = ada_l + (size_t)(tok >> 11) * 6144;
#pragma unroll
    for (int k = 0; k < 4; ++k) { const int d = t + 256 * k; const float y = (v[k] - mu) * rstd * g[d] + bta[d]; h[(size_t)tok * 1024 + d] = y;
        if (ubuf) ubuf[(size_t)tok * UYW_ + d] = f2bf(y * (1.f + a[off_sc + d]) + a[off_sh + d]); }
}

DEV void nb_peer_topk(int vb, int t, unsigned char* sm, const bf16_t* __restrict__ Q2, const float* __restrict__ keys_l, int* __restrict__ eidx, float* __restrict__ egate) {
    const int grp = t >> 7; const int th = vb * 2 + grp; const int tok = th >> 3, h = th & 7; t &= 127;
    float* qs = (float*)sm + grp * 1024; float* s1 = qs + 256; float* s2 = s1 + 128; float* t1v = s2 + 128; float* t2v = t1v + 16; float* cand = t2v + 16; float* bestv = cand + 256;
    int* t1i = (int*)(bestv + 16); int* t2i = t1i + 16; int* besti = t2i + 16;
    qs[t] = bf2f(Q2[(size_t)tok * 2048 + h * 256 + t]); qs[t + 128] = bf2f(Q2[(size_t)tok * 2048 + h * 256 + 128 + t]);
    __syncthreads();
    { const float* k1 = keys_l + ((size_t)(h * 2 + 0) * 128 + t) * 128; const float* k2 = keys_l + ((size_t)(h * 2 + 1) * 128 + t) * 128; float a = 0.f, bsum = 0.f;
        for (int c = 0; c < 128; ++c) { a += qs[c] * k1[c]; bsum += qs[128 + c] * k2[c]; }
        s1[t] = a; s2[t] = bsum; }
    __syncthreads();
    { const float a = s1[t], bb = s2[t]; int r1 = 0, r2 = 0;
        for (int m = 0; m < 128; ++m) { const float x = s1[m], y = s2[m]; r1 += (x > a || (x == a && m < t)) ? 1 : 0; r2 += (y > bb || (y == bb && m < t)) ? 1 : 0; }
        if (r1 < 16) { t1v[r1] = a; t1i[r1] = t; } if (r2 < 16) { t2v[r2] = bb; t2i[r2] = t; } }
    __syncthreads();
    cand[t] = t1v[t >> 4] + t2v[t & 15]; cand[t + 128] = t1v[(t + 128) >> 4] + t2v[t & 15];
    __syncthreads();
#pragma unroll
    for (int rr = 0; rr < 2; ++rr) { const int ci = t + 128 * rr; const float a = cand[ci]; int r = 0;
        for (int m = 0; m < 256; ++m) { const float x = cand[m]; r += (x > a || (x == a && m < ci)) ? 1 : 0; }
        if (r < 16) { bestv[r] = a; besti[r] = ci; } }
    __syncthreads();
    if (t < 16) { const float mx = bestv[0]; float sum = 0.f;
        for (int k = 0; k < 16; ++k) sum += expf(bestv[k] - mx);
        const int ci = besti[t]; const size_t o = ((size_t)tok * 8 + h) * 16 + t;
        eidx[o] = ((t1i[(ci >> 4) & 15] & 127) * 128 + (t2i[ci & 15] & 127)); egate[o] = expf(bestv[t] - mx) / sum; }
}

DEV void nb_peer(int vb, int t, unsigned char* sm, float* __restrict__ xio, const float* __restrict__ ada_l, const int* __restrict__ eidx, const float* __restrict__ egate,
                                              const float* __restrict__ pu, const float* __restrict__ pv, const float* __restrict__ g, const float* __restrict__ bta,
                                              const float* __restrict__ ada_next, bf16_t* __restrict__ ubuf) {
    const int tok = vb, lane = t & 63, w = t >> 6;
    float* xs = (float*)sm; float* wv = xs + 1024; float* red = wv + 128; int* es = (int*)(red + 256);
    const float* a = ada_l + (size_t)(tok >> 11) * 6144; float x1[4];
#pragma unroll
    for (int k = 0; k < 4; ++k) { const int d = t + 256 * k; x1[k] = xio[(size_t)tok * 1024 + d]; xs[d] = x1[k] * (1.f + a[4096 + d]) + a[3072 + d]; }
    if (t < 128) es[t] = eidx[(size_t)tok * 128 + t];
    __syncthreads();
    for (int i = w; i < 128; i += 4) { const float* ur = pu + (size_t)es[i] * 1024; float dsum = 0.f;
#pragma unroll
        for (int k = 0; k < 16; ++k) dsum += ur[lane + 64 * k] * xs[lane + 64 * k];
#pragma unroll
        for (int off = 32; off > 0; off >>= 1) dsum += __shfl_xor(dsum, off);
        if (lane == 0) wv[i] = egate[(size_t)tok * 128 + i] * 0.5f * dsum * (1.f + erff(dsum * 0.70710678118654752f)); }
    __syncthreads();
    float acc[4] = {0.f, 0.f, 0.f, 0.f};
    for (int i = 0; i < 128; ++i) { const float* vr = pv + (size_t)es[i] * 1024; const float wi = wv[i];
#pragma unroll
        for (int k = 0; k < 4; ++k) acc[k] += wi * vr[t + 256 * k]; }
    float v[4]; float s = 0.f;
#pragma unroll
    for (int k = 0; k < 4; ++k) { v[k] = ALPHA_ * x1[k] + a[5120 + t + 256 * k] * acc[k]; s += v[k]; }
    red[t] = s; __syncthreads();
    for (int st = 128; st > 0; st >>= 1) { if (t < st) red[t] += red[t + st]; __syncthreads(); }
    const float mu = red[0] * (1.f / 1024.f); __syncthreads();
    float q = 0.f;
#pragma unroll
    for (int k = 0; k < 4; ++k) { const float dd = v[k] - mu; q += dd * dd; }
    red[t] = q; __syncthreads();
    for (int st = 128; st > 0; st >>= 1) { if (t < st) red[t] += red[t + st]; __syncthreads(); }
    const float rstd = rsqrtf(red[0] * (1.f / 1024.f) + LN_EPS_);
    const float* an = ada_next ? ada_next + (size_t)(tok >> 11) * 6144 : nullptr;
#pragma unroll
    for (int k = 0; k < 4; ++k) { const int d = t + 256 * k; const float y = (v[k] - mu) * rstd * g[d] + bta[d]; xio[(size_t)tok * 1024 + d] = y;
        if (an) ubuf[(size_t)tok * UYW_ + d] = f2bf(y * (1.f + an[1024 + d]) + an[d]); }
}

#define LAS __attribute__((address_space(3)))
typedef short bf16x8 __attribute__((ext_vector_type(8)));
typedef float f32x4 __attribute__((ext_vector_type(4)));
typedef float f32x2 __attribute__((ext_vector_type(2)));
typedef unsigned u32x4 __attribute__((ext_vector_type(4)));
typedef unsigned u32x2 __attribute__((ext_vector_type(2)));
typedef int i32x8 __attribute__((ext_vector_type(8)));
namespace pg8 {
constexpr int BM = 256, BK = 64, HALF = 128, HTB = HALF * BK * 2, STAGE_BYTES = 8 * HTB, NXCD = 8, WGM = 8;
DEV int lds_byte(int r, int c) { const int st = (r >> 4) * 2 + (c >> 5), rr = r & 15, cc = c & 31, ob = rr * 64 + cc * 2; return st * 1024 + (ob ^ (((ob >> 9) & 1) << 5)); }
DEV void stage_rc(int b, int& R, int& C) { const int st = b / 1024, sb = b % 1024, swz = sb ^ (((sb >> 9) & 1) << 5); R = (st >> 1) * 16 + swz / 64; C = (st & 1) * 32 + (swz % 64) / 2; }
DEV int perm32(int rho) { const int n = rho >> 4, i = rho & 15; return 8 * (i >> 2) + 4 * n + (i & 3); }
DEV unsigned cvt_pk_bf16(float lo, float hi) { unsigned r; asm volatile("v_cvt_pk_bf16_f32 %0, %1, %2" : "=v"(r) : "v"(lo), "v"(hi)); return r; }

struct Unit { int pm, pn, tag, nt; const char* a; const char* b; };
DEV void tile_of(int L, int nM, int nN, int& pm, int& pn) {
    const int nwg = nM * nN; int wgid = L; { const int q = nwg / NXCD, r = nwg % NXCD, xcd = wgid % NXCD, off = wgid / NXCD; wgid = (xcd < r ? xcd * (q + 1) : r * (q + 1) + (xcd - r) * q) + off; }
    const int nig = WGM * nN, gid = wgid / nig, fm = gid * WGM, gsz = (nM - fm) < WGM ? (nM - fm) : WGM;
    pm = fm + ((wgid % nig) % gsz); pn = (wgid % nig) / gsz;
}
struct PlainSched { const bf16_t* A; const bf16_t* Bt; int lda, ldb, nM, nN, nt, G, c;
    DEV bool next(int i, Unit& u) const { const long L = (long)i * G + c; if (L >= (long)nM * nN) return false; tile_of((int)L, nM, nN, u.pm, u.pn); u.tag = 0; u.nt = nt;
        u.a = (const char*)(A + (size_t)u.pm * BM * lda); u.b = (const char*)(Bt + (size_t)u.pn * BM * ldb); return true; } };

template <class Epi, class Sched>
DEV void gemm_phase(LAS unsigned char* lds, const int lda, const int ldb, const Sched& S, const Epi& E, const int wv) {
    int wv_ = wv, ln_; asm volatile("v_mbcnt_lo_u32_b32 %1, -1, 0\n\tv_mbcnt_hi_u32_b32 %1, -1, %1" : "+s"(wv_), "=v"(ln_)); int tid_ = (wv_ << 6) | ln_;
    const int tid = tid_, wid = __builtin_amdgcn_readfirstlane(tid >> 6), lane = tid & 63, wr = wid >> 2, wc = wid & 3, fr = lane & 15, fq = lane >> 4;
    unsigned voffA[2], voffB[2];
#pragma unroll
    for (int i = 0; i < 2; ++i) { int R, C; stage_rc(tid * 16 + i * 8192, R, C); const int Rb = Epi::PERM ? ((R & ~31) + perm32(R & 31)) : R;
        voffA[i] = (unsigned)(R * lda + C) * 2u; voffB[i] = (unsigned)(Rb * ldb + C) * 2u; }
    const size_t kstep = (size_t)(BK * 2);
    const size_t hstepA = (size_t)HALF * lda * 2, hstepB = (size_t)HALF * ldb * 2;
    const unsigned ldsw = (unsigned)wid * 1024u;
    const int aoff = lds_byte(wr * 64 + fr, fq * 8), boff = lds_byte(wc * 32 + fr, fq * 8);
#define PG8_SA(b, h) (((b) * 2 + (h)) * HTB)
#define PG8_SB(b, h) ((4 + (b) * 2 + (h)) * HTB)
#define PG8_STAGE(bufoff, gbase, voff) do { _Pragma("unroll") for (int _i = 0; _i < 2; ++_i) \
        __builtin_amdgcn_global_load_lds((const unsigned*)((const char*)(gbase) + (voff)[_i]), (LAS unsigned*)(lds + (bufoff) + ldsw + _i * 8192), 16, 0, 0); } while (0)
#define PG8_LDA(dst, b, h) do { _Pragma("unroll") for (int m = 0; m < 4; ++m) _Pragma("unroll") for (int k = 0; k < 2; ++k) dst[m][k] = *(const LAS bf16x8*)(lds + PG8_SA(b, h) + aoff + m * 2048 + k * 1024); } while (0)
#define PG8_LDB(dst, b, h) do { _Pragma("unroll") for (int n = 0; n < 2; ++n) _Pragma("unroll") for (int k = 0; k < 2; ++k) dst[n][k] = *(const LAS bf16x8*)(lds + PG8_SB(b, h) + boff + n * 2048 + k * 1024); } while (0)
#define PG8_MMA(ai, bj, At, Bt) do { __builtin_amdgcn_s_setprio(1); _Pragma("unroll") for (int m = 0; m < 4; ++m) _Pragma("unroll") for (int n = 0; n < 2; ++n) _Pragma("unroll") for (int k = 0; k < 2; ++k) \
        acc[ai][bj][m][n] = __builtin_amdgcn_mfma_f32_16x16x32_bf16(Bt[n][k], At[m][k], acc[ai][bj][m][n], 0, 0, 0); __builtin_amdgcn_s_setprio(0); } while (0)
#define PG8_WAIT_V(n) asm volatile("s_waitcnt vmcnt(" #n ")" ::: "memory")
#define PG8_WAIT_L(n) asm volatile("s_waitcnt lgkmcnt(" #n ")" ::: "memory")
#define PG8_BAR __builtin_amdgcn_s_barrier()
#define PG8_SCHED __builtin_amdgcn_sched_barrier(0)
    Unit cur, nxt; int ui = 0;
    if (!S.next(0, cur)) return;
    f32x4 acc[2][2][4][2];
#pragma unroll
    for (int a = 0; a < 2; ++a)
#pragma unroll
        for (int b = 0; b < 2; ++b)
#pragma unroll
            for (int m = 0; m < 4; ++m)
#pragma unroll
                for (int n = 0; n < 2; ++n) acc[a][b][m][n] = (f32x4){0.f, 0.f, 0.f, 0.f};
    bf16x8 At[4][2], B0[2][2], B1[2][2];
    const char* cA = cur.a; const char* cB = cur.b;
    PG8_STAGE(PG8_SB(0, 0), cB, voffB); PG8_STAGE(PG8_SA(0, 0), cA, voffA); PG8_STAGE(PG8_SB(0, 1), cB + hstepB, voffB); PG8_STAGE(PG8_SA(0, 1), cA + hstepA, voffA);
    if (wr == 1) PG8_BAR;
    PG8_WAIT_V(4); PG8_BAR;
    PG8_STAGE(PG8_SB(1, 0), cB + kstep, voffB); PG8_STAGE(PG8_SA(1, 0), cA + kstep, voffA); PG8_STAGE(PG8_SB(1, 1), cB + hstepB + kstep, voffB);
    PG8_WAIT_V(6); PG8_BAR;
    for (;;) {
        const bool has_next = S.next(ui + 1, nxt);
        const char* nA = has_next ? nxt.a : cA; const char* nB = has_next ? nxt.b : cB;
        const int nt = cur.nt;
        for (int t = 0; t < nt; t += 2) {
            const bool last = (t == nt - 2);
            const char* a1 = cA + (size_t)(t + 1) * kstep;
            const char* a2 = last ? nA : cA + (size_t)(t + 2) * kstep; const char* b2 = last ? nB : cB + (size_t)(t + 2) * kstep;
            const char* a3 = a2 + kstep; const char* b3 = b2 + kstep;
            PG8_LDB(B0, 0, 0); PG8_SCHED; PG8_LDA(At, 0, 0); PG8_STAGE(PG8_SA(1, 1), a1 + hstepA, voffA);
            PG8_WAIT_L(8); PG8_BAR; PG8_WAIT_L(0); PG8_MMA(0, 0, At, B0); PG8_BAR; PG8_SCHED;
            PG8_LDB(B1, 0, 1); PG8_STAGE(PG8_SB(0, 0), b2, voffB);
            PG8_BAR; PG8_WAIT_L(0); PG8_MMA(0, 1, At, B1); PG8_BAR;
            PG8_LDA(At, 0, 1); PG8_STAGE(PG8_SA(0, 0), a2, voffA);
            PG8_BAR; PG8_WAIT_L(0); PG8_MMA(1, 0, At, B0); PG8_BAR; PG8_SCHED;
            PG8_STAGE(PG8_SB(0, 1), b2 + hstepB, voffB);
            PG8_WAIT_V(6); PG8_BAR; PG8_MMA(1, 1, At, B1); PG8_BAR;
            PG8_LDB(B0, 1, 0); PG8_SCHED; PG8_LDA(At, 1, 0); PG8_STAGE(PG8_SA(0, 1), a2 + hstepA, voffA);
            PG8_WAIT_L(8); PG8_BAR; PG8_WAIT_L(0); PG8_MMA(0, 0, At, B0); PG8_BAR; PG8_SCHED;
            PG8_LDB(B1, 1, 1); PG8_STAGE(PG8_SB(1, 0), b3, voffB);
            PG8_BAR; PG8_WAIT_L(0); PG8_MMA(0, 1, At, B1); PG8_BAR;
            PG8_LDA(At, 1, 1); PG8_STAGE(PG8_SA(1, 0), a3, voffA);
            PG8_BAR; PG8_WAIT_L(0); PG8_MMA(1, 0, At, B0); PG8_BAR; PG8_SCHED;
            PG8_STAGE(PG8_SB(1, 1), b3 + hstepB, voffB);
            PG8_WAIT_V(6); PG8_BAR; PG8_MMA(1, 1, At, B1); PG8_BAR;
        }
        E(acc, cur, wr, wc, fr, fq);
        if (!has_next) break;
#pragma unroll
        for (int a = 0; a < 2; ++a)
#pragma unroll
            for (int b = 0; b < 2; ++b)
#pragma unroll
                for (int m = 0; m < 4; ++m)
#pragma unroll
                    for (int n = 0; n < 2; ++n) acc[a][b][m][n] = (f32x4){0.f, 0.f, 0.f, 0.f};
        cur = nxt; cA = nA; cB = nB; ++ui;
    }
    PG8_WAIT_V(0);
    if (wr == 0) PG8_BAR;
    PG8_BAR;
#undef PG8_SA
#undef PG8_SB
#undef PG8_STAGE
#undef PG8_LDA
#undef PG8_LDB
#undef PG8_MMA
#undef PG8_WAIT_V
#undef PG8_WAIT_L
#undef PG8_BAR
#undef PG8_SCHED
}
struct EpiBf { static constexpr bool PERM = true; bf16_t* O; int ldc; int pad;
    DEV void operator()(const f32x4 (&acc)[2][2][4][2], const Unit& u, int wr, int wc, int fr, int fq) const {
        const int row0 = u.pm * BM + wr * 64 + fr, col0 = u.pn * BM + wc * 32 + 8 * fq;
#pragma unroll
        for (int ai = 0; ai < 2; ++ai)
#pragma unroll
            for (int m = 0; m < 4; ++m) { bf16_t* rowp = O + (size_t)(row0 + ai * HALF + m * 16) * ldc + col0;
#pragma unroll
                for (int bj = 0; bj < 2; ++bj) { const f32x4 v0 = acc[ai][bj][m][0], v1 = acc[ai][bj][m][1];
                    u32x4 w; w.x = cvt_pk_bf16(v0[0], v0[1]); w.y = cvt_pk_bf16(v0[2], v0[3]); w.z = cvt_pk_bf16(v1[0], v1[1]); w.w = cvt_pk_bf16(v1[2], v1[3]);
                    *(u32x4*)(rowp + bj * HALF) = w; } }
    } };
struct EpiP { static constexpr bool PERM = true; bf16_t* P; const float2* rope;
    DEV void operator()(const f32x4 (&acc)[2][2][4][2], const Unit& u, int wr, int wc, int fr, int fq) const {
        const int row0 = u.pm * BM + wr * 64 + fr, col0 = u.pn * BM + wc * 32 + 8 * fq; const int g = (wc & 1) * 4 + fq; const int pn = u.pn;
        const bool qs = (pn < 3) || (pn == 9) || (pn == 10);
#pragma unroll
        for (int ai = 0; ai < 2; ++ai)
#pragma unroll
            for (int m = 0; m < 4; ++m) { const int row = row0 + ai * HALF + m * 16; bf16_t* rowp = P + (size_t)row * PW_ + col0;
                const float4* rp = (const float4*)(rope + (size_t)(row & 2047) * 32 + 4 * g); const float4 cs0 = rp[0], cs1 = rp[1];
                const float cc[4] = {cs0.x, cs0.z, cs1.x, cs1.z}, ss[4] = {cs0.y, cs0.w, cs1.y, cs1.w};
#pragma unroll
                for (int bj = 0; bj < 2; ++bj) { f32x4 v0 = acc[ai][bj][m][0], v1 = acc[ai][bj][m][1];
                    const bool rp_ = (pn < 6) || (pn == 9) || (pn == 10) || (pn == 11 && bj == 0);
                    if (rp_) {
#pragma unroll
                        for (int j = 0; j < 4; ++j) { const float x1 = v0[j], x2 = v1[j]; float o1 = x1 * cc[j] - x2 * ss[j], o2 = x2 * cc[j] + x1 * ss[j];
                            if (qs) { o1 *= QSCALE_; o2 *= QSCALE_; } v0[j] = o1; v1[j] = o2; } }
                    u32x4 w; w.x = cvt_pk_bf16(v0[0], v0[1]); w.y = cvt_pk_bf16(v0[2], v0[3]); w.z = cvt_pk_bf16(v1[0], v1[1]); w.w = cvt_pk_bf16(v1[2], v1[3]);
                    *(u32x4*)(rowp + bj * HALF) = w; } }
    } };
struct EpiMergeAll { static constexpr bool PERM = true; bf16_t* gtmp; bf16_t* merged;
    DEV void operator()(const f32x4 (&acc)[2][2][4][2], const Unit& u, int wr, int wc, int fr, int fq) const {
        const int row0 = u.pm * BM + wr * 64 + fr, col0 = u.pn * BM + wc * 32 + 8 * fq; const int tag = u.tag;
#pragma unroll
        for (int ai = 0; ai < 2; ++ai)
#pragma unroll
            for (int m = 0; m < 4; ++m) { const size_t ro = (size_t)(row0 + ai * HALF + m * 16) * 1024 + col0;
#pragma unroll
                for (int bj = 0; bj < 2; ++bj) { f32x4 v0 = acc[ai][bj][m][0], v1 = acc[ai][bj][m][1]; const size_t o = ro + bj * HALF;
                    if ((tag & 1) == 0) {
#pragma unroll
                        for (int j = 0; j < 4; ++j) { v0[j] = 1.f / (1.f + __expf(-v0[j])); v1[j] = 1.f / (1.f + __expf(-v1[j])); }
                        u32x4 w; w.x = cvt_pk_bf16(v0[0], v0[1]); w.y = cvt_pk_bf16(v0[2], v0[3]); w.z = cvt_pk_bf16(v1[0], v1[1]); w.w = cvt_pk_bf16(v1[2], v1[3]);
                        *(u32x4*)(gtmp + o) = w;
                    } else {
                        const u32x4 gq = *(const u32x4*)(gtmp + o);
                        float gg[8] = {__uint_as_float(gq.x << 16), __uint_as_float(gq.x & 0xffff0000u), __uint_as_float(gq.y << 16), __uint_as_float(gq.y & 0xffff0000u),
                                       __uint_as_float(gq.z << 16), __uint_as_float(gq.z & 0xffff0000u), __uint_as_float(gq.w << 16), __uint_as_float(gq.w & 0xffff0000u)};
#pragma unroll
                        for (int j = 0; j < 4; ++j) { v0[j] *= gg[j]; v1[j] *= gg[4 + j]; }
                        if (tag != 1) { const u32x4 mq = *(const u32x4*)(merged + o);
                            float mm[8] = {__uint_as_float(mq.x << 16), __uint_as_float(mq.x & 0xffff0000u), __uint_as_float(mq.y << 16), __uint_as_float(mq.y & 0xffff0000u),
                                           __uint_as_float(mq.z << 16), __uint_as_float(mq.z & 0xffff0000u), __uint_as_float(mq.w << 16), __uint_as_float(mq.w & 0xffff0000u)};
#pragma unroll
                            for (int j = 0; j < 4; ++j) { v0[j] += mm[j]; v1[j] += mm[4 + j]; } }
                        u32x4 w; w.x = cvt_pk_bf16(v0[0], v0[1]); w.y = cvt_pk_bf16(v0[2], v0[3]); w.z = cvt_pk_bf16(v1[0], v1[1]); w.w = cvt_pk_bf16(v1[2], v1[3]);
                        *(u32x4*)(merged + o) = w;
                    } } }
    } };
struct EpiOut { static constexpr bool PERM = false; const float* xin; float* h; const float* ada_g;
    DEV void operator()(const f32x4 (&acc)[2][2][4][2], const Unit& u, int wr, int wc, int fr, int fq) const {
        const int row0 = u.pm * BM + wr * 64 + fr, col0 = u.pn * BM + wc * 32 + 4 * fq; const float* gv = ada_g + (size_t)(u.pm >> 3) * 6144 + col0;
        f32x4 g[2][2];
#pragma unroll
        for (int bj = 0; bj < 2; ++bj)
#pragma unroll
            for (int n = 0; n < 2; ++n) g[bj][n] = *(const f32x4*)(gv + bj * HALF + n * 16);
#pragma unroll
        for (int ai = 0; ai < 2; ++ai)
#pragma unroll
            for (int m = 0; m < 4; ++m) { const size_t ro = (size_t)(row0 + ai * HALF + m * 16) * 1024 + col0;
#pragma unroll
                for (int bj = 0; bj < 2; ++bj)
#pragma unroll
                    for (int n = 0; n < 2; ++n) { const size_t o = ro + bj * HALF + n * 16; const f32x4 xv = *(const f32x4*)(xin + o); *(f32x4*)(h + o) = ALPHA_ * xv + g[bj][n] * acc[ai][bj][m][n]; } }
    } };
struct MergeSched { const bf16_t* UY; const bf16_t* WmT; int G, c;
    DEV bool next(int i, Unit& u) const { const int ti = i / 6, ps = i - ti * 6; const long L = (long)ti * G + c; if (L >= 128 * 4) return false; tile_of((int)L, 128, 4, u.pm, u.pn); u.tag = ps;
        const int br = ps >> 1; const bf16_t* ar = UY + (size_t)u.pm * BM * UYW_; const bf16_t* brow = WmT + (size_t)u.pn * BM * WMW_;
        if ((ps & 1) == 0) { u.nt = 16; u.a = (const char*)ar; u.b = (const char*)(brow + br * 1024); }
        else { const int koff = br == 0 ? 0 : (br == 1 ? 256 : 768); u.nt = br == 0 ? 4 : 8; u.a = (const char*)(ar + 1024 + koff); u.b = (const char*)(brow + 3072 + koff); }
        return true; } };
}

DEV int win_orig_col(int n) {
    if (n >= 3072) return n < 4608 ? (n - 3072 + 2304) : n;
    const int head = n >> 6, p = n & 63; const bool rp = (head < 24) || (head >= 36 && head < 46);
    const int d = rp ? ((p & 4) ? 32 + 4 * (p >> 3) + (p & 3) : 4 * (p >> 3) + (p & 3)) : p;
    return ((n < 2304) ? head * 64 : 3840 + (head - 36) * 64) + d;
}
struct WPrep { const float *w_in, *wba, *wbb, *wbc, *w_out, *peer_wq; bf16_t *WinT, *WmT, *WoutT, *WqT; };
DEV void nb_wprep(int vb, int t, unsigned char* sm, const WPrep& q) {
    const int l = vb / 3008; int r = vb - l * 3008; const float* W; int ldw; bf16_t* Wt; int ldt, koff = 0, ntk = 16, mode = 0, nsub = 0;
    if (r < 1920) { W = q.w_in + (size_t)l * 1024 * 7680; ldw = 7680; mode = 1;
        if (r < 72 * 16) { Wt = q.WinT + (size_t)l * 7680 * 1024; ldt = 1024; }
        else { const int br = (r / 16 - 72) / 16; Wt = q.WmT + (size_t)l * 1024 * WMW_; ldt = WMW_; koff = br * 1024; nsub = 4608 + br * 1024; } }
    else if (r < 1984) { r -= 1920; W = q.wba + (size_t)l * 256 * 1024; ldw = 1024; Wt = q.WmT + (size_t)l * 1024 * WMW_; ldt = WMW_; koff = 3072; ntk = 4; }
    else if (r < 2112) { r -= 1984; W = q.wbb + (size_t)l * 512 * 1024; ldw = 1024; Wt = q.WmT + (size_t)l * 1024 * WMW_; ldt = WMW_; koff = 3072 + 256; ntk = 8; }
    else if (r < 2240) { r -= 2112; W = q.wbc + (size_t)l * 512 * 1024; ldw = 1024; Wt = q.WmT + (size_t)l * 1024 * WMW_; ldt = WMW_; koff = 3072 + 768; ntk = 8; }
    else if (r < 2496) { r -= 2240; W = q.w_out + (size_t)l * 1024 * 1024; ldw = 1024; Wt = q.WoutT + (size_t)l * 1024 * 1024; ldt = 1024; }
    else { r -= 2496; W = q.peer_wq + (size_t)l * 1024 * 2048; ldw = 2048; Wt = q.WqT + (size_t)l * 2048 * 1024; ldt = 1024; }
    const int n0 = (r / ntk) * 64, k0 = (r % ntk) * 64; const int c0 = mode ? (win_orig_col(n0) & ~63) : n0;
    bf16_t* tile = (bf16_t*)sm;
    { const int kk = t >> 2, cs = (t & 3) * 16; const float* src = W + (size_t)(k0 + kk) * ldw + c0 + cs;
#pragma unroll
        for (int i = 0; i < 16; i += 4) { const float4 v = *(const float4*)(src + i); tile[kk * 66 + cs + i] = f2bf(v.x); tile[kk * 66 + cs + i + 1] = f2bf(v.y); tile[kk * 66 + cs + i + 2] = f2bf(v.z); tile[kk * 66 + cs + i + 3] = f2bf(v.w); } }
    __syncthreads();
    { const int nn = t >> 2, ks = (t & 3) * 16; const int dl = mode ? (win_orig_col(n0 + nn) - c0) : nn; bf16_t* dst = Wt + (size_t)(n0 + nn - nsub) * ldt + koff + k0 + ks;
        unsigned w[8];
#pragma unroll
        for (int i = 0; i < 8; ++i) w[i] = (unsigned)tile[(ks + 2 * i) * 66 + dl] | ((unsigned)tile[(ks + 2 * i + 1) * 66 + dl] << 16);
        *(u32x4*)dst = (u32x4){w[0], w[1], w[2], w[3]}; *(u32x4*)(dst + 8) = (u32x4){w[4], w[5], w[6], w[7]}; }
}

namespace hy {
constexpr int ZS = 2064;
constexpr int G0_OFF = 0, G1_OFF = 8192, Z0_OFF = 16384, Z1_OFF = Z0_OFF + 16 * ZS * 2, LDS_END = Z1_OFF + 16 * ZS * 2;
DEV bf16x8 load_frag(LAS const unsigned char* lane_base, int d) {
    const LAS unsigned* p = (const LAS unsigned*)(lane_base + 32 * d); u32x4 w; w.x = p[0]; w.y = p[1]; w.z = p[2]; w.w = p[3];
    return __builtin_bit_cast(bf16x8, w);
}
DEV void load_filter(LAS unsigned char* lds, const bf16_t* g, int tid) {
    const u32x4 c = *(const u32x4*)(g + tid * 8); const unsigned nx = (tid < 511) ? (unsigned)g[tid * 8 + 8] : 0u;
    *(LAS u32x4*)(lds + G0_OFF + tid * 16) = c;
    u32x4 s; s.x = (c.x >> 16) | (c.y << 16); s.y = (c.y >> 16) | (c.z << 16); s.z = (c.z >> 16) | (c.w << 16); s.w = (c.w >> 16) | (nx << 16);
    *(LAS u32x4*)(lds + G1_OFF + tid * 16) = s;
}
DEV float bflo(unsigned w) { return __uint_as_float(w << 16); }
DEV float bfhi(unsigned w) { return __uint_as_float(w & 0xffff0000u); }
DEV void conv_rows(LAS const unsigned char* lds, int zoff, int w, int lane, f32x4 (&D)[16]) {
    const int r = lane & 15, q = lane >> 4;
    LAS const unsigned char* abase = lds + ((r & 1) ? (G0_OFF + 2 * (8 * q - r + 2047)) : (G1_OFF + 2 * (8 * q - r + 2046)));
    LAS const unsigned char* bbase = lds + zoff + (r * ZS + 8 * q) * 2;
    bf16x8 ring[16];
#pragma unroll
    for (int rb = 0; rb < 16; ++rb) D[rb] = (f32x4){0.f, 0.f, 0.f, 0.f};
#pragma unroll
    for (int rb = 2; rb < 16; ++rb) ring[rb] = load_frag(abase, -16 * w - rb);
#pragma unroll 1
    for (int jb0 = 0; jb0 < 64; jb0 += 8) {
#pragma unroll
        for (int u = 0; u < 8; ++u) { const int jb = jb0 + u;
            ring[(16 - 2 * u) & 15] = load_frag(abase, 2 * jb - 16 * w);
            ring[(17 - 2 * u) & 15] = load_frag(abase, 2 * jb - 16 * w - 1);
            const bf16x8 bf = *(const LAS bf16x8*)(bbase + 64 * jb);
#pragma unroll
            for (int rb = 0; rb < 16; ++rb) D[rb] = __builtin_amdgcn_mfma_f32_16x16x32_bf16(ring[(rb - 2 * u) & 15], bf, D[rb], 0, 0, 0);
        }
    }
}
DEV void sconv4(const bf16_t* in, int i, float w0, float w1, float w2, float cb, float (&o)[4]) {
    const u32x2 v = *(const u32x2*)(in + i); const float pm = (i > 0) ? bf2f(in[i - 1]) : 0.f, pn = (i + 4 < 2048) ? bf2f(in[i + 4]) : 0.f;
    const float x0 = bflo(v.x), x1 = bfhi(v.x), x2 = bflo(v.y), x3 = bfhi(v.y);
    o[0] = cb + w0 * pm + w1 * x0 + w2 * x1; o[1] = cb + w0 * x0 + w1 * x1 + w2 * x2; o[2] = cb + w0 * x1 + w1 * x2 + w2 * x3; o[3] = cb + w0 * x2 + w1 * x3 + w2 * pn;
}
DEV void hyena_phase(LAS unsigned char* lds, bf16_t* hyT, const bf16_t* Gr_l, const float* conv_w, const float* conv_b, const float* hy_bias, int G, int cblk, int wv) {
    int wv_ = wv, ln_; asm volatile("v_mbcnt_lo_u32_b32 %1, -1, 0\n\tv_mbcnt_hi_u32_b32 %1, -1, %1" : "+s"(wv_), "=v"(ln_)); int tid_ = (wv_ << 6) | ln_;
    const int tid = tid_, w = __builtin_amdgcn_readfirstlane(tid >> 6), lane = tid & 63, q = lane >> 4, b = lane & 15;
#pragma unroll 1
    for (int c = cblk; c < 512; c += G) {
        __syncthreads();
        load_filter(lds, Gr_l + (size_t)c * 4096, tid);
        { const float w0 = conv_w[c], w1 = conv_w[1536 + c], w2 = conv_w[3072 + c], cb = conv_b[c]; const bf16_t* row = hyT + (size_t)c * T_;
#pragma unroll 2
            for (int k = 0; k < 8; ++k) { const int pos = (k * 512 + tid) * 8; const int s = pos & 2047, bb = pos >> 11;
                const u32x4 v = *(const u32x4*)(row + pos); const float pm = (s > 0) ? bf2f(row[pos - 1]) : 0.f, pn = (s + 8 < 2048) ? bf2f(row[pos + 8]) : 0.f;
                const float x[10] = {pm, bflo(v.x), bfhi(v.x), bflo(v.y), bfhi(v.y), bflo(v.z), bfhi(v.z), bflo(v.w), bfhi(v.w), pn};
                float z[8];
#pragma unroll
                for (int e = 0; e < 8; ++e) z[e] = cb + w0 * x[e] + w1 * x[e + 1] + w2 * x[e + 2];
                u32x4 o; o.x = pg8::cvt_pk_bf16(z[0], z[1]); o.y = pg8::cvt_pk_bf16(z[2], z[3]); o.z = pg8::cvt_pk_bf16(z[4], z[5]); o.w = pg8::cvt_pk_bf16(z[6], z[7]);
                *(LAS u32x4*)(lds + Z0_OFF + (bb * ZS + s) * 2) = o; } }
        __syncthreads();
        f32x4 D[16];
        conv_rows(lds, Z0_OFF, w, lane, D);
        { const int xc = 512 + c; const float w0 = conv_w[xc], w1 = conv_w[1536 + xc], w2 = conv_w[3072 + xc], cb = conv_b[xc], bias = hy_bias[c]; const bf16_t* xin = hyT + (size_t)xc * T_ + b * 2048;
#pragma unroll
            for (int rb = 0; rb < 16; ++rb) { const int i = 256 * w + 16 * rb + 4 * q; float xv[4]; sconv4(xin, i, w0, w1, w2, cb, xv);
                const u32x2 zq = *(const LAS u32x2*)(lds + Z0_OFF + (b * ZS + i) * 2); const float zv[4] = {bflo(zq.x), bfhi(zq.x), bflo(zq.y), bfhi(zq.y)};
                float o[4];
#pragma unroll
                for (int e = 0; e < 4; ++e) o[e] = xv[e] * (D[rb][e] + bias * zv[e]);
                u32x2 pk; pk.x = pg8::cvt_pk_bf16(o[0], o[1]); pk.y = pg8::cvt_pk_bf16(o[2], o[3]);
                *(LAS u32x2*)(lds + Z1_OFF + (b * ZS + i) * 2) = pk; } }
        __syncthreads();
        load_filter(lds, Gr_l + (size_t)(512 + c) * 4096, tid);
        __syncthreads();
        conv_rows(lds, Z1_OFF, w, lane, D);
        { const int xc = 1024 + c; const float w0 = conv_w[xc], w1 = conv_w[1536 + xc], w2 = conv_w[3072 + xc], cb = conv_b[xc], bias = hy_bias[512 + c]; const bf16_t* xin = hyT + (size_t)xc * T_ + b * 2048;
            bf16_t* yout = hyT + (size_t)c * T_ + b * 2048;
#pragma unroll
            for (int rb = 0; rb < 16; ++rb) { const int i = 256 * w + 16 * rb + 4 * q; float xv[4]; sconv4(xin, i, w0, w1, w2, cb, xv);
                const u32x2 zq = *(const LAS u32x2*)(lds + Z1_OFF + (b * ZS + i) * 2); const float zv[4] = {bflo(zq.x), bfhi(zq.x), bflo(zq.y), bfhi(zq.y)};
                float o[4];
#pragma unroll
                for (int e = 0; e < 4; ++e) o[e] = xv[e] * (D[rb][e] + bias * zv[e]);
                u32x2 pk; pk.x = pg8::cvt_pk_bf16(o[0], o[1]); pk.y = pg8::cvt_pk_bf16(o[2], o[3]);
                *(u32x2*)(yout + i) = pk; } }
    }
    __syncthreads();
}
}

namespace peer {
DEV float wave_sum(float v, int lane) {
#pragma unroll
    for (int off = 32; off > 0; off >>= 1) v += xor_f(v, off, lane);
    return v;
}
DEV float wave_max(float v, int lane) {
#pragma unroll
    for (int off = 32; off > 0; off >>= 1) v = fmaxf(v, xor_f(v, off, lane));
    return v;
}
DEV unsigned pk4_fp8(float a, float b, float c, float d) { int w = __builtin_amdgcn_cvt_pk_fp8_f32(a, b, 0, false); w = __builtin_amdgcn_cvt_pk_fp8_f32(c, d, w, true); return (unsigned)w; }
DEV void nb_quant_tables(int vb, int t, const float* __restrict__ pu, const float* __restrict__ pv, unsigned char* __restrict__ U8, unsigned char* __restrict__ V4, float* __restrict__ sinv) {
    const int row = vb * 4 + (t >> 6), lane = t & 63; const float* src = (row < 16384) ? pu + (size_t)row * 1024 : pv + (size_t)(row - 16384) * 1024;
    const float4 a = *(const float4*)(src + 16 * lane), b = *(const float4*)(src + 16 * lane + 4), c = *(const float4*)(src + 16 * lane + 8), d = *(const float4*)(src + 16 * lane + 12);
    float mx = fmaxf(fmaxf(fmaxf(fabsf(a.x), fabsf(a.y)), fmaxf(fabsf(a.z), fabsf(a.w))), fmaxf(fmaxf(fabsf(b.x), fabsf(b.y)), fmaxf(fabsf(b.z), fabsf(b.w))));
    mx = fmaxf(mx, fmaxf(fmaxf(fmaxf(fabsf(c.x), fabsf(c.y)), fmaxf(fabsf(c.z), fabsf(c.w))), fmaxf(fmaxf(fabsf(d.x), fabsf(d.y)), fmaxf(fabsf(d.z), fabsf(d.w)))));
    mx = wave_max(mx, lane);
    {
        const float sc = (mx > 0.f) ? 6.f / mx : 0.f; unsigned w0 = 0u, w1 = 0u; const bool sw = false;
        w0 = __builtin_amdgcn_cvt_scalef32_pk_fp4_f32(w0, (sw ? a.y : a.x) * sc, (sw ? a.x : a.y) * sc, 1.0f, 0); w0 = __builtin_amdgcn_cvt_scalef32_pk_fp4_f32(w0, (sw ? a.w : a.z) * sc, (sw ? a.z : a.w) * sc, 1.0f, 1);
        w0 = __builtin_amdgcn_cvt_scalef32_pk_fp4_f32(w0, (sw ? b.y : b.x) * sc, (sw ? b.x : b.y) * sc, 1.0f, 2); w0 = __builtin_amdgcn_cvt_scalef32_pk_fp4_f32(w0, (sw ? b.w : b.z) * sc, (sw ? b.z : b.w) * sc, 1.0f, 3);
        w1 = __builtin_amdgcn_cvt_scalef32_pk_fp4_f32(w1, (sw ? c.y : c.x) * sc, (sw ? c.x : c.y) * sc, 1.0f, 0); w1 = __builtin_amdgcn_cvt_scalef32_pk_fp4_f32(w1, (sw ? c.w : c.z) * sc, (sw ? c.z : c.w) * sc, 1.0f, 1);
        w1 = __builtin_amdgcn_cvt_scalef32_pk_fp4_f32(w1, (sw ? d.y : d.x) * sc, (sw ? d.x : d.y) * sc, 1.0f, 2); w1 = __builtin_amdgcn_cvt_scalef32_pk_fp4_f32(w1, (sw ? d.w : d.z) * sc, (sw ? d.z : d.w) * sc, 1.0f, 3);
        unsigned char* dst = (row < 16384) ? U8 + (size_t)row * 512 : V4 + (size_t)(row - 16384) * 512;
        *(u32x2*)(dst + 8 * lane) = (u32x2){w0, w1};
        if (lane == 0) sinv[row] = (mx > 0.f) ? mx * (1.f / 6.f) : 0.f;
    }
}
DEV void peer_phase(LAS unsigned char* lds, float* xio, const float* ada_l, const int* __restrict__ eidx, const float* __restrict__ egate, const unsigned char* __restrict__ U8, const unsigned char* __restrict__ V4,
                    const float* __restrict__ sinv, const float* __restrict__ g, const float* __restrict__ bta, const float* ada_next, bf16_t* UY, int G, int cblk, int wv) {
    int wv_ = wv, ln_; asm volatile("v_mbcnt_lo_u32_b32 %1, -1, 0\n\tv_mbcnt_hi_u32_b32 %1, -1, %1" : "+s"(wv_), "=v"(ln_)); int tid_ = (wv_ << 6) | ln_;
    const int tid = tid_, w = __builtin_amdgcn_readfirstlane(tid >> 6), lane = tid & 63;
    LAS unsigned char* urow_l = lds + w * 3072; LAS int* E_l = (LAS int*)(urow_l + 1024); LAS float* W_l = (LAS float*)(urow_l + 1536); LAS float* SU_l = (LAS float*)(urow_l + 2048); LAS float* SV_l = (LAS float*)(urow_l + 2560);
#define PEER_SB __builtin_amdgcn_sched_barrier(0)
#define PEER_ISSUE_U(buf, gi) do { const int e_ = E_l[(gi) * 16 + n]; const unsigned char* ur_ = U8 + (size_t)e_ * 512 + 16 * q; _Pragma("unroll") for (int k2 = 0; k2 < 8; ++k2) buf[k2] = *(const u32x4*)(ur_ + 64 * k2); } while (0)
#define PEER_ISSUE_V(buf, gi) do { _Pragma("unroll") for (int n2 = 0; n2 < 8; ++n2) { const int e_ = E_l[(gi) * 16 + 2 * n2 + hh]; buf[n2] = *(const u32x4*)(V4 + (size_t)e_ * 512 + 16 * r32); } } while (0)
#define PEER_COMP_U(buf) do { _Pragma("unroll") for (int k2 = 0; k2 < 8; ++k2) { const u32x4 bw = buf[k2]; const u32x4 alo = *(const LAS u32x4*)(urow_l + 128 * k2 + 16 * q), ahi = *(const LAS u32x4*)(urow_l + 128 * k2 + 64 + 16 * q);     \
            const i32x8 av = (i32x8){(int)alo.x, (int)alo.y, (int)alo.z, (int)alo.w, (int)ahi.x, (int)ahi.y, (int)ahi.z, (int)ahi.w}; const i32x8 bv = (i32x8){(int)bw.x, (int)bw.y, (int)bw.z, (int)bw.w, 0, 0, 0, 0}; \
            acc = __builtin_amdgcn_mfma_scale_f32_16x16x128_f8f6f4(av, bv, acc, 0  , 4  , 0, 0x7F7F7F7F, 0, 0x7F7F7F7F); } } while (0)
#define PEER_UNPK(wd, base) do { const f32x2 p0_ = __builtin_amdgcn_cvt_scalef32_pk_f32_fp4((wd), 1.0f, 0), p1_ = __builtin_amdgcn_cvt_scalef32_pk_f32_fp4((wd), 1.0f, 1), p2_ = __builtin_amdgcn_cvt_scalef32_pk_f32_fp4((wd), 1.0f, 2), p3_ = __builtin_amdgcn_cvt_scalef32_pk_f32_fp4((wd), 1.0f, 3); \
            o[base + 0] += wt * p0_[0]; o[base + 1] += wt * p0_[1]; o[base + 2] += wt * p1_[0]; o[base + 3] += wt * p1_[1]; o[base + 4] += wt * p2_[0]; o[base + 5] += wt * p2_[1]; o[base + 6] += wt * p3_[0]; o[base + 7] += wt * p3_[1]; } while (0)
#define PEER_COMP_V(buf, gi) do { _Pragma("unroll") for (int n2 = 0; n2 < 8; ++n2) { const float wt = W_l[(gi) * 16 + 2 * n2 + hh]; u32x4 v = buf[n2]; \
              \
            asm volatile("" : "+v"(v.x), "+v"(v.y), "+v"(v.z), "+v"(v.w), "+v"(o[0]), "+v"(o[1]), "+v"(o[2]), "+v"(o[3]), "+v"(o[4]), "+v"(o[5]), "+v"(o[6]), "+v"(o[7]), "+v"(o[8]), "+v"(o[9]), "+v"(o[10])); asm volatile("" : "+v"(o[11]), "+v"(o[12]), "+v"(o[13]), "+v"(o[14]), "+v"(o[15]), "+v"(o[16]), "+v"(o[17]), "+v"(o[18]), "+v"(o[19]), "+v"(o[20]), "+v"(o[21])); asm volatile("" : "+v"(o[22]), "+v"(o[23]), "+v"(o[24]), "+v"(o[25]), "+v"(o[26]), "+v"(o[27]), "+v"(o[28]), "+v"(o[29]), "+v"(o[30]), "+v"(o[31])); \
            PEER_UNPK(v.x, 0); PEER_UNPK(v.y, 8); PEER_UNPK(v.z, 16); PEER_UNPK(v.w, 24); } } while (0)
#pragma unroll 1
    for (int tok = cblk * 8 + w; tok < T_; tok += G * 8) {
        int lane_o = lane; asm volatile("" : "+v"(lane_o));
        const int q = lane_o >> 4, n = lane_o & 15, r32 = lane_o & 31, hh = lane_o >> 5; int d0 = 32 * r32 + 16 * hh;
        const float* a = ada_l + (size_t)(tok >> 11) * 6144; float* xr = xio + (size_t)tok * 1024 + d0;
        float stinv;
        {
            const int e0 = eidx[(size_t)tok * 128 + lane_o], e1 = eidx[(size_t)tok * 128 + 64 + lane_o];
            const float g0 = egate[(size_t)tok * 128 + lane_o], g1 = egate[(size_t)tok * 128 + 64 + lane_o];
            float x1[16];
#pragma unroll
            for (int j = 0; j < 16; j += 4) { const float4 v = *(const float4*)(xr + j); x1[j] = v.x; x1[j + 1] = v.y; x1[j + 2] = v.z; x1[j + 3] = v.w; }
            E_l[lane_o] = e0; E_l[64 + lane_o] = e1; W_l[lane_o] = g0; W_l[64 + lane_o] = g1;
            SU_l[lane_o] = sinv[e0]; SU_l[64 + lane_o] = sinv[e1]; SV_l[lane_o] = sinv[16384 + e0]; SV_l[64 + lane_o] = sinv[16384 + e1];
            float u[16]; float um = 0.f;
#pragma unroll
            for (int j = 0; j < 16; j += 4) { const float4 sc = *(const float4*)(a + 4096 + d0 + j), sh = *(const float4*)(a + 3072 + d0 + j);
                u[j] = x1[j] * (1.f + sc.x) + sh.x; u[j + 1] = x1[j + 1] * (1.f + sc.y) + sh.y; u[j + 2] = x1[j + 2] * (1.f + sc.z) + sh.z; u[j + 3] = x1[j + 3] * (1.f + sc.w) + sh.w;
                um = fmaxf(um, fmaxf(fmaxf(fabsf(u[j]), fabsf(u[j + 1])), fmaxf(fabsf(u[j + 2]), fabsf(u[j + 3])))); }
            um = wave_max(um, lane_o); const float st = (um > 0.f) ? 224.f / um : 1.f; stinv = (um > 0.f) ? um * (1.f / 224.f) : 1.f;
            u32x4 pq; pq.x = pk4_fp8(u[0] * st, u[1] * st, u[2] * st, u[3] * st); pq.y = pk4_fp8(u[4] * st, u[5] * st, u[6] * st, u[7] * st);
            pq.z = pk4_fp8(u[8] * st, u[9] * st, u[10] * st, u[11] * st); pq.w = pk4_fp8(u[12] * st, u[13] * st, u[14] * st, u[15] * st);
            *(LAS u32x4*)(urow_l + d0) = pq; }
        asm volatile("s_waitcnt lgkmcnt(0)" ::: "memory");
        u32x4 bufA[8], bufB[8];
        PEER_ISSUE_U(bufA, 0); PEER_SB;
#define PEER_FIN_U(gi) do { const float ds_ = acc[0] * (SU_l[(gi) * 16 + n] * stinv); const float wv_ = W_l[(gi) * 16 + n] * 0.5f * ds_ * (1.f + erff(ds_ * 0.70710678118654752f)) * SV_l[(gi) * 16 + n]; if (q == 0) W_l[(gi) * 16 + n] = wv_; } while (0)
#pragma unroll 1
        for (int gi = 0; gi < 8; gi += 2) { f32x4 acc = (f32x4){0.f, 0.f, 0.f, 0.f};
            PEER_ISSUE_U(bufB, gi + 1); PEER_SB; PEER_COMP_U(bufA); PEER_FIN_U(gi); PEER_SB;
            if (gi < 6) PEER_ISSUE_U(bufA, gi + 2); else PEER_ISSUE_V(bufA, 0);
            PEER_SB; acc = (f32x4){0.f, 0.f, 0.f, 0.f}; PEER_COMP_U(bufB); PEER_FIN_U(gi + 1); PEER_SB; }
#undef PEER_FIN_U
        asm volatile("s_waitcnt lgkmcnt(0)" ::: "memory");
        float o32[32];
#pragma unroll
        for (int j = 0; j < 32; ++j) o32[j] = 0.f;
        { float (&o)[32] = o32;
#pragma unroll 1
        for (int gi = 0; gi < 8; gi += 2) {
            PEER_ISSUE_V(bufB, gi + 1); PEER_SB; PEER_COMP_V(bufA, gi); PEER_SB;
            if (gi < 6) PEER_ISSUE_V(bufA, gi + 2);
            PEER_SB; PEER_COMP_V(bufB, gi + 1); PEER_SB; } }
        asm volatile("" : "+v"(lane_o)); d0 = 32 * (lane_o & 31) + 16 * (lane_o >> 5); xr = xio + (size_t)tok * 1024 + d0;
        const unsigned hm = 0u - (unsigned)(lane_o >> 5);
        float o[16];
#pragma unroll
        for (int j = 0; j < 16; ++j) { const float lo_ = o32[j], hi_ = o32[16 + j];
            const float keep = __uint_as_float((__float_as_uint(lo_) & ~hm) | (__float_as_uint(hi_) & hm)), send = __uint_as_float((__float_as_uint(hi_) & ~hm) | (__float_as_uint(lo_) & hm));
            o[j] = keep + xor_f(send, 32, lane_o); }
        float hv[16]; float s = 0.f;
#pragma unroll
        for (int j = 0; j < 16; j += 4) { const float4 g2 = *(const float4*)(a + 5120 + d0 + j); const float4 xv = *(const float4*)(xr + j);
            hv[j] = ALPHA_ * xv.x + g2.x * o[j]; hv[j + 1] = ALPHA_ * xv.y + g2.y * o[j + 1]; hv[j + 2] = ALPHA_ * xv.z + g2.z * o[j + 2]; hv[j + 3] = ALPHA_ * xv.w + g2.w * o[j + 3];
            s += (hv[j] + hv[j + 1]) + (hv[j + 2] + hv[j + 3]); }
        const float mu = wave_sum(s, lane_o) * (1.f / 1024.f); float qq = 0.f;
#pragma unroll
        for (int j = 0; j < 16; ++j) { const float dd = hv[j] - mu; qq += dd * dd; }
        const float rstd = rsqrtf(wave_sum(qq, lane_o) * (1.f / 1024.f) + LN_EPS_);
        const float* an = ada_next ? ada_next + (size_t)(tok >> 11) * 6144 : nullptr;
        float y[16];
#pragma unroll
        for (int j = 0; j < 16; j += 4) { const float4 gg = *(const float4*)(g + d0 + j), bb = *(const float4*)(bta + d0 + j);
            y[j] = (hv[j] - mu) * rstd * gg.x + bb.x; y[j + 1] = (hv[j + 1] - mu) * rstd * gg.y + bb.y; y[j + 2] = (hv[j + 2] - mu) * rstd * gg.z + bb.z; y[j + 3] = (hv[j + 3] - mu) * rstd * gg.w + bb.w;
            *(float4*)(xr + j) = make_float4(y[j], y[j + 1], y[j + 2], y[j + 3]); }
        if (an) { float uu[16];
#pragma unroll
            for (int j = 0; j < 16; j += 4) { const float4 sc = *(const float4*)(an + 1024 + d0 + j), sh = *(const float4*)(an + d0 + j);
                uu[j] = y[j] * (1.f + sc.x) + sh.x; uu[j + 1] = y[j + 1] * (1.f + sc.y) + sh.y; uu[j + 2] = y[j + 2] * (1.f + sc.z) + sh.z; uu[j + 3] = y[j + 3] * (1.f + sc.w) + sh.w; }
            u32x4 p0, p1; p0.x = pg8::cvt_pk_bf16(uu[0], uu[1]); p0.y = pg8::cvt_pk_bf16(uu[2], uu[3]); p0.z = pg8::cvt_pk_bf16(uu[4], uu[5]); p0.w = pg8::cvt_pk_bf16(uu[6], uu[7]);
            p1.x = pg8::cvt_pk_bf16(uu[8], uu[9]); p1.y = pg8::cvt_pk_bf16(uu[10], uu[11]); p1.z = pg8::cvt_pk_bf16(uu[12], uu[13]); p1.w = pg8::cvt_pk_bf16(uu[14], uu[15]);
            bf16_t* up = UY + (size_t)tok * UYW_ + d0; *(u32x4*)up = p0; *(u32x4*)(up + 8) = p1; }
        asm volatile("s_waitcnt lgkmcnt(0)" ::: "memory");
    }
#undef PEER_SB
#undef PEER_ISSUE_U
#undef PEER_ISSUE_V
#undef PEER_COMP_U
#undef PEER_COMP_V
#undef PEER_UNPK
    __syncthreads();
}
}

namespace tk {
typedef float f32x16 __attribute__((ext_vector_type(16)));
constexpr int KROW = 272;
DEV unsigned sortable(float v) { const unsigned u = __float_as_uint(v); return u ^ ((unsigned)((int)u >> 31) | 0x80000000u); }
DEV float unsortable(unsigned k) { return __uint_as_float(k ^ ((~(unsigned)((int)k >> 31)) | 0x80000000u)); }
DEV unsigned umax_(unsigned a, unsigned b) { return a > b ? a : b; }
DEV unsigned umin_(unsigned a, unsigned b) { return a < b ? a : b; }
#define CE(x, y) { const unsigned hi_ = umax_(a[x], a[y]), lo_ = umin_(a[x], a[y]); a[x] = hi_; a[y] = lo_; }
DEV void sort16(unsigned (&a)[16]) {
    CE(0, 1); CE(3, 2); CE(4, 5); CE(7, 6); CE(8, 9); CE(11, 10); CE(12, 13); CE(15, 14); CE(0, 2); CE(1, 3); CE(6, 4); CE(7, 5); CE(8, 10); CE(9, 11); CE(14, 12); CE(15, 13); CE(0, 1); CE(2, 3); CE(5, 4); CE(7, 6); CE(8, 9); CE(10, 11); CE(13, 12); CE(15, 14); CE(0, 4); CE(1, 5); CE(2, 6); CE(3, 7); CE(12, 8); CE(13, 9); CE(14, 10); CE(15, 11); CE(0, 2); CE(1, 3); CE(4, 6); CE(5, 7); CE(10, 8); CE(11, 9); CE(14, 12); CE(15, 13); CE(0, 1); CE(2, 3); CE(4, 5); CE(6, 7); CE(9, 8); CE(11, 10); CE(13, 12); CE(15, 14); CE(0, 8); CE(1, 9); CE(2, 10); CE(3, 11); CE(4, 12); CE(5, 13); CE(6, 14); CE(7, 15); CE(0, 4); CE(1, 5); CE(2, 6); CE(3, 7); CE(8, 12); CE(9, 13); CE(10, 14); CE(11, 15); CE(0, 2); CE(1, 3); CE(4, 6); CE(5, 7); CE(8, 10); CE(9, 11); CE(12, 14); CE(13, 15); CE(0, 1); CE(2, 3); CE(4, 5); CE(6, 7); CE(8, 9); CE(10, 11); CE(12, 13); CE(14, 15);
}
DEV void bmerge16(unsigned (&a)[16]) {
    CE(0, 8); CE(1, 9); CE(2, 10); CE(3, 11); CE(4, 12); CE(5, 13); CE(6, 14); CE(7, 15); CE(0, 4); CE(1, 5); CE(2, 6); CE(3, 7); CE(8, 12); CE(9, 13); CE(10, 14); CE(11, 15); CE(0, 2); CE(1, 3); CE(4, 6); CE(5, 7); CE(8, 10); CE(9, 11); CE(12, 14); CE(13, 15); CE(0, 1); CE(2, 3); CE(4, 5); CE(6, 7); CE(8, 9); CE(10, 11); CE(12, 13); CE(14, 15);
}
#undef CE
DEV void top_merge(unsigned (&a)[16], const unsigned (&b)[16]) {
#pragma unroll
    for (int i = 0; i < 16; ++i) a[i] = umax_(a[i], b[15 - i]);
    bmerge16(a);
}
DEV void xlane_merge(unsigned (&a)[16], int lane) {
    unsigned b[16];
#pragma unroll
    for (int i = 0; i < 16; ++i) b[i] = (unsigned)xor_i((int)a[i], 32, lane);
    top_merge(a, b);
}
DEV unsigned lookup_idx(unsigned long long lo, unsigned long long hi, int a) { const unsigned long long wv = (a < 8) ? lo : hi; return (unsigned)(wv >> ((a & 7) * 8)) & 127u; }
DEV unsigned blendu(unsigned m, unsigned a, unsigned b) { return (a & ~m) | (b & m); }
DEV float blendf(unsigned m, float a, float b) { return __uint_as_float((__float_as_uint(a) & ~m) | (__float_as_uint(b) & m)); }

DEV void topk_phase(LAS unsigned char* lds, const bf16_t* __restrict__ Q2, const float* __restrict__ keys_l, int* __restrict__ eidx, float* __restrict__ egate, int G, int cblk, int wv) {
    int wv_ = wv, ln_; asm volatile("v_mbcnt_lo_u32_b32 %1, -1, 0\n\tv_mbcnt_hi_u32_b32 %1, -1, %1" : "+s"(wv_), "=v"(ln_)); int tid_ = (wv_ << 6) | ln_;
    const int tid = tid_, w = __builtin_amdgcn_readfirstlane(tid >> 6), lane = tid & 63, tl = lane & 31, hh = lane >> 5;
    asm volatile("" : "+s"(G));
    const bool by_head = (G & 7) == 0;
#pragma unroll 1
    for (int h = 0; h < 8; ++h) {
        if (by_head && h != (cblk & 7)) continue;
        __syncthreads();
        {
            const int r = tid >> 1, c0 = (tid & 1) * 64; const float* src = keys_l + ((size_t)h * 256 + r) * 128 + c0; LAS unsigned char* dst = lds + r * KROW + c0 * 2;
#pragma unroll
            for (int j = 0; j < 64; j += 8) { const float4 a = *(const float4*)(src + j), b = *(const float4*)(src + j + 4);
                u32x4 o; o.x = pg8::cvt_pk_bf16(a.x, a.y); o.y = pg8::cvt_pk_bf16(a.z, a.w); o.z = pg8::cvt_pk_bf16(b.x, b.y); o.w = pg8::cvt_pk_bf16(b.z, b.w); *(LAS u32x4*)(dst + j * 2) = o; }
        }
        __syncthreads();
        const int first = by_head ? (cblk >> 3) * 8 + w : cblk * 8 + w, stride = by_head ? (G >> 3) * 8 : G * 8;
#pragma unroll 1
        for (int blk = first; blk < T_ / 32; blk += stride) {
            const int tok = blk * 32 + tl; const bf16_t* qrow = Q2 + (size_t)tok * 2048 + h * 256 + 8 * hh;
            unsigned L[2][16];
#pragma unroll
            for (int p = 0; p < 2; ++p) {
                bf16x8 bq[8];
#pragma unroll
                for (int ks = 0; ks < 8; ++ks) bq[ks] = *(const bf16x8*)(qrow + p * 128 + 16 * ks);
#pragma unroll
                for (int t = 0; t < 4; ++t) {
                    f32x16 acc;
#pragma unroll
                    for (int e = 0; e < 16; ++e) acc[e] = 0.f;
#pragma unroll
                    for (int ks = 0; ks < 8; ++ks) { const bf16x8 ak = *(const LAS bf16x8*)(lds + (p * 128 + 32 * t + tl) * KROW + (16 * ks + 8 * hh) * 2);
                        acc = __builtin_amdgcn_mfma_f32_32x32x16_bf16(ak, bq[ks], acc, 0, 0, 0); }
                    unsigned K[16];
#pragma unroll
                    for (int e = 0; e < 16; ++e) K[e] = (sortable(acc[e]) & ~127u) | (unsigned)((127 - 32 * t - (e & 3) - 8 * (e >> 2)) - 4 * hh);
                    sort16(K);
                    if (t == 0) {
#pragma unroll
                        for (int e = 0; e < 16; ++e) L[p][e] = K[e];
                    } else top_merge(L[p], K);
                    __builtin_amdgcn_sched_barrier(0);
                }
                xlane_merge(L[p], lane);
                __builtin_amdgcn_sched_barrier(0);
            }
            float f1[16], f2[16];
#pragma unroll
            for (int e = 0; e < 16; ++e) { f1[e] = unsortable(L[0][e] & ~127u); f2[e] = unsortable(L[1][e] & ~127u); }
            unsigned hm = 0u - (unsigned)hh; asm volatile("" : "+v"(hm));
            unsigned C[2][16];
            C[0][0] = (sortable(blendf(hm, f1[0], f1[2]) + blendf(hm, f2[0], f2[1])) & ~255u) | (255u - blendu(hm, 0u, 33u));
            C[0][1] = (sortable(blendf(hm, f1[0], f1[2]) + blendf(hm, f2[1], f2[2])) & ~255u) | (255u - blendu(hm, 1u, 34u));
            C[0][2] = (sortable(blendf(hm, f1[0], f1[2]) + blendf(hm, f2[2], f2[3])) & ~255u) | (255u - blendu(hm, 2u, 35u));
            C[0][3] = (sortable(blendf(hm, f1[0], f1[2]) + blendf(hm, f2[3], f2[4])) & ~255u) | (255u - blendu(hm, 3u, 36u));
            C[0][4] = (sortable(blendf(hm, f1[0], f1[3]) + blendf(hm, f2[4], f2[0])) & ~255u) | (255u - blendu(hm, 4u, 48u));
            C[0][5] = (sortable(blendf(hm, f1[0], f1[3]) + blendf(hm, f2[5], f2[1])) & ~255u) | (255u - blendu(hm, 5u, 49u));
            C[0][6] = (sortable(blendf(hm, f1[0], f1[3]) + blendf(hm, f2[6], f2[2])) & ~255u) | (255u - blendu(hm, 6u, 50u));
            C[0][7] = (sortable(blendf(hm, f1[0], f1[3]) + blendf(hm, f2[7], f2[3])) & ~255u) | (255u - blendu(hm, 7u, 51u));
            C[0][8] = (sortable(blendf(hm, f1[0], f1[4]) + blendf(hm, f2[8], f2[0])) & ~255u) | (255u - blendu(hm, 8u, 64u));
            C[0][9] = (sortable(blendf(hm, f1[0], f1[4]) + blendf(hm, f2[9], f2[1])) & ~255u) | (255u - blendu(hm, 9u, 65u));
            C[0][10] = (sortable(blendf(hm, f1[0], f1[4]) + blendf(hm, f2[10], f2[2])) & ~255u) | (255u - blendu(hm, 10u, 66u));
            C[0][11] = (sortable(blendf(hm, f1[0], f1[5]) + blendf(hm, f2[11], f2[0])) & ~255u) | (255u - blendu(hm, 11u, 80u));
            C[0][12] = (sortable(blendf(hm, f1[0], f1[5]) + blendf(hm, f2[12], f2[1])) & ~255u) | (255u - blendu(hm, 12u, 81u));
            C[0][13] = (sortable(blendf(hm, f1[0], f1[6]) + blendf(hm, f2[13], f2[0])) & ~255u) | (255u - blendu(hm, 13u, 96u));
            C[0][14] = (sortable(blendf(hm, f1[0], f1[6]) + blendf(hm, f2[14], f2[1])) & ~255u) | (255u - blendu(hm, 14u, 97u));
            C[0][15] = (sortable(blendf(hm, f1[0], f1[7]) + blendf(hm, f2[15], f2[0])) & ~255u) | (255u - blendu(hm, 15u, 112u));
            C[1][0] = (sortable(blendf(hm, f1[1], f1[7]) + blendf(hm, f2[0], f2[1])) & ~255u) | (255u - blendu(hm, 16u, 113u));
            C[1][1] = (sortable(blendf(hm, f1[1], f1[8]) + blendf(hm, f2[1], f2[0])) & ~255u) | (255u - blendu(hm, 17u, 128u));
            C[1][2] = (sortable(blendf(hm, f1[1], f1[9]) + blendf(hm, f2[2], f2[0])) & ~255u) | (255u - blendu(hm, 18u, 144u));
            C[1][3] = (sortable(blendf(hm, f1[1], f1[10]) + blendf(hm, f2[3], f2[0])) & ~255u) | (255u - blendu(hm, 19u, 160u));
            C[1][4] = (sortable(blendf(hm, f1[1], f1[11]) + blendf(hm, f2[4], f2[0])) & ~255u) | (255u - blendu(hm, 20u, 176u));
            C[1][5] = (sortable(blendf(hm, f1[1], f1[12]) + blendf(hm, f2[5], f2[0])) & ~255u) | (255u - blendu(hm, 21u, 192u));
            C[1][6] = (sortable(blendf(hm, f1[1], f1[13]) + blendf(hm, f2[6], f2[0])) & ~255u) | (255u - blendu(hm, 22u, 208u));
            C[1][7] = (sortable(blendf(hm, f1[1], f1[14]) + blendf(hm, f2[7], f2[0])) & ~255u) | (255u - blendu(hm, 23u, 224u));
            C[1][8] = (sortable(blendf(hm, f1[2], f1[15]) + blendf(hm, f2[0], f2[0])) & ~255u) | (255u - blendu(hm, 32u, 240u));
            C[1][9] = 0u;
            C[1][10] = 0u;
            C[1][11] = 0u;
            C[1][12] = 0u;
            C[1][13] = 0u;
            C[1][14] = 0u;
            C[1][15] = 0u;
            sort16(C[0]); sort16(C[1]); top_merge(C[0], C[1]); xlane_merge(C[0], lane);
            unsigned long long p1lo = 0ull, p1hi = 0ull, p2lo = 0ull, p2hi = 0ull;
#pragma unroll
            for (int m = 0; m < 8; ++m) { p1lo |= (unsigned long long)(127u - (L[0][m] & 127u)) << (8 * m); p1hi |= (unsigned long long)(127u - (L[0][8 + m] & 127u)) << (8 * m);
                p2lo |= (unsigned long long)(127u - (L[1][m] & 127u)) << (8 * m); p2hi |= (unsigned long long)(127u - (L[1][8 + m] & 127u)) << (8 * m); }
            float val[16]; unsigned ex[16]; float sum = 0.f;
#pragma unroll
            for (int k = 0; k < 16; ++k) { const unsigned flat = 255u - (C[0][k] & 255u); const int a = (int)(flat >> 4), b = (int)(flat & 15u);
                val[k] = unsortable(C[0][k] & ~255u); ex[k] = lookup_idx(p1lo, p1hi, a) * 128u + lookup_idx(p2lo, p2hi, b); }
            const float mx = val[0];
#pragma unroll
            for (int k = 0; k < 16; ++k) { val[k] = __expf(val[k] - mx); sum += val[k]; }
            const float inv = 1.f / sum;
            int eo[8]; float go[8];
#pragma unroll
            for (int k = 0; k < 8; ++k) { eo[k] = (int)blendu(hm, ex[k], ex[8 + k]); go[k] = blendf(hm, val[k], val[8 + k]) * inv; }
            const size_t ob = ((size_t)tok * 8 + h) * 16 + 8 * hh;
            *(int4*)(eidx + ob) = make_int4(eo[0], eo[1], eo[2], eo[3]); *(int4*)(eidx + ob + 4) = make_int4(eo[4], eo[5], eo[6], eo[7]);
            *(float4*)(egate + ob) = make_float4(go[0], go[1], go[2], go[3]); *(float4*)(egate + ob + 4) = make_float4(go[4], go[5], go[6], go[7]);
        }
    }
    __syncthreads();
}
}

namespace at {
typedef float f32x16 __attribute__((ext_vector_type(16)));
constexpr int KROWB = 144, VROWB = 776, K_OFF = 0, V_OFF = 384 * KROWB, LDS_END = V_OFF + 64 * VROWB;
constexpr int N_ITEMS_A = 16 * 12 * 8, N_ITEMS_C = 16 * 2 * 16 * 2;

struct Band { int p_w, ls, R, slot_base; };
DEV void chunk(LAS const unsigned char* lds, const Band& bd, int c, const bf16x8 (&qf)[4], int tl, int hh, f32x16 (&O)[2], float& m, float& l) {
    const int kp0 = bd.p_w - bd.R + 32 * c;
    if (kp0 + 31 < 0 || kp0 >= bd.ls) return;
    const int s0 = kp0 + bd.slot_base;
    f32x16 S;
#pragma unroll
    for (int e = 0; e < 16; ++e) S[e] = 0.f;
#pragma unroll
    for (int ks = 0; ks < 4; ++ks) { const bf16x8 ak = *(const LAS bf16x8*)(lds + K_OFF + (s0 + tl) * KROWB + (16 * ks + 8 * hh) * 2); S = __builtin_amdgcn_mfma_f32_32x32x16_bf16(ak, qf[ks], S, 0, 0, 0); }
    const int dbase = (32 * c - bd.R) - tl + 4 * hh;
    const int kb = kp0 + 4 * hh;
    float cmax = -1e30f;
#pragma unroll
    for (int e = 0; e < 16; ++e) { const int ro = (e & 3) + 8 * (e >> 2); const int diff = dbase + ro, kp = kb + ro;
        const bool ok = (diff <= bd.R) && (diff >= -bd.R) && (kp >= 0) && (kp < bd.ls); S[e] = ok ? S[e] : -1e30f; cmax = fmaxf(cmax, S[e]); }
    cmax = fmaxf(cmax, xor_f(cmax, 32, tl + 32 * hh));
    const float mn = fmaxf(m, cmax), alpha = exp2f(m - mn); m = mn;
    float psum = 0.f;
#pragma unroll
    for (int e = 0; e < 16; ++e) { S[e] = exp2f(S[e] - mn); psum += S[e]; }
    l = l * alpha + psum;
#pragma unroll
    for (int e = 0; e < 16; ++e) { O[0][e] *= alpha; O[1][e] *= alpha; }
#pragma unroll
    for (int sx = 0; sx < 2; ++sx) {
        u32x4 pw; pw.x = pg8::cvt_pk_bf16(S[8 * sx + 0], S[8 * sx + 1]); pw.y = pg8::cvt_pk_bf16(S[8 * sx + 2], S[8 * sx + 3]); pw.z = pg8::cvt_pk_bf16(S[8 * sx + 4], S[8 * sx + 5]); pw.w = pg8::cvt_pk_bf16(S[8 * sx + 6], S[8 * sx + 7]);
        const bf16x8 pb = __builtin_bit_cast(bf16x8, pw);
#pragma unroll
        for (int dt = 0; dt < 2; ++dt) { LAS const unsigned char* vp = lds + V_OFF + (32 * dt + tl) * VROWB + (s0 + 16 * sx + 4 * hh) * 2;
            const u32x2 lo = *(const LAS u32x2*)vp, hi = *(const LAS u32x2*)(vp + 16); const u32x4 vw = (u32x4){lo.x, lo.y, hi.x, hi.y};
            O[dt] = __builtin_amdgcn_mfma_f32_32x32x16_bf16(__builtin_bit_cast(bf16x8, vw), pb, O[dt], 0, 0, 0); }
    }
}
DEV void attn_phase(LAS unsigned char* lds, bf16_t* P, float* lse2, bf16_t* Y, const float* sink_l, int G, int cblk, int wv) {
    int wv_ = wv, ln_; asm volatile("v_mbcnt_lo_u32_b32 %1, -1, 0\n\tv_mbcnt_hi_u32_b32 %1, -1, %1" : "+s"(wv_), "=v"(ln_)); int tid_ = (wv_ << 6) | ln_;
    const int tid = tid_, w = __builtin_amdgcn_readfirstlane(tid >> 6), lane = tid & 63, tl = lane & 31, hh = lane >> 5;
#pragma unroll 1
    for (int item = cblk; item < N_ITEMS_A + N_ITEMS_C; item += G) {
        int b, dil, ls, r, klo, nsl, R, kcol, vcol, qcol, two = 0, rp = 0, sb = 0, head = 0, isC = 0, nb = 0, qh0 = 0;
        if (item < N_ITEMS_A) { b = item / 96; const int rem = item - b * 96; head = rem >> 3; const int sub = rem & 7, g = head >> 2; R = 64;
            kcol = 768 + head * 64; vcol = 1536 + head * 64; qcol = head * 64;
            if (g == 0) { dil = 1; ls = 2048; r = 0; sb = sub; klo = 256 * sb - 64; nsl = 384; }
            else if (g == 1) { dil = 4; ls = 512; r = sub >> 1; sb = sub & 1; klo = 256 * sb - 64; nsl = 384; }
            else { dil = 16; ls = 128; r = 0; rp = sub; klo = 0; nsl = 256; two = 1; } }
        else { const int it = item - N_ITEMS_A; b = it >> 6; const int rem = it & 63; const int kvh = rem >> 5; nb = (rem & 31) >> 1; const int hp = rem & 1; isC = 1; R = 128;
            dil = 1; ls = 2048; r = 0; klo = 128 * nb - 128; nsl = 384; kcol = 2816 + kvh * 64; vcol = 2944 + kvh * 64; qh0 = kvh * 4 + hp * 2; qcol = 2304 + qh0 * 64; }
        __syncthreads();
        for (int i = tid; i < nsl * 8; i += 512) { const int slot = i >> 3, part = i & 7; int kpos, rr;
            if (two) { kpos = slot & 127; rr = 2 * rp + (slot >> 7); } else { kpos = klo + slot; rr = r; }
            u32x4 kv = (u32x4){0u, 0u, 0u, 0u}, vv = kv;
            if (kpos >= 0 && kpos < ls) { const bf16_t* rowp = P + (size_t)(b * 2048 + kpos * dil + rr) * PW_; kv = *(const u32x4*)(rowp + kcol + part * 8); vv = *(const u32x4*)(rowp + vcol + part * 8); }
            *(LAS u32x4*)(lds + K_OFF + slot * KROWB + part * 16) = kv;
            LAS unsigned short* vt = (LAS unsigned short*)(lds + V_OFF + (part * 8) * VROWB + slot * 2);
            vt[0 * (VROWB / 2)] = (unsigned short)(vv.x & 0xffffu); vt[1 * (VROWB / 2)] = (unsigned short)(vv.x >> 16); vt[2 * (VROWB / 2)] = (unsigned short)(vv.y & 0xffffu); vt[3 * (VROWB / 2)] = (unsigned short)(vv.y >> 16);
            vt[4 * (VROWB / 2)] = (unsigned short)(vv.z & 0xffffu); vt[5 * (VROWB / 2)] = (unsigned short)(vv.z >> 16); vt[6 * (VROWB / 2)] = (unsigned short)(vv.w & 0xffffu); vt[7 * (VROWB / 2)] = (unsigned short)(vv.w >> 16); }
        __syncthreads();
        Band bd; int qtok, rr = r; bd.ls = ls; bd.R = R;
        if (two) { const int half = w >> 2; bd.p_w = 32 * (w & 3); rr = 2 * rp + half; bd.slot_base = half * 128; }
        else if (isC) { bd.p_w = 128 * nb + 32 * (w & 3); bd.slot_base = -klo; }
        else { bd.p_w = 256 * sb + 32 * w; bd.slot_base = -klo; }
        qtok = b * 2048 + (bd.p_w + tl) * dil + rr;
        const int qc = isC ? (qcol + (w >> 2) * 64) : qcol;
        const bf16_t* qp = P + (size_t)qtok * PW_ + qc + 8 * hh;
        bf16x8 qf[4];
#pragma unroll
        for (int ks = 0; ks < 4; ++ks) qf[ks] = *(const bf16x8*)(qp + 16 * ks);
        f32x16 O[2];
#pragma unroll
        for (int e = 0; e < 16; ++e) { O[0][e] = 0.f; O[1][e] = 0.f; }
        float m = -1e30f, l = 0.f;
        const int nch = R / 16 + 1, cd = R / 32;
        chunk(lds, bd, cd, qf, tl, hh, O, m, l);
#pragma unroll 1
        for (int c = 0; c < nch; ++c) { if (c != cd) chunk(lds, bd, c, qf, tl, hh, O, m, l); }
        float lt = l + xor_f(l, 32, lane), scale;
        if (isC) { const float sk = sink_l[qh0 + (w >> 2)] * LOG2E_; const float mf = fmaxf(m, sk), corr = exp2f(m - mf); lt = lt * corr + exp2f(sk - mf); scale = corr / lt; }
        else { scale = 1.f / lt; if (hh == 0) lse2[(size_t)qtok * 12 + head] = m + log2f(lt); }
        bf16_t* op = isC ? (Y + (size_t)qtok * UYW_ + 768 + (qh0 + (w >> 2)) * 64) : (P + (size_t)qtok * PW_ + qcol);
#pragma unroll
        for (int dt = 0; dt < 2; ++dt)
#pragma unroll
            for (int g4 = 0; g4 < 4; ++g4) { u32x2 pk; pk.x = pg8::cvt_pk_bf16(O[dt][4 * g4] * scale, O[dt][4 * g4 + 1] * scale); pk.y = pg8::cvt_pk_bf16(O[dt][4 * g4 + 2] * scale, O[dt][4 * g4 + 3] * scale);
                *(u32x2*)(op + 32 * dt + 8 * g4 + 4 * hh) = pk; }
    }
    __syncthreads();
}
}

namespace xb {
constexpr int XB_TMO = 128, XB_TOP = 3328, XB_TOPGEN = 3392, XCD_BAR_WORDS = 3456; constexpr unsigned XB_SPIN_CAP = 1u << 22;
DEV constexpr int XB_XCNT(int j) { return 256 + 64 * j; }
DEV constexpr int XB_XSUB(int j) { return 1280 + 64 * j; }
DEV constexpr int XB_XGEN(int j) { return 2304 + 64 * j; }
DEV unsigned xb_ld(unsigned* p) { return __hip_atomic_load(p, __ATOMIC_RELAXED, __HIP_MEMORY_SCOPE_AGENT); }
DEV unsigned xb_add(unsigned* p, unsigned v) { return __hip_atomic_fetch_add(p, v, __ATOMIC_RELAXED, __HIP_MEMORY_SCOPE_AGENT); }
DEV unsigned xb_xcc_id() { return (unsigned)__builtin_amdgcn_s_getreg((3 << 11) | 20) & 0xFu; }
#define XB_SPIN(cond, bar) do { unsigned _sp = 0; while (cond) { __builtin_amdgcn_s_sleep(1); \
    if ((++_sp & 255u) == 0u) { if (xb_ld(&(bar)[XB_TMO])) break; if (_sp > XB_SPIN_CAP) { atomicAdd(&(bar)[XB_TMO], 1u); break; } } } } while (0)
struct XcdBarrier { unsigned* bar; unsigned x; volatile LAS unsigned* st; };
DEV XcdBarrier xcd_barrier_post(unsigned* bar, volatile LAS unsigned* st) { XcdBarrier b; b.bar = bar; b.x = xb_xcc_id(); b.st = st; if (threadIdx.x == 0) (void)xb_add(&bar[XB_XCNT(b.x)], 1u); return b; }
DEV void xcd_barrier_complete(unsigned* bar, unsigned x, unsigned& nloc, unsigned& nx) {
    const unsigned G = gridDim.x * gridDim.y * gridDim.z; unsigned sum, cnt, mine, sp = 0u;
    for (;;) { sum = 0u; cnt = 0u; mine = 0u;
#pragma unroll
        for (unsigned j = 0; j < 16; ++j) { const unsigned c = xb_ld(&bar[XB_XCNT(j)]); sum += c; cnt += (c > 0u) ? 1u : 0u; mine = (j == x) ? c : mine; }
        if (sum == G) break;
        __builtin_amdgcn_s_sleep(1);
        if ((++sp & 255u) == 0u) { if (xb_ld(&bar[XB_TMO])) break; if (sp > XB_SPIN_CAP) { atomicAdd(&bar[XB_TMO], 1u); break; } } }
    nloc = mine > 0u ? mine : 1u; nx = cnt > 0u ? cnt : 1u;
}
DEV void xcd_barrier(const XcdBarrier& b, int wv) {
    asm volatile("s_waitcnt vmcnt(0)" ::: "memory");
    __syncthreads();
    int ln0_; asm volatile("v_mbcnt_lo_u32_b32 %0, -1, 0\n\tv_mbcnt_hi_u32_b32 %0, -1, %0" : "=v"(ln0_));
    if (wv == 0 && ln0_ == 0) {
        unsigned* bar = b.bar; asm volatile("" : "+s"(bar));
        unsigned bx = xb_xcc_id(); asm volatile("" : "+s"(bx));
        __builtin_amdgcn_s_waitcnt(0);
        unsigned nloc = b.st[0], nx = b.st[1];
        if (nloc == 0u) { xcd_barrier_complete(bar, bx, nloc, nx); b.st[0] = nloc; b.st[1] = nx; }
        const unsigned old = xb_add(&bar[XB_XSUB(bx)], 1u); const unsigned gen = old / nloc;
        if (old + 1u == (gen + 1u) * nloc) {
            __builtin_amdgcn_fence(__ATOMIC_RELEASE, "agent");
            asm volatile("s_waitcnt vmcnt(0)" ::: "memory");
            const unsigned og = xb_add(&bar[XB_TOP], 1u); const unsigned tg = og / nx;
            if (og + 1u == (tg + 1u) * nx) xb_add(&bar[XB_TOPGEN], 1u);
            else XB_SPIN(xb_ld(&bar[XB_TOPGEN]) == tg, bar);
            __builtin_amdgcn_fence(__ATOMIC_ACQUIRE, "agent");
            xb_add(&bar[XB_XGEN(bx)], 1u);
            asm volatile("s_waitcnt vmcnt(0)" ::: "memory");
        } else {
            XB_SPIN(xb_ld(&bar[XB_XGEN(bx)]) == gen, bar);
            __builtin_amdgcn_fence(__ATOMIC_ACQUIRE, "agent");
            asm volatile("s_waitcnt vmcnt(0)" ::: "memory");
        }
    }
    __syncthreads();
}
}

namespace misc {
DEV void ada_phase(LAS unsigned char* lds, const float* __restrict__ c, const float* __restrict__ w_ada, const float* __restrict__ b_ada, float* __restrict__ ada, int G, int cblk, int wv) {
    int wv_ = wv, ln_; asm volatile("v_mbcnt_lo_u32_b32 %1, -1, 0\n\tv_mbcnt_hi_u32_b32 %1, -1, %1" : "+s"(wv_), "=v"(ln_)); int tid_ = (wv_ << 6) | ln_; const int tid = tid_, col = tid & 63, kg = tid >> 6;
    LAS float* cond = (LAS float*)lds;
    LAS float* part = (LAS float*)(lds + 65536);
    for (int i = tid; i < 16384; i += 512) { const float v = c[i]; cond[i] = v / (1.f + __expf(-v)); }
    __syncthreads();
#pragma unroll 1
    for (int item = cblk; item < 192; item += G) { const int l = item / 96, n0 = (item - l * 96) * 64;
        float acc[16];
#pragma unroll
        for (int b = 0; b < 16; ++b) acc[b] = 0.f;
        const float* wp = w_ada + ((size_t)l * 1024 + kg * 128) * 6144 + n0 + col;
#pragma unroll 4
        for (int kk = 0; kk < 128; ++kk) { const float wv = wp[(size_t)kk * 6144];
#pragma unroll
            for (int b = 0; b < 16; ++b) acc[b] += cond[b * 1024 + kg * 128 + kk] * wv; }
#pragma unroll
        for (int b = 0; b < 16; ++b) part[(kg * 16 + b) * 64 + col] = acc[b];
        __syncthreads();
        for (int o = tid; o < 1024; o += 512) { const int b = o >> 6, cc = o & 63; float sacc = b_ada[l * 6144 + n0 + cc];
#pragma unroll
            for (int g8 = 0; g8 < 8; ++g8) sacc += part[(g8 * 16 + b) * 64 + cc];
            ada[((size_t)l * 16 + b) * 6144 + n0 + cc] = sacc; }
        __syncthreads();
    }
}
DEV void ln_phase(float* xio, const float* __restrict__ g, const float* __restrict__ bta, const float* ada_l, bf16_t* UY, int G, int cblk, int wv) {
    int wv_ = wv, ln_; asm volatile("v_mbcnt_lo_u32_b32 %1, -1, 0\n\tv_mbcnt_hi_u32_b32 %1, -1, %1" : "+s"(wv_), "=v"(ln_)); int tid_ = (wv_ << 6) | ln_; const int tid = tid_, w = __builtin_amdgcn_readfirstlane(tid >> 6), lane = tid & 63; const int d0 = 16 * lane;
#pragma unroll 1
    for (int tok = cblk * 8 + w; tok < T_; tok += G * 8) { const float* a = ada_l + (size_t)(tok >> 11) * 6144; float* xr = xio + (size_t)tok * 1024 + d0;
        float hv[16]; float s = 0.f;
#pragma unroll
        for (int j = 0; j < 16; j += 4) { const float4 v = *(const float4*)(xr + j); hv[j] = v.x; hv[j + 1] = v.y; hv[j + 2] = v.z; hv[j + 3] = v.w; s += (v.x + v.y) + (v.z + v.w); }
        const float mu = peer::wave_sum(s, lane) * (1.f / 1024.f); float qq = 0.f;
#pragma unroll
        for (int j = 0; j < 16; ++j) { const float dd = hv[j] - mu; qq += dd * dd; }
        const float rstd = rsqrtf(peer::wave_sum(qq, lane) * (1.f / 1024.f) + LN_EPS_);
        float uu[16];
#pragma unroll
        for (int j = 0; j < 16; j += 4) { const float4 gg = *(const float4*)(g + d0 + j), bb = *(const float4*)(bta + d0 + j), sc = *(const float4*)(a + 4096 + d0 + j), sh = *(const float4*)(a + 3072 + d0 + j);
            const float y0 = (hv[j] - mu) * rstd * gg.x + bb.x, y1 = (hv[j + 1] - mu) * rstd * gg.y + bb.y, y2 = (hv[j + 2] - mu) * rstd * gg.z + bb.z, y3 = (hv[j + 3] - mu) * rstd * gg.w + bb.w;
            *(float4*)(xr + j) = make_float4(y0, y1, y2, y3);
            uu[j] = y0 * (1.f + sc.x) + sh.x; uu[j + 1] = y1 * (1.f + sc.y) + sh.y; uu[j + 2] = y2 * (1.f + sc.z) + sh.z; uu[j + 3] = y3 * (1.f + sc.w) + sh.w; }
        u32x4 p0, p1; p0.x = pg8::cvt_pk_bf16(uu[0], uu[1]); p0.y = pg8::cvt_pk_bf16(uu[2], uu[3]); p0.z = pg8::cvt_pk_bf16(uu[4], uu[5]); p0.w = pg8::cvt_pk_bf16(uu[6], uu[7]);
        p1.x = pg8::cvt_pk_bf16(uu[8], uu[9]); p1.y = pg8::cvt_pk_bf16(uu[10], uu[11]); p1.z = pg8::cvt_pk_bf16(uu[12], uu[13]); p1.w = pg8::cvt_pk_bf16(uu[14], uu[15]);
        bf16_t* up = UY + (size_t)tok * UYW_ + d0; *(u32x4*)up = p0; *(u32x4*)(up + 8) = p1; }
}
DEV void yprep_phase(LAS unsigned char* lds, const bf16_t* __restrict__ hyT, const bf16_t* P, const float* __restrict__ lse2, bf16_t* Y, int G, int cblk, int wv) {
    int wv_ = wv, ln_; asm volatile("v_mbcnt_lo_u32_b32 %1, -1, 0\n\tv_mbcnt_hi_u32_b32 %1, -1, %1" : "+s"(wv_), "=v"(ln_)); int tid_ = (wv_ << 6) | ln_; const int tid = tid_;
    LAS unsigned short* tile = (LAS unsigned short*)lds;
#pragma unroll 1
    for (int it = cblk; it < 4096; it += G) { const int t0 = (it >> 3) * 64, c0 = (it & 7) * 64;
        __syncthreads();
        { const int cc = tid >> 3, seg = (tid & 7) * 8; const u32x4 v = *(const u32x4*)(hyT + (size_t)(c0 + cc) * T_ + t0 + seg); *(LAS u32x4*)(tile + cc * 72 + seg) = v; }
        __syncthreads();
        { const int tt = tid >> 3, seg = (tid & 7) * 8; unsigned wv[4];
#pragma unroll
            for (int e = 0; e < 4; ++e) wv[e] = (unsigned)tile[(seg + 2 * e) * 72 + tt] | ((unsigned)tile[(seg + 2 * e + 1) * 72 + tt] << 16);
            *(u32x4*)(Y + (size_t)(t0 + tt) * UYW_ + 256 + c0 + seg) = (u32x4){wv[0], wv[1], wv[2], wv[3]}; }
    }
#pragma unroll 1
    for (size_t idx = (size_t)cblk * 512 + tid; idx < (size_t)T_ * 32; idx += (size_t)G * 512) { const size_t tok = idx >> 5; const int c8 = (int)(idx & 31) * 8, hh = c8 >> 6;
        const float l0 = lse2[tok * 12 + hh], l1 = lse2[tok * 12 + 4 + hh], l2 = lse2[tok * 12 + 8 + hh]; const float mx = fmaxf(l0, fmaxf(l1, l2));
        float w0 = exp2f(l0 - mx), w1 = exp2f(l1 - mx), w2 = exp2f(l2 - mx); const float inv = 1.f / (w0 + w1 + w2); w0 *= inv; w1 *= inv; w2 *= inv;
        const bf16_t* pr = P + tok * PW_ + c8; const u32x4 a = *(const u32x4*)pr, b = *(const u32x4*)(pr + 256), c = *(const u32x4*)(pr + 512);
        const unsigned aw[4] = {a.x, a.y, a.z, a.w}, bw[4] = {b.x, b.y, b.z, b.w}, cw[4] = {c.x, c.y, c.z, c.w}; unsigned o[4];
#pragma unroll
        for (int e = 0; e < 4; ++e) { const float lo = w0 * __uint_as_float(aw[e] << 16) + w1 * __uint_as_float(bw[e] << 16) + w2 * __uint_as_float(cw[e] << 16);
            const float hi = w0 * __uint_as_float(aw[e] & 0xffff0000u) + w1 * __uint_as_float(bw[e] & 0xffff0000u) + w2 * __uint_as_float(cw[e] & 0xffff0000u); o[e] = pg8::cvt_pk_bf16(lo, hi); }
        *(u32x4*)(Y + tok * UYW_ + c8) = (u32x4){o[0], o[1], o[2], o[3]}; }
    __syncthreads();
}
DEV void filt_phase(LAS unsigned char* lds, const float* __restrict__ h2, const float* __restrict__ w3, const float* __restrict__ log_decay, bf16_t* __restrict__ Gr, int G, int cblk, int wv) {
    int wv_ = wv, ln_; asm volatile("v_mbcnt_lo_u32_b32 %1, -1, 0\n\tv_mbcnt_hi_u32_b32 %1, -1, %1" : "+s"(wv_), "=v"(ln_)); const int tid = (wv_ << 6) | ln_, lane = ln_;
    LAS float* hrow = (LAS float*)lds;
    LAS float* w3s = (LAS float*)(lds + 512 * 68 * 4);
    LAS float* dec = w3s + 1024;
    LAS float* red = dec + 16;
#pragma unroll 1
    for (int item = cblk; item < 256; item += G) { const int l = item >> 7, o = (item >> 6) & 1, cg = item & 63; const int colf0 = o * 512 + cg * 8;
        __syncthreads();
        for (int i = tid; i < 1024; i += 512) { const int jj = i >> 4, c16 = i & 15; const int col = (c16 < 8) ? colf0 + c16 : 1024 + colf0 + (c16 - 8); w3s[i] = w3[((size_t)l * 64 + jj) * 2048 + col]; }
        if (tid < 16) { const int col = (tid < 8) ? colf0 + tid : 1024 + colf0 + (tid - 8); dec[tid] = __expf(log_decay[l * 2048 + col]); }
        float vals[4][16];
#pragma unroll
        for (int ch = 0; ch < 4; ++ch) {
            __syncthreads();
            { const float* src = h2 + ((size_t)l * 2048 + ch * 512) * 64;
#pragma unroll 4
                for (int k = 0; k < 16; ++k) { const int idx = tid + 512 * k; const int row = idx >> 4, c4 = idx & 15; *(LAS f32x4*)(hrow + row * 68 + c4 * 4) = *(const f32x4*)(src + (size_t)idx * 4); } }
            __syncthreads();
            float acc[16];
#pragma unroll
            for (int c = 0; c < 16; ++c) acc[c] = 0.f;
#pragma unroll 2
            for (int j4 = 0; j4 < 16; ++j4) { const f32x4 hv = *(const LAS f32x4*)(hrow + tid * 68 + j4 * 4); const float hh4[4] = {hv.x, hv.y, hv.z, hv.w};
#pragma unroll
                for (int e = 0; e < 4; ++e) { const LAS f32x4* wr = (const LAS f32x4*)(w3s + (j4 * 4 + e) * 16); const f32x4 w0 = wr[0], w1 = wr[1], w2 = wr[2], w3v = wr[3];
                    acc[0] += hh4[e] * w0.x; acc[1] += hh4[e] * w0.y; acc[2] += hh4[e] * w0.z; acc[3] += hh4[e] * w0.w; acc[4] += hh4[e] * w1.x; acc[5] += hh4[e] * w1.y; acc[6] += hh4[e] * w1.z; acc[7] += hh4[e] * w1.w;
                    acc[8] += hh4[e] * w2.x; acc[9] += hh4[e] * w2.y; acc[10] += hh4[e] * w2.z; acc[11] += hh4[e] * w2.w; acc[12] += hh4[e] * w3v.x; acc[13] += hh4[e] * w3v.y; acc[14] += hh4[e] * w3v.z; acc[15] += hh4[e] * w3v.w; } }
            const float tn = (float)(ch * 512 + tid) * (1.f / 2047.f);
#pragma unroll
            for (int c = 0; c < 16; ++c) vals[ch][c] = acc[c] * __expf(-tn * dec[c]);
        }
        float ss[8];
#pragma unroll
        for (int c = 0; c < 8; ++c) { float a = 0.f;
#pragma unroll
            for (int ch = 0; ch < 4; ++ch) { a += vals[ch][c] * vals[ch][c]; if (ch > 0 || tid > 0) a += vals[ch][8 + c] * vals[ch][8 + c]; }
            ss[c] = peer::wave_sum(a, lane); }
        if (lane == 0) {
#pragma unroll
            for (int c = 0; c < 8; ++c) red[wv_ * 8 + c] = ss[c]; }
        __syncthreads();
        float scale[8];
#pragma unroll
        for (int c = 0; c < 8; ++c) { float a = 0.f;
#pragma unroll
            for (int g8 = 0; g8 < 8; ++g8) a += red[g8 * 8 + c];
            scale[c] = rsqrtf(a + 1e-12f); }
#pragma unroll
        for (int c = 0; c < 8; ++c) { bf16_t* gp = Gr + (((size_t)l * 2 + o) * 512 + cg * 8 + c) * 4096;
#pragma unroll
            for (int ch = 0; ch < 4; ++ch) { const int t = ch * 512 + tid; gp[2047 - t] = f2bf(vals[ch][c] * scale[c]); if (t > 0) gp[2047 + t] = f2bf(vals[ch][8 + c] * scale[c]); }
            if (tid == 0) gp[4095] = 0; }
    }
    __syncthreads();
}
DEV void modulate_phase(const float* __restrict__ x, const float* __restrict__ ada0, bf16_t* UY, int G, int cblk, int wv) {
    int wv_ = wv, ln_; asm volatile("v_mbcnt_lo_u32_b32 %1, -1, 0\n\tv_mbcnt_hi_u32_b32 %1, -1, %1" : "+s"(wv_), "=v"(ln_)); const int tid = (wv_ << 6) | ln_;
#pragma unroll 1
    for (size_t i = (size_t)cblk * 512 + tid; i < (size_t)T_ * 128; i += (size_t)G * 512) { const size_t tok = i >> 7; const int d = (int)(i & 127) * 8; const float* a = ada0 + (tok >> 11) * 6144;
        const float4 x0 = *(const float4*)(x + tok * 1024 + d), x1 = *(const float4*)(x + tok * 1024 + d + 4), s0 = *(const float4*)(a + 1024 + d), s1 = *(const float4*)(a + 1024 + d + 4), h0 = *(const float4*)(a + d), h1 = *(const float4*)(a + d + 4);
        u32x4 o; o.x = pg8::cvt_pk_bf16(x0.x * (1.f + s0.x) + h0.x, x0.y * (1.f + s0.y) + h0.y); o.y = pg8::cvt_pk_bf16(x0.z * (1.f + s0.z) + h0.z, x0.w * (1.f + s0.w) + h0.w);
        o.z = pg8::cvt_pk_bf16(x1.x * (1.f + s1.x) + h1.x, x1.y * (1.f + s1.y) + h1.y); o.w = pg8::cvt_pk_bf16(x1.z * (1.f + s1.z) + h1.z, x1.w * (1.f + s1.w) + h1.w);
        *(u32x4*)(UY + tok * UYW_ + d) = o; }
}
}

struct Params {
    const float *x, *c, *w_ada, *b_ada, *w_in, *conv_w, *conv_b, *hy_w1, *hy_b1, *hy_w2, *hy_b2, *hy_w3, *hy_freq, *hy_ld, *hy_bias, *attn_sink, *wba, *wbb, *wbc, *w_out, *ln_g, *ln_b,
        *peer_wq, *peer_keys, *peer_u, *peer_v;
    float* out; char* ws;
};
constexpr int LDS_PHASE = 148480;
constexpr int LDS_BYTES = LDS_PHASE + 16;
constexpr size_t OFF_BAR = OFF_LSE + 1792 * 1024;

#define RUN(nvb, call) do { const int wv = wave_s; int wv_ = wv, ln_; asm volatile("v_mbcnt_lo_u32_b32 %1, -1, 0\n\tv_mbcnt_hi_u32_b32 %1, -1, %1" : "+s"(wv_), "=v"(ln_)); int tid_ = (wv_ << 6) | ln_; const int t = tid_ & 255, sub = tid_ >> 8; unsigned char* sm = lds + sub * 16384; \
        for (int vb = (int)blockIdx.x * 2 + sub; vb < (nvb); vb += (int)gridDim.x * 2) { call; __syncthreads(); } } while (0)
#define GSYNC_CG() do { __builtin_amdgcn_sched_barrier(0); grid.sync(); __builtin_amdgcn_sched_barrier(0); } while (0)
#define GSYNC() do { __builtin_amdgcn_sched_barrier(0); xb::xcd_barrier(xbar, wave_s); __builtin_amdgcn_sched_barrier(0); } while (0)

__global__ void __launch_bounds__(512, 2) mega(Params p) {
    extern __shared__ __attribute__((aligned(16))) unsigned char lds[];
    cg::grid_group grid = cg::this_grid();
    LAS unsigned char* ldsl = (LAS unsigned char*)lds;
    const int G = gridDim.x, cblk = blockIdx.x;
    const int wave_s = __builtin_amdgcn_readfirstlane((int)threadIdx.x >> 6);
    float* out = p.out; (void)out;
    if (threadIdx.x < 4) ((LAS unsigned*)(ldsl + LDS_PHASE))[threadIdx.x] = 0u;
    __syncthreads();
    const xb::XcdBarrier xbar = xb::xcd_barrier_post((unsigned*)(p.ws + OFF_BAR), (volatile LAS unsigned*)(ldsl + LDS_PHASE));
    {
    char* ws = p.ws;
    float* ada = (float*)(ws + OFF_ADA); float2* rope = (float2*)(ws + OFF_ROPE); bf16_t* Gr = (bf16_t*)(ws + OFF_GR); float* lse2 = (float*)(ws + OFF_LSE);
    bf16_t* WinT = (bf16_t*)(ws + OFF_WINT); bf16_t* WmT = (bf16_t*)(ws + OFF_WMT); bf16_t* WoutT = (bf16_t*)(ws + OFF_WOUTT); bf16_t* WqT = (bf16_t*)(ws + OFF_WQT);
    bf16_t* UY = (bf16_t*)(ws + OFF_UY); bf16_t* Y = UY + 1024; bf16_t* P = (bf16_t*)(ws + OFF_P); bf16_t* hyT = (bf16_t*)(ws + OFF_HYT);
    bf16_t* merged = (bf16_t*)(ws + OFF_P); bf16_t* gtmp = (bf16_t*)(ws + OFF_P + 64 * MB_); bf16_t* Q2 = (bf16_t*)(ws + OFF_P);
    int* eidx = (int*)(ws + OFF_HYT); float* egate = (float*)(ws + OFF_HYT + 16 * MB_); unsigned char* U8 = (unsigned char*)(ws + OFF_HYT + 32 * MB_); unsigned char* V4 = (unsigned char*)(ws + OFF_HYT + 48 * MB_); float* sinv = (float*)(ws + OFF_HYT + 64 * MB_);
    float* h2 = (float*)(ws + OFF_P);
    (void)lse2; (void)P; (void)hyT; (void)merged; (void)gtmp; (void)Q2; (void)eidx; (void)egate; (void)U8; (void)V4; (void)sinv; (void)Y;

    misc::ada_phase(ldsl, p.c, p.w_ada, p.b_ada, ada, G, cblk, wave_s);
    RUN(256, nb_rope(vb, t, sm, rope));
    RUN(1024, nb_filt_h2(vb, t, sm, p.hy_w1, p.hy_b1, p.hy_w2, p.hy_b2, p.hy_freq, h2));
    { const WPrep wq{p.w_in, p.wba, p.wbb, p.wbc, p.w_out, p.peer_wq, WinT, WmT, WoutT, WqT}; RUN(6016, nb_wprep(vb, t, sm, wq)); }
    GSYNC_CG();
    misc::filt_phase(ldsl, h2, p.hy_w3, p.hy_ld, Gr, G, cblk, wave_s);
    misc::modulate_phase(p.x, ada, UY, G, cblk, wave_s);
    GSYNC();
    }
#pragma unroll 1
    for (int l = 0; l < 2; ++l) {
        size_t zoff = 0; asm volatile("" : "+s"(zoff));
        char* ws = p.ws + zoff; float* out = p.out + zoff;
        int Gl = gridDim.x, cl = blockIdx.x; asm volatile("" : "+s"(Gl), "+s"(cl));
        float* ada = (float*)(ws + OFF_ADA); float2* rope = (float2*)(ws + OFF_ROPE); bf16_t* Gr = (bf16_t*)(ws + OFF_GR); float* lse2 = (float*)(ws + OFF_LSE);
        bf16_t* WinT = (bf16_t*)(ws + OFF_WINT); bf16_t* WmT = (bf16_t*)(ws + OFF_WMT); bf16_t* WoutT = (bf16_t*)(ws + OFF_WOUTT); bf16_t* WqT = (bf16_t*)(ws + OFF_WQT);
        bf16_t* UY = (bf16_t*)(ws + OFF_UY); bf16_t* Y = UY + 1024; bf16_t* P = (bf16_t*)(ws + OFF_P); bf16_t* hyT = (bf16_t*)(ws + OFF_HYT);
        bf16_t* merged = (bf16_t*)(ws + OFF_P); bf16_t* gtmp = (bf16_t*)(ws + OFF_P + 64 * MB_); bf16_t* Q2 = (bf16_t*)(ws + OFF_P);
        int* eidx = (int*)(ws + OFF_HYT); float* egate = (float*)(ws + OFF_HYT + 16 * MB_); unsigned char* U8 = (unsigned char*)(ws + OFF_HYT + 32 * MB_); unsigned char* V4 = (unsigned char*)(ws + OFF_HYT + 48 * MB_); float* sinv = (float*)(ws + OFF_HYT + 64 * MB_);
        const float* ada_l = ada + (size_t)l * 16 * 6144;
        const float* xin = (l == 0) ? p.x : out;
        const bf16_t* WinT_l = WinT + (size_t)l * 7680 * 1024;
        {
            const pg8::PlainSched S1{UY, WinT_l, UYW_, 1024, 128, 12, 16, Gl, cl}; const pg8::EpiP E1{P, rope};
            pg8::gemm_phase(ldsl, UYW_, 1024, S1, E1, wave_s);
            const pg8::PlainSched S2{WinT_l + (size_t)3072 * 1024, UY, 1024, UYW_, 6, 128, 16, Gl, cl}; const pg8::EpiBf E2{hyT, T_, 0};
            pg8::gemm_phase(ldsl, 1024, UYW_, S2, E2, wave_s);
        }
        GSYNC();
        at::attn_phase(ldsl, P, lse2, Y, p.attn_sink + l * 8, Gl, cl, wave_s);
        hy::hyena_phase(ldsl, hyT, Gr + (size_t)l * 2 * 512 * 4096, p.conv_w + (size_t)l * 3 * 1536, p.conv_b + (size_t)l * 1536, p.hy_bias + (size_t)l * 1024, Gl, cl, wave_s);
        GSYNC();
        misc::yprep_phase(ldsl, hyT, P, lse2, Y, Gl, cl, wave_s);
        GSYNC();
        {
            const pg8::MergeSched S{UY, WmT + (size_t)l * 1024 * WMW_, Gl, cl}; const pg8::EpiMergeAll E{gtmp, merged};
            pg8::gemm_phase(ldsl, UYW_, WMW_, S, E, wave_s);
        }
        GSYNC();
        {
            const pg8::PlainSched S{merged, WoutT + (size_t)l * 1024 * 1024, 1024, 1024, 128, 4, 16, Gl, cl}; const pg8::EpiOut E{xin, out, ada_l + 2048};
            pg8::gemm_phase(ldsl, 1024, 1024, S, E, wave_s);
        }
        GSYNC();
        misc::ln_phase(out, p.ln_g + (size_t)(l * 2 + 0) * 1024, p.ln_b + (size_t)(l * 2 + 0) * 1024, ada_l, UY, Gl, cl, wave_s);
        RUN(8192, peer::nb_quant_tables(vb, t, p.peer_u + (size_t)l * 16384 * 1024, p.peer_v + (size_t)l * 16384 * 1024, U8, V4, sinv));
        GSYNC();
        {
            const pg8::PlainSched S{UY, WqT + (size_t)l * 2048 * 1024, UYW_, 1024, 128, 8, 16, Gl, cl}; const pg8::EpiBf E{Q2, 2048, 0};
            pg8::gemm_phase(ldsl, UYW_, 1024, S, E, wave_s);
        }
        GSYNC();
        tk::topk_phase(ldsl, Q2, p.peer_keys + (size_t)l * 8 * 2 * 128 * 128, eidx, egate, Gl, cl, wave_s);
        GSYNC();
        peer::peer_phase(ldsl, out, ada_l, eidx, egate, U8, V4, sinv, p.ln_g + (size_t)(l * 2 + 1) * 1024, p.ln_b + (size_t)(l * 2 + 1) * 1024,
                         (l == 0) ? ada + (size_t)16 * 6144 : (const float*)nullptr, UY, Gl, cl, wave_s);
        if (l == 0) GSYNC();
    }
}

extern "C" void kernel_launch(void* const* d_in, const int* in_sizes, int n_in, void* d_out, int out_size, void* d_ws, size_t ws_size, hipStream_t stream) {
    static int grid = 0;
    if (grid == 0) {
        if (ws_size < WS_NEED || n_in != 26) { fprintf(stderr, "kernel_launch: workspace %zu < %zu or n_in %d != 26\n", ws_size, (size_t)WS_NEED, n_in); grid = -1; return; }
        int dev = 0, cus = 0, per_cu = 0;
        (void)hipGetDevice(&dev); (void)hipDeviceGetAttribute(&cus, hipDeviceAttributeMultiprocessorCount, dev);
        (void)hipFuncSetAttribute((const void*)mega, hipFuncAttributeMaxDynamicSharedMemorySize, LDS_BYTES);
        (void)hipOccupancyMaxActiveBlocksPerMultiprocessor(&per_cu, (const void*)mega, 512, LDS_BYTES);
        if (per_cu < 1) { fprintf(stderr, "kernel_launch: occupancy query says %d blocks per CU\n", per_cu); grid = -1; return; }
        grid = cus;
    }
    if (grid < 0) return;
    Params p{};
    const float** pp = (const float**)&p;
    for (int i = 0; i < 26; ++i) pp[i] = (const float*)d_in[i];
    p.out = (float*)d_out; p.ws = (char*)d_ws;
    (void)hipMemsetAsync((char*)d_ws + OFF_BAR, 0, xb::XCD_BAR_WORDS * sizeof(unsigned), stream);
    void* args[] = {&p};
    hipError_t e = hipLaunchCooperativeKernel((const void*)mega, dim3(grid), dim3(512), args, LDS_BYTES, stream);
    if (e != hipSuccess) fprintf(stderr, "cooperative launch failed: %s (grid %d)\n", hipGetErrorString(e), grid);
}
```

```cpp
#include <hip/hip_runtime.h>
#include <hip/hip_cooperative_groups.h>
namespace cg = cooperative_groups;
#include <stdint.h>
#include <stdio.h>

#define DEV __device__ __forceinline__
typedef unsigned short bf16_t;

constexpr int D_ = 1024, B_ = 16, S_ = 2048, T_ = B_ * S_;
constexpr float ALPHA_ = 1.41421356237309515f;
constexpr float LOG2E_ = 1.4426950408889634f;
constexpr float QSCALE_ = 0.125f * 1.4426950408889634f;
constexpr float LN_EPS_ = 1e-5f;
constexpr int PW_ = 3072;
constexpr int UYW_ = 2304;
constexpr int WMW_ = 2816;
constexpr float WQ8_ = 1024.f;
constexpr size_t GSTRIDE_ = (size_t)32 * 1024 * 1024;

constexpr size_t MB_ = 1024 * 1024;
constexpr size_t OFF_ADA = 0, OFF_ROPE = 1 * MB_, OFF_GR = 2 * MB_, OFF_LSE = 18 * MB_, OFF_WINT = 20 * MB_, OFF_WMT = 50 * MB_,
                 OFF_WOUTT = 68 * MB_, OFF_WQT = 72 * MB_, OFF_KEYS = 80 * MB_, OFF_UY = 82 * MB_, OFF_P = 226 * MB_, OFF_HYT = 418 * MB_,
                 WS_NEED = 514 * MB_;

DEV int xor_i(int v, int off, int lane) { return __builtin_amdgcn_ds_bpermute((lane ^ off) << 2, v); }
DEV float xor_f(float v, int off, int lane) { return __int_as_float(__builtin_amdgcn_ds_bpermute((lane ^ off) << 2, __float_as_int(v))); }
DEV float bf2f(bf16_t v) { return __uint_as_float(((unsigned)v) << 16); }
DEV bf16_t f2bf(float f) { unsigned u = __float_as_uint(f); u += 0x7FFFu + ((u >> 16) & 1u); return (bf16_t)(u >> 16); }

DEV void nb_rope(int vb, int t, unsigned char* sm, float2* __restrict__ rope) {
    const int idx = vb * 256 + t; const int s = idx >> 5, i = idx & 31;
    const float inv = powf(10000.f, -(float)i / 32.f); const float ang = (float)s * inv;
    rope[idx] = make_float2(cosf(ang), sinf(ang));
}

DEV void nb_filt_h2(int vb, int t, unsigned char* sm, const float* __restrict__ w1, const float* __restrict__ b1, const float* __restrict__ w2, const float* __restrict__ b2,
                                                const float* __restrict__ freq, float* __restrict__ h2) {
    const int grp = t >> 6, j = t & 63; const int lt = vb * 4 + grp; const int l = lt / 2048, tt = lt % 2048;
    float* z = (float*)sm + grp * 128; float* h1 = z + 64;
    if (j < 33) {
        const float idx = (float)tt, tn = idx / 2047.f, w = 6.283185307179586f * idx / 2048.f;
        if (j == 0) z[0] = tn;
        else { const int k = (j <= 16) ? (j - 1) : (j - 17); const float band = 1e-4f + (float)k * ((15.f - 1e-4f) / 15.f); const float ang = w * band;
            z[j] = (j <= 16) ? cosf(ang) : -sinf(ang); }
    }
    __syncthreads();
    float a = b1[l * 64 + j];
    for (int e = 0; e < 33; ++e) a += z[e] * w1[(l * 33 + e) * 64 + j];
    h1[j] = sinf(freq[(l * 2 + 0) * 64 + j] * a);
    __syncthreads();
    float a2 = b2[l * 64 + j];
    for (int i = 0; i < 64; ++i) a2 += h1[i] * w2[(l * 64 + i) * 64 + j];
    h2[((size_t)l * 2048 + tt) * 64 + j] = sinf(freq[(l * 2 + 1) * 64 + j] * a2);
}

#define LAS __attribute__((address_space(3)))
typedef short bf16x8 __attribute__((ext_vector_type(8)));
typedef float f32x4 __attribute__((ext_vector_type(4)));
typedef float f32x2 __attribute__((ext_vector_type(2)));
typedef unsigned u32x4 __attribute__((ext_vector_type(4)));
typedef unsigned u32x2 __attribute__((ext_vector_type(2)));
typedef int i32x8 __attribute__((ext_vector_type(8)));
typedef int i32x4 __attribute__((ext_vector_type(4)));
namespace pg8 {
constexpr int BM = 256, BK = 64, HALF = 128, HTB = HALF * BK * 2, STAGE_BYTES = 8 * HTB, NXCD = 8, WGM = 8;
DEV int lds_byte(int r, int c) { const int st = (r >> 4) * 2 + (c >> 5), rr = r & 15, cc = c & 31, ob = rr * 64 + cc * 2; return st * 1024 + (ob ^ (((ob >> 9) & 1) << 5)); }
DEV void stage_rc(int b, int& R, int& C) { const int st = b / 1024, sb = b % 1024, swz = sb ^ (((sb >> 9) & 1) << 5); R = (st >> 1) * 16 + swz / 64; C = (st & 1) * 32 + (swz % 64) / 2; }
DEV int perm32(int rho) { const int n = rho >> 4, i = rho & 15; return 8 * (i >> 2) + 4 * n + (i & 3); }
typedef __bf16 bf16x2_t __attribute__((ext_vector_type(2)));
DEV unsigned cvt_pk_bf16(float lo, float hi) { return __builtin_bit_cast(unsigned, __builtin_convertvector((f32x2){lo, hi}, bf16x2_t)); }

struct Unit { int pm, pn, tag, nt; const char* a; const char* b; };
DEV void tile_of(int L, int nM, int nN, int& pm, int& pn) {
    const int nwg = nM * nN; int wgid = L; { const int q = nwg / NXCD, r = nwg % NXCD, xcd = wgid % NXCD, off = wgid / NXCD; wgid = (xcd < r ? xcd * (q + 1) : r * (q + 1) + (xcd - r) * q) + off; }
    const int nig = WGM * nN, gid = wgid / nig, fm = gid * WGM, gsz = (nM - fm) < WGM ? (nM - fm) : WGM;
    pm = fm + ((wgid % nig) % gsz); pn = (wgid % nig) / gsz;
}
struct PlainSched { const bf16_t* A; const bf16_t* Bt; int lda, ldb, nM, nN, nt, G, c, first, count;
    DEV bool next(int i, Unit& u) const { if (i >= count) return false; const long L = (long)(first + i) * G + c; if (L >= (long)nM * nN) return false; tile_of((int)L, nM, nN, u.pm, u.pn); u.tag = 0; u.nt = nt;
        u.a = (const char*)(A + (size_t)u.pm * BM * lda); u.b = (const char*)(Bt + (size_t)u.pn * BM * ldb); return true; } };

template <class Epi, class Sched, bool SP2 = true, bool ALIGN_EPI = true, int I8 = 0>
DEV void gemm_phase(LAS unsigned char* lds, const int lda, const int ldb, const Sched& S, const Epi& E, const int wv) {
    int wv_ = wv, ln_; asm volatile("v_mbcnt_lo_u32_b32 %1, -1, 0\n\tv_mbcnt_hi_u32_b32 %1, -1, %1" : "+s"(wv_), "=v"(ln_)); int tid_ = (wv_ << 6) | ln_;
    const int tid = tid_, wid = __builtin_amdgcn_readfirstlane(tid >> 6), lane = tid & 63, wr = wid >> 2, wc = wid & 3, fr = lane & 15, fq = lane >> 4;
    unsigned voffA[2], voffB[2];
#pragma unroll
    for (int i = 0; i < 2; ++i) { int R, C; stage_rc(tid * 16 + i * 8192, R, C); const int Rb = Epi::PERM ? ((R & ~31) + perm32(R & 31)) : R;
        voffA[i] = (unsigned)(R * lda + C) * 2u; voffB[i] = (unsigned)(Rb * ldb + C) * 2u; }
    const size_t kstep = (size_t)(BK * 2);
    const size_t hstepA = (size_t)HALF * lda * 2, hstepB = (size_t)HALF * ldb * 2;
    const unsigned ldsw = (unsigned)wid * 1024u;
    const int aoff = lds_byte(wr * 64 + fr, fq * 8), boff = lds_byte(wc * 32 + fr, fq * 8);
#define PG8_SA(b, h) (((b) * 2 + (h)) * HTB)
#define PG8_SB(b, h) ((4 + (b) * 2 + (h)) * HTB)
#define PG8_STAGE(bufoff, gbase, voff) do { _Pragma("unroll") for (int _i = 0; _i < 2; ++_i) \
        __builtin_amdgcn_global_load_lds((const unsigned*)((const char*)(gbase) + (voff)[_i]), (LAS unsigned*)(lds + (bufoff) + ldsw + _i * 8192), 16, 0, 0); } while (0)
#define PG8_LDA(dst, b, h) do { _Pragma("unroll") for (int m = 0; m < 4; ++m) _Pragma("unroll") for (int k = 0; k < 2; ++k) dst[m][k] = *(const LAS bf16x8*)(lds + PG8_SA(b, h) + aoff + m * 2048 + k * 1024); } while (0)
#define PG8_LDB(dst, b, h) do { _Pragma("unroll") for (int n = 0; n < 2; ++n) _Pragma("unroll") for (int k = 0; k < 2; ++k) dst[n][k] = *(const LAS bf16x8*)(lds + PG8_SB(b, h) + boff + n * 2048 + k * 1024); } while (0)
#define PG8_MMA(ai, bj, At, Bt) do { __builtin_amdgcn_s_setprio(1); \
        if (I8 == 1 || (I8 == 2 && (cur.tag & 1) == 0)) { _Pragma("unroll") for (int m = 0; m < 4; ++m) _Pragma("unroll") for (int n = 0; n < 2; ++n) _Pragma("unroll") for (int k = 0; k < 2; ++k) \
            acc[ai][bj][m][n] = __builtin_bit_cast(f32x4, __builtin_amdgcn_mfma_i32_16x16x64_i8(__builtin_bit_cast(i32x4, Bt[n][k]), __builtin_bit_cast(i32x4, At[m][k]), __builtin_bit_cast(i32x4, acc[ai][bj][m][n]), 0, 0, 0)); } \
        else { _Pragma("unroll") for (int m = 0; m < 4; ++m) _Pragma("unroll") for (int n = 0; n < 2; ++n) _Pragma("unroll") for (int k = 0; k < 2; ++k) \
            acc[ai][bj][m][n] = __builtin_amdgcn_mfma_f32_16x16x32_bf16(Bt[n][k], At[m][k], acc[ai][bj][m][n], 0, 0, 0); } __builtin_amdgcn_s_setprio(0); } while (0)
#define PG8_WAIT_V(n) asm volatile("s_waitcnt vmcnt(" #n ")" ::: "memory")
#define PG8_WAIT_L(n) asm volatile("s_waitcnt lgkmcnt(" #n ")" ::: "memory")
#define PG8_BAR __builtin_amdgcn_s_barrier()
#define PG8_SCHED __builtin_amdgcn_sched_barrier(0)
    Unit cur, nxt; int ui = 0;
    if (!S.next(0, cur)) return;
    f32x4 acc[2][2][4][2];
#pragma unroll
    for (int a = 0; a < 2; ++a)
#pragma unroll
        for (int b = 0; b < 2; ++b)
#pragma unroll
            for (int m = 0; m < 4; ++m)
#pragma unroll
                for (int n = 0; n < 2; ++n) acc[a][b][m][n] = (f32x4){0.f, 0.f, 0.f, 0.f};
    bf16x8 At[4][2], B0[2][2], B1[2][2];
    const char* cA = cur.a; const char* cB = cur.b;
    if constexpr (SP2) {
        PG8_STAGE(PG8_SB(0, 0), cB, voffB); PG8_STAGE(PG8_SB(0, 1), cB + hstepB, voffB); PG8_STAGE(PG8_SA(0, 0), cA, voffA); PG8_STAGE(PG8_SA(0, 1), cA + hstepA, voffA);
        if (wr == 1) PG8_BAR;
        PG8_WAIT_V(2); PG8_BAR;
        PG8_STAGE(PG8_SB(1, 0), cB + kstep, voffB); PG8_STAGE(PG8_SA(1, 0), cA + kstep, voffA); PG8_STAGE(PG8_SB(1, 1), cB + hstepB + kstep, voffB);
        PG8_WAIT_V(6); PG8_BAR;
    } else {
    PG8_STAGE(PG8_SB(0, 0), cB, voffB); PG8_STAGE(PG8_SA(0, 0), cA, voffA); PG8_STAGE(PG8_SB(0, 1), cB + hstepB, voffB); PG8_STAGE(PG8_SA(0, 1), cA + hstepA, voffA);
    if (wr == 1) PG8_BAR;
    PG8_WAIT_V(4); PG8_BAR;
    PG8_STAGE(PG8_SB(1, 0), cB + kstep, voffB); PG8_STAGE(PG8_SA(1, 0), cA + kstep, voffA); PG8_STAGE(PG8_SB(1, 1), cB + hstepB + kstep, voffB);
    PG8_WAIT_V(6); PG8_BAR;
    }
    for (;;) {
        const bool has_next = S.next(ui + 1, nxt);
        const char* nA = has_next ? nxt.a : cA; const char* nB = has_next ? nxt.b : cB;
        const int nt = cur.nt;
        for (int t = 0; t < nt; t += 2) {
            const bool last = (t == nt - 2);
            const char* a1 = cA + (size_t)(t + 1) * kstep;
            const char* a2 = last ? nA : cA + (size_t)(t + 2) * kstep; const char* b2 = last ? nB : cB + (size_t)(t + 2) * kstep;
            const char* a3 = a2 + kstep; const char* b3 = b2 + kstep;
            if constexpr (SP2) {
            PG8_LDB(B0, 0, 0); PG8_LDB(B1, 0, 1); PG8_SCHED; PG8_LDA(At, 0, 0); PG8_STAGE(PG8_SA(1, 1), a1 + hstepA, voffA);
            PG8_WAIT_V(8); PG8_WAIT_L(0); PG8_BAR; PG8_MMA(0, 0, At, B0); PG8_MMA(0, 1, At, B1); PG8_BAR; PG8_SCHED;
            PG8_LDA(At, 0, 1); PG8_STAGE(PG8_SB(0, 0), b2, voffB); PG8_STAGE(PG8_SB(0, 1), b2 + hstepB, voffB); PG8_STAGE(PG8_SA(0, 0), a2, voffA);
            PG8_WAIT_V(8); PG8_WAIT_L(0); PG8_BAR; PG8_MMA(1, 0, At, B0); PG8_MMA(1, 1, At, B1); PG8_BAR; PG8_SCHED;
            PG8_LDB(B0, 1, 0); PG8_LDB(B1, 1, 1); PG8_SCHED; PG8_LDA(At, 1, 0); PG8_STAGE(PG8_SA(0, 1), a2 + hstepA, voffA);
            PG8_WAIT_V(8); PG8_WAIT_L(0); PG8_BAR; PG8_MMA(0, 0, At, B0); PG8_MMA(0, 1, At, B1); PG8_BAR; PG8_SCHED;
            PG8_LDA(At, 1, 1); PG8_STAGE(PG8_SB(1, 0), b3, voffB); PG8_STAGE(PG8_SB(1, 1), b3 + hstepB, voffB); PG8_STAGE(PG8_SA(1, 0), a3, voffA);
            PG8_WAIT_V(8); PG8_WAIT_L(0); PG8_BAR; PG8_MMA(1, 0, At, B0); PG8_MMA(1, 1, At, B1); PG8_BAR; PG8_SCHED;
            } else {
            PG8_LDB(B0, 0, 0); PG8_SCHED; PG8_LDA(At, 0, 0); PG8_STAGE(PG8_SA(1, 1), a1 + hstepA, voffA);
            PG8_WAIT_L(8); PG8_BAR; PG8_WAIT_L(0); PG8_MMA(0, 0, At, B0); PG8_BAR; PG8_SCHED;
            PG8_LDB(B1, 0, 1); PG8_STAGE(PG8_SB(0, 0), b2, voffB);
            PG8_BAR; PG8_WAIT_L(0); PG8_MMA(0, 1, At, B1); PG8_BAR;
            PG8_LDA(At, 0, 1); PG8_STAGE(PG8_SA(0, 0), a2, voffA);
            PG8_BAR; PG8_WAIT_L(0); PG8_MMA(1, 0, At, B0); PG8_BAR; PG8_SCHED;
            PG8_STAGE(PG8_SB(0, 1), b2 + hstepB, voffB);
            PG8_WAIT_V(6); PG8_BAR; PG8_MMA(1, 1, At, B1); PG8_BAR;
            PG8_LDB(B0, 1, 0); PG8_SCHED; PG8_LDA(At, 1, 0); PG8_STAGE(PG8_SA(0, 1), a2 + hstepA, voffA);
            PG8_WAIT_L(8); PG8_BAR; PG8_WAIT_L(0); PG8_MMA(0, 0, At, B0); PG8_BAR; PG8_SCHED;
            PG8_LDB(B1, 1, 1); PG8_STAGE(PG8_SB(1, 0), b3, voffB);
            PG8_BAR; PG8_WAIT_L(0); PG8_MMA(0, 1, At, B1); PG8_BAR;
            PG8_LDA(At, 1, 1); PG8_STAGE(PG8_SA(1, 0), a3, voffA);
            PG8_BAR; PG8_WAIT_L(0); PG8_MMA(1, 0, At, B0); PG8_BAR; PG8_SCHED;
            PG8_STAGE(PG8_SB(1, 1), b3 + hstepB, voffB);
            PG8_WAIT_V(6); PG8_BAR; PG8_MMA(1, 1, At, B1); PG8_BAR;
            }
        }
        if constexpr (ALIGN_EPI) { if (wr == 0) PG8_BAR; }
        if constexpr (!Epi::AFTER_DRAIN) E(acc, cur, wr, wc, fr, fq);
        if (!has_next) break;
        if constexpr (!Epi::INPLACE)
#pragma unroll
        for (int a = 0; a < 2; ++a)
#pragma unroll
            for (int b = 0; b < 2; ++b)
#pragma unroll
                for (int m = 0; m < 4; ++m)
#pragma unroll
                    for (int n = 0; n < 2; ++n) acc[a][b][m][n] = (f32x4){0.f, 0.f, 0.f, 0.f};
        cur = nxt; cA = nA; cB = nB; ++ui;
        if constexpr (ALIGN_EPI) { if (wr == 1) PG8_BAR; }
    }
    PG8_WAIT_V(0);
    if constexpr (!ALIGN_EPI) { if (wr == 0) PG8_BAR; }
    PG8_BAR;
    if constexpr (Epi::AFTER_DRAIN) E.fused(acc, cur, wr, wc, fr, fq, lds, wid, lane);
#undef PG8_SA
#undef PG8_SB
#undef PG8_STAGE
#undef PG8_LDA
#undef PG8_LDB
#undef PG8_MMA
#undef PG8_WAIT_V
#undef PG8_WAIT_L
#undef PG8_BAR
#undef PG8_SCHED
}
struct EpiBf { static constexpr bool PERM = true, AFTER_DRAIN = false, INPLACE = false; bf16_t* O; int ldc; int pad;
    DEV void operator()(const f32x4 (&acc)[2][2][4][2], const Unit& u, int wr, int wc, int fr, int fq) const {
        const int row0 = u.pm * BM + wr * 64 + fr, col0 = u.pn * BM + wc * 32 + 8 * fq;
#pragma unroll
        for (int ai = 0; ai < 2; ++ai)
#pragma unroll
            for (int m = 0; m < 4; ++m) { bf16_t* rowp = O + (size_t)(row0 + ai * HALF + m * 16) * ldc + col0;
#pragma unroll
                for (int bj = 0; bj < 2; ++bj) { const f32x4 v0 = acc[ai][bj][m][0], v1 = acc[ai][bj][m][1];
                    u32x4 w; w.x = cvt_pk_bf16(v0[0], v0[1]); w.y = cvt_pk_bf16(v0[2], v0[3]); w.z = cvt_pk_bf16(v1[0], v1[1]); w.w = cvt_pk_bf16(v1[2], v1[3]);
                    *(u32x4*)(rowp + bj * HALF) = w; } }
    } };
struct EpiHyT8 { static constexpr bool PERM = true, AFTER_DRAIN = false, INPLACE = false; bf16_t* O; const float* su;
    DEV void operator()(const f32x4 (&acc)[2][2][4][2], const Unit& u, int wr, int wc, int fr, int fq) const {
        const int row0 = u.pm * BM + wr * 64 + fr, col0 = u.pn * BM + wc * 32 + 8 * fq;
        f32x4 cs[2][2];
#pragma unroll
        for (int bj = 0; bj < 2; ++bj)
#pragma unroll
            for (int h = 0; h < 2; ++h) cs[bj][h] = *(const f32x4*)(su + col0 + bj * HALF + 4 * h) * (1.0f / WQ8_);
#pragma unroll
        for (int ai = 0; ai < 2; ++ai)
#pragma unroll
            for (int m = 0; m < 4; ++m) { bf16_t* rowp = O + (size_t)(row0 + ai * HALF + m * 16) * T_ + col0;
#pragma unroll
                for (int bj = 0; bj < 2; ++bj) { const i32x4 i0 = __builtin_bit_cast(i32x4, acc[ai][bj][m][0]), i1 = __builtin_bit_cast(i32x4, acc[ai][bj][m][1]);
                    const f32x4 v0 = (f32x4){(float)i0[0], (float)i0[1], (float)i0[2], (float)i0[3]} * cs[bj][0], v1 = (f32x4){(float)i1[0], (float)i1[1], (float)i1[2], (float)i1[3]} * cs[bj][1];
                    u32x4 w; w.x = cvt_pk_bf16(v0[0], v0[1]); w.y = cvt_pk_bf16(v0[2], v0[3]); w.z = cvt_pk_bf16(v1[0], v1[1]); w.w = cvt_pk_bf16(v1[2], v1[3]);
                    *(u32x4*)(rowp + bj * HALF) = w; } }
    } };
struct EpiP { static constexpr bool PERM = true, AFTER_DRAIN = false, INPLACE = false; bf16_t* P; const float2* rope; const float* su;
    DEV void operator()(const f32x4 (&acc)[2][2][4][2], const Unit& u, int wr, int wc, int fr, int fq) const {
        const int row0 = u.pm * BM + wr * 64 + fr, col0 = u.pn * BM + wc * 32 + 8 * fq; const int g = (wc & 1) * 4 + fq; const int pn = u.pn;
        const bool qs = (pn < 3) || (pn == 9) || (pn == 10);
#pragma unroll
        for (int ai = 0; ai < 2; ++ai)
#pragma unroll
            for (int m = 0; m < 4; ++m) { const int row = row0 + ai * HALF + m * 16; bf16_t* rowp = P + (size_t)row * PW_ + col0; const float rsc = su[row] * (1.0f / WQ8_);
                const float4* rp = (const float4*)(rope + (size_t)(row & 2047) * 32 + 4 * g); const float4 cs0 = rp[0], cs1 = rp[1];
                const float cc[4] = {cs0.x, cs0.z, cs1.x, cs1.z}, ss[4] = {cs0.y, cs0.w, cs1.y, cs1.w};
#pragma unroll
                for (int bj = 0; bj < 2; ++bj) { f32x4 v0, v1; { const i32x4 i0 = __builtin_bit_cast(i32x4, acc[ai][bj][m][0]), i1 = __builtin_bit_cast(i32x4, acc[ai][bj][m][1]);
                        v0 = (f32x4){(float)i0[0], (float)i0[1], (float)i0[2], (float)i0[3]} * rsc; v1 = (f32x4){(float)i1[0], (float)i1[1], (float)i1[2], (float)i1[3]} * rsc; }
                    const bool rp_ = (pn < 6) || (pn == 9) || (pn == 10) || (pn == 11 && bj == 0);
                    if (rp_) {
#pragma unroll
                        for (int j = 0; j < 4; ++j) { const float x1 = v0[j], x2 = v1[j]; float o1 = x1 * cc[j] - x2 * ss[j], o2 = x2 * cc[j] + x1 * ss[j];
                            if (qs) { o1 *= QSCALE_; o2 *= QSCALE_; } v0[j] = o1; v1[j] = o2; } }
                    u32x4 w; w.x = cvt_pk_bf16(v0[0], v0[1]); w.y = cvt_pk_bf16(v0[2], v0[3]); w.z = cvt_pk_bf16(v1[0], v1[1]); w.w = cvt_pk_bf16(v1[2], v1[3]);
                    *(u32x4*)(rowp + bj * HALF) = w; } }
    } };
struct EpiGate { static constexpr bool PERM = true, AFTER_DRAIN = false, INPLACE = false; bf16_t* g; const float* su;
    DEV void operator()(const f32x4 (&acc)[2][2][4][2], const Unit& u, int wr, int wc, int fr, int fq) const {
        bf16_t* gt = g + (size_t)(u.pn >> 2) * GSTRIDE_;
        const int row0 = u.pm * BM + wr * 64 + fr, col0 = (u.pn & 3) * BM + wc * 32 + 8 * fq;
#pragma unroll
        for (int ai = 0; ai < 2; ++ai)
#pragma unroll
            for (int m = 0; m < 4; ++m) { const size_t ro = (size_t)(row0 + ai * HALF + m * 16) * 1024 + col0; const float rsc = su[row0 + ai * HALF + m * 16] * (1.0f / WQ8_);
#pragma unroll
                for (int bj = 0; bj < 2; ++bj) { const i32x4 i0 = __builtin_bit_cast(i32x4, acc[ai][bj][m][0]), i1 = __builtin_bit_cast(i32x4, acc[ai][bj][m][1]); f32x4 v0, v1;
#pragma unroll
                    for (int j = 0; j < 4; ++j) { v0[j] = fmaxf(__builtin_amdgcn_rcpf(1.f + __expf(-(float)i0[j] * rsc)), 1e-30f); v1[j] = fmaxf(__builtin_amdgcn_rcpf(1.f + __expf(-(float)i1[j] * rsc)), 1e-30f); }
                    u32x4 w; w.x = cvt_pk_bf16(v0[0], v0[1]); w.y = cvt_pk_bf16(v0[2], v0[3]); w.z = cvt_pk_bf16(v1[0], v1[1]); w.w = cvt_pk_bf16(v1[2], v1[3]);
                    *(u32x4*)(gt + ro + bj * HALF) = w; } }
    } };
struct EpiBranch3 { static constexpr bool PERM = true, AFTER_DRAIN = false, INPLACE = true; const bf16_t* g; bf16_t* merged;
    DEV static void unpack8(const u32x4 q, float (&f)[8]) { f[0] = __uint_as_float(q.x << 16); f[1] = __uint_as_float(q.x & 0xffff0000u); f[2] = __uint_as_float(q.y << 16); f[3] = __uint_as_float(q.y & 0xffff0000u);
        f[4] = __uint_as_float(q.z << 16); f[5] = __uint_as_float(q.z & 0xffff0000u); f[6] = __uint_as_float(q.w << 16); f[7] = __uint_as_float(q.w & 0xffff0000u); }
    DEV void operator()(f32x4 (&acc)[2][2][4][2], const Unit& u, int wr, int wc, int fr, int fq) const {
        const int row0 = u.pm * BM + wr * 64 + fr, col0 = u.pn * BM + wc * 32 + 8 * fq; const int tag = u.tag;
        const bool fin = (tag == 2); const float keepf = fin ? 0.f : 1.f; const bf16_t* gn = g + (size_t)tag * GSTRIDE_; const bf16_t* gd = gn + GSTRIDE_;
#pragma unroll
        for (int ah = 0; ah < 4; ++ah) { const int ai = ah >> 1, m0 = (ah & 1) * 2; u32x4 nq[2][2], dq[2][2];
#pragma unroll
            for (int mm = 0; mm < 2; ++mm)
#pragma unroll
                for (int bj = 0; bj < 2; ++bj) { const size_t o = (size_t)(row0 + ai * HALF + (m0 + mm) * 16) * 1024 + col0 + bj * HALF; nq[mm][bj] = *(const u32x4*)(gn + o);
                    dq[mm][bj] = (u32x4){0x3f803f80u, 0x3f803f80u, 0x3f803f80u, 0x3f803f80u}; if (!fin) dq[mm][bj] = *(const u32x4*)(gd + o); }
            asm volatile("" ::: "memory");
#pragma unroll
            for (int mm = 0; mm < 2; ++mm)
#pragma unroll
                for (int bj = 0; bj < 2; ++bj) { const int m = m0 + mm; const size_t o = (size_t)(row0 + ai * HALF + m * 16) * 1024 + col0 + bj * HALF; float nn[8], dd[8]; unpack8(nq[mm][bj], nn); unpack8(dq[mm][bj], dd);
                    const f32x4 s0 = (f32x4){nn[0] * __builtin_amdgcn_rcpf(dd[0]), nn[1] * __builtin_amdgcn_rcpf(dd[1]), nn[2] * __builtin_amdgcn_rcpf(dd[2]), nn[3] * __builtin_amdgcn_rcpf(dd[3])};
                    const f32x4 s1 = (f32x4){nn[4] * __builtin_amdgcn_rcpf(dd[4]), nn[5] * __builtin_amdgcn_rcpf(dd[5]), nn[6] * __builtin_amdgcn_rcpf(dd[6]), nn[7] * __builtin_amdgcn_rcpf(dd[7])};
                    const f32x4 r0 = acc[ai][bj][m][0] * s0, r1 = acc[ai][bj][m][1] * s1;
                    if (fin) { u32x4 w; w.x = cvt_pk_bf16(r0[0], r0[1]); w.y = cvt_pk_bf16(r0[2], r0[3]); w.z = cvt_pk_bf16(r1[0], r1[1]); w.w = cvt_pk_bf16(r1[2], r1[3]); *(u32x4*)(merged + o) = w; }
                    acc[ai][bj][m][0] = r0 * keepf; acc[ai][bj][m][1] = r1 * keepf; asm volatile("" : "+v"(acc[ai][bj][m][0]), "+v"(acc[ai][bj][m][1])); }
            asm volatile("" ::: "memory"); }
    } };
struct EpiH { static constexpr bool PERM = true, AFTER_DRAIN = false, INPLACE = false; const float* xin; const bf16_t* xin16; bf16_t* hout; const float* ada_b;
    DEV void operator()(const f32x4 (&acc)[2][2][4][2], const Unit& u, int wr, int wc, int fr, int fq) const {
        const int row0 = u.pm * BM + wr * 64 + fr, col0 = u.pn * BM + wc * 32 + 8 * fq; const float* ab = ada_b + (size_t)(u.pm >> 3) * 6144 + 2048 + col0;
        const f32x4 g00 = *(const f32x4*)ab, g01 = *(const f32x4*)(ab + 4), g10 = *(const f32x4*)(ab + HALF), g11 = *(const f32x4*)(ab + HALF + 4);
        if (xin) {
#pragma unroll
            for (int ah = 0; ah < 4; ++ah) { const int ai = ah >> 1, m0 = (ah & 1) * 2; f32x4 xa[2][2][2];
#pragma unroll
                for (int mm = 0; mm < 2; ++mm)
#pragma unroll
                    for (int bj = 0; bj < 2; ++bj) { const float* xp = xin + (size_t)(row0 + ai * HALF + (m0 + mm) * 16) * 1024 + col0 + bj * HALF; xa[mm][bj][0] = *(const f32x4*)xp; xa[mm][bj][1] = *(const f32x4*)(xp + 4); }
                asm volatile("" ::: "memory");
#pragma unroll
                for (int mm = 0; mm < 2; ++mm)
#pragma unroll
                    for (int bj = 0; bj < 2; ++bj) { const int m = m0 + mm; const f32x4 h0 = ALPHA_ * xa[mm][bj][0] + (bj ? g10 : g00) * acc[ai][bj][m][0], h1 = ALPHA_ * xa[mm][bj][1] + (bj ? g11 : g01) * acc[ai][bj][m][1];
                        u32x4 w; w.x = cvt_pk_bf16(h0[0], h0[1]); w.y = cvt_pk_bf16(h0[2], h0[3]); w.z = cvt_pk_bf16(h1[0], h1[1]); w.w = cvt_pk_bf16(h1[2], h1[3]);
                        *(u32x4*)(hout + (size_t)(row0 + ai * HALF + m * 16) * 1024 + col0 + bj * HALF) = w; }
                asm volatile("" ::: "memory"); }
        } else {
#pragma unroll
            for (int ai = 0; ai < 2; ++ai) { u32x4 xq[4][2];
#pragma unroll
                for (int m = 0; m < 4; ++m)
#pragma unroll
                    for (int bj = 0; bj < 2; ++bj) xq[m][bj] = *(const u32x4*)(xin16 + (size_t)(row0 + ai * HALF + m * 16) * 1024 + col0 + bj * HALF);
                asm volatile("" ::: "memory");
#pragma unroll
                for (int m = 0; m < 4; ++m)
#pragma unroll
                    for (int bj = 0; bj < 2; ++bj) { const u32x4 q = xq[m][bj];
                        const f32x4 x0 = (f32x4){__uint_as_float(q.x << 16), __uint_as_float(q.x & 0xffff0000u), __uint_as_float(q.y << 16), __uint_as_float(q.y & 0xffff0000u)}, x1 = (f32x4){__uint_as_float(q.z << 16), __uint_as_float(q.z & 0xffff0000u), __uint_as_float(q.w << 16), __uint_as_float(q.w & 0xffff0000u)};
                        const f32x4 h0 = ALPHA_ * x0 + (bj ? g10 : g00) * acc[ai][bj][m][0], h1 = ALPHA_ * x1 + (bj ? g11 : g01) * acc[ai][bj][m][1];
                        u32x4 w; w.x = cvt_pk_bf16(h0[0], h0[1]); w.y = cvt_pk_bf16(h0[2], h0[3]); w.z = cvt_pk_bf16(h1[0], h1[1]); w.w = cvt_pk_bf16(h1[2], h1[3]);
                        *(u32x4*)(hout + (size_t)(row0 + ai * HALF + m * 16) * 1024 + col0 + bj * HALF) = w; }
                asm volatile("" ::: "memory"); }
        }
    } };
struct PanelStats {
    unsigned* xbuf;
    unsigned* cnt;
    unsigned* tmo;
    float eps;
    DEV bool run(const f32x4 (&v)[2][2][4][2], const Unit& u, int wr, int wc, int fr, int fq, LAS unsigned char* lds, int wid, int lane) const {
        LAS f32x2* Pt = (LAS f32x2*)lds;
        LAS f32x2* S = (LAS f32x2*)(lds + 8192);
        LAS unsigned* flag = (LAS unsigned*)(lds + 8192 + 2048);
#pragma unroll
        for (int ai = 0; ai < 2; ++ai)
#pragma unroll
            for (int m = 0; m < 4; ++m) {
                float s = 0.f;
#pragma unroll
                for (int bj = 0; bj < 2; ++bj)
#pragma unroll
                    for (int n = 0; n < 2; ++n) { const f32x4 x = v[ai][bj][m][n]; s += (x[0] + x[1]) + (x[2] + x[3]); }
                s += xor_f(s, 16, lane); s += xor_f(s, 32, lane);
                const float mw = s * (1.0f / 64.0f); float q = 0.f;
#pragma unroll
                for (int bj = 0; bj < 2; ++bj)
#pragma unroll
                    for (int n = 0; n < 2; ++n) { const f32x4 d = v[ai][bj][m][n] - mw; q += (d[0] * d[0] + d[1] * d[1]) + (d[2] * d[2] + d[3] * d[3]); }
                q += xor_f(q, 16, lane); q += xor_f(q, 32, lane);
                if (fq == 0) Pt[(ai * HALF + wr * 64 + m * 16 + fr) * 4 + wc] = (f32x2){mw, q};
            }
        asm volatile("s_waitcnt lgkmcnt(0)" ::: "memory"); __builtin_amdgcn_s_barrier(); asm volatile("" ::: "memory");
        const int row = wid * 32 + (lane & 31);
        if (lane < 32) {
            const f32x2 a = Pt[row * 4 + 0], b = Pt[row * 4 + 1], c = Pt[row * 4 + 2], d = Pt[row * 4 + 3];
            const float mt = (a.x + b.x + c.x + d.x) * 0.25f;
            const float da = a.x - mt, db = b.x - mt, dc = c.x - mt, dd = d.x - mt;
            const float m2 = (a.y + b.y) + (c.y + d.y) + 64.0f * ((da * da + db * db) + (dc * dc + dd * dd));
            unsigned long long* slot = (unsigned long long*)xbuf + ((size_t)(u.pm * BM + row) * 4 + u.pn);
            __hip_atomic_store(slot, ((unsigned long long)__float_as_uint(m2) << 32) | __float_as_uint(mt), __ATOMIC_RELAXED, __HIP_MEMORY_SCOPE_AGENT);
        }
        asm volatile("s_waitcnt vmcnt(0)" ::: "memory");
        if (lane == 0) __hip_atomic_fetch_add(cnt + 64 * u.pm, 1u, __ATOMIC_RELAXED, __HIP_MEMORY_SCOPE_AGENT);
        if (wid == 0) {
            bool dead = false; const unsigned long long t0 = __builtin_amdgcn_s_memrealtime();
            for (;;) {
                if ((unsigned)__builtin_amdgcn_readfirstlane(__hip_atomic_load(cnt + 64 * u.pm, __ATOMIC_RELAXED, __HIP_MEMORY_SCOPE_AGENT)) >= 32u) break;
                if (__builtin_amdgcn_s_memrealtime() - t0 > 2000000ull) { if (lane == 0) __hip_atomic_store(tmo, 1u, __ATOMIC_RELAXED, __HIP_MEMORY_SCOPE_AGENT); dead = true; break; }
                __builtin_amdgcn_s_sleep(2);
            }
            __builtin_amdgcn_fence(__ATOMIC_ACQUIRE, "agent");
            if (lane == 0) flag[0] = dead ? 1u : 0u;
        }
        asm volatile("s_waitcnt vmcnt(0) lgkmcnt(0)" ::: "memory"); __builtin_amdgcn_s_barrier(); asm volatile("" ::: "memory");
        const bool bad = flag[0] != 0u;
        if (lane < 32) {
            const unsigned long long* slot = (const unsigned long long*)xbuf + (size_t)(u.pm * BM + row) * 4; float mt[4], m2[4]; float ms = 0.f;
#pragma unroll
            for (int t = 0; t < 4; ++t) { const unsigned long long wv = __hip_atomic_load(slot + t, __ATOMIC_RELAXED, __HIP_MEMORY_SCOPE_AGENT); mt[t] = __uint_as_float((unsigned)wv); m2[t] = __uint_as_float((unsigned)(wv >> 32)); ms += mt[t]; }
            const float mean = ms * 0.25f; float q = 0.f;
#pragma unroll
            for (int t = 0; t < 4; ++t) { const float dm = mt[t] - mean; q += m2[t] + 256.0f * dm * dm; }
            S[row] = (f32x2){mean, 1.0f / sqrtf(q * (1.0f / 1024.0f) + eps)};
        }
        asm volatile("s_waitcnt lgkmcnt(0)" ::: "memory"); __builtin_amdgcn_s_barrier(); asm volatile("" ::: "memory");
        return bad;
    }
};
struct EpiOutLn { static constexpr bool PERM = false, AFTER_DRAIN = true, INPLACE = false; const float* xin; const bf16_t* xin16; bf16_t* xout;   const float* ada_b; const float* lng; const float* lnb; bf16_t* UY; PanelStats st;
    DEV void operator()(const f32x4 (&)[2][2][4][2], const Unit&, int, int, int, int) const {}
    DEV void fused(f32x4 (&acc)[2][2][4][2], const Unit& u, int wr, int wc, int fr, int fq, LAS unsigned char* lds, int wid, int lane) const {
        const LAS f32x2* S = (const LAS f32x2*)(lds + 8192);
        const int col0 = u.pn * BM + wc * 32 + 4 * fq; const float* ab = ada_b + (size_t)(u.pm >> 3) * 6144;
#pragma unroll
        for (int bj = 0; bj < 2; ++bj)
#pragma unroll
            for (int n = 0; n < 2; ++n) { const int cc = col0 + bj * HALF + n * 16; const f32x4 g1 = *(const f32x4*)(ab + 2048 + cc);
#pragma unroll
                for (int ai = 0; ai < 2; ++ai) {
#pragma unroll
                    for (int m = 0; m < 4; ++m) { const size_t xo_ = (size_t)(u.pm * BM + ai * HALF + wr * 64 + m * 16 + fr) * 1024 + cc; f32x4 xv;
                        if (xin) xv = *(const f32x4*)(xin + xo_); else { const u32x2 xq = *(const u32x2*)(xin16 + xo_); xv = (f32x4){__uint_as_float(xq.x << 16), __uint_as_float(xq.x & 0xffff0000u), __uint_as_float(xq.y << 16), __uint_as_float(xq.y & 0xffff0000u)}; }
                        acc[ai][bj][m][n] = ALPHA_ * xv + g1 * acc[ai][bj][m][n]; }
                    asm volatile("" : "+v"(acc[ai][bj][0][n]), "+v"(acc[ai][bj][1][n]), "+v"(acc[ai][bj][2][n]), "+v"(acc[ai][bj][3][n]) :: "memory"); } }
        const bool bad = st.run(acc, u, wr, wc, fr, fq, lds, wid, lane);
        const float qnan = __builtin_nanf("");
#pragma unroll
        for (int bj = 0; bj < 2; ++bj)
#pragma unroll
            for (int n = 0; n < 2; ++n) { const int cc = col0 + bj * HALF + n * 16; const f32x4 gg = *(const f32x4*)(lng + cc), bb = *(const f32x4*)(lnb + cc), sc = *(const f32x4*)(ab + 4096 + cc), sh = *(const f32x4*)(ab + 3072 + cc);
#pragma unroll
                for (int ai = 0; ai < 2; ++ai)
#pragma unroll
                    for (int m = 0; m < 4; ++m) { const int r = ai * HALF + wr * 64 + m * 16 + fr; const f32x2 sr = S[r]; const size_t row = (size_t)(u.pm * BM + r);
                        f32x4 y = (acc[ai][bj][m][n] - sr.x) * sr.y * gg + bb; if (bad) y = (f32x4){qnan, qnan, qnan, qnan};
                        { u32x2 xk; xk.x = cvt_pk_bf16(y[0], y[1]); xk.y = cvt_pk_bf16(y[2], y[3]); *(u32x2*)(xout + row * 1024 + cc) = xk; }
                        const f32x4 uu = y * (1.0f + sc) + sh; u32x2 pk; pk.x = cvt_pk_bf16(uu[0], uu[1]); pk.y = cvt_pk_bf16(uu[2], uu[3]);
                        *(u32x2*)(UY + row * UYW_ + cc) = pk; }
                asm volatile("" ::: "memory"); }
        asm volatile("s_waitcnt lgkmcnt(0)" ::: "memory"); __builtin_amdgcn_s_barrier(); asm volatile("" ::: "memory");
    }
};
struct GateSched { const bf16_t* UY; const unsigned char* WmT8; int G, c;
    DEV bool next(int i, Unit& u) const { const long L = (long)i * G + c; if (L >= 128 * 12) return false; tile_of((int)L, 128, 12, u.pm, u.pn); u.tag = 0; u.nt = 8;
        u.a = (const char*)(UY + (size_t)u.pm * BM * UYW_); u.b = (const char*)(WmT8 + (size_t)(u.pn & 3) * BM * (WMW_ * 2)) + (u.pn >> 2) * 1024; return true; } };
struct Branch3Sched { const bf16_t* UY; const unsigned char* WmT8; int G, c;
    DEV bool next(int i, Unit& u) const { const int ti = i / 3, ps = i - ti * 3; const long L = (long)ti * G + c; if (L >= 128 * 4) return false; tile_of((int)L, 128, 4, u.pm, u.pn); u.tag = ps;
        const int koff = ps == 0 ? 0 : (ps == 1 ? 256 : 768); u.nt = ps == 0 ? 4 : 8;
        u.a = (const char*)(UY + (size_t)u.pm * BM * UYW_) + (1024 + koff) * 2; u.b = (const char*)(WmT8 + (size_t)u.pn * BM * (WMW_ * 2)) + 3072 + koff * 2; return true; } };
}

DEV int win_orig_col(int n) {
    if (n >= 3072) return n < 4608 ? (n - 3072 + 2304) : n;
    const int head = n >> 6, p = n & 63; const bool rp = (head < 24) || (head >= 36 && head < 46);
    const int d = rp ? ((p & 4) ? 32 + 4 * (p >> 3) + (p & 3) : 4 * (p >> 3) + (p & 3)) : p;
    return ((n < 2304) ? head * 64 : 3840 + (head - 36) * 64) + d;
}
struct WPrep { const float *w_in, *wba, *wbb, *wbc, *w_out, *peer_wq; unsigned char *WinT8, *WmT8; bf16_t *WoutT, *WqT; };
DEV void nb_wprep(int vb, int t, unsigned char* sm, const WPrep& q) {
    const int l = vb / 3008; int r = vb - l * 3008; const float* W; int ldw; bf16_t* Wt = nullptr; unsigned char* W8 = nullptr; int ldt = 0, ld8 = 0, koff = 0, ntk = 16, mode = 0, nsub = 0;
    if (r < 1920) { W = q.w_in + (size_t)l * 1024 * 7680; ldw = 7680; mode = 1;
        if (r < 72 * 16) { W8 = q.WinT8 + (size_t)l * 4608 * 1024; ld8 = 1024; }
        else { const int br = (r / 16 - 72) / 16; W8 = q.WmT8 + (size_t)l * 1024 * (WMW_ * 2) + br * 1024; ld8 = WMW_ * 2; nsub = 4608 + br * 1024; } }
    else if (r < 1984) { r -= 1920; W = q.wba + (size_t)l * 256 * 1024; ldw = 1024; Wt = (bf16_t*)(q.WmT8 + (size_t)l * 1024 * (WMW_ * 2) + 3072); ldt = WMW_; koff = 0; ntk = 4; }
    else if (r < 2112) { r -= 1984; W = q.wbb + (size_t)l * 512 * 1024; ldw = 1024; Wt = (bf16_t*)(q.WmT8 + (size_t)l * 1024 * (WMW_ * 2) + 3072); ldt = WMW_; koff = 256; ntk = 8; }
    else if (r < 2240) { r -= 2112; W = q.wbc + (size_t)l * 512 * 1024; ldw = 1024; Wt = (bf16_t*)(q.WmT8 + (size_t)l * 1024 * (WMW_ * 2) + 3072); ldt = WMW_; koff = 768; ntk = 8; }
    else if (r < 2496) { r -= 2240; W = q.w_out + (size_t)l * 1024 * 1024; ldw = 1024; Wt = q.WoutT + (size_t)l * 1024 * 1024; ldt = 1024; }
    else { r -= 2496; W = q.peer_wq + (size_t)l * 1024 * 2048; ldw = 2048; Wt = q.WqT + (size_t)l * 2048 * 1024; ldt = 1024; }
    const int n0 = (r / ntk) * 64, k0 = (r % ntk) * 64; const int c0 = mode ? (win_orig_col(n0) & ~63) : n0;
    bf16_t* tile = (bf16_t*)sm;
    { const int kk = t >> 2, cs = (t & 3) * 16; const float* src = W + (size_t)(k0 + kk) * ldw + c0 + cs;
#pragma unroll
        for (int i = 0; i < 16; i += 4) { const float4 v = *(const float4*)(src + i); tile[kk * 66 + cs + i] = f2bf(v.x); tile[kk * 66 + cs + i + 1] = f2bf(v.y); tile[kk * 66 + cs + i + 2] = f2bf(v.z); tile[kk * 66 + cs + i + 3] = f2bf(v.w); } }
    __syncthreads();
    if (W8) { const int nn = t >> 2, ks = (t & 3) * 16; const int dl = win_orig_col(n0 + nn) - c0; unsigned char* dst8 = W8 + (size_t)(n0 + nn - nsub) * ld8 + k0 + ks; unsigned w8[4];
#pragma unroll
        for (int i = 0; i < 4; ++i) { w8[i] = 0u;
#pragma unroll
            for (int j = 0; j < 4; ++j) { const int qv = (int)rintf(fminf(fmaxf(bf2f(tile[(ks + 4 * i + j) * 66 + dl]) * WQ8_, -127.f), 127.f)); w8[i] |= ((unsigned)qv & 0xffu) << (8 * j); } }
        *(u32x4*)dst8 = (u32x4){w8[0], w8[1], w8[2], w8[3]}; }
    else { const int nn = t >> 2, ks = (t & 3) * 16; const int dl = mode ? (win_orig_col(n0 + nn) - c0) : nn; bf16_t* dst = Wt + (size_t)(n0 + nn - nsub) * ldt + koff + k0 + ks;
        unsigned w[8];
#pragma unroll
        for (int i = 0; i < 8; ++i) w[i] = (unsigned)tile[(ks + 2 * i) * 66 + dl] | ((unsigned)tile[(ks + 2 * i + 1) * 66 + dl] << 16);
        *(u32x4*)dst = (u32x4){w[0], w[1], w[2], w[3]}; *(u32x4*)(dst + 8) = (u32x4){w[4], w[5], w[6], w[7]}; }
}

namespace hy {
constexpr int ZS = 2064;
constexpr int G0_OFF = 0, G1_OFF = 8192, Z0_OFF = 16384, Z1_OFF = Z0_OFF + 16 * ZS * 2, LDS_END = Z1_OFF + 16 * ZS * 2;
DEV bf16x8 load_frag(LAS const unsigned char* lane_base, int d) {
    const LAS unsigned* p = (const LAS unsigned*)(lane_base + 32 * d); u32x4 w; w.x = p[0]; w.y = p[1]; w.z = p[2]; w.w = p[3];
    return __builtin_bit_cast(bf16x8, w);
}
DEV void load_filter(LAS unsigned char* lds, const bf16_t* g, int tid) {
    const u32x4 c = *(const u32x4*)(g + tid * 8); const unsigned nx = (tid < 511) ? (unsigned)g[tid * 8 + 8] : 0u;
    *(LAS u32x4*)(lds + G0_OFF + tid * 16) = c;
    u32x4 s; s.x = (c.x >> 16) | (c.y << 16); s.y = (c.y >> 16) | (c.z << 16); s.z = (c.z >> 16) | (c.w << 16); s.w = (c.w >> 16) | (nx << 16);
    *(LAS u32x4*)(lds + G1_OFF + tid * 16) = s;
}
DEV float bflo(unsigned w) { return __uint_as_float(w << 16); }
DEV float bfhi(unsigned w) { return __uint_as_float(w & 0xffff0000u); }
DEV void conv_rows(LAS const unsigned char* lds, int zoff, int w, int lane, f32x4 (&D)[16]) {
    const int r = lane & 15, q = lane >> 4;
    LAS const unsigned char* abase = lds + ((r & 1) ? (G0_OFF + 2 * (8 * q - r + 2047)) : (G1_OFF + 2 * (8 * q - r + 2046)));
    LAS const unsigned char* bbase = lds + zoff + (r * ZS + 8 * q) * 2;
    bf16x8 ring[16];
#pragma unroll
    for (int rb = 0; rb < 16; ++rb) D[rb] = (f32x4){0.f, 0.f, 0.f, 0.f};
#pragma unroll
    for (int rb = 2; rb < 16; ++rb) ring[rb] = load_frag(abase, -16 * w - rb);
#pragma unroll 1
    for (int jb0 = 0; jb0 < 64; jb0 += 8) {
#pragma unroll
        for (int u = 0; u < 8; ++u) { const int jb = jb0 + u;
            ring[(16 - 2 * u) & 15] = load_frag(abase, 2 * jb - 16 * w);
            ring[(17 - 2 * u) & 15] = load_frag(abase, 2 * jb - 16 * w - 1);
            const bf16x8 bf = *(const LAS bf16x8*)(bbase + 64 * jb);
#pragma unroll
            for (int rb = 0; rb < 16; ++rb) D[rb] = __builtin_amdgcn_mfma_f32_16x16x32_bf16(ring[(rb - 2 * u) & 15], bf, D[rb], 0, 0, 0);
        }
    }
}
DEV void sconv4(const bf16_t* in, int i, float w0, float w1, float w2, float cb, float (&o)[4]) {
    const u32x2 v = *(const u32x2*)(in + i); const float pm = (i > 0) ? bf2f(in[i - 1]) : 0.f, pn = (i + 4 < 2048) ? bf2f(in[i + 4]) : 0.f;
    const float x0 = bflo(v.x), x1 = bfhi(v.x), x2 = bflo(v.y), x3 = bfhi(v.y);
    o[0] = cb + w0 * pm + w1 * x0 + w2 * x1; o[1] = cb + w0 * x0 + w1 * x1 + w2 * x2; o[2] = cb + w0 * x1 + w1 * x2 + w2 * x3; o[3] = cb + w0 * x2 + w1 * x3 + w2 * pn;
}
DEV void hyena_phase(LAS unsigned char* lds, bf16_t* hyT, const bf16_t* Gr_l, const float* conv_w, const float* conv_b, const float* hy_bias, int G, int cblk, int wv) {
    int wv_ = wv, ln_; asm volatile("v_mbcnt_lo_u32_b32 %1, -1, 0\n\tv_mbcnt_hi_u32_b32 %1, -1, %1" : "+s"(wv_), "=v"(ln_)); int tid_ = (wv_ << 6) | ln_;
    const int tid = tid_, w = __builtin_amdgcn_readfirstlane(tid >> 6), lane = tid & 63, q = lane >> 4, b = lane & 15;
#pragma unroll 1
    for (int c = cblk; c < 512; c += G) {
        __syncthreads();
        load_filter(lds, Gr_l + (size_t)c * 4096, tid);
        { const float w0 = conv_w[c], w1 = conv_w[1536 + c], w2 = conv_w[3072 + c], cb = conv_b[c]; const bf16_t* row = hyT + (size_t)c * T_;
#pragma unroll 2
            for (int k = 0; k < 8; ++k) { const int pos = (k * 512 + tid) * 8; const int s = pos & 2047, bb = pos >> 11;
                const u32x4 v = *(const u32x4*)(row + pos); const float pm = (s > 0) ? bf2f(row[pos - 1]) : 0.f, pn = (s + 8 < 2048) ? bf2f(row[pos + 8]) : 0.f;
                const float x[10] = {pm, bflo(v.x), bfhi(v.x), bflo(v.y), bfhi(v.y), bflo(v.z), bfhi(v.z), bflo(v.w), bfhi(v.w), pn};
                float z[8];
#pragma unroll
                for (int e = 0; e < 8; ++e) z[e] = cb + w0 * x[e] + w1 * x[e + 1] + w2 * x[e + 2];
                u32x4 o; o.x = pg8::cvt_pk_bf16(z[0], z[1]); o.y = pg8::cvt_pk_bf16(z[2], z[3]); o.z = pg8::cvt_pk_bf16(z[4], z[5]); o.w = pg8::cvt_pk_bf16(z[6], z[7]);
                *(LAS u32x4*)(lds + Z0_OFF + (bb * ZS + s) * 2) = o; } }
        __syncthreads();
        f32x4 D[16];
        conv_rows(lds, Z0_OFF, w, lane, D);
        { const int xc = 512 + c; const float w0 = conv_w[xc], w1 = conv_w[1536 + xc], w2 = conv_w[3072 + xc], cb = conv_b[xc], bias = hy_bias[c]; const bf16_t* xin = hyT + (size_t)xc * T_ + b * 2048;
#pragma unroll
            for (int rb = 0; rb < 16; ++rb) { const int i = 256 * w + 16 * rb + 4 * q; float xv[4]; sconv4(xin, i, w0, w1, w2, cb, xv);
                const u32x2 zq = *(const LAS u32x2*)(lds + Z0_OFF + (b * ZS + i) * 2); const float zv[4] = {bflo(zq.x), bfhi(zq.x), bflo(zq.y), bfhi(zq.y)};
                float o[4];
#pragma unroll
                for (int e = 0; e < 4; ++e) o[e] = xv[e] * (D[rb][e] + bias * zv[e]);
                u32x2 pk; pk.x = pg8::cvt_pk_bf16(o[0], o[1]); pk.y = pg8::cvt_pk_bf16(o[2], o[3]);
                *(LAS u32x2*)(lds + Z1_OFF + (b * ZS + i) * 2) = pk; } }
        __syncthreads();
        load_filter(lds, Gr_l + (size_t)(512 + c) * 4096, tid);
        __syncthreads();
        conv_rows(lds, Z1_OFF, w, lane, D);
        { const int xc = 1024 + c; const float w0 = conv_w[xc], w1 = conv_w[1536 + xc], w2 = conv_w[3072 + xc], cb = conv_b[xc], bias = hy_bias[512 + c]; const bf16_t* xin = hyT + (size_t)xc * T_ + b * 2048;
            bf16_t* yout = hyT + (size_t)c * T_ + b * 2048;
#pragma unroll
            for (int rb = 0; rb < 16; ++rb) { const int i = 256 * w + 16 * rb + 4 * q; float xv[4]; sconv4(xin, i, w0, w1, w2, cb, xv);
                const u32x2 zq = *(const LAS u32x2*)(lds + Z1_OFF + (b * ZS + i) * 2); const float zv[4] = {bflo(zq.x), bfhi(zq.x), bflo(zq.y), bfhi(zq.y)};
                float o[4];
#pragma unroll
                for (int e = 0; e < 4; ++e) o[e] = xv[e] * (D[rb][e] + bias * zv[e]);
                u32x2 pk; pk.x = pg8::cvt_pk_bf16(o[0], o[1]); pk.y = pg8::cvt_pk_bf16(o[2], o[3]);
                *(u32x2*)(yout + i) = pk; } }
    }
    __syncthreads();
}
}

namespace peer {
DEV float wave_sum(float v, int lane) {
#pragma unroll
    for (int off = 32; off > 0; off >>= 1) v += xor_f(v, off, lane);
    return v;
}
DEV float wave_max(float v, int lane) {
#pragma unroll
    for (int off = 32; off > 0; off >>= 1) v = fmaxf(v, xor_f(v, off, lane));
    return v;
}
DEV unsigned pk4_fp8(float a, float b, float c, float d) { int w = __builtin_amdgcn_cvt_pk_fp8_f32(a, b, 0, false); w = __builtin_amdgcn_cvt_pk_fp8_f32(c, d, w, true); return (unsigned)w; }
DEV void nb_quant_tables(int vb, int t, const float* __restrict__ pu, const float* __restrict__ pv, unsigned char* __restrict__ U8, unsigned char* __restrict__ V4, float* __restrict__ sinv) {
    const int row = vb * 4 + (t >> 6), lane = t & 63; const float* src = (row < 16384) ? pu + (size_t)row * 1024 : pv + (size_t)(row - 16384) * 1024;
    const float4 a = *(const float4*)(src + 16 * lane), b = *(const float4*)(src + 16 * lane + 4), c = *(const float4*)(src + 16 * lane + 8), d = *(const float4*)(src + 16 * lane + 12);
    float mx = fmaxf(fmaxf(fmaxf(fabsf(a.x), fabsf(a.y)), fmaxf(fabsf(a.z), fabsf(a.w))), fmaxf(fmaxf(fabsf(b.x), fabsf(b.y)), fmaxf(fabsf(b.z), fabsf(b.w))));
    mx = fmaxf(mx, fmaxf(fmaxf(fmaxf(fabsf(c.x), fabsf(c.y)), fmaxf(fabsf(c.z), fabsf(c.w))), fmaxf(fmaxf(fabsf(d.x), fabsf(d.y)), fmaxf(fabsf(d.z), fabsf(d.w)))));
    mx = wave_max(mx, lane);
    {
        const float sc = (mx > 0.f) ? 6.f / mx : 0.f; unsigned w0 = 0u, w1 = 0u; const bool sw = false;
        w0 = __builtin_amdgcn_cvt_scalef32_pk_fp4_f32(w0, (sw ? a.y : a.x) * sc, (sw ? a.x : a.y) * sc, 1.0f, 0); w0 = __builtin_amdgcn_cvt_scalef32_pk_fp4_f32(w0, (sw ? a.w : a.z) * sc, (sw ? a.z : a.w) * sc, 1.0f, 1);
        w0 = __builtin_amdgcn_cvt_scalef32_pk_fp4_f32(w0, (sw ? b.y : b.x) * sc, (sw ? b.x : b.y) * sc, 1.0f, 2); w0 = __builtin_amdgcn_cvt_scalef32_pk_fp4_f32(w0, (sw ? b.w : b.z) * sc, (sw ? b.z : b.w) * sc, 1.0f, 3);
        w1 = __builtin_amdgcn_cvt_scalef32_pk_fp4_f32(w1, (sw ? c.y : c.x) * sc, (sw ? c.x : c.y) * sc, 1.0f, 0); w1 = __builtin_amdgcn_cvt_scalef32_pk_fp4_f32(w1, (sw ? c.w : c.z) * sc, (sw ? c.z : c.w) * sc, 1.0f, 1);
        w1 = __builtin_amdgcn_cvt_scalef32_pk_fp4_f32(w1, (sw ? d.y : d.x) * sc, (sw ? d.x : d.y) * sc, 1.0f, 2); w1 = __builtin_amdgcn_cvt_scalef32_pk_fp4_f32(w1, (sw ? d.w : d.z) * sc, (sw ? d.z : d.w) * sc, 1.0f, 3);
        unsigned char* dst = (row < 16384) ? U8 + (size_t)row * 512 : V4 + (size_t)(row - 16384) * 512;
        *(u32x2*)(dst + 8 * lane) = (u32x2){w0, w1};
        if (lane == 0) sinv[row] = (mx > 0.f) ? mx * (1.f / 6.f) : 0.f;
    }
}
DEV void peer_phase(LAS unsigned char* lds, const bf16_t* __restrict__ x1in, float* xout32, bf16_t* xout16, const float* ada_l,
                    const int* __restrict__ eidx, const float* __restrict__ egate, const unsigned char* __restrict__ U8, const unsigned char* __restrict__ V4,
                    const float* __restrict__ sinv, const float* __restrict__ g, const float* __restrict__ bta, const float* ada_next, bf16_t* UY, float* su_next, int G, int cblk, int wv) {
    int wv_ = wv, ln_; asm volatile("v_mbcnt_lo_u32_b32 %1, -1, 0\n\tv_mbcnt_hi_u32_b32 %1, -1, %1" : "+s"(wv_), "=v"(ln_)); int tid_ = (wv_ << 6) | ln_;
    const int tid = tid_, w = __builtin_amdgcn_readfirstlane(tid >> 6), lane = tid & 63;
    LAS unsigned char* urow_l = lds + w * 3072; LAS int* E_l = (LAS int*)(urow_l + 1024); LAS float* W_l = (LAS float*)(urow_l + 1536); LAS float* SU_l = (LAS float*)(urow_l + 2048); LAS float* SV_l = (LAS float*)(urow_l + 2560); LAS unsigned char* stage_l = lds + 24576 + w * 8448;
#define PEER_SB __builtin_amdgcn_sched_barrier(0)
#define PEER_ISSUE_U(buf, gi) do { _Pragma("unroll") for (int n2 = 0; n2 < 8; ++n2) { const int e_ = E_l[(gi) * 16 + 2 * n2 + hh]; buf[n2] = *(const u32x4*)(U8 + (size_t)e_ * 512 + 16 * r32); } } while (0)
#define PEER_ISSUE_V(buf, gi) do { _Pragma("unroll") for (int n2 = 0; n2 < 8; ++n2) { const int e_ = E_l[(gi) * 16 + 2 * n2 + hh]; buf[n2] = *(const u32x4*)(V4 + (size_t)e_ * 512 + 16 * r32); } } while (0)
#define PEER_COMP_U(buf) do { _Pragma("unroll") for (int n2 = 0; n2 < 8; ++n2) *(LAS u32x4*)(stage_l + (2 * n2 + hh) * 528 + 16 * r32) = buf[n2]; asm volatile("s_waitcnt lgkmcnt(0)" ::: "memory"); \
        _Pragma("unroll") for (int k2 = 0; k2 < 8; ++k2) { const u32x4 bw = *(const LAS u32x4*)(stage_l + n * 528 + 64 * k2 + 16 * q); const u32x4 alo = *(const LAS u32x4*)(urow_l + 128 * k2 + 16 * q), ahi = *(const LAS u32x4*)(urow_l + 128 * k2 + 64 + 16 * q);     \
            const i32x8 av = (i32x8){(int)alo.x, (int)alo.y, (int)alo.z, (int)alo.w, (int)ahi.x, (int)ahi.y, (int)ahi.z, (int)ahi.w}; const i32x8 bv = (i32x8){(int)bw.x, (int)bw.y, (int)bw.z, (int)bw.w, 0, 0, 0, 0}; \
            acc = __builtin_amdgcn_mfma_scale_f32_16x16x128_f8f6f4(av, bv, acc, 0  , 4  , 0, 0x7F7F7F7F, 0, 0x7F7F7F7F); } } while (0)
#define PEER_UNPK(wd, base) do { const f32x2 p0_ = __builtin_amdgcn_cvt_scalef32_pk_f32_fp4((wd), 1.0f, 0), p1_ = __builtin_amdgcn_cvt_scalef32_pk_f32_fp4((wd), 1.0f, 1), p2_ = __builtin_amdgcn_cvt_scalef32_pk_f32_fp4((wd), 1.0f, 2), p3_ = __builtin_amdgcn_cvt_scalef32_pk_f32_fp4((wd), 1.0f, 3); \
            o[base + 0] += wt * p0_[0]; o[base + 1] += wt * p0_[1]; o[base + 2] += wt * p1_[0]; o[base + 3] += wt * p1_[1]; o[base + 4] += wt * p2_[0]; o[base + 5] += wt * p2_[1]; o[base + 6] += wt * p3_[0]; o[base + 7] += wt * p3_[1]; } while (0)
#define PEER_COMP_V(buf, gi) do { _Pragma("unroll") for (int n2 = 0; n2 < 8; ++n2) { const float wt = W_l[(gi) * 16 + 2 * n2 + hh]; u32x4 v = buf[n2]; \
              \
            asm volatile("" : "+v"(v.x), "+v"(v.y), "+v"(v.z), "+v"(v.w), "+v"(o[0]), "+v"(o[1]), "+v"(o[2]), "+v"(o[3]), "+v"(o[4]), "+v"(o[5]), "+v"(o[6]), "+v"(o[7]), "+v"(o[8]), "+v"(o[9]), "+v"(o[10])); asm volatile("" : "+v"(o[11]), "+v"(o[12]), "+v"(o[13]), "+v"(o[14]), "+v"(o[15]), "+v"(o[16]), "+v"(o[17]), "+v"(o[18]), "+v"(o[19]), "+v"(o[20]), "+v"(o[21])); asm volatile("" : "+v"(o[22]), "+v"(o[23]), "+v"(o[24]), "+v"(o[25]), "+v"(o[26]), "+v"(o[27]), "+v"(o[28]), "+v"(o[29]), "+v"(o[30]), "+v"(o[31])); \
            PEER_UNPK(v.x, 0); PEER_UNPK(v.y, 8); PEER_UNPK(v.z, 16); PEER_UNPK(v.w, 24); } } while (0)
    int ne0 = 0, ne1 = 0; float ng0 = 0.f, ng1 = 0.f, nsu0 = 0.f, nsu1 = 0.f, nsv0 = 0.f, nsv1 = 0.f; u32x4 nx0 = (u32x4){0u, 0u, 0u, 0u}, nx1 = nx0;
    { const int tok0 = cblk * 8 + w; if (tok0 < T_) { const int dd = 32 * (lane & 31) + 16 * (lane >> 5); nx0 = *(const u32x4*)(x1in + (size_t)tok0 * 1024 + dd); nx1 = *(const u32x4*)(x1in + (size_t)tok0 * 1024 + dd + 8); ne0 = eidx[(size_t)tok0 * 128 + lane]; ne1 = eidx[(size_t)tok0 * 128 + 64 + lane]; ng0 = egate[(size_t)tok0 * 128 + lane]; ng1 = egate[(size_t)tok0 * 128 + 64 + lane];
        nsu0 = sinv[ne0]; nsu1 = sinv[ne1]; nsv0 = sinv[16384 + ne0]; nsv1 = sinv[16384 + ne1]; } }
#pragma unroll 1
    for (int tok = cblk * 8 + w; tok < T_; tok += G * 8) {
        int lane_o = lane; asm volatile("" : "+v"(lane_o));
        const int q = lane_o >> 4, n = lane_o & 15, r32 = lane_o & 31, hh = lane_o >> 5; int d0 = 32 * r32 + 16 * hh;
        const float* a = ada_l + (size_t)(tok >> 11) * 6144;
        float stinv; float x1[16]; u32x4 bufA[8], bufB[8];
        {
#pragma unroll
            for (int j = 0; j < 16; j += 8) { const u32x4 v = j ? nx1 : nx0;
                x1[j] = __uint_as_float(v.x << 16); x1[j + 1] = __uint_as_float(v.x & 0xffff0000u); x1[j + 2] = __uint_as_float(v.y << 16); x1[j + 3] = __uint_as_float(v.y & 0xffff0000u);
                x1[j + 4] = __uint_as_float(v.z << 16); x1[j + 5] = __uint_as_float(v.z & 0xffff0000u); x1[j + 6] = __uint_as_float(v.w << 16); x1[j + 7] = __uint_as_float(v.w & 0xffff0000u); }
            E_l[lane_o] = ne0; E_l[64 + lane_o] = ne1; W_l[lane_o] = ng0; W_l[64 + lane_o] = ng1;
            SU_l[lane_o] = nsu0; SU_l[64 + lane_o] = nsu1; SV_l[lane_o] = nsv0; SV_l[64 + lane_o] = nsv1;
            asm volatile("s_waitcnt lgkmcnt(0)" ::: "memory");
            PEER_ISSUE_U(bufA, 0); PEER_SB;
            float u[16]; float um = 0.f;
#pragma unroll
            for (int j = 0; j < 16; j += 4) { const float4 sc = *(const float4*)(a + 4096 + d0 + j), sh = *(const float4*)(a + 3072 + d0 + j);
                u[j] = x1[j] * (1.f + sc.x) + sh.x; u[j + 1] = x1[j + 1] * (1.f + sc.y) + sh.y; u[j + 2] = x1[j + 2] * (1.f + sc.z) + sh.z; u[j + 3] = x1[j + 3] * (1.f + sc.w) + sh.w;
                um = fmaxf(um, fmaxf(fmaxf(fabsf(u[j]), fabsf(u[j + 1])), fmaxf(fabsf(u[j + 2]), fabsf(u[j + 3])))); }
            um = wave_max(um, lane_o); const float st = (um > 0.f) ? 224.f / um : 1.f; stinv = (um > 0.f) ? um * (1.f / 224.f) : 1.f;
            u32x4 pq; pq.x = pk4_fp8(u[0] * st, u[1] * st, u[2] * st, u[3] * st); pq.y = pk4_fp8(u[4] * st, u[5] * st, u[6] * st, u[7] * st);
            pq.z = pk4_fp8(u[8] * st, u[9] * st, u[10] * st, u[11] * st); pq.w = pk4_fp8(u[12] * st, u[13] * st, u[14] * st, u[15] * st);
            *(LAS u32x4*)(urow_l + d0) = pq; }
        asm volatile("s_waitcnt lgkmcnt(0)" ::: "memory");
        PEER_SB;
#define PEER_FIN_U(gi) do { const float ds_ = acc[0] * (SU_l[(gi) * 16 + n] * stinv); const float wv_ = W_l[(gi) * 16 + n] * 0.5f * ds_ * (1.f + erff(ds_ * 0.70710678118654752f)) * SV_l[(gi) * 16 + n]; if (q == 0) W_l[(gi) * 16 + n] = wv_; } while (0)
#pragma unroll 1
        for (int gi = 0; gi < 8; gi += 2) { f32x4 acc = (f32x4){0.f, 0.f, 0.f, 0.f};
            PEER_ISSUE_U(bufB, gi + 1); PEER_SB; PEER_COMP_U(bufA); PEER_FIN_U(gi); PEER_SB;
            if (gi < 6) PEER_ISSUE_U(bufA, gi + 2); else PEER_ISSUE_V(bufA, 0);
            PEER_SB; acc = (f32x4){0.f, 0.f, 0.f, 0.f}; PEER_COMP_U(bufB); PEER_FIN_U(gi + 1); PEER_SB; }
#undef PEER_FIN_U
        asm volatile("s_waitcnt lgkmcnt(0)" ::: "memory");
        float o32[32];
#pragma unroll
        for (int j = 0; j < 32; ++j) o32[j] = 0.f;
        const int tokn = tok + G * 8; const bool hasn = tokn < T_;
        if (hasn) { nx0 = *(const u32x4*)(x1in + (size_t)tokn * 1024 + d0); nx1 = *(const u32x4*)(x1in + (size_t)tokn * 1024 + d0 + 8); ne0 = eidx[(size_t)tokn * 128 + lane_o]; ne1 = eidx[(size_t)tokn * 128 + 64 + lane_o]; ng0 = egate[(size_t)tokn * 128 + lane_o]; ng1 = egate[(size_t)tokn * 128 + 64 + lane_o]; }
        PEER_SB;
        { float (&o)[32] = o32;
#pragma unroll 1
        for (int gi = 0; gi < 8; gi += 2) {
            PEER_ISSUE_V(bufB, gi + 1); PEER_SB; PEER_COMP_V(bufA, gi); PEER_SB;
            if (gi < 6) PEER_ISSUE_V(bufA, gi + 2);
            if (gi == 2 && hasn) { nsu0 = sinv[ne0]; nsu1 = sinv[ne1]; nsv0 = sinv[16384 + ne0]; nsv1 = sinv[16384 + ne1]; }
            PEER_SB; PEER_COMP_V(bufB, gi + 1); PEER_SB; } }
        asm volatile("" : "+v"(lane_o)); d0 = 32 * (lane_o & 31) + 16 * (lane_o >> 5);
        const unsigned hm = 0u - (unsigned)(lane_o >> 5);
        float o[16];
#pragma unroll
        for (int j = 0; j < 16; ++j) { const float lo_ = o32[j], hi_ = o32[16 + j];
            const float keep = __uint_as_float((__float_as_uint(lo_) & ~hm) | (__float_as_uint(hi_) & hm)), send = __uint_as_float((__float_as_uint(hi_) & ~hm) | (__float_as_uint(lo_) & hm));
            o[j] = keep + xor_f(send, 32, lane_o); }
        float hv[16]; float s = 0.f;
#pragma unroll
        for (int j = 0; j < 16; j += 4) { const float4 g2 = *(const float4*)(a + 5120 + d0 + j);
            hv[j] = ALPHA_ * x1[j] + g2.x * o[j]; hv[j + 1] = ALPHA_ * x1[j + 1] + g2.y * o[j + 1]; hv[j + 2] = ALPHA_ * x1[j + 2] + g2.z * o[j + 2]; hv[j + 3] = ALPHA_ * x1[j + 3] + g2.w * o[j + 3];
            s += (hv[j] + hv[j + 1]) + (hv[j + 2] + hv[j + 3]); }
        const float mu = wave_sum(s, lane_o) * (1.f / 1024.f); float qq = 0.f;
#pragma unroll
        for (int j = 0; j < 16; ++j) { const float dd = hv[j] - mu; qq += dd * dd; }
        const float rstd = rsqrtf(wave_sum(qq, lane_o) * (1.f / 1024.f) + LN_EPS_);
        const float* an = ada_next ? ada_next + (size_t)(tok >> 11) * 6144 : nullptr;
        float y[16];
#pragma unroll
        for (int j = 0; j < 16; j += 4) { const float4 gg = *(const float4*)(g + d0 + j), bb = *(const float4*)(bta + d0 + j);
            y[j] = (hv[j] - mu) * rstd * gg.x + bb.x; y[j + 1] = (hv[j + 1] - mu) * rstd * gg.y + bb.y; y[j + 2] = (hv[j + 2] - mu) * rstd * gg.z + bb.z; y[j + 3] = (hv[j + 3] - mu) * rstd * gg.w + bb.w;
            if (!xout16) *(float4*)(xout32 + (size_t)tok * 1024 + d0 + j) = make_float4(y[j], y[j + 1], y[j + 2], y[j + 3]); }
        if (xout16) { u32x4 q0, q1; q0.x = pg8::cvt_pk_bf16(y[0], y[1]); q0.y = pg8::cvt_pk_bf16(y[2], y[3]); q0.z = pg8::cvt_pk_bf16(y[4], y[5]); q0.w = pg8::cvt_pk_bf16(y[6], y[7]);
            q1.x = pg8::cvt_pk_bf16(y[8], y[9]); q1.y = pg8::cvt_pk_bf16(y[10], y[11]); q1.z = pg8::cvt_pk_bf16(y[12], y[13]); q1.w = pg8::cvt_pk_bf16(y[14], y[15]);
            bf16_t* xo = xout16 + (size_t)tok * 1024 + d0; *(u32x4*)xo = q0; *(u32x4*)(xo + 8) = q1; }
        if (an) { float uu[16]; float um = 0.f;
#pragma unroll
            for (int j = 0; j < 16; j += 4) { const float4 sc = *(const float4*)(an + 1024 + d0 + j), sh = *(const float4*)(an + d0 + j);
                uu[j] = y[j] * (1.f + sc.x) + sh.x; uu[j + 1] = y[j + 1] * (1.f + sc.y) + sh.y; uu[j + 2] = y[j + 2] * (1.f + sc.z) + sh.z; uu[j + 3] = y[j + 3] * (1.f + sc.w) + sh.w;
                um = fmaxf(um, fmaxf(fmaxf(fabsf(uu[j]), fabsf(uu[j + 1])), fmaxf(fabsf(uu[j + 2]), fabsf(uu[j + 3])))); }
            um = wave_max(um, lane_o); const float qs = (um > 0.f) ? 127.f / um : 0.f; unsigned o8[4];
#pragma unroll
            for (int e = 0; e < 4; ++e) { o8[e] = 0u;
#pragma unroll
                for (int j = 0; j < 4; ++j) o8[e] |= ((unsigned)(int)rintf(uu[4 * e + j] * qs) & 0xffu) << (8 * j); }
            *(u32x4*)((unsigned char*)(UY + (size_t)tok * UYW_) + d0) = (u32x4){o8[0], o8[1], o8[2], o8[3]};
            if (lane_o == 0) su_next[tok] = um * (1.f / 127.f); }
        asm volatile("s_waitcnt lgkmcnt(0)" ::: "memory");
    }
#undef PEER_SB
#undef PEER_ISSUE_U
#undef PEER_ISSUE_V
#undef PEER_COMP_U
#undef PEER_COMP_V
#undef PEER_UNPK
    __syncthreads();
}
}

namespace tk {
typedef float f32x16 __attribute__((ext_vector_type(16)));
constexpr int KROW = 272;
DEV unsigned sortable(float v) { const unsigned u = __float_as_uint(v); return u ^ ((unsigned)((int)u >> 31) | 0x80000000u); }
DEV float unsortable(unsigned k) { return __uint_as_float(k ^ ((~(unsigned)((int)k >> 31)) | 0x80000000u)); }
DEV unsigned umax_(unsigned a, unsigned b) { return a > b ? a : b; }
DEV unsigned umin_(unsigned a, unsigned b) { return a < b ? a : b; }
#define CE(x, y) { const unsigned hi_ = umax_(a[x], a[y]), lo_ = umin_(a[x], a[y]); a[x] = hi_; a[y] = lo_; }
DEV void sort16(unsigned (&a)[16]) {
    CE(0, 1); CE(3, 2); CE(4, 5); CE(7, 6); CE(8, 9); CE(11, 10); CE(12, 13); CE(15, 14); CE(0, 2); CE(1, 3); CE(6, 4); CE(7, 5); CE(8, 10); CE(9, 11); CE(14, 12); CE(15, 13); CE(0, 1); CE(2, 3); CE(5, 4); CE(7, 6); CE(8, 9); CE(10, 11); CE(13, 12); CE(15, 14); CE(0, 4); CE(1, 5); CE(2, 6); CE(3, 7); CE(12, 8); CE(13, 9); CE(14, 10); CE(15, 11); CE(0, 2); CE(1, 3); CE(4, 6); CE(5, 7); CE(10, 8); CE(11, 9); CE(14, 12); CE(15, 13); CE(0, 1); CE(2, 3); CE(4, 5); CE(6, 7); CE(9, 8); CE(11, 10); CE(13, 12); CE(15, 14); CE(0, 8); CE(1, 9); CE(2, 10); CE(3, 11); CE(4, 12); CE(5, 13); CE(6, 14); CE(7, 15); CE(0, 4); CE(1, 5); CE(2, 6); CE(3, 7); CE(8, 12); CE(9, 13); CE(10, 14); CE(11, 15); CE(0, 2); CE(1, 3); CE(4, 6); CE(5, 7); CE(8, 10); CE(9, 11); CE(12, 14); CE(13, 15); CE(0, 1); CE(2, 3); CE(4, 5); CE(6, 7); CE(8, 9); CE(10, 11); CE(12, 13); CE(14, 15);
}
DEV void bmerge16(unsigned (&a)[16]) {
    CE(0, 8); CE(1, 9); CE(2, 10); CE(3, 11); CE(4, 12); CE(5, 13); CE(6, 14); CE(7, 15); CE(0, 4); CE(1, 5); CE(2, 6); CE(3, 7); CE(8, 12); CE(9, 13); CE(10, 14); CE(11, 15); CE(0, 2); CE(1, 3); CE(4, 6); CE(5, 7); CE(8, 10); CE(9, 11); CE(12, 14); CE(13, 15); CE(0, 1); CE(2, 3); CE(4, 5); CE(6, 7); CE(8, 9); CE(10, 11); CE(12, 13); CE(14, 15);
}
#undef CE
DEV void top_merge(unsigned (&a)[16], const unsigned (&b)[16]) {
#pragma unroll
    for (int i = 0; i < 16; ++i) a[i] = umax_(a[i], b[15 - i]);
    bmerge16(a);
}
DEV void xlane_merge(unsigned (&a)[16], int lane) {
    unsigned b[16];
#pragma unroll
    for (int i = 0; i < 16; ++i) b[i] = (unsigned)xor_i((int)a[i], 32, lane);
    top_merge(a, b);
}
DEV unsigned lookup_idx(unsigned long long lo, unsigned long long hi, int a) { const unsigned long long wv = (a < 8) ? lo : hi; return (unsigned)(wv >> ((a & 7) * 8)) & 127u; }
DEV unsigned blendu(unsigned m, unsigned a, unsigned b) { return (a & ~m) | (b & m); }
DEV float blendf(unsigned m, float a, float b) { return __uint_as_float((__float_as_uint(a) & ~m) | (__float_as_uint(b) & m)); }

DEV void topk_phase(LAS unsigned char* lds, const bf16_t* __restrict__ Q2, const float* __restrict__ keys_l, int* __restrict__ eidx, float* __restrict__ egate, int G, int cblk, int wv) {
    int wv_ = wv, ln_; asm volatile("v_mbcnt_lo_u32_b32 %1, -1, 0\n\tv_mbcnt_hi_u32_b32 %1, -1, %1" : "+s"(wv_), "=v"(ln_)); int tid_ = (wv_ << 6) | ln_;
    const int tid = tid_, w = __builtin_amdgcn_readfirstlane(tid >> 6), lane = tid & 63, tl = lane & 31, hh = lane >> 5;
    asm volatile("" : "+s"(G));
    const bool by_head = (G & 7) == 0;
#pragma unroll 1
    for (int h = 0; h < 8; ++h) {
        if (by_head && h != (cblk & 7)) continue;
        __syncthreads();
        {
            const int r = tid >> 1, c0 = (tid & 1) * 64; const float* src = keys_l + ((size_t)h * 256 + r) * 128 + c0; LAS unsigned char* dst = lds + r * KROW + c0 * 2;
#pragma unroll
            for (int j = 0; j < 64; j += 8) { const float4 a = *(const float4*)(src + j), b = *(const float4*)(src + j + 4);
                u32x4 o; o.x = pg8::cvt_pk_bf16(a.x, a.y); o.y = pg8::cvt_pk_bf16(a.z, a.w); o.z = pg8::cvt_pk_bf16(b.x, b.y); o.w = pg8::cvt_pk_bf16(b.z, b.w); *(LAS u32x4*)(dst + j * 2) = o; }
        }
        __syncthreads();
        const int first = by_head ? (cblk >> 3) * 8 + w : cblk * 8 + w, stride = by_head ? (G >> 3) * 8 : G * 8;
#pragma unroll 1
        for (int blk = first; blk < T_ / 32; blk += stride) {
            const int tok = blk * 32 + tl; const bf16_t* qrow = Q2 + (size_t)tok * 2048 + h * 256 + 8 * hh;
            unsigned L[2][16];
#pragma unroll
            for (int p = 0; p < 2; ++p) {
                bf16x8 bq[8];
#pragma unroll
                for (int ks = 0; ks < 8; ++ks) bq[ks] = *(const bf16x8*)(qrow + p * 128 + 16 * ks);
#pragma unroll
                for (int t = 0; t < 4; ++t) {
                    f32x16 acc;
#pragma unroll
                    for (int e = 0; e < 16; ++e) acc[e] = 0.f;
#pragma unroll
                    for (int ks = 0; ks < 8; ++ks) { const bf16x8 ak = *(const LAS bf16x8*)(lds + (p * 128 + 32 * t + tl) * KROW + (16 * ks + 8 * hh) * 2);
                        acc = __builtin_amdgcn_mfma_f32_32x32x16_bf16(ak, bq[ks], acc, 0, 0, 0); }
                    unsigned K[16];
#pragma unroll
                    for (int e = 0; e < 16; ++e) K[e] = (sortable(acc[e]) & ~127u) | (unsigned)((127 - 32 * t - (e & 3) - 8 * (e >> 2)) - 4 * hh);
                    sort16(K);
                    if (t == 0) {
#pragma unroll
                        for (int e = 0; e < 16; ++e) L[p][e] = K[e];
                    } else top_merge(L[p], K);
                    __builtin_amdgcn_sched_barrier(0);
                }
                xlane_merge(L[p], lane);
                __builtin_amdgcn_sched_barrier(0);
            }
            float f1[16], f2[16];
#pragma unroll
            for (int e = 0; e < 16; ++e) { f1[e] = unsortable(L[0][e] & ~127u); f2[e] = unsortable(L[1][e] & ~127u); }
            unsigned hm = 0u - (unsigned)hh; asm volatile("" : "+v"(hm));
            unsigned C[2][16];
            C[0][0] = (sortable(blendf(hm, f1[0], f1[2]) + blendf(hm, f2[0], f2[1])) & ~255u) | (255u - blendu(hm, 0u, 33u));
            C[0][1] = (sortable(blendf(hm, f1[0], f1[2]) + blendf(hm, f2[1], f2[2])) & ~255u) | (255u - blendu(hm, 1u, 34u));
            C[0][2] = (sortable(blendf(hm, f1[0], f1[2]) + blendf(hm, f2[2], f2[3])) & ~255u) | (255u - blendu(hm, 2u, 35u));
            C[0][3] = (sortable(blendf(hm, f1[0], f1[2]) + blendf(hm, f2[3], f2[4])) & ~255u) | (255u - blendu(hm, 3u, 36u));
            C[0][4] = (sortable(blendf(hm, f1[0], f1[3]) + blendf(hm, f2[4], f2[0])) & ~255u) | (255u - blendu(hm, 4u, 48u));
            C[0][5] = (sortable(blendf(hm, f1[0], f1[3]) + blendf(hm, f2[5], f2[1])) & ~255u) | (255u - blendu(hm, 5u, 49u));
            C[0][6] = (sortable(blendf(hm, f1[0], f1[3]) + blendf(hm, f2[6], f2[2])) & ~255u) | (255u - blendu(hm, 6u, 50u));
            C[0][7] = (sortable(blendf(hm, f1[0], f1[3]) + blendf(hm, f2[7], f2[3])) & ~255u) | (255u - blendu(hm, 7u, 51u));
            C[0][8] = (sortable(blendf(hm, f1[0], f1[4]) + blendf(hm, f2[8], f2[0])) & ~255u) | (255u - blendu(hm, 8u, 64u));
            C[0][9] = (sortable(blendf(hm, f1[0], f1[4]) + blendf(hm, f2[9], f2[1])) & ~255u) | (255u - blendu(hm, 9u, 65u));
            C[0][10] = (sortable(blendf(hm, f1[0], f1[4]) + blendf(hm, f2[10], f2[2])) & ~255u) | (255u - blendu(hm, 10u, 66u));
            C[0][11] = (sortable(blendf(hm, f1[0], f1[5]) + blendf(hm, f2[11], f2[0])) & ~255u) | (255u - blendu(hm, 11u, 80u));
            C[0][12] = (sortable(blendf(hm, f1[0], f1[5]) + blendf(hm, f2[12], f2[1])) & ~255u) | (255u - blendu(hm, 12u, 81u));
            C[0][13] = (sortable(blendf(hm, f1[0], f1[6]) + blendf(hm, f2[13], f2[0])) & ~255u) | (255u - blendu(hm, 13u, 96u));
            C[0][14] = (sortable(blendf(hm, f1[0], f1[6]) + blendf(hm, f2[14], f2[1])) & ~255u) | (255u - blendu(hm, 14u, 97u));
            C[0][15] = (sortable(blendf(hm, f1[0], f1[7]) + blendf(hm, f2[15], f2[0])) & ~255u) | (255u - blendu(hm, 15u, 112u));
            C[1][0] = (sortable(blendf(hm, f1[1], f1[7]) + blendf(hm, f2[0], f2[1])) & ~255u) | (255u - blendu(hm, 16u, 113u));
            C[1][1] = (sortable(blendf(hm, f1[1], f1[8]) + blendf(hm, f2[1], f2[0])) & ~255u) | (255u - blendu(hm, 17u, 128u));
            C[1][2] = (sortable(blendf(hm, f1[1], f1[9]) + blendf(hm, f2[2], f2[0])) & ~255u) | (255u - blendu(hm, 18u, 144u));
            C[1][3] = (sortable(blendf(hm, f1[1], f1[10]) + blendf(hm, f2[3], f2[0])) & ~255u) | (255u - blendu(hm, 19u, 160u));
            C[1][4] = (sortable(blendf(hm, f1[1], f1[11]) + blendf(hm, f2[4], f2[0])) & ~255u) | (255u - blendu(hm, 20u, 176u));
            C[1][5] = (sortable(blendf(hm, f1[1], f1[12]) + blendf(hm, f2[5], f2[0])) & ~255u) | (255u - blendu(hm, 21u, 192u));
            C[1][6] = (sortable(blendf(hm, f1[1], f1[13]) + blendf(hm, f2[6], f2[0])) & ~255u) | (255u - blendu(hm, 22u, 208u));
            C[1][7] = (sortable(blendf(hm, f1[1], f1[14]) + blendf(hm, f2[7], f2[0])) & ~255u) | (255u - blendu(hm, 23u, 224u));
            C[1][8] = (sortable(blendf(hm, f1[2], f1[15]) + blendf(hm, f2[0], f2[0])) & ~255u) | (255u - blendu(hm, 32u, 240u));
            C[1][9] = 0u;
            C[1][10] = 0u;
            C[1][11] = 0u;
            C[1][12] = 0u;
            C[1][13] = 0u;
            C[1][14] = 0u;
            C[1][15] = 0u;
            sort16(C[0]); sort16(C[1]); top_merge(C[0], C[1]); xlane_merge(C[0], lane);
            unsigned long long p1lo = 0ull, p1hi = 0ull, p2lo = 0ull, p2hi = 0ull;
#pragma unroll
            for (int m = 0; m < 8; ++m) { p1lo |= (unsigned long long)(127u - (L[0][m] & 127u)) << (8 * m); p1hi |= (unsigned long long)(127u - (L[0][8 + m] & 127u)) << (8 * m);
                p2lo |= (unsigned long long)(127u - (L[1][m] & 127u)) << (8 * m); p2hi |= (unsigned long long)(127u - (L[1][8 + m] & 127u)) << (8 * m); }
            float val[16]; unsigned ex[16]; float sum = 0.f;
#pragma unroll
            for (int k = 0; k < 16; ++k) { const unsigned flat = 255u - (C[0][k] & 255u); const int a = (int)(flat >> 4), b = (int)(flat & 15u);
                val[k] = unsortable(C[0][k] & ~255u); ex[k] = lookup_idx(p1lo, p1hi, a) * 128u + lookup_idx(p2lo, p2hi, b); }
            const float mx = val[0];
#pragma unroll
            for (int k = 0; k < 16; ++k) { val[k] = __expf(val[k] - mx); sum += val[k]; }
            const float inv = 1.f / sum;
            int eo[8]; float go[8];
#pragma unroll
            for (int k = 0; k < 8; ++k) { eo[k] = (int)blendu(hm, ex[k], ex[8 + k]); go[k] = blendf(hm, val[k], val[8 + k]) * inv; }
            const size_t ob = ((size_t)tok * 8 + h) * 16 + 8 * hh;
            *(int4*)(eidx + ob) = make_int4(eo[0], eo[1], eo[2], eo[3]); *(int4*)(eidx + ob + 4) = make_int4(eo[4], eo[5], eo[6], eo[7]);
            *(float4*)(egate + ob) = make_float4(go[0], go[1], go[2], go[3]); *(float4*)(egate + ob + 4) = make_float4(go[4], go[5], go[6], go[7]);
        }
    }
    __syncthreads();
}
}

namespace at {
typedef float f32x16 __attribute__((ext_vector_type(16)));
constexpr int KROWB = 144, VROWB = 776, K_OFF = 0, V_OFF = 384 * KROWB, LDS_END = V_OFF + 64 * VROWB;
constexpr int N_ITEMS_A = 16 * 12 * 8, N_ITEMS_C = 16 * 2 * 16 * 2;

struct Band { int p_w, ls, R, slot_base; };
template <bool MASK>
DEV void chunk(LAS const unsigned char* lds, const Band& bd, int c, const bf16x8 (&qf)[4], int tl, int hh, int lane, f32x16 (&O)[2], float& m, float& l) {
    const int kp0 = bd.p_w - bd.R + 32 * c;
    if (kp0 + 31 < 0 || kp0 >= bd.ls) return;
    const int s0 = kp0 + bd.slot_base;
    f32x16 S;
#pragma unroll
    for (int e = 0; e < 16; ++e) S[e] = 0.f;
#pragma unroll
    for (int ks = 0; ks < 4; ++ks) { const bf16x8 ak = *(const LAS bf16x8*)(lds + K_OFF + (s0 + tl) * KROWB + (16 * ks + 8 * hh) * 2); S = __builtin_amdgcn_mfma_f32_32x32x16_bf16(ak, qf[ks], S, 0, 0, 0); }
    float cmax = -1e30f;
    if (MASK) {
        const int dbase = (32 * c - bd.R) - tl + 4 * hh;
#pragma unroll
        for (int e = 0; e < 16; ++e) { const int diff = dbase + (e & 3) + 8 * (e >> 2); const bool ok = (diff <= bd.R) && (diff >= -bd.R); S[e] = ok ? S[e] : -1e30f; cmax = fmaxf(cmax, S[e]); }
    } else {
#pragma unroll
        for (int e = 0; e < 16; ++e) cmax = fmaxf(cmax, S[e]);
    }
    cmax = fmaxf(cmax, xor_f(cmax, 32, lane));
    const float mn = fmaxf(m, cmax), alpha = __builtin_amdgcn_exp2f(m - mn); m = mn;
    float psum = 0.f;
#pragma unroll
    for (int e = 0; e < 16; ++e) { S[e] = __builtin_amdgcn_exp2f(S[e] - mn); psum += S[e]; }
    l = l * alpha + psum;
#pragma unroll
    for (int e = 0; e < 16; ++e) { O[0][e] *= alpha; O[1][e] *= alpha; }
#pragma unroll
    for (int sx = 0; sx < 2; ++sx) {
        u32x4 pw; pw.x = pg8::cvt_pk_bf16(S[8 * sx + 0], S[8 * sx + 1]); pw.y = pg8::cvt_pk_bf16(S[8 * sx + 2], S[8 * sx + 3]); pw.z = pg8::cvt_pk_bf16(S[8 * sx + 4], S[8 * sx + 5]); pw.w = pg8::cvt_pk_bf16(S[8 * sx + 6], S[8 * sx + 7]);
        const bf16x8 pb = __builtin_bit_cast(bf16x8, pw);
#pragma unroll
        for (int dt = 0; dt < 2; ++dt) { LAS const unsigned char* vp = lds + V_OFF + (32 * dt + tl) * VROWB + (s0 + 16 * sx + 4 * hh) * 2;
            const u32x2 lo = *(const LAS u32x2*)vp, hi = *(const LAS u32x2*)(vp + 16); const u32x4 vw = (u32x4){lo.x, lo.y, hi.x, hi.y};
            O[dt] = __builtin_amdgcn_mfma_f32_32x32x16_bf16(__builtin_bit_cast(bf16x8, vw), pb, O[dt], 0, 0, 0); }
    }
}
DEV void attn_phase(LAS unsigned char* lds, bf16_t* P, float* lse2, bf16_t* Y, const float* sink_l, int G, int cblk, int wv) {
    int wv_ = wv, ln_; asm volatile("v_mbcnt_lo_u32_b32 %1, -1, 0\n\tv_mbcnt_hi_u32_b32 %1, -1, %1" : "+s"(wv_), "=v"(ln_)); int tid_ = (wv_ << 6) | ln_;
    const int tid = tid_, w = __builtin_amdgcn_readfirstlane(tid >> 6), lane = tid & 63, tl = lane & 31, hh = lane >> 5;
#pragma unroll 1
    for (int item = cblk; item < N_ITEMS_A + N_ITEMS_C; item += G) {
        int b, dil, ls, r, klo, nsl, R, kcol, vcol, qcol, two = 0, rp = 0, sb = 0, head = 0, isC = 0, nb = 0, qh0 = 0;
        if (item < N_ITEMS_A) { b = item / 96; const int rem = item - b * 96; head = rem >> 3; const int sub = rem & 7, g = head >> 2; R = 64;
            kcol = 768 + head * 64; vcol = 1536 + head * 64; qcol = head * 64;
            if (g == 0) { dil = 1; ls = 2048; r = 0; sb = sub; klo = 256 * sb - 64; nsl = 384; }
            else if (g == 1) { dil = 4; ls = 512; r = sub >> 1; sb = sub & 1; klo = 256 * sb - 64; nsl = 384; }
            else { dil = 16; ls = 128; r = 0; rp = sub; klo = 0; nsl = 256; two = 1; } }
        else { const int it = item - N_ITEMS_A; b = it >> 6; const int rem = it & 63; const int kvh = rem >> 5; nb = (rem & 31) >> 1; const int hp = rem & 1; isC = 1; R = 128;
            dil = 1; ls = 2048; r = 0; klo = 128 * nb - 128; nsl = 384; kcol = 2816 + kvh * 64; vcol = 2944 + kvh * 64; qh0 = kvh * 4 + hp * 2; qcol = 2304 + qh0 * 64; }
        __syncthreads();
        for (int i = tid; i < nsl * 8; i += 512) { const int slot = i >> 3, part = i & 7; int kpos, rr;
            if (two) { kpos = slot & 127; rr = 2 * rp + (slot >> 7); } else { kpos = klo + slot; rr = r; }
            u32x4 kv = (u32x4){0u, 0u, 0u, 0u}, vv = kv;
            if (kpos >= 0 && kpos < ls) { const bf16_t* rowp = P + (size_t)(b * 2048 + kpos * dil + rr) * PW_; kv = *(const u32x4*)(rowp + kcol + part * 8); vv = *(const u32x4*)(rowp + vcol + part * 8); }
            *(LAS u32x4*)(lds + K_OFF + slot * KROWB + part * 16) = kv;
            LAS unsigned short* vt = (LAS unsigned short*)(lds + V_OFF + (part * 8) * VROWB + slot * 2);
            vt[0 * (VROWB / 2)] = (unsigned short)(vv.x & 0xffffu); vt[1 * (VROWB / 2)] = (unsigned short)(vv.x >> 16); vt[2 * (VROWB / 2)] = (unsigned short)(vv.y & 0xffffu); vt[3 * (VROWB / 2)] = (unsigned short)(vv.y >> 16);
            vt[4 * (VROWB / 2)] = (unsigned short)(vv.z & 0xffffu); vt[5 * (VROWB / 2)] = (unsigned short)(vv.z >> 16); vt[6 * (VROWB / 2)] = (unsigned short)(vv.w & 0xffffu); vt[7 * (VROWB / 2)] = (unsigned short)(vv.w >> 16); }
        __syncthreads();
        Band bd; int qtok, rr = r; bd.ls = ls; bd.R = R;
        if (two) { const int half = w >> 2; bd.p_w = 32 * (w & 3); rr = 2 * rp + half; bd.slot_base = half * 128; }
        else if (isC) { bd.p_w = 128 * nb + 32 * (w & 3); bd.slot_base = -klo; }
        else { bd.p_w = 256 * sb + 32 * w; bd.slot_base = -klo; }
        qtok = b * 2048 + (bd.p_w + tl) * dil + rr;
        const int qc = isC ? (qcol + (w >> 2) * 64) : qcol;
        const bf16_t* qp = P + (size_t)qtok * PW_ + qc + 8 * hh;
        bf16x8 qf[4];
#pragma unroll
        for (int ks = 0; ks < 4; ++ks) qf[ks] = *(const bf16x8*)(qp + 16 * ks);
        f32x16 O[2];
#pragma unroll
        for (int e = 0; e < 16; ++e) { O[0][e] = 0.f; O[1][e] = 0.f; }
        float m = -1e30f, l = 0.f;
        const int nch = R / 16 + 1, cd = R / 32;
        chunk<false>(lds, bd, cd, qf, tl, hh, lane, O, m, l);
        chunk<true>(lds, bd, 0, qf, tl, hh, lane, O, m, l); chunk<true>(lds, bd, nch - 1, qf, tl, hh, lane, O, m, l);
#pragma unroll 1
        for (int c = 1; c < nch - 1; ++c) { if (c != cd) chunk<false>(lds, bd, c, qf, tl, hh, lane, O, m, l); }
        float lt = l + xor_f(l, 32, lane), scale;
        if (isC) { const float sk = sink_l[qh0 + (w >> 2)] * LOG2E_; const float mf = fmaxf(m, sk), corr = exp2f(m - mf); lt = lt * corr + exp2f(sk - mf); scale = corr / lt; }
        else { scale = 1.f / lt; if (hh == 0) lse2[(size_t)qtok * 12 + head] = m + log2f(lt); }
        bf16_t* op = isC ? (Y + (size_t)qtok * UYW_ + 768 + (qh0 + (w >> 2)) * 64) : (P + (size_t)qtok * PW_ + qcol);
#pragma unroll
        for (int dt = 0; dt < 2; ++dt)
#pragma unroll
            for (int g4 = 0; g4 < 4; ++g4) { u32x2 pk; pk.x = pg8::cvt_pk_bf16(O[dt][4 * g4] * scale, O[dt][4 * g4 + 1] * scale); pk.y = pg8::cvt_pk_bf16(O[dt][4 * g4 + 2] * scale, O[dt][4 * g4 + 3] * scale);
                *(u32x2*)(op + 32 * dt + 8 * g4 + 4 * hh) = pk; }
    }
    __syncthreads();
}
}

namespace xb {
constexpr int XB_TMO = 128, XB_TOP = 3328, XB_TOPGEN = 3392, XCD_BAR_WORDS = 3456; constexpr unsigned XB_SPIN_CAP = 1u << 22;
DEV constexpr int XB_XCNT(int j) { return 256 + 64 * j; }
DEV constexpr int XB_XSUB(int j) { return 1280 + 64 * j; }
DEV constexpr int XB_XGEN(int j) { return 2304 + 64 * j; }
DEV unsigned xb_ld(unsigned* p) { return __hip_atomic_load(p, __ATOMIC_RELAXED, __HIP_MEMORY_SCOPE_AGENT); }
DEV unsigned xb_add(unsigned* p, unsigned v) { return __hip_atomic_fetch_add(p, v, __ATOMIC_RELAXED, __HIP_MEMORY_SCOPE_AGENT); }
DEV unsigned xb_xcc_id() { return (unsigned)__builtin_amdgcn_s_getreg((3 << 11) | 20) & 0xFu; }
#define XB_SPIN(cond, bar) do { unsigned _sp = 0; while (cond) { __builtin_amdgcn_s_sleep(1); \
    if ((++_sp & 255u) == 0u) { if (xb_ld(&(bar)[XB_TMO])) break; if (_sp > XB_SPIN_CAP) { atomicAdd(&(bar)[XB_TMO], 1u); break; } } } } while (0)
struct XcdBarrier { unsigned* bar; unsigned x; volatile LAS unsigned* st; };
DEV XcdBarrier xcd_barrier_post(unsigned* bar, volatile LAS unsigned* st) { XcdBarrier b; b.bar = bar; b.x = xb_xcc_id(); b.st = st; if (threadIdx.x == 0) (void)xb_add(&bar[XB_XCNT(b.x)], 1u); return b; }
DEV void xcd_barrier_complete(unsigned* bar, unsigned x, unsigned& nloc, unsigned& nx) {
    const unsigned G = gridDim.x * gridDim.y * gridDim.z; unsigned sum, cnt, mine, sp = 0u;
    for (;;) { sum = 0u; cnt = 0u; mine = 0u;
#pragma unroll
        for (unsigned j = 0; j < 16; ++j) { const unsigned c = xb_ld(&bar[XB_XCNT(j)]); sum += c; cnt += (c > 0u) ? 1u : 0u; mine = (j == x) ? c : mine; }
        if (sum == G) break;
        __builtin_amdgcn_s_sleep(1);
        if ((++sp & 255u) == 0u) { if (xb_ld(&bar[XB_TMO])) break; if (sp > XB_SPIN_CAP) { atomicAdd(&bar[XB_TMO], 1u); break; } } }
    nloc = mine > 0u ? mine : 1u; nx = cnt > 0u ? cnt : 1u;
}
DEV void xcd_barrier(const XcdBarrier& b, int wv) {
    asm volatile("s_waitcnt vmcnt(0)" ::: "memory");
    __syncthreads();
    int ln0_; asm volatile("v_mbcnt_lo_u32_b32 %0, -1, 0\n\tv_mbcnt_hi_u32_b32 %0, -1, %0" : "=v"(ln0_));
    if (wv == 0 && ln0_ == 0) {
        unsigned* bar = b.bar; asm volatile("" : "+s"(bar));
        unsigned bx = xb_xcc_id(); asm volatile("" : "+s"(bx));
        __builtin_amdgcn_s_waitcnt(0);
        unsigned nloc = b.st[0], nx = b.st[1];
        if (nloc == 0u) { xcd_barrier_complete(bar, bx, nloc, nx); b.st[0] = nloc; b.st[1] = nx; }
        const unsigned old = xb_add(&bar[XB_XSUB(bx)], 1u); const unsigned gen = old / nloc;
        if (old + 1u == (gen + 1u) * nloc) {
            __builtin_amdgcn_fence(__ATOMIC_RELEASE, "agent");
            asm volatile("s_waitcnt vmcnt(0)" ::: "memory");
            const unsigned og = xb_add(&bar[XB_TOP], 1u); const unsigned tg = og / nx;
            if (og + 1u == (tg + 1u) * nx) xb_add(&bar[XB_TOPGEN], 1u);
            else XB_SPIN(xb_ld(&bar[XB_TOPGEN]) == tg, bar);
            __builtin_amdgcn_fence(__ATOMIC_ACQUIRE, "agent");
            xb_add(&bar[XB_XGEN(bx)], 1u);
            asm volatile("s_waitcnt vmcnt(0)" ::: "memory");
        } else {
            XB_SPIN(xb_ld(&bar[XB_XGEN(bx)]) == gen, bar);
            __builtin_amdgcn_fence(__ATOMIC_ACQUIRE, "agent");
            asm volatile("s_waitcnt vmcnt(0)" ::: "memory");
        }
    }
    __syncthreads();
}
}

namespace misc {
DEV void ada_phase(LAS unsigned char* lds, const float* __restrict__ c, const float* __restrict__ w_ada, const float* __restrict__ b_ada, float* __restrict__ ada, int G, int cblk, int wv) {
    int wv_ = wv, ln_; asm volatile("v_mbcnt_lo_u32_b32 %1, -1, 0\n\tv_mbcnt_hi_u32_b32 %1, -1, %1" : "+s"(wv_), "=v"(ln_)); int tid_ = (wv_ << 6) | ln_; const int tid = tid_, col = tid & 63, kg = tid >> 6;
    LAS float* cond = (LAS float*)lds;
    LAS float* part = (LAS float*)(lds + 65536);
    for (int i = tid; i < 16384; i += 512) { const float v = c[i]; cond[i] = v / (1.f + __expf(-v)); }
    __syncthreads();
#pragma unroll 1
    for (int item = cblk; item < 192; item += G) { const int l = item / 96, n0 = (item - l * 96) * 64;
        float acc[16];
#pragma unroll
        for (int b = 0; b < 16; ++b) acc[b] = 0.f;
        const float* wp = w_ada + ((size_t)l * 1024 + kg * 128) * 6144 + n0 + col;
#pragma unroll 4
        for (int kk = 0; kk < 128; ++kk) { const float wv = wp[(size_t)kk * 6144];
#pragma unroll
            for (int b = 0; b < 16; ++b) acc[b] += cond[b * 1024 + kg * 128 + kk] * wv; }
#pragma unroll
        for (int b = 0; b < 16; ++b) part[(kg * 16 + b) * 64 + col] = acc[b];
        __syncthreads();
        for (int o = tid; o < 1024; o += 512) { const int b = o >> 6, cc = o & 63; float sacc = b_ada[l * 6144 + n0 + cc];
#pragma unroll
            for (int g8 = 0; g8 < 8; ++g8) sacc += part[(g8 * 16 + b) * 64 + cc];
            ada[((size_t)l * 16 + b) * 6144 + n0 + cc] = sacc; }
        __syncthreads();
    }
}
DEV void yprep_phase(LAS unsigned char* lds, const bf16_t* __restrict__ hyT, const bf16_t* P, const float* __restrict__ lse2, bf16_t* Y, int G, int cblk, int wv) {
    int wv_ = wv, ln_; asm volatile("v_mbcnt_lo_u32_b32 %1, -1, 0\n\tv_mbcnt_hi_u32_b32 %1, -1, %1" : "+s"(wv_), "=v"(ln_)); int tid_ = (wv_ << 6) | ln_; const int tid = tid_;
    LAS unsigned short* tile = (LAS unsigned short*)lds;
#pragma unroll 1
    for (int it = cblk; it < 4096; it += G) { const int t0 = (it >> 3) * 64, c0 = (it & 7) * 64;
        __syncthreads();
        { const int cc = tid >> 3, seg = (tid & 7) * 8; const u32x4 v = *(const u32x4*)(hyT + (size_t)(c0 + cc) * T_ + t0 + seg); *(LAS u32x4*)(tile + cc * 72 + seg) = v; }
        __syncthreads();
        { const int tt = tid >> 3, seg = (tid & 7) * 8; unsigned wv[4];
#pragma unroll
            for (int e = 0; e < 4; ++e) wv[e] = (unsigned)tile[(seg + 2 * e) * 72 + tt] | ((unsigned)tile[(seg + 2 * e + 1) * 72 + tt] << 16);
            *(u32x4*)(Y + (size_t)(t0 + tt) * UYW_ + 256 + c0 + seg) = (u32x4){wv[0], wv[1], wv[2], wv[3]}; }
    }
#pragma unroll 1
    for (size_t idx = (size_t)cblk * 512 + tid; idx < (size_t)T_ * 32; idx += (size_t)G * 512) { const size_t tok = idx >> 5; const int c8 = (int)(idx & 31) * 8, hh = c8 >> 6;
        const float l0 = lse2[tok * 12 + hh], l1 = lse2[tok * 12 + 4 + hh], l2 = lse2[tok * 12 + 8 + hh]; const float mx = fmaxf(l0, fmaxf(l1, l2));
        float w0 = exp2f(l0 - mx), w1 = exp2f(l1 - mx), w2 = exp2f(l2 - mx); const float inv = 1.f / (w0 + w1 + w2); w0 *= inv; w1 *= inv; w2 *= inv;
        const bf16_t* pr = P + tok * PW_ + c8; const u32x4 a = *(const u32x4*)pr, b = *(const u32x4*)(pr + 256), c = *(const u32x4*)(pr + 512);
        const unsigned aw[4] = {a.x, a.y, a.z, a.w}, bw[4] = {b.x, b.y, b.z, b.w}, cw[4] = {c.x, c.y, c.z, c.w}; unsigned o[4];
#pragma unroll
        for (int e = 0; e < 4; ++e) { const float lo = w0 * __uint_as_float(aw[e] << 16) + w1 * __uint_as_float(bw[e] << 16) + w2 * __uint_as_float(cw[e] << 16);
            const float hi = w0 * __uint_as_float(aw[e] & 0xffff0000u) + w1 * __uint_as_float(bw[e] & 0xffff0000u) + w2 * __uint_as_float(cw[e] & 0xffff0000u); o[e] = pg8::cvt_pk_bf16(lo, hi); }
        *(u32x4*)(Y + tok * UYW_ + c8) = (u32x4){o[0], o[1], o[2], o[3]}; }
    __syncthreads();
}
DEV void filt_phase(LAS unsigned char* lds, const float* __restrict__ h2, const float* __restrict__ w3, const float* __restrict__ log_decay, bf16_t* __restrict__ Gr, int G, int cblk, int wv) {
    int wv_ = wv, ln_; asm volatile("v_mbcnt_lo_u32_b32 %1, -1, 0\n\tv_mbcnt_hi_u32_b32 %1, -1, %1" : "+s"(wv_), "=v"(ln_)); const int tid = (wv_ << 6) | ln_, lane = ln_;
    LAS float* hrow = (LAS float*)lds;
    LAS float* w3s = (LAS float*)(lds + 512 * 68 * 4);
    LAS float* dec = w3s + 1024;
    LAS float* red = dec + 16;
#pragma unroll 1
    for (int item = cblk; item < 256; item += G) { const int l = item >> 7, o = (item >> 6) & 1, cg = item & 63; const int colf0 = o * 512 + cg * 8;
        __syncthreads();
        for (int i = tid; i < 1024; i += 512) { const int jj = i >> 4, c16 = i & 15; const int col = (c16 < 8) ? colf0 + c16 : 1024 + colf0 + (c16 - 8); w3s[i] = w3[((size_t)l * 64 + jj) * 2048 + col]; }
        if (tid < 16) { const int col = (tid < 8) ? colf0 + tid : 1024 + colf0 + (tid - 8); dec[tid] = __expf(log_decay[l * 2048 + col]); }
        float vals[4][16];
#pragma unroll
        for (int ch = 0; ch < 4; ++ch) {
            __syncthreads();
            { const float* src = h2 + ((size_t)l * 2048 + ch * 512) * 64;
#pragma unroll 4
                for (int k = 0; k < 16; ++k) { const int idx = tid + 512 * k; const int row = idx >> 4, c4 = idx & 15; *(LAS f32x4*)(hrow + row * 68 + c4 * 4) = *(const f32x4*)(src + (size_t)idx * 4); } }
            __syncthreads();
            float acc[16];
#pragma unroll
            for (int c = 0; c < 16; ++c) acc[c] = 0.f;
#pragma unroll 2
            for (int j4 = 0; j4 < 16; ++j4) { const f32x4 hv = *(const LAS f32x4*)(hrow + tid * 68 + j4 * 4); const float hh4[4] = {hv.x, hv.y, hv.z, hv.w};
#pragma unroll
                for (int e = 0; e < 4; ++e) { const LAS f32x4* wr = (const LAS f32x4*)(w3s + (j4 * 4 + e) * 16); const f32x4 w0 = wr[0], w1 = wr[1], w2 = wr[2], w3v = wr[3];
                    acc[0] += hh4[e] * w0.x; acc[1] += hh4[e] * w0.y; acc[2] += hh4[e] * w0.z; acc[3] += hh4[e] * w0.w; acc[4] += hh4[e] * w1.x; acc[5] += hh4[e] * w1.y; acc[6] += hh4[e] * w1.z; acc[7] += hh4[e] * w1.w;
                    acc[8] += hh4[e] * w2.x; acc[9] += hh4[e] * w2.y; acc[10] += hh4[e] * w2.z; acc[11] += hh4[e] * w2.w; acc[12] += hh4[e] * w3v.x; acc[13] += hh4[e] * w3v.y; acc[14] += hh4[e] * w3v.z; acc[15] += hh4[e] * w3v.w; } }
            const float tn = (float)(ch * 512 + tid) * (1.f / 2047.f);
#pragma unroll
            for (int c = 0; c < 16; ++c) vals[ch][c] = acc[c] * __expf(-tn * dec[c]);
        }
        float ss[8];
#pragma unroll
        for (int c = 0; c < 8; ++c) { float a = 0.f;
#pragma unroll
            for (int ch = 0; ch < 4; ++ch) { a += vals[ch][c] * vals[ch][c]; if (ch > 0 || tid > 0) a += vals[ch][8 + c] * vals[ch][8 + c]; }
            ss[c] = peer::wave_sum(a, lane); }
        if (lane == 0) {
#pragma unroll
            for (int c = 0; c < 8; ++c) red[wv_ * 8 + c] = ss[c]; }
        __syncthreads();
        float scale[8];
#pragma unroll
        for (int c = 0; c < 8; ++c) { float a = 0.f;
#pragma unroll
            for (int g8 = 0; g8 < 8; ++g8) a += red[g8 * 8 + c];
            scale[c] = rsqrtf(a + 1e-12f); }
#pragma unroll
        for (int c = 0; c < 8; ++c) { bf16_t* gp = Gr + (((size_t)l * 2 + o) * 512 + cg * 8 + c) * 4096;
#pragma unroll
            for (int ch = 0; ch < 4; ++ch) { const int t = ch * 512 + tid; gp[2047 - t] = f2bf(vals[ch][c] * scale[c]); if (t > 0) gp[2047 + t] = f2bf(vals[ch][8 + c] * scale[c]); }
            if (tid == 0) gp[4095] = 0; }
    }
    __syncthreads();
}
DEV void modulate_phase(const float* __restrict__ x, const float* __restrict__ ada0, bf16_t* UY, float* __restrict__ su, int G, int cblk, int wv) {
    int wv_ = wv, ln_; asm volatile("v_mbcnt_lo_u32_b32 %1, -1, 0\n\tv_mbcnt_hi_u32_b32 %1, -1, %1" : "+s"(wv_), "=v"(ln_)); const int lane = ln_, w = wv_; const int d0 = 16 * lane;
#pragma unroll 1
    for (int tok = cblk * 8 + w; tok < T_; tok += G * 8) { const float* a = ada0 + (size_t)(tok >> 11) * 6144; const float* xr = x + (size_t)tok * 1024 + d0; float u[16]; float um = 0.f;
#pragma unroll
        for (int j = 0; j < 16; j += 4) { const float4 xv = *(const float4*)(xr + j), sc = *(const float4*)(a + 1024 + d0 + j), sh = *(const float4*)(a + d0 + j);
            u[j] = xv.x * (1.f + sc.x) + sh.x; u[j + 1] = xv.y * (1.f + sc.y) + sh.y; u[j + 2] = xv.z * (1.f + sc.z) + sh.z; u[j + 3] = xv.w * (1.f + sc.w) + sh.w;
            um = fmaxf(um, fmaxf(fmaxf(fabsf(u[j]), fabsf(u[j + 1])), fmaxf(fabsf(u[j + 2]), fabsf(u[j + 3])))); }
        um = peer::wave_max(um, lane); const float qs = (um > 0.f) ? 127.f / um : 0.f; unsigned o[4];
#pragma unroll
        for (int e = 0; e < 4; ++e) { o[e] = 0u;
#pragma unroll
            for (int j = 0; j < 4; ++j) o[e] |= ((unsigned)(int)rintf(u[4 * e + j] * qs) & 0xffu) << (8 * j); }
        *(u32x4*)((unsigned char*)(UY + (size_t)tok * UYW_) + d0) = (u32x4){o[0], o[1], o[2], o[3]};
        if (lane == 0) su[tok] = um * (1.f / 127.f); }
}
DEV void lnmod_phase(bf16_t* hx, const float* __restrict__ ada_l, const float* __restrict__ g, const float* __restrict__ bta, bf16_t* UY, int G, int cblk, int wv) {
    int wv_ = wv, ln_; asm volatile("v_mbcnt_lo_u32_b32 %1, -1, 0\n\tv_mbcnt_hi_u32_b32 %1, -1, %1" : "+s"(wv_), "=v"(ln_)); const int lane = ln_, w = wv_; const int d0 = 16 * lane;
#pragma unroll 1
    for (int tok0 = cblk * 8 + w; tok0 < T_; tok0 += 2 * G * 8) { u32x4 q[2][2]; const int tok1 = tok0 + G * 8; const bool two = tok1 < T_;
        q[0][0] = *(const u32x4*)(hx + (size_t)tok0 * 1024 + d0); q[0][1] = *(const u32x4*)(hx + (size_t)tok0 * 1024 + d0 + 8);
        q[1][0] = q[0][0]; q[1][1] = q[0][1]; if (two) { q[1][0] = *(const u32x4*)(hx + (size_t)tok1 * 1024 + d0); q[1][1] = *(const u32x4*)(hx + (size_t)tok1 * 1024 + d0 + 8); }
#pragma unroll
        for (int t = 0; t < 2; ++t) { const int tok = t ? tok1 : tok0; float hv[16]; float s = 0.f;
#pragma unroll
            for (int j = 0; j < 2; ++j) { const u32x4 v = q[t][j]; hv[8 * j] = __uint_as_float(v.x << 16); hv[8 * j + 1] = __uint_as_float(v.x & 0xffff0000u); hv[8 * j + 2] = __uint_as_float(v.y << 16); hv[8 * j + 3] = __uint_as_float(v.y & 0xffff0000u);
                hv[8 * j + 4] = __uint_as_float(v.z << 16); hv[8 * j + 5] = __uint_as_float(v.z & 0xffff0000u); hv[8 * j + 6] = __uint_as_float(v.w << 16); hv[8 * j + 7] = __uint_as_float(v.w & 0xffff0000u); }
#pragma unroll
            for (int j = 0; j < 16; j += 4) s += (hv[j] + hv[j + 1]) + (hv[j + 2] + hv[j + 3]);
            const float mu = peer::wave_sum(s, lane) * (1.f / 1024.f); float qq = 0.f;
#pragma unroll
            for (int j = 0; j < 16; ++j) { const float dd = hv[j] - mu; qq += dd * dd; }
            const float rstd = rsqrtf(peer::wave_sum(qq, lane) * (1.f / 1024.f) + LN_EPS_);
            const float* a = ada_l + (size_t)(tok >> 11) * 6144; float y[16], uu[16];
#pragma unroll
            for (int j = 0; j < 16; j += 4) { const float4 gg = *(const float4*)(g + d0 + j), bb = *(const float4*)(bta + d0 + j), sc = *(const float4*)(a + 4096 + d0 + j), sh = *(const float4*)(a + 3072 + d0 + j);
                y[j] = (hv[j] - mu) * rstd * gg.x + bb.x; y[j + 1] = (hv[j + 1] - mu) * rstd * gg.y + bb.y; y[j + 2] = (hv[j + 2] - mu) * rstd * gg.z + bb.z; y[j + 3] = (hv[j + 3] - mu) * rstd * gg.w + bb.w;
                uu[j] = y[j] * (1.f + sc.x) + sh.x; uu[j + 1] = y[j + 1] * (1.f + sc.y) + sh.y; uu[j + 2] = y[j + 2] * (1.f + sc.z) + sh.z; uu[j + 3] = y[j + 3] * (1.f + sc.w) + sh.w; }
            if (t == 0 || two) { u32x4 q0, q1, p0, p1;
                q0.x = pg8::cvt_pk_bf16(y[0], y[1]); q0.y = pg8::cvt_pk_bf16(y[2], y[3]); q0.z = pg8::cvt_pk_bf16(y[4], y[5]); q0.w = pg8::cvt_pk_bf16(y[6], y[7]);
                q1.x = pg8::cvt_pk_bf16(y[8], y[9]); q1.y = pg8::cvt_pk_bf16(y[10], y[11]); q1.z = pg8::cvt_pk_bf16(y[12], y[13]); q1.w = pg8::cvt_pk_bf16(y[14], y[15]);
                p0.x = pg8::cvt_pk_bf16(uu[0], uu[1]); p0.y = pg8::cvt_pk_bf16(uu[2], uu[3]); p0.z = pg8::cvt_pk_bf16(uu[4], uu[5]); p0.w = pg8::cvt_pk_bf16(uu[6], uu[7]);
                p1.x = pg8::cvt_pk_bf16(uu[8], uu[9]); p1.y = pg8::cvt_pk_bf16(uu[10], uu[11]); p1.z = pg8::cvt_pk_bf16(uu[12], uu[13]); p1.w = pg8::cvt_pk_bf16(uu[14], uu[15]);
                bf16_t* xo = hx + (size_t)tok * 1024 + d0; *(u32x4*)xo = q0; *(u32x4*)(xo + 8) = q1; bf16_t* up = UY + (size_t)tok * UYW_ + d0; *(u32x4*)up = p0; *(u32x4*)(up + 8) = p1; } }
    }
}
}

struct Params {
    const float *x, *c, *w_ada, *b_ada, *w_in, *conv_w, *conv_b, *hy_w1, *hy_b1, *hy_w2, *hy_b2, *hy_w3, *hy_freq, *hy_ld, *hy_bias, *attn_sink, *wba, *wbb, *wbc, *w_out, *ln_g, *ln_b,
        *peer_wq, *peer_keys, *peer_u, *peer_v;
    float* out; char* ws;
};
constexpr int LDS_PHASE = 148480;
constexpr int LDS_BYTES = LDS_PHASE + 16;
constexpr size_t OFF_BAR = OFF_LSE + 1792 * 1024;

#define RUN(nvb, call) do { const int wv = wave_s; int wv_ = wv, ln_; asm volatile("v_mbcnt_lo_u32_b32 %1, -1, 0\n\tv_mbcnt_hi_u32_b32 %1, -1, %1" : "+s"(wv_), "=v"(ln_)); int tid_ = (wv_ << 6) | ln_; const int t = tid_ & 255, sub = tid_ >> 8; unsigned char* sm = lds + sub * 16384; \
        for (int vb = (int)blockIdx.x * 2 + sub; vb < (nvb); vb += (int)gridDim.x * 2) { call; __syncthreads(); } } while (0)
#define GSYNC_CG() do { __builtin_amdgcn_sched_barrier(0); grid.sync(); __builtin_amdgcn_sched_barrier(0); } while (0)
#define GSYNC() do { __builtin_amdgcn_sched_barrier(0); xb::xcd_barrier(xbar, wave_s); __builtin_amdgcn_sched_barrier(0); } while (0)

__global__ void __launch_bounds__(512, 2) mega(Params p) {
    extern __shared__ __attribute__((aligned(16))) unsigned char lds[];
    cg::grid_group grid = cg::this_grid();
    LAS unsigned char* ldsl = (LAS unsigned char*)lds;
    const int G = gridDim.x, cblk = blockIdx.x;
    const int wave_s = __builtin_amdgcn_readfirstlane((int)threadIdx.x >> 6);
    float* out = p.out; (void)out;
    if (threadIdx.x < 4) ((LAS unsigned*)(ldsl + LDS_PHASE))[threadIdx.x] = 0u;
    __syncthreads();
    const xb::XcdBarrier xbar = xb::xcd_barrier_post((unsigned*)(p.ws + OFF_BAR), (volatile LAS unsigned*)(ldsl + LDS_PHASE));
    {
    char* ws = p.ws;
    float* ada = (float*)(ws + OFF_ADA); float2* rope = (float2*)(ws + OFF_ROPE); bf16_t* Gr = (bf16_t*)(ws + OFF_GR); float* lse2 = (float*)(ws + OFF_LSE);
    unsigned char* WinT8 = (unsigned char*)(ws + OFF_WINT); unsigned char* WmT8 = (unsigned char*)(ws + OFF_WMT); float* su = (float*)(ws + OFF_LSE + 1536 * 1024); bf16_t* WoutT = (bf16_t*)(ws + OFF_WOUTT); bf16_t* WqT = (bf16_t*)(ws + OFF_WQT);
    bf16_t* UY = (bf16_t*)(ws + OFF_UY); bf16_t* Y = UY + 1024; bf16_t* P = (bf16_t*)(ws + OFF_P); bf16_t* hyT = (bf16_t*)(ws + OFF_HYT);
    bf16_t* merged = (bf16_t*)(ws + OFF_P); bf16_t* gtmp = (bf16_t*)(ws + OFF_P + 64 * MB_); bf16_t* Q2 = (bf16_t*)(ws + OFF_P); bf16_t* x1b = (bf16_t*)(ws + OFF_P + 128 * MB_);
    int* eidx = (int*)(ws + OFF_HYT); float* egate = (float*)(ws + OFF_HYT + 16 * MB_); unsigned char* U8 = (unsigned char*)(ws + OFF_HYT + 32 * MB_); unsigned char* V4 = (unsigned char*)(ws + OFF_HYT + 48 * MB_); float* sinv = (float*)(ws + OFF_HYT + 64 * MB_);
    float* h2 = (float*)(ws + OFF_P);
    (void)lse2; (void)P; (void)hyT; (void)merged; (void)gtmp; (void)Q2; (void)x1b; (void)eidx; (void)egate; (void)U8; (void)V4; (void)sinv; (void)Y;

    misc::ada_phase(ldsl, p.c, p.w_ada, p.b_ada, ada, G, cblk, wave_s);
    RUN(256, nb_rope(vb, t, sm, rope));
    RUN(1024, nb_filt_h2(vb, t, sm, p.hy_w1, p.hy_b1, p.hy_w2, p.hy_b2, p.hy_freq, h2));
    { const WPrep wq{p.w_in, p.wba, p.wbb, p.wbc, p.w_out, p.peer_wq, WinT8, WmT8, WoutT, WqT}; RUN(6016, nb_wprep(vb, t, sm, wq)); }
    GSYNC();
    misc::filt_phase(ldsl, h2, p.hy_w3, p.hy_ld, Gr, G, cblk, wave_s);
    misc::modulate_phase(p.x, ada, UY, su, G, cblk, wave_s);
    GSYNC();
    }
#pragma unroll 1
    for (int l = 0; l < 2; ++l) {
        size_t zoff = 0; asm volatile("" : "+s"(zoff));
        char* ws = p.ws + zoff; float* out = p.out + zoff;
        int Gl = gridDim.x, cl = blockIdx.x; asm volatile("" : "+s"(Gl), "+s"(cl));
        float* ada = (float*)(ws + OFF_ADA); float2* rope = (float2*)(ws + OFF_ROPE); bf16_t* Gr = (bf16_t*)(ws + OFF_GR); float* lse2 = (float*)(ws + OFF_LSE);
        unsigned char* WinT8 = (unsigned char*)(ws + OFF_WINT); unsigned char* WmT8 = (unsigned char*)(ws + OFF_WMT); float* su = (float*)(ws + OFF_LSE + 1536 * 1024); bf16_t* WoutT = (bf16_t*)(ws + OFF_WOUTT); bf16_t* WqT = (bf16_t*)(ws + OFF_WQT);
        bf16_t* UY = (bf16_t*)(ws + OFF_UY); bf16_t* Y = UY + 1024; bf16_t* P = (bf16_t*)(ws + OFF_P); bf16_t* hyT = (bf16_t*)(ws + OFF_HYT);
        bf16_t* merged = (bf16_t*)(ws + OFF_P); bf16_t* gtmp = (bf16_t*)(ws + OFF_P + 64 * MB_); bf16_t* Q2 = (bf16_t*)(ws + OFF_P); bf16_t* x1b = (bf16_t*)(ws + OFF_P + 128 * MB_);
        int* eidx = (int*)(ws + OFF_HYT); float* egate = (float*)(ws + OFF_HYT + 16 * MB_); unsigned char* U8 = (unsigned char*)(ws + OFF_HYT + 32 * MB_); unsigned char* V4 = (unsigned char*)(ws + OFF_HYT + 48 * MB_); float* sinv = (float*)(ws + OFF_HYT + 64 * MB_);
        const float* ada_l = ada + (size_t)l * 16 * 6144;
        const unsigned char* WinT8_l = WinT8 + (size_t)l * 4608 * 1024;
        {
            const pg8::PlainSched S1{UY, (const bf16_t*)WinT8_l, UYW_, 512, 128, 12, 8, Gl, cl, 0, 1 << 30}; const pg8::EpiP E1{P, rope, su};
            pg8::gemm_phase<pg8::EpiP, pg8::PlainSched, true, true, 1>(ldsl, UYW_, 512, S1, E1, wave_s);
            const pg8::PlainSched S2{(const bf16_t*)(WinT8_l + (size_t)3072 * 1024), UY, 512, UYW_, 6, 128, 8, Gl, cl, 0, 1 << 30}; const pg8::EpiHyT8 E2{hyT, su};
            pg8::gemm_phase<pg8::EpiHyT8, pg8::PlainSched, true, true, 1>(ldsl, 512, UYW_, S2, E2, wave_s);
        }
        GSYNC();
        at::attn_phase(ldsl, P, lse2, Y, p.attn_sink + l * 8, Gl, cl, wave_s);
        hy::hyena_phase(ldsl, hyT, Gr + (size_t)l * 2 * 512 * 4096, p.conv_w + (size_t)l * 3 * 1536, p.conv_b + (size_t)l * 1536, p.hy_bias + (size_t)l * 1024, Gl, cl, wave_s);
        GSYNC();
        misc::yprep_phase(ldsl, hyT, P, lse2, Y, Gl, cl, wave_s);
        GSYNC();
        {
            const unsigned char* WmT8_l = WmT8 + (size_t)l * 1024 * (WMW_ * 2);
            static_assert(OFF_P + 192 * MB_ == OFF_HYT, "gate buffers");
            const pg8::GateSched Sg{UY, WmT8_l, Gl, cl}; const pg8::EpiGate Eg{gtmp, su};
            pg8::gemm_phase<pg8::EpiGate, pg8::GateSched, true, true, 1>(ldsl, UYW_, WMW_, Sg, Eg, wave_s);
            const pg8::Branch3Sched Sb{UY, WmT8_l, Gl, cl}; const pg8::EpiBranch3 Eb{gtmp, merged};
            pg8::gemm_phase<pg8::EpiBranch3, pg8::Branch3Sched, true, true, 0>(ldsl, UYW_, WMW_, Sb, Eb, wave_s);
        }
        GSYNC();
        {
            const pg8::PlainSched S{merged, WoutT + (size_t)l * 1024 * 1024, 1024, 1024, 128, 4, 16, Gl, cl, 0, 1 << 30}; const pg8::EpiH E{(l == 0) ? p.x : (const float*)nullptr, (const bf16_t*)out, x1b, ada_l};
            pg8::gemm_phase(ldsl, 1024, 1024, S, E, wave_s);
        }
        RUN(8192, peer::nb_quant_tables(vb, t, p.peer_u + (size_t)l * 16384 * 1024, p.peer_v + (size_t)l * 16384 * 1024, U8, V4, sinv));
        GSYNC();
        misc::lnmod_phase(x1b, ada_l, p.ln_g + (size_t)(l * 2 + 0) * 1024, p.ln_b + (size_t)(l * 2 + 0) * 1024, UY, Gl, cl, wave_s);
        GSYNC();
        {
            const pg8::PlainSched S{UY, WqT + (size_t)l * 2048 * 1024, UYW_, 1024, 128, 8, 16, Gl, cl, 0, 1 << 30}; const pg8::EpiBf E{Q2, 2048, 0};
            pg8::gemm_phase(ldsl, UYW_, 1024, S, E, wave_s);
        }
        GSYNC();
        tk::topk_phase(ldsl, Q2, p.peer_keys + (size_t)l * 8 * 2 * 128 * 128, eidx, egate, Gl, cl, wave_s);
        GSYNC();
        peer::peer_phase(ldsl, x1b, out, (l == 0) ? (bf16_t*)out : (bf16_t*)nullptr, ada_l, eidx, egate, U8, V4, sinv, p.ln_g + (size_t)(l * 2 + 1) * 1024, p.ln_b + (size_t)(l * 2 + 1) * 1024,
                         (l == 0) ? ada + (size_t)16 * 6144 : (const float*)nullptr, UY, su, Gl, cl, wave_s);
        if (l == 0) GSYNC();
    }
}

extern "C" void kernel_launch(void* const* d_in, const int* in_sizes, int n_in, void* d_out, int out_size, void* d_ws, size_t ws_size, hipStream_t stream) {
    static int grid = 0;
    if (grid == 0) {
        if (ws_size < WS_NEED || n_in != 26) { fprintf(stderr, "kernel_launch: workspace %zu < %zu or n_in %d != 26\n", ws_size, (size_t)WS_NEED, n_in); grid = -1; return; }
        int dev = 0, cus = 0, per_cu = 0;
        (void)hipGetDevice(&dev); (void)hipDeviceGetAttribute(&cus, hipDeviceAttributeMultiprocessorCount, dev);
        (void)hipFuncSetAttribute((const void*)mega, hipFuncAttributeMaxDynamicSharedMemorySize, LDS_BYTES);
        (void)hipOccupancyMaxActiveBlocksPerMultiprocessor(&per_cu, (const void*)mega, 512, LDS_BYTES);
        if (per_cu < 1) { fprintf(stderr, "kernel_launch: occupancy query says %d blocks per CU\n", per_cu); grid = -1; return; }
        if (cus != 256) { fprintf(stderr, "kernel_launch: built for a 256-CU device (the fused LayerNorm epilogue pairs the four column-tile owners of a row panel by grid position), found %d CUs\n", cus); grid = -1; return; }
        grid = cus;
    }
    if (grid < 0) return;
    Params p{};
    const float** pp = (const float**)&p;
    for (int i = 0; i < 26; ++i) pp[i] = (const float*)d_in[i];
    p.out = (float*)d_out; p.ws = (char*)d_ws;
    (void)hipMemsetAsync((char*)d_ws + OFF_BAR, 0, 16384 + 2 * 32768, stream);
    void* args[] = {&p};
    hipError_t e = hipLaunchCooperativeKernel((const void*)mega, dim3(grid), dim3(512), args, LDS_BYTES, stream);
    if (e != hipSuccess) fprintf(stderr, "cooperative launch failed: %s (grid %d)\n", hipGetErrorString(e), grid);
}
```

```cpp
#include <hip/hip_runtime.h>
#include <hip/hip_cooperative_groups.h>
namespace cg = cooperative_groups;
#include <stdint.h>
#include <stdio.h>

#define DEV __device__ __forceinline__
typedef unsigned short bf16_t;

constexpr int D_ = 1024, B_ = 16, S_ = 2048, T_ = B_ * S_;
constexpr float ALPHA_ = 1.41421356237309515f;
constexpr float LOG2E_ = 1.4426950408889634f;
constexpr float QSCALE_ = 0.125f * 1.4426950408889634f;
constexpr float LN_EPS_ = 1e-5f;
constexpr int PW_ = 3072;
constexpr int UYW_ = 2304;
constexpr int WMW_ = 2816;
constexpr float WQ8_ = 1024.f;
constexpr size_t GSTRIDE_ = (size_t)32 * 1024 * 1024;

constexpr size_t MB_ = 1024 * 1024;
constexpr size_t OFF_ADA = 0, OFF_ROPE = 1 * MB_, OFF_GR = 2 * MB_, OFF_LSE = 18 * MB_, OFF_WINT = 20 * MB_, OFF_WMT = 50 * MB_,
                 OFF_WOUTT = 68 * MB_, OFF_WQT = 72 * MB_, OFF_KEYS = 80 * MB_, OFF_UY = 82 * MB_, OFF_P = 226 * MB_, OFF_HYT = 418 * MB_,
                 WS_NEED = 514 * MB_;

DEV int xor_i(int v, int off, int lane) { return __builtin_amdgcn_ds_bpermute((lane ^ off) << 2, v); }
DEV float xor_f(float v, int off, int lane) { return __int_as_float(__builtin_amdgcn_ds_bpermute((lane ^ off) << 2, __float_as_int(v))); }
DEV float bf2f(bf16_t v) { return __uint_as_float(((unsigned)v) << 16); }
DEV bf16_t f2bf(float f) { unsigned u = __float_as_uint(f); u += 0x7FFFu + ((u >> 16) & 1u); return (bf16_t)(u >> 16); }

DEV void nb_rope(int vb, int t, unsigned char* sm, float2* __restrict__ rope) {
    const int idx = vb * 256 + t; const int s = idx >> 5, i = idx & 31;
    const float inv = powf(10000.f, -(float)i / 32.f); const float ang = (float)s * inv;
    rope[idx] = make_float2(cosf(ang), sinf(ang));
}

DEV void nb_filt_h2(int vb, int t, unsigned char* sm, const float* __restrict__ w1, const float* __restrict__ b1, const float* __restrict__ w2, const float* __restrict__ b2,
                                                const float* __restrict__ freq, float* __restrict__ h2) {
    const int grp = t >> 6, j = t & 63; const int lt = vb * 4 + grp; const int l = lt / 2048, tt = lt % 2048;
    float* z = (float*)sm + grp * 128; float* h1 = z + 64;
    if (j < 33) {
        const float idx = (float)tt, tn = idx / 2047.f, w = 6.283185307179586f * idx / 2048.f;
        if (j == 0) z[0] = tn;
        else { const int k = (j <= 16) ? (j - 1) : (j - 17); const float band = 1e-4f + (float)k * ((15.f - 1e-4f) / 15.f); const float ang = w * band;
            z[j] = (j <= 16) ? cosf(ang) : -sinf(ang); }
    }
    __syncthreads();
    float a = b1[l * 64 + j];
    for (int e = 0; e < 33; ++e) a += z[e] * w1[(l * 33 + e) * 64 + j];
    h1[j] = sinf(freq[(l * 2 + 0) * 64 + j] * a);
    __syncthreads();
    float a2 = b2[l * 64 + j];
    for (int i = 0; i < 64; ++i) a2 += h1[i] * w2[(l * 64 + i) * 64 + j];
    h2[((size_t)l * 2048 + tt) * 64 + j] = sinf(freq[(l * 2 + 1) * 64 + j] * a2);
}

#define LAS __attribute__((address_space(3)))
typedef short bf16x8 __attribute__((ext_vector_type(8)));
typedef float f32x4 __attribute__((ext_vector_type(4)));
typedef float f32x2 __attribute__((ext_vector_type(2)));
typedef unsigned u32x4 __attribute__((ext_vector_type(4)));
typedef unsigned u32x2 __attribute__((ext_vector_type(2)));
typedef int i32x8 __attribute__((ext_vector_type(8)));
typedef _Float16 h2 __attribute__((ext_vector_type(2)));
typedef int i32x4 __attribute__((ext_vector_type(4)));
namespace pg8 {
constexpr int BM = 256, BK = 64, HALF = 128, HTB = HALF * BK * 2, STAGE_BYTES = 8 * HTB, NXCD = 8, WGM = 8;
DEV int lds_byte(int r, int c) { const int st = (r >> 4) * 2 + (c >> 5), rr = r & 15, cc = c & 31, ob = rr * 64 + cc * 2; return st * 1024 + (ob ^ (((ob >> 9) & 1) << 5)); }
DEV void stage_rc(int b, int& R, int& C) { const int st = b / 1024, sb = b % 1024, swz = sb ^ (((sb >> 9) & 1) << 5); R = (st >> 1) * 16 + swz / 64; C = (st & 1) * 32 + (swz % 64) / 2; }
DEV int perm32(int rho) { const int n = rho >> 4, i = rho & 15; return 8 * (i >> 2) + 4 * n + (i & 3); }
typedef __bf16 bf16x2_t __attribute__((ext_vector_type(2)));
DEV unsigned cvt_pk_bf16(float lo, float hi) { return __builtin_bit_cast(unsigned, __builtin_convertvector((f32x2){lo, hi}, bf16x2_t)); }

struct Unit { int pm, pn, tag, nt; const char* a; const char* b; };
DEV void tile_of(int L, int nM, int nN, int& pm, int& pn) {
    const int nwg = nM * nN; int wgid = L; { const int q = nwg / NXCD, r = nwg % NXCD, xcd = wgid % NXCD, off = wgid / NXCD; wgid = (xcd < r ? xcd * (q + 1) : r * (q + 1) + (xcd - r) * q) + off; }
    const int nig = WGM * nN, gid = wgid / nig, fm = gid * WGM, gsz = (nM - fm) < WGM ? (nM - fm) : WGM;
    pm = fm + ((wgid % nig) % gsz); pn = (wgid % nig) / gsz;
}
struct PlainSched { const bf16_t* A; const bf16_t* Bt; int lda, ldb, nM, nN, nt, G, c, first, count;
    DEV bool next(int i, Unit& u) const { if (i >= count) return false; const long L = (long)(first + i) * G + c; if (L >= (long)nM * nN) return false; tile_of((int)L, nM, nN, u.pm, u.pn); u.tag = 0; u.nt = nt;
        u.a = (const char*)(A + (size_t)u.pm * BM * lda); u.b = (const char*)(Bt + (size_t)u.pn * BM * ldb); return true; } };

template <class Epi, class Sched, bool SP2 = true, bool ALIGN_EPI = true, int I8 = 0>
DEV void gemm_phase(LAS unsigned char* lds, const int lda, const int ldb, const Sched& S, const Epi& E, const int wv) {
    int wv_ = wv, ln_; asm volatile("v_mbcnt_lo_u32_b32 %1, -1, 0\n\tv_mbcnt_hi_u32_b32 %1, -1, %1" : "+s"(wv_), "=v"(ln_)); int tid_ = (wv_ << 6) | ln_;
    const int tid = tid_, wid = __builtin_amdgcn_readfirstlane(tid >> 6), lane = tid & 63, wr = wid >> 2, wc = wid & 3, fr = lane & 15, fq = lane >> 4;
    unsigned voffA[2], voffB[2];
#pragma unroll
    for (int i = 0; i < 2; ++i) { int R, C; stage_rc(tid * 16 + i * 8192, R, C); const int Rb = Epi::PERM ? ((R & ~31) + perm32(R & 31)) : R;
        voffA[i] = (unsigned)(R * lda + C) * 2u; voffB[i] = (unsigned)(Rb * ldb + C) * 2u; }
    const size_t kstep = (size_t)(BK * 2);
    const size_t hstepA = (size_t)HALF * lda * 2, hstepB = (size_t)HALF * ldb * 2;
    const unsigned ldsw = (unsigned)wid * 1024u;
    const int aoff = lds_byte(wr * 64 + fr, fq * 8), boff = lds_byte(wc * 32 + fr, fq * 8);
#define PG8_SA(b, h) (((b) * 2 + (h)) * HTB)
#define PG8_SB(b, h) ((4 + (b) * 2 + (h)) * HTB)
#define PG8_STAGE(bufoff, gbase, voff) do { _Pragma("unroll") for (int _i = 0; _i < 2; ++_i) \
        __builtin_amdgcn_global_load_lds((const unsigned*)((const char*)(gbase) + (voff)[_i]), (LAS unsigned*)(lds + (bufoff) + ldsw + _i * 8192), 16, 0, 0); } while (0)
#define PG8_LDA(dst, b, h) do { _Pragma("unroll") for (int m = 0; m < 4; ++m) _Pragma("unroll") for (int k = 0; k < 2; ++k) dst[m][k] = *(const LAS bf16x8*)(lds + PG8_SA(b, h) + aoff + m * 2048 + k * 1024); } while (0)
#define PG8_LDB(dst, b, h) do { _Pragma("unroll") for (int n = 0; n < 2; ++n) _Pragma("unroll") for (int k = 0; k < 2; ++k) dst[n][k] = *(const LAS bf16x8*)(lds + PG8_SB(b, h) + boff + n * 2048 + k * 1024); } while (0)
#define PG8_MMA(ai, bj, At, Bt) do { __builtin_amdgcn_s_setprio(1); \
        if (I8 == 1 || (I8 == 2 && (cur.tag & 1) == 0)) { _Pragma("unroll") for (int m = 0; m < 4; ++m) _Pragma("unroll") for (int n = 0; n < 2; ++n) _Pragma("unroll") for (int k = 0; k < 2; ++k) \
            acc[ai][bj][m][n] = __builtin_bit_cast(f32x4, __builtin_amdgcn_mfma_i32_16x16x64_i8(__builtin_bit_cast(i32x4, Bt[n][k]), __builtin_bit_cast(i32x4, At[m][k]), __builtin_bit_cast(i32x4, acc[ai][bj][m][n]), 0, 0, 0)); } \
        else { _Pragma("unroll") for (int m = 0; m < 4; ++m) _Pragma("unroll") for (int n = 0; n < 2; ++n) _Pragma("unroll") for (int k = 0; k < 2; ++k) \
            acc[ai][bj][m][n] = __builtin_amdgcn_mfma_f32_16x16x32_bf16(Bt[n][k], At[m][k], acc[ai][bj][m][n], 0, 0, 0); } __builtin_amdgcn_s_setprio(0); } while (0)
#define PG8_WAIT_V(n) asm volatile("s_waitcnt vmcnt(" #n ")" ::: "memory")
#define PG8_WAIT_L(n) asm volatile("s_waitcnt lgkmcnt(" #n ")" ::: "memory")
#define PG8_BAR __builtin_amdgcn_s_barrier()
#define PG8_SCHED __builtin_amdgcn_sched_barrier(0)
    Unit cur, nxt; int ui = 0;
    if (!S.next(0, cur)) return;
    f32x4 acc[2][2][4][2];
#pragma unroll
    for (int a = 0; a < 2; ++a)
#pragma unroll
        for (int b = 0; b < 2; ++b)
#pragma unroll
            for (int m = 0; m < 4; ++m)
#pragma unroll
                for (int n = 0; n < 2; ++n) acc[a][b][m][n] = (f32x4){0.f, 0.f, 0.f, 0.f};
    bf16x8 At[4][2], B0[2][2], B1[2][2];
    const char* cA = cur.a; const char* cB = cur.b;
    if constexpr (SP2) {
        PG8_STAGE(PG8_SB(0, 0), cB, voffB); PG8_STAGE(PG8_SB(0, 1), cB + hstepB, voffB); PG8_STAGE(PG8_SA(0, 0), cA, voffA); PG8_STAGE(PG8_SA(0, 1), cA + hstepA, voffA);
        if (wr == 1) PG8_BAR;
        PG8_WAIT_V(2); PG8_BAR;
        PG8_STAGE(PG8_SB(1, 0), cB + kstep, voffB); PG8_STAGE(PG8_SA(1, 0), cA + kstep, voffA); PG8_STAGE(PG8_SB(1, 1), cB + hstepB + kstep, voffB);
        PG8_WAIT_V(6); PG8_BAR;
    } else {
    PG8_STAGE(PG8_SB(0, 0), cB, voffB); PG8_STAGE(PG8_SA(0, 0), cA, voffA); PG8_STAGE(PG8_SB(0, 1), cB + hstepB, voffB); PG8_STAGE(PG8_SA(0, 1), cA + hstepA, voffA);
    if (wr == 1) PG8_BAR;
    PG8_WAIT_V(4); PG8_BAR;
    PG8_STAGE(PG8_SB(1, 0), cB + kstep, voffB); PG8_STAGE(PG8_SA(1, 0), cA + kstep, voffA); PG8_STAGE(PG8_SB(1, 1), cB + hstepB + kstep, voffB);
    PG8_WAIT_V(6); PG8_BAR;
    }
    for (;;) {
        const bool has_next = S.next(ui + 1, nxt);
        const char* nA = has_next ? nxt.a : cA; const char* nB = has_next ? nxt.b : cB;
        const int nt = cur.nt;
        for (int t = 0; t < nt; t += 2) {
            const bool last = (t == nt - 2);
            const char* a1 = cA + (size_t)(t + 1) * kstep;
            const char* a2 = last ? nA : cA + (size_t)(t + 2) * kstep; const char* b2 = last ? nB : cB + (size_t)(t + 2) * kstep;
            const char* a3 = a2 + kstep; const char* b3 = b2 + kstep;
            if constexpr (SP2) {
            PG8_LDB(B0, 0, 0); PG8_LDB(B1, 0, 1); PG8_SCHED; PG8_LDA(At, 0, 0); PG8_STAGE(PG8_SA(1, 1), a1 + hstepA, voffA);
            PG8_WAIT_V(8); PG8_WAIT_L(0); PG8_BAR; PG8_MMA(0, 0, At, B0); PG8_MMA(0, 1, At, B1); PG8_BAR; PG8_SCHED;
            PG8_LDA(At, 0, 1); PG8_STAGE(PG8_SB(0, 0), b2, voffB); PG8_STAGE(PG8_SB(0, 1), b2 + hstepB, voffB); PG8_STAGE(PG8_SA(0, 0), a2, voffA);
            PG8_WAIT_V(8); PG8_WAIT_L(0); PG8_BAR; PG8_MMA(1, 0, At, B0); PG8_MMA(1, 1, At, B1); PG8_BAR; PG8_SCHED;
            PG8_LDB(B0, 1, 0); PG8_LDB(B1, 1, 1); PG8_SCHED; PG8_LDA(At, 1, 0); PG8_STAGE(PG8_SA(0, 1), a2 + hstepA, voffA);
            PG8_WAIT_V(8); PG8_WAIT_L(0); PG8_BAR; PG8_MMA(0, 0, At, B0); PG8_MMA(0, 1, At, B1); PG8_BAR; PG8_SCHED;
            PG8_LDA(At, 1, 1); PG8_STAGE(PG8_SB(1, 0), b3, voffB); PG8_STAGE(PG8_SB(1, 1), b3 + hstepB, voffB); PG8_STAGE(PG8_SA(1, 0), a3, voffA);
            PG8_WAIT_V(8); PG8_WAIT_L(0); PG8_BAR; PG8_MMA(1, 0, At, B0); PG8_MMA(1, 1, At, B1); PG8_BAR; PG8_SCHED;
            } else {
            PG8_LDB(B0, 0, 0); PG8_SCHED; PG8_LDA(At, 0, 0); PG8_STAGE(PG8_SA(1, 1), a1 + hstepA, voffA);
            PG8_WAIT_L(8); PG8_BAR; PG8_WAIT_L(0); PG8_MMA(0, 0, At, B0); PG8_BAR; PG8_SCHED;
            PG8_LDB(B1, 0, 1); PG8_STAGE(PG8_SB(0, 0), b2, voffB);
            PG8_BAR; PG8_WAIT_L(0); PG8_MMA(0, 1, At, B1); PG8_BAR;
            PG8_LDA(At, 0, 1); PG8_STAGE(PG8_SA(0, 0), a2, voffA);
            PG8_BAR; PG8_WAIT_L(0); PG8_MMA(1, 0, At, B0); PG8_BAR; PG8_SCHED;
            PG8_STAGE(PG8_SB(0, 1), b2 + hstepB, voffB);
            PG8_WAIT_V(6); PG8_BAR; PG8_MMA(1, 1, At, B1); PG8_BAR;
            PG8_LDB(B0, 1, 0); PG8_SCHED; PG8_LDA(At, 1, 0); PG8_STAGE(PG8_SA(0, 1), a2 + hstepA, voffA);
            PG8_WAIT_L(8); PG8_BAR; PG8_WAIT_L(0); PG8_MMA(0, 0, At, B0); PG8_BAR; PG8_SCHED;
            PG8_LDB(B1, 1, 1); PG8_STAGE(PG8_SB(1, 0), b3, voffB);
            PG8_BAR; PG8_WAIT_L(0); PG8_MMA(0, 1, At, B1); PG8_BAR;
            PG8_LDA(At, 1, 1); PG8_STAGE(PG8_SA(1, 0), a3, voffA);
            PG8_BAR; PG8_WAIT_L(0); PG8_MMA(1, 0, At, B0); PG8_BAR; PG8_SCHED;
            PG8_STAGE(PG8_SB(1, 1), b3 + hstepB, voffB);
            PG8_WAIT_V(6); PG8_BAR; PG8_MMA(1, 1, At, B1); PG8_BAR;
            }
        }
        if constexpr (ALIGN_EPI) { if (wr == 0) PG8_BAR; }
        if constexpr (!Epi::AFTER_DRAIN) E(acc, cur, wr, wc, fr, fq);
        if (!has_next) break;
        if constexpr (!Epi::INPLACE)
#pragma unroll
        for (int a = 0; a < 2; ++a)
#pragma unroll
            for (int b = 0; b < 2; ++b)
#pragma unroll
                for (int m = 0; m < 4; ++m)
#pragma unroll
                    for (int n = 0; n < 2; ++n) acc[a][b][m][n] = (f32x4){0.f, 0.f, 0.f, 0.f};
        cur = nxt; cA = nA; cB = nB; ++ui;
        if constexpr (ALIGN_EPI) { if (wr == 1) PG8_BAR; }
    }
    PG8_WAIT_V(0);
    if constexpr (!ALIGN_EPI) { if (wr == 0) PG8_BAR; }
    PG8_BAR;
    if constexpr (Epi::AFTER_DRAIN) E.fused(acc, cur, wr, wc, fr, fq, lds, wid, lane);
#undef PG8_SA
#undef PG8_SB
#undef PG8_STAGE
#undef PG8_LDA
#undef PG8_LDB
#undef PG8_MMA
#undef PG8_WAIT_V
#undef PG8_WAIT_L
#undef PG8_BAR
#undef PG8_SCHED
}
struct EpiBf { static constexpr bool PERM = true, AFTER_DRAIN = false, INPLACE = false; bf16_t* O; int ldc; int pad;
    DEV void operator()(const f32x4 (&acc)[2][2][4][2], const Unit& u, int wr, int wc, int fr, int fq) const {
        const int row0 = u.pm * BM + wr * 64 + fr, col0 = u.pn * BM + wc * 32 + 8 * fq;
#pragma unroll
        for (int ai = 0; ai < 2; ++ai)
#pragma unroll
            for (int m = 0; m < 4; ++m) { bf16_t* rowp = O + (size_t)(row0 + ai * HALF + m * 16) * ldc + col0;
#pragma unroll
                for (int bj = 0; bj < 2; ++bj) { const f32x4 v0 = acc[ai][bj][m][0], v1 = acc[ai][bj][m][1];
                    u32x4 w; w.x = cvt_pk_bf16(v0[0], v0[1]); w.y = cvt_pk_bf16(v0[2], v0[3]); w.z = cvt_pk_bf16(v1[0], v1[1]); w.w = cvt_pk_bf16(v1[2], v1[3]);
                    *(u32x4*)(rowp + bj * HALF) = w; } }
    } };
struct EpiHyT8 { static constexpr bool PERM = true, AFTER_DRAIN = false, INPLACE = false; bf16_t* O; const float* su;
    DEV void operator()(const f32x4 (&acc)[2][2][4][2], const Unit& u, int wr, int wc, int fr, int fq) const {
        const int row0 = u.pm * BM + wr * 64 + fr, col0 = u.pn * BM + wc * 32 + 8 * fq;
        f32x4 cs[2][2];
#pragma unroll
        for (int bj = 0; bj < 2; ++bj)
#pragma unroll
            for (int h = 0; h < 2; ++h) cs[bj][h] = *(const f32x4*)(su + col0 + bj * HALF + 4 * h) * (1.0f / WQ8_);
#pragma unroll
        for (int ai = 0; ai < 2; ++ai)
#pragma unroll
            for (int m = 0; m < 4; ++m) { bf16_t* rowp = O + (size_t)(row0 + ai * HALF + m * 16) * T_ + col0;
#pragma unroll
                for (int bj = 0; bj < 2; ++bj) { const i32x4 i0 = __builtin_bit_cast(i32x4, acc[ai][bj][m][0]), i1 = __builtin_bit_cast(i32x4, acc[ai][bj][m][1]);
                    const f32x4 v0 = (f32x4){(float)i0[0], (float)i0[1], (float)i0[2], (float)i0[3]} * cs[bj][0], v1 = (f32x4){(float)i1[0], (float)i1[1], (float)i1[2], (float)i1[3]} * cs[bj][1];
                    u32x4 w; w.x = cvt_pk_bf16(v0[0], v0[1]); w.y = cvt_pk_bf16(v0[2], v0[3]); w.z = cvt_pk_bf16(v1[0], v1[1]); w.w = cvt_pk_bf16(v1[2], v1[3]);
                    *(u32x4*)(rowp + bj * HALF) = w; } }
    } };
struct EpiP { static constexpr bool PERM = true, AFTER_DRAIN = false, INPLACE = false; bf16_t* P; const float2* rope; const float* su;
    DEV void operator()(const f32x4 (&acc)[2][2][4][2], const Unit& u, int wr, int wc, int fr, int fq) const {
        const int row0 = u.pm * BM + wr * 64 + fr, col0 = u.pn * BM + wc * 32 + 8 * fq; const int g = (wc & 1) * 4 + fq; const int pn = u.pn;
        const bool qs = (pn < 3) || (pn == 9) || (pn == 10);
#pragma unroll
        for (int ai = 0; ai < 2; ++ai)
#pragma unroll
            for (int m = 0; m < 4; ++m) { const int row = row0 + ai * HALF + m * 16; bf16_t* rowp = P + (size_t)row * PW_ + col0; const float rsc = su[row] * (1.0f / WQ8_);
                const float4* rp = (const float4*)(rope + (size_t)(row & 2047) * 32 + 4 * g); const float4 cs0 = rp[0], cs1 = rp[1];
                const float cc[4] = {cs0.x, cs0.z, cs1.x, cs1.z}, ss[4] = {cs0.y, cs0.w, cs1.y, cs1.w};
#pragma unroll
                for (int bj = 0; bj < 2; ++bj) { f32x4 v0, v1; { const i32x4 i0 = __builtin_bit_cast(i32x4, acc[ai][bj][m][0]), i1 = __builtin_bit_cast(i32x4, acc[ai][bj][m][1]);
                        v0 = (f32x4){(float)i0[0], (float)i0[1], (float)i0[2], (float)i0[3]} * rsc; v1 = (f32x4){(float)i1[0], (float)i1[1], (float)i1[2], (float)i1[3]} * rsc; }
                    const bool rp_ = (pn < 6) || (pn == 9) || (pn == 10) || (pn == 11 && bj == 0);
                    if (rp_) {
#pragma unroll
                        for (int j = 0; j < 4; ++j) { const float x1 = v0[j], x2 = v1[j]; float o1 = x1 * cc[j] - x2 * ss[j], o2 = x2 * cc[j] + x1 * ss[j];
                            if (qs) { o1 *= QSCALE_; o2 *= QSCALE_; } v0[j] = o1; v1[j] = o2; } }
                    u32x4 w; w.x = cvt_pk_bf16(v0[0], v0[1]); w.y = cvt_pk_bf16(v0[2], v0[3]); w.z = cvt_pk_bf16(v1[0], v1[1]); w.w = cvt_pk_bf16(v1[2], v1[3]);
                    *(u32x4*)(rowp + bj * HALF) = w; } }
    } };
struct EpiGate { static constexpr bool PERM = true, AFTER_DRAIN = false, INPLACE = false; bf16_t* g; const float* su;
    DEV void operator()(const f32x4 (&acc)[2][2][4][2], const Unit& u, int wr, int wc, int fr, int fq) const {
        bf16_t* gt = g + (size_t)(u.pn >> 2) * GSTRIDE_;
        const int row0 = u.pm * BM + wr * 64 + fr, col0 = (u.pn & 3) * BM + wc * 32 + 8 * fq;
#pragma unroll
        for (int ai = 0; ai < 2; ++ai)
#pragma unroll
            for (int m = 0; m < 4; ++m) { const size_t ro = (size_t)(row0 + ai * HALF + m * 16) * 1024 + col0; const float rsc = su[row0 + ai * HALF + m * 16] * (1.0f / WQ8_);
#pragma unroll
                for (int bj = 0; bj < 2; ++bj) { const i32x4 i0 = __builtin_bit_cast(i32x4, acc[ai][bj][m][0]), i1 = __builtin_bit_cast(i32x4, acc[ai][bj][m][1]); f32x4 v0, v1;
#pragma unroll
                    for (int j = 0; j < 4; ++j) { v0[j] = fmaxf(__builtin_amdgcn_rcpf(1.f + __expf(-(float)i0[j] * rsc)), 1e-30f); v1[j] = fmaxf(__builtin_amdgcn_rcpf(1.f + __expf(-(float)i1[j] * rsc)), 1e-30f); }
                    u32x4 w; w.x = cvt_pk_bf16(v0[0], v0[1]); w.y = cvt_pk_bf16(v0[2], v0[3]); w.z = cvt_pk_bf16(v1[0], v1[1]); w.w = cvt_pk_bf16(v1[2], v1[3]);
                    *(u32x4*)(gt + ro + bj * HALF) = w; } }
    } };
struct EpiBranch3 { static constexpr bool PERM = true, AFTER_DRAIN = false, INPLACE = true; const bf16_t* g; bf16_t* merged;
    DEV static void unpack8(const u32x4 q, float (&f)[8]) { f[0] = __uint_as_float(q.x << 16); f[1] = __uint_as_float(q.x & 0xffff0000u); f[2] = __uint_as_float(q.y << 16); f[3] = __uint_as_float(q.y & 0xffff0000u);
        f[4] = __uint_as_float(q.z << 16); f[5] = __uint_as_float(q.z & 0xffff0000u); f[6] = __uint_as_float(q.w << 16); f[7] = __uint_as_float(q.w & 0xffff0000u); }
    DEV void operator()(f32x4 (&acc)[2][2][4][2], const Unit& u, int wr, int wc, int fr, int fq) const {
        const int row0 = u.pm * BM + wr * 64 + fr, col0 = u.pn * BM + wc * 32 + 8 * fq; const int tag = u.tag;
        const bool fin = (tag == 2); const float keepf = fin ? 0.f : 1.f; const bf16_t* gn = g + (size_t)tag * GSTRIDE_; const bf16_t* gd = gn + GSTRIDE_;
#pragma unroll
        for (int ah = 0; ah < 4; ++ah) { const int ai = ah >> 1, m0 = (ah & 1) * 2; u32x4 nq[2][2], dq[2][2];
#pragma unroll
            for (int mm = 0; mm < 2; ++mm)
#pragma unroll
                for (int bj = 0; bj < 2; ++bj) { const size_t o = (size_t)(row0 + ai * HALF + (m0 + mm) * 16) * 1024 + col0 + bj * HALF; nq[mm][bj] = *(const u32x4*)(gn + o);
                    dq[mm][bj] = (u32x4){0x3f803f80u, 0x3f803f80u, 0x3f803f80u, 0x3f803f80u}; if (!fin) dq[mm][bj] = *(const u32x4*)(gd + o); }
            asm volatile("" ::: "memory");
#pragma unroll
            for (int mm = 0; mm < 2; ++mm)
#pragma unroll
                for (int bj = 0; bj < 2; ++bj) { const int m = m0 + mm; const size_t o = (size_t)(row0 + ai * HALF + m * 16) * 1024 + col0 + bj * HALF; float nn[8], dd[8]; unpack8(nq[mm][bj], nn); unpack8(dq[mm][bj], dd);
                    const f32x4 s0 = (f32x4){nn[0] * __builtin_amdgcn_rcpf(dd[0]), nn[1] * __builtin_amdgcn_rcpf(dd[1]), nn[2] * __builtin_amdgcn_rcpf(dd[2]), nn[3] * __builtin_amdgcn_rcpf(dd[3])};
                    const f32x4 s1 = (f32x4){nn[4] * __builtin_amdgcn_rcpf(dd[4]), nn[5] * __builtin_amdgcn_rcpf(dd[5]), nn[6] * __builtin_amdgcn_rcpf(dd[6]), nn[7] * __builtin_amdgcn_rcpf(dd[7])};
                    const f32x4 r0 = acc[ai][bj][m][0] * s0, r1 = acc[ai][bj][m][1] * s1;
                    if (fin) { u32x4 w; w.x = cvt_pk_bf16(r0[0], r0[1]); w.y = cvt_pk_bf16(r0[2], r0[3]); w.z = cvt_pk_bf16(r1[0], r1[1]); w.w = cvt_pk_bf16(r1[2], r1[3]); *(u32x4*)(merged + o) = w; }
                    acc[ai][bj][m][0] = r0 * keepf; acc[ai][bj][m][1] = r1 * keepf; asm volatile("" : "+v"(acc[ai][bj][m][0]), "+v"(acc[ai][bj][m][1])); }
            asm volatile("" ::: "memory"); }
    } };
struct EpiH { static constexpr bool PERM = true, AFTER_DRAIN = false, INPLACE = false; const float* xin; const bf16_t* xin16; bf16_t* hout; const float* ada_b;
    DEV void operator()(const f32x4 (&acc)[2][2][4][2], const Unit& u, int wr, int wc, int fr, int fq) const {
        const int row0 = u.pm * BM + wr * 64 + fr, col0 = u.pn * BM + wc * 32 + 8 * fq; const float* ab = ada_b + (size_t)(u.pm >> 3) * 6144 + 2048 + col0;
        const f32x4 g00 = *(const f32x4*)ab, g01 = *(const f32x4*)(ab + 4), g10 = *(const f32x4*)(ab + HALF), g11 = *(const f32x4*)(ab + HALF + 4);
        if (xin) {
#pragma unroll
            for (int ah = 0; ah < 4; ++ah) { const int ai = ah >> 1, m0 = (ah & 1) * 2; f32x4 xa[2][2][2];
#pragma unroll
                for (int mm = 0; mm < 2; ++mm)
#pragma unroll
                    for (int bj = 0; bj < 2; ++bj) { const float* xp = xin + (size_t)(row0 + ai * HALF + (m0 + mm) * 16) * 1024 + col0 + bj * HALF; xa[mm][bj][0] = *(const f32x4*)xp; xa[mm][bj][1] = *(const f32x4*)(xp + 4); }
                asm volatile("" ::: "memory");
#pragma unroll
                for (int mm = 0; mm < 2; ++mm)
#pragma unroll
                    for (int bj = 0; bj < 2; ++bj) { const int m = m0 + mm; const f32x4 h0 = ALPHA_ * xa[mm][bj][0] + (bj ? g10 : g00) * acc[ai][bj][m][0], h1 = ALPHA_ * xa[mm][bj][1] + (bj ? g11 : g01) * acc[ai][bj][m][1];
                        u32x4 w; w.x = cvt_pk_bf16(h0[0], h0[1]); w.y = cvt_pk_bf16(h0[2], h0[3]); w.z = cvt_pk_bf16(h1[0], h1[1]); w.w = cvt_pk_bf16(h1[2], h1[3]);
                        *(u32x4*)(hout + (size_t)(row0 + ai * HALF + m * 16) * 1024 + col0 + bj * HALF) = w; }
                asm volatile("" ::: "memory"); }
        } else {
#pragma unroll
            for (int ai = 0; ai < 2; ++ai) { u32x4 xq[4][2];
#pragma unroll
                for (int m = 0; m < 4; ++m)
#pragma unroll
                    for (int bj = 0; bj < 2; ++bj) xq[m][bj] = *(const u32x4*)(xin16 + (size_t)(row0 + ai * HALF + m * 16) * 1024 + col0 + bj * HALF);
                asm volatile("" ::: "memory");
#pragma unroll
                for (int m = 0; m < 4; ++m)
#pragma unroll
                    for (int bj = 0; bj < 2; ++bj) { const u32x4 q = xq[m][bj];
                        const f32x4 x0 = (f32x4){__uint_as_float(q.x << 16), __uint_as_float(q.x & 0xffff0000u), __uint_as_float(q.y << 16), __uint_as_float(q.y & 0xffff0000u)}, x1 = (f32x4){__uint_as_float(q.z << 16), __uint_as_float(q.z & 0xffff0000u), __uint_as_float(q.w << 16), __uint_as_float(q.w & 0xffff0000u)};
                        const f32x4 h0 = ALPHA_ * x0 + (bj ? g10 : g00) * acc[ai][bj][m][0], h1 = ALPHA_ * x1 + (bj ? g11 : g01) * acc[ai][bj][m][1];
                        u32x4 w; w.x = cvt_pk_bf16(h0[0], h0[1]); w.y = cvt_pk_bf16(h0[2], h0[3]); w.z = cvt_pk_bf16(h1[0], h1[1]); w.w = cvt_pk_bf16(h1[2], h1[3]);
                        *(u32x4*)(hout + (size_t)(row0 + ai * HALF + m * 16) * 1024 + col0 + bj * HALF) = w; }
                asm volatile("" ::: "memory"); }
        }
    } };
struct PanelStats {
    unsigned* xbuf;
    unsigned* cnt;
    unsigned* tmo;
    float eps;
    DEV bool run(const f32x4 (&v)[2][2][4][2], const Unit& u, int wr, int wc, int fr, int fq, LAS unsigned char* lds, int wid, int lane) const {
        LAS f32x2* Pt = (LAS f32x2*)lds;
        LAS f32x2* S = (LAS f32x2*)(lds + 8192);
        LAS unsigned* flag = (LAS unsigned*)(lds + 8192 + 2048);
#pragma unroll
        for (int ai = 0; ai < 2; ++ai)
#pragma unroll
            for (int m = 0; m < 4; ++m) {
                float s = 0.f;
#pragma unroll
                for (int bj = 0; bj < 2; ++bj)
#pragma unroll
                    for (int n = 0; n < 2; ++n) { const f32x4 x = v[ai][bj][m][n]; s += (x[0] + x[1]) + (x[2] + x[3]); }
                s += xor_f(s, 16, lane); s += xor_f(s, 32, lane);
                const float mw = s * (1.0f / 64.0f); float q = 0.f;
#pragma unroll
                for (int bj = 0; bj < 2; ++bj)
#pragma unroll
                    for (int n = 0; n < 2; ++n) { const f32x4 d = v[ai][bj][m][n] - mw; q += (d[0] * d[0] + d[1] * d[1]) + (d[2] * d[2] + d[3] * d[3]); }
                q += xor_f(q, 16, lane); q += xor_f(q, 32, lane);
                if (fq == 0) Pt[(ai * HALF + wr * 64 + m * 16 + fr) * 4 + wc] = (f32x2){mw, q};
            }
        asm volatile("s_waitcnt lgkmcnt(0)" ::: "memory"); __builtin_amdgcn_s_barrier(); asm volatile("" ::: "memory");
        const int row = wid * 32 + (lane & 31);
        if (lane < 32) {
            const f32x2 a = Pt[row * 4 + 0], b = Pt[row * 4 + 1], c = Pt[row * 4 + 2], d = Pt[row * 4 + 3];
            const float mt = (a.x + b.x + c.x + d.x) * 0.25f;
            const float da = a.x - mt, db = b.x - mt, dc = c.x - mt, dd = d.x - mt;
            const float m2 = (a.y + b.y) + (c.y + d.y) + 64.0f * ((da * da + db * db) + (dc * dc + dd * dd));
            unsigned long long* slot = (unsigned long long*)xbuf + ((size_t)(u.pm * BM + row) * 4 + u.pn);
            __hip_atomic_store(slot, ((unsigned long long)__float_as_uint(m2) << 32) | __float_as_uint(mt), __ATOMIC_RELAXED, __HIP_MEMORY_SCOPE_AGENT);
        }
        asm volatile("s_waitcnt vmcnt(0)" ::: "memory");
        if (lane == 0) __hip_atomic_fetch_add(cnt + 64 * u.pm, 1u, __ATOMIC_RELAXED, __HIP_MEMORY_SCOPE_AGENT);
        if (wid == 0) {
            bool dead = false; const unsigned long long t0 = __builtin_amdgcn_s_memrealtime();
            for (;;) {
                if ((unsigned)__builtin_amdgcn_readfirstlane(__hip_atomic_load(cnt + 64 * u.pm, __ATOMIC_RELAXED, __HIP_MEMORY_SCOPE_AGENT)) >= 32u) break;
                if (__builtin_amdgcn_s_memrealtime() - t0 > 2000000ull) { if (lane == 0) __hip_atomic_store(tmo, 1u, __ATOMIC_RELAXED, __HIP_MEMORY_SCOPE_AGENT); dead = true; break; }
                __builtin_amdgcn_s_sleep(2);
            }
            __builtin_amdgcn_fence(__ATOMIC_ACQUIRE, "agent");
            if (lane == 0) flag[0] = dead ? 1u : 0u;
        }
        asm volatile("s_waitcnt vmcnt(0) lgkmcnt(0)" ::: "memory"); __builtin_amdgcn_s_barrier(); asm volatile("" ::: "memory");
        const bool bad = flag[0] != 0u;
        if (lane < 32) {
            const unsigned long long* slot = (const unsigned long long*)xbuf + (size_t)(u.pm * BM + row) * 4; float mt[4], m2[4]; float ms = 0.f;
#pragma unroll
            for (int t = 0; t < 4; ++t) { const unsigned long long wv = __hip_atomic_load(slot + t, __ATOMIC_RELAXED, __HIP_MEMORY_SCOPE_AGENT); mt[t] = __uint_as_float((unsigned)wv); m2[t] = __uint_as_float((unsigned)(wv >> 32)); ms += mt[t]; }
            const float mean = ms * 0.25f; float q = 0.f;
#pragma unroll
            for (int t = 0; t < 4; ++t) { const float dm = mt[t] - mean; q += m2[t] + 256.0f * dm * dm; }
            S[row] = (f32x2){mean, 1.0f / sqrtf(q * (1.0f / 1024.0f) + eps)};
        }
        asm volatile("s_waitcnt lgkmcnt(0)" ::: "memory"); __builtin_amdgcn_s_barrier(); asm volatile("" ::: "memory");
        return bad;
    }
};
struct EpiOutLn { static constexpr bool PERM = false, AFTER_DRAIN = true, INPLACE = false; const float* xin; const bf16_t* xin16; bf16_t* xout;   const float* ada_b; const float* lng; const float* lnb; bf16_t* UY; PanelStats st;
    DEV void operator()(const f32x4 (&)[2][2][4][2], const Unit&, int, int, int, int) const {}
    DEV void fused(f32x4 (&acc)[2][2][4][2], const Unit& u, int wr, int wc, int fr, int fq, LAS unsigned char* lds, int wid, int lane) const {
        const LAS f32x2* S = (const LAS f32x2*)(lds + 8192);
        const int col0 = u.pn * BM + wc * 32 + 4 * fq; const float* ab = ada_b + (size_t)(u.pm >> 3) * 6144;
#pragma unroll
        for (int bj = 0; bj < 2; ++bj)
#pragma unroll
            for (int n = 0; n < 2; ++n) { const int cc = col0 + bj * HALF + n * 16; const f32x4 g1 = *(const f32x4*)(ab + 2048 + cc);
#pragma unroll
                for (int ai = 0; ai < 2; ++ai) {
#pragma unroll
                    for (int m = 0; m < 4; ++m) { const size_t xo_ = (size_t)(u.pm * BM + ai * HALF + wr * 64 + m * 16 + fr) * 1024 + cc; f32x4 xv;
                        if (xin) xv = *(const f32x4*)(xin + xo_); else { const u32x2 xq = *(const u32x2*)(xin16 + xo_); xv = (f32x4){__uint_as_float(xq.x << 16), __uint_as_float(xq.x & 0xffff0000u), __uint_as_float(xq.y << 16), __uint_as_float(xq.y & 0xffff0000u)}; }
                        acc[ai][bj][m][n] = ALPHA_ * xv + g1 * acc[ai][bj][m][n]; }
                    asm volatile("" : "+v"(acc[ai][bj][0][n]), "+v"(acc[ai][bj][1][n]), "+v"(acc[ai][bj][2][n]), "+v"(acc[ai][bj][3][n]) :: "memory"); } }
        const bool bad = st.run(acc, u, wr, wc, fr, fq, lds, wid, lane);
        const float qnan = __builtin_nanf("");
#pragma unroll
        for (int bj = 0; bj < 2; ++bj)
#pragma unroll
            for (int n = 0; n < 2; ++n) { const int cc = col0 + bj * HALF + n * 16; const f32x4 gg = *(const f32x4*)(lng + cc), bb = *(const f32x4*)(lnb + cc), sc = *(const f32x4*)(ab + 4096 + cc), sh = *(const f32x4*)(ab + 3072 + cc);
#pragma unroll
                for (int ai = 0; ai < 2; ++ai)
#pragma unroll
                    for (int m = 0; m < 4; ++m) { const int r = ai * HALF + wr * 64 + m * 16 + fr; const f32x2 sr = S[r]; const size_t row = (size_t)(u.pm * BM + r);
                        f32x4 y = (acc[ai][bj][m][n] - sr.x) * sr.y * gg + bb; if (bad) y = (f32x4){qnan, qnan, qnan, qnan};
                        { u32x2 xk; xk.x = cvt_pk_bf16(y[0], y[1]); xk.y = cvt_pk_bf16(y[2], y[3]); *(u32x2*)(xout + row * 1024 + cc) = xk; }
                        const f32x4 uu = y * (1.0f + sc) + sh; u32x2 pk; pk.x = cvt_pk_bf16(uu[0], uu[1]); pk.y = cvt_pk_bf16(uu[2], uu[3]);
                        *(u32x2*)(UY + row * UYW_ + cc) = pk; }
                asm volatile("" ::: "memory"); }
        asm volatile("s_waitcnt lgkmcnt(0)" ::: "memory"); __builtin_amdgcn_s_barrier(); asm volatile("" ::: "memory");
    }
};
struct GateSched { const bf16_t* UY; const unsigned char* WmT8; int G, c;
    DEV bool next(int i, Unit& u) const { const long L = (long)i * G + c; if (L >= 128 * 12) return false; tile_of((int)L, 128, 12, u.pm, u.pn); u.tag = 0; u.nt = 8;
        u.a = (const char*)(UY + (size_t)u.pm * BM * UYW_); u.b = (const char*)(WmT8 + (size_t)(u.pn & 3) * BM * (WMW_ * 2)) + (u.pn >> 2) * 1024; return true; } };
struct Branch3Sched { const bf16_t* UY; const unsigned char* WmT8; int G, c;
    DEV bool next(int i, Unit& u) const { const int ti = i / 3, ps = i - ti * 3; const long L = (long)ti * G + c; if (L >= 128 * 4) return false; tile_of((int)L, 128, 4, u.pm, u.pn); u.tag = ps;
        const int koff = ps == 0 ? 0 : (ps == 1 ? 256 : 768); u.nt = ps == 0 ? 4 : 8;
        u.a = (const char*)(UY + (size_t)u.pm * BM * UYW_) + (1024 + koff) * 2; u.b = (const char*)(WmT8 + (size_t)u.pn * BM * (WMW_ * 2)) + 3072 + koff * 2; return true; } };
}

DEV int win_orig_col(int n) {
    if (n >= 3072) return n < 4608 ? (n - 3072 + 2304) : n;
    const int head = n >> 6, p = n & 63; const bool rp = (head < 24) || (head >= 36 && head < 46);
    const int d = rp ? ((p & 4) ? 32 + 4 * (p >> 3) + (p & 3) : 4 * (p >> 3) + (p & 3)) : p;
    return ((n < 2304) ? head * 64 : 3840 + (head - 36) * 64) + d;
}
struct WPrep { const float *w_in, *wba, *wbb, *wbc, *w_out, *peer_wq; unsigned char *WinT8, *WmT8; bf16_t *WoutT, *WqT; };
DEV void nb_wprep(int vb, int t, unsigned char* sm, const WPrep& q) {
    const int l = vb / 3008; int r = vb - l * 3008; const float* W; int ldw; bf16_t* Wt = nullptr; unsigned char* W8 = nullptr; int ldt = 0, ld8 = 0, koff = 0, ntk = 16, mode = 0, nsub = 0;
    if (r < 1920) { W = q.w_in + (size_t)l * 1024 * 7680; ldw = 7680; mode = 1;
        if (r < 72 * 16) { W8 = q.WinT8 + (size_t)l * 4608 * 1024; ld8 = 1024; }
        else { const int br = (r / 16 - 72) / 16; W8 = q.WmT8 + (size_t)l * 1024 * (WMW_ * 2) + br * 1024; ld8 = WMW_ * 2; nsub = 4608 + br * 1024; } }
    else if (r < 1984) { r -= 1920; W = q.wba + (size_t)l * 256 * 1024; ldw = 1024; Wt = (bf16_t*)(q.WmT8 + (size_t)l * 1024 * (WMW_ * 2) + 3072); ldt = WMW_; koff = 0; ntk = 4; }
    else if (r < 2112) { r -= 1984; W = q.wbb + (size_t)l * 512 * 1024; ldw = 1024; Wt = (bf16_t*)(q.WmT8 + (size_t)l * 1024 * (WMW_ * 2) + 3072); ldt = WMW_; koff = 256; ntk = 8; }
    else if (r < 2240) { r -= 2112; W = q.wbc + (size_t)l * 512 * 1024; ldw = 1024; Wt = (bf16_t*)(q.WmT8 + (size_t)l * 1024 * (WMW_ * 2) + 3072); ldt = WMW_; koff = 768; ntk = 8; }
    else if (r < 2496) { r -= 2240; W = q.w_out + (size_t)l * 1024 * 1024; ldw = 1024; Wt = q.WoutT + (size_t)l * 1024 * 1024; ldt = 1024; }
    else { r -= 2496; W = q.peer_wq + (size_t)l * 1024 * 2048; ldw = 2048; Wt = q.WqT + (size_t)l * 2048 * 1024; ldt = 1024; }
    const int n0 = (r / ntk) * 64, k0 = (r % ntk) * 64; const int c0 = mode ? (win_orig_col(n0) & ~63) : n0;
    bf16_t* tile = (bf16_t*)sm;
    { const int kk = t >> 2, cs = (t & 3) * 16; const float* src = W + (size_t)(k0 + kk) * ldw + c0 + cs;
#pragma unroll
        for (int i = 0; i < 16; i += 4) { const float4 v = *(const float4*)(src + i); tile[kk * 66 + cs + i] = f2bf(v.x); tile[kk * 66 + cs + i + 1] = f2bf(v.y); tile[kk * 66 + cs + i + 2] = f2bf(v.z); tile[kk * 66 + cs + i + 3] = f2bf(v.w); } }
    __syncthreads();
    if (W8) { const int nn = t >> 2, ks = (t & 3) * 16; const int dl = win_orig_col(n0 + nn) - c0; unsigned char* dst8 = W8 + (size_t)(n0 + nn - nsub) * ld8 + k0 + ks; unsigned w8[4];
#pragma unroll
        for (int i = 0; i < 4; ++i) { w8[i] = 0u;
#pragma unroll
            for (int j = 0; j < 4; ++j) { const int qv = (int)rintf(fminf(fmaxf(bf2f(tile[(ks + 4 * i + j) * 66 + dl]) * WQ8_, -127.f), 127.f)); w8[i] |= ((unsigned)qv & 0xffu) << (8 * j); } }
        *(u32x4*)dst8 = (u32x4){w8[0], w8[1], w8[2], w8[3]}; }
    else { const int nn = t >> 2, ks = (t & 3) * 16; const int dl = mode ? (win_orig_col(n0 + nn) - c0) : nn; bf16_t* dst = Wt + (size_t)(n0 + nn - nsub) * ldt + koff + k0 + ks;
        unsigned w[8];
#pragma unroll
        for (int i = 0; i < 8; ++i) w[i] = (unsigned)tile[(ks + 2 * i) * 66 + dl] | ((unsigned)tile[(ks + 2 * i + 1) * 66 + dl] << 16);
        *(u32x4*)dst = (u32x4){w[0], w[1], w[2], w[3]}; *(u32x4*)(dst + 8) = (u32x4){w[4], w[5], w[6], w[7]}; }
}

namespace hy {
constexpr int ZS = 2064;
constexpr int G0_OFF = 0, G1_OFF = 8192, Z0_OFF = 16384, Z1_OFF = Z0_OFF + 16 * ZS * 2, LDS_END = Z1_OFF + 16 * ZS * 2;
DEV bf16x8 load_frag(LAS const unsigned char* lane_base, int d) {
    const LAS unsigned* p = (const LAS unsigned*)(lane_base + 32 * d); u32x4 w; w.x = p[0]; w.y = p[1]; w.z = p[2]; w.w = p[3];
    return __builtin_bit_cast(bf16x8, w);
}
DEV void load_filter(LAS unsigned char* lds, const bf16_t* g, int tid) {
    const u32x4 c = *(const u32x4*)(g + tid * 8); const unsigned nx = (tid < 511) ? (unsigned)g[tid * 8 + 8] : 0u;
    *(LAS u32x4*)(lds + G0_OFF + tid * 16) = c;
    u32x4 s; s.x = (c.x >> 16) | (c.y << 16); s.y = (c.y >> 16) | (c.z << 16); s.z = (c.z >> 16) | (c.w << 16); s.w = (c.w >> 16) | (nx << 16);
    *(LAS u32x4*)(lds + G1_OFF + tid * 16) = s;
}
DEV float bflo(unsigned w) { return __uint_as_float(w << 16); }
DEV float bfhi(unsigned w) { return __uint_as_float(w & 0xffff0000u); }
DEV void conv_rows(LAS const unsigned char* lds, int zoff, int w, int lane, f32x4 (&D)[16]) {
    const int r = lane & 15, q = lane >> 4;
    LAS const unsigned char* abase = lds + ((r & 1) ? (G0_OFF + 2 * (8 * q - r + 2047)) : (G1_OFF + 2 * (8 * q - r + 2046)));
    LAS const unsigned char* bbase = lds + zoff + (r * ZS + 8 * q) * 2;
    bf16x8 ring[16];
#pragma unroll
    for (int rb = 0; rb < 16; ++rb) D[rb] = (f32x4){0.f, 0.f, 0.f, 0.f};
#pragma unroll
    for (int rb = 2; rb < 16; ++rb) ring[rb] = load_frag(abase, -16 * w - rb);
#pragma unroll 1
    for (int jb0 = 0; jb0 < 64; jb0 += 8) {
#pragma unroll
        for (int u = 0; u < 8; ++u) { const int jb = jb0 + u;
            ring[(16 - 2 * u) & 15] = load_frag(abase, 2 * jb - 16 * w);
            ring[(17 - 2 * u) & 15] = load_frag(abase, 2 * jb - 16 * w - 1);
            const bf16x8 bf = *(const LAS bf16x8*)(bbase + 64 * jb);
#pragma unroll
            for (int rb = 0; rb < 16; ++rb) D[rb] = __builtin_amdgcn_mfma_f32_16x16x32_bf16(ring[(rb - 2 * u) & 15], bf, D[rb], 0, 0, 0);
        }
    }
}
DEV void sconv4(const bf16_t* in, int i, float w0, float w1, float w2, float cb, float (&o)[4]) {
    const u32x2 v = *(const u32x2*)(in + i); const float pm = (i > 0) ? bf2f(in[i - 1]) : 0.f, pn = (i + 4 < 2048) ? bf2f(in[i + 4]) : 0.f;
    const float x0 = bflo(v.x), x1 = bfhi(v.x), x2 = bflo(v.y), x3 = bfhi(v.y);
    o[0] = cb + w0 * pm + w1 * x0 + w2 * x1; o[1] = cb + w0 * x0 + w1 * x1 + w2 * x2; o[2] = cb + w0 * x1 + w1 * x2 + w2 * x3; o[3] = cb + w0 * x2 + w1 * x3 + w2 * pn;
}
DEV void hyena_phase(LAS unsigned char* lds, bf16_t* hyT, const bf16_t* Gr_l, const float* conv_w, const float* conv_b, const float* hy_bias, int G, int cblk, int wv) {
    int wv_ = wv, ln_; asm volatile("v_mbcnt_lo_u32_b32 %1, -1, 0\n\tv_mbcnt_hi_u32_b32 %1, -1, %1" : "+s"(wv_), "=v"(ln_)); int tid_ = (wv_ << 6) | ln_;
    const int tid = tid_, w = __builtin_amdgcn_readfirstlane(tid >> 6), lane = tid & 63, q = lane >> 4, b = lane & 15;
#pragma unroll 1
    for (int c = cblk; c < 512; c += G) {
        __syncthreads();
        load_filter(lds, Gr_l + (size_t)c * 4096, tid);
        { const float w0 = conv_w[c], w1 = conv_w[1536 + c], w2 = conv_w[3072 + c], cb = conv_b[c]; const bf16_t* row = hyT + (size_t)c * T_;
#pragma unroll 2
            for (int k = 0; k < 8; ++k) { const int pos = (k * 512 + tid) * 8; const int s = pos & 2047, bb = pos >> 11;
                const u32x4 v = *(const u32x4*)(row + pos); const float pm = (s > 0) ? bf2f(row[pos - 1]) : 0.f, pn = (s + 8 < 2048) ? bf2f(row[pos + 8]) : 0.f;
                const float x[10] = {pm, bflo(v.x), bfhi(v.x), bflo(v.y), bfhi(v.y), bflo(v.z), bfhi(v.z), bflo(v.w), bfhi(v.w), pn};
                float z[8];
#pragma unroll
                for (int e = 0; e < 8; ++e) z[e] = cb + w0 * x[e] + w1 * x[e + 1] + w2 * x[e + 2];
                u32x4 o; o.x = pg8::cvt_pk_bf16(z[0], z[1]); o.y = pg8::cvt_pk_bf16(z[2], z[3]); o.z = pg8::cvt_pk_bf16(z[4], z[5]); o.w = pg8::cvt_pk_bf16(z[6], z[7]);
                *(LAS u32x4*)(lds + Z0_OFF + (bb * ZS + s) * 2) = o; } }
        __syncthreads();
        f32x4 D[16];
        conv_rows(lds, Z0_OFF, w, lane, D);
        { const int xc = 512 + c; const float w0 = conv_w[xc], w1 = conv_w[1536 + xc], w2 = conv_w[3072 + xc], cb = conv_b[xc], bias = hy_bias[c]; const bf16_t* xin = hyT + (size_t)xc * T_ + b * 2048;
#pragma unroll
            for (int rb = 0; rb < 16; ++rb) { const int i = 256 * w + 16 * rb + 4 * q; float xv[4]; sconv4(xin, i, w0, w1, w2, cb, xv);
                const u32x2 zq = *(const LAS u32x2*)(lds + Z0_OFF + (b * ZS + i) * 2); const float zv[4] = {bflo(zq.x), bfhi(zq.x), bflo(zq.y), bfhi(zq.y)};
                float o[4];
#pragma unroll
                for (int e = 0; e < 4; ++e) o[e] = xv[e] * (D[rb][e] + bias * zv[e]);
                u32x2 pk; pk.x = pg8::cvt_pk_bf16(o[0], o[1]); pk.y = pg8::cvt_pk_bf16(o[2], o[3]);
                *(LAS u32x2*)(lds + Z1_OFF + (b * ZS + i) * 2) = pk; } }
        __syncthreads();
        load_filter(lds, Gr_l + (size_t)(512 + c) * 4096, tid);
        __syncthreads();
        conv_rows(lds, Z1_OFF, w, lane, D);
        { const int xc = 1024 + c; const float w0 = conv_w[xc], w1 = conv_w[1536 + xc], w2 = conv_w[3072 + xc], cb = conv_b[xc], bias = hy_bias[512 + c]; const bf16_t* xin = hyT + (size_t)xc * T_ + b * 2048;
            bf16_t* yout = hyT + (size_t)c * T_ + b * 2048;
#pragma unroll
            for (int rb = 0; rb < 16; ++rb) { const int i = 256 * w + 16 * rb + 4 * q; float xv[4]; sconv4(xin, i, w0, w1, w2, cb, xv);
                const u32x2 zq = *(const LAS u32x2*)(lds + Z1_OFF + (b * ZS + i) * 2); const float zv[4] = {bflo(zq.x), bfhi(zq.x), bflo(zq.y), bfhi(zq.y)};
                float o[4];
#pragma unroll
                for (int e = 0; e < 4; ++e) o[e] = xv[e] * (D[rb][e] + bias * zv[e]);
                u32x2 pk; pk.x = pg8::cvt_pk_bf16(o[0], o[1]); pk.y = pg8::cvt_pk_bf16(o[2], o[3]);
                *(u32x2*)(yout + i) = pk; } }
    }
    __syncthreads();
}
}

namespace peer {
DEV float wave_sum(float v, int lane) {
#pragma unroll
    for (int off = 32; off > 0; off >>= 1) v += xor_f(v, off, lane);
    return v;
}
DEV float wave_max(float v, int lane) {
#pragma unroll
    for (int off = 32; off > 0; off >>= 1) v = fmaxf(v, xor_f(v, off, lane));
    return v;
}
DEV unsigned pk4_fp8(float a, float b, float c, float d) { int w = __builtin_amdgcn_cvt_pk_fp8_f32(a, b, 0, false); w = __builtin_amdgcn_cvt_pk_fp8_f32(c, d, w, true); return (unsigned)w; }
DEV void nb_quant_tables(int vb, int t, const float* __restrict__ pu, const float* __restrict__ pv, unsigned char* __restrict__ U8, unsigned char* __restrict__ V4, float* __restrict__ sinv) {
    const int row = vb * 4 + (t >> 6), lane = t & 63; const float* src = (row < 16384) ? pu + (size_t)row * 1024 : pv + (size_t)(row - 16384) * 1024;
    const float4 a = *(const float4*)(src + 16 * lane), b = *(const float4*)(src + 16 * lane + 4), c = *(const float4*)(src + 16 * lane + 8), d = *(const float4*)(src + 16 * lane + 12);
    float mx = fmaxf(fmaxf(fmaxf(fabsf(a.x), fabsf(a.y)), fmaxf(fabsf(a.z), fabsf(a.w))), fmaxf(fmaxf(fabsf(b.x), fabsf(b.y)), fmaxf(fabsf(b.z), fabsf(b.w))));
    mx = fmaxf(mx, fmaxf(fmaxf(fmaxf(fabsf(c.x), fabsf(c.y)), fmaxf(fabsf(c.z), fabsf(c.w))), fmaxf(fmaxf(fabsf(d.x), fabsf(d.y)), fmaxf(fabsf(d.z), fabsf(d.w)))));
    mx = wave_max(mx, lane);
    {
        const float sc = (mx > 0.f) ? 6.f / mx : 0.f; unsigned w0 = 0u, w1 = 0u; const bool sw = false;
        w0 = __builtin_amdgcn_cvt_scalef32_pk_fp4_f32(w0, (sw ? a.y : a.x) * sc, (sw ? a.x : a.y) * sc, 1.0f, 0); w0 = __builtin_amdgcn_cvt_scalef32_pk_fp4_f32(w0, (sw ? a.w : a.z) * sc, (sw ? a.z : a.w) * sc, 1.0f, 1);
        w0 = __builtin_amdgcn_cvt_scalef32_pk_fp4_f32(w0, (sw ? b.y : b.x) * sc, (sw ? b.x : b.y) * sc, 1.0f, 2); w0 = __builtin_amdgcn_cvt_scalef32_pk_fp4_f32(w0, (sw ? b.w : b.z) * sc, (sw ? b.z : b.w) * sc, 1.0f, 3);
        w1 = __builtin_amdgcn_cvt_scalef32_pk_fp4_f32(w1, (sw ? c.y : c.x) * sc, (sw ? c.x : c.y) * sc, 1.0f, 0); w1 = __builtin_amdgcn_cvt_scalef32_pk_fp4_f32(w1, (sw ? c.w : c.z) * sc, (sw ? c.z : c.w) * sc, 1.0f, 1);
        w1 = __builtin_amdgcn_cvt_scalef32_pk_fp4_f32(w1, (sw ? d.y : d.x) * sc, (sw ? d.x : d.y) * sc, 1.0f, 2); w1 = __builtin_amdgcn_cvt_scalef32_pk_fp4_f32(w1, (sw ? d.w : d.z) * sc, (sw ? d.z : d.w) * sc, 1.0f, 3);
        unsigned char* dst = (row < 16384) ? U8 + (size_t)row * 512 : V4 + (size_t)(row - 16384) * 512;
        *(u32x2*)(dst + 8 * lane) = (u32x2){w0, w1};
        if (lane == 0) sinv[row] = (mx > 0.f) ? mx * (1.f / 6.f) : 0.f;
    }
}
DEV void peer_phase(LAS unsigned char* lds, const bf16_t* __restrict__ x1in, float* xout32, bf16_t* xout16, const float* ada_l,
                    const int* __restrict__ eidx, const float* __restrict__ egate, const unsigned char* __restrict__ U8, const unsigned char* __restrict__ V4,
                    const float* __restrict__ sinv, const float* __restrict__ g, const float* __restrict__ bta, const float* ada_next, bf16_t* UY, float* su_next, int G, int cblk, int wv) {
    int wv_ = wv, ln_; asm volatile("v_mbcnt_lo_u32_b32 %1, -1, 0\n\tv_mbcnt_hi_u32_b32 %1, -1, %1" : "+s"(wv_), "=v"(ln_)); int tid_ = (wv_ << 6) | ln_;
    const int tid = tid_, w = __builtin_amdgcn_readfirstlane(tid >> 6), lane = tid & 63;
    LAS unsigned char* urow_l = lds + w * 3072; LAS int* E_l = (LAS int*)(urow_l + 1024); LAS float* W_l = (LAS float*)(urow_l + 1536); LAS float* SU_l = (LAS float*)(urow_l + 2048); LAS float* SV_l = (LAS float*)(urow_l + 2560); LAS float* D_l = (LAS float*)(lds + 24576 + 8 * 8448 + w * 512); LAS unsigned char* stage_l = lds + 24576 + w * 8448;
#define PEER_SB __builtin_amdgcn_sched_barrier(0)
#define PEER_ISSUE_U(buf, gi) do { _Pragma("unroll") for (int n2 = 0; n2 < 8; ++n2) { const int e_ = E_l[(gi) * 16 + 2 * n2 + hh]; buf[n2] = *(const u32x4*)(U8 + (size_t)e_ * 512 + 16 * r32); } } while (0)
#define PEER_ISSUE_V(buf, gi) do { _Pragma("unroll") for (int n2 = 0; n2 < 8; ++n2) { const int e_ = E_l[(gi) * 16 + 2 * n2 + hh]; buf[n2] = *(const u32x4*)(V4 + (size_t)e_ * 512 + 16 * r32); } } while (0)
#define PEER_COMP_U(buf) do { _Pragma("unroll") for (int n2 = 0; n2 < 8; ++n2) *(LAS u32x4*)(stage_l + (2 * n2 + hh) * 528 + 16 * r32) = buf[n2]; asm volatile("s_waitcnt lgkmcnt(0)" ::: "memory"); \
        _Pragma("unroll") for (int k2 = 0; k2 < 8; ++k2) { const u32x4 bw = *(const LAS u32x4*)(stage_l + n * 528 + 64 * k2 + 16 * q); const u32x4 alo = *(const LAS u32x4*)(urow_l + 128 * k2 + 16 * q), ahi = *(const LAS u32x4*)(urow_l + 128 * k2 + 64 + 16 * q);     \
            const i32x8 av = (i32x8){(int)alo.x, (int)alo.y, (int)alo.z, (int)alo.w, (int)ahi.x, (int)ahi.y, (int)ahi.z, (int)ahi.w}; const i32x8 bv = (i32x8){(int)bw.x, (int)bw.y, (int)bw.z, (int)bw.w, 0, 0, 0, 0}; \
            if (k2 & 1) acc1 = __builtin_amdgcn_mfma_scale_f32_16x16x128_f8f6f4(av, bv, acc1, 0, 4, 0, 0x7F7F7F7F, 0, 0x7F7F7F7F); else acc = __builtin_amdgcn_mfma_scale_f32_16x16x128_f8f6f4(av, bv, acc, 0  , 4  , 0, 0x7F7F7F7F, 0, 0x7F7F7F7F); } } while (0)
#define PEER_UNPK(wd, base) do { o[(base) / 2 + 0] = __builtin_elementwise_fma(__builtin_bit_cast(h2, __builtin_amdgcn_cvt_scalef32_pk_f16_fp4((wd), 1.0f, 0)), w2, o[(base) / 2 + 0]); o[(base) / 2 + 1] = __builtin_elementwise_fma(__builtin_bit_cast(h2, __builtin_amdgcn_cvt_scalef32_pk_f16_fp4((wd), 1.0f, 1)), w2, o[(base) / 2 + 1]); \
            o[(base) / 2 + 2] = __builtin_elementwise_fma(__builtin_bit_cast(h2, __builtin_amdgcn_cvt_scalef32_pk_f16_fp4((wd), 1.0f, 2)), w2, o[(base) / 2 + 2]); o[(base) / 2 + 3] = __builtin_elementwise_fma(__builtin_bit_cast(h2, __builtin_amdgcn_cvt_scalef32_pk_f16_fp4((wd), 1.0f, 3)), w2, o[(base) / 2 + 3]); } while (0)
#define PEER_COMP_V(buf, gi) do { float wq_[8]; _Pragma("unroll") for (int n2 = 0; n2 < 8; ++n2) wq_[n2] = W_l[(gi) * 16 + 2 * n2 + hh]; \
        _Pragma("unroll") for (int n2 = 0; n2 < 8; ++n2) { const h2 w2 = __builtin_bit_cast(h2, wq_[n2]); const u32x4 v = buf[n2]; \
              \
            asm volatile("" : "+v"(o[0]), "+v"(o[1]), "+v"(o[2]), "+v"(o[3]), "+v"(o[4]), "+v"(o[5]), "+v"(o[6]), "+v"(o[7]), "+v"(o[8]), "+v"(o[9]), "+v"(o[10]), "+v"(o[11]), "+v"(o[12]), "+v"(o[13]), "+v"(o[14]), "+v"(o[15])); \
            PEER_UNPK(v.x, 0); PEER_UNPK(v.y, 8); PEER_UNPK(v.z, 16); PEER_UNPK(v.w, 24); } } while (0)
    int ne0 = 0, ne1 = 0; float ng0 = 0.f, ng1 = 0.f, nsu0 = 0.f, nsu1 = 0.f, nsv0 = 0.f, nsv1 = 0.f; u32x4 nx0 = (u32x4){0u, 0u, 0u, 0u}, nx1 = nx0;
    { const int tok0 = cblk * 8 + w; if (tok0 < T_) { const int dd = 32 * (lane & 31) + 16 * (lane >> 5); nx0 = *(const u32x4*)(x1in + (size_t)tok0 * 1024 + dd); nx1 = *(const u32x4*)(x1in + (size_t)tok0 * 1024 + dd + 8); ne0 = eidx[(size_t)tok0 * 128 + lane]; ne1 = eidx[(size_t)tok0 * 128 + 64 + lane]; ng0 = egate[(size_t)tok0 * 128 + lane]; ng1 = egate[(size_t)tok0 * 128 + 64 + lane];
        nsu0 = sinv[ne0]; nsu1 = sinv[ne1]; nsv0 = sinv[16384 + ne0]; nsv1 = sinv[16384 + ne1]; } }
#pragma unroll 1
    for (int tok = cblk * 8 + w; tok < T_; tok += G * 8) {
        int lane_o = lane; asm volatile("" : "+v"(lane_o));
        const int q = lane_o >> 4, n = lane_o & 15, r32 = lane_o & 31, hh = lane_o >> 5; int d0 = 32 * r32 + 16 * hh;
        const float* a = ada_l + (size_t)(tok >> 11) * 6144;
        float stinv; float x1[16]; u32x4 bufA[8], bufB[8];
        {
#pragma unroll
            for (int j = 0; j < 16; j += 8) { const u32x4 v = j ? nx1 : nx0;
                x1[j] = __uint_as_float(v.x << 16); x1[j + 1] = __uint_as_float(v.x & 0xffff0000u); x1[j + 2] = __uint_as_float(v.y << 16); x1[j + 3] = __uint_as_float(v.y & 0xffff0000u);
                x1[j + 4] = __uint_as_float(v.z << 16); x1[j + 5] = __uint_as_float(v.z & 0xffff0000u); x1[j + 6] = __uint_as_float(v.w << 16); x1[j + 7] = __uint_as_float(v.w & 0xffff0000u); }
            E_l[lane_o] = ne0; E_l[64 + lane_o] = ne1; W_l[lane_o] = ng0; W_l[64 + lane_o] = ng1;
            SU_l[lane_o] = nsu0; SU_l[64 + lane_o] = nsu1; SV_l[lane_o] = nsv0; SV_l[64 + lane_o] = nsv1;
            asm volatile("s_waitcnt lgkmcnt(0)" ::: "memory");
            PEER_ISSUE_U(bufA, 0); PEER_SB;
            float u[16]; float um = 0.f;
#pragma unroll
            for (int j = 0; j < 16; j += 4) { const float4 sc = *(const float4*)(a + 4096 + d0 + j), sh = *(const float4*)(a + 3072 + d0 + j);
                u[j] = x1[j] * (1.f + sc.x) + sh.x; u[j + 1] = x1[j + 1] * (1.f + sc.y) + sh.y; u[j + 2] = x1[j + 2] * (1.f + sc.z) + sh.z; u[j + 3] = x1[j + 3] * (1.f + sc.w) + sh.w;
                um = fmaxf(um, fmaxf(fmaxf(fabsf(u[j]), fabsf(u[j + 1])), fmaxf(fabsf(u[j + 2]), fabsf(u[j + 3])))); }
            um = wave_max(um, lane_o); const float st = (um > 0.f) ? 224.f / um : 1.f; stinv = (um > 0.f) ? um * (1.f / 224.f) : 1.f;
            u32x4 pq; pq.x = pk4_fp8(u[0] * st, u[1] * st, u[2] * st, u[3] * st); pq.y = pk4_fp8(u[4] * st, u[5] * st, u[6] * st, u[7] * st);
            pq.z = pk4_fp8(u[8] * st, u[9] * st, u[10] * st, u[11] * st); pq.w = pk4_fp8(u[12] * st, u[13] * st, u[14] * st, u[15] * st);
            *(LAS u32x4*)(urow_l + d0) = pq; }
        asm volatile("s_waitcnt lgkmcnt(0)" ::: "memory");
        PEER_SB;
#define PEER_FIN_U(gi) do { if (q == 0) D_l[(gi) * 16 + n] = acc[0] + acc1[0]; } while (0)
#pragma unroll 1
        for (int gi = 0; gi < 8; gi += 2) { f32x4 acc = (f32x4){0.f, 0.f, 0.f, 0.f}, acc1 = acc;
            PEER_ISSUE_U(bufB, gi + 1); PEER_SB; PEER_COMP_U(bufA); PEER_FIN_U(gi); PEER_SB;
            if (gi < 6) PEER_ISSUE_U(bufA, gi + 2); else PEER_ISSUE_V(bufA, 0);
            PEER_SB; acc = (f32x4){0.f, 0.f, 0.f, 0.f}; acc1 = acc; PEER_COMP_U(bufB); PEER_FIN_U(gi + 1); PEER_SB; }
        asm volatile("s_waitcnt lgkmcnt(0)" ::: "memory");
#pragma unroll
        for (int t = 0; t < 2; ++t) { const int ix = lane_o + 64 * t; const float ds_ = D_l[ix] * (SU_l[ix] * stinv); const float wv_ = W_l[ix] * 0.5f * ds_ * (1.f + erff(ds_ * 0.70710678118654752f)) * SV_l[ix];
            const _Float16 wh_ = (_Float16)wv_; W_l[ix] = __builtin_bit_cast(float, (h2){wh_, wh_}); }
#undef PEER_FIN_U
        asm volatile("s_waitcnt lgkmcnt(0)" ::: "memory");
        h2 o2[16];
#pragma unroll
        for (int j = 0; j < 16; ++j) o2[j] = (h2){(_Float16)0.f, (_Float16)0.f};
        const int tokn = tok + G * 8; const bool hasn = tokn < T_;
        if (hasn) { nx0 = *(const u32x4*)(x1in + (size_t)tokn * 1024 + d0); nx1 = *(const u32x4*)(x1in + (size_t)tokn * 1024 + d0 + 8); ne0 = eidx[(size_t)tokn * 128 + lane_o]; ne1 = eidx[(size_t)tokn * 128 + 64 + lane_o]; ng0 = egate[(size_t)tokn * 128 + lane_o]; ng1 = egate[(size_t)tokn * 128 + 64 + lane_o]; }
        PEER_SB;
        { h2 (&o)[16] = o2;
#pragma unroll 1
        for (int gi = 0; gi < 8; gi += 2) {
            PEER_ISSUE_V(bufB, gi + 1); PEER_SB; PEER_COMP_V(bufA, gi); PEER_SB;
            if (gi < 6) PEER_ISSUE_V(bufA, gi + 2);
            if (gi == 2 && hasn) { nsu0 = sinv[ne0]; nsu1 = sinv[ne1]; nsv0 = sinv[16384 + ne0]; nsv1 = sinv[16384 + ne1]; }
            PEER_SB; PEER_COMP_V(bufB, gi + 1); PEER_SB; } }
        asm volatile("" : "+v"(lane_o)); d0 = 32 * (lane_o & 31) + 16 * (lane_o >> 5);
        const unsigned hm = 0u - (unsigned)(lane_o >> 5);
        float o[16];
#pragma unroll
        for (int j = 0; j < 16; ++j) { const float lo_ = (float)o2[j >> 1][j & 1], hi_ = (float)o2[8 + (j >> 1)][j & 1];
            const float keep = __uint_as_float((__float_as_uint(lo_) & ~hm) | (__float_as_uint(hi_) & hm)), send = __uint_as_float((__float_as_uint(hi_) & ~hm) | (__float_as_uint(lo_) & hm));
            o[j] = keep + xor_f(send, 32, lane_o); }
        float hv[16]; float s = 0.f;
#pragma unroll
        for (int j = 0; j < 16; j += 4) { const float4 g2 = *(const float4*)(a + 5120 + d0 + j);
            hv[j] = ALPHA_ * x1[j] + g2.x * o[j]; hv[j + 1] = ALPHA_ * x1[j + 1] + g2.y * o[j + 1]; hv[j + 2] = ALPHA_ * x1[j + 2] + g2.z * o[j + 2]; hv[j + 3] = ALPHA_ * x1[j + 3] + g2.w * o[j + 3];
            s += (hv[j] + hv[j + 1]) + (hv[j + 2] + hv[j + 3]); }
        const float mu = wave_sum(s, lane_o) * (1.f / 1024.f); float qq = 0.f;
#pragma unroll
        for (int j = 0; j < 16; ++j) { const float dd = hv[j] - mu; qq += dd * dd; }
        const float rstd = rsqrtf(wave_sum(qq, lane_o) * (1.f / 1024.f) + LN_EPS_);
        const float* an = ada_next ? ada_next + (size_t)(tok >> 11) * 6144 : nullptr;
        float y[16];
#pragma unroll
        for (int j = 0; j < 16; j += 4) { const float4 gg = *(const float4*)(g + d0 + j), bb = *(const float4*)(bta + d0 + j);
            y[j] = (hv[j] - mu) * rstd * gg.x + bb.x; y[j + 1] = (hv[j + 1] - mu) * rstd * gg.y + bb.y; y[j + 2] = (hv[j + 2] - mu) * rstd * gg.z + bb.z; y[j + 3] = (hv[j + 3] - mu) * rstd * gg.w + bb.w;
            if (!xout16) *(float4*)(xout32 + (size_t)tok * 1024 + d0 + j) = make_float4(y[j], y[j + 1], y[j + 2], y[j + 3]); }
        if (xout16) { u32x4 q0, q1; q0.x = pg8::cvt_pk_bf16(y[0], y[1]); q0.y = pg8::cvt_pk_bf16(y[2], y[3]); q0.z = pg8::cvt_pk_bf16(y[4], y[5]); q0.w = pg8::cvt_pk_bf16(y[6], y[7]);
            q1.x = pg8::cvt_pk_bf16(y[8], y[9]); q1.y = pg8::cvt_pk_bf16(y[10], y[11]); q1.z = pg8::cvt_pk_bf16(y[12], y[13]); q1.w = pg8::cvt_pk_bf16(y[14], y[15]);
            bf16_t* xo = xout16 + (size_t)tok * 1024 + d0; *(u32x4*)xo = q0; *(u32x4*)(xo + 8) = q1; }
        if (an) { float uu[16]; float um = 0.f;
#pragma unroll
            for (int j = 0; j < 16; j += 4) { const float4 sc = *(const float4*)(an + 1024 + d0 + j), sh = *(const float4*)(an + d0 + j);
                uu[j] = y[j] * (1.f + sc.x) + sh.x; uu[j + 1] = y[j + 1] * (1.f + sc.y) + sh.y; uu[j + 2] = y[j + 2] * (1.f + sc.z) + sh.z; uu[j + 3] = y[j + 3] * (1.f + sc.w) + sh.w;
                um = fmaxf(um, fmaxf(fmaxf(fabsf(uu[j]), fabsf(uu[j + 1])), fmaxf(fabsf(uu[j + 2]), fabsf(uu[j + 3])))); }
            um = wave_max(um, lane_o); const float qs = (um > 0.f) ? 127.f / um : 0.f; unsigned o8[4];
#pragma unroll
            for (int e = 0; e < 4; ++e) { o8[e] = 0u;
#pragma unroll
                for (int j = 0; j < 4; ++j) o8[e] |= ((unsigned)(int)rintf(uu[4 * e + j] * qs) & 0xffu) << (8 * j); }
            *(u32x4*)((unsigned char*)(UY + (size_t)tok * UYW_) + d0) = (u32x4){o8[0], o8[1], o8[2], o8[3]};
            if (lane_o == 0) su_next[tok] = um * (1.f / 127.f); }
        asm volatile("s_waitcnt lgkmcnt(0)" ::: "memory");
    }
#undef PEER_SB
#undef PEER_ISSUE_U
#undef PEER_ISSUE_V
#undef PEER_COMP_U
#undef PEER_COMP_V
#undef PEER_UNPK
    __syncthreads();
}
}

namespace tk {
typedef float f32x16 __attribute__((ext_vector_type(16)));
constexpr int KROW = 272;
DEV unsigned sortable(float v) { const unsigned u = __float_as_uint(v); return u ^ ((unsigned)((int)u >> 31) | 0x80000000u); }
DEV float unsortable(unsigned k) { return __uint_as_float(k ^ ((~(unsigned)((int)k >> 31)) | 0x80000000u)); }
DEV unsigned umax_(unsigned a, unsigned b) { return a > b ? a : b; }
DEV unsigned umin_(unsigned a, unsigned b) { return a < b ? a : b; }
#define CE(x, y) { const unsigned hi_ = umax_(a[x], a[y]), lo_ = umin_(a[x], a[y]); a[x] = hi_; a[y] = lo_; }
DEV void sort16(unsigned (&a)[16]) {
    CE(0, 1); CE(3, 2); CE(4, 5); CE(7, 6); CE(8, 9); CE(11, 10); CE(12, 13); CE(15, 14); CE(0, 2); CE(1, 3); CE(6, 4); CE(7, 5); CE(8, 10); CE(9, 11); CE(14, 12); CE(15, 13); CE(0, 1); CE(2, 3); CE(5, 4); CE(7, 6); CE(8, 9); CE(10, 11); CE(13, 12); CE(15, 14); CE(0, 4); CE(1, 5); CE(2, 6); CE(3, 7); CE(12, 8); CE(13, 9); CE(14, 10); CE(15, 11); CE(0, 2); CE(1, 3); CE(4, 6); CE(5, 7); CE(10, 8); CE(11, 9); CE(14, 12); CE(15, 13); CE(0, 1); CE(2, 3); CE(4, 5); CE(6, 7); CE(9, 8); CE(11, 10); CE(13, 12); CE(15, 14); CE(0, 8); CE(1, 9); CE(2, 10); CE(3, 11); CE(4, 12); CE(5, 13); CE(6, 14); CE(7, 15); CE(0, 4); CE(1, 5); CE(2, 6); CE(3, 7); CE(8, 12); CE(9, 13); CE(10, 14); CE(11, 15); CE(0, 2); CE(1, 3); CE(4, 6); CE(5, 7); CE(8, 10); CE(9, 11); CE(12, 14); CE(13, 15); CE(0, 1); CE(2, 3); CE(4, 5); CE(6, 7); CE(8, 9); CE(10, 11); CE(12, 13); CE(14, 15);
}
DEV void bmerge16(unsigned (&a)[16]) {
    CE(0, 8); CE(1, 9); CE(2, 10); CE(3, 11); CE(4, 12); CE(5, 13); CE(6, 14); CE(7, 15); CE(0, 4); CE(1, 5); CE(2, 6); CE(3, 7); CE(8, 12); CE(9, 13); CE(10, 14); CE(11, 15); CE(0, 2); CE(1, 3); CE(4, 6); CE(5, 7); CE(8, 10); CE(9, 11); CE(12, 14); CE(13, 15); CE(0, 1); CE(2, 3); CE(4, 5); CE(6, 7); CE(8, 9); CE(10, 11); CE(12, 13); CE(14, 15);
}
#undef CE
DEV void top_merge(unsigned (&a)[16], const unsigned (&b)[16]) {
#pragma unroll
    for (int i = 0; i < 16; ++i) a[i] = umax_(a[i], b[15 - i]);
    bmerge16(a);
}
DEV void xlane_merge(unsigned (&a)[16], int lane) {
    unsigned b[16];
#pragma unroll
    for (int i = 0; i < 16; ++i) b[i] = (unsigned)xor_i((int)a[i], 32, lane);
    top_merge(a, b);
}
DEV unsigned lookup_idx(unsigned long long lo, unsigned long long hi, int a) { const unsigned long long wv = (a < 8) ? lo : hi; return (unsigned)(wv >> ((a & 7) * 8)) & 127u; }
DEV unsigned blendu(unsigned m, unsigned a, unsigned b) { return (a & ~m) | (b & m); }
DEV float blendf(unsigned m, float a, float b) { return __uint_as_float((__float_as_uint(a) & ~m) | (__float_as_uint(b) & m)); }

DEV void topk_phase(LAS unsigned char* lds, const bf16_t* __restrict__ Q2, const float* __restrict__ keys_l, int* __restrict__ eidx, float* __restrict__ egate, int G, int cblk, int wv) {
    int wv_ = wv, ln_; asm volatile("v_mbcnt_lo_u32_b32 %1, -1, 0\n\tv_mbcnt_hi_u32_b32 %1, -1, %1" : "+s"(wv_), "=v"(ln_)); int tid_ = (wv_ << 6) | ln_;
    const int tid = tid_, w = __builtin_amdgcn_readfirstlane(tid >> 6), lane = tid & 63, tl = lane & 31, hh = lane >> 5;
    asm volatile("" : "+s"(G));
    const bool by_head = (G & 7) == 0;
#pragma unroll 1
    for (int h = 0; h < 8; ++h) {
        if (by_head && h != (cblk & 7)) continue;
        __syncthreads();
        {
            const int r = tid >> 1, c0 = (tid & 1) * 64; const float* src = keys_l + ((size_t)h * 256 + r) * 128 + c0; LAS unsigned char* dst = lds + r * KROW + c0 * 2;
#pragma unroll
            for (int j = 0; j < 64; j += 8) { const float4 a = *(const float4*)(src + j), b = *(const float4*)(src + j + 4);
                u32x4 o; o.x = pg8::cvt_pk_bf16(a.x, a.y); o.y = pg8::cvt_pk_bf16(a.z, a.w); o.z = pg8::cvt_pk_bf16(b.x, b.y); o.w = pg8::cvt_pk_bf16(b.z, b.w); *(LAS u32x4*)(dst + j * 2) = o; }
        }
        __syncthreads();
        const int first = by_head ? (cblk >> 3) * 8 + w : cblk * 8 + w, stride = by_head ? (G >> 3) * 8 : G * 8;
#pragma unroll 1
        for (int blk = first; blk < T_ / 32; blk += stride) {
            const int tok = blk * 32 + tl; const bf16_t* qrow = Q2 + (size_t)tok * 2048 + h * 256 + 8 * hh;
            unsigned L[2][16];
#pragma unroll
            for (int p = 0; p < 2; ++p) {
                bf16x8 bq[8];
#pragma unroll
                for (int ks = 0; ks < 8; ++ks) bq[ks] = *(const bf16x8*)(qrow + p * 128 + 16 * ks);
#pragma unroll
                for (int t = 0; t < 4; ++t) {
                    f32x16 acc;
#pragma unroll
                    for (int e = 0; e < 16; ++e) acc[e] = 0.f;
#pragma unroll
                    for (int ks = 0; ks < 8; ++ks) { const bf16x8 ak = *(const LAS bf16x8*)(lds + (p * 128 + 32 * t + tl) * KROW + (16 * ks + 8 * hh) * 2);
                        acc = __builtin_amdgcn_mfma_f32_32x32x16_bf16(ak, bq[ks], acc, 0, 0, 0); }
                    unsigned K[16];
#pragma unroll
                    for (int e = 0; e < 16; ++e) K[e] = (sortable(acc[e]) & ~127u) | (unsigned)((127 - 32 * t - (e & 3) - 8 * (e >> 2)) - 4 * hh);
                    sort16(K);
                    if (t == 0) {
#pragma unroll
                        for (int e = 0; e < 16; ++e) L[p][e] = K[e];
                    } else top_merge(L[p], K);
                    __builtin_amdgcn_sched_barrier(0);
                }
                xlane_merge(L[p], lane);
                __builtin_amdgcn_sched_barrier(0);
            }
            float f1[16], f2[16];
#pragma unroll
            for (int e = 0; e < 16; ++e) { f1[e] = unsortable(L[0][e] & ~127u); f2[e] = unsortable(L[1][e] & ~127u); }
            unsigned hm = 0u - (unsigned)hh; asm volatile("" : "+v"(hm));
            unsigned C[2][16];
            C[0][0] = (sortable(blendf(hm, f1[0], f1[2]) + blendf(hm, f2[0], f2[1])) & ~255u) | (255u - blendu(hm, 0u, 33u));
            C[0][1] = (sortable(blendf(hm, f1[0], f1[2]) + blendf(hm, f2[1], f2[2])) & ~255u) | (255u - blendu(hm, 1u, 34u));
            C[0][2] = (sortable(blendf(hm, f1[0], f1[2]) + blendf(hm, f2[2], f2[3])) & ~255u) | (255u - blendu(hm, 2u, 35u));
            C[0][3] = (sortable(blendf(hm, f1[0], f1[2]) + blendf(hm, f2[3], f2[4])) & ~255u) | (255u - blendu(hm, 3u, 36u));
            C[0][4] = (sortable(blendf(hm, f1[0], f1[3]) + blendf(hm, f2[4], f2[0])) & ~255u) | (255u - blendu(hm, 4u, 48u));
            C[0][5] = (sortable(blendf(hm, f1[0], f1[3]) + blendf(hm, f2[5], f2[1])) & ~255u) | (255u - blendu(hm, 5u, 49u));
            C[0][6] = (sortable(blendf(hm, f1[0], f1[3]) + blendf(hm, f2[6], f2[2])) & ~255u) | (255u - blendu(hm, 6u, 50u));
            C[0][7] = (sortable(blendf(hm, f1[0], f1[3]) + blendf(hm, f2[7], f2[3])) & ~255u) | (255u - blendu(hm, 7u, 51u));
            C[0][8] = (sortable(blendf(hm, f1[0], f1[4]) + blendf(hm, f2[8], f2[0])) & ~255u) | (255u - blendu(hm, 8u, 64u));
            C[0][9] = (sortable(blendf(hm, f1[0], f1[4]) + blendf(hm, f2[9], f2[1])) & ~255u) | (255u - blendu(hm, 9u, 65u));
            C[0][10] = (sortable(blendf(hm, f1[0], f1[4]) + blendf(hm, f2[10], f2[2])) & ~255u) | (255u - blendu(hm, 10u, 66u));
            C[0][11] = (sortable(blendf(hm, f1[0], f1[5]) + blendf(hm, f2[11], f2[0])) & ~255u) | (255u - blendu(hm, 11u, 80u));
            C[0][12] = (sortable(blendf(hm, f1[0], f1[5]) + blendf(hm, f2[12], f2[1])) & ~255u) | (255u - blendu(hm, 12u, 81u));
            C[0][13] = (sortable(blendf(hm, f1[0], f1[6]) + blendf(hm, f2[13], f2[0])) & ~255u) | (255u - blendu(hm, 13u, 96u));
            C[0][14] = (sortable(blendf(hm, f1[0], f1[6]) + blendf(hm, f2[14], f2[1])) & ~255u) | (255u - blendu(hm, 14u, 97u));
            C[0][15] = (sortable(blendf(hm, f1[0], f1[7]) + blendf(hm, f2[15], f2[0])) & ~255u) | (255u - blendu(hm, 15u, 112u));
            C[1][0] = (sortable(blendf(hm, f1[1], f1[7]) + blendf(hm, f2[0], f2[1])) & ~255u) | (255u - blendu(hm, 16u, 113u));
            C[1][1] = (sortable(blendf(hm, f1[1], f1[8]) + blendf(hm, f2[1], f2[0])) & ~255u) | (255u - blendu(hm, 17u, 128u));
            C[1][2] = (sortable(blendf(hm, f1[1], f1[9]) + blendf(hm, f2[2], f2[0])) & ~255u) | (255u - blendu(hm, 18u, 144u));
            C[1][3] = (sortable(blendf(hm, f1[1], f1[10]) + blendf(hm, f2[3], f2[0])) & ~255u) | (255u - blendu(hm, 19u, 160u));
            C[1][4] = (sortable(blendf(hm, f1[1], f1[11]) + blendf(hm, f2[4], f2[0])) & ~255u) | (255u - blendu(hm, 20u, 176u));
            C[1][5] = (sortable(blendf(hm, f1[1], f1[12]) + blendf(hm, f2[5], f2[0])) & ~255u) | (255u - blendu(hm, 21u, 192u));
            C[1][6] = (sortable(blendf(hm, f1[1], f1[13]) + blendf(hm, f2[6], f2[0])) & ~255u) | (255u - blendu(hm, 22u, 208u));
            C[1][7] = (sortable(blendf(hm, f1[1], f1[14]) + blendf(hm, f2[7], f2[0])) & ~255u) | (255u - blendu(hm, 23u, 224u));
            C[1][8] = (sortable(blendf(hm, f1[2], f1[15]) + blendf(hm, f2[0], f2[0])) & ~255u) | (255u - blendu(hm, 32u, 240u));
            C[1][9] = 0u;
            C[1][10] = 0u;
            C[1][11] = 0u;
            C[1][12] = 0u;
            C[1][13] = 0u;
            C[1][14] = 0u;
            C[1][15] = 0u;
            sort16(C[0]); sort16(C[1]); top_merge(C[0], C[1]); xlane_merge(C[0], lane);
            unsigned long long p1lo = 0ull, p1hi = 0ull, p2lo = 0ull, p2hi = 0ull;
#pragma unroll
            for (int m = 0; m < 8; ++m) { p1lo |= (unsigned long long)(127u - (L[0][m] & 127u)) << (8 * m); p1hi |= (unsigned long long)(127u - (L[0][8 + m] & 127u)) << (8 * m);
                p2lo |= (unsigned long long)(127u - (L[1][m] & 127u)) << (8 * m); p2hi |= (unsigned long long)(127u - (L[1][8 + m] & 127u)) << (8 * m); }
            float val[16]; unsigned ex[16]; float sum = 0.f;
#pragma unroll
            for (int k = 0; k < 16; ++k) { const unsigned flat = 255u - (C[0][k] & 255u); const int a = (int)(flat >> 4), b = (int)(flat & 15u);
                val[k] = unsortable(C[0][k] & ~255u); ex[k] = lookup_idx(p1lo, p1hi, a) * 128u + lookup_idx(p2lo, p2hi, b); }
            const float mx = val[0];
#pragma unroll
            for (int k = 0; k < 16; ++k) { val[k] = __expf(val[k] - mx); sum += val[k]; }
            const float inv = 1.f / sum;
            int eo[8]; float go[8];
#pragma unroll
            for (int k = 0; k < 8; ++k) { eo[k] = (int)blendu(hm, ex[k], ex[8 + k]); go[k] = blendf(hm, val[k], val[8 + k]) * inv; }
            const size_t ob = ((size_t)tok * 8 + h) * 16 + 8 * hh;
            *(int4*)(eidx + ob) = make_int4(eo[0], eo[1], eo[2], eo[3]); *(int4*)(eidx + ob + 4) = make_int4(eo[4], eo[5], eo[6], eo[7]);
            *(float4*)(egate + ob) = make_float4(go[0], go[1], go[2], go[3]); *(float4*)(egate + ob + 4) = make_float4(go[4], go[5], go[6], go[7]);
        }
    }
    __syncthreads();
}
}

namespace at {
typedef float f32x16 __attribute__((ext_vector_type(16)));
constexpr int KROWB = 144, VROWB = 776, K_OFF = 0, V_OFF = 384 * KROWB, LDS_END = V_OFF + 64 * VROWB;
constexpr int N_ITEMS_A = 16 * 12 * 8, N_ITEMS_C = 16 * 2 * 16 * 2;

struct Band { int p_w, ls, R, slot_base; };
template <bool MASK>
DEV void chunk(LAS const unsigned char* lds, const Band& bd, int c, const bf16x8 (&qf)[4], int tl, int hh, int lane, f32x16 (&O)[2], float& m, float& l) {
    const int kp0 = bd.p_w - bd.R + 32 * c;
    if (kp0 + 31 < 0 || kp0 >= bd.ls) return;
    const int s0 = kp0 + bd.slot_base;
    f32x16 S;
#pragma unroll
    for (int e = 0; e < 16; ++e) S[e] = 0.f;
#pragma unroll
    for (int ks = 0; ks < 4; ++ks) { const bf16x8 ak = *(const LAS bf16x8*)(lds + K_OFF + (s0 + tl) * KROWB + (16 * ks + 8 * hh) * 2); S = __builtin_amdgcn_mfma_f32_32x32x16_bf16(ak, qf[ks], S, 0, 0, 0); }
    float cmax = -1e30f;
    if (MASK) {
        const int dbase = (32 * c - bd.R) - tl + 4 * hh;
#pragma unroll
        for (int e = 0; e < 16; ++e) { const int diff = dbase + (e & 3) + 8 * (e >> 2); const bool ok = (diff <= bd.R) && (diff >= -bd.R); S[e] = ok ? S[e] : -1e30f; cmax = fmaxf(cmax, S[e]); }
    } else {
#pragma unroll
        for (int e = 0; e < 16; ++e) cmax = fmaxf(cmax, S[e]);
    }
    cmax = fmaxf(cmax, xor_f(cmax, 32, lane));
    const float mn = fmaxf(m, cmax), alpha = __builtin_amdgcn_exp2f(m - mn); m = mn;
    float psum = 0.f;
#pragma unroll
    for (int e = 0; e < 16; ++e) { S[e] = __builtin_amdgcn_exp2f(S[e] - mn); psum += S[e]; }
    l = l * alpha + psum;
#pragma unroll
    for (int e = 0; e < 16; ++e) { O[0][e] *= alpha; O[1][e] *= alpha; }
#pragma unroll
    for (int sx = 0; sx < 2; ++sx) {
        u32x4 pw; pw.x = pg8::cvt_pk_bf16(S[8 * sx + 0], S[8 * sx + 1]); pw.y = pg8::cvt_pk_bf16(S[8 * sx + 2], S[8 * sx + 3]); pw.z = pg8::cvt_pk_bf16(S[8 * sx + 4], S[8 * sx + 5]); pw.w = pg8::cvt_pk_bf16(S[8 * sx + 6], S[8 * sx + 7]);
        const bf16x8 pb = __builtin_bit_cast(bf16x8, pw);
#pragma unroll
        for (int dt = 0; dt < 2; ++dt) { LAS const unsigned char* vp = lds + V_OFF + (32 * dt + tl) * VROWB + (s0 + 16 * sx + 4 * hh) * 2;
            const u32x2 lo = *(const LAS u32x2*)vp, hi = *(const LAS u32x2*)(vp + 16); const u32x4 vw = (u32x4){lo.x, lo.y, hi.x, hi.y};
            O[dt] = __builtin_amdgcn_mfma_f32_32x32x16_bf16(__builtin_bit_cast(bf16x8, vw), pb, O[dt], 0, 0, 0); }
    }
}
DEV void attn_phase(LAS unsigned char* lds, bf16_t* P, float* lse2, bf16_t* Y, const float* sink_l, int G, int cblk, int wv) {
    int wv_ = wv, ln_; asm volatile("v_mbcnt_lo_u32_b32 %1, -1, 0\n\tv_mbcnt_hi_u32_b32 %1, -1, %1" : "+s"(wv_), "=v"(ln_)); int tid_ = (wv_ << 6) | ln_;
    const int tid = tid_, w = __builtin_amdgcn_readfirstlane(tid >> 6), lane = tid & 63, tl = lane & 31, hh = lane >> 5;
#pragma unroll 1
    for (int item = cblk; item < N_ITEMS_A + N_ITEMS_C; item += G) {
        int b, dil, ls, r, klo, nsl, R, kcol, vcol, qcol, two = 0, rp = 0, sb = 0, head = 0, isC = 0, nb = 0, qh0 = 0;
        if (item < N_ITEMS_A) { b = item / 96; const int rem = item - b * 96; head = rem >> 3; const int sub = rem & 7, g = head >> 2; R = 64;
            kcol = 768 + head * 64; vcol = 1536 + head * 64; qcol = head * 64;
            if (g == 0) { dil = 1; ls = 2048; r = 0; sb = sub; klo = 256 * sb - 64; nsl = 384; }
            else if (g == 1) { dil = 4; ls = 512; r = sub >> 1; sb = sub & 1; klo = 256 * sb - 64; nsl = 384; }
            else { dil = 16; ls = 128; r = 0; rp = sub; klo = 0; nsl = 256; two = 1; } }
        else { const int it = item - N_ITEMS_A; b = it >> 6; const int rem = it & 63; const int kvh = rem >> 5; nb = (rem & 31) >> 1; const int hp = rem & 1; isC = 1; R = 128;
            dil = 1; ls = 2048; r = 0; klo = 128 * nb - 128; nsl = 384; kcol = 2816 + kvh * 64; vcol = 2944 + kvh * 64; qh0 = kvh * 4 + hp * 2; qcol = 2304 + qh0 * 64; }
        __syncthreads();
        for (int i = tid; i < nsl * 8; i += 512) { const int slot = i >> 3, part = i & 7; int kpos, rr;
            if (two) { kpos = slot & 127; rr = 2 * rp + (slot >> 7); } else { kpos = klo + slot; rr = r; }
            u32x4 kv = (u32x4){0u, 0u, 0u, 0u}, vv = kv;
            if (kpos >= 0 && kpos < ls) { const bf16_t* rowp = P + (size_t)(b * 2048 + kpos * dil + rr) * PW_; kv = *(const u32x4*)(rowp + kcol + part * 8); vv = *(const u32x4*)(rowp + vcol + part * 8); }
            *(LAS u32x4*)(lds + K_OFF + slot * KROWB + part * 16) = kv;
            LAS unsigned short* vt = (LAS unsigned short*)(lds + V_OFF + (part * 8) * VROWB + slot * 2);
            vt[0 * (VROWB / 2)] = (unsigned short)(vv.x & 0xffffu); vt[1 * (VROWB / 2)] = (unsigned short)(vv.x >> 16); vt[2 * (VROWB / 2)] = (unsigned short)(vv.y & 0xffffu); vt[3 * (VROWB / 2)] = (unsigned short)(vv.y >> 16);
            vt[4 * (VROWB / 2)] = (unsigned short)(vv.z & 0xffffu); vt[5 * (VROWB / 2)] = (unsigned short)(vv.z >> 16); vt[6 * (VROWB / 2)] = (unsigned short)(vv.w & 0xffffu); vt[7 * (VROWB / 2)] = (unsigned short)(vv.w >> 16); }
        __syncthreads();
        Band bd; int qtok, rr = r; bd.ls = ls; bd.R = R;
        if (two) { const int half = w >> 2; bd.p_w = 32 * (w & 3); rr = 2 * rp + half; bd.slot_base = half * 128; }
        else if (isC) { bd.p_w = 128 * nb + 32 * (w & 3); bd.slot_base = -klo; }
        else { bd.p_w = 256 * sb + 32 * w; bd.slot_base = -klo; }
        qtok = b * 2048 + (bd.p_w + tl) * dil + rr;
        const int qc = isC ? (qcol + (w >> 2) * 64) : qcol;
        const bf16_t* qp = P + (size_t)qtok * PW_ + qc + 8 * hh;
        bf16x8 qf[4];
#pragma unroll
        for (int ks = 0; ks < 4; ++ks) qf[ks] = *(const bf16x8*)(qp + 16 * ks);
        f32x16 O[2];
#pragma unroll
        for (int e = 0; e < 16; ++e) { O[0][e] = 0.f; O[1][e] = 0.f; }
        float m = -1e30f, l = 0.f;
        const int nch = R / 16 + 1, cd = R / 32;
        chunk<false>(lds, bd, cd, qf, tl, hh, lane, O, m, l);
        chunk<true>(lds, bd, 0, qf, tl, hh, lane, O, m, l); chunk<true>(lds, bd, nch - 1, qf, tl, hh, lane, O, m, l);
#pragma unroll 1
        for (int c = 1; c < nch - 1; ++c) { if (c != cd) chunk<false>(lds, bd, c, qf, tl, hh, lane, O, m, l); }
        float lt = l + xor_f(l, 32, lane), scale;
        if (isC) { const float sk = sink_l[qh0 + (w >> 2)] * LOG2E_; const float mf = fmaxf(m, sk), corr = exp2f(m - mf); lt = lt * corr + exp2f(sk - mf); scale = corr / lt; }
        else { scale = 1.f / lt; if (hh == 0) lse2[(size_t)qtok * 12 + head] = m + log2f(lt); }
        bf16_t* op = isC ? (Y + (size_t)qtok * UYW_ + 768 + (qh0 + (w >> 2)) * 64) : (P + (size_t)qtok * PW_ + qcol);
#pragma unroll
        for (int dt = 0; dt < 2; ++dt)
#pragma unroll
            for (int g4 = 0; g4 < 4; ++g4) { u32x2 pk; pk.x = pg8::cvt_pk_bf16(O[dt][4 * g4] * scale, O[dt][4 * g4 + 1] * scale); pk.y = pg8::cvt_pk_bf16(O[dt][4 * g4 + 2] * scale, O[dt][4 * g4 + 3] * scale);
                *(u32x2*)(op + 32 * dt + 8 * g4 + 4 * hh) = pk; }
    }
    __syncthreads();
}
}

namespace xb {
constexpr int XB_TMO = 128, XB_TOP = 3328, XB_TOPGEN = 3392, XCD_BAR_WORDS = 3456; constexpr unsigned XB_SPIN_CAP = 1u << 22;
DEV constexpr int XB_XCNT(int j) { return 256 + 64 * j; }
DEV constexpr int XB_XSUB(int j) { return 1280 + 64 * j; }
DEV constexpr int XB_XGEN(int j) { return 2304 + 64 * j; }
DEV unsigned xb_ld(unsigned* p) { return __hip_atomic_load(p, __ATOMIC_RELAXED, __HIP_MEMORY_SCOPE_AGENT); }
DEV unsigned xb_add(unsigned* p, unsigned v) { return __hip_atomic_fetch_add(p, v, __ATOMIC_RELAXED, __HIP_MEMORY_SCOPE_AGENT); }
DEV unsigned xb_xcc_id() { return (unsigned)__builtin_amdgcn_s_getreg((3 << 11) | 20) & 0xFu; }
#define XB_SPIN(cond, bar) do { unsigned _sp = 0; while (cond) { __builtin_amdgcn_s_sleep(1); \
    if ((++_sp & 255u) == 0u) { if (xb_ld(&(bar)[XB_TMO])) break; if (_sp > XB_SPIN_CAP) { atomicAdd(&(bar)[XB_TMO], 1u); break; } } } } while (0)
struct XcdBarrier { unsigned* bar; unsigned x; volatile LAS unsigned* st; };
DEV XcdBarrier xcd_barrier_post(unsigned* bar, volatile LAS unsigned* st) { XcdBarrier b; b.bar = bar; b.x = xb_xcc_id(); b.st = st; if (threadIdx.x == 0) (void)xb_add(&bar[XB_XCNT(b.x)], 1u); return b; }
DEV void xcd_barrier_complete(unsigned* bar, unsigned x, unsigned& nloc, unsigned& nx) {
    const unsigned G = gridDim.x * gridDim.y * gridDim.z; unsigned sum, cnt, mine, sp = 0u;
    for (;;) { sum = 0u; cnt = 0u; mine = 0u;
#pragma unroll
        for (unsigned j = 0; j < 16; ++j) { const unsigned c = xb_ld(&bar[XB_XCNT(j)]); sum += c; cnt += (c > 0u) ? 1u : 0u; mine = (j == x) ? c : mine; }
        if (sum == G) break;
        __builtin_amdgcn_s_sleep(1);
        if ((++sp & 255u) == 0u) { if (xb_ld(&bar[XB_TMO])) break; if (sp > XB_SPIN_CAP) { atomicAdd(&bar[XB_TMO], 1u); break; } } }
    nloc = mine > 0u ? mine : 1u; nx = cnt > 0u ? cnt : 1u;
}
DEV void xcd_barrier(const XcdBarrier& b, int wv) {
    asm volatile("s_waitcnt vmcnt(0)" ::: "memory");
    __syncthreads();
    int ln0_; asm volatile("v_mbcnt_lo_u32_b32 %0, -1, 0\n\tv_mbcnt_hi_u32_b32 %0, -1, %0" : "=v"(ln0_));
    if (wv == 0 && ln0_ == 0) {
        unsigned* bar = b.bar; asm volatile("" : "+s"(bar));
        unsigned bx = xb_xcc_id(); asm volatile("" : "+s"(bx));
        __builtin_amdgcn_s_waitcnt(0);
        unsigned nloc = b.st[0], nx = b.st[1];
        if (nloc == 0u) { xcd_barrier_complete(bar, bx, nloc, nx); b.st[0] = nloc; b.st[1] = nx; }
        const unsigned old = xb_add(&bar[XB_XSUB(bx)], 1u); const unsigned gen = old / nloc;
        if (old + 1u == (gen + 1u) * nloc) {
            __builtin_amdgcn_fence(__ATOMIC_RELEASE, "agent");
            asm volatile("s_waitcnt vmcnt(0)" ::: "memory");
            const unsigned og = xb_add(&bar[XB_TOP], 1u); const unsigned tg = og / nx;
            if (og + 1u == (tg + 1u) * nx) xb_add(&bar[XB_TOPGEN], 1u);
            else XB_SPIN(xb_ld(&bar[XB_TOPGEN]) == tg, bar);
            __builtin_amdgcn_fence(__ATOMIC_ACQUIRE, "agent");
            xb_add(&bar[XB_XGEN(bx)], 1u);
            asm volatile("s_waitcnt vmcnt(0)" ::: "memory");
        } else {
            XB_SPIN(xb_ld(&bar[XB_XGEN(bx)]) == gen, bar);
            __builtin_amdgcn_fence(__ATOMIC_ACQUIRE, "agent");
            asm volatile("s_waitcnt vmcnt(0)" ::: "memory");
        }
    }
    __syncthreads();
}
}

namespace misc {
DEV void ada_phase(LAS unsigned char* lds, const float* __restrict__ c, const float* __restrict__ w_ada, const float* __restrict__ b_ada, float* __restrict__ ada, int G, int cblk, int wv) {
    int wv_ = wv, ln_; asm volatile("v_mbcnt_lo_u32_b32 %1, -1, 0\n\tv_mbcnt_hi_u32_b32 %1, -1, %1" : "+s"(wv_), "=v"(ln_)); int tid_ = (wv_ << 6) | ln_; const int tid = tid_, col = tid & 63, kg = tid >> 6;
    LAS float* cond = (LAS float*)lds;
    LAS float* part = (LAS float*)(lds + 65536);
    for (int i = tid; i < 16384; i += 512) { const float v = c[i]; cond[i] = v / (1.f + __expf(-v)); }
    __syncthreads();
#pragma unroll 1
    for (int item = cblk; item < 192; item += G) { const int l = item / 96, n0 = (item - l * 96) * 64;
        float acc[16];
#pragma unroll
        for (int b = 0; b < 16; ++b) acc[b] = 0.f;
        const float* wp = w_ada + ((size_t)l * 1024 + kg * 128) * 6144 + n0 + col;
#pragma unroll 4
        for (int kk = 0; kk < 128; ++kk) { const float wv = wp[(size_t)kk * 6144];
#pragma unroll
            for (int b = 0; b < 16; ++b) acc[b] += cond[b * 1024 + kg * 128 + kk] * wv; }
#pragma unroll
        for (int b = 0; b < 16; ++b) part[(kg * 16 + b) * 64 + col] = acc[b];
        __syncthreads();
        for (int o = tid; o < 1024; o += 512) { const int b = o >> 6, cc = o & 63; float sacc = b_ada[l * 6144 + n0 + cc];
#pragma unroll
            for (int g8 = 0; g8 < 8; ++g8) sacc += part[(g8 * 16 + b) * 64 + cc];
            ada[((size_t)l * 16 + b) * 6144 + n0 + cc] = sacc; }
        __syncthreads();
    }
}
DEV void yprep_phase(LAS unsigned char* lds, const bf16_t* __restrict__ hyT, const bf16_t* P, const float* __restrict__ lse2, bf16_t* Y, int G, int cblk, int wv) {
    int wv_ = wv, ln_; asm volatile("v_mbcnt_lo_u32_b32 %1, -1, 0\n\tv_mbcnt_hi_u32_b32 %1, -1, %1" : "+s"(wv_), "=v"(ln_)); int tid_ = (wv_ << 6) | ln_; const int tid = tid_;
    LAS unsigned short* tile = (LAS unsigned short*)lds;
#pragma unroll 1
    for (int it = cblk; it < 4096; it += G) { const int t0 = (it >> 3) * 64, c0 = (it & 7) * 64;
        __syncthreads();
        { const int cc = tid >> 3, seg = (tid & 7) * 8; const u32x4 v = *(const u32x4*)(hyT + (size_t)(c0 + cc) * T_ + t0 + seg); *(LAS u32x4*)(tile + cc * 72 + seg) = v; }
        __syncthreads();
        { const int tt = tid >> 3, seg = (tid & 7) * 8; unsigned wv[4];
#pragma unroll
            for (int e = 0; e < 4; ++e) wv[e] = (unsigned)tile[(seg + 2 * e) * 72 + tt] | ((unsigned)tile[(seg + 2 * e + 1) * 72 + tt] << 16);
            *(u32x4*)(Y + (size_t)(t0 + tt) * UYW_ + 256 + c0 + seg) = (u32x4){wv[0], wv[1], wv[2], wv[3]}; }
    }
#pragma unroll 1
    for (size_t idx = (size_t)cblk * 512 + tid; idx < (size_t)T_ * 32; idx += (size_t)G * 512) { const size_t tok = idx >> 5; const int c8 = (int)(idx & 31) * 8, hh = c8 >> 6;
        const float l0 = lse2[tok * 12 + hh], l1 = lse2[tok * 12 + 4 + hh], l2 = lse2[tok * 12 + 8 + hh]; const float mx = fmaxf(l0, fmaxf(l1, l2));
        float w0 = exp2f(l0 - mx), w1 = exp2f(l1 - mx), w2 = exp2f(l2 - mx); const float inv = 1.f / (w0 + w1 + w2); w0 *= inv; w1 *= inv; w2 *= inv;
        const bf16_t* pr = P + tok * PW_ + c8; const u32x4 a = *(const u32x4*)pr, b = *(const u32x4*)(pr + 256), c = *(const u32x4*)(pr + 512);
        const unsigned aw[4] = {a.x, a.y, a.z, a.w}, bw[4] = {b.x, b.y, b.z, b.w}, cw[4] = {c.x, c.y, c.z, c.w}; unsigned o[4];
#pragma unroll
        for (int e = 0; e < 4; ++e) { const float lo = w0 * __uint_as_float(aw[e] << 16) + w1 * __uint_as_float(bw[e] << 16) + w2 * __uint_as_float(cw[e] << 16);
            const float hi = w0 * __uint_as_float(aw[e] & 0xffff0000u) + w1 * __uint_as_float(bw[e] & 0xffff0000u) + w2 * __uint_as_float(cw[e] & 0xffff0000u); o[e] = pg8::cvt_pk_bf16(lo, hi); }
        *(u32x4*)(Y + tok * UYW_ + c8) = (u32x4){o[0], o[1], o[2], o[3]}; }
    __syncthreads();
}
DEV void filt_phase(LAS unsigned char* lds, const float* __restrict__ h2, const float* __restrict__ w3, const float* __restrict__ log_decay, bf16_t* __restrict__ Gr, int G, int cblk, int wv) {
    int wv_ = wv, ln_; asm volatile("v_mbcnt_lo_u32_b32 %1, -1, 0\n\tv_mbcnt_hi_u32_b32 %1, -1, %1" : "+s"(wv_), "=v"(ln_)); const int tid = (wv_ << 6) | ln_, lane = ln_;
    LAS float* hrow = (LAS float*)lds;
    LAS float* w3s = (LAS float*)(lds + 512 * 68 * 4);
    LAS float* dec = w3s + 1024;
    LAS float* red = dec + 16;
#pragma unroll 1
    for (int item = cblk; item < 256; item += G) { const int l = item >> 7, o = (item >> 6) & 1, cg = item & 63; const int colf0 = o * 512 + cg * 8;
        __syncthreads();
        for (int i = tid; i < 1024; i += 512) { const int jj = i >> 4, c16 = i & 15; const int col = (c16 < 8) ? colf0 + c16 : 1024 + colf0 + (c16 - 8); w3s[i] = w3[((size_t)l * 64 + jj) * 2048 + col]; }
        if (tid < 16) { const int col = (tid < 8) ? colf0 + tid : 1024 + colf0 + (tid - 8); dec[tid] = __expf(log_decay[l * 2048 + col]); }
        float vals[4][16];
#pragma unroll
        for (int ch = 0; ch < 4; ++ch) {
            __syncthreads();
            { const float* src = h2 + ((size_t)l * 2048 + ch * 512) * 64;
#pragma unroll 4
                for (int k = 0; k < 16; ++k) { const int idx = tid + 512 * k; const int row = idx >> 4, c4 = idx & 15; *(LAS f32x4*)(hrow + row * 68 + c4 * 4) = *(const f32x4*)(src + (size_t)idx * 4); } }
            __syncthreads();
            float acc[16];
#pragma unroll
            for (int c = 0; c < 16; ++c) acc[c] = 0.f;
#pragma unroll 2
            for (int j4 = 0; j4 < 16; ++j4) { const f32x4 hv = *(const LAS f32x4*)(hrow + tid * 68 + j4 * 4); const float hh4[4] = {hv.x, hv.y, hv.z, hv.w};
#pragma unroll
                for (int e = 0; e < 4; ++e) { const LAS f32x4* wr = (const LAS f32x4*)(w3s + (j4 * 4 + e) * 16); const f32x4 w0 = wr[0], w1 = wr[1], w2 = wr[2], w3v = wr[3];
                    acc[0] += hh4[e] * w0.x; acc[1] += hh4[e] * w0.y; acc[2] += hh4[e] * w0.z; acc[3] += hh4[e] * w0.w; acc[4] += hh4[e] * w1.x; acc[5] += hh4[e] * w1.y; acc[6] += hh4[e] * w1.z; acc[7] += hh4[e] * w1.w;
                    acc[8] += hh4[e] * w2.x; acc[9] += hh4[e] * w2.y; acc[10] += hh4[e] * w2.z; acc[11] += hh4[e] * w2.w; acc[12] += hh4[e] * w3v.x; acc[13] += hh4[e] * w3v.y; acc[14] += hh4[e] * w3v.z; acc[15] += hh4[e] * w3v.w; } }
            const float tn = (float)(ch * 512 + tid) * (1.f / 2047.f);
#pragma unroll
            for (int c = 0; c < 16; ++c) vals[ch][c] = acc[c] * __expf(-tn * dec[c]);
        }
        float ss[8];
#pragma unroll
        for (int c = 0; c < 8; ++c) { float a = 0.f;
#pragma unroll
            for (int ch = 0; ch < 4; ++ch) { a += vals[ch][c] * vals[ch][c]; if (ch > 0 || tid > 0) a += vals[ch][8 + c] * vals[ch][8 + c]; }
            ss[c] = peer::wave_sum(a, lane); }
        if (lane == 0) {
#pragma unroll
            for (int c = 0; c < 8; ++c) red[wv_ * 8 + c] = ss[c]; }
        __syncthreads();
        float scale[8];
#pragma unroll
        for (int c = 0; c < 8; ++c) { float a = 0.f;
#pragma unroll
            for (int g8 = 0; g8 < 8; ++g8) a += red[g8 * 8 + c];
            scale[c] = rsqrtf(a + 1e-12f); }
#pragma unroll
        for (int c = 0; c < 8; ++c) { bf16_t* gp = Gr + (((size_t)l * 2 + o) * 512 + cg * 8 + c) * 4096;
#pragma unroll
            for (int ch = 0; ch < 4; ++ch) { const int t = ch * 512 + tid; gp[2047 - t] = f2bf(vals[ch][c] * scale[c]); if (t > 0) gp[2047 + t] = f2bf(vals[ch][8 + c] * scale[c]); }
            if (tid == 0) gp[4095] = 0; }
    }
    __syncthreads();
}
DEV void modulate_phase(const float* __restrict__ x, const float* __restrict__ ada0, bf16_t* UY, float* __restrict__ su, int G, int cblk, int wv) {
    int wv_ = wv, ln_; asm volatile("v_mbcnt_lo_u32_b32 %1, -1, 0\n\tv_mbcnt_hi_u32_b32 %1, -1, %1" : "+s"(wv_), "=v"(ln_)); const int lane = ln_, w = wv_; const int d0 = 16 * lane;
#pragma unroll 1
    for (int tok = cblk * 8 + w; tok < T_; tok += G * 8) { const float* a = ada0 + (size_t)(tok >> 11) * 6144; const float* xr = x + (size_t)tok * 1024 + d0; float u[16]; float um = 0.f;
#pragma unroll
        for (int j = 0; j < 16; j += 4) { const float4 xv = *(const float4*)(xr + j), sc = *(const float4*)(a + 1024 + d0 + j), sh = *(const float4*)(a + d0 + j);
            u[j] = xv.x * (1.f + sc.x) + sh.x; u[j + 1] = xv.y * (1.f + sc.y) + sh.y; u[j + 2] = xv.z * (1.f + sc.z) + sh.z; u[j + 3] = xv.w * (1.f + sc.w) + sh.w;
            um = fmaxf(um, fmaxf(fmaxf(fabsf(u[j]), fabsf(u[j + 1])), fmaxf(fabsf(u[j + 2]), fabsf(u[j + 3])))); }
        um = peer::wave_max(um, lane); const float qs = (um > 0.f) ? 127.f / um : 0.f; unsigned o[4];
#pragma unroll
        for (int e = 0; e < 4; ++e) { o[e] = 0u;
#pragma unroll
            for (int j = 0; j < 4; ++j) o[e] |= ((unsigned)(int)rintf(u[4 * e + j] * qs) & 0xffu) << (8 * j); }
        *(u32x4*)((unsigned char*)(UY + (size_t)tok * UYW_) + d0) = (u32x4){o[0], o[1], o[2], o[3]};
        if (lane == 0) su[tok] = um * (1.f / 127.f); }
}
DEV void lnmod_phase(bf16_t* hx, const float* __restrict__ ada_l, const float* __restrict__ g, const float* __restrict__ bta, bf16_t* UY, int G, int cblk, int wv) {
    int wv_ = wv, ln_; asm volatile("v_mbcnt_lo_u32_b32 %1, -1, 0\n\tv_mbcnt_hi_u32_b32 %1, -1, %1" : "+s"(wv_), "=v"(ln_)); const int lane = ln_, w = wv_; const int d0 = 16 * lane;
#pragma unroll 1
    for (int tok0 = cblk * 8 + w; tok0 < T_; tok0 += 2 * G * 8) { u32x4 q[2][2]; const int tok1 = tok0 + G * 8; const bool two = tok1 < T_;
        q[0][0] = *(const u32x4*)(hx + (size_t)tok0 * 1024 + d0); q[0][1] = *(const u32x4*)(hx + (size_t)tok0 * 1024 + d0 + 8);
        q[1][0] = q[0][0]; q[1][1] = q[0][1]; if (two) { q[1][0] = *(const u32x4*)(hx + (size_t)tok1 * 1024 + d0); q[1][1] = *(const u32x4*)(hx + (size_t)tok1 * 1024 + d0 + 8); }
#pragma unroll
        for (int t = 0; t < 2; ++t) { const int tok = t ? tok1 : tok0; float hv[16]; float s = 0.f;
#pragma unroll
            for (int j = 0; j < 2; ++j) { const u32x4 v = q[t][j]; hv[8 * j] = __uint_as_float(v.x << 16); hv[8 * j + 1] = __uint_as_float(v.x & 0xffff0000u); hv[8 * j + 2] = __uint_as_float(v.y << 16); hv[8 * j + 3] = __uint_as_float(v.y & 0xffff0000u);
                hv[8 * j + 4] = __uint_as_float(v.z << 16); hv[8 * j + 5] = __uint_as_float(v.z & 0xffff0000u); hv[8 * j + 6] = __uint_as_float(v.w << 16); hv[8 * j + 7] = __uint_as_float(v.w & 0xffff0000u); }
#pragma unroll
            for (int j = 0; j < 16; j += 4) s += (hv[j] + hv[j + 1]) + (hv[j + 2] + hv[j + 3]);
            const float mu = peer::wave_sum(s, lane) * (1.f / 1024.f); float qq = 0.f;
#pragma unroll
            for (int j = 0; j < 16; ++j) { const float dd = hv[j] - mu; qq += dd * dd; }
            const float rstd = rsqrtf(peer::wave_sum(qq, lane) * (1.f / 1024.f) + LN_EPS_);
            const float* a = ada_l + (size_t)(tok >> 11) * 6144; float y[16], uu[16];
#pragma unroll
            for (int j = 0; j < 16; j += 4) { const float4 gg = *(const float4*)(g + d0 + j), bb = *(const float4*)(bta + d0 + j), sc = *(const float4*)(a + 4096 + d0 + j), sh = *(const float4*)(a + 3072 + d0 + j);
                y[j] = (hv[j] - mu) * rstd * gg.x + bb.x; y[j + 1] = (hv[j + 1] - mu) * rstd * gg.y + bb.y; y[j + 2] = (hv[j + 2] - mu) * rstd * gg.z + bb.z; y[j + 3] = (hv[j + 3] - mu) * rstd * gg.w + bb.w;
                uu[j] = y[j] * (1.f + sc.x) + sh.x; uu[j + 1] = y[j + 1] * (1.f + sc.y) + sh.y; uu[j + 2] = y[j + 2] * (1.f + sc.z) + sh.z; uu[j + 3] = y[j + 3] * (1.f + sc.w) + sh.w; }
            if (t == 0 || two) { u32x4 q0, q1, p0, p1;
                q0.x = pg8::cvt_pk_bf16(y[0], y[1]); q0.y = pg8::cvt_pk_bf16(y[2], y[3]); q0.z = pg8::cvt_pk_bf16(y[4], y[5]); q0.w = pg8::cvt_pk_bf16(y[6], y[7]);
                q1.x = pg8::cvt_pk_bf16(y[8], y[9]); q1.y = pg8::cvt_pk_bf16(y[10], y[11]); q1.z = pg8::cvt_pk_bf16(y[12], y[13]); q1.w = pg8::cvt_pk_bf16(y[14], y[15]);
                p0.x = pg8::cvt_pk_bf16(uu[0], uu[1]); p0.y = pg8::cvt_pk_bf16(uu[2], uu[3]); p0.z = pg8::cvt_pk_bf16(uu[4], uu[5]); p0.w = pg8::cvt_pk_bf16(uu[6], uu[7]);
                p1.x = pg8::cvt_pk_bf16(uu[8], uu[9]); p1.y = pg8::cvt_pk_bf16(uu[10], uu[11]); p1.z = pg8::cvt_pk_bf16(uu[12], uu[13]); p1.w = pg8::cvt_pk_bf16(uu[14], uu[15]);
                bf16_t* xo = hx + (size_t)tok * 1024 + d0; *(u32x4*)xo = q0; *(u32x4*)(xo + 8) = q1; bf16_t* up = UY + (size_t)tok * UYW_ + d0; *(u32x4*)up = p0; *(u32x4*)(up + 8) = p1; } }
    }
}
}

struct Params {
    const float *x, *c, *w_ada, *b_ada, *w_in, *conv_w, *conv_b, *hy_w1, *hy_b1, *hy_w2, *hy_b2, *hy_w3, *hy_freq, *hy_ld, *hy_bias, *attn_sink, *wba, *wbb, *wbc, *w_out, *ln_g, *ln_b,
        *peer_wq, *peer_keys, *peer_u, *peer_v;
    float* out; char* ws;
};
constexpr int LDS_PHASE = 148480;
constexpr int LDS_BYTES = LDS_PHASE + 16;
constexpr size_t OFF_BAR = OFF_LSE + 1792 * 1024;

#define RUN(nvb, call) do { const int wv = wave_s; int wv_ = wv, ln_; asm volatile("v_mbcnt_lo_u32_b32 %1, -1, 0\n\tv_mbcnt_hi_u32_b32 %1, -1, %1" : "+s"(wv_), "=v"(ln_)); int tid_ = (wv_ << 6) | ln_; const int t = tid_ & 255, sub = tid_ >> 8; unsigned char* sm = lds + sub * 16384; \
        for (int vb = (int)blockIdx.x * 2 + sub; vb < (nvb); vb += (int)gridDim.x * 2) { call; __syncthreads(); } } while (0)
#define GSYNC_CG() do { __builtin_amdgcn_sched_barrier(0); grid.sync(); __builtin_amdgcn_sched_barrier(0); } while (0)
#define GSYNC() do { __builtin_amdgcn_sched_barrier(0); xb::xcd_barrier(xbar, wave_s); __builtin_amdgcn_sched_barrier(0); } while (0)

__global__ void __launch_bounds__(512, 2) mega(Params p) {
    extern __shared__ __attribute__((aligned(16))) unsigned char lds[];
    cg::grid_group grid = cg::this_grid();
    LAS unsigned char* ldsl = (LAS unsigned char*)lds;
    const int G = gridDim.x, cblk = blockIdx.x;
    const int wave_s = __builtin_amdgcn_readfirstlane((int)threadIdx.x >> 6);
    float* out = p.out; (void)out;
    if (threadIdx.x < 4) ((LAS unsigned*)(ldsl + LDS_PHASE))[threadIdx.x] = 0u;
    __syncthreads();
    const xb::XcdBarrier xbar = xb::xcd_barrier_post((unsigned*)(p.ws + OFF_BAR), (volatile LAS unsigned*)(ldsl + LDS_PHASE));
    {
    char* ws = p.ws;
    float* ada = (float*)(ws + OFF_ADA); float2* rope = (float2*)(ws + OFF_ROPE); bf16_t* Gr = (bf16_t*)(ws + OFF_GR); float* lse2 = (float*)(ws + OFF_LSE);
    unsigned char* WinT8 = (unsigned char*)(ws + OFF_WINT); unsigned char* WmT8 = (unsigned char*)(ws + OFF_WMT); float* su = (float*)(ws + OFF_LSE + 1536 * 1024); bf16_t* WoutT = (bf16_t*)(ws + OFF_WOUTT); bf16_t* WqT = (bf16_t*)(ws + OFF_WQT);
    bf16_t* UY = (bf16_t*)(ws + OFF_UY); bf16_t* Y = UY + 1024; bf16_t* P = (bf16_t*)(ws + OFF_P); bf16_t* hyT = (bf16_t*)(ws + OFF_HYT);
    bf16_t* merged = (bf16_t*)(ws + OFF_P); bf16_t* gtmp = (bf16_t*)(ws + OFF_P + 64 * MB_); bf16_t* Q2 = (bf16_t*)(ws + OFF_P); bf16_t* x1b = (bf16_t*)(ws + OFF_P + 128 * MB_);
    int* eidx = (int*)(ws + OFF_HYT); float* egate = (float*)(ws + OFF_HYT + 16 * MB_); unsigned char* U8 = (unsigned char*)(ws + OFF_HYT + 32 * MB_); unsigned char* V4 = (unsigned char*)(ws + OFF_HYT + 48 * MB_); float* sinv = (float*)(ws + OFF_HYT + 64 * MB_);
    float* h2 = (float*)(ws + OFF_P);
    (void)lse2; (void)P; (void)hyT; (void)merged; (void)gtmp; (void)Q2; (void)x1b; (void)eidx; (void)egate; (void)U8; (void)V4; (void)sinv; (void)Y;

    misc::ada_phase(ldsl, p.c, p.w_ada, p.b_ada, ada, G, cblk, wave_s);
    RUN(256, nb_rope(vb, t, sm, rope));
    RUN(1024, nb_filt_h2(vb, t, sm, p.hy_w1, p.hy_b1, p.hy_w2, p.hy_b2, p.hy_freq, h2));
    { const WPrep wq{p.w_in, p.wba, p.wbb, p.wbc, p.w_out, p.peer_wq, WinT8, WmT8, WoutT, WqT}; RUN(6016, nb_wprep(vb, t, sm, wq)); }
    GSYNC();
    misc::filt_phase(ldsl, h2, p.hy_w3, p.hy_ld, Gr, G, cblk, wave_s);
    misc::modulate_phase(p.x, ada, UY, su, G, cblk, wave_s);
    GSYNC();
    }
#pragma unroll 1
    for (int l = 0; l < 2; ++l) {
        size_t zoff = 0; asm volatile("" : "+s"(zoff));
        char* ws = p.ws + zoff; float* out = p.out + zoff;
        int Gl = gridDim.x, cl = blockIdx.x; asm volatile("" : "+s"(Gl), "+s"(cl));
        float* ada = (float*)(ws + OFF_ADA); float2* rope = (float2*)(ws + OFF_ROPE); bf16_t* Gr = (bf16_t*)(ws + OFF_GR); float* lse2 = (float*)(ws + OFF_LSE);
        unsigned char* WinT8 = (unsigned char*)(ws + OFF_WINT); unsigned char* WmT8 = (unsigned char*)(ws + OFF_WMT); float* su = (float*)(ws + OFF_LSE + 1536 * 1024); bf16_t* WoutT = (bf16_t*)(ws + OFF_WOUTT); bf16_t* WqT = (bf16_t*)(ws + OFF_WQT);
        bf16_t* UY = (bf16_t*)(ws + OFF_UY); bf16_t* Y = UY + 1024; bf16_t* P = (bf16_t*)(ws + OFF_P); bf16_t* hyT = (bf16_t*)(ws + OFF_HYT);
        bf16_t* merged = (bf16_t*)(ws + OFF_P); bf16_t* gtmp = (bf16_t*)(ws + OFF_P + 64 * MB_); bf16_t* Q2 = (bf16_t*)(ws + OFF_P); bf16_t* x1b = (bf16_t*)(ws + OFF_P + 128 * MB_);
        int* eidx = (int*)(ws + OFF_HYT); float* egate = (float*)(ws + OFF_HYT + 16 * MB_); unsigned char* U8 = (unsigned char*)(ws + OFF_HYT + 32 * MB_); unsigned char* V4 = (unsigned char*)(ws + OFF_HYT + 48 * MB_); float* sinv = (float*)(ws + OFF_HYT + 64 * MB_);
        const float* ada_l = ada + (size_t)l * 16 * 6144;
        const unsigned char* WinT8_l = WinT8 + (size_t)l * 4608 * 1024;
        {
            const pg8::PlainSched S1{UY, (const bf16_t*)WinT8_l, UYW_, 512, 128, 12, 8, Gl, cl, 0, 1 << 30}; const pg8::EpiP E1{P, rope, su};
            pg8::gemm_phase<pg8::EpiP, pg8::PlainSched, true, true, 1>(ldsl, UYW_, 512, S1, E1, wave_s);
            const pg8::PlainSched S2{(const bf16_t*)(WinT8_l + (size_t)3072 * 1024), UY, 512, UYW_, 6, 128, 8, Gl, cl, 0, 1 << 30}; const pg8::EpiHyT8 E2{hyT, su};
            pg8::gemm_phase<pg8::EpiHyT8, pg8::PlainSched, true, true, 1>(ldsl, 512, UYW_, S2, E2, wave_s);
        }
        GSYNC();
        at::attn_phase(ldsl, P, lse2, Y, p.attn_sink + l * 8, Gl, cl, wave_s);
        hy::hyena_phase(ldsl, hyT, Gr + (size_t)l * 2 * 512 * 4096, p.conv_w + (size_t)l * 3 * 1536, p.conv_b + (size_t)l * 1536, p.hy_bias + (size_t)l * 1024, Gl, cl, wave_s);
        GSYNC();
        misc::yprep_phase(ldsl, hyT, P, lse2, Y, Gl, cl, wave_s);
        GSYNC();
        {
            const unsigned char* WmT8_l = WmT8 + (size_t)l * 1024 * (WMW_ * 2);
            static_assert(OFF_P + 192 * MB_ == OFF_HYT, "gate buffers");
            const pg8::GateSched Sg{UY, WmT8_l, Gl, cl}; const pg8::EpiGate Eg{gtmp, su};
            pg8::gemm_phase<pg8::EpiGate, pg8::GateSched, true, true, 1>(ldsl, UYW_, WMW_, Sg, Eg, wave_s);
            const pg8::Branch3Sched Sb{UY, WmT8_l, Gl, cl}; const pg8::EpiBranch3 Eb{gtmp, merged};
            pg8::gemm_phase<pg8::EpiBranch3, pg8::Branch3Sched, true, true, 0>(ldsl, UYW_, WMW_, Sb, Eb, wave_s);
        }
        GSYNC();
        {
            const pg8::PlainSched S{merged, WoutT + (size_t)l * 1024 * 1024, 1024, 1024, 128, 4, 16, Gl, cl, 0, 1 << 30}; const pg8::EpiH E{(l == 0) ? p.x : (const float*)nullptr, (const bf16_t*)out, x1b, ada_l};
            pg8::gemm_phase(ldsl, 1024, 1024, S, E, wave_s);
        }
        RUN(8192, peer::nb_quant_tables(vb, t, p.peer_u + (size_t)l * 16384 * 1024, p.peer_v + (size_t)l * 16384 * 1024, U8, V4, sinv));
        GSYNC();
        misc::lnmod_phase(x1b, ada_l, p.ln_g + (size_t)(l * 2 + 0) * 1024, p.ln_b + (size_t)(l * 2 + 0) * 1024, UY, Gl, cl, wave_s);
        GSYNC();
        {
            const pg8::PlainSched S{UY, WqT + (size_t)l * 2048 * 1024, UYW_, 1024, 128, 8, 16, Gl, cl, 0, 1 << 30}; const pg8::EpiBf E{Q2, 2048, 0};
            pg8::gemm_phase(ldsl, UYW_, 1024, S, E, wave_s);
        }
        GSYNC();
        tk::topk_phase(ldsl, Q2, p.peer_keys + (size_t)l * 8 * 2 * 128 * 128, eidx, egate, Gl, cl, wave_s);
        GSYNC();
        peer::peer_phase(ldsl, x1b, out, (l == 0) ? (bf16_t*)out : (bf16_t*)nullptr, ada_l, eidx, egate, U8, V4, sinv, p.ln_g + (size_t)(l * 2 + 1) * 1024, p.ln_b + (size_t)(l * 2 + 1) * 1024,
                         (l == 0) ? ada + (size_t)16 * 6144 : (const float*)nullptr, UY, su, Gl, cl, wave_s);
        if (l == 0) GSYNC();
    }
}

extern "C" void kernel_launch(void* const* d_in, const int* in_sizes, int n_in, void* d_out, int out_size, void* d_ws, size_t ws_size, hipStream_t stream) {
    static int grid = 0;
    if (grid == 0) {
        if (ws_size < WS_NEED || n_in != 26) { fprintf(stderr, "kernel_launch: workspace %zu < %zu or n_in %d != 26\n", ws_size, (size_t)WS_NEED, n_in); grid = -1; return; }
        int dev = 0, cus = 0, per_cu = 0;
        (void)hipGetDevice(&dev); (void)hipDeviceGetAttribute(&cus, hipDeviceAttributeMultiprocessorCount, dev);
        (void)hipFuncSetAttribute((const void*)mega, hipFuncAttributeMaxDynamicSharedMemorySize, LDS_BYTES);
        (void)hipOccupancyMaxActiveBlocksPerMultiprocessor(&per_cu, (const void*)mega, 512, LDS_BYTES);
        if (per_cu < 1) { fprintf(stderr, "kernel_launch: occupancy query says %d blocks per CU\n", per_cu); grid = -1; return; }
        if (cus != 256) { fprintf(stderr, "kernel_launch: built for a 256-CU device (the fused LayerNorm epilogue pairs the four column-tile owners of a row panel by grid position), found %d CUs\n", cus); grid = -1; return; }
        grid = cus;
    }
    if (grid < 0) return;
    Params p{};
    const float** pp = (const float**)&p;
    for (int i = 0; i < 26; ++i) pp[i] = (const float*)d_in[i];
    p.out = (float*)d_out; p.ws = (char*)d_ws;
    (void)hipMemsetAsync((char*)d_ws + OFF_BAR, 0, 16384 + 2 * 32768, stream);
    void* args[] = {&p};
    hipError_t e = hipLaunchCooperativeKernel((const void*)mega, dim3(grid), dim3(512), args, LDS_BYTES, stream);
    if (e != hipSuccess) fprintf(stderr, "cooperative launch failed: %s (grid %d)\n", hipGetErrorString(e), grid);
}
```

```cpp
#include <hip/hip_runtime.h>
#include <hip/hip_cooperative_groups.h>
namespace cg = cooperative_groups;
#include <stdint.h>
#include <stdio.h>

#define DEV __device__ __forceinline__
typedef unsigned short bf16_t;

constexpr int D_ = 1024, B_ = 16, S_ = 2048, T_ = B_ * S_;
constexpr float ALPHA_ = 1.41421356237309515f;
constexpr float LOG2E_ = 1.4426950408889634f;
constexpr float QSCALE_ = 0.125f * 1.4426950408889634f;
constexpr float LN_EPS_ = 1e-5f;
constexpr int PW_ = 3072;
constexpr int UYW_ = 2304;
constexpr int WMW_ = 2816;
constexpr size_t GSTRIDE_ = (size_t)32 * 1024 * 1024;

constexpr size_t MB_ = 1024 * 1024;
constexpr size_t OFF_ADA = 0, OFF_ROPE = 1 * MB_, OFF_GR = 2 * MB_, OFF_LSE = 18 * MB_, OFF_WINT = 20 * MB_, OFF_WMT = 50 * MB_,
                 OFF_WOUTT = 68 * MB_, OFF_WQT = 72 * MB_, OFF_KEYS = 80 * MB_, OFF_UY = 82 * MB_, OFF_P = 226 * MB_, OFF_HYT = 418 * MB_,
                 WS_NEED = 514 * MB_;

DEV int xor_i(int v, int off, int lane) { return __builtin_amdgcn_ds_bpermute((lane ^ off) << 2, v); }
DEV float xor_f(float v, int off, int lane) { return __int_as_float(__builtin_amdgcn_ds_bpermute((lane ^ off) << 2, __float_as_int(v))); }
DEV float bf2f(bf16_t v) { return __uint_as_float(((unsigned)v) << 16); }
DEV bf16_t f2bf(float f) { unsigned u = __float_as_uint(f); u += 0x7FFFu + ((u >> 16) & 1u); return (bf16_t)(u >> 16); }

DEV void nb_rope(int vb, int t, unsigned char* sm, float2* __restrict__ rope) {
    const int idx = vb * 256 + t; const int s = idx >> 5, i = idx & 31;
    const float inv = powf(10000.f, -(float)i / 32.f); const float ang = (float)s * inv;
    rope[idx] = make_float2(cosf(ang), sinf(ang));
}

DEV void nb_filt_h2(int vb, int t, unsigned char* sm, const float* __restrict__ w1, const float* __restrict__ b1, const float* __restrict__ w2, const float* __restrict__ b2,
                                                const float* __restrict__ freq, float* __restrict__ h2) {
    const int grp = t >> 6, j = t & 63; const int lt = vb * 4 + grp; const int l = lt / 2048, tt = lt % 2048;
    float* z = (float*)sm + grp * 128; float* h1 = z + 64;
    if (j < 33) {
        const float idx = (float)tt, tn = idx / 2047.f, w = 6.283185307179586f * idx / 2048.f;
        if (j == 0) z[0] = tn;
        else { const int k = (j <= 16) ? (j - 1) : (j - 17); const float band = 1e-4f + (float)k * ((15.f - 1e-4f) / 15.f); const float ang = w * band;
            z[j] = (j <= 16) ? cosf(ang) : -sinf(ang); }
    }
    __syncthreads();
    float a = b1[l * 64 + j];
    for (int e = 0; e < 33; ++e) a += z[e] * w1[(l * 33 + e) * 64 + j];
    h1[j] = sinf(freq[(l * 2 + 0) * 64 + j] * a);
    __syncthreads();
    float a2 = b2[l * 64 + j];
    for (int i = 0; i < 64; ++i) a2 += h1[i] * w2[(l * 64 + i) * 64 + j];
    h2[((size_t)l * 2048 + tt) * 64 + j] = sinf(freq[(l * 2 + 1) * 64 + j] * a2);
}

#define LAS __attribute__((address_space(3)))
typedef short bf16x8 __attribute__((ext_vector_type(8)));
typedef float f32x4 __attribute__((ext_vector_type(4)));
typedef float f32x2 __attribute__((ext_vector_type(2)));
typedef unsigned u32x4 __attribute__((ext_vector_type(4)));
typedef unsigned u32x2 __attribute__((ext_vector_type(2)));
typedef int i32x8 __attribute__((ext_vector_type(8)));
typedef _Float16 h2 __attribute__((ext_vector_type(2)));
typedef int i32x4 __attribute__((ext_vector_type(4)));
namespace pg8 {
constexpr int BM = 256, BK = 64, HALF = 128, HTB = HALF * BK * 2, STAGE_BYTES = 8 * HTB, NXCD = 8, WGM = 8;
DEV int lds_byte(int r, int c) { const int st = (r >> 4) * 2 + (c >> 5), rr = r & 15, cc = c & 31, ob = rr * 64 + cc * 2; return st * 1024 + (ob ^ (((ob >> 9) & 1) << 5)); }
DEV void stage_rc(int b, int& R, int& C) { const int st = b / 1024, sb = b % 1024, swz = sb ^ (((sb >> 9) & 1) << 5); R = (st >> 1) * 16 + swz / 64; C = (st & 1) * 32 + (swz % 64) / 2; }
DEV int perm32(int rho) { const int n = rho >> 4, i = rho & 15; return 8 * (i >> 2) + 4 * n + (i & 3); }
typedef __bf16 bf16x2_t __attribute__((ext_vector_type(2)));
DEV unsigned cvt_pk_bf16(float lo, float hi) { return __builtin_bit_cast(unsigned, __builtin_convertvector((f32x2){lo, hi}, bf16x2_t)); }

struct Unit { int pm, pn, tag, nt; const char* a; const char* b; };
DEV void tile_of(int L, int nM, int nN, int& pm, int& pn) {
    const int nwg = nM * nN; int wgid = L; { const int q = nwg / NXCD, r = nwg % NXCD, xcd = wgid % NXCD, off = wgid / NXCD; wgid = (xcd < r ? xcd * (q + 1) : r * (q + 1) + (xcd - r) * q) + off; }
    const int nig = WGM * nN, gid = wgid / nig, fm = gid * WGM, gsz = (nM - fm) < WGM ? (nM - fm) : WGM;
    pm = fm + ((wgid % nig) % gsz); pn = (wgid % nig) / gsz;
}
struct PlainSched { const bf16_t* A; const bf16_t* Bt; int lda, ldb, nM, nN, nt, G, c, first, count;
    DEV bool next(int i, Unit& u) const { if (i >= count) return false; const long L = (long)(first + i) * G + c; if (L >= (long)nM * nN) return false; tile_of((int)L, nM, nN, u.pm, u.pn); u.tag = 0; u.nt = nt;
        u.a = (const char*)(A + (size_t)u.pm * BM * lda); u.b = (const char*)(Bt + (size_t)u.pn * BM * ldb); return true; } };

template <class Epi, class Sched, bool SP2 = true, bool ALIGN_EPI = true, int I8 = 0>
DEV void gemm_phase(LAS unsigned char* lds, const int lda, const int ldb, const Sched& S, const Epi& E, const int wv) {
    int wv_ = wv, ln_; asm volatile("v_mbcnt_lo_u32_b32 %1, -1, 0\n\tv_mbcnt_hi_u32_b32 %1, -1, %1" : "+s"(wv_), "=v"(ln_)); int tid_ = (wv_ << 6) | ln_;
    const int tid = tid_, wid = __builtin_amdgcn_readfirstlane(tid >> 6), lane = tid & 63, wr = wid >> 2, wc = wid & 3, fr = lane & 15, fq = lane >> 4;
    unsigned voffA[2], voffB[2];
#pragma unroll
    for (int i = 0; i < 2; ++i) { int R, C; stage_rc(tid * 16 + i * 8192, R, C); const int Rb = Epi::PERM ? ((R & ~31) + perm32(R & 31)) : R;
        voffA[i] = (unsigned)(R * lda + C) * 2u; voffB[i] = (unsigned)(Rb * ldb + C) * 2u; }
    const size_t kstep = (size_t)(BK * 2);
    const size_t hstepA = (size_t)HALF * lda * 2, hstepB = (size_t)HALF * ldb * 2;
    const unsigned ldsw = (unsigned)wid * 1024u;
    const int aoff = lds_byte(wr * 64 + fr, fq * 8), boff = lds_byte(wc * 32 + fr, fq * 8);
#define PG8_SA(b, h) (((b) * 2 + (h)) * HTB)
#define PG8_SB(b, h) ((4 + (b) * 2 + (h)) * HTB)
#define PG8_STAGE(bufoff, gbase, voff) do { _Pragma("unroll") for (int _i = 0; _i < 2; ++_i) \
        __builtin_amdgcn_global_load_lds((const unsigned*)((const char*)(gbase) + (voff)[_i]), (LAS unsigned*)(lds + (bufoff) + ldsw + _i * 8192), 16, 0, 0); } while (0)
#define PG8_LDA(dst, b, h) do { _Pragma("unroll") for (int m = 0; m < 4; ++m) _Pragma("unroll") for (int k = 0; k < 2; ++k) dst[m][k] = *(const LAS bf16x8*)(lds + PG8_SA(b, h) + aoff + m * 2048 + k * 1024); } while (0)
#define PG8_LDB(dst, b, h) do { _Pragma("unroll") for (int n = 0; n < 2; ++n) _Pragma("unroll") for (int k = 0; k < 2; ++k) dst[n][k] = *(const LAS bf16x8*)(lds + PG8_SB(b, h) + boff + n * 2048 + k * 1024); } while (0)
#define PG8_MMA(ai, bj, At, Bt) do { __builtin_amdgcn_s_setprio(1); \
        if (I8 == 1) { _Pragma("unroll") for (int m = 0; m < 4; ++m) _Pragma("unroll") for (int n = 0; n < 2; ++n) _Pragma("unroll") for (int k = 0; k < 2; ++k) \
            acc[ai][bj][m][n] = __builtin_bit_cast(f32x4, __builtin_amdgcn_mfma_i32_16x16x64_i8(__builtin_bit_cast(i32x4, Bt[n][k]), __builtin_bit_cast(i32x4, At[m][k]), __builtin_bit_cast(i32x4, acc[ai][bj][m][n]), 0, 0, 0)); } \
        else { _Pragma("unroll") for (int m = 0; m < 4; ++m) _Pragma("unroll") for (int n = 0; n < 2; ++n) _Pragma("unroll") for (int k = 0; k < 2; ++k) \
            acc[ai][bj][m][n] = __builtin_amdgcn_mfma_f32_16x16x32_bf16(Bt[n][k], At[m][k], acc[ai][bj][m][n], 0, 0, 0); } __builtin_amdgcn_s_setprio(0); } while (0)
#define PG8_WAIT_V(n) asm volatile("s_waitcnt vmcnt(" #n ")" ::: "memory")
#define PG8_WAIT_L(n) asm volatile("s_waitcnt lgkmcnt(" #n ")" ::: "memory")
#define PG8_BAR __builtin_amdgcn_s_barrier()
#define PG8_SCHED __builtin_amdgcn_sched_barrier(0)
    Unit cur, nxt; int ui = 0;
    if (!S.next(0, cur)) return;
    f32x4 acc[2][2][4][2];
#pragma unroll
    for (int a = 0; a < 2; ++a)
#pragma unroll
        for (int b = 0; b < 2; ++b)
#pragma unroll
            for (int m = 0; m < 4; ++m)
#pragma unroll
                for (int n = 0; n < 2; ++n) acc[a][b][m][n] = (f32x4){0.f, 0.f, 0.f, 0.f};
    bf16x8 At[4][2], B0[2][2], B1[2][2];
    const char* cA = cur.a; const char* cB = cur.b;
    if constexpr (SP2) {
        PG8_STAGE(PG8_SB(0, 0), cB, voffB); PG8_STAGE(PG8_SB(0, 1), cB + hstepB, voffB); PG8_STAGE(PG8_SA(0, 0), cA, voffA); PG8_STAGE(PG8_SA(0, 1), cA + hstepA, voffA);
        if (wr == 1) PG8_BAR;
        PG8_WAIT_V(2); PG8_BAR;
        PG8_STAGE(PG8_SB(1, 0), cB + kstep, voffB); PG8_STAGE(PG8_SA(1, 0), cA + kstep, voffA); PG8_STAGE(PG8_SB(1, 1), cB + hstepB + kstep, voffB);
        PG8_WAIT_V(6); PG8_BAR;
    } else {
    PG8_STAGE(PG8_SB(0, 0), cB, voffB); PG8_STAGE(PG8_SA(0, 0), cA, voffA); PG8_STAGE(PG8_SB(0, 1), cB + hstepB, voffB); PG8_STAGE(PG8_SA(0, 1), cA + hstepA, voffA);
    if (wr == 1) PG8_BAR;
    PG8_WAIT_V(4); PG8_BAR;
    PG8_STAGE(PG8_SB(1, 0), cB + kstep, voffB); PG8_STAGE(PG8_SA(1, 0), cA + kstep, voffA); PG8_STAGE(PG8_SB(1, 1), cB + hstepB + kstep, voffB);
    PG8_WAIT_V(6); PG8_BAR;
    }
    for (;;) {
        const bool has_next = S.next(ui + 1, nxt);
        const char* nA = has_next ? nxt.a : cA; const char* nB = has_next ? nxt.b : cB;
        const int nt = cur.nt;
        for (int t = 0; t < nt; t += 2) {
            const bool last = (t == nt - 2);
            const char* a1 = cA + (size_t)(t + 1) * kstep;
            const char* a2 = last ? nA : cA + (size_t)(t + 2) * kstep; const char* b2 = last ? nB : cB + (size_t)(t + 2) * kstep;
            const char* a3 = a2 + kstep; const char* b3 = b2 + kstep;
            if constexpr (SP2) {
            PG8_LDB(B0, 0, 0); PG8_LDB(B1, 0, 1); PG8_SCHED; PG8_LDA(At, 0, 0); PG8_STAGE(PG8_SA(1, 1), a1 + hstepA, voffA);
            PG8_WAIT_V(8); PG8_WAIT_L(0); PG8_BAR; PG8_MMA(0, 0, At, B0); PG8_MMA(0, 1, At, B1); PG8_BAR; PG8_SCHED;
            PG8_LDA(At, 0, 1); PG8_STAGE(PG8_SB(0, 0), b2, voffB); PG8_STAGE(PG8_SB(0, 1), b2 + hstepB, voffB); PG8_STAGE(PG8_SA(0, 0), a2, voffA);
            PG8_WAIT_V(8); PG8_WAIT_L(0); PG8_BAR; PG8_MMA(1, 0, At, B0); PG8_MMA(1, 1, At, B1); PG8_BAR; PG8_SCHED;
            PG8_LDB(B0, 1, 0); PG8_LDB(B1, 1, 1); PG8_SCHED; PG8_LDA(At, 1, 0); PG8_STAGE(PG8_SA(0, 1), a2 + hstepA, voffA);
            PG8_WAIT_V(8); PG8_WAIT_L(0); PG8_BAR; PG8_MMA(0, 0, At, B0); PG8_MMA(0, 1, At, B1); PG8_BAR; PG8_SCHED;
            PG8_LDA(At, 1, 1); PG8_STAGE(PG8_SB(1, 0), b3, voffB); PG8_STAGE(PG8_SB(1, 1), b3 + hstepB, voffB); PG8_STAGE(PG8_SA(1, 0), a3, voffA);
            PG8_WAIT_V(8); PG8_WAIT_L(0); PG8_BAR; PG8_MMA(1, 0, At, B0); PG8_MMA(1, 1, At, B1); PG8_BAR; PG8_SCHED;
            } else {
            PG8_LDB(B0, 0, 0); PG8_SCHED; PG8_LDA(At, 0, 0); PG8_STAGE(PG8_SA(1, 1), a1 + hstepA, voffA);
            PG8_WAIT_L(8); PG8_BAR; PG8_WAIT_L(0); PG8_MMA(0, 0, At, B0); PG8_BAR; PG8_SCHED;
            PG8_LDB(B1, 0, 1); PG8_STAGE(PG8_SB(0, 0), b2, voffB);
            PG8_BAR; PG8_WAIT_L(0); PG8_MMA(0, 1, At, B1); PG8_BAR;
            PG8_LDA(At, 0, 1); PG8_STAGE(PG8_SA(0, 0), a2, voffA);
            PG8_BAR; PG8_WAIT_L(0); PG8_MMA(1, 0, At, B0); PG8_BAR; PG8_SCHED;
            PG8_STAGE(PG8_SB(0, 1), b2 + hstepB, voffB);
            PG8_WAIT_V(6); PG8_BAR; PG8_MMA(1, 1, At, B1); PG8_BAR;
            PG8_LDB(B0, 1, 0); PG8_SCHED; PG8_LDA(At, 1, 0); PG8_STAGE(PG8_SA(0, 1), a2 + hstepA, voffA);
            PG8_WAIT_L(8); PG8_BAR; PG8_WAIT_L(0); PG8_MMA(0, 0, At, B0); PG8_BAR; PG8_SCHED;
            PG8_LDB(B1, 1, 1); PG8_STAGE(PG8_SB(1, 0), b3, voffB);
            PG8_BAR; PG8_WAIT_L(0); PG8_MMA(0, 1, At, B1); PG8_BAR;
            PG8_LDA(At, 1, 1); PG8_STAGE(PG8_SA(1, 0), a3, voffA);
            PG8_BAR; PG8_WAIT_L(0); PG8_MMA(1, 0, At, B0); PG8_BAR; PG8_SCHED;
            PG8_STAGE(PG8_SB(1, 1), b3 + hstepB, voffB);
            PG8_WAIT_V(6); PG8_BAR; PG8_MMA(1, 1, At, B1); PG8_BAR;
            }
        }
        if constexpr (ALIGN_EPI) { if (wr == 0) PG8_BAR; }
        if constexpr (!Epi::AFTER_DRAIN) E(acc, cur, wr, wc, fr, fq);
        if (!has_next) break;
        if constexpr (!Epi::INPLACE)
#pragma unroll
        for (int a = 0; a < 2; ++a)
#pragma unroll
            for (int b = 0; b < 2; ++b)
#pragma unroll
                for (int m = 0; m < 4; ++m)
#pragma unroll
                    for (int n = 0; n < 2; ++n) acc[a][b][m][n] = (f32x4){0.f, 0.f, 0.f, 0.f};
        cur = nxt; cA = nA; cB = nB; ++ui;
        if constexpr (ALIGN_EPI) { if (wr == 1) PG8_BAR; }
    }
    PG8_WAIT_V(0);
    if constexpr (!ALIGN_EPI) { if (wr == 0) PG8_BAR; }
    PG8_BAR;
#undef PG8_SA
#undef PG8_SB
#undef PG8_STAGE
#undef PG8_LDA
#undef PG8_LDB
#undef PG8_MMA
#undef PG8_WAIT_V
#undef PG8_WAIT_L
#undef PG8_BAR
#undef PG8_SCHED
}
struct EpiBf { static constexpr bool PERM = true, AFTER_DRAIN = false, INPLACE = false; bf16_t* O; int ldc; int pad;
    DEV void operator()(const f32x4 (&acc)[2][2][4][2], const Unit& u, int wr, int wc, int fr, int fq) const {
        const int row0 = u.pm * BM + wr * 64 + fr, col0 = u.pn * BM + wc * 32 + 8 * fq;
#pragma unroll
        for (int ai = 0; ai < 2; ++ai)
#pragma unroll
            for (int m = 0; m < 4; ++m) { bf16_t* rowp = O + (size_t)(row0 + ai * HALF + m * 16) * ldc + col0;
#pragma unroll
                for (int bj = 0; bj < 2; ++bj) { const f32x4 v0 = acc[ai][bj][m][0], v1 = acc[ai][bj][m][1];
                    u32x4 w; w.x = cvt_pk_bf16(v0[0], v0[1]); w.y = cvt_pk_bf16(v0[2], v0[3]); w.z = cvt_pk_bf16(v1[0], v1[1]); w.w = cvt_pk_bf16(v1[2], v1[3]);
                    *(u32x4*)(rowp + bj * HALF) = w; } }
    } };
struct EpiHyT8 { static constexpr bool PERM = true, AFTER_DRAIN = false, INPLACE = false; bf16_t* O; const float* su; const float* wi;
    DEV void operator()(const f32x4 (&acc)[2][2][4][2], const Unit& u, int wr, int wc, int fr, int fq) const {
        const int row0 = u.pm * BM + wr * 64 + fr, col0 = u.pn * BM + wc * 32 + 8 * fq;
        f32x4 cs[2][2];
#pragma unroll
        for (int bj = 0; bj < 2; ++bj)
#pragma unroll
            for (int h = 0; h < 2; ++h) cs[bj][h] = *(const f32x4*)(su + col0 + bj * HALF + 4 * h);
#pragma unroll
        for (int ai = 0; ai < 2; ++ai)
#pragma unroll
            for (int m = 0; m < 4; ++m) { bf16_t* rowp = O + (size_t)(row0 + ai * HALF + m * 16) * T_ + col0; const float wr_ = wi[row0 + ai * HALF + m * 16];
#pragma unroll
                for (int bj = 0; bj < 2; ++bj) { const i32x4 i0 = __builtin_bit_cast(i32x4, acc[ai][bj][m][0]), i1 = __builtin_bit_cast(i32x4, acc[ai][bj][m][1]);
                    const f32x4 v0 = (f32x4){(float)i0[0], (float)i0[1], (float)i0[2], (float)i0[3]} * (cs[bj][0] * wr_), v1 = (f32x4){(float)i1[0], (float)i1[1], (float)i1[2], (float)i1[3]} * (cs[bj][1] * wr_);
                    u32x4 w; w.x = cvt_pk_bf16(v0[0], v0[1]); w.y = cvt_pk_bf16(v0[2], v0[3]); w.z = cvt_pk_bf16(v1[0], v1[1]); w.w = cvt_pk_bf16(v1[2], v1[3]);
                    *(u32x4*)(rowp + bj * HALF) = w; } }
    } };
struct EpiP { static constexpr bool PERM = true, AFTER_DRAIN = false, INPLACE = false; bf16_t* P; const float2* rope; const float* su; const float* wi;
    DEV void operator()(const f32x4 (&acc)[2][2][4][2], const Unit& u, int wr, int wc, int fr, int fq) const {
        const int row0 = u.pm * BM + wr * 64 + fr, col0 = u.pn * BM + wc * 32 + 8 * fq; const int g = (wc & 1) * 4 + fq; const int pn = u.pn;
        const bool qs = (pn < 3) || (pn == 9) || (pn == 10);
        const f32x4 w00 = *(const f32x4*)(wi + col0), w01 = *(const f32x4*)(wi + col0 + 4), w10 = *(const f32x4*)(wi + col0 + HALF), w11 = *(const f32x4*)(wi + col0 + HALF + 4);
#pragma unroll
        for (int ai = 0; ai < 2; ++ai)
#pragma unroll
            for (int m = 0; m < 4; ++m) { const int row = row0 + ai * HALF + m * 16; bf16_t* rowp = P + (size_t)row * PW_ + col0; const float rsc = su[row];
                const float4* rp = (const float4*)(rope + (size_t)(row & 2047) * 32 + 4 * g); const float4 cs0 = rp[0], cs1 = rp[1];
                const float cc[4] = {cs0.x, cs0.z, cs1.x, cs1.z}, ss[4] = {cs0.y, cs0.w, cs1.y, cs1.w};
#pragma unroll
                for (int bj = 0; bj < 2; ++bj) { f32x4 v0, v1; { const i32x4 i0 = __builtin_bit_cast(i32x4, acc[ai][bj][m][0]), i1 = __builtin_bit_cast(i32x4, acc[ai][bj][m][1]);
                        v0 = (f32x4){(float)i0[0], (float)i0[1], (float)i0[2], (float)i0[3]} * ((bj ? w10 : w00) * rsc); v1 = (f32x4){(float)i1[0], (float)i1[1], (float)i1[2], (float)i1[3]} * ((bj ? w11 : w01) * rsc); }
                    const bool rp_ = (pn < 6) || (pn == 9) || (pn == 10) || (pn == 11 && bj == 0);
                    if (rp_) {
#pragma unroll
                        for (int j = 0; j < 4; ++j) { const float x1 = v0[j], x2 = v1[j]; float o1 = x1 * cc[j] - x2 * ss[j], o2 = x2 * cc[j] + x1 * ss[j];
                            if (qs) { o1 *= QSCALE_; o2 *= QSCALE_; } v0[j] = o1; v1[j] = o2; } }
                    u32x4 w; w.x = cvt_pk_bf16(v0[0], v0[1]); w.y = cvt_pk_bf16(v0[2], v0[3]); w.z = cvt_pk_bf16(v1[0], v1[1]); w.w = cvt_pk_bf16(v1[2], v1[3]);
                    *(u32x4*)(rowp + bj * HALF) = w; } }
    } };
struct EpiGate { static constexpr bool PERM = true, AFTER_DRAIN = false, INPLACE = false; bf16_t* g; const float* su; const float* wi;
    DEV void operator()(const f32x4 (&acc)[2][2][4][2], const Unit& u, int wr, int wc, int fr, int fq) const {
        bf16_t* gt = g + (size_t)(u.pn >> 2) * GSTRIDE_;
        const int row0 = u.pm * BM + wr * 64 + fr, col0 = (u.pn & 3) * BM + wc * 32 + 8 * fq;
        const float* wp_ = wi + u.pn * BM + wc * 32 + 8 * fq; const f32x4 w00 = *(const f32x4*)wp_, w01 = *(const f32x4*)(wp_ + 4), w10 = *(const f32x4*)(wp_ + HALF), w11 = *(const f32x4*)(wp_ + HALF + 4);
#pragma unroll
        for (int ai = 0; ai < 2; ++ai)
#pragma unroll
            for (int m = 0; m < 4; ++m) { const size_t ro = (size_t)(row0 + ai * HALF + m * 16) * 1024 + col0; const float rsc = su[row0 + ai * HALF + m * 16];
#pragma unroll
                for (int bj = 0; bj < 2; ++bj) { const i32x4 i0 = __builtin_bit_cast(i32x4, acc[ai][bj][m][0]), i1 = __builtin_bit_cast(i32x4, acc[ai][bj][m][1]); f32x4 v0, v1;
#pragma unroll
                    for (int j = 0; j < 4; ++j) { v0[j] = fmaxf(__builtin_amdgcn_rcpf(1.f + __expf(-(float)i0[j] * (rsc * (bj ? w10 : w00)[j]))), 1e-30f); v1[j] = fmaxf(__builtin_amdgcn_rcpf(1.f + __expf(-(float)i1[j] * (rsc * (bj ? w11 : w01)[j]))), 1e-30f); }
                    u32x4 w; w.x = cvt_pk_bf16(v0[0], v0[1]); w.y = cvt_pk_bf16(v0[2], v0[3]); w.z = cvt_pk_bf16(v1[0], v1[1]); w.w = cvt_pk_bf16(v1[2], v1[3]);
                    *(u32x4*)(gt + ro + bj * HALF) = w; } }
    } };
struct EpiBranch3 { static constexpr bool PERM = true, AFTER_DRAIN = false, INPLACE = true; const bf16_t* g; bf16_t* merged;
    DEV static void unpack8(const u32x4 q, float (&f)[8]) { f[0] = __uint_as_float(q.x << 16); f[1] = __uint_as_float(q.x & 0xffff0000u); f[2] = __uint_as_float(q.y << 16); f[3] = __uint_as_float(q.y & 0xffff0000u);
        f[4] = __uint_as_float(q.z << 16); f[5] = __uint_as_float(q.z & 0xffff0000u); f[6] = __uint_as_float(q.w << 16); f[7] = __uint_as_float(q.w & 0xffff0000u); }
    DEV void operator()(f32x4 (&acc)[2][2][4][2], const Unit& u, int wr, int wc, int fr, int fq) const {
        const int row0 = u.pm * BM + wr * 64 + fr, col0 = u.pn * BM + wc * 32 + 8 * fq; const int tag = u.tag;
        const bool fin = (tag == 2); const float keepf = fin ? 0.f : 1.f; const bf16_t* gn = g + (size_t)tag * GSTRIDE_; const bf16_t* gd = gn + GSTRIDE_;
#pragma unroll
        for (int ah = 0; ah < 4; ++ah) { const int ai = ah >> 1, m0 = (ah & 1) * 2; u32x4 nq[2][2], dq[2][2];
#pragma unroll
            for (int mm = 0; mm < 2; ++mm)
#pragma unroll
                for (int bj = 0; bj < 2; ++bj) { const size_t o = (size_t)(row0 + ai * HALF + (m0 + mm) * 16) * 1024 + col0 + bj * HALF; nq[mm][bj] = *(const u32x4*)(gn + o);
                    dq[mm][bj] = (u32x4){0x3f803f80u, 0x3f803f80u, 0x3f803f80u, 0x3f803f80u}; if (!fin) dq[mm][bj] = *(const u32x4*)(gd + o); }
            asm volatile("" ::: "memory");
#pragma unroll
            for (int mm = 0; mm < 2; ++mm)
#pragma unroll
                for (int bj = 0; bj < 2; ++bj) { const int m = m0 + mm; const size_t o = (size_t)(row0 + ai * HALF + m * 16) * 1024 + col0 + bj * HALF; float nn[8], dd[8]; unpack8(nq[mm][bj], nn); unpack8(dq[mm][bj], dd);
                    const f32x4 s0 = (f32x4){nn[0] * __builtin_amdgcn_rcpf(dd[0]), nn[1] * __builtin_amdgcn_rcpf(dd[1]), nn[2] * __builtin_amdgcn_rcpf(dd[2]), nn[3] * __builtin_amdgcn_rcpf(dd[3])};
                    const f32x4 s1 = (f32x4){nn[4] * __builtin_amdgcn_rcpf(dd[4]), nn[5] * __builtin_amdgcn_rcpf(dd[5]), nn[6] * __builtin_amdgcn_rcpf(dd[6]), nn[7] * __builtin_amdgcn_rcpf(dd[7])};
                    const f32x4 r0 = acc[ai][bj][m][0] * s0, r1 = acc[ai][bj][m][1] * s1;
                    if (fin) { u32x4 w; w.x = cvt_pk_bf16(r0[0], r0[1]); w.y = cvt_pk_bf16(r0[2], r0[3]); w.z = cvt_pk_bf16(r1[0], r1[1]); w.w = cvt_pk_bf16(r1[2], r1[3]); *(u32x4*)(merged + o) = w; }
                    acc[ai][bj][m][0] = r0 * keepf; acc[ai][bj][m][1] = r1 * keepf; asm volatile("" : "+v"(acc[ai][bj][m][0]), "+v"(acc[ai][bj][m][1])); }
            asm volatile("" ::: "memory"); }
    } };
struct EpiH { static constexpr bool PERM = true, AFTER_DRAIN = false, INPLACE = false; const float* xin; const bf16_t* xin16; bf16_t* hout; const float* ada_b;
    DEV void operator()(const f32x4 (&acc)[2][2][4][2], const Unit& u, int wr, int wc, int fr, int fq) const {
        const int row0 = u.pm * BM + wr * 64 + fr, col0 = u.pn * BM + wc * 32 + 8 * fq; const float* ab = ada_b + (size_t)(u.pm >> 3) * 6144 + 2048 + col0;
        const f32x4 g00 = *(const f32x4*)ab, g01 = *(const f32x4*)(ab + 4), g10 = *(const f32x4*)(ab + HALF), g11 = *(const f32x4*)(ab + HALF + 4);
        if (xin) {
#pragma unroll
            for (int ah = 0; ah < 4; ++ah) { const int ai = ah >> 1, m0 = (ah & 1) * 2; f32x4 xa[2][2][2];
#pragma unroll
                for (int mm = 0; mm < 2; ++mm)
#pragma unroll
                    for (int bj = 0; bj < 2; ++bj) { const float* xp = xin + (size_t)(row0 + ai * HALF + (m0 + mm) * 16) * 1024 + col0 + bj * HALF; xa[mm][bj][0] = *(const f32x4*)xp; xa[mm][bj][1] = *(const f32x4*)(xp + 4); }
                asm volatile("" ::: "memory");
#pragma unroll
                for (int mm = 0; mm < 2; ++mm)
#pragma unroll
                    for (int bj = 0; bj < 2; ++bj) { const int m = m0 + mm; const f32x4 h0 = ALPHA_ * xa[mm][bj][0] + (bj ? g10 : g00) * acc[ai][bj][m][0], h1 = ALPHA_ * xa[mm][bj][1] + (bj ? g11 : g01) * acc[ai][bj][m][1];
                        u32x4 w; w.x = cvt_pk_bf16(h0[0], h0[1]); w.y = cvt_pk_bf16(h0[2], h0[3]); w.z = cvt_pk_bf16(h1[0], h1[1]); w.w = cvt_pk_bf16(h1[2], h1[3]);
                        *(u32x4*)(hout + (size_t)(row0 + ai * HALF + m * 16) * 1024 + col0 + bj * HALF) = w; }
                asm volatile("" ::: "memory"); }
        } else {
#pragma unroll
            for (int ai = 0; ai < 2; ++ai) { u32x4 xq[4][2];
#pragma unroll
                for (int m = 0; m < 4; ++m)
#pragma unroll
                    for (int bj = 0; bj < 2; ++bj) xq[m][bj] = *(const u32x4*)(xin16 + (size_t)(row0 + ai * HALF + m * 16) * 1024 + col0 + bj * HALF);
                asm volatile("" ::: "memory");
#pragma unroll
                for (int m = 0; m < 4; ++m)
#pragma unroll
                    for (int bj = 0; bj < 2; ++bj) { const u32x4 q = xq[m][bj];
                        const f32x4 x0 = (f32x4){__uint_as_float(q.x << 16), __uint_as_float(q.x & 0xffff0000u), __uint_as_float(q.y << 16), __uint_as_float(q.y & 0xffff0000u)}, x1 = (f32x4){__uint_as_float(q.z << 16), __uint_as_float(q.z & 0xffff0000u), __uint_as_float(q.w << 16), __uint_as_float(q.w & 0xffff0000u)};
                        const f32x4 h0 = ALPHA_ * x0 + (bj ? g10 : g00) * acc[ai][bj][m][0], h1 = ALPHA_ * x1 + (bj ? g11 : g01) * acc[ai][bj][m][1];
                        u32x4 w; w.x = cvt_pk_bf16(h0[0], h0[1]); w.y = cvt_pk_bf16(h0[2], h0[3]); w.z = cvt_pk_bf16(h1[0], h1[1]); w.w = cvt_pk_bf16(h1[2], h1[3]);
                        *(u32x4*)(hout + (size_t)(row0 + ai * HALF + m * 16) * 1024 + col0 + bj * HALF) = w; }
                asm volatile("" ::: "memory"); }
        }
    } };
struct GateSched { const bf16_t* UY; const unsigned char* WmT8; int G, c;
    DEV bool next(int i, Unit& u) const { const long L = (long)i * G + c; if (L >= 128 * 12) return false; tile_of((int)L, 128, 12, u.pm, u.pn); u.tag = 0; u.nt = 8;
        u.a = (const char*)(UY + (size_t)u.pm * BM * UYW_); u.b = (const char*)(WmT8 + (size_t)(u.pn & 3) * BM * (WMW_ * 2)) + (u.pn >> 2) * 1024; return true; } };
struct Branch3Sched { const bf16_t* UY; const unsigned char* WmT8; int G, c;
    DEV bool next(int i, Unit& u) const { const int ti = i / 3, ps = i - ti * 3; const long L = (long)ti * G + c; if (L >= 128 * 4) return false; tile_of((int)L, 128, 4, u.pm, u.pn); u.tag = ps;
        const int koff = ps == 0 ? 0 : (ps == 1 ? 256 : 768); u.nt = ps == 0 ? 4 : 8;
        u.a = (const char*)(UY + (size_t)u.pm * BM * UYW_) + (1024 + koff) * 2; u.b = (const char*)(WmT8 + (size_t)u.pn * BM * (WMW_ * 2)) + 3072 + koff * 2; return true; } };
}

DEV int win_orig_col(int n) {
    if (n >= 3072) return n < 4608 ? (n - 3072 + 2304) : n;
    const int head = n >> 6, p = n & 63; const bool rp = (head < 24) || (head >= 36 && head < 46);
    const int d = rp ? ((p & 4) ? 32 + 4 * (p >> 3) + (p & 3) : 4 * (p >> 3) + (p & 3)) : p;
    return ((n < 2304) ? head * 64 : 3840 + (head - 36) * 64) + d;
}
struct WPrep { const float *w_in, *wba, *wbb, *wbc, *w_out, *peer_wq; unsigned char *WinT8, *WmT8; bf16_t *WoutT, *WqT; };
DEV void nb_wprep(int vb, int t, unsigned char* sm, const WPrep& q) {
    const int l = vb / 1088; int r = vb - l * 1088 + 1920; const float* W; int ldw; bf16_t* Wt = nullptr; unsigned char* W8 = nullptr; int ldt = 0, ld8 = 0, koff = 0, ntk = 16, mode = 0, nsub = 0;
    if (false) {}
    else if (r < 1984) { r -= 1920; W = q.wba + (size_t)l * 256 * 1024; ldw = 1024; Wt = (bf16_t*)(q.WmT8 + (size_t)l * 1024 * (WMW_ * 2) + 3072); ldt = WMW_; koff = 0; ntk = 4; }
    else if (r < 2112) { r -= 1984; W = q.wbb + (size_t)l * 512 * 1024; ldw = 1024; Wt = (bf16_t*)(q.WmT8 + (size_t)l * 1024 * (WMW_ * 2) + 3072); ldt = WMW_; koff = 256; ntk = 8; }
    else if (r < 2240) { r -= 2112; W = q.wbc + (size_t)l * 512 * 1024; ldw = 1024; Wt = (bf16_t*)(q.WmT8 + (size_t)l * 1024 * (WMW_ * 2) + 3072); ldt = WMW_; koff = 768; ntk = 8; }
    else if (r < 2496) { r -= 2240; W = q.w_out + (size_t)l * 1024 * 1024; ldw = 1024; Wt = q.WoutT + (size_t)l * 1024 * 1024; ldt = 1024; }
    else { r -= 2496; W = q.peer_wq + (size_t)l * 1024 * 2048; ldw = 2048; Wt = q.WqT + (size_t)l * 2048 * 1024; ldt = 1024; }
    const int n0 = (r / ntk) * 64, k0 = (r % ntk) * 64; const int c0 = mode ? (win_orig_col(n0) & ~63) : n0;
    bf16_t* tile = (bf16_t*)sm;
    { const int kk = t >> 2, cs = (t & 3) * 16; const float* src = W + (size_t)(k0 + kk) * ldw + c0 + cs;
#pragma unroll
        for (int i = 0; i < 16; i += 4) { const float4 v = *(const float4*)(src + i); tile[kk * 66 + cs + i] = f2bf(v.x); tile[kk * 66 + cs + i + 1] = f2bf(v.y); tile[kk * 66 + cs + i + 2] = f2bf(v.z); tile[kk * 66 + cs + i + 3] = f2bf(v.w); } }
    __syncthreads();
    (void)W8; (void)ld8;
    { const int nn = t >> 2, ks = (t & 3) * 16; const int dl = mode ? (win_orig_col(n0 + nn) - c0) : nn; bf16_t* dst = Wt + (size_t)(n0 + nn - nsub) * ldt + koff + k0 + ks;
        unsigned w[8];
#pragma unroll
        for (int i = 0; i < 8; ++i) w[i] = (unsigned)tile[(ks + 2 * i) * 66 + dl] | ((unsigned)tile[(ks + 2 * i + 1) * 66 + dl] << 16);
        *(u32x4*)dst = (u32x4){w[0], w[1], w[2], w[3]}; *(u32x4*)(dst + 8) = (u32x4){w[4], w[5], w[6], w[7]}; }
}

DEV void winprep_phase(LAS unsigned char* lds, const float* __restrict__ w_in, unsigned char* WinT8, unsigned char* WmT8, float* __restrict__ winv, int G, int cblk, int wv) {
    int wv_ = wv, ln_; asm volatile("v_mbcnt_lo_u32_b32 %1, -1, 0\n\tv_mbcnt_hi_u32_b32 %1, -1, %1" : "+s"(wv_), "=v"(ln_)); const int tid = (wv_ << 6) | ln_, lane = ln_;
    LAS bf16_t* tile = (LAS bf16_t*)lds;
#pragma unroll 1
    for (int item = cblk; item < 240; item += G) { const int l = item / 120, nt = item - l * 120, n0 = nt * 64; const int c0 = win_orig_col(n0) & ~63;
        const float* W = w_in + (size_t)l * 1024 * 7680 + c0;
        __syncthreads();
        { const int r0 = tid >> 4, cs = (tid & 15) * 4;
#pragma unroll 1
            for (int i = 0; i < 32; i += 8) { float4 v[8];
#pragma unroll
                for (int j = 0; j < 8; ++j) v[j] = *(const float4*)(W + (size_t)(r0 + 32 * (i + j)) * 7680 + cs);
#pragma unroll
                for (int j = 0; j < 8; ++j) { LAS bf16_t* d = tile + (r0 + 32 * (i + j)) * 66 + cs; d[0] = f2bf(v[j].x); d[1] = f2bf(v[j].y); d[2] = f2bf(v[j].z); d[3] = f2bf(v[j].w); } } }
        __syncthreads();
        { const int nn = tid >> 3, kq = tid & 7; const int dl = win_orig_col(n0 + nn) - c0; float mx = 0.f;
#pragma unroll 8
            for (int k = 0; k < 128; ++k) mx = fmaxf(mx, fabsf(bf2f(tile[(kq + 8 * k) * 66 + dl])));
            mx = fmaxf(mx, xor_f(mx, 1, lane)); mx = fmaxf(mx, xor_f(mx, 2, lane)); mx = fmaxf(mx, xor_f(mx, 4, lane));
            const float qs = (mx > 0.f) ? 127.f / mx : 0.f;
            unsigned char* dst8;
            if (nt < 72) dst8 = WinT8 + (size_t)l * 4608 * 1024 + (size_t)(n0 + nn) * 1024;
            else { const int br = (nt - 72) >> 4; dst8 = WmT8 + (size_t)l * 1024 * (WMW_ * 2) + br * 1024 + (size_t)(n0 + nn - 4608 - br * 1024) * (WMW_ * 2); }
#pragma unroll 2
            for (int c = 0; c < 8; ++c) { unsigned w8[4]; const int ks = 16 * (kq + 8 * c);
#pragma unroll
                for (int i = 0; i < 4; ++i) { w8[i] = 0u;
#pragma unroll
                    for (int j = 0; j < 4; ++j) { const int qv = (int)rintf(bf2f(tile[(ks + 4 * i + j) * 66 + dl]) * qs); w8[i] |= ((unsigned)qv & 0xffu) << (8 * j); } }
                *(u32x4*)(dst8 + ks) = (u32x4){w8[0], w8[1], w8[2], w8[3]}; }
            if (kq == 0) winv[(size_t)l * 7680 + n0 + nn] = mx * (1.f / 127.f); }
    }
    __syncthreads();
}

namespace hy {
constexpr int ZS = 2064;
constexpr int G0_OFF = 0, G1_OFF = 8192, Z0_OFF = 16384, Z1_OFF = Z0_OFF + 16 * ZS * 2, LDS_END = Z1_OFF + 16 * ZS * 2;
DEV bf16x8 load_frag(LAS const unsigned char* lane_base, int d) {
    const LAS unsigned* p = (const LAS unsigned*)(lane_base + 32 * d); u32x4 w; w.x = p[0]; w.y = p[1]; w.z = p[2]; w.w = p[3];
    return __builtin_bit_cast(bf16x8, w);
}
DEV void load_filter(LAS unsigned char* lds, const bf16_t* g, int tid) {
    const u32x4 c = *(const u32x4*)(g + tid * 8); const unsigned nx = (tid < 511) ? (unsigned)g[tid * 8 + 8] : 0u;
    *(LAS u32x4*)(lds + G0_OFF + tid * 16) = c;
    u32x4 s; s.x = (c.x >> 16) | (c.y << 16); s.y = (c.y >> 16) | (c.z << 16); s.z = (c.z >> 16) | (c.w << 16); s.w = (c.w >> 16) | (nx << 16);
    *(LAS u32x4*)(lds + G1_OFF + tid * 16) = s;
}
DEV float bflo(unsigned w) { return __uint_as_float(w << 16); }
DEV float bfhi(unsigned w) { return __uint_as_float(w & 0xffff0000u); }
DEV void conv_rows(LAS const unsigned char* lds, int zoff, int w, int lane, f32x4 (&D)[16]) {
    const int r = lane & 15, q = lane >> 4;
    LAS const unsigned char* abase = lds + ((r & 1) ? (G0_OFF + 2 * (8 * q - r + 2047)) : (G1_OFF + 2 * (8 * q - r + 2046)));
    LAS const unsigned char* bbase = lds + zoff + (r * ZS + 8 * q) * 2;
    bf16x8 ring[16];
#pragma unroll
    for (int rb = 0; rb < 16; ++rb) D[rb] = (f32x4){0.f, 0.f, 0.f, 0.f};
#pragma unroll
    for (int rb = 2; rb < 16; ++rb) ring[rb] = load_frag(abase, -16 * w - rb);
#pragma unroll 1
    for (int jb0 = 0; jb0 < 64; jb0 += 8) {
#pragma unroll
        for (int u = 0; u < 8; ++u) { const int jb = jb0 + u;
            ring[(16 - 2 * u) & 15] = load_frag(abase, 2 * jb - 16 * w);
            ring[(17 - 2 * u) & 15] = load_frag(abase, 2 * jb - 16 * w - 1);
            const bf16x8 bf = *(const LAS bf16x8*)(bbase + 64 * jb);
#pragma unroll
            for (int rb = 0; rb < 16; ++rb) D[rb] = __builtin_amdgcn_mfma_f32_16x16x32_bf16(ring[(rb - 2 * u) & 15], bf, D[rb], 0, 0, 0);
        }
    }
}
DEV void sconv4(const bf16_t* in, int i, float w0, float w1, float w2, float cb, float (&o)[4]) {
    const u32x2 v = *(const u32x2*)(in + i); const float pm = (i > 0) ? bf2f(in[i - 1]) : 0.f, pn = (i + 4 < 2048) ? bf2f(in[i + 4]) : 0.f;
    const float x0 = bflo(v.x), x1 = bfhi(v.x), x2 = bflo(v.y), x3 = bfhi(v.y);
    o[0] = cb + w0 * pm + w1 * x0 + w2 * x1; o[1] = cb + w0 * x0 + w1 * x1 + w2 * x2; o[2] = cb + w0 * x1 + w1 * x2 + w2 * x3; o[3] = cb + w0 * x2 + w1 * x3 + w2 * pn;
}
DEV void hyena_phase(LAS unsigned char* lds, bf16_t* hyT, const bf16_t* Gr_l, const float* conv_w, const float* conv_b, const float* hy_bias, int G, int cblk, int wv) {
    int wv_ = wv, ln_; asm volatile("v_mbcnt_lo_u32_b32 %1, -1, 0\n\tv_mbcnt_hi_u32_b32 %1, -1, %1" : "+s"(wv_), "=v"(ln_)); int tid_ = (wv_ << 6) | ln_;
    const int tid = tid_, w = __builtin_amdgcn_readfirstlane(tid >> 6), lane = tid & 63, q = lane >> 4, b = lane & 15;
#pragma unroll 1
    for (int c = cblk; c < 512; c += G) {
        __syncthreads();
        load_filter(lds, Gr_l + (size_t)c * 4096, tid);
        { const float w0 = conv_w[c], w1 = conv_w[1536 + c], w2 = conv_w[3072 + c], cb = conv_b[c]; const bf16_t* row = hyT + (size_t)c * T_;
#pragma unroll 2
            for (int k = 0; k < 8; ++k) { const int pos = (k * 512 + tid) * 8; const int s = pos & 2047, bb = pos >> 11;
                const u32x4 v = *(const u32x4*)(row + pos); const float pm = (s > 0) ? bf2f(row[pos - 1]) : 0.f, pn = (s + 8 < 2048) ? bf2f(row[pos + 8]) : 0.f;
                const float x[10] = {pm, bflo(v.x), bfhi(v.x), bflo(v.y), bfhi(v.y), bflo(v.z), bfhi(v.z), bflo(v.w), bfhi(v.w), pn};
                float z[8];
#pragma unroll
                for (int e = 0; e < 8; ++e) z[e] = cb + w0 * x[e] + w1 * x[e + 1] + w2 * x[e + 2];
                u32x4 o; o.x = pg8::cvt_pk_bf16(z[0], z[1]); o.y = pg8::cvt_pk_bf16(z[2], z[3]); o.z = pg8::cvt_pk_bf16(z[4], z[5]); o.w = pg8::cvt_pk_bf16(z[6], z[7]);
                *(LAS u32x4*)(lds + Z0_OFF + (bb * ZS + s) * 2) = o; } }
        __syncthreads();
        f32x4 D[16];
        conv_rows(lds, Z0_OFF, w, lane, D);
        { const int xc = 512 + c; const float w0 = conv_w[xc], w1 = conv_w[1536 + xc], w2 = conv_w[3072 + xc], cb = conv_b[xc], bias = hy_bias[c]; const bf16_t* xin = hyT + (size_t)xc * T_ + b * 2048;
#pragma unroll
            for (int rb = 0; rb < 16; ++rb) { const int i = 256 * w + 16 * rb + 4 * q; float xv[4]; sconv4(xin, i, w0, w1, w2, cb, xv);
                const u32x2 zq = *(const LAS u32x2*)(lds + Z0_OFF + (b * ZS + i) * 2); const float zv[4] = {bflo(zq.x), bfhi(zq.x), bflo(zq.y), bfhi(zq.y)};
                float o[4];
#pragma unroll
                for (int e = 0; e < 4; ++e) o[e] = xv[e] * (D[rb][e] + bias * zv[e]);
                u32x2 pk; pk.x = pg8::cvt_pk_bf16(o[0], o[1]); pk.y = pg8::cvt_pk_bf16(o[2], o[3]);
                *(LAS u32x2*)(lds + Z1_OFF + (b * ZS + i) * 2) = pk; } }
        __syncthreads();
        load_filter(lds, Gr_l + (size_t)(512 + c) * 4096, tid);
        __syncthreads();
        conv_rows(lds, Z1_OFF, w, lane, D);
        { const int xc = 1024 + c; const float w0 = conv_w[xc], w1 = conv_w[1536 + xc], w2 = conv_w[3072 + xc], cb = conv_b[xc], bias = hy_bias[512 + c]; const bf16_t* xin = hyT + (size_t)xc * T_ + b * 2048;
            bf16_t* yout = hyT + (size_t)c * T_ + b * 2048;
#pragma unroll
            for (int rb = 0; rb < 16; ++rb) { const int i = 256 * w + 16 * rb + 4 * q; float xv[4]; sconv4(xin, i, w0, w1, w2, cb, xv);
                const u32x2 zq = *(const LAS u32x2*)(lds + Z1_OFF + (b * ZS + i) * 2); const float zv[4] = {bflo(zq.x), bfhi(zq.x), bflo(zq.y), bfhi(zq.y)};
                float o[4];
#pragma unroll
                for (int e = 0; e < 4; ++e) o[e] = xv[e] * (D[rb][e] + bias * zv[e]);
                u32x2 pk; pk.x = pg8::cvt_pk_bf16(o[0], o[1]); pk.y = pg8::cvt_pk_bf16(o[2], o[3]);
                *(u32x2*)(yout + i) = pk; } }
    }
    __syncthreads();
}
}

namespace peer {
DEV float wave_sum(float v, int lane) {
#pragma unroll
    for (int off = 32; off > 0; off >>= 1) v += xor_f(v, off, lane);
    return v;
}
DEV float wave_max(float v, int lane) {
#pragma unroll
    for (int off = 32; off > 0; off >>= 1) v = fmaxf(v, xor_f(v, off, lane));
    return v;
}
DEV unsigned pk4_fp8(float a, float b, float c, float d) { int w = __builtin_amdgcn_cvt_pk_fp8_f32(a, b, 0, false); w = __builtin_amdgcn_cvt_pk_fp8_f32(c, d, w, true); return (unsigned)w; }
DEV void nb_quant_tables(int vb, int t, const float* __restrict__ pu, const float* __restrict__ pv, unsigned char* __restrict__ U8, unsigned char* __restrict__ V4, float* __restrict__ sinv) {
    const int row = vb * 4 + (t >> 6), lane = t & 63; const float* src = (row < 16384) ? pu + (size_t)row * 1024 : pv + (size_t)(row - 16384) * 1024;
    const float4 a = *(const float4*)(src + 16 * lane), b = *(const float4*)(src + 16 * lane + 4), c = *(const float4*)(src + 16 * lane + 8), d = *(const float4*)(src + 16 * lane + 12);
    float mx = fmaxf(fmaxf(fmaxf(fabsf(a.x), fabsf(a.y)), fmaxf(fabsf(a.z), fabsf(a.w))), fmaxf(fmaxf(fabsf(b.x), fabsf(b.y)), fmaxf(fabsf(b.z), fabsf(b.w))));
    mx = fmaxf(mx, fmaxf(fmaxf(fmaxf(fabsf(c.x), fabsf(c.y)), fmaxf(fabsf(c.z), fabsf(c.w))), fmaxf(fmaxf(fabsf(d.x), fabsf(d.y)), fmaxf(fabsf(d.z), fabsf(d.w)))));
    mx = wave_max(mx, lane);
    {
        const float sc = (mx > 0.f) ? 6.f / mx : 0.f; unsigned w0 = 0u, w1 = 0u; const bool sw = false;
        w0 = __builtin_amdgcn_cvt_scalef32_pk_fp4_f32(w0, (sw ? a.y : a.x) * sc, (sw ? a.x : a.y) * sc, 1.0f, 0); w0 = __builtin_amdgcn_cvt_scalef32_pk_fp4_f32(w0, (sw ? a.w : a.z) * sc, (sw ? a.z : a.w) * sc, 1.0f, 1);
        w0 = __builtin_amdgcn_cvt_scalef32_pk_fp4_f32(w0, (sw ? b.y : b.x) * sc, (sw ? b.x : b.y) * sc, 1.0f, 2); w0 = __builtin_amdgcn_cvt_scalef32_pk_fp4_f32(w0, (sw ? b.w : b.z) * sc, (sw ? b.z : b.w) * sc, 1.0f, 3);
        w1 = __builtin_amdgcn_cvt_scalef32_pk_fp4_f32(w1, (sw ? c.y : c.x) * sc, (sw ? c.x : c.y) * sc, 1.0f, 0); w1 = __builtin_amdgcn_cvt_scalef32_pk_fp4_f32(w1, (sw ? c.w : c.z) * sc, (sw ? c.z : c.w) * sc, 1.0f, 1);
        w1 = __builtin_amdgcn_cvt_scalef32_pk_fp4_f32(w1, (sw ? d.y : d.x) * sc, (sw ? d.x : d.y) * sc, 1.0f, 2); w1 = __builtin_amdgcn_cvt_scalef32_pk_fp4_f32(w1, (sw ? d.w : d.z) * sc, (sw ? d.z : d.w) * sc, 1.0f, 3);
        unsigned char* dst = (row < 16384) ? U8 + (size_t)row * 512 : V4 + (size_t)(row - 16384) * 512;
        *(u32x2*)(dst + 8 * lane) = (u32x2){w0, w1};
        if (lane == 0) sinv[row] = (mx > 0.f) ? mx * (1.f / 6.f) : 0.f;
    }
}
DEV void peer_phase(LAS unsigned char* lds, const bf16_t* __restrict__ x1in, float* xout32, bf16_t* xout16, const float* ada_l,
                    const int* __restrict__ eidx, const float* __restrict__ egate, const unsigned char* __restrict__ U8, const unsigned char* __restrict__ V4,
                    const float* __restrict__ sinv, const float* __restrict__ g, const float* __restrict__ bta, const float* ada_next, bf16_t* UY, float* su_next, int G, int cblk, int wv) {
    int wv_ = wv, ln_; asm volatile("v_mbcnt_lo_u32_b32 %1, -1, 0\n\tv_mbcnt_hi_u32_b32 %1, -1, %1" : "+s"(wv_), "=v"(ln_)); int tid_ = (wv_ << 6) | ln_;
    const int tid = tid_, w = __builtin_amdgcn_readfirstlane(tid >> 6), lane = tid & 63;
    LAS unsigned char* urow_l = lds + w * 3072; LAS int* E_l = (LAS int*)(urow_l + 1024); LAS float* W_l = (LAS float*)(urow_l + 1536); LAS float* SU_l = (LAS float*)(urow_l + 2048); LAS float* SV_l = (LAS float*)(urow_l + 2560); LAS float* D_l = (LAS float*)(lds + 24576 + 8 * 8448 + w * 512); LAS unsigned char* stage_l = lds + 24576 + w * 8448;
#define PEER_SB __builtin_amdgcn_sched_barrier(0)
#define PEER_ISSUE_U(buf, gi) do { _Pragma("unroll") for (int n2 = 0; n2 < 8; ++n2) { const int e_ = E_l[(gi) * 16 + 2 * n2 + hh]; buf[n2] = *(const u32x4*)(U8 + (size_t)e_ * 512 + 16 * r32); } } while (0)
#define PEER_ISSUE_V(buf, gi) do { _Pragma("unroll") for (int n2 = 0; n2 < 8; ++n2) { const int e_ = E_l[(gi) * 16 + 2 * n2 + hh]; buf[n2] = *(const u32x4*)(V4 + (size_t)e_ * 512 + 16 * r32); } } while (0)
#define PEER_COMP_U(buf) do { _Pragma("unroll") for (int n2 = 0; n2 < 8; ++n2) *(LAS u32x4*)(stage_l + (2 * n2 + hh) * 528 + 16 * r32) = buf[n2]; asm volatile("s_waitcnt lgkmcnt(0)" ::: "memory"); \
        _Pragma("unroll") for (int k2 = 0; k2 < 8; ++k2) { const u32x4 bw = *(const LAS u32x4*)(stage_l + n * 528 + 64 * k2 + 16 * q); const u32x4 alo = *(const LAS u32x4*)(urow_l + 128 * k2 + 16 * q), ahi = *(const LAS u32x4*)(urow_l + 128 * k2 + 64 + 16 * q);     \
            const i32x8 av = (i32x8){(int)alo.x, (int)alo.y, (int)alo.z, (int)alo.w, (int)ahi.x, (int)ahi.y, (int)ahi.z, (int)ahi.w}; const i32x8 bv = (i32x8){(int)bw.x, (int)bw.y, (int)bw.z, (int)bw.w, 0, 0, 0, 0}; \
            if (k2 & 1) acc1 = __builtin_amdgcn_mfma_scale_f32_16x16x128_f8f6f4(av, bv, acc1, 0, 4, 0, 0x7F7F7F7F, 0, 0x7F7F7F7F); else acc = __builtin_amdgcn_mfma_scale_f32_16x16x128_f8f6f4(av, bv, acc, 0  , 4  , 0, 0x7F7F7F7F, 0, 0x7F7F7F7F); } } while (0)
#define PEER_UNPK(wd, base) do { o[(base) / 2 + 0] = __builtin_elementwise_fma(__builtin_bit_cast(h2, __builtin_amdgcn_cvt_scalef32_pk_f16_fp4((wd), 1.0f, 0)), w2, o[(base) / 2 + 0]); o[(base) / 2 + 1] = __builtin_elementwise_fma(__builtin_bit_cast(h2, __builtin_amdgcn_cvt_scalef32_pk_f16_fp4((wd), 1.0f, 1)), w2, o[(base) / 2 + 1]); \
            o[(base) / 2 + 2] = __builtin_elementwise_fma(__builtin_bit_cast(h2, __builtin_amdgcn_cvt_scalef32_pk_f16_fp4((wd), 1.0f, 2)), w2, o[(base) / 2 + 2]); o[(base) / 2 + 3] = __builtin_elementwise_fma(__builtin_bit_cast(h2, __builtin_amdgcn_cvt_scalef32_pk_f16_fp4((wd), 1.0f, 3)), w2, o[(base) / 2 + 3]); } while (0)
#define PEER_COMP_V(buf, gi) do { float wq_[8]; _Pragma("unroll") for (int n2 = 0; n2 < 8; ++n2) wq_[n2] = W_l[(gi) * 16 + 2 * n2 + hh]; \
        _Pragma("unroll") for (int n2 = 0; n2 < 8; ++n2) { const h2 w2 = __builtin_bit_cast(h2, wq_[n2]); const u32x4 v = buf[n2]; \
              \
            asm volatile("" : "+v"(o[0]), "+v"(o[1]), "+v"(o[2]), "+v"(o[3]), "+v"(o[4]), "+v"(o[5]), "+v"(o[6]), "+v"(o[7]), "+v"(o[8]), "+v"(o[9]), "+v"(o[10]), "+v"(o[11]), "+v"(o[12]), "+v"(o[13]), "+v"(o[14]), "+v"(o[15])); \
            PEER_UNPK(v.x, 0); PEER_UNPK(v.y, 8); PEER_UNPK(v.z, 16); PEER_UNPK(v.w, 24); } } while (0)
    int ne0 = 0, ne1 = 0; float ng0 = 0.f, ng1 = 0.f, nsu0 = 0.f, nsu1 = 0.f, nsv0 = 0.f, nsv1 = 0.f; u32x4 nx0 = (u32x4){0u, 0u, 0u, 0u}, nx1 = nx0;
    { const int tok0 = cblk * 8 + w; if (tok0 < T_) { const int dd = 32 * (lane & 31) + 16 * (lane >> 5); nx0 = *(const u32x4*)(x1in + (size_t)tok0 * 1024 + dd); nx1 = *(const u32x4*)(x1in + (size_t)tok0 * 1024 + dd + 8); ne0 = eidx[(size_t)tok0 * 128 + lane]; ne1 = eidx[(size_t)tok0 * 128 + 64 + lane]; ng0 = egate[(size_t)tok0 * 128 + lane]; ng1 = egate[(size_t)tok0 * 128 + 64 + lane];
        nsu0 = sinv[ne0]; nsu1 = sinv[ne1]; nsv0 = sinv[16384 + ne0]; nsv1 = sinv[16384 + ne1]; } }
#pragma unroll 1
    for (int tok = cblk * 8 + w; tok < T_; tok += G * 8) {
        int lane_o = lane; asm volatile("" : "+v"(lane_o));
        const int q = lane_o >> 4, n = lane_o & 15, r32 = lane_o & 31, hh = lane_o >> 5; int d0 = 32 * r32 + 16 * hh;
        const float* a = ada_l + (size_t)(tok >> 11) * 6144;
        float stinv; float x1[16]; u32x4 bufA[8], bufB[8];
        {
#pragma unroll
            for (int j = 0; j < 16; j += 8) { const u32x4 v = j ? nx1 : nx0;
                x1[j] = __uint_as_float(v.x << 16); x1[j + 1] = __uint_as_float(v.x & 0xffff0000u); x1[j + 2] = __uint_as_float(v.y << 16); x1[j + 3] = __uint_as_float(v.y & 0xffff0000u);
                x1[j + 4] = __uint_as_float(v.z << 16); x1[j + 5] = __uint_as_float(v.z & 0xffff0000u); x1[j + 6] = __uint_as_float(v.w << 16); x1[j + 7] = __uint_as_float(v.w & 0xffff0000u); }
            E_l[lane_o] = ne0; E_l[64 + lane_o] = ne1; W_l[lane_o] = ng0; W_l[64 + lane_o] = ng1;
            SU_l[lane_o] = nsu0; SU_l[64 + lane_o] = nsu1; SV_l[lane_o] = nsv0; SV_l[64 + lane_o] = nsv1;
            asm volatile("s_waitcnt lgkmcnt(0)" ::: "memory");
            PEER_ISSUE_U(bufA, 0); PEER_SB;
            float u[16]; float um = 0.f;
#pragma unroll
            for (int j = 0; j < 16; j += 4) { const float4 sc = *(const float4*)(a + 4096 + d0 + j), sh = *(const float4*)(a + 3072 + d0 + j);
                u[j] = x1[j] * (1.f + sc.x) + sh.x; u[j + 1] = x1[j + 1] * (1.f + sc.y) + sh.y; u[j + 2] = x1[j + 2] * (1.f + sc.z) + sh.z; u[j + 3] = x1[j + 3] * (1.f + sc.w) + sh.w;
                um = fmaxf(um, fmaxf(fmaxf(fabsf(u[j]), fabsf(u[j + 1])), fmaxf(fabsf(u[j + 2]), fabsf(u[j + 3])))); }
            um = wave_max(um, lane_o); const float st = (um > 0.f) ? 224.f / um : 1.f; stinv = (um > 0.f) ? um * (1.f / 224.f) : 1.f;
            u32x4 pq; pq.x = pk4_fp8(u[0] * st, u[1] * st, u[2] * st, u[3] * st); pq.y = pk4_fp8(u[4] * st, u[5] * st, u[6] * st, u[7] * st);
            pq.z = pk4_fp8(u[8] * st, u[9] * st, u[10] * st, u[11] * st); pq.w = pk4_fp8(u[12] * st, u[13] * st, u[14] * st, u[15] * st);
            *(LAS u32x4*)(urow_l + d0) = pq; }
        asm volatile("s_waitcnt lgkmcnt(0)" ::: "memory");
        PEER_SB;
#define PEER_FIN_U(gi) do { if (q == 0) D_l[(gi) * 16 + n] = acc[0] + acc1[0]; } while (0)
#pragma unroll 1
        for (int gi = 0; gi < 8; gi += 2) { f32x4 acc = (f32x4){0.f, 0.f, 0.f, 0.f}, acc1 = acc;
            PEER_ISSUE_U(bufB, gi + 1); PEER_SB; PEER_COMP_U(bufA); PEER_FIN_U(gi); PEER_SB;
            if (gi < 6) PEER_ISSUE_U(bufA, gi + 2); else PEER_ISSUE_V(bufA, 0);
            PEER_SB; acc = (f32x4){0.f, 0.f, 0.f, 0.f}; acc1 = acc; PEER_COMP_U(bufB); PEER_FIN_U(gi + 1); PEER_SB; }
        asm volatile("s_waitcnt lgkmcnt(0)" ::: "memory");
#pragma unroll
        for (int t = 0; t < 2; ++t) { const int ix = lane_o + 64 * t; const float ds_ = D_l[ix] * (SU_l[ix] * stinv); const float wv_ = W_l[ix] * 0.5f * ds_ * (1.f + erff(ds_ * 0.70710678118654752f)) * SV_l[ix];
            const _Float16 wh_ = (_Float16)wv_; W_l[ix] = __builtin_bit_cast(float, (h2){wh_, wh_}); }
#undef PEER_FIN_U
        asm volatile("s_waitcnt lgkmcnt(0)" ::: "memory");
        h2 o2[16];
#pragma unroll
        for (int j = 0; j < 16; ++j) o2[j] = (h2){(_Float16)0.f, (_Float16)0.f};
        const int tokn = tok + G * 8; const bool hasn = tokn < T_;
        if (hasn) { nx0 = *(const u32x4*)(x1in + (size_t)tokn * 1024 + d0); nx1 = *(const u32x4*)(x1in + (size_t)tokn * 1024 + d0 + 8); ne0 = eidx[(size_t)tokn * 128 + lane_o]; ne1 = eidx[(size_t)tokn * 128 + 64 + lane_o]; ng0 = egate[(size_t)tokn * 128 + lane_o]; ng1 = egate[(size_t)tokn * 128 + 64 + lane_o]; }
        PEER_SB;
        { h2 (&o)[16] = o2;
#pragma unroll 1
        for (int gi = 0; gi < 8; gi += 2) {
            PEER_ISSUE_V(bufB, gi + 1); PEER_SB; PEER_COMP_V(bufA, gi); PEER_SB;
            if (gi < 6) PEER_ISSUE_V(bufA, gi + 2);
            if (gi == 2 && hasn) { nsu0 = sinv[ne0]; nsu1 = sinv[ne1]; nsv0 = sinv[16384 + ne0]; nsv1 = sinv[16384 + ne1]; }
            PEER_SB; PEER_COMP_V(bufB, gi + 1); PEER_SB; } }
        asm volatile("" : "+v"(lane_o)); d0 = 32 * (lane_o & 31) + 16 * (lane_o >> 5);
        const unsigned hm = 0u - (unsigned)(lane_o >> 5);
        float o[16];
#pragma unroll
        for (int j = 0; j < 16; ++j) { const float lo_ = (float)o2[j >> 1][j & 1], hi_ = (float)o2[8 + (j >> 1)][j & 1];
            const float keep = __uint_as_float((__float_as_uint(lo_) & ~hm) | (__float_as_uint(hi_) & hm)), send = __uint_as_float((__float_as_uint(hi_) & ~hm) | (__float_as_uint(lo_) & hm));
            o[j] = keep + xor_f(send, 32, lane_o); }
        float hv[16]; float s = 0.f;
#pragma unroll
        for (int j = 0; j < 16; j += 4) { const float4 g2 = *(const float4*)(a + 5120 + d0 + j);
            hv[j] = ALPHA_ * x1[j] + g2.x * o[j]; hv[j + 1] = ALPHA_ * x1[j + 1] + g2.y * o[j + 1]; hv[j + 2] = ALPHA_ * x1[j + 2] + g2.z * o[j + 2]; hv[j + 3] = ALPHA_ * x1[j + 3] + g2.w * o[j + 3];
            s += (hv[j] + hv[j + 1]) + (hv[j + 2] + hv[j + 3]); }
        const float mu = wave_sum(s, lane_o) * (1.f / 1024.f); float qq = 0.f;
#pragma unroll
        for (int j = 0; j < 16; ++j) { const float dd = hv[j] - mu; qq += dd * dd; }
        const float rstd = rsqrtf(wave_sum(qq, lane_o) * (1.f / 1024.f) + LN_EPS_);
        const float* an = ada_next ? ada_next + (size_t)(tok >> 11) * 6144 : nullptr;
        float y[16];
#pragma unroll
        for (int j = 0; j < 16; j += 4) { const float4 gg = *(const float4*)(g + d0 + j), bb = *(const float4*)(bta + d0 + j);
            y[j] = (hv[j] - mu) * rstd * gg.x + bb.x; y[j + 1] = (hv[j + 1] - mu) * rstd * gg.y + bb.y; y[j + 2] = (hv[j + 2] - mu) * rstd * gg.z + bb.z; y[j + 3] = (hv[j + 3] - mu) * rstd * gg.w + bb.w;
            if (!xout16) *(float4*)(xout32 + (size_t)tok * 1024 + d0 + j) = make_float4(y[j], y[j + 1], y[j + 2], y[j + 3]); }
        if (xout16) { u32x4 q0, q1; q0.x = pg8::cvt_pk_bf16(y[0], y[1]); q0.y = pg8::cvt_pk_bf16(y[2], y[3]); q0.z = pg8::cvt_pk_bf16(y[4], y[5]); q0.w = pg8::cvt_pk_bf16(y[6], y[7]);
            q1.x = pg8::cvt_pk_bf16(y[8], y[9]); q1.y = pg8::cvt_pk_bf16(y[10], y[11]); q1.z = pg8::cvt_pk_bf16(y[12], y[13]); q1.w = pg8::cvt_pk_bf16(y[14], y[15]);
            bf16_t* xo = xout16 + (size_t)tok * 1024 + d0; *(u32x4*)xo = q0; *(u32x4*)(xo + 8) = q1; }
        if (an) { float uu[16]; float um = 0.f;
#pragma unroll
            for (int j = 0; j < 16; j += 4) { const float4 sc = *(const float4*)(an + 1024 + d0 + j), sh = *(const float4*)(an + d0 + j);
                uu[j] = y[j] * (1.f + sc.x) + sh.x; uu[j + 1] = y[j + 1] * (1.f + sc.y) + sh.y; uu[j + 2] = y[j + 2] * (1.f + sc.z) + sh.z; uu[j + 3] = y[j + 3] * (1.f + sc.w) + sh.w;
                um = fmaxf(um, fmaxf(fmaxf(fabsf(uu[j]), fabsf(uu[j + 1])), fmaxf(fabsf(uu[j + 2]), fabsf(uu[j + 3])))); }
            um = wave_max(um, lane_o); const float qs = (um > 0.f) ? 127.f / um : 0.f; unsigned o8[4];
#pragma unroll
            for (int e = 0; e < 4; ++e) { o8[e] = 0u;
#pragma unroll
                for (int j = 0; j < 4; ++j) o8[e] |= ((unsigned)(int)rintf(uu[4 * e + j] * qs) & 0xffu) << (8 * j); }
            *(u32x4*)((unsigned char*)(UY + (size_t)tok * UYW_) + d0) = (u32x4){o8[0], o8[1], o8[2], o8[3]};
            if (lane_o == 0) su_next[tok] = um * (1.f / 127.f); }
        asm volatile("s_waitcnt lgkmcnt(0)" ::: "memory");
    }
#undef PEER_SB
#undef PEER_ISSUE_U
#undef PEER_ISSUE_V
#undef PEER_COMP_U
#undef PEER_COMP_V
#undef PEER_UNPK
    __syncthreads();
}
}

namespace tk {
typedef float f32x16 __attribute__((ext_vector_type(16)));
constexpr int KROW = 272;
DEV unsigned sortable(float v) { const unsigned u = __float_as_uint(v); return u ^ ((unsigned)((int)u >> 31) | 0x80000000u); }
DEV float unsortable(unsigned k) { return __uint_as_float(k ^ ((~(unsigned)((int)k >> 31)) | 0x80000000u)); }
DEV unsigned umax_(unsigned a, unsigned b) { return a > b ? a : b; }
DEV unsigned umin_(unsigned a, unsigned b) { return a < b ? a : b; }
#define CE(x, y) { const unsigned hi_ = umax_(a[x], a[y]), lo_ = umin_(a[x], a[y]); a[x] = hi_; a[y] = lo_; }
DEV void sort16(unsigned (&a)[16]) {
    CE(0, 1); CE(3, 2); CE(4, 5); CE(7, 6); CE(8, 9); CE(11, 10); CE(12, 13); CE(15, 14); CE(0, 2); CE(1, 3); CE(6, 4); CE(7, 5); CE(8, 10); CE(9, 11); CE(14, 12); CE(15, 13); CE(0, 1); CE(2, 3); CE(5, 4); CE(7, 6); CE(8, 9); CE(10, 11); CE(13, 12); CE(15, 14); CE(0, 4); CE(1, 5); CE(2, 6); CE(3, 7); CE(12, 8); CE(13, 9); CE(14, 10); CE(15, 11); CE(0, 2); CE(1, 3); CE(4, 6); CE(5, 7); CE(10, 8); CE(11, 9); CE(14, 12); CE(15, 13); CE(0, 1); CE(2, 3); CE(4, 5); CE(6, 7); CE(9, 8); CE(11, 10); CE(13, 12); CE(15, 14); CE(0, 8); CE(1, 9); CE(2, 10); CE(3, 11); CE(4, 12); CE(5, 13); CE(6, 14); CE(7, 15); CE(0, 4); CE(1, 5); CE(2, 6); CE(3, 7); CE(8, 12); CE(9, 13); CE(10, 14); CE(11, 15); CE(0, 2); CE(1, 3); CE(4, 6); CE(5, 7); CE(8, 10); CE(9, 11); CE(12, 14); CE(13, 15); CE(0, 1); CE(2, 3); CE(4, 5); CE(6, 7); CE(8, 9); CE(10, 11); CE(12, 13); CE(14, 15);
}
DEV void bmerge16(unsigned (&a)[16]) {
    CE(0, 8); CE(1, 9); CE(2, 10); CE(3, 11); CE(4, 12); CE(5, 13); CE(6, 14); CE(7, 15); CE(0, 4); CE(1, 5); CE(2, 6); CE(3, 7); CE(8, 12); CE(9, 13); CE(10, 14); CE(11, 15); CE(0, 2); CE(1, 3); CE(4, 6); CE(5, 7); CE(8, 10); CE(9, 11); CE(12, 14); CE(13, 15); CE(0, 1); CE(2, 3); CE(4, 5); CE(6, 7); CE(8, 9); CE(10, 11); CE(12, 13); CE(14, 15);
}
#undef CE
DEV void top_merge(unsigned (&a)[16], const unsigned (&b)[16]) {
#pragma unroll
    for (int i = 0; i < 16; ++i) a[i] = umax_(a[i], b[15 - i]);
    bmerge16(a);
}
DEV void xlane_merge(unsigned (&a)[16], int lane) {
    unsigned b[16];
#pragma unroll
    for (int i = 0; i < 16; ++i) b[i] = (unsigned)xor_i((int)a[i], 32, lane);
    top_merge(a, b);
}
DEV unsigned lookup_idx(unsigned long long lo, unsigned long long hi, int a) { const unsigned long long wv = (a < 8) ? lo : hi; return (unsigned)(wv >> ((a & 7) * 8)) & 127u; }
DEV unsigned blendu(unsigned m, unsigned a, unsigned b) { return (a & ~m) | (b & m); }
DEV float blendf(unsigned m, float a, float b) { return __uint_as_float((__float_as_uint(a) & ~m) | (__float_as_uint(b) & m)); }

DEV void topk_phase(LAS unsigned char* lds, const bf16_t* __restrict__ Q2, const float* __restrict__ keys_l, int* __restrict__ eidx, float* __restrict__ egate, int G, int cblk, int wv) {
    int wv_ = wv, ln_; asm volatile("v_mbcnt_lo_u32_b32 %1, -1, 0\n\tv_mbcnt_hi_u32_b32 %1, -1, %1" : "+s"(wv_), "=v"(ln_)); int tid_ = (wv_ << 6) | ln_;
    const int tid = tid_, w = __builtin_amdgcn_readfirstlane(tid >> 6), lane = tid & 63, tl = lane & 31, hh = lane >> 5;
    asm volatile("" : "+s"(G));
    const bool by_head = (G & 7) == 0;
#pragma unroll 1
    for (int h = 0; h < 8; ++h) {
        if (by_head && h != (cblk & 7)) continue;
        __syncthreads();
        {
            const int r = tid >> 1, c0 = (tid & 1) * 64; const float* src = keys_l + ((size_t)h * 256 + r) * 128 + c0; LAS unsigned char* dst = lds + r * KROW + c0 * 2;
#pragma unroll
            for (int j = 0; j < 64; j += 8) { const float4 a = *(const float4*)(src + j), b = *(const float4*)(src + j + 4);
                u32x4 o; o.x = pg8::cvt_pk_bf16(a.x, a.y); o.y = pg8::cvt_pk_bf16(a.z, a.w); o.z = pg8::cvt_pk_bf16(b.x, b.y); o.w = pg8::cvt_pk_bf16(b.z, b.w); *(LAS u32x4*)(dst + j * 2) = o; }
        }
        __syncthreads();
        const int first = by_head ? (cblk >> 3) * 8 + w : cblk * 8 + w, stride = by_head ? (G >> 3) * 8 : G * 8;
#pragma unroll 1
        for (int blk = first; blk < T_ / 32; blk += stride) {
            const int tok = blk * 32 + tl; const bf16_t* qrow = Q2 + (size_t)tok * 2048 + h * 256 + 8 * hh;
            unsigned L[2][16];
#pragma unroll
            for (int p = 0; p < 2; ++p) {
                bf16x8 bq[8];
#pragma unroll
                for (int ks = 0; ks < 8; ++ks) bq[ks] = *(const bf16x8*)(qrow + p * 128 + 16 * ks);
#pragma unroll
                for (int t = 0; t < 4; ++t) {
                    f32x16 acc;
#pragma unroll
                    for (int e = 0; e < 16; ++e) acc[e] = 0.f;
#pragma unroll
                    for (int ks = 0; ks < 8; ++ks) { const bf16x8 ak = *(const LAS bf16x8*)(lds + (p * 128 + 32 * t + tl) * KROW + (16 * ks + 8 * hh) * 2);
                        acc = __builtin_amdgcn_mfma_f32_32x32x16_bf16(ak, bq[ks], acc, 0, 0, 0); }
                    unsigned K[16];
#pragma unroll
                    for (int e = 0; e < 16; ++e) K[e] = (sortable(acc[e]) & ~127u) | (unsigned)((127 - 32 * t - (e & 3) - 8 * (e >> 2)) - 4 * hh);
                    sort16(K);
                    if (t == 0) {
#pragma unroll
                        for (int e = 0; e < 16; ++e) L[p][e] = K[e];
                    } else top_merge(L[p], K);
                    __builtin_amdgcn_sched_barrier(0);
                }
                xlane_merge(L[p], lane);
                __builtin_amdgcn_sched_barrier(0);
            }
            float f1[16], f2[16];
#pragma unroll
            for (int e = 0; e < 16; ++e) { f1[e] = unsortable(L[0][e] & ~127u); f2[e] = unsortable(L[1][e] & ~127u); }
            unsigned hm = 0u - (unsigned)hh; asm volatile("" : "+v"(hm));
            unsigned C[2][16];
            C[0][0] = (sortable(blendf(hm, f1[0], f1[2]) + blendf(hm, f2[0], f2[1])) & ~255u) | (255u - blendu(hm, 0u, 33u));
            C[0][1] = (sortable(blendf(hm, f1[0], f1[2]) + blendf(hm, f2[1], f2[2])) & ~255u) | (255u - blendu(hm, 1u, 34u));
            C[0][2] = (sortable(blendf(hm, f1[0], f1[2]) + blendf(hm, f2[2], f2[3])) & ~255u) | (255u - blendu(hm, 2u, 35u));
            C[0][3] = (sortable(blendf(hm, f1[0], f1[2]) + blendf(hm, f2[3], f2[4])) & ~255u) | (255u - blendu(hm, 3u, 36u));
            C[0][4] = (sortable(blendf(hm, f1[0], f1[3]) + blendf(hm, f2[4], f2[0])) & ~255u) | (255u - blendu(hm, 4u, 48u));
            C[0][5] = (sortable(blendf(hm, f1[0], f1[3]) + blendf(hm, f2[5], f2[1])) & ~255u) | (255u - blendu(hm, 5u, 49u));
            C[0][6] = (sortable(blendf(hm, f1[0], f1[3]) + blendf(hm, f2[6], f2[2])) & ~255u) | (255u - blendu(hm, 6u, 50u));
            C[0][7] = (sortable(blendf(hm, f1[0], f1[3]) + blendf(hm, f2[7], f2[3])) & ~255u) | (255u - blendu(hm, 7u, 51u));
            C[0][8] = (sortable(blendf(hm, f1[0], f1[4]) + blendf(hm, f2[8], f2[0])) & ~255u) | (255u - blendu(hm, 8u, 64u));
            C[0][9] = (sortable(blendf(hm, f1[0], f1[4]) + blendf(hm, f2[9], f2[1])) & ~255u) | (255u - blendu(hm, 9u, 65u));
            C[0][10] = (sortable(blendf(hm, f1[0], f1[4]) + blendf(hm, f2[10], f2[2])) & ~255u) | (255u - blendu(hm, 10u, 66u));
            C[0][11] = (sortable(blendf(hm, f1[0], f1[5]) + blendf(hm, f2[11], f2[0])) & ~255u) | (255u - blendu(hm, 11u, 80u));
            C[0][12] = (sortable(blendf(hm, f1[0], f1[5]) + blendf(hm, f2[12], f2[1])) & ~255u) | (255u - blendu(hm, 12u, 81u));
            C[0][13] = (sortable(blendf(hm, f1[0], f1[6]) + blendf(hm, f2[13], f2[0])) & ~255u) | (255u - blendu(hm, 13u, 96u));
            C[0][14] = (sortable(blendf(hm, f1[0], f1[6]) + blendf(hm, f2[14], f2[1])) & ~255u) | (255u - blendu(hm, 14u, 97u));
            C[0][15] = (sortable(blendf(hm, f1[0], f1[7]) + blendf(hm, f2[15], f2[0])) & ~255u) | (255u - blendu(hm, 15u, 112u));
            C[1][0] = (sortable(blendf(hm, f1[1], f1[7]) + blendf(hm, f2[0], f2[1])) & ~255u) | (255u - blendu(hm, 16u, 113u));
            C[1][1] = (sortable(blendf(hm, f1[1], f1[8]) + blendf(hm, f2[1], f2[0])) & ~255u) | (255u - blendu(hm, 17u, 128u));
            C[1][2] = (sortable(blendf(hm, f1[1], f1[9]) + blendf(hm, f2[2], f2[0])) & ~255u) | (255u - blendu(hm, 18u, 144u));
            C[1][3] = (sortable(blendf(hm, f1[1], f1[10]) + blendf(hm, f2[3], f2[0])) & ~255u) | (255u - blendu(hm, 19u, 160u));
            C[1][4] = (sortable(blendf(hm, f1[1], f1[11]) + blendf(hm, f2[4], f2[0])) & ~255u) | (255u - blendu(hm, 20u, 176u));
            C[1][5] = (sortable(blendf(hm, f1[1], f1[12]) + blendf(hm, f2[5], f2[0])) & ~255u) | (255u - blendu(hm, 21u, 192u));
            C[1][6] = (sortable(blendf(hm, f1[1], f1[13]) + blendf(hm, f2[6], f2[0])) & ~255u) | (255u - blendu(hm, 22u, 208u));
            C[1][7] = (sortable(blendf(hm, f1[1], f1[14]) + blendf(hm, f2[7], f2[0])) & ~255u) | (255u - blendu(hm, 23u, 224u));
            C[1][8] = (sortable(blendf(hm, f1[2], f1[15]) + blendf(hm, f2[0], f2[0])) & ~255u) | (255u - blendu(hm, 32u, 240u));
            C[1][9] = 0u;
            C[1][10] = 0u;
            C[1][11] = 0u;
            C[1][12] = 0u;
            C[1][13] = 0u;
            C[1][14] = 0u;
            C[1][15] = 0u;
            sort16(C[0]); sort16(C[1]); top_merge(C[0], C[1]); xlane_merge(C[0], lane);
            unsigned long long p1lo = 0ull, p1hi = 0ull, p2lo = 0ull, p2hi = 0ull;
#pragma unroll
            for (int m = 0; m < 8; ++m) { p1lo |= (unsigned long long)(127u - (L[0][m] & 127u)) << (8 * m); p1hi |= (unsigned long long)(127u - (L[0][8 + m] & 127u)) << (8 * m);
                p2lo |= (unsigned long long)(127u - (L[1][m] & 127u)) << (8 * m); p2hi |= (unsigned long long)(127u - (L[1][8 + m] & 127u)) << (8 * m); }
            float val[16]; unsigned ex[16]; float sum = 0.f;
#pragma unroll
            for (int k = 0; k < 16; ++k) { const unsigned flat = 255u - (C[0][k] & 255u); const int a = (int)(flat >> 4), b = (int)(flat & 15u);
                val[k] = unsortable(C[0][k] & ~255u); ex[k] = lookup_idx(p1lo, p1hi, a) * 128u + lookup_idx(p2lo, p2hi, b); }
            const float mx = val[0];
#pragma unroll
            for (int k = 0; k < 16; ++k) { val[k] = __expf(val[k] - mx); sum += val[k]; }
            const float inv = 1.f / sum;
            int eo[8]; float go[8];
#pragma unroll
            for (int k = 0; k < 8; ++k) { eo[k] = (int)blendu(hm, ex[k], ex[8 + k]); go[k] = blendf(hm, val[k], val[8 + k]) * inv; }
            const size_t ob = ((size_t)tok * 8 + h) * 16 + 8 * hh;
            *(int4*)(eidx + ob) = make_int4(eo[0], eo[1], eo[2], eo[3]); *(int4*)(eidx + ob + 4) = make_int4(eo[4], eo[5], eo[6], eo[7]);
            *(float4*)(egate + ob) = make_float4(go[0], go[1], go[2], go[3]); *(float4*)(egate + ob + 4) = make_float4(go[4], go[5], go[6], go[7]);
        }
    }
    __syncthreads();
}
}

namespace at {
typedef float f32x16 __attribute__((ext_vector_type(16)));
constexpr int KROWB = 144, VROWB = 776, K_OFF = 0, V_OFF = 384 * KROWB, LDS_END = V_OFF + 64 * VROWB;
constexpr int N_ITEMS_A = 16 * 12 * 8, N_ITEMS_C = 16 * 2 * 16 * 2;

struct Band { int p_w, ls, R, slot_base; };
template <bool MASK>
DEV void chunk(LAS const unsigned char* lds, const Band& bd, int c, const bf16x8 (&qf)[4], int tl, int hh, int lane, f32x16 (&O)[2], float& m, float& l) {
    const int kp0 = bd.p_w - bd.R + 32 * c;
    if (kp0 + 31 < 0 || kp0 >= bd.ls) return;
    const int s0 = kp0 + bd.slot_base;
    f32x16 S;
#pragma unroll
    for (int e = 0; e < 16; ++e) S[e] = 0.f;
#pragma unroll
    for (int ks = 0; ks < 4; ++ks) { const bf16x8 ak = *(const LAS bf16x8*)(lds + K_OFF + (s0 + tl) * KROWB + (16 * ks + 8 * hh) * 2); S = __builtin_amdgcn_mfma_f32_32x32x16_bf16(ak, qf[ks], S, 0, 0, 0); }
    float cmax = -1e30f;
    if (MASK) {
        const int dbase = (32 * c - bd.R) - tl + 4 * hh;
#pragma unroll
        for (int e = 0; e < 16; ++e) { const int diff = dbase + (e & 3) + 8 * (e >> 2); const bool ok = (diff <= bd.R) && (diff >= -bd.R); S[e] = ok ? S[e] : -1e30f; cmax = fmaxf(cmax, S[e]); }
    } else {
#pragma unroll
        for (int e = 0; e < 16; ++e) cmax = fmaxf(cmax, S[e]);
    }
    cmax = fmaxf(cmax, xor_f(cmax, 32, lane));
    const float mn = fmaxf(m, cmax), alpha = __builtin_amdgcn_exp2f(m - mn); m = mn;
    float psum = 0.f;
#pragma unroll
    for (int e = 0; e < 16; ++e) { S[e] = __builtin_amdgcn_exp2f(S[e] - mn); psum += S[e]; }
    l = l * alpha + psum;
#pragma unroll
    for (int e = 0; e < 16; ++e) { O[0][e] *= alpha; O[1][e] *= alpha; }
#pragma unroll
    for (int sx = 0; sx < 2; ++sx) {
        u32x4 pw; pw.x = pg8::cvt_pk_bf16(S[8 * sx + 0], S[8 * sx + 1]); pw.y = pg8::cvt_pk_bf16(S[8 * sx + 2], S[8 * sx + 3]); pw.z = pg8::cvt_pk_bf16(S[8 * sx + 4], S[8 * sx + 5]); pw.w = pg8::cvt_pk_bf16(S[8 * sx + 6], S[8 * sx + 7]);
        const bf16x8 pb = __builtin_bit_cast(bf16x8, pw);
#pragma unroll
        for (int dt = 0; dt < 2; ++dt) { LAS const unsigned char* vp = lds + V_OFF + (32 * dt + tl) * VROWB + (s0 + 16 * sx + 4 * hh) * 2;
            const u32x2 lo = *(const LAS u32x2*)vp, hi = *(const LAS u32x2*)(vp + 16); const u32x4 vw = (u32x4){lo.x, lo.y, hi.x, hi.y};
            O[dt] = __builtin_amdgcn_mfma_f32_32x32x16_bf16(__builtin_bit_cast(bf16x8, vw), pb, O[dt], 0, 0, 0); }
    }
}
DEV void attn_phase(LAS unsigned char* lds, bf16_t* P, float* lse2, bf16_t* Y, const float* sink_l, int G, int cblk, int wv) {
    int wv_ = wv, ln_; asm volatile("v_mbcnt_lo_u32_b32 %1, -1, 0\n\tv_mbcnt_hi_u32_b32 %1, -1, %1" : "+s"(wv_), "=v"(ln_)); int tid_ = (wv_ << 6) | ln_;
    const int tid = tid_, w = __builtin_amdgcn_readfirstlane(tid >> 6), lane = tid & 63, tl = lane & 31, hh = lane >> 5;
#pragma unroll 1
    for (int item = cblk; item < N_ITEMS_A + N_ITEMS_C; item += G) {
        int b, dil, ls, r, klo, nsl, R, kcol, vcol, qcol, two = 0, rp = 0, sb = 0, head = 0, isC = 0, nb = 0, qh0 = 0;
        if (item < N_ITEMS_A) { b = item / 96; const int rem = item - b * 96; head = rem >> 3; const int sub = rem & 7, g = head >> 2; R = 64;
            kcol = 768 + head * 64; vcol = 1536 + head * 64; qcol = head * 64;
            if (g == 0) { dil = 1; ls = 2048; r = 0; sb = sub; klo = 256 * sb - 64; nsl = 384; }
            else if (g == 1) { dil = 4; ls = 512; r = sub >> 1; sb = sub & 1; klo = 256 * sb - 64; nsl = 384; }
            else { dil = 16; ls = 128; r = 0; rp = sub; klo = 0; nsl = 256; two = 1; } }
        else { const int it = item - N_ITEMS_A; b = it >> 6; const int rem = it & 63; const int kvh = rem >> 5; nb = (rem & 31) >> 1; const int hp = rem & 1; isC = 1; R = 128;
            dil = 1; ls = 2048; r = 0; klo = 128 * nb - 128; nsl = 384; kcol = 2816 + kvh * 64; vcol = 2944 + kvh * 64; qh0 = kvh * 4 + hp * 2; qcol = 2304 + qh0 * 64; }
        __syncthreads();
        for (int i = tid; i < nsl * 8; i += 512) { const int slot = i >> 3, part = i & 7; int kpos, rr;
            if (two) { kpos = slot & 127; rr = 2 * rp + (slot >> 7); } else { kpos = klo + slot; rr = r; }
            u32x4 kv = (u32x4){0u, 0u, 0u, 0u}, vv = kv;
            if (kpos >= 0 && kpos < ls) { const bf16_t* rowp = P + (size_t)(b * 2048 + kpos * dil + rr) * PW_; kv = *(const u32x4*)(rowp + kcol + part * 8); vv = *(const u32x4*)(rowp + vcol + part * 8); }
            *(LAS u32x4*)(lds + K_OFF + slot * KROWB + part * 16) = kv;
            LAS unsigned short* vt = (LAS unsigned short*)(lds + V_OFF + (part * 8) * VROWB + slot * 2);
            vt[0 * (VROWB / 2)] = (unsigned short)(vv.x & 0xffffu); vt[1 * (VROWB / 2)] = (unsigned short)(vv.x >> 16); vt[2 * (VROWB / 2)] = (unsigned short)(vv.y & 0xffffu); vt[3 * (VROWB / 2)] = (unsigned short)(vv.y >> 16);
            vt[4 * (VROWB / 2)] = (unsigned short)(vv.z & 0xffffu); vt[5 * (VROWB / 2)] = (unsigned short)(vv.z >> 16); vt[6 * (VROWB / 2)] = (unsigned short)(vv.w & 0xffffu); vt[7 * (VROWB / 2)] = (unsigned short)(vv.w >> 16); }
        __syncthreads();
        Band bd; int qtok, rr = r; bd.ls = ls; bd.R = R;
        if (two) { const int half = w >> 2; bd.p_w = 32 * (w & 3); rr = 2 * rp + half; bd.slot_base = half * 128; }
        else if (isC) { bd.p_w = 128 * nb + 32 * (w & 3); bd.slot_base = -klo; }
        else { bd.p_w = 256 * sb + 32 * w; bd.slot_base = -klo; }
        qtok = b * 2048 + (bd.p_w + tl) * dil + rr;
        const int qc = isC ? (qcol + (w >> 2) * 64) : qcol;
        const bf16_t* qp = P + (size_t)qtok * PW_ + qc + 8 * hh;
        bf16x8 qf[4];
#pragma unroll
        for (int ks = 0; ks < 4; ++ks) qf[ks] = *(const bf16x8*)(qp + 16 * ks);
        f32x16 O[2];
#pragma unroll
        for (int e = 0; e < 16; ++e) { O[0][e] = 0.f; O[1][e] = 0.f; }
        float m = -1e30f, l = 0.f;
        const int nch = R / 16 + 1, cd = R / 32;
        chunk<false>(lds, bd, cd, qf, tl, hh, lane, O, m, l);
        chunk<true>(lds, bd, 0, qf, tl, hh, lane, O, m, l); chunk<true>(lds, bd, nch - 1, qf, tl, hh, lane, O, m, l);
#pragma unroll 1
        for (int c = 1; c < nch - 1; ++c) { if (c != cd) chunk<false>(lds, bd, c, qf, tl, hh, lane, O, m, l); }
        float lt = l + xor_f(l, 32, lane), scale;
        if (isC) { const float sk = sink_l[qh0 + (w >> 2)] * LOG2E_; const float mf = fmaxf(m, sk), corr = exp2f(m - mf); lt = lt * corr + exp2f(sk - mf); scale = corr / lt; }
        else { scale = 1.f / lt; if (hh == 0) lse2[(size_t)qtok * 12 + head] = m + log2f(lt); }
        bf16_t* op = isC ? (Y + (size_t)qtok * UYW_ + 768 + (qh0 + (w >> 2)) * 64) : (P + (size_t)qtok * PW_ + qcol);
#pragma unroll
        for (int dt = 0; dt < 2; ++dt)
#pragma unroll
            for (int g4 = 0; g4 < 4; ++g4) { u32x2 pk; pk.x = pg8::cvt_pk_bf16(O[dt][4 * g4] * scale, O[dt][4 * g4 + 1] * scale); pk.y = pg8::cvt_pk_bf16(O[dt][4 * g4 + 2] * scale, O[dt][4 * g4 + 3] * scale);
                *(u32x2*)(op + 32 * dt + 8 * g4 + 4 * hh) = pk; }
    }
    __syncthreads();
}
}

namespace xb {
constexpr int XB_TMO = 128, XB_TOP = 3328, XB_TOPGEN = 3392, XCD_BAR_WORDS = 3456; constexpr unsigned XB_SPIN_CAP = 1u << 22;
DEV constexpr int XB_XCNT(int j) { return 256 + 64 * j; }
DEV constexpr int XB_XSUB(int j) { return 1280 + 64 * j; }
DEV constexpr int XB_XGEN(int j) { return 2304 + 64 * j; }
DEV unsigned xb_ld(unsigned* p) { return __hip_atomic_load(p, __ATOMIC_RELAXED, __HIP_MEMORY_SCOPE_AGENT); }
DEV unsigned xb_add(unsigned* p, unsigned v) { return __hip_atomic_fetch_add(p, v, __ATOMIC_RELAXED, __HIP_MEMORY_SCOPE_AGENT); }
DEV unsigned xb_xcc_id() { return (unsigned)__builtin_amdgcn_s_getreg((3 << 11) | 20) & 0xFu; }
#define XB_SPIN(cond, bar) do { unsigned _sp = 0; while (cond) { __builtin_amdgcn_s_sleep(1); \
    if ((++_sp & 255u) == 0u) { if (xb_ld(&(bar)[XB_TMO])) break; if (_sp > XB_SPIN_CAP) { atomicAdd(&(bar)[XB_TMO], 1u); break; } } } } while (0)
struct XcdBarrier { unsigned* bar; unsigned x; volatile LAS unsigned* st; };
DEV XcdBarrier xcd_barrier_post(unsigned* bar, volatile LAS unsigned* st) { XcdBarrier b; b.bar = bar; b.x = xb_xcc_id(); b.st = st; if (threadIdx.x == 0) (void)xb_add(&bar[XB_XCNT(b.x)], 1u); return b; }
DEV void xcd_barrier_complete(unsigned* bar, unsigned x, unsigned& nloc, unsigned& nx) {
    const unsigned G = gridDim.x * gridDim.y * gridDim.z; unsigned sum, cnt, mine, sp = 0u;
    for (;;) { sum = 0u; cnt = 0u; mine = 0u;
#pragma unroll
        for (unsigned j = 0; j < 16; ++j) { const unsigned c = xb_ld(&bar[XB_XCNT(j)]); sum += c; cnt += (c > 0u) ? 1u : 0u; mine = (j == x) ? c : mine; }
        if (sum == G) break;
        __builtin_amdgcn_s_sleep(1);
        if ((++sp & 255u) == 0u) { if (xb_ld(&bar[XB_TMO])) break; if (sp > XB_SPIN_CAP) { atomicAdd(&bar[XB_TMO], 1u); break; } } }
    nloc = mine > 0u ? mine : 1u; nx = cnt > 0u ? cnt : 1u;
}
DEV void xcd_barrier(const XcdBarrier& b, int wv) {
    asm volatile("s_waitcnt vmcnt(0)" ::: "memory");
    __syncthreads();
    int ln0_; asm volatile("v_mbcnt_lo_u32_b32 %0, -1, 0\n\tv_mbcnt_hi_u32_b32 %0, -1, %0" : "=v"(ln0_));
    if (wv == 0 && ln0_ == 0) {
        unsigned* bar = b.bar; asm volatile("" : "+s"(bar));
        unsigned bx = xb_xcc_id(); asm volatile("" : "+s"(bx));
        __builtin_amdgcn_s_waitcnt(0);
        unsigned nloc = b.st[0], nx = b.st[1];
        if (nloc == 0u) { xcd_barrier_complete(bar, bx, nloc, nx); b.st[0] = nloc; b.st[1] = nx; }
        const unsigned old = xb_add(&bar[XB_XSUB(bx)], 1u); const unsigned gen = old / nloc;
        if (old + 1u == (gen + 1u) * nloc) {
            __builtin_amdgcn_fence(__ATOMIC_RELEASE, "agent");
            asm volatile("s_waitcnt vmcnt(0)" ::: "memory");
            const unsigned og = xb_add(&bar[XB_TOP], 1u); const unsigned tg = og / nx;
            if (og + 1u == (tg + 1u) * nx) xb_add(&bar[XB_TOPGEN], 1u);
            else XB_SPIN(xb_ld(&bar[XB_TOPGEN]) == tg, bar);
            __builtin_amdgcn_fence(__ATOMIC_ACQUIRE, "agent");
            xb_add(&bar[XB_XGEN(bx)], 1u);
            asm volatile("s_waitcnt vmcnt(0)" ::: "memory");
        } else {
            XB_SPIN(xb_ld(&bar[XB_XGEN(bx)]) == gen, bar);
            __builtin_amdgcn_fence(__ATOMIC_ACQUIRE, "agent");
            asm volatile("s_waitcnt vmcnt(0)" ::: "memory");
        }
    }
    __syncthreads();
}
}

namespace misc {
DEV void ada_phase(LAS unsigned char* lds, const float* __restrict__ c, const float* __restrict__ w_ada, const float* __restrict__ b_ada, float* __restrict__ ada, int G, int cblk, int wv) {
    int wv_ = wv, ln_; asm volatile("v_mbcnt_lo_u32_b32 %1, -1, 0\n\tv_mbcnt_hi_u32_b32 %1, -1, %1" : "+s"(wv_), "=v"(ln_)); int tid_ = (wv_ << 6) | ln_; const int tid = tid_, col = tid & 63, kg = tid >> 6;
    LAS float* cond = (LAS float*)lds;
    LAS float* part = (LAS float*)(lds + 65536);
    for (int i = tid; i < 16384; i += 512) { const float v = c[i]; cond[i] = v / (1.f + __expf(-v)); }
    __syncthreads();
#pragma unroll 1
    for (int item = cblk; item < 192; item += G) { const int l = item / 96, n0 = (item - l * 96) * 64;
        float acc[16];
#pragma unroll
        for (int b = 0; b < 16; ++b) acc[b] = 0.f;
        const float* wp = w_ada + ((size_t)l * 1024 + kg * 128) * 6144 + n0 + col;
#pragma unroll 2
        for (int kk = 0; kk < 128; kk += 8) { float wv[8];
#pragma unroll
            for (int j = 0; j < 8; ++j) wv[j] = wp[(size_t)(kk + j) * 6144];
#pragma unroll
            for (int b = 0; b < 16; ++b) { const f32x4 c0 = *(const LAS f32x4*)(cond + b * 1024 + kg * 128 + kk), c1 = *(const LAS f32x4*)(cond + b * 1024 + kg * 128 + kk + 4);
                acc[b] += (c0[0] * wv[0] + c0[1] * wv[1]) + (c0[2] * wv[2] + c0[3] * wv[3]) + (c1[0] * wv[4] + c1[1] * wv[5]) + (c1[2] * wv[6] + c1[3] * wv[7]); } }
#pragma unroll
        for (int b = 0; b < 16; ++b) part[(kg * 16 + b) * 64 + col] = acc[b];
        __syncthreads();
        for (int o = tid; o < 1024; o += 512) { const int b = o >> 6, cc = o & 63; float sacc = b_ada[l * 6144 + n0 + cc];
#pragma unroll
            for (int g8 = 0; g8 < 8; ++g8) sacc += part[(g8 * 16 + b) * 64 + cc];
            ada[((size_t)l * 16 + b) * 6144 + n0 + cc] = sacc; }
        __syncthreads();
    }
}
DEV void yprep_phase(LAS unsigned char* lds, const bf16_t* __restrict__ hyT, const bf16_t* P, const float* __restrict__ lse2, bf16_t* Y, int G, int cblk, int wv) {
    int wv_ = wv, ln_; asm volatile("v_mbcnt_lo_u32_b32 %1, -1, 0\n\tv_mbcnt_hi_u32_b32 %1, -1, %1" : "+s"(wv_), "=v"(ln_)); int tid_ = (wv_ << 6) | ln_; const int tid = tid_;
    LAS unsigned short* tile = (LAS unsigned short*)lds;
#pragma unroll 1
    for (int it = cblk; it < 4096; it += G) { const int t0 = (it >> 3) * 64, c0 = (it & 7) * 64;
        __syncthreads();
        { const int cc = tid >> 3, seg = (tid & 7) * 8; const u32x4 v = *(const u32x4*)(hyT + (size_t)(c0 + cc) * T_ + t0 + seg); *(LAS u32x4*)(tile + cc * 72 + seg) = v; }
        __syncthreads();
        { const int tt = tid >> 3, seg = (tid & 7) * 8; unsigned wv[4];
#pragma unroll
            for (int e = 0; e < 4; ++e) wv[e] = (unsigned)tile[(seg + 2 * e) * 72 + tt] | ((unsigned)tile[(seg + 2 * e + 1) * 72 + tt] << 16);
            *(u32x4*)(Y + (size_t)(t0 + tt) * UYW_ + 256 + c0 + seg) = (u32x4){wv[0], wv[1], wv[2], wv[3]}; }
    }
#pragma unroll 1
    for (size_t idx = (size_t)cblk * 512 + tid; idx < (size_t)T_ * 32; idx += (size_t)G * 512) { const size_t tok = idx >> 5; const int c8 = (int)(idx & 31) * 8, hh = c8 >> 6;
        const float l0 = lse2[tok * 12 + hh], l1 = lse2[tok * 12 + 4 + hh], l2 = lse2[tok * 12 + 8 + hh]; const float mx = fmaxf(l0, fmaxf(l1, l2));
        float w0 = exp2f(l0 - mx), w1 = exp2f(l1 - mx), w2 = exp2f(l2 - mx); const float inv = 1.f / (w0 + w1 + w2); w0 *= inv; w1 *= inv; w2 *= inv;
        const bf16_t* pr = P + tok * PW_ + c8; const u32x4 a = *(const u32x4*)pr, b = *(const u32x4*)(pr + 256), c = *(const u32x4*)(pr + 512);
        const unsigned aw[4] = {a.x, a.y, a.z, a.w}, bw[4] = {b.x, b.y, b.z, b.w}, cw[4] = {c.x, c.y, c.z, c.w}; unsigned o[4];
#pragma unroll
        for (int e = 0; e < 4; ++e) { const float lo = w0 * __uint_as_float(aw[e] << 16) + w1 * __uint_as_float(bw[e] << 16) + w2 * __uint_as_float(cw[e] << 16);
            const float hi = w0 * __uint_as_float(aw[e] & 0xffff0000u) + w1 * __uint_as_float(bw[e] & 0xffff0000u) + w2 * __uint_as_float(cw[e] & 0xffff0000u); o[e] = pg8::cvt_pk_bf16(lo, hi); }
        *(u32x4*)(Y + tok * UYW_ + c8) = (u32x4){o[0], o[1], o[2], o[3]}; }
    __syncthreads();
}
DEV void filt_phase(LAS unsigned char* lds, const float* __restrict__ h2, const float* __restrict__ w3, const float* __restrict__ log_decay, bf16_t* __restrict__ Gr, int G, int cblk, int wv) {
    int wv_ = wv, ln_; asm volatile("v_mbcnt_lo_u32_b32 %1, -1, 0\n\tv_mbcnt_hi_u32_b32 %1, -1, %1" : "+s"(wv_), "=v"(ln_)); const int tid = (wv_ << 6) | ln_, lane = ln_;
    LAS float* hrow = (LAS float*)lds;
    LAS float* w3s = (LAS float*)(lds + 512 * 68 * 4);
    LAS float* dec = w3s + 1024;
    LAS float* red = dec + 16;
#pragma unroll 1
    for (int item = cblk; item < 256; item += G) { const int l = item >> 7, o = (item >> 6) & 1, cg = item & 63; const int colf0 = o * 512 + cg * 8;
        __syncthreads();
        for (int i = tid; i < 1024; i += 512) { const int jj = i >> 4, c16 = i & 15; const int col = (c16 < 8) ? colf0 + c16 : 1024 + colf0 + (c16 - 8); w3s[i] = w3[((size_t)l * 64 + jj) * 2048 + col]; }
        if (tid < 16) { const int col = (tid < 8) ? colf0 + tid : 1024 + colf0 + (tid - 8); dec[tid] = __expf(log_decay[l * 2048 + col]); }
        float vals[4][16];
#pragma unroll
        for (int ch = 0; ch < 4; ++ch) {
            __syncthreads();
            { const float* src = h2 + ((size_t)l * 2048 + ch * 512) * 64;
#pragma unroll 4
                for (int k = 0; k < 16; ++k) { const int idx = tid + 512 * k; const int row = idx >> 4, c4 = idx & 15; *(LAS f32x4*)(hrow + row * 68 + c4 * 4) = *(const f32x4*)(src + (size_t)idx * 4); } }
            __syncthreads();
            float acc[16];
#pragma unroll
            for (int c = 0; c < 16; ++c) acc[c] = 0.f;
#pragma unroll 2
            for (int j4 = 0; j4 < 16; ++j4) { const f32x4 hv = *(const LAS f32x4*)(hrow + tid * 68 + j4 * 4); const float hh4[4] = {hv.x, hv.y, hv.z, hv.w};
#pragma unroll
                for (int e = 0; e < 4; ++e) { const LAS f32x4* wr = (const LAS f32x4*)(w3s + (j4 * 4 + e) * 16); const f32x4 w0 = wr[0], w1 = wr[1], w2 = wr[2], w3v = wr[3];
                    acc[0] += hh4[e] * w0.x; acc[1] += hh4[e] * w0.y; acc[2] += hh4[e] * w0.z; acc[3] += hh4[e] * w0.w; acc[4] += hh4[e] * w1.x; acc[5] += hh4[e] * w1.y; acc[6] += hh4[e] * w1.z; acc[7] += hh4[e] * w1.w;
                    acc[8] += hh4[e] * w2.x; acc[9] += hh4[e] * w2.y; acc[10] += hh4[e] * w2.z; acc[11] += hh4[e] * w2.w; acc[12] += hh4[e] * w3v.x; acc[13] += hh4[e] * w3v.y; acc[14] += hh4[e] * w3v.z; acc[15] += hh4[e] * w3v.w; } }
            const float tn = (float)(ch * 512 + tid) * (1.f / 2047.f);
#pragma unroll
            for (int c = 0; c < 16; ++c) vals[ch][c] = acc[c] * __expf(-tn * dec[c]);
        }
        float ss[8];
#pragma unroll
        for (int c = 0; c < 8; ++c) { float a = 0.f;
#pragma unroll
            for (int ch = 0; ch < 4; ++ch) { a += vals[ch][c] * vals[ch][c]; if (ch > 0 || tid > 0) a += vals[ch][8 + c] * vals[ch][8 + c]; }
            ss[c] = peer::wave_sum(a, lane); }
        if (lane == 0) {
#pragma unroll
            for (int c = 0; c < 8; ++c) red[wv_ * 8 + c] = ss[c]; }
        __syncthreads();
        float scale[8];
#pragma unroll
        for (int c = 0; c < 8; ++c) { float a = 0.f;
#pragma unroll
            for (int g8 = 0; g8 < 8; ++g8) a += red[g8 * 8 + c];
            scale[c] = rsqrtf(a + 1e-12f); }
#pragma unroll
        for (int c = 0; c < 8; ++c) { bf16_t* gp = Gr + (((size_t)l * 2 + o) * 512 + cg * 8 + c) * 4096;
#pragma unroll
            for (int ch = 0; ch < 4; ++ch) { const int t = ch * 512 + tid; gp[2047 - t] = f2bf(vals[ch][c] * scale[c]); if (t > 0) gp[2047 + t] = f2bf(vals[ch][8 + c] * scale[c]); }
            if (tid == 0) gp[4095] = 0; }
    }
    __syncthreads();
}
DEV void modulate_phase(const float* __restrict__ x, const float* __restrict__ ada0, bf16_t* UY, float* __restrict__ su, int G, int cblk, int wv) {
    int wv_ = wv, ln_; asm volatile("v_mbcnt_lo_u32_b32 %1, -1, 0\n\tv_mbcnt_hi_u32_b32 %1, -1, %1" : "+s"(wv_), "=v"(ln_)); const int lane = ln_, w = wv_; const int d0 = 16 * lane;
#pragma unroll 1
    for (int tok0 = cblk * 8 + w; tok0 < T_; tok0 += 4 * G * 8) { float4 xv[4][4];
#pragma unroll
        for (int tt = 0; tt < 4; ++tt) { const int tk = tok0 + tt * G * 8; const float* xr = x + (size_t)(tk < T_ ? tk : tok0) * 1024 + d0;
#pragma unroll
            for (int j = 0; j < 4; ++j) xv[tt][j] = *(const float4*)(xr + 4 * j); }
#pragma unroll
        for (int tt = 0; tt < 4; ++tt) { const int tok = tok0 + tt * G * 8; const float* a = ada0 + (size_t)((tok < T_ ? tok : tok0) >> 11) * 6144; float u[16]; float um = 0.f;
#pragma unroll
            for (int j = 0; j < 16; j += 4) { const float4 xq = xv[tt][j >> 2], sc = *(const float4*)(a + 1024 + d0 + j), sh = *(const float4*)(a + d0 + j);
                u[j] = xq.x * (1.f + sc.x) + sh.x; u[j + 1] = xq.y * (1.f + sc.y) + sh.y; u[j + 2] = xq.z * (1.f + sc.z) + sh.z; u[j + 3] = xq.w * (1.f + sc.w) + sh.w;
                um = fmaxf(um, fmaxf(fmaxf(fabsf(u[j]), fabsf(u[j + 1])), fmaxf(fabsf(u[j + 2]), fabsf(u[j + 3])))); }
            um = peer::wave_max(um, lane); const float qs = (um > 0.f) ? 127.f / um : 0.f; unsigned o[4];
#pragma unroll
            for (int e = 0; e < 4; ++e) { o[e] = 0u;
#pragma unroll
                for (int j = 0; j < 4; ++j) o[e] |= ((unsigned)(int)rintf(u[4 * e + j] * qs) & 0xffu) << (8 * j); }
            if (tok < T_) { *(u32x4*)((unsigned char*)(UY + (size_t)tok * UYW_) + d0) = (u32x4){o[0], o[1], o[2], o[3]};
                if (lane == 0) su[tok] = um * (1.f / 127.f); } } }
}
DEV void lnmod_phase(bf16_t* hx, const float* __restrict__ ada_l, const float* __restrict__ g, const float* __restrict__ bta, bf16_t* UY, int G, int cblk, int wv) {
    int wv_ = wv, ln_; asm volatile("v_mbcnt_lo_u32_b32 %1, -1, 0\n\tv_mbcnt_hi_u32_b32 %1, -1, %1" : "+s"(wv_), "=v"(ln_)); const int lane = ln_, w = wv_; const int d0 = 16 * lane;
#pragma unroll 1
    for (int tok0 = cblk * 8 + w; tok0 < T_; tok0 += 2 * G * 8) { u32x4 q[2][2]; const int tok1 = tok0 + G * 8; const bool two = tok1 < T_;
        q[0][0] = *(const u32x4*)(hx + (size_t)tok0 * 1024 + d0); q[0][1] = *(const u32x4*)(hx + (size_t)tok0 * 1024 + d0 + 8);
        q[1][0] = q[0][0]; q[1][1] = q[0][1]; if (two) { q[1][0] = *(const u32x4*)(hx + (size_t)tok1 * 1024 + d0); q[1][1] = *(const u32x4*)(hx + (size_t)tok1 * 1024 + d0 + 8); }
#pragma unroll
        for (int t = 0; t < 2; ++t) { const int tok = t ? tok1 : tok0; float hv[16]; float s = 0.f;
#pragma unroll
            for (int j = 0; j < 2; ++j) { const u32x4 v = q[t][j]; hv[8 * j] = __uint_as_float(v.x << 16); hv[8 * j + 1] = __uint_as_float(v.x & 0xffff0000u); hv[8 * j + 2] = __uint_as_float(v.y << 16); hv[8 * j + 3] = __uint_as_float(v.y & 0xffff0000u);
                hv[8 * j + 4] = __uint_as_float(v.z << 16); hv[8 * j + 5] = __uint_as_float(v.z & 0xffff0000u); hv[8 * j + 6] = __uint_as_float(v.w << 16); hv[8 * j + 7] = __uint_as_float(v.w & 0xffff0000u); }
#pragma unroll
            for (int j = 0; j < 16; j += 4) s += (hv[j] + hv[j + 1]) + (hv[j + 2] + hv[j + 3]);
            const float mu = peer::wave_sum(s, lane) * (1.f / 1024.f); float qq = 0.f;
#pragma unroll
            for (int j = 0; j < 16; ++j) { const float dd = hv[j] - mu; qq += dd * dd; }
            const float rstd = rsqrtf(peer::wave_sum(qq, lane) * (1.f / 1024.f) + LN_EPS_);
            const float* a = ada_l + (size_t)(tok >> 11) * 6144; float y[16], uu[16];
#pragma unroll
            for (int j = 0; j < 16; j += 4) { const float4 gg = *(const float4*)(g + d0 + j), bb = *(const float4*)(bta + d0 + j), sc = *(const float4*)(a + 4096 + d0 + j), sh = *(const float4*)(a + 3072 + d0 + j);
                y[j] = (hv[j] - mu) * rstd * gg.x + bb.x; y[j + 1] = (hv[j + 1] - mu) * rstd * gg.y + bb.y; y[j + 2] = (hv[j + 2] - mu) * rstd * gg.z + bb.z; y[j + 3] = (hv[j + 3] - mu) * rstd * gg.w + bb.w;
                uu[j] = y[j] * (1.f + sc.x) + sh.x; uu[j + 1] = y[j + 1] * (1.f + sc.y) + sh.y; uu[j + 2] = y[j + 2] * (1.f + sc.z) + sh.z; uu[j + 3] = y[j + 3] * (1.f + sc.w) + sh.w; }
            if (t == 0 || two) { u32x4 q0, q1, p0, p1;
                q0.x = pg8::cvt_pk_bf16(y[0], y[1]); q0.y = pg8::cvt_pk_bf16(y[2], y[3]); q0.z = pg8::cvt_pk_bf16(y[4], y[5]); q0.w = pg8::cvt_pk_bf16(y[6], y[7]);
                q1.x = pg8::cvt_pk_bf16(y[8], y[9]); q1.y = pg8::cvt_pk_bf16(y[10], y[11]); q1.z = pg8::cvt_pk_bf16(y[12], y[13]); q1.w = pg8::cvt_pk_bf16(y[14], y[15]);
                p0.x = pg8::cvt_pk_bf16(uu[0], uu[1]); p0.y = pg8::cvt_pk_bf16(uu[2], uu[3]); p0.z = pg8::cvt_pk_bf16(uu[4], uu[5]); p0.w = pg8::cvt_pk_bf16(uu[6], uu[7]);
                p1.x = pg8::cvt_pk_bf16(uu[8], uu[9]); p1.y = pg8::cvt_pk_bf16(uu[10], uu[11]); p1.z = pg8::cvt_pk_bf16(uu[12], uu[13]); p1.w = pg8::cvt_pk_bf16(uu[14], uu[15]);
                bf16_t* xo = hx + (size_t)tok * 1024 + d0; *(u32x4*)xo = q0; *(u32x4*)(xo + 8) = q1; bf16_t* up = UY + (size_t)tok * UYW_ + d0; *(u32x4*)up = p0; *(u32x4*)(up + 8) = p1; } }
    }
}
}

struct Params {
    const float *x, *c, *w_ada, *b_ada, *w_in, *conv_w, *conv_b, *hy_w1, *hy_b1, *hy_w2, *hy_b2, *hy_w3, *hy_freq, *hy_ld, *hy_bias, *attn_sink, *wba, *wbb, *wbc, *w_out, *ln_g, *ln_b,
        *peer_wq, *peer_keys, *peer_u, *peer_v;
    float* out; char* ws;
};
constexpr int LDS_PHASE = 148480;
constexpr int LDS_BYTES = LDS_PHASE + 16;
constexpr size_t OFF_BAR = OFF_LSE + 1792 * 1024;

#define RUN(nvb, call) do { const int wv = wave_s; int wv_ = wv, ln_; asm volatile("v_mbcnt_lo_u32_b32 %1, -1, 0\n\tv_mbcnt_hi_u32_b32 %1, -1, %1" : "+s"(wv_), "=v"(ln_)); int tid_ = (wv_ << 6) | ln_; const int t = tid_ & 255, sub = tid_ >> 8; unsigned char* sm = lds + sub * 16384; \
        for (int vb = (int)blockIdx.x * 2 + sub; vb < (nvb); vb += (int)gridDim.x * 2) { call; __syncthreads(); } } while (0)
#define GSYNC_CG() do { __builtin_amdgcn_sched_barrier(0); grid.sync(); __builtin_amdgcn_sched_barrier(0); } while (0)
#define GSYNC() do { __builtin_amdgcn_sched_barrier(0); xb::xcd_barrier(xbar, wave_s); __builtin_amdgcn_sched_barrier(0); } while (0)

__global__ void __launch_bounds__(512, 2) mega(Params p) {
    extern __shared__ __attribute__((aligned(16))) unsigned char lds[];
    cg::grid_group grid = cg::this_grid();
    LAS unsigned char* ldsl = (LAS unsigned char*)lds;
    const int G = gridDim.x, cblk = blockIdx.x;
    const int wave_s = __builtin_amdgcn_readfirstlane((int)threadIdx.x >> 6);
    float* out = p.out; (void)out;
    if (threadIdx.x < 4) ((LAS unsigned*)(ldsl + LDS_PHASE))[threadIdx.x] = 0u;
    __syncthreads();
    const xb::XcdBarrier xbar = xb::xcd_barrier_post((unsigned*)(p.ws + OFF_BAR), (volatile LAS unsigned*)(ldsl + LDS_PHASE));
    {
    char* ws = p.ws;
    float* ada = (float*)(ws + OFF_ADA); float2* rope = (float2*)(ws + OFF_ROPE); bf16_t* Gr = (bf16_t*)(ws + OFF_GR); float* lse2 = (float*)(ws + OFF_LSE);
    unsigned char* WinT8 = (unsigned char*)(ws + OFF_WINT); unsigned char* WmT8 = (unsigned char*)(ws + OFF_WMT); float* su = (float*)(ws + OFF_LSE + 1536 * 1024); float* winv = (float*)(ws + OFF_LSE + 1664 * 1024);     bf16_t* WoutT = (bf16_t*)(ws + OFF_WOUTT); bf16_t* WqT = (bf16_t*)(ws + OFF_WQT);
    bf16_t* UY = (bf16_t*)(ws + OFF_UY); bf16_t* Y = UY + 1024; bf16_t* P = (bf16_t*)(ws + OFF_P); bf16_t* hyT = (bf16_t*)(ws + OFF_HYT);
    bf16_t* merged = (bf16_t*)(ws + OFF_P); bf16_t* gtmp = (bf16_t*)(ws + OFF_P + 64 * MB_); bf16_t* Q2 = (bf16_t*)(ws + OFF_P); bf16_t* x1b = (bf16_t*)(ws + OFF_P + 128 * MB_);
    int* eidx = (int*)(ws + OFF_HYT); float* egate = (float*)(ws + OFF_HYT + 16 * MB_); unsigned char* U8 = (unsigned char*)(ws + OFF_HYT + 32 * MB_); unsigned char* V4 = (unsigned char*)(ws + OFF_HYT + 48 * MB_); float* sinv = (float*)(ws + OFF_HYT + 64 * MB_);
    float* h2 = (float*)(ws + OFF_P);
    (void)lse2; (void)P; (void)hyT; (void)merged; (void)gtmp; (void)Q2; (void)x1b; (void)eidx; (void)egate; (void)U8; (void)V4; (void)sinv; (void)Y;

    misc::ada_phase(ldsl, p.c, p.w_ada, p.b_ada, ada, G, cblk, wave_s);
    RUN(256, nb_rope(vb, t, sm, rope));
    RUN(1024, nb_filt_h2(vb, t, sm, p.hy_w1, p.hy_b1, p.hy_w2, p.hy_b2, p.hy_freq, h2));
    winprep_phase(ldsl, p.w_in, WinT8, WmT8, winv, G, cblk, wave_s);
    { const WPrep wq{p.w_in, p.wba, p.wbb, p.wbc, p.w_out, p.peer_wq, WinT8, WmT8, WoutT, WqT}; RUN(2176, nb_wprep(vb, t, sm, wq)); }
    GSYNC();
    misc::filt_phase(ldsl, h2, p.hy_w3, p.hy_ld, Gr, G, cblk, wave_s);
    misc::modulate_phase(p.x, ada, UY, su, G, cblk, wave_s);
    GSYNC();
    }
#pragma unroll 1
    for (int l = 0; l < 2; ++l) {
        size_t zoff = 0; asm volatile("" : "+s"(zoff));
        char* ws = p.ws + zoff; float* out = p.out + zoff;
        int Gl = gridDim.x, cl = blockIdx.x; asm volatile("" : "+s"(Gl), "+s"(cl));
        float* ada = (float*)(ws + OFF_ADA); float2* rope = (float2*)(ws + OFF_ROPE); bf16_t* Gr = (bf16_t*)(ws + OFF_GR); float* lse2 = (float*)(ws + OFF_LSE);
        unsigned char* WinT8 = (unsigned char*)(ws + OFF_WINT); unsigned char* WmT8 = (unsigned char*)(ws + OFF_WMT); float* su = (float*)(ws + OFF_LSE + 1536 * 1024); float* winv = (float*)(ws + OFF_LSE + 1664 * 1024);     bf16_t* WoutT = (bf16_t*)(ws + OFF_WOUTT); bf16_t* WqT = (bf16_t*)(ws + OFF_WQT);
        bf16_t* UY = (bf16_t*)(ws + OFF_UY); bf16_t* Y = UY + 1024; bf16_t* P = (bf16_t*)(ws + OFF_P); bf16_t* hyT = (bf16_t*)(ws + OFF_HYT);
        bf16_t* merged = (bf16_t*)(ws + OFF_P); bf16_t* gtmp = (bf16_t*)(ws + OFF_P + 64 * MB_); bf16_t* Q2 = (bf16_t*)(ws + OFF_P); bf16_t* x1b = (bf16_t*)(ws + OFF_P + 128 * MB_);
        int* eidx = (int*)(ws + OFF_HYT); float* egate = (float*)(ws + OFF_HYT + 16 * MB_); unsigned char* U8 = (unsigned char*)(ws + OFF_HYT + 32 * MB_); unsigned char* V4 = (unsigned char*)(ws + OFF_HYT + 48 * MB_); float* sinv = (float*)(ws + OFF_HYT + 64 * MB_);
        const float* ada_l = ada + (size_t)l * 16 * 6144;
        const unsigned char* WinT8_l = WinT8 + (size_t)l * 4608 * 1024;
        {
            const pg8::PlainSched S1{UY, (const bf16_t*)WinT8_l, UYW_, 512, 128, 12, 8, Gl, cl, 0, 1 << 30}; const pg8::EpiP E1{P, rope, su, winv + (size_t)l * 7680};
            pg8::gemm_phase<pg8::EpiP, pg8::PlainSched, true, true, 1>(ldsl, UYW_, 512, S1, E1, wave_s);
            const pg8::PlainSched S2{(const bf16_t*)(WinT8_l + (size_t)3072 * 1024), UY, 512, UYW_, 6, 128, 8, Gl, cl, 0, 1 << 30}; const pg8::EpiHyT8 E2{hyT, su, winv + (size_t)l * 7680 + 3072};
            pg8::gemm_phase<pg8::EpiHyT8, pg8::PlainSched, true, true, 1>(ldsl, 512, UYW_, S2, E2, wave_s);
        }
        GSYNC();
        at::attn_phase(ldsl, P, lse2, Y, p.attn_sink + l * 8, Gl, cl, wave_s);
        hy::hyena_phase(ldsl, hyT, Gr + (size_t)l * 2 * 512 * 4096, p.conv_w + (size_t)l * 3 * 1536, p.conv_b + (size_t)l * 1536, p.hy_bias + (size_t)l * 1024, Gl, cl, wave_s);
        GSYNC();
        misc::yprep_phase(ldsl, hyT, P, lse2, Y, Gl, cl, wave_s);
        GSYNC();
        {
            const unsigned char* WmT8_l = WmT8 + (size_t)l * 1024 * (WMW_ * 2);
            static_assert(OFF_P + 192 * MB_ == OFF_HYT, "gate buffers");
            const pg8::GateSched Sg{UY, WmT8_l, Gl, cl}; const pg8::EpiGate Eg{gtmp, su, winv + (size_t)l * 7680 + 4608};
            pg8::gemm_phase<pg8::EpiGate, pg8::GateSched, true, true, 1>(ldsl, UYW_, WMW_, Sg, Eg, wave_s);
            const pg8::Branch3Sched Sb{UY, WmT8_l, Gl, cl}; const pg8::EpiBranch3 Eb{gtmp, merged};
            pg8::gemm_phase<pg8::EpiBranch3, pg8::Branch3Sched, true, true, 0>(ldsl, UYW_, WMW_, Sb, Eb, wave_s);
        }
        GSYNC();
        {
            const pg8::PlainSched S{merged, WoutT + (size_t)l * 1024 * 1024, 1024, 1024, 128, 4, 16, Gl, cl, 0, 1 << 30}; const pg8::EpiH E{(l == 0) ? p.x : (const float*)nullptr, (const bf16_t*)out, x1b, ada_l};
            pg8::gemm_phase(ldsl, 1024, 1024, S, E, wave_s);
        }
        RUN(8192, peer::nb_quant_tables(vb, t, p.peer_u + (size_t)l * 16384 * 1024, p.peer_v + (size_t)l * 16384 * 1024, U8, V4, sinv));
        GSYNC();
        misc::lnmod_phase(x1b, ada_l, p.ln_g + (size_t)(l * 2 + 0) * 1024, p.ln_b + (size_t)(l * 2 + 0) * 1024, UY, Gl, cl, wave_s);
        GSYNC();
        {
            const pg8::PlainSched S{UY, WqT + (size_t)l * 2048 * 1024, UYW_, 1024, 128, 8, 16, Gl, cl, 0, 1 << 30}; const pg8::EpiBf E{Q2, 2048, 0};
            pg8::gemm_phase(ldsl, UYW_, 1024, S, E, wave_s);
        }
        GSYNC();
        tk::topk_phase(ldsl, Q2, p.peer_keys + (size_t)l * 8 * 2 * 128 * 128, eidx, egate, Gl, cl, wave_s);
        GSYNC();
        peer::peer_phase(ldsl, x1b, out, (l == 0) ? (bf16_t*)out : (bf16_t*)nullptr, ada_l, eidx, egate, U8, V4, sinv, p.ln_g + (size_t)(l * 2 + 1) * 1024, p.ln_b + (size_t)(l * 2 + 1) * 1024,
                         (l == 0) ? ada + (size_t)16 * 6144 : (const float*)nullptr, UY, su, Gl, cl, wave_s);
        if (l == 0) GSYNC();
    }
}

extern "C" void kernel_launch(void* const* d_in, const int* in_sizes, int n_in, void* d_out, int out_size, void* d_ws, size_t ws_size, hipStream_t stream) {
    static int grid = 0;
    if (grid == 0) {
        if (ws_size < WS_NEED || n_in != 26) { fprintf(stderr, "kernel_launch: workspace %zu < %zu or n_in %d != 26\n", ws_size, (size_t)WS_NEED, n_in); grid = -1; return; }
        int dev = 0, cus = 0, per_cu = 0;
        (void)hipGetDevice(&dev); (void)hipDeviceGetAttribute(&cus, hipDeviceAttributeMultiprocessorCount, dev);
        (void)hipFuncSetAttribute((const void*)mega, hipFuncAttributeMaxDynamicSharedMemorySize, LDS_BYTES);
        (void)hipOccupancyMaxActiveBlocksPerMultiprocessor(&per_cu, (const void*)mega, 512, LDS_BYTES);
        if (per_cu < 1) { fprintf(stderr, "kernel_launch: occupancy query says %d blocks per CU\n", per_cu); grid = -1; return; }
        if (cus != 256) { fprintf(stderr, "kernel_launch: built for a 256-CU device (work partitions and the XCD barrier assume 256 workgroups), found %d CUs\n", cus); grid = -1; return; }
        grid = cus;
    }
    if (grid < 0) return;
    Params p{};
    const float** pp = (const float**)&p;
    for (int i = 0; i < 26; ++i) pp[i] = (const float*)d_in[i];
    p.out = (float*)d_out; p.ws = (char*)d_ws;
    (void)hipMemsetAsync((char*)d_ws + OFF_BAR, 0, 16384, stream);
    void* args[] = {&p};
    hipError_t e = hipLaunchCooperativeKernel((const void*)mega, dim3(grid), dim3(512), args, LDS_BYTES, stream);
    if (e != hipSuccess) fprintf(stderr, "cooperative launch failed: %s (grid %d)\n", hipGetErrorString(e), grid);
}
```

```cpp
#include <hip/hip_runtime.h>
#include <hip/hip_cooperative_groups.h>
namespace cg = cooperative_groups;
#include <stdint.h>
#include <stdio.h>

#define DEV __device__ __forceinline__
typedef unsigned short bf16_t;

constexpr int D_ = 1024, B_ = 16, S_ = 2048, T_ = B_ * S_;
constexpr float ALPHA_ = 1.41421356237309515f;
constexpr float LOG2E_ = 1.4426950408889634f;
constexpr float QSCALE_ = 0.125f * 1.4426950408889634f;
constexpr float LN_EPS_ = 1e-5f;
constexpr int PW_ = 3072;
constexpr int UYW_ = 2304;
constexpr int WMW_ = 2816;
constexpr size_t GSTRIDE_ = (size_t)32 * 1024 * 1024;

constexpr size_t MB_ = 1024 * 1024;
constexpr size_t OFF_ADA = 0, OFF_ROPE = 1 * MB_, OFF_GR = 2 * MB_, OFF_LSE = 18 * MB_, OFF_WINT = 20 * MB_, OFF_WMT = 50 * MB_,
                 OFF_WOUTT = 68 * MB_, OFF_WQT = 72 * MB_, OFF_KEYS = 80 * MB_, OFF_UY = 82 * MB_, OFF_P = 226 * MB_, OFF_HYT = 418 * MB_,
                 WS_NEED = 514 * MB_;

DEV int xor_i(int v, int off, int lane) { return __builtin_amdgcn_ds_bpermute((lane ^ off) << 2, v); }
DEV float xor_f(float v, int off, int lane) { return __int_as_float(__builtin_amdgcn_ds_bpermute((lane ^ off) << 2, __float_as_int(v))); }
DEV float bf2f(bf16_t v) { return __uint_as_float(((unsigned)v) << 16); }
DEV bf16_t f2bf(float f) { unsigned u = __float_as_uint(f); u += 0x7FFFu + ((u >> 16) & 1u); return (bf16_t)(u >> 16); }

DEV void nb_rope(int vb, int t, unsigned char* sm, float2* __restrict__ rope) {
    const int idx = vb * 256 + t; const int s = idx >> 5, i = idx & 31;
    const float inv = powf(10000.f, -(float)i / 32.f); const float ang = (float)s * inv;
    rope[idx] = make_float2(cosf(ang), sinf(ang));
}

DEV void nb_filt_h2(int vb, int t, unsigned char* sm, const float* __restrict__ w1, const float* __restrict__ b1, const float* __restrict__ w2, const float* __restrict__ b2,
                                                const float* __restrict__ freq, float* __restrict__ h2) {
    const int grp = t >> 6, j = t & 63; const int lt = vb * 4 + grp; const int l = lt / 2048, tt = lt % 2048;
    float* z = (float*)sm + grp * 128; float* h1 = z + 64;
    if (j < 33) {
        const float idx = (float)tt, tn = idx / 2047.f, w = 6.283185307179586f * idx / 2048.f;
        if (j == 0) z[0] = tn;
        else { const int k = (j <= 16) ? (j - 1) : (j - 17); const float band = 1e-4f + (float)k * ((15.f - 1e-4f) / 15.f); const float ang = w * band;
            z[j] = (j <= 16) ? cosf(ang) : -sinf(ang); }
    }
    __syncthreads();
    float a = b1[l * 64 + j];
    for (int e = 0; e < 33; ++e) a += z[e] * w1[(l * 33 + e) * 64 + j];
    h1[j] = sinf(freq[(l * 2 + 0) * 64 + j] * a);
    __syncthreads();
    float a2 = b2[l * 64 + j];
    for (int i = 0; i < 64; ++i) a2 += h1[i] * w2[(l * 64 + i) * 64 + j];
    h2[((size_t)l * 2048 + tt) * 64 + j] = sinf(freq[(l * 2 + 1) * 64 + j] * a2);
}

#define LAS __attribute__((address_space(3)))
typedef short bf16x8 __attribute__((ext_vector_type(8)));
typedef float f32x4 __attribute__((ext_vector_type(4)));
typedef float f32x2 __attribute__((ext_vector_type(2)));
typedef unsigned u32x4 __attribute__((ext_vector_type(4)));
typedef unsigned u32x2 __attribute__((ext_vector_type(2)));
typedef int i32x8 __attribute__((ext_vector_type(8)));
typedef _Float16 h2 __attribute__((ext_vector_type(2)));
typedef int i32x4 __attribute__((ext_vector_type(4)));
namespace pg8 {
constexpr int BM = 256, BK = 64, HALF = 128, HTB = HALF * BK * 2, STAGE_BYTES = 8 * HTB, NXCD = 8, WGM = 8;
DEV int lds_byte(int r, int c) { const int st = (r >> 4) * 2 + (c >> 5), rr = r & 15, cc = c & 31, ob = rr * 64 + cc * 2; return st * 1024 + (ob ^ (((ob >> 9) & 1) << 5)); }
DEV void stage_rc(int b, int& R, int& C) { const int st = b / 1024, sb = b % 1024, swz = sb ^ (((sb >> 9) & 1) << 5); R = (st >> 1) * 16 + swz / 64; C = (st & 1) * 32 + (swz % 64) / 2; }
DEV int perm32(int rho) { const int n = rho >> 4, i = rho & 15; return 8 * (i >> 2) + 4 * n + (i & 3); }
typedef __bf16 bf16x2_t __attribute__((ext_vector_type(2)));
DEV unsigned cvt_pk_bf16(float lo, float hi) { return __builtin_bit_cast(unsigned, __builtin_convertvector((f32x2){lo, hi}, bf16x2_t)); }

struct Unit { int pm, pn, tag, nt; const char* a; const char* b; };
DEV void tile_of(int L, int nM, int nN, int& pm, int& pn) {
    const int nwg = nM * nN; int wgid = L; { const int q = nwg / NXCD, r = nwg % NXCD, xcd = wgid % NXCD, off = wgid / NXCD; wgid = (xcd < r ? xcd * (q + 1) : r * (q + 1) + (xcd - r) * q) + off; }
    const int nig = WGM * nN, gid = wgid / nig, fm = gid * WGM, gsz = (nM - fm) < WGM ? (nM - fm) : WGM;
    pm = fm + ((wgid % nig) % gsz); pn = (wgid % nig) / gsz;
}
struct PlainSched { const bf16_t* A; const bf16_t* Bt; int lda, ldb, nM, nN, nt, G, c, first, count;
    DEV bool next(int i, Unit& u) const { if (i >= count) return false; const long L = (long)(first + i) * G + c; if (L >= (long)nM * nN) return false; tile_of((int)L, nM, nN, u.pm, u.pn); u.tag = 0; u.nt = nt;
        u.a = (const char*)(A + (size_t)u.pm * BM * lda); u.b = (const char*)(Bt + (size_t)u.pn * BM * ldb); return true; } };

template <class Epi, class Sched, bool SP2 = true, bool ALIGN_EPI = true, int I8 = 0>
DEV void gemm_phase(LAS unsigned char* lds, const int lda, const int ldb, const Sched& S, const Epi& E, const int wv) {
    int wv_ = wv, ln_; asm volatile("v_mbcnt_lo_u32_b32 %1, -1, 0\n\tv_mbcnt_hi_u32_b32 %1, -1, %1" : "+s"(wv_), "=v"(ln_)); int tid_ = (wv_ << 6) | ln_;
    const int tid = tid_, wid = __builtin_amdgcn_readfirstlane(tid >> 6), lane = tid & 63, wr = wid >> 2, wc = wid & 3, fr = lane & 15, fq = lane >> 4;
    unsigned voffA[2], voffB[2];
#pragma unroll
    for (int i = 0; i < 2; ++i) { int R, C; stage_rc(tid * 16 + i * 8192, R, C); const int Rb = Epi::PERM ? ((R & ~31) + perm32(R & 31)) : R;
        voffA[i] = (unsigned)(R * lda + C) * 2u; voffB[i] = (unsigned)(Rb * ldb + C) * 2u; }
    const size_t kstep = (size_t)(BK * 2);
    const size_t hstepA = (size_t)HALF * lda * 2, hstepB = (size_t)HALF * ldb * 2;
    const unsigned ldsw = (unsigned)wid * 1024u;
    const int aoff = lds_byte(wr * 64 + fr, fq * 8), boff = lds_byte(wc * 32 + fr, fq * 8);
#define PG8_SA(b, h) (((b) * 2 + (h)) * HTB)
#define PG8_SB(b, h) ((4 + (b) * 2 + (h)) * HTB)
#define PG8_STAGE(bufoff, gbase, voff) do { _Pragma("unroll") for (int _i = 0; _i < 2; ++_i) \
        __builtin_amdgcn_global_load_lds((const unsigned*)((const char*)(gbase) + (voff)[_i]), (LAS unsigned*)(lds + (bufoff) + ldsw + _i * 8192), 16, 0, 0); } while (0)
#define PG8_LDA(dst, b, h) do { _Pragma("unroll") for (int m = 0; m < 4; ++m) _Pragma("unroll") for (int k = 0; k < 2; ++k) dst[m][k] = *(const LAS bf16x8*)(lds + PG8_SA(b, h) + aoff + m * 2048 + k * 1024); } while (0)
#define PG8_LDB(dst, b, h) do { _Pragma("unroll") for (int n = 0; n < 2; ++n) _Pragma("unroll") for (int k = 0; k < 2; ++k) dst[n][k] = *(const LAS bf16x8*)(lds + PG8_SB(b, h) + boff + n * 2048 + k * 1024); } while (0)
#define PG8_MMA(ai, bj, At, Bt) do { __builtin_amdgcn_s_setprio(1); \
        if (I8 == 1) { _Pragma("unroll") for (int m = 0; m < 4; ++m) _Pragma("unroll") for (int n = 0; n < 2; ++n) _Pragma("unroll") for (int k = 0; k < 2; ++k) \
            acc[ai][bj][m][n] = __builtin_bit_cast(f32x4, __builtin_amdgcn_mfma_i32_16x16x64_i8(__builtin_bit_cast(i32x4, Bt[n][k]), __builtin_bit_cast(i32x4, At[m][k]), __builtin_bit_cast(i32x4, acc[ai][bj][m][n]), 0, 0, 0)); } \
        else { _Pragma("unroll") for (int m = 0; m < 4; ++m) _Pragma("unroll") for (int n = 0; n < 2; ++n) _Pragma("unroll") for (int k = 0; k < 2; ++k) \
            acc[ai][bj][m][n] = __builtin_amdgcn_mfma_f32_16x16x32_bf16(Bt[n][k], At[m][k], acc[ai][bj][m][n], 0, 0, 0); } __builtin_amdgcn_s_setprio(0); } while (0)
#define PG8_WAIT_V(n) asm volatile("s_waitcnt vmcnt(" #n ")" ::: "memory")
#define PG8_WAIT_L(n) asm volatile("s_waitcnt lgkmcnt(" #n ")" ::: "memory")
#define PG8_BAR __builtin_amdgcn_s_barrier()
#define PG8_SCHED __builtin_amdgcn_sched_barrier(0)
    Unit cur, nxt; int ui = 0;
    if (!S.next(0, cur)) return;
    f32x4 acc[2][2][4][2];
#pragma unroll
    for (int a = 0; a < 2; ++a)
#pragma unroll
        for (int b = 0; b < 2; ++b)
#pragma unroll
            for (int m = 0; m < 4; ++m)
#pragma unroll
                for (int n = 0; n < 2; ++n) acc[a][b][m][n] = (f32x4){0.f, 0.f, 0.f, 0.f};
    bf16x8 At[4][2], B0[2][2], B1[2][2];
    const char* cA = cur.a; const char* cB = cur.b;
    if constexpr (SP2) {
        PG8_STAGE(PG8_SB(0, 0), cB, voffB); PG8_STAGE(PG8_SB(0, 1), cB + hstepB, voffB); PG8_STAGE(PG8_SA(0, 0), cA, voffA); PG8_STAGE(PG8_SA(0, 1), cA + hstepA, voffA);
        if (wr == 1) PG8_BAR;
        PG8_WAIT_V(2); PG8_BAR;
        PG8_STAGE(PG8_SB(1, 0), cB + kstep, voffB); PG8_STAGE(PG8_SA(1, 0), cA + kstep, voffA); PG8_STAGE(PG8_SB(1, 1), cB + hstepB + kstep, voffB);
        PG8_WAIT_V(6); PG8_BAR;
    } else {
    PG8_STAGE(PG8_SB(0, 0), cB, voffB); PG8_STAGE(PG8_SA(0, 0), cA, voffA); PG8_STAGE(PG8_SB(0, 1), cB + hstepB, voffB); PG8_STAGE(PG8_SA(0, 1), cA + hstepA, voffA);
    if (wr == 1) PG8_BAR;
    PG8_WAIT_V(4); PG8_BAR;
    PG8_STAGE(PG8_SB(1, 0), cB + kstep, voffB); PG8_STAGE(PG8_SA(1, 0), cA + kstep, voffA); PG8_STAGE(PG8_SB(1, 1), cB + hstepB + kstep, voffB);
    PG8_WAIT_V(6); PG8_BAR;
    }
    for (;;) {
        const bool has_next = S.next(ui + 1, nxt);
        const char* nA = has_next ? nxt.a : cA; const char* nB = has_next ? nxt.b : cB;
        const int nt = cur.nt;
        for (int t = 0; t < nt; t += 2) {
            const bool last = (t == nt - 2);
            const char* a1 = cA + (size_t)(t + 1) * kstep;
            const char* a2 = last ? nA : cA + (size_t)(t + 2) * kstep; const char* b2 = last ? nB : cB + (size_t)(t + 2) * kstep;
            const char* a3 = a2 + kstep; const char* b3 = b2 + kstep;
            if constexpr (SP2) {
            PG8_LDB(B0, 0, 0); PG8_LDB(B1, 0, 1); PG8_SCHED; PG8_LDA(At, 0, 0); PG8_STAGE(PG8_SA(1, 1), a1 + hstepA, voffA);
            PG8_WAIT_V(8); PG8_WAIT_L(0); PG8_BAR; PG8_MMA(0, 0, At, B0); PG8_MMA(0, 1, At, B1); PG8_BAR; PG8_SCHED;
            PG8_LDA(At, 0, 1); PG8_STAGE(PG8_SB(0, 0), b2, voffB); PG8_STAGE(PG8_SB(0, 1), b2 + hstepB, voffB); PG8_STAGE(PG8_SA(0, 0), a2, voffA);
            PG8_WAIT_V(8); PG8_WAIT_L(0); PG8_BAR; PG8_MMA(1, 0, At, B0); PG8_MMA(1, 1, At, B1); PG8_BAR; PG8_SCHED;
            PG8_LDB(B0, 1, 0); PG8_LDB(B1, 1, 1); PG8_SCHED; PG8_LDA(At, 1, 0); PG8_STAGE(PG8_SA(0, 1), a2 + hstepA, voffA);
            PG8_WAIT_V(8); PG8_WAIT_L(0); PG8_BAR; PG8_MMA(0, 0, At, B0); PG8_MMA(0, 1, At, B1); PG8_BAR; PG8_SCHED;
            PG8_LDA(At, 1, 1); PG8_STAGE(PG8_SB(1, 0), b3, voffB); PG8_STAGE(PG8_SB(1, 1), b3 + hstepB, voffB); PG8_STAGE(PG8_SA(1, 0), a3, voffA);
            PG8_WAIT_V(8); PG8_WAIT_L(0); PG8_BAR; PG8_MMA(1, 0, At, B0); PG8_MMA(1, 1, At, B1); PG8_BAR; PG8_SCHED;
            } else {
            PG8_LDB(B0, 0, 0); PG8_SCHED; PG8_LDA(At, 0, 0); PG8_STAGE(PG8_SA(1, 1), a1 + hstepA, voffA);
            PG8_WAIT_L(8); PG8_BAR; PG8_WAIT_L(0); PG8_MMA(0, 0, At, B0); PG8_BAR; PG8_SCHED;
            PG8_LDB(B1, 0, 1); PG8_STAGE(PG8_SB(0, 0), b2, voffB);
            PG8_BAR; PG8_WAIT_L(0); PG8_MMA(0, 1, At, B1); PG8_BAR;
            PG8_LDA(At, 0, 1); PG8_STAGE(PG8_SA(0, 0), a2, voffA);
            PG8_BAR; PG8_WAIT_L(0); PG8_MMA(1, 0, At, B0); PG8_BAR; PG8_SCHED;
            PG8_STAGE(PG8_SB(0, 1), b2 + hstepB, voffB);
            PG8_WAIT_V(6); PG8_BAR; PG8_MMA(1, 1, At, B1); PG8_BAR;
            PG8_LDB(B0, 1, 0); PG8_SCHED; PG8_LDA(At, 1, 0); PG8_STAGE(PG8_SA(0, 1), a2 + hstepA, voffA);
            PG8_WAIT_L(8); PG8_BAR; PG8_WAIT_L(0); PG8_MMA(0, 0, At, B0); PG8_BAR; PG8_SCHED;
            PG8_LDB(B1, 1, 1); PG8_STAGE(PG8_SB(1, 0), b3, voffB);
            PG8_BAR; PG8_WAIT_L(0); PG8_MMA(0, 1, At, B1); PG8_BAR;
            PG8_LDA(At, 1, 1); PG8_STAGE(PG8_SA(1, 0), a3, voffA);
            PG8_BAR; PG8_WAIT_L(0); PG8_MMA(1, 0, At, B0); PG8_BAR; PG8_SCHED;
            PG8_STAGE(PG8_SB(1, 1), b3 + hstepB, voffB);
            PG8_WAIT_V(6); PG8_BAR; PG8_MMA(1, 1, At, B1); PG8_BAR;
            }
        }
        if constexpr (ALIGN_EPI) { if (wr == 0) PG8_BAR; }
        if constexpr (!Epi::AFTER_DRAIN) E(acc, cur, wr, wc, fr, fq);
        if (!has_next) break;
        if constexpr (!Epi::INPLACE)
#pragma unroll
        for (int a = 0; a < 2; ++a)
#pragma unroll
            for (int b = 0; b < 2; ++b)
#pragma unroll
                for (int m = 0; m < 4; ++m)
#pragma unroll
                    for (int n = 0; n < 2; ++n) acc[a][b][m][n] = (f32x4){0.f, 0.f, 0.f, 0.f};
        cur = nxt; cA = nA; cB = nB; ++ui;
        if constexpr (ALIGN_EPI) { if (wr == 1) PG8_BAR; }
    }
    PG8_WAIT_V(0);
    if constexpr (!ALIGN_EPI) { if (wr == 0) PG8_BAR; }
    PG8_BAR;
#undef PG8_SA
#undef PG8_SB
#undef PG8_STAGE
#undef PG8_LDA
#undef PG8_LDB
#undef PG8_MMA
#undef PG8_WAIT_V
#undef PG8_WAIT_L
#undef PG8_BAR
#undef PG8_SCHED
}
struct EpiBf { static constexpr bool PERM = true, AFTER_DRAIN = false, INPLACE = false; bf16_t* O; int ldc; int pad;
    DEV void operator()(const f32x4 (&acc)[2][2][4][2], const Unit& u, int wr, int wc, int fr, int fq) const {
        const int row0 = u.pm * BM + wr * 64 + fr, col0 = u.pn * BM + wc * 32 + 8 * fq;
#pragma unroll
        for (int ai = 0; ai < 2; ++ai)
#pragma unroll
            for (int m = 0; m < 4; ++m) { bf16_t* rowp = O + (size_t)(row0 + ai * HALF + m * 16) * ldc + col0;
#pragma unroll
                for (int bj = 0; bj < 2; ++bj) { const f32x4 v0 = acc[ai][bj][m][0], v1 = acc[ai][bj][m][1];
                    u32x4 w; w.x = cvt_pk_bf16(v0[0], v0[1]); w.y = cvt_pk_bf16(v0[2], v0[3]); w.z = cvt_pk_bf16(v1[0], v1[1]); w.w = cvt_pk_bf16(v1[2], v1[3]);
                    *(u32x4*)(rowp + bj * HALF) = w; } }
    } };
struct EpiHyT8 { static constexpr bool PERM = true, AFTER_DRAIN = false, INPLACE = false; bf16_t* O; const float* su; const float* wi;
    DEV void operator()(const f32x4 (&acc)[2][2][4][2], const Unit& u, int wr, int wc, int fr, int fq) const {
        const int row0 = u.pm * BM + wr * 64 + fr, col0 = u.pn * BM + wc * 32 + 8 * fq;
        f32x4 cs[2][2];
#pragma unroll
        for (int bj = 0; bj < 2; ++bj)
#pragma unroll
            for (int h = 0; h < 2; ++h) cs[bj][h] = *(const f32x4*)(su + col0 + bj * HALF + 4 * h);
#pragma unroll
        for (int ai = 0; ai < 2; ++ai)
#pragma unroll
            for (int m = 0; m < 4; ++m) { bf16_t* rowp = O + (size_t)(row0 + ai * HALF + m * 16) * T_ + col0; const float wr_ = wi[row0 + ai * HALF + m * 16];
#pragma unroll
                for (int bj = 0; bj < 2; ++bj) { const i32x4 i0 = __builtin_bit_cast(i32x4, acc[ai][bj][m][0]), i1 = __builtin_bit_cast(i32x4, acc[ai][bj][m][1]);
                    const f32x4 v0 = (f32x4){(float)i0[0], (float)i0[1], (float)i0[2], (float)i0[3]} * (cs[bj][0] * wr_), v1 = (f32x4){(float)i1[0], (float)i1[1], (float)i1[2], (float)i1[3]} * (cs[bj][1] * wr_);
                    u32x4 w; w.x = cvt_pk_bf16(v0[0], v0[1]); w.y = cvt_pk_bf16(v0[2], v0[3]); w.z = cvt_pk_bf16(v1[0], v1[1]); w.w = cvt_pk_bf16(v1[2], v1[3]);
                    *(u32x4*)(rowp + bj * HALF) = w; } }
    } };
struct EpiP { static constexpr bool PERM = true, AFTER_DRAIN = false, INPLACE = false; bf16_t* P; const float2* rope; const float* su; const float* wi;
    DEV void operator()(const f32x4 (&acc)[2][2][4][2], const Unit& u, int wr, int wc, int fr, int fq) const {
        const int row0 = u.pm * BM + wr * 64 + fr, col0 = u.pn * BM + wc * 32 + 8 * fq; const int g = (wc & 1) * 4 + fq; const int pn = u.pn;
        const bool qs = (pn < 3) || (pn == 9) || (pn == 10);
        const f32x4 w00 = *(const f32x4*)(wi + col0), w01 = *(const f32x4*)(wi + col0 + 4), w10 = *(const f32x4*)(wi + col0 + HALF), w11 = *(const f32x4*)(wi + col0 + HALF + 4);
#pragma unroll
        for (int ai = 0; ai < 2; ++ai)
#pragma unroll
            for (int m = 0; m < 4; ++m) { const int row = row0 + ai * HALF + m * 16; bf16_t* rowp = P + (size_t)row * PW_ + col0; const float rsc = su[row];
                const float4* rp = (const float4*)(rope + (size_t)(row & 2047) * 32 + 4 * g); const float4 cs0 = rp[0], cs1 = rp[1];
                const float cc[4] = {cs0.x, cs0.z, cs1.x, cs1.z}, ss[4] = {cs0.y, cs0.w, cs1.y, cs1.w};
#pragma unroll
                for (int bj = 0; bj < 2; ++bj) { f32x4 v0, v1; { const i32x4 i0 = __builtin_bit_cast(i32x4, acc[ai][bj][m][0]), i1 = __builtin_bit_cast(i32x4, acc[ai][bj][m][1]);
                        v0 = (f32x4){(float)i0[0], (float)i0[1], (float)i0[2], (float)i0[3]} * ((bj ? w10 : w00) * rsc); v1 = (f32x4){(float)i1[0], (float)i1[1], (float)i1[2], (float)i1[3]} * ((bj ? w11 : w01) * rsc); }
                    const bool rp_ = (pn < 6) || (pn == 9) || (pn == 10) || (pn == 11 && bj == 0);
                    if (rp_) {
#pragma unroll
                        for (int j = 0; j < 4; ++j) { const float x1 = v0[j], x2 = v1[j]; float o1 = x1 * cc[j] - x2 * ss[j], o2 = x2 * cc[j] + x1 * ss[j];
                            if (qs) { o1 *= QSCALE_; o2 *= QSCALE_; } v0[j] = o1; v1[j] = o2; } }
                    u32x4 w; w.x = cvt_pk_bf16(v0[0], v0[1]); w.y = cvt_pk_bf16(v0[2], v0[3]); w.z = cvt_pk_bf16(v1[0], v1[1]); w.w = cvt_pk_bf16(v1[2], v1[3]);
                    *(u32x4*)(rowp + bj * HALF) = w; } }
    } };
struct EpiGate { static constexpr bool PERM = true, AFTER_DRAIN = false, INPLACE = false; bf16_t* g; const float* su; const float* wi;
    DEV void operator()(const f32x4 (&acc)[2][2][4][2], const Unit& u, int wr, int wc, int fr, int fq) const {
        bf16_t* gt = g + (size_t)(u.pn >> 2) * GSTRIDE_;
        const int row0 = u.pm * BM + wr * 64 + fr, col0 = (u.pn & 3) * BM + wc * 32 + 8 * fq;
        const float* wp_ = wi + u.pn * BM + wc * 32 + 8 * fq; const f32x4 w00 = *(const f32x4*)wp_, w01 = *(const f32x4*)(wp_ + 4), w10 = *(const f32x4*)(wp_ + HALF), w11 = *(const f32x4*)(wp_ + HALF + 4);
#pragma unroll
        for (int ai = 0; ai < 2; ++ai)
#pragma unroll
            for (int m = 0; m < 4; ++m) { const size_t ro = (size_t)(row0 + ai * HALF + m * 16) * 1024 + col0; const float rsc = su[row0 + ai * HALF + m * 16];
#pragma unroll
                for (int bj = 0; bj < 2; ++bj) { const i32x4 i0 = __builtin_bit_cast(i32x4, acc[ai][bj][m][0]), i1 = __builtin_bit_cast(i32x4, acc[ai][bj][m][1]); f32x4 v0, v1;
#pragma unroll
                    for (int j = 0; j < 4; ++j) { v0[j] = fmaxf(__builtin_amdgcn_rcpf(1.f + __expf(-(float)i0[j] * (rsc * (bj ? w10 : w00)[j]))), 1e-30f); v1[j] = fmaxf(__builtin_amdgcn_rcpf(1.f + __expf(-(float)i1[j] * (rsc * (bj ? w11 : w01)[j]))), 1e-30f); }
                    u32x4 w; w.x = cvt_pk_bf16(v0[0], v0[1]); w.y = cvt_pk_bf16(v0[2], v0[3]); w.z = cvt_pk_bf16(v1[0], v1[1]); w.w = cvt_pk_bf16(v1[2], v1[3]);
                    *(u32x4*)(gt + ro + bj * HALF) = w; } }
    } };
struct EpiBranch3 { static constexpr bool PERM = true, AFTER_DRAIN = false, INPLACE = true; const bf16_t* g; bf16_t* merged;
    DEV static void unpack8(const u32x4 q, float (&f)[8]) { f[0] = __uint_as_float(q.x << 16); f[1] = __uint_as_float(q.x & 0xffff0000u); f[2] = __uint_as_float(q.y << 16); f[3] = __uint_as_float(q.y & 0xffff0000u);
        f[4] = __uint_as_float(q.z << 16); f[5] = __uint_as_float(q.z & 0xffff0000u); f[6] = __uint_as_float(q.w << 16); f[7] = __uint_as_float(q.w & 0xffff0000u); }
    DEV void operator()(f32x4 (&acc)[2][2][4][2], const Unit& u, int wr, int wc, int fr, int fq) const {
        const int row0 = u.pm * BM + wr * 64 + fr, col0 = u.pn * BM + wc * 32 + 8 * fq; const int tag = u.tag;
        const bool fin = (tag == 2); const float keepf = fin ? 0.f : 1.f; const bf16_t* gn = g + (size_t)tag * GSTRIDE_; const bf16_t* gd = gn + GSTRIDE_;
#pragma unroll
        for (int ah = 0; ah < 4; ++ah) { const int ai = ah >> 1, m0 = (ah & 1) * 2; u32x4 nq[2][2], dq[2][2];
#pragma unroll
            for (int mm = 0; mm < 2; ++mm)
#pragma unroll
                for (int bj = 0; bj < 2; ++bj) { const size_t o = (size_t)(row0 + ai * HALF + (m0 + mm) * 16) * 1024 + col0 + bj * HALF; nq[mm][bj] = *(const u32x4*)(gn + o);
                    dq[mm][bj] = (u32x4){0x3f803f80u, 0x3f803f80u, 0x3f803f80u, 0x3f803f80u}; if (!fin) dq[mm][bj] = *(const u32x4*)(gd + o); }
            asm volatile("" ::: "memory");
#pragma unroll
            for (int mm = 0; mm < 2; ++mm)
#pragma unroll
                for (int bj = 0; bj < 2; ++bj) { const int m = m0 + mm; const size_t o = (size_t)(row0 + ai * HALF + m * 16) * 1024 + col0 + bj * HALF; float nn[8], dd[8]; unpack8(nq[mm][bj], nn); unpack8(dq[mm][bj], dd);
                    const f32x4 s0 = (f32x4){nn[0] * __builtin_amdgcn_rcpf(dd[0]), nn[1] * __builtin_amdgcn_rcpf(dd[1]), nn[2] * __builtin_amdgcn_rcpf(dd[2]), nn[3] * __builtin_amdgcn_rcpf(dd[3])};
                    const f32x4 s1 = (f32x4){nn[4] * __builtin_amdgcn_rcpf(dd[4]), nn[5] * __builtin_amdgcn_rcpf(dd[5]), nn[6] * __builtin_amdgcn_rcpf(dd[6]), nn[7] * __builtin_amdgcn_rcpf(dd[7])};
                    const f32x4 r0 = acc[ai][bj][m][0] * s0, r1 = acc[ai][bj][m][1] * s1;
                    if (fin) { u32x4 w; w.x = cvt_pk_bf16(r0[0], r0[1]); w.y = cvt_pk_bf16(r0[2], r0[3]); w.z = cvt_pk_bf16(r1[0], r1[1]); w.w = cvt_pk_bf16(r1[2], r1[3]); *(u32x4*)(merged + o) = w; }
                    acc[ai][bj][m][0] = r0 * keepf; acc[ai][bj][m][1] = r1 * keepf; asm volatile("" : "+v"(acc[ai][bj][m][0]), "+v"(acc[ai][bj][m][1])); }
            asm volatile("" ::: "memory"); }
    } };
struct EpiH { static constexpr bool PERM = true, AFTER_DRAIN = false, INPLACE = false; const float* xin; const bf16_t* xin16; bf16_t* hout; const float* ada_b;
    DEV void operator()(const f32x4 (&acc)[2][2][4][2], const Unit& u, int wr, int wc, int fr, int fq) const {
        const int row0 = u.pm * BM + wr * 64 + fr, col0 = u.pn * BM + wc * 32 + 8 * fq; const float* ab = ada_b + (size_t)(u.pm >> 3) * 6144 + 2048 + col0;
        const f32x4 g00 = *(const f32x4*)ab, g01 = *(const f32x4*)(ab + 4), g10 = *(const f32x4*)(ab + HALF), g11 = *(const f32x4*)(ab + HALF + 4);
        if (xin) {
#pragma unroll
            for (int ah = 0; ah < 4; ++ah) { const int ai = ah >> 1, m0 = (ah & 1) * 2; f32x4 xa[2][2][2];
#pragma unroll
                for (int mm = 0; mm < 2; ++mm)
#pragma unroll
                    for (int bj = 0; bj < 2; ++bj) { const float* xp = xin + (size_t)(row0 + ai * HALF + (m0 + mm) * 16) * 1024 + col0 + bj * HALF; xa[mm][bj][0] = *(const f32x4*)xp; xa[mm][bj][1] = *(const f32x4*)(xp + 4); }
                asm volatile("" ::: "memory");
#pragma unroll
                for (int mm = 0; mm < 2; ++mm)
#pragma unroll
                    for (int bj = 0; bj < 2; ++bj) { const int m = m0 + mm; const f32x4 h0 = ALPHA_ * xa[mm][bj][0] + (bj ? g10 : g00) * acc[ai][bj][m][0], h1 = ALPHA_ * xa[mm][bj][1] + (bj ? g11 : g01) * acc[ai][bj][m][1];
                        u32x4 w; w.x = cvt_pk_bf16(h0[0], h0[1]); w.y = cvt_pk_bf16(h0[2], h0[3]); w.z = cvt_pk_bf16(h1[0], h1[1]); w.w = cvt_pk_bf16(h1[2], h1[3]);
                        *(u32x4*)(hout + (size_t)(row0 + ai * HALF + m * 16) * 1024 + col0 + bj * HALF) = w; }
                asm volatile("" ::: "memory"); }
        } else {
#pragma unroll
            for (int ai = 0; ai < 2; ++ai) { u32x4 xq[4][2];
#pragma unroll
                for (int m = 0; m < 4; ++m)
#pragma unroll
                    for (int bj = 0; bj < 2; ++bj) xq[m][bj] = *(const u32x4*)(xin16 + (size_t)(row0 + ai * HALF + m * 16) * 1024 + col0 + bj * HALF);
                asm volatile("" ::: "memory");
#pragma unroll
                for (int m = 0; m < 4; ++m)
#pragma unroll
                    for (int bj = 0; bj < 2; ++bj) { const u32x4 q = xq[m][bj];
                        const f32x4 x0 = (f32x4){__uint_as_float(q.x << 16), __uint_as_float(q.x & 0xffff0000u), __uint_as_float(q.y << 16), __uint_as_float(q.y & 0xffff0000u)}, x1 = (f32x4){__uint_as_float(q.z << 16), __uint_as_float(q.z & 0xffff0000u), __uint_as_float(q.w << 16), __uint_as_float(q.w & 0xffff0000u)};
                        const f32x4 h0 = ALPHA_ * x0 + (bj ? g10 : g00) * acc[ai][bj][m][0], h1 = ALPHA_ * x1 + (bj ? g11 : g01) * acc[ai][bj][m][1];
                        u32x4 w; w.x = cvt_pk_bf16(h0[0], h0[1]); w.y = cvt_pk_bf16(h0[2], h0[3]); w.z = cvt_pk_bf16(h1[0], h1[1]); w.w = cvt_pk_bf16(h1[2], h1[3]);
                        *(u32x4*)(hout + (size_t)(row0 + ai * HALF + m * 16) * 1024 + col0 + bj * HALF) = w; }
                asm volatile("" ::: "memory"); }
        }
    } };
struct GateSched { const bf16_t* UY; const unsigned char* WmT8; int G, c;
    DEV bool next(int i, Unit& u) const { const long L = (long)i * G + c; if (L >= 128 * 12) return false; tile_of((int)L, 128, 12, u.pm, u.pn); u.tag = 0; u.nt = 8;
        u.a = (const char*)(UY + (size_t)u.pm * BM * UYW_); u.b = (const char*)(WmT8 + (size_t)(u.pn & 3) * BM * (WMW_ * 2)) + (u.pn >> 2) * 1024; return true; } };
struct Branch3Sched { const bf16_t* UY; const unsigned char* WmT8; int G, c;
    DEV bool next(int i, Unit& u) const { const int ti = i / 3, ps = i - ti * 3; const long L = (long)ti * G + c; if (L >= 128 * 4) return false; tile_of((int)L, 128, 4, u.pm, u.pn); u.tag = ps;
        const int koff = ps == 0 ? 0 : (ps == 1 ? 256 : 768); u.nt = ps == 0 ? 4 : 8;
        u.a = (const char*)(UY + (size_t)u.pm * BM * UYW_) + (1024 + koff) * 2; u.b = (const char*)(WmT8 + (size_t)u.pn * BM * (WMW_ * 2)) + 3072 + koff * 2; return true; } };
}

DEV int win_orig_col(int n) {
    if (n >= 3072) return n < 4608 ? (n - 3072 + 2304) : n;
    const int head = n >> 6, p = n & 63; const bool rp = (head < 24) || (head >= 36 && head < 46);
    const int d = rp ? ((p & 4) ? 32 + 4 * (p >> 3) + (p & 3) : 4 * (p >> 3) + (p & 3)) : p;
    return ((n < 2304) ? head * 64 : 3840 + (head - 36) * 64) + d;
}
struct WPrep { const float *w_in, *wba, *wbb, *wbc, *w_out, *peer_wq; unsigned char *WinT8, *WmT8; bf16_t *WoutT, *WqT; };
DEV void nb_wprep(int vb, int t, unsigned char* sm, const WPrep& q) {
    const int l = vb / 1088; int r = vb - l * 1088 + 1920; const float* W; int ldw; bf16_t* Wt = nullptr; unsigned char* W8 = nullptr; int ldt = 0, ld8 = 0, koff = 0, ntk = 16, mode = 0, nsub = 0;
    if (false) {}
    else if (r < 1984) { r -= 1920; W = q.wba + (size_t)l * 256 * 1024; ldw = 1024; Wt = (bf16_t*)(q.WmT8 + (size_t)l * 1024 * (WMW_ * 2) + 3072); ldt = WMW_; koff = 0; ntk = 4; }
    else if (r < 2112) { r -= 1984; W = q.wbb + (size_t)l * 512 * 1024; ldw = 1024; Wt = (bf16_t*)(q.WmT8 + (size_t)l * 1024 * (WMW_ * 2) + 3072); ldt = WMW_; koff = 256; ntk = 8; }
    else if (r < 2240) { r -= 2112; W = q.wbc + (size_t)l * 512 * 1024; ldw = 1024; Wt = (bf16_t*)(q.WmT8 + (size_t)l * 1024 * (WMW_ * 2) + 3072); ldt = WMW_; koff = 768; ntk = 8; }
    else if (r < 2496) { r -= 2240; W = q.w_out + (size_t)l * 1024 * 1024; ldw = 1024; Wt = q.WoutT + (size_t)l * 1024 * 1024; ldt = 1024; }
    else { r -= 2496; W = q.peer_wq + (size_t)l * 1024 * 2048; ldw = 2048; Wt = q.WqT + (size_t)l * 2048 * 1024; ldt = 1024; }
    const int n0 = (r / ntk) * 64, k0 = (r % ntk) * 64; const int c0 = mode ? (win_orig_col(n0) & ~63) : n0;
    bf16_t* tile = (bf16_t*)sm;
    { const int kk = t >> 2, cs = (t & 3) * 16; const float* src = W + (size_t)(k0 + kk) * ldw + c0 + cs;
#pragma unroll
        for (int i = 0; i < 16; i += 4) { const float4 v = *(const float4*)(src + i); tile[kk * 66 + cs + i] = f2bf(v.x); tile[kk * 66 + cs + i + 1] = f2bf(v.y); tile[kk * 66 + cs + i + 2] = f2bf(v.z); tile[kk * 66 + cs + i + 3] = f2bf(v.w); } }
    __syncthreads();
    (void)W8; (void)ld8;
    { const int nn = t >> 2, ks = (t & 3) * 16; const int dl = mode ? (win_orig_col(n0 + nn) - c0) : nn; bf16_t* dst = Wt + (size_t)(n0 + nn - nsub) * ldt + koff + k0 + ks;
        unsigned w[8];
#pragma unroll
        for (int i = 0; i < 8; ++i) w[i] = (unsigned)tile[(ks + 2 * i) * 66 + dl] | ((unsigned)tile[(ks + 2 * i + 1) * 66 + dl] << 16);
        *(u32x4*)dst = (u32x4){w[0], w[1], w[2], w[3]}; *(u32x4*)(dst + 8) = (u32x4){w[4], w[5], w[6], w[7]}; }
}

DEV void winprep_phase(LAS unsigned char* lds, const float* __restrict__ w_in, unsigned char* WinT8, unsigned char* WmT8, float* __restrict__ winv, int G, int cblk, int wv) {
    int wv_ = wv, ln_; asm volatile("v_mbcnt_lo_u32_b32 %1, -1, 0\n\tv_mbcnt_hi_u32_b32 %1, -1, %1" : "+s"(wv_), "=v"(ln_)); const int tid = (wv_ << 6) | ln_, lane = ln_;
    LAS bf16_t* tt = (LAS bf16_t*)lds;
#pragma unroll 1
    for (int item = cblk; item < 240; item += G) { const int l = item / 120, nt = item - l * 120, n0 = nt * 64; const int c0 = win_orig_col(n0) & ~63;
        const bool rp = (nt < 24) || (nt >= 36 && nt < 46);
        const float* W = w_in + (size_t)l * 1024 * 7680 + c0;
        __syncthreads();
        { const int r0 = tid >> 4, cs = (tid & 15) * 4; int nn4[4];
#pragma unroll
            for (int e = 0; e < 4; ++e) { const int d = cs + e; nn4[e] = rp ? ((d < 32) ? 8 * (d >> 2) + (d & 3) : 8 * ((d - 32) >> 2) + 4 + (d & 3)) : d; }
#pragma unroll 1
            for (int i = 0; i < 32; i += 8) { float4 v[8];
#pragma unroll
                for (int j = 0; j < 8; ++j) v[j] = *(const float4*)(W + (size_t)(r0 + 32 * (i + j)) * 7680 + cs);
#pragma unroll
                for (int j = 0; j < 8; ++j) { const int r = r0 + 32 * (i + j); tt[nn4[0] * 1032 + r] = f2bf(v[j].x); tt[nn4[1] * 1032 + r] = f2bf(v[j].y); tt[nn4[2] * 1032 + r] = f2bf(v[j].z); tt[nn4[3] * 1032 + r] = f2bf(v[j].w); } } }
        __syncthreads();
        { const int nn = tid >> 3, kq = tid & 7; const LAS bf16_t* row = tt + nn * 1032; float mx = 0.f;
#pragma unroll 4
            for (int j = 0; j < 16; ++j) { const u32x4 q = *(const LAS u32x4*)(row + 8 * (kq + 8 * j));
                mx = fmaxf(mx, fmaxf(fmaxf(fabsf(__uint_as_float(q.x << 16)), fabsf(__uint_as_float(q.x & 0xffff0000u))), fmaxf(fabsf(__uint_as_float(q.y << 16)), fabsf(__uint_as_float(q.y & 0xffff0000u)))));
                mx = fmaxf(mx, fmaxf(fmaxf(fabsf(__uint_as_float(q.z << 16)), fabsf(__uint_as_float(q.z & 0xffff0000u))), fmaxf(fabsf(__uint_as_float(q.w << 16)), fabsf(__uint_as_float(q.w & 0xffff0000u))))); }
            mx = fmaxf(mx, xor_f(mx, 1, lane)); mx = fmaxf(mx, xor_f(mx, 2, lane)); mx = fmaxf(mx, xor_f(mx, 4, lane));
            const float qs = (mx > 0.f) ? 127.f / mx : 0.f;
            unsigned char* dst8;
            if (nt < 72) dst8 = WinT8 + (size_t)l * 4608 * 1024 + (size_t)(n0 + nn) * 1024;
            else { const int br = (nt - 72) >> 4; dst8 = WmT8 + (size_t)l * 1024 * (WMW_ * 2) + br * 1024 + (size_t)(n0 + nn - 4608 - br * 1024) * (WMW_ * 2); }
#pragma unroll 2
            for (int c = 0; c < 8; ++c) { const int ks = 16 * (kq + 8 * c); const u32x4 qa = *(const LAS u32x4*)(row + ks), qb = *(const LAS u32x4*)(row + ks + 8);
                const unsigned wsrc[8] = {qa.x, qa.y, qa.z, qa.w, qb.x, qb.y, qb.z, qb.w}; unsigned w8[4];
#pragma unroll
                for (int i = 0; i < 4; ++i) { const int q0 = (int)rintf(__uint_as_float(wsrc[2 * i] << 16) * qs), q1 = (int)rintf(__uint_as_float(wsrc[2 * i] & 0xffff0000u) * qs),
                                                        q2 = (int)rintf(__uint_as_float(wsrc[2 * i + 1] << 16) * qs), q3 = (int)rintf(__uint_as_float(wsrc[2 * i + 1] & 0xffff0000u) * qs);
                    w8[i] = ((unsigned)q0 & 0xffu) | (((unsigned)q1 & 0xffu) << 8) | (((unsigned)q2 & 0xffu) << 16) | (((unsigned)q3 & 0xffu) << 24); }
                *(u32x4*)(dst8 + ks) = (u32x4){w8[0], w8[1], w8[2], w8[3]}; }
            if (kq == 0) winv[(size_t)l * 7680 + n0 + nn] = mx * (1.f / 127.f); }
    }
    __syncthreads();
}

namespace hy {
constexpr int ZS = 2064;
constexpr int G0_OFF = 0, G1_OFF = 8192, Z0_OFF = 16384, Z1_OFF = Z0_OFF + 16 * ZS * 2, LDS_END = Z1_OFF + 16 * ZS * 2;
DEV bf16x8 load_frag(LAS const unsigned char* lane_base, int d) {
    const LAS unsigned* p = (const LAS unsigned*)(lane_base + 32 * d); u32x4 w; w.x = p[0]; w.y = p[1]; w.z = p[2]; w.w = p[3];
    return __builtin_bit_cast(bf16x8, w);
}
DEV void load_filter(LAS unsigned char* lds, const bf16_t* g, int tid) {
    const u32x4 c = *(const u32x4*)(g + tid * 8); const unsigned nx = (tid < 511) ? (unsigned)g[tid * 8 + 8] : 0u;
    *(LAS u32x4*)(lds + G0_OFF + tid * 16) = c;
    u32x4 s; s.x = (c.x >> 16) | (c.y << 16); s.y = (c.y >> 16) | (c.z << 16); s.z = (c.z >> 16) | (c.w << 16); s.w = (c.w >> 16) | (nx << 16);
    *(LAS u32x4*)(lds + G1_OFF + tid * 16) = s;
}
DEV float bflo(unsigned w) { return __uint_as_float(w << 16); }
DEV float bfhi(unsigned w) { return __uint_as_float(w & 0xffff0000u); }
DEV void conv_rows(LAS const unsigned char* lds, int zoff, int w, int lane, f32x4 (&D)[16]) {
    const int r = lane & 15, q = lane >> 4;
    LAS const unsigned char* abase = lds + ((r & 1) ? (G0_OFF + 2 * (8 * q - r + 2047)) : (G1_OFF + 2 * (8 * q - r + 2046)));
    LAS const unsigned char* bbase = lds + zoff + (r * ZS + 8 * q) * 2;
    bf16x8 ring[16];
#pragma unroll
    for (int rb = 0; rb < 16; ++rb) D[rb] = (f32x4){0.f, 0.f, 0.f, 0.f};
#pragma unroll
    for (int rb = 2; rb < 16; ++rb) ring[rb] = load_frag(abase, -16 * w - rb);
#pragma unroll 1
    for (int jb0 = 0; jb0 < 64; jb0 += 8) {
#pragma unroll
        for (int u = 0; u < 8; ++u) { const int jb = jb0 + u;
            ring[(16 - 2 * u) & 15] = load_frag(abase, 2 * jb - 16 * w);
            ring[(17 - 2 * u) & 15] = load_frag(abase, 2 * jb - 16 * w - 1);
            const bf16x8 bf = *(const LAS bf16x8*)(bbase + 64 * jb);
#pragma unroll
            for (int rb = 0; rb < 16; ++rb) D[rb] = __builtin_amdgcn_mfma_f32_16x16x32_bf16(ring[(rb - 2 * u) & 15], bf, D[rb], 0, 0, 0);
        }
    }
}
DEV void sconv4(const bf16_t* in, int i, float w0, float w1, float w2, float cb, float (&o)[4]) {
    const u32x2 v = *(const u32x2*)(in + i); const float pm = (i > 0) ? bf2f(in[i - 1]) : 0.f, pn = (i + 4 < 2048) ? bf2f(in[i + 4]) : 0.f;
    const float x0 = bflo(v.x), x1 = bfhi(v.x), x2 = bflo(v.y), x3 = bfhi(v.y);
    o[0] = cb + w0 * pm + w1 * x0 + w2 * x1; o[1] = cb + w0 * x0 + w1 * x1 + w2 * x2; o[2] = cb + w0 * x1 + w1 * x2 + w2 * x3; o[3] = cb + w0 * x2 + w1 * x3 + w2 * pn;
}
DEV void hyena_phase(LAS unsigned char* lds, bf16_t* hyT, const bf16_t* Gr_l, const float* conv_w, const float* conv_b, const float* hy_bias, int G, int cblk, int wv) {
    int wv_ = wv, ln_; asm volatile("v_mbcnt_lo_u32_b32 %1, -1, 0\n\tv_mbcnt_hi_u32_b32 %1, -1, %1" : "+s"(wv_), "=v"(ln_)); int tid_ = (wv_ << 6) | ln_;
    const int tid = tid_, w = __builtin_amdgcn_readfirstlane(tid >> 6), lane = tid & 63, q = lane >> 4, b = lane & 15;
#pragma unroll 1
    for (int c = cblk; c < 512; c += G) {
        __syncthreads();
        load_filter(lds, Gr_l + (size_t)c * 4096, tid);
        { const float w0 = conv_w[c], w1 = conv_w[1536 + c], w2 = conv_w[3072 + c], cb = conv_b[c]; const bf16_t* row = hyT + (size_t)c * T_;
#pragma unroll 2
            for (int k = 0; k < 8; ++k) { const int pos = (k * 512 + tid) * 8; const int s = pos & 2047, bb = pos >> 11;
                const u32x4 v = *(const u32x4*)(row + pos); const float pm = (s > 0) ? bf2f(row[pos - 1]) : 0.f, pn = (s + 8 < 2048) ? bf2f(row[pos + 8]) : 0.f;
                const float x[10] = {pm, bflo(v.x), bfhi(v.x), bflo(v.y), bfhi(v.y), bflo(v.z), bfhi(v.z), bflo(v.w), bfhi(v.w), pn};
                float z[8];
#pragma unroll
                for (int e = 0; e < 8; ++e) z[e] = cb + w0 * x[e] + w1 * x[e + 1] + w2 * x[e + 2];
                u32x4 o; o.x = pg8::cvt_pk_bf16(z[0], z[1]); o.y = pg8::cvt_pk_bf16(z[2], z[3]); o.z = pg8::cvt_pk_bf16(z[4], z[5]); o.w = pg8::cvt_pk_bf16(z[6], z[7]);
                *(LAS u32x4*)(lds + Z0_OFF + (bb * ZS + s) * 2) = o; } }
        __syncthreads();
        f32x4 D[16];
        conv_rows(lds, Z0_OFF, w, lane, D);
        { const int xc = 512 + c; const float w0 = conv_w[xc], w1 = conv_w[1536 + xc], w2 = conv_w[3072 + xc], cb = conv_b[xc], bias = hy_bias[c]; const bf16_t* xin = hyT + (size_t)xc * T_ + b * 2048;
#pragma unroll
            for (int rb = 0; rb < 16; ++rb) { const int i = 256 * w + 16 * rb + 4 * q; float xv[4]; sconv4(xin, i, w0, w1, w2, cb, xv);
                const u32x2 zq = *(const LAS u32x2*)(lds + Z0_OFF + (b * ZS + i) * 2); const float zv[4] = {bflo(zq.x), bfhi(zq.x), bflo(zq.y), bfhi(zq.y)};
                float o[4];
#pragma unroll
                for (int e = 0; e < 4; ++e) o[e] = xv[e] * (D[rb][e] + bias * zv[e]);
                u32x2 pk; pk.x = pg8::cvt_pk_bf16(o[0], o[1]); pk.y = pg8::cvt_pk_bf16(o[2], o[3]);
                *(LAS u32x2*)(lds + Z1_OFF + (b * ZS + i) * 2) = pk; } }
        __syncthreads();
        load_filter(lds, Gr_l + (size_t)(512 + c) * 4096, tid);
        __syncthreads();
        conv_rows(lds, Z1_OFF, w, lane, D);
        { const int xc = 1024 + c; const float w0 = conv_w[xc], w1 = conv_w[1536 + xc], w2 = conv_w[3072 + xc], cb = conv_b[xc], bias = hy_bias[512 + c]; const bf16_t* xin = hyT + (size_t)xc * T_ + b * 2048;
            bf16_t* yout = hyT + (size_t)c * T_ + b * 2048;
#pragma unroll
            for (int rb = 0; rb < 16; ++rb) { const int i = 256 * w + 16 * rb + 4 * q; float xv[4]; sconv4(xin, i, w0, w1, w2, cb, xv);
                const u32x2 zq = *(const LAS u32x2*)(lds + Z1_OFF + (b * ZS + i) * 2); const float zv[4] = {bflo(zq.x), bfhi(zq.x), bflo(zq.y), bfhi(zq.y)};
                float o[4];
#pragma unroll
                for (int e = 0; e < 4; ++e) o[e] = xv[e] * (D[rb][e] + bias * zv[e]);
                u32x2 pk; pk.x = pg8::cvt_pk_bf16(o[0], o[1]); pk.y = pg8::cvt_pk_bf16(o[2], o[3]);
                *(u32x2*)(yout + i) = pk; } }
    }
    __syncthreads();
}
}

namespace peer {
DEV float wave_sum(float v, int lane) {
#pragma unroll
    for (int off = 32; off > 0; off >>= 1) v += xor_f(v, off, lane);
    return v;
}
DEV float wave_max(float v, int lane) {
#pragma unroll
    for (int off = 32; off > 0; off >>= 1) v = fmaxf(v, xor_f(v, off, lane));
    return v;
}
DEV unsigned pk4_fp8(float a, float b, float c, float d) { int w = __builtin_amdgcn_cvt_pk_fp8_f32(a, b, 0, false); w = __builtin_amdgcn_cvt_pk_fp8_f32(c, d, w, true); return (unsigned)w; }
DEV void nb_quant_tables(int vb, int t, const float* __restrict__ pu, const float* __restrict__ pv, unsigned char* __restrict__ U8, unsigned char* __restrict__ V4, float* __restrict__ sinv) {
    const int row = vb * 4 + (t >> 6), lane = t & 63; const float* src = (row < 16384) ? pu + (size_t)row * 1024 : pv + (size_t)(row - 16384) * 1024;
    const float4 a = *(const float4*)(src + 16 * lane), b = *(const float4*)(src + 16 * lane + 4), c = *(const float4*)(src + 16 * lane + 8), d = *(const float4*)(src + 16 * lane + 12);
    float mx = fmaxf(fmaxf(fmaxf(fabsf(a.x), fabsf(a.y)), fmaxf(fabsf(a.z), fabsf(a.w))), fmaxf(fmaxf(fabsf(b.x), fabsf(b.y)), fmaxf(fabsf(b.z), fabsf(b.w))));
    mx = fmaxf(mx, fmaxf(fmaxf(fmaxf(fabsf(c.x), fabsf(c.y)), fmaxf(fabsf(c.z), fabsf(c.w))), fmaxf(fmaxf(fabsf(d.x), fabsf(d.y)), fmaxf(fabsf(d.z), fabsf(d.w)))));
    mx = wave_max(mx, lane);
    {
        const float sc = (mx > 0.f) ? 6.f / mx : 0.f; unsigned w0 = 0u, w1 = 0u; const bool sw = false;
        w0 = __builtin_amdgcn_cvt_scalef32_pk_fp4_f32(w0, (sw ? a.y : a.x) * sc, (sw ? a.x : a.y) * sc, 1.0f, 0); w0 = __builtin_amdgcn_cvt_scalef32_pk_fp4_f32(w0, (sw ? a.w : a.z) * sc, (sw ? a.z : a.w) * sc, 1.0f, 1);
        w0 = __builtin_amdgcn_cvt_scalef32_pk_fp4_f32(w0, (sw ? b.y : b.x) * sc, (sw ? b.x : b.y) * sc, 1.0f, 2); w0 = __builtin_amdgcn_cvt_scalef32_pk_fp4_f32(w0, (sw ? b.w : b.z) * sc, (sw ? b.z : b.w) * sc, 1.0f, 3);
        w1 = __builtin_amdgcn_cvt_scalef32_pk_fp4_f32(w1, (sw ? c.y : c.x) * sc, (sw ? c.x : c.y) * sc, 1.0f, 0); w1 = __builtin_amdgcn_cvt_scalef32_pk_fp4_f32(w1, (sw ? c.w : c.z) * sc, (sw ? c.z : c.w) * sc, 1.0f, 1);
        w1 = __builtin_amdgcn_cvt_scalef32_pk_fp4_f32(w1, (sw ? d.y : d.x) * sc, (sw ? d.x : d.y) * sc, 1.0f, 2); w1 = __builtin_amdgcn_cvt_scalef32_pk_fp4_f32(w1, (sw ? d.w : d.z) * sc, (sw ? d.z : d.w) * sc, 1.0f, 3);
        unsigned char* dst = (row < 16384) ? U8 + (size_t)row * 512 : V4 + (size_t)(row - 16384) * 512;
        *(u32x2*)(dst + 8 * lane) = (u32x2){w0, w1};
        if (lane == 0) sinv[row] = (mx > 0.f) ? mx * (1.f / 6.f) : 0.f;
    }
}
DEV void peer_phase(LAS unsigned char* lds, const bf16_t* __restrict__ x1in, float* xout32, bf16_t* xout16, const float* ada_l,
                    const int* __restrict__ eidx, const float* __restrict__ egate, const unsigned char* __restrict__ U8, const unsigned char* __restrict__ V4,
                    const float* __restrict__ sinv, const float* __restrict__ g, const float* __restrict__ bta, const float* ada_next, bf16_t* UY, float* su_next, int G, int cblk, int wv) {
    int wv_ = wv, ln_; asm volatile("v_mbcnt_lo_u32_b32 %1, -1, 0\n\tv_mbcnt_hi_u32_b32 %1, -1, %1" : "+s"(wv_), "=v"(ln_)); int tid_ = (wv_ << 6) | ln_;
    const int tid = tid_, w = __builtin_amdgcn_readfirstlane(tid >> 6), lane = tid & 63;
    LAS unsigned char* urow_l = lds + w * 3072; LAS int* E_l = (LAS int*)(urow_l + 1024); LAS float* W_l = (LAS float*)(urow_l + 1536); LAS float* SU_l = (LAS float*)(urow_l + 2048); LAS float* SV_l = (LAS float*)(urow_l + 2560); LAS float* D_l = (LAS float*)(lds + 24576 + 8 * 8448 + w * 512); LAS unsigned char* stage_l = lds + 24576 + w * 8448;
#define PEER_SB __builtin_amdgcn_sched_barrier(0)
#define PEER_ISSUE_U(buf, gi) do { _Pragma("unroll") for (int n2 = 0; n2 < 8; ++n2) { const int e_ = E_l[(gi) * 16 + 2 * n2 + hh]; buf[n2] = *(const u32x4*)(U8 + (size_t)e_ * 512 + 16 * r32); } } while (0)
#define PEER_ISSUE_V(buf, gi) do { _Pragma("unroll") for (int n2 = 0; n2 < 8; ++n2) { const int e_ = E_l[(gi) * 16 + 2 * n2 + hh]; buf[n2] = *(const u32x4*)(V4 + (size_t)e_ * 512 + 16 * r32); } } while (0)
#define PEER_COMP_U(buf) do { _Pragma("unroll") for (int n2 = 0; n2 < 8; ++n2) *(LAS u32x4*)(stage_l + (2 * n2 + hh) * 528 + 16 * r32) = buf[n2]; asm volatile("s_waitcnt lgkmcnt(0)" ::: "memory"); \
        _Pragma("unroll") for (int k2 = 0; k2 < 8; ++k2) { const u32x4 bw = *(const LAS u32x4*)(stage_l + n * 528 + 64 * k2 + 16 * q); const u32x4 alo = *(const LAS u32x4*)(urow_l + 128 * k2 + 16 * q), ahi = *(const LAS u32x4*)(urow_l + 128 * k2 + 64 + 16 * q);     \
            const i32x8 av = (i32x8){(int)alo.x, (int)alo.y, (int)alo.z, (int)alo.w, (int)ahi.x, (int)ahi.y, (int)ahi.z, (int)ahi.w}; const i32x8 bv = (i32x8){(int)bw.x, (int)bw.y, (int)bw.z, (int)bw.w, 0, 0, 0, 0}; \
            if (k2 & 1) acc1 = __builtin_amdgcn_mfma_scale_f32_16x16x128_f8f6f4(av, bv, acc1, 0, 4, 0, 0x7F7F7F7F, 0, 0x7F7F7F7F); else acc = __builtin_amdgcn_mfma_scale_f32_16x16x128_f8f6f4(av, bv, acc, 0  , 4  , 0, 0x7F7F7F7F, 0, 0x7F7F7F7F); } } while (0)
#define PEER_UNPK(wd, base) do { o[(base) / 2 + 0] = __builtin_elementwise_fma(__builtin_bit_cast(h2, __builtin_amdgcn_cvt_scalef32_pk_f16_fp4((wd), 1.0f, 0)), w2, o[(base) / 2 + 0]); o[(base) / 2 + 1] = __builtin_elementwise_fma(__builtin_bit_cast(h2, __builtin_amdgcn_cvt_scalef32_pk_f16_fp4((wd), 1.0f, 1)), w2, o[(base) / 2 + 1]); \
            o[(base) / 2 + 2] = __builtin_elementwise_fma(__builtin_bit_cast(h2, __builtin_amdgcn_cvt_scalef32_pk_f16_fp4((wd), 1.0f, 2)), w2, o[(base) / 2 + 2]); o[(base) / 2 + 3] = __builtin_elementwise_fma(__builtin_bit_cast(h2, __builtin_amdgcn_cvt_scalef32_pk_f16_fp4((wd), 1.0f, 3)), w2, o[(base) / 2 + 3]); } while (0)
#define PEER_COMP_V(buf, gi) do { float wq_[8]; _Pragma("unroll") for (int n2 = 0; n2 < 8; ++n2) wq_[n2] = W_l[(gi) * 16 + 2 * n2 + hh]; \
        _Pragma("unroll") for (int n2 = 0; n2 < 8; ++n2) { const h2 w2 = __builtin_bit_cast(h2, wq_[n2]); const u32x4 v = buf[n2]; \
              \
            asm volatile("" : "+v"(o[0]), "+v"(o[1]), "+v"(o[2]), "+v"(o[3]), "+v"(o[4]), "+v"(o[5]), "+v"(o[6]), "+v"(o[7]), "+v"(o[8]), "+v"(o[9]), "+v"(o[10]), "+v"(o[11]), "+v"(o[12]), "+v"(o[13]), "+v"(o[14]), "+v"(o[15])); \
            PEER_UNPK(v.x, 0); PEER_UNPK(v.y, 8); PEER_UNPK(v.z, 16); PEER_UNPK(v.w, 24); } } while (0)
    int ne0 = 0, ne1 = 0; float ng0 = 0.f, ng1 = 0.f, nsu0 = 0.f, nsu1 = 0.f, nsv0 = 0.f, nsv1 = 0.f; u32x4 nx0 = (u32x4){0u, 0u, 0u, 0u}, nx1 = nx0;
    { const int tok0 = cblk * 8 + w; if (tok0 < T_) { const int dd = 32 * (lane & 31) + 16 * (lane >> 5); nx0 = *(const u32x4*)(x1in + (size_t)tok0 * 1024 + dd); nx1 = *(const u32x4*)(x1in + (size_t)tok0 * 1024 + dd + 8); ne0 = eidx[(size_t)tok0 * 128 + lane]; ne1 = eidx[(size_t)tok0 * 128 + 64 + lane]; ng0 = egate[(size_t)tok0 * 128 + lane]; ng1 = egate[(size_t)tok0 * 128 + 64 + lane];
        nsu0 = sinv[ne0]; nsu1 = sinv[ne1]; nsv0 = sinv[16384 + ne0]; nsv1 = sinv[16384 + ne1]; } }
#pragma unroll 1
    for (int tok = cblk * 8 + w; tok < T_; tok += G * 8) {
        int lane_o = lane; asm volatile("" : "+v"(lane_o));
        const int q = lane_o >> 4, n = lane_o & 15, r32 = lane_o & 31, hh = lane_o >> 5; int d0 = 32 * r32 + 16 * hh;
        const float* a = ada_l + (size_t)(tok >> 11) * 6144;
        float stinv; float x1[16]; u32x4 bufA[8], bufB[8];
        {
#pragma unroll
            for (int j = 0; j < 16; j += 8) { const u32x4 v = j ? nx1 : nx0;
                x1[j] = __uint_as_float(v.x << 16); x1[j + 1] = __uint_as_float(v.x & 0xffff0000u); x1[j + 2] = __uint_as_float(v.y << 16); x1[j + 3] = __uint_as_float(v.y & 0xffff0000u);
                x1[j + 4] = __uint_as_float(v.z << 16); x1[j + 5] = __uint_as_float(v.z & 0xffff0000u); x1[j + 6] = __uint_as_float(v.w << 16); x1[j + 7] = __uint_as_float(v.w & 0xffff0000u); }
            E_l[lane_o] = ne0; E_l[64 + lane_o] = ne1; W_l[lane_o] = ng0; W_l[64 + lane_o] = ng1;
            SU_l[lane_o] = nsu0; SU_l[64 + lane_o] = nsu1; SV_l[lane_o] = nsv0; SV_l[64 + lane_o] = nsv1;
            asm volatile("s_waitcnt lgkmcnt(0)" ::: "memory");
            PEER_ISSUE_U(bufA, 0); PEER_SB;
            float u[16]; float um = 0.f;
#pragma unroll
            for (int j = 0; j < 16; j += 4) { const float4 sc = *(const float4*)(a + 4096 + d0 + j), sh = *(const float4*)(a + 3072 + d0 + j);
                u[j] = x1[j] * (1.f + sc.x) + sh.x; u[j + 1] = x1[j + 1] * (1.f + sc.y) + sh.y; u[j + 2] = x1[j + 2] * (1.f + sc.z) + sh.z; u[j + 3] = x1[j + 3] * (1.f + sc.w) + sh.w;
                um = fmaxf(um, fmaxf(fmaxf(fabsf(u[j]), fabsf(u[j + 1])), fmaxf(fabsf(u[j + 2]), fabsf(u[j + 3])))); }
            um = wave_max(um, lane_o); const float st = (um > 0.f) ? 224.f / um : 1.f; stinv = (um > 0.f) ? um * (1.f / 224.f) : 1.f;
            u32x4 pq; pq.x = pk4_fp8(u[0] * st, u[1] * st, u[2] * st, u[3] * st); pq.y = pk4_fp8(u[4] * st, u[5] * st, u[6] * st, u[7] * st);
            pq.z = pk4_fp8(u[8] * st, u[9] * st, u[10] * st, u[11] * st); pq.w = pk4_fp8(u[12] * st, u[13] * st, u[14] * st, u[15] * st);
            *(LAS u32x4*)(urow_l + d0) = pq; }
        asm volatile("s_waitcnt lgkmcnt(0)" ::: "memory");
        PEER_SB;
#define PEER_FIN_U(gi) do { if (q == 0) D_l[(gi) * 16 + n] = acc[0] + acc1[0]; } while (0)
#pragma unroll 1
        for (int gi = 0; gi < 8; gi += 2) { f32x4 acc = (f32x4){0.f, 0.f, 0.f, 0.f}, acc1 = acc;
            PEER_ISSUE_U(bufB, gi + 1); PEER_SB; PEER_COMP_U(bufA); PEER_FIN_U(gi); PEER_SB;
            if (gi < 6) PEER_ISSUE_U(bufA, gi + 2); else PEER_ISSUE_V(bufA, 0);
            PEER_SB; acc = (f32x4){0.f, 0.f, 0.f, 0.f}; acc1 = acc; PEER_COMP_U(bufB); PEER_FIN_U(gi + 1); PEER_SB; }
        asm volatile("s_waitcnt lgkmcnt(0)" ::: "memory");
#pragma unroll
        for (int t = 0; t < 2; ++t) { const int ix = lane_o + 64 * t; const float ds_ = D_l[ix] * (SU_l[ix] * stinv); const float wv_ = W_l[ix] * 0.5f * ds_ * (1.f + erff(ds_ * 0.70710678118654752f)) * SV_l[ix];
            const _Float16 wh_ = (_Float16)wv_; W_l[ix] = __builtin_bit_cast(float, (h2){wh_, wh_}); }
#undef PEER_FIN_U
        asm volatile("s_waitcnt lgkmcnt(0)" ::: "memory");
        h2 o2[16];
#pragma unroll
        for (int j = 0; j < 16; ++j) o2[j] = (h2){(_Float16)0.f, (_Float16)0.f};
        const int tokn = tok + G * 8; const bool hasn = tokn < T_;
        if (hasn) { nx0 = *(const u32x4*)(x1in + (size_t)tokn * 1024 + d0); nx1 = *(const u32x4*)(x1in + (size_t)tokn * 1024 + d0 + 8); ne0 = eidx[(size_t)tokn * 128 + lane_o]; ne1 = eidx[(size_t)tokn * 128 + 64 + lane_o]; ng0 = egate[(size_t)tokn * 128 + lane_o]; ng1 = egate[(size_t)tokn * 128 + 64 + lane_o]; }
        PEER_SB;
        { h2 (&o)[16] = o2;
#pragma unroll 1
        for (int gi = 0; gi < 8; gi += 2) {
            PEER_ISSUE_V(bufB, gi + 1); PEER_SB; PEER_COMP_V(bufA, gi); PEER_SB;
            if (gi < 6) PEER_ISSUE_V(bufA, gi + 2);
            if (gi == 2 && hasn) { nsu0 = sinv[ne0]; nsu1 = sinv[ne1]; nsv0 = sinv[16384 + ne0]; nsv1 = sinv[16384 + ne1]; }
            PEER_SB; PEER_COMP_V(bufB, gi + 1); PEER_SB; } }
        asm volatile("" : "+v"(lane_o)); d0 = 32 * (lane_o & 31) + 16 * (lane_o >> 5);
        const unsigned hm = 0u - (unsigned)(lane_o >> 5);
        float o[16];
#pragma unroll
        for (int j = 0; j < 16; ++j) { const float lo_ = (float)o2[j >> 1][j & 1], hi_ = (float)o2[8 + (j >> 1)][j & 1];
            const float keep = __uint_as_float((__float_as_uint(lo_) & ~hm) | (__float_as_uint(hi_) & hm)), send = __uint_as_float((__float_as_uint(hi_) & ~hm) | (__float_as_uint(lo_) & hm));
            o[j] = keep + xor_f(send, 32, lane_o); }
        float hv[16]; float s = 0.f;
#pragma unroll
        for (int j = 0; j < 16; j += 4) { const float4 g2 = *(const float4*)(a + 5120 + d0 + j);
            hv[j] = ALPHA_ * x1[j] + g2.x * o[j]; hv[j + 1] = ALPHA_ * x1[j + 1] + g2.y * o[j + 1]; hv[j + 2] = ALPHA_ * x1[j + 2] + g2.z * o[j + 2]; hv[j + 3] = ALPHA_ * x1[j + 3] + g2.w * o[j + 3];
            s += (hv[j] + hv[j + 1]) + (hv[j + 2] + hv[j + 3]); }
        const float mu = wave_sum(s, lane_o) * (1.f / 1024.f); float qq = 0.f;
#pragma unroll
        for (int j = 0; j < 16; ++j) { const float dd = hv[j] - mu; qq += dd * dd; }
        const float rstd = rsqrtf(wave_sum(qq, lane_o) * (1.f / 1024.f) + LN_EPS_);
        const float* an = ada_next ? ada_next + (size_t)(tok >> 11) * 6144 : nullptr;
        float y[16];
#pragma unroll
        for (int j = 0; j < 16; j += 4) { const float4 gg = *(const float4*)(g + d0 + j), bb = *(const float4*)(bta + d0 + j);
            y[j] = (hv[j] - mu) * rstd * gg.x + bb.x; y[j + 1] = (hv[j + 1] - mu) * rstd * gg.y + bb.y; y[j + 2] = (hv[j + 2] - mu) * rstd * gg.z + bb.z; y[j + 3] = (hv[j + 3] - mu) * rstd * gg.w + bb.w;
            if (!xout16) *(float4*)(xout32 + (size_t)tok * 1024 + d0 + j) = make_float4(y[j], y[j + 1], y[j + 2], y[j + 3]); }
        if (xout16) { u32x4 q0, q1; q0.x = pg8::cvt_pk_bf16(y[0], y[1]); q0.y = pg8::cvt_pk_bf16(y[2], y[3]); q0.z = pg8::cvt_pk_bf16(y[4], y[5]); q0.w = pg8::cvt_pk_bf16(y[6], y[7]);
            q1.x = pg8::cvt_pk_bf16(y[8], y[9]); q1.y = pg8::cvt_pk_bf16(y[10], y[11]); q1.z = pg8::cvt_pk_bf16(y[12], y[13]); q1.w = pg8::cvt_pk_bf16(y[14], y[15]);
            bf16_t* xo = xout16 + (size_t)tok * 1024 + d0; *(u32x4*)xo = q0; *(u32x4*)(xo + 8) = q1; }
        if (an) { float uu[16]; float um = 0.f;
#pragma unroll
            for (int j = 0; j < 16; j += 4) { const float4 sc = *(const float4*)(an + 1024 + d0 + j), sh = *(const float4*)(an + d0 + j);
                uu[j] = y[j] * (1.f + sc.x) + sh.x; uu[j + 1] = y[j + 1] * (1.f + sc.y) + sh.y; uu[j + 2] = y[j + 2] * (1.f + sc.z) + sh.z; uu[j + 3] = y[j + 3] * (1.f + sc.w) + sh.w;
                um = fmaxf(um, fmaxf(fmaxf(fabsf(uu[j]), fabsf(uu[j + 1])), fmaxf(fabsf(uu[j + 2]), fabsf(uu[j + 3])))); }
            um = wave_max(um, lane_o); const float qs = (um > 0.f) ? 127.f / um : 0.f; unsigned o8[4];
#pragma unroll
            for (int e = 0; e < 4; ++e) { o8[e] = 0u;
#pragma unroll
                for (int j = 0; j < 4; ++j) o8[e] |= ((unsigned)(int)rintf(uu[4 * e + j] * qs) & 0xffu) << (8 * j); }
            *(u32x4*)((unsigned char*)(UY + (size_t)tok * UYW_) + d0) = (u32x4){o8[0], o8[1], o8[2], o8[3]};
            if (lane_o == 0) su_next[tok] = um * (1.f / 127.f); }
        asm volatile("s_waitcnt lgkmcnt(0)" ::: "memory");
    }
#undef PEER_SB
#undef PEER_ISSUE_U
#undef PEER_ISSUE_V
#undef PEER_COMP_U
#undef PEER_COMP_V
#undef PEER_UNPK
    __syncthreads();
}
}

namespace tk {
typedef float f32x16 __attribute__((ext_vector_type(16)));
constexpr int KROW = 272;
DEV unsigned sortable(float v) { const unsigned u = __float_as_uint(v); return u ^ ((unsigned)((int)u >> 31) | 0x80000000u); }
DEV float unsortable(unsigned k) { return __uint_as_float(k ^ ((~(unsigned)((int)k >> 31)) | 0x80000000u)); }
DEV unsigned umax_(unsigned a, unsigned b) { return a > b ? a : b; }
DEV unsigned umin_(unsigned a, unsigned b) { return a < b ? a : b; }
#define CE(x, y) { const unsigned hi_ = umax_(a[x], a[y]), lo_ = umin_(a[x], a[y]); a[x] = hi_; a[y] = lo_; }
DEV void sort16(unsigned (&a)[16]) {
    CE(0, 1); CE(3, 2); CE(4, 5); CE(7, 6); CE(8, 9); CE(11, 10); CE(12, 13); CE(15, 14); CE(0, 2); CE(1, 3); CE(6, 4); CE(7, 5); CE(8, 10); CE(9, 11); CE(14, 12); CE(15, 13); CE(0, 1); CE(2, 3); CE(5, 4); CE(7, 6); CE(8, 9); CE(10, 11); CE(13, 12); CE(15, 14); CE(0, 4); CE(1, 5); CE(2, 6); CE(3, 7); CE(12, 8); CE(13, 9); CE(14, 10); CE(15, 11); CE(0, 2); CE(1, 3); CE(4, 6); CE(5, 7); CE(10, 8); CE(11, 9); CE(14, 12); CE(15, 13); CE(0, 1); CE(2, 3); CE(4, 5); CE(6, 7); CE(9, 8); CE(11, 10); CE(13, 12); CE(15, 14); CE(0, 8); CE(1, 9); CE(2, 10); CE(3, 11); CE(4, 12); CE(5, 13); CE(6, 14); CE(7, 15); CE(0, 4); CE(1, 5); CE(2, 6); CE(3, 7); CE(8, 12); CE(9, 13); CE(10, 14); CE(11, 15); CE(0, 2); CE(1, 3); CE(4, 6); CE(5, 7); CE(8, 10); CE(9, 11); CE(12, 14); CE(13, 15); CE(0, 1); CE(2, 3); CE(4, 5); CE(6, 7); CE(8, 9); CE(10, 11); CE(12, 13); CE(14, 15);
}
DEV void bmerge16(unsigned (&a)[16]) {
    CE(0, 8); CE(1, 9); CE(2, 10); CE(3, 11); CE(4, 12); CE(5, 13); CE(6, 14); CE(7, 15); CE(0, 4); CE(1, 5); CE(2, 6); CE(3, 7); CE(8, 12); CE(9, 13); CE(10, 14); CE(11, 15); CE(0, 2); CE(1, 3); CE(4, 6); CE(5, 7); CE(8, 10); CE(9, 11); CE(12, 14); CE(13, 15); CE(0, 1); CE(2, 3); CE(4, 5); CE(6, 7); CE(8, 9); CE(10, 11); CE(12, 13); CE(14, 15);
}
#undef CE
DEV void top_merge(unsigned (&a)[16], const unsigned (&b)[16]) {
#pragma unroll
    for (int i = 0; i < 16; ++i) a[i] = umax_(a[i], b[15 - i]);
    bmerge16(a);
}
DEV void xlane_merge(unsigned (&a)[16], int lane) {
    unsigned b[16];
#pragma unroll
    for (int i = 0; i < 16; ++i) b[i] = (unsigned)xor_i((int)a[i], 32, lane);
    top_merge(a, b);
}
DEV unsigned lookup_idx(unsigned long long lo, unsigned long long hi, int a) { const unsigned long long wv = (a < 8) ? lo : hi; return (unsigned)(wv >> ((a & 7) * 8)) & 127u; }
DEV unsigned blendu(unsigned m, unsigned a, unsigned b) { return (a & ~m) | (b & m); }
DEV float blendf(unsigned m, float a, float b) { return __uint_as_float((__float_as_uint(a) & ~m) | (__float_as_uint(b) & m)); }

DEV void topk_phase(LAS unsigned char* lds, const bf16_t* __restrict__ Q2, const float* __restrict__ keys_l, int* __restrict__ eidx, float* __restrict__ egate, int G, int cblk, int wv) {
    int wv_ = wv, ln_; asm volatile("v_mbcnt_lo_u32_b32 %1, -1, 0\n\tv_mbcnt_hi_u32_b32 %1, -1, %1" : "+s"(wv_), "=v"(ln_)); int tid_ = (wv_ << 6) | ln_;
    const int tid = tid_, w = __builtin_amdgcn_readfirstlane(tid >> 6), lane = tid & 63, tl = lane & 31, hh = lane >> 5;
    asm volatile("" : "+s"(G));
    const bool by_head = (G & 7) == 0;
#pragma unroll 1
    for (int h = 0; h < 8; ++h) {
        if (by_head && h != (cblk & 7)) continue;
        __syncthreads();
        {
            const int r = tid >> 1, c0 = (tid & 1) * 64; const float* src = keys_l + ((size_t)h * 256 + r) * 128 + c0; LAS unsigned char* dst = lds + r * KROW + c0 * 2;
#pragma unroll
            for (int j = 0; j < 64; j += 8) { const float4 a = *(const float4*)(src + j), b = *(const float4*)(src + j + 4);
                u32x4 o; o.x = pg8::cvt_pk_bf16(a.x, a.y); o.y = pg8::cvt_pk_bf16(a.z, a.w); o.z = pg8::cvt_pk_bf16(b.x, b.y); o.w = pg8::cvt_pk_bf16(b.z, b.w); *(LAS u32x4*)(dst + j * 2) = o; }
        }
        __syncthreads();
        const int first = by_head ? (cblk >> 3) * 8 + w : cblk * 8 + w, stride = by_head ? (G >> 3) * 8 : G * 8;
#pragma unroll 1
        for (int blk = first; blk < T_ / 32; blk += stride) {
            const int tok = blk * 32 + tl; const bf16_t* qrow = Q2 + (size_t)tok * 2048 + h * 256 + 8 * hh;
            unsigned L[2][16];
#pragma unroll
            for (int p = 0; p < 2; ++p) {
                bf16x8 bq[8];
#pragma unroll
                for (int ks = 0; ks < 8; ++ks) bq[ks] = *(const bf16x8*)(qrow + p * 128 + 16 * ks);
#pragma unroll
                for (int t = 0; t < 4; ++t) {
                    f32x16 acc;
#pragma unroll
                    for (int e = 0; e < 16; ++e) acc[e] = 0.f;
#pragma unroll
                    for (int ks = 0; ks < 8; ++ks) { const bf16x8 ak = *(const LAS bf16x8*)(lds + (p * 128 + 32 * t + tl) * KROW + (16 * ks + 8 * hh) * 2);
                        acc = __builtin_amdgcn_mfma_f32_32x32x16_bf16(ak, bq[ks], acc, 0, 0, 0); }
                    unsigned K[16];
#pragma unroll
                    for (int e = 0; e < 16; ++e) K[e] = (sortable(acc[e]) & ~127u) | (unsigned)((127 - 32 * t - (e & 3) - 8 * (e >> 2)) - 4 * hh);
                    sort16(K);
                    if (t == 0) {
#pragma unroll
                        for (int e = 0; e < 16; ++e) L[p][e] = K[e];
                    } else top_merge(L[p], K);
                    __builtin_amdgcn_sched_barrier(0);
                }
                xlane_merge(L[p], lane);
                __builtin_amdgcn_sched_barrier(0);
            }
            float f1[16], f2[16];
#pragma unroll
            for (int e = 0; e < 16; ++e) { f1[e] = unsortable(L[0][e] & ~127u); f2[e] = unsortable(L[1][e] & ~127u); }
            unsigned hm = 0u - (unsigned)hh; asm volatile("" : "+v"(hm));
            unsigned C[2][16];
            C[0][0] = (sortable(blendf(hm, f1[0], f1[2]) + blendf(hm, f2[0], f2[1])) & ~255u) | (255u - blendu(hm, 0u, 33u));
            C[0][1] = (sortable(blendf(hm, f1[0], f1[2]) + blendf(hm, f2[1], f2[2])) & ~255u) | (255u - blendu(hm, 1u, 34u));
            C[0][2] = (sortable(blendf(hm, f1[0], f1[2]) + blendf(hm, f2[2], f2[3])) & ~255u) | (255u - blendu(hm, 2u, 35u));
            C[0][3] = (sortable(blendf(hm, f1[0], f1[2]) + blendf(hm, f2[3], f2[4])) & ~255u) | (255u - blendu(hm, 3u, 36u));
            C[0][4] = (sortable(blendf(hm, f1[0], f1[3]) + blendf(hm, f2[4], f2[0])) & ~255u) | (255u - blendu(hm, 4u, 48u));
            C[0][5] = (sortable(blendf(hm, f1[0], f1[3]) + blendf(hm, f2[5], f2[1])) & ~255u) | (255u - blendu(hm, 5u, 49u));
            C[0][6] = (sortable(blendf(hm, f1[0], f1[3]) + blendf(hm, f2[6], f2[2])) & ~255u) | (255u - blendu(hm, 6u, 50u));
            C[0][7] = (sortable(blendf(hm, f1[0], f1[3]) + blendf(hm, f2[7], f2[3])) & ~255u) | (255u - blendu(hm, 7u, 51u));
            C[0][8] = (sortable(blendf(hm, f1[0], f1[4]) + blendf(hm, f2[8], f2[0])) & ~255u) | (255u - blendu(hm, 8u, 64u));
            C[0][9] = (sortable(blendf(hm, f1[0], f1[4]) + blendf(hm, f2[9], f2[1])) & ~255u) | (255u - blendu(hm, 9u, 65u));
            C[0][10] = (sortable(blendf(hm, f1[0], f1[4]) + blendf(hm, f2[10], f2[2])) & ~255u) | (255u - blendu(hm, 10u, 66u));
            C[0][11] = (sortable(blendf(hm, f1[0], f1[5]) + blendf(hm, f2[11], f2[0])) & ~255u) | (255u - blendu(hm, 11u, 80u));
            C[0][12] = (sortable(blendf(hm, f1[0], f1[5]) + blendf(hm, f2[12], f2[1])) & ~255u) | (255u - blendu(hm, 12u, 81u));
            C[0][13] = (sortable(blendf(hm, f1[0], f1[6]) + blendf(hm, f2[13], f2[0])) & ~255u) | (255u - blendu(hm, 13u, 96u));
            C[0][14] = (sortable(blendf(hm, f1[0], f1[6]) + blendf(hm, f2[14], f2[1])) & ~255u) | (255u - blendu(hm, 14u, 97u));
            C[0][15] = (sortable(blendf(hm, f1[0], f1[7]) + blendf(hm, f2[15], f2[0])) & ~255u) | (255u - blendu(hm, 15u, 112u));
            C[1][0] = (sortable(blendf(hm, f1[1], f1[7]) + blendf(hm, f2[0], f2[1])) & ~255u) | (255u - blendu(hm, 16u, 113u));
            C[1][1] = (sortable(blendf(hm, f1[1], f1[8]) + blendf(hm, f2[1], f2[0])) & ~255u) | (255u - blendu(hm, 17u, 128u));
            C[1][2] = (sortable(blendf(hm, f1[1], f1[9]) + blendf(hm, f2[2], f2[0])) & ~255u) | (255u - blendu(hm, 18u, 144u));
            C[1][3] = (sortable(blendf(hm, f1[1], f1[10]) + blendf(hm, f2[3], f2[0])) & ~255u) | (255u - blendu(hm, 19u, 160u));
            C[1][4] = (sortable(blendf(hm, f1[1], f1[11]) + blendf(hm, f2[4], f2[0])) & ~255u) | (255u - blendu(hm, 20u, 176u));
            C[1][5] = (sortable(blendf(hm, f1[1], f1[12]) + blendf(hm, f2[5], f2[0])) & ~255u) | (255u - blendu(hm, 21u, 192u));
            C[1][6] = (sortable(blendf(hm, f1[1], f1[13]) + blendf(hm, f2[6], f2[0])) & ~255u) | (255u - blendu(hm, 22u, 208u));
            C[1][7] = (sortable(blendf(hm, f1[1], f1[14]) + blendf(hm, f2[7], f2[0])) & ~255u) | (255u - blendu(hm, 23u, 224u));
            C[1][8] = (sortable(blendf(hm, f1[2], f1[15]) + blendf(hm, f2[0], f2[0])) & ~255u) | (255u - blendu(hm, 32u, 240u));
            C[1][9] = 0u;
            C[1][10] = 0u;
            C[1][11] = 0u;
            C[1][12] = 0u;
            C[1][13] = 0u;
            C[1][14] = 0u;
            C[1][15] = 0u;
            sort16(C[0]); sort16(C[1]); top_merge(C[0], C[1]); xlane_merge(C[0], lane);
            unsigned long long p1lo = 0ull, p1hi = 0ull, p2lo = 0ull, p2hi = 0ull;
#pragma unroll
            for (int m = 0; m < 8; ++m) { p1lo |= (unsigned long long)(127u - (L[0][m] & 127u)) << (8 * m); p1hi |= (unsigned long long)(127u - (L[0][8 + m] & 127u)) << (8 * m);
                p2lo |= (unsigned long long)(127u - (L[1][m] & 127u)) << (8 * m); p2hi |= (unsigned long long)(127u - (L[1][8 + m] & 127u)) << (8 * m); }
            float val[16]; unsigned ex[16]; float sum = 0.f;
#pragma unroll
            for (int k = 0; k < 16; ++k) { const unsigned flat = 255u - (C[0][k] & 255u); const int a = (int)(flat >> 4), b = (int)(flat & 15u);
                val[k] = unsortable(C[0][k] & ~255u); ex[k] = lookup_idx(p1lo, p1hi, a) * 128u + lookup_idx(p2lo, p2hi, b); }
            const float mx = val[0];
#pragma unroll
            for (int k = 0; k < 16; ++k) { val[k] = __expf(val[k] - mx); sum += val[k]; }
            const float inv = 1.f / sum;
            int eo[8]; float go[8];
#pragma unroll
            for (int k = 0; k < 8; ++k) { eo[k] = (int)blendu(hm, ex[k], ex[8 + k]); go[k] = blendf(hm, val[k], val[8 + k]) * inv; }
            const size_t ob = ((size_t)tok * 8 + h) * 16 + 8 * hh;
            *(int4*)(eidx + ob) = make_int4(eo[0], eo[1], eo[2], eo[3]); *(int4*)(eidx + ob + 4) = make_int4(eo[4], eo[5], eo[6], eo[7]);
            *(float4*)(egate + ob) = make_float4(go[0], go[1], go[2], go[3]); *(float4*)(egate + ob + 4) = make_float4(go[4], go[5], go[6], go[7]);
        }
    }
    __syncthreads();
}
}

namespace at {
typedef float f32x16 __attribute__((ext_vector_type(16)));
constexpr int KROWB = 144, VROWB = 776, K_OFF = 0, V_OFF = 384 * KROWB, LDS_END = V_OFF + 64 * VROWB;
constexpr int N_ITEMS_A = 16 * 12 * 8, N_ITEMS_C = 16 * 2 * 16 * 2;

struct Band { int p_w, ls, R, slot_base; };
template <bool MASK>
DEV void chunk(LAS const unsigned char* lds, const Band& bd, int c, const bf16x8 (&qf)[4], int tl, int hh, int lane, f32x16 (&O)[2], float& m, float& l) {
    const int kp0 = bd.p_w - bd.R + 32 * c;
    if (kp0 + 31 < 0 || kp0 >= bd.ls) return;
    const int s0 = kp0 + bd.slot_base;
    f32x16 S;
#pragma unroll
    for (int e = 0; e < 16; ++e) S[e] = 0.f;
#pragma unroll
    for (int ks = 0; ks < 4; ++ks) { const bf16x8 ak = *(const LAS bf16x8*)(lds + K_OFF + (s0 + tl) * KROWB + (16 * ks + 8 * hh) * 2); S = __builtin_amdgcn_mfma_f32_32x32x16_bf16(ak, qf[ks], S, 0, 0, 0); }
    float cmax = -1e30f;
    if (MASK) {
        const int dbase = (32 * c - bd.R) - tl + 4 * hh;
#pragma unroll
        for (int e = 0; e < 16; ++e) { const int diff = dbase + (e & 3) + 8 * (e >> 2); const bool ok = (diff <= bd.R) && (diff >= -bd.R); S[e] = ok ? S[e] : -1e30f; cmax = fmaxf(cmax, S[e]); }
    } else {
#pragma unroll
        for (int e = 0; e < 16; ++e) cmax = fmaxf(cmax, S[e]);
    }
    cmax = fmaxf(cmax, xor_f(cmax, 32, lane));
    const float mn = fmaxf(m, cmax), alpha = __builtin_amdgcn_exp2f(m - mn); m = mn;
    float psum = 0.f;
#pragma unroll
    for (int e = 0; e < 16; ++e) { S[e] = __builtin_amdgcn_exp2f(S[e] - mn); psum += S[e]; }
    l = l * alpha + psum;
#pragma unroll
    for (int e = 0; e < 16; ++e) { O[0][e] *= alpha; O[1][e] *= alpha; }
#pragma unroll
    for (int sx = 0; sx < 2; ++sx) {
        u32x4 pw; pw.x = pg8::cvt_pk_bf16(S[8 * sx + 0], S[8 * sx + 1]); pw.y = pg8::cvt_pk_bf16(S[8 * sx + 2], S[8 * sx + 3]); pw.z = pg8::cvt_pk_bf16(S[8 * sx + 4], S[8 * sx + 5]); pw.w = pg8::cvt_pk_bf16(S[8 * sx + 6], S[8 * sx + 7]);
        const bf16x8 pb = __builtin_bit_cast(bf16x8, pw);
#pragma unroll
        for (int dt = 0; dt < 2; ++dt) { LAS const unsigned char* vp = lds + V_OFF + (32 * dt + tl) * VROWB + (s0 + 16 * sx + 4 * hh) * 2;
            const u32x2 lo = *(const LAS u32x2*)vp, hi = *(const LAS u32x2*)(vp + 16); const u32x4 vw = (u32x4){lo.x, lo.y, hi.x, hi.y};
            O[dt] = __builtin_amdgcn_mfma_f32_32x32x16_bf16(__builtin_bit_cast(bf16x8, vw), pb, O[dt], 0, 0, 0); }
    }
}
DEV void attn_phase(LAS unsigned char* lds, bf16_t* P, float* lse2, bf16_t* Y, const float* sink_l, int G, int cblk, int wv) {
    int wv_ = wv, ln_; asm volatile("v_mbcnt_lo_u32_b32 %1, -1, 0\n\tv_mbcnt_hi_u32_b32 %1, -1, %1" : "+s"(wv_), "=v"(ln_)); int tid_ = (wv_ << 6) | ln_;
    const int tid = tid_, w = __builtin_amdgcn_readfirstlane(tid >> 6), lane = tid & 63, tl = lane & 31, hh = lane >> 5;
#pragma unroll 1
    for (int item = cblk; item < N_ITEMS_A + N_ITEMS_C; item += G) {
        int b, dil, ls, r, klo, nsl, R, kcol, vcol, qcol, two = 0, rp = 0, sb = 0, head = 0, isC = 0, nb = 0, qh0 = 0;
        if (item < N_ITEMS_A) { b = item / 96; const int rem = item - b * 96; head = rem >> 3; const int sub = rem & 7, g = head >> 2; R = 64;
            kcol = 768 + head * 64; vcol = 1536 + head * 64; qcol = head * 64;
            if (g == 0) { dil = 1; ls = 2048; r = 0; sb = sub; klo = 256 * sb - 64; nsl = 384; }
            else if (g == 1) { dil = 4; ls = 512; r = sub >> 1; sb = sub & 1; klo = 256 * sb - 64; nsl = 384; }
            else { dil = 16; ls = 128; r = 0; rp = sub; klo = 0; nsl = 256; two = 1; } }
        else { const int it = item - N_ITEMS_A; b = it >> 6; const int rem = it & 63; const int kvh = rem >> 5; nb = (rem & 31) >> 1; const int hp = rem & 1; isC = 1; R = 128;
            dil = 1; ls = 2048; r = 0; klo = 128 * nb - 128; nsl = 384; kcol = 2816 + kvh * 64; vcol = 2944 + kvh * 64; qh0 = kvh * 4 + hp * 2; qcol = 2304 + qh0 * 64; }
        __syncthreads();
        for (int i = tid; i < nsl * 8; i += 512) { const int slot = i >> 3, part = i & 7; int kpos, rr;
            if (two) { kpos = slot & 127; rr = 2 * rp + (slot >> 7); } else { kpos = klo + slot; rr = r; }
            u32x4 kv = (u32x4){0u, 0u, 0u, 0u}, vv = kv;
            if (kpos >= 0 && kpos < ls) { const bf16_t* rowp = P + (size_t)(b * 2048 + kpos * dil + rr) * PW_; kv = *(const u32x4*)(rowp + kcol + part * 8); vv = *(const u32x4*)(rowp + vcol + part * 8); }
            *(LAS u32x4*)(lds + K_OFF + slot * KROWB + part * 16) = kv;
            LAS unsigned short* vt = (LAS unsigned short*)(lds + V_OFF + (part * 8) * VROWB + slot * 2);
            vt[0 * (VROWB / 2)] = (unsigned short)(vv.x & 0xffffu); vt[1 * (VROWB / 2)] = (unsigned short)(vv.x >> 16); vt[2 * (VROWB / 2)] = (unsigned short)(vv.y & 0xffffu); vt[3 * (VROWB / 2)] = (unsigned short)(vv.y >> 16);
            vt[4 * (VROWB / 2)] = (unsigned short)(vv.z & 0xffffu); vt[5 * (VROWB / 2)] = (unsigned short)(vv.z >> 16); vt[6 * (VROWB / 2)] = (unsigned short)(vv.w & 0xffffu); vt[7 * (VROWB / 2)] = (unsigned short)(vv.w >> 16); }
        __syncthreads();
        Band bd; int qtok, rr = r; bd.ls = ls; bd.R = R;
        if (two) { const int half = w >> 2; bd.p_w = 32 * (w & 3); rr = 2 * rp + half; bd.slot_base = half * 128; }
        else if (isC) { bd.p_w = 128 * nb + 32 * (w & 3); bd.slot_base = -klo; }
        else { bd.p_w = 256 * sb + 32 * w; bd.slot_base = -klo; }
        qtok = b * 2048 + (bd.p_w + tl) * dil + rr;
        const int qc = isC ? (qcol + (w >> 2) * 64) : qcol;
        const bf16_t* qp = P + (size_t)qtok * PW_ + qc + 8 * hh;
        bf16x8 qf[4];
#pragma unroll
        for (int ks = 0; ks < 4; ++ks) qf[ks] = *(const bf16x8*)(qp + 16 * ks);
        f32x16 O[2];
#pragma unroll
        for (int e = 0; e < 16; ++e) { O[0][e] = 0.f; O[1][e] = 0.f; }
        float m = -1e30f, l = 0.f;
        const int nch = R / 16 + 1, cd = R / 32;
        chunk<false>(lds, bd, cd, qf, tl, hh, lane, O, m, l);
        chunk<true>(lds, bd, 0, qf, tl, hh, lane, O, m, l); chunk<true>(lds, bd, nch - 1, qf, tl, hh, lane, O, m, l);
#pragma unroll 1
        for (int c = 1; c < nch - 1; ++c) { if (c != cd) chunk<false>(lds, bd, c, qf, tl, hh, lane, O, m, l); }
        float lt = l + xor_f(l, 32, lane), scale;
        if (isC) { const float sk = sink_l[qh0 + (w >> 2)] * LOG2E_; const float mf = fmaxf(m, sk), corr = exp2f(m - mf); lt = lt * corr + exp2f(sk - mf); scale = corr / lt; }
        else { scale = 1.f / lt; if (hh == 0) lse2[(size_t)qtok * 12 + head] = m + log2f(lt); }
        bf16_t* op = isC ? (Y + (size_t)qtok * UYW_ + 768 + (qh0 + (w >> 2)) * 64) : (P + (size_t)qtok * PW_ + qcol);
#pragma unroll
        for (int dt = 0; dt < 2; ++dt)
#pragma unroll
            for (int g4 = 0; g4 < 4; ++g4) { u32x2 pk; pk.x = pg8::cvt_pk_bf16(O[dt][4 * g4] * scale, O[dt][4 * g4 + 1] * scale); pk.y = pg8::cvt_pk_bf16(O[dt][4 * g4 + 2] * scale, O[dt][4 * g4 + 3] * scale);
                *(u32x2*)(op + 32 * dt + 8 * g4 + 4 * hh) = pk; }
    }
    __syncthreads();
}
}

namespace xb {
constexpr int XB_TMO = 128, XB_TOP = 3328, XB_TOPGEN = 3392, XCD_BAR_WORDS = 3456; constexpr unsigned XB_SPIN_CAP = 1u << 22;
DEV constexpr int XB_XCNT(int j) { return 256 + 64 * j; }
DEV constexpr int XB_XSUB(int j) { return 1280 + 64 * j; }
DEV constexpr int XB_XGEN(int j) { return 2304 + 64 * j; }
DEV unsigned xb_ld(unsigned* p) { return __hip_atomic_load(p, __ATOMIC_RELAXED, __HIP_MEMORY_SCOPE_AGENT); }
DEV unsigned xb_add(unsigned* p, unsigned v) { return __hip_atomic_fetch_add(p, v, __ATOMIC_RELAXED, __HIP_MEMORY_SCOPE_AGENT); }
DEV unsigned xb_xcc_id() { return (unsigned)__builtin_amdgcn_s_getreg((3 << 11) | 20) & 0xFu; }
#define XB_SPIN(cond, bar) do { unsigned _sp = 0; while (cond) { __builtin_amdgcn_s_sleep(1); \
    if ((++_sp & 255u) == 0u) { if (xb_ld(&(bar)[XB_TMO])) break; if (_sp > XB_SPIN_CAP) { atomicAdd(&(bar)[XB_TMO], 1u); break; } } } } while (0)
struct XcdBarrier { unsigned* bar; unsigned x; volatile LAS unsigned* st; };
DEV XcdBarrier xcd_barrier_post(unsigned* bar, volatile LAS unsigned* st) { XcdBarrier b; b.bar = bar; b.x = xb_xcc_id(); b.st = st; if (threadIdx.x == 0) (void)xb_add(&bar[XB_XCNT(b.x)], 1u); return b; }
DEV void xcd_barrier_complete(unsigned* bar, unsigned x, unsigned& nloc, unsigned& nx) {
    const unsigned G = gridDim.x * gridDim.y * gridDim.z; unsigned sum, cnt, mine, sp = 0u;
    for (;;) { sum = 0u; cnt = 0u; mine = 0u;
#pragma unroll
        for (unsigned j = 0; j < 16; ++j) { const unsigned c = xb_ld(&bar[XB_XCNT(j)]); sum += c; cnt += (c > 0u) ? 1u : 0u; mine = (j == x) ? c : mine; }
        if (sum == G) break;
        __builtin_amdgcn_s_sleep(1);
        if ((++sp & 255u) == 0u) { if (xb_ld(&bar[XB_TMO])) break; if (sp > XB_SPIN_CAP) { atomicAdd(&bar[XB_TMO], 1u); break; } } }
    nloc = mine > 0u ? mine : 1u; nx = cnt > 0u ? cnt : 1u;
}
DEV void xcd_barrier(const XcdBarrier& b, int wv) {
    asm volatile("s_waitcnt vmcnt(0)" ::: "memory");
    __syncthreads();
    int ln0_; asm volatile("v_mbcnt_lo_u32_b32 %0, -1, 0\n\tv_mbcnt_hi_u32_b32 %0, -1, %0" : "=v"(ln0_));
    if (wv == 0 && ln0_ == 0) {
        unsigned* bar = b.bar; asm volatile("" : "+s"(bar));
        unsigned bx = xb_xcc_id(); asm volatile("" : "+s"(bx));
        __builtin_amdgcn_s_waitcnt(0);
        unsigned nloc = b.st[0], nx = b.st[1];
        if (nloc == 0u) { xcd_barrier_complete(bar, bx, nloc, nx); b.st[0] = nloc; b.st[1] = nx; }
        const unsigned old = xb_add(&bar[XB_XSUB(bx)], 1u); const unsigned gen = old / nloc;
        if (old + 1u == (gen + 1u) * nloc) {
            __builtin_amdgcn_fence(__ATOMIC_RELEASE, "agent");
            asm volatile("s_waitcnt vmcnt(0)" ::: "memory");
            const unsigned og = xb_add(&bar[XB_TOP], 1u); const unsigned tg = og / nx;
            if (og + 1u == (tg + 1u) * nx) xb_add(&bar[XB_TOPGEN], 1u);
            else XB_SPIN(xb_ld(&bar[XB_TOPGEN]) == tg, bar);
            __builtin_amdgcn_fence(__ATOMIC_ACQUIRE, "agent");
            xb_add(&bar[XB_XGEN(bx)], 1u);
            asm volatile("s_waitcnt vmcnt(0)" ::: "memory");
        } else {
            XB_SPIN(xb_ld(&bar[XB_XGEN(bx)]) == gen, bar);
            __builtin_amdgcn_fence(__ATOMIC_ACQUIRE, "agent");
            asm volatile("s_waitcnt vmcnt(0)" ::: "memory");
        }
    }
    __syncthreads();
}
}

namespace misc {
DEV void ada_phase(LAS unsigned char* lds, const float* __restrict__ c, const float* __restrict__ w_ada, const float* __restrict__ b_ada, float* __restrict__ ada, int G, int cblk, int wv) {
    int wv_ = wv, ln_; asm volatile("v_mbcnt_lo_u32_b32 %1, -1, 0\n\tv_mbcnt_hi_u32_b32 %1, -1, %1" : "+s"(wv_), "=v"(ln_)); int tid_ = (wv_ << 6) | ln_; const int tid = tid_, col = tid & 63, kg = tid >> 6;
    LAS float* cond = (LAS float*)lds;
    LAS float* part = (LAS float*)(lds + 65536);
    for (int i = tid; i < 16384; i += 512) { const float v = c[i]; cond[i] = v / (1.f + __expf(-v)); }
    __syncthreads();
#pragma unroll 1
    for (int item = cblk; item < 192; item += G) { const int l = item / 96, n0 = (item - l * 96) * 64;
        float acc[16];
#pragma unroll
        for (int b = 0; b < 16; ++b) acc[b] = 0.f;
        const float* wp = w_ada + ((size_t)l * 1024 + kg * 128) * 6144 + n0 + col;
#pragma unroll 2
        for (int kk = 0; kk < 128; kk += 8) { float wv[8];
#pragma unroll
            for (int j = 0; j < 8; ++j) wv[j] = wp[(size_t)(kk + j) * 6144];
#pragma unroll
            for (int b = 0; b < 16; ++b) { const f32x4 c0 = *(const LAS f32x4*)(cond + b * 1024 + kg * 128 + kk), c1 = *(const LAS f32x4*)(cond + b * 1024 + kg * 128 + kk + 4);
                acc[b] += (c0[0] * wv[0] + c0[1] * wv[1]) + (c0[2] * wv[2] + c0[3] * wv[3]) + (c1[0] * wv[4] + c1[1] * wv[5]) + (c1[2] * wv[6] + c1[3] * wv[7]); } }
#pragma unroll
        for (int b = 0; b < 16; ++b) part[(kg * 16 + b) * 64 + col] = acc[b];
        __syncthreads();
        for (int o = tid; o < 1024; o += 512) { const int b = o >> 6, cc = o & 63; float sacc = b_ada[l * 6144 + n0 + cc];
#pragma unroll
            for (int g8 = 0; g8 < 8; ++g8) sacc += part[(g8 * 16 + b) * 64 + cc];
            ada[((size_t)l * 16 + b) * 6144 + n0 + cc] = sacc; }
        __syncthreads();
    }
}
DEV void yprep_phase(LAS unsigned char* lds, const bf16_t* __restrict__ hyT, const bf16_t* P, const float* __restrict__ lse2, bf16_t* Y, int G, int cblk, int wv) {
    int wv_ = wv, ln_; asm volatile("v_mbcnt_lo_u32_b32 %1, -1, 0\n\tv_mbcnt_hi_u32_b32 %1, -1, %1" : "+s"(wv_), "=v"(ln_)); int tid_ = (wv_ << 6) | ln_; const int tid = tid_;
    LAS unsigned short* tile = (LAS unsigned short*)lds;
#pragma unroll 1
    for (int it = cblk; it < 4096; it += G) { const int t0 = (it >> 3) * 64, c0 = (it & 7) * 64;
        __syncthreads();
        { const int cc = tid >> 3, seg = (tid & 7) * 8; const u32x4 v = *(const u32x4*)(hyT + (size_t)(c0 + cc) * T_ + t0 + seg); *(LAS u32x4*)(tile + cc * 72 + seg) = v; }
        __syncthreads();
        { const int tt = tid >> 3, seg = (tid & 7) * 8; unsigned wv[4];
#pragma unroll
            for (int e = 0; e < 4; ++e) wv[e] = (unsigned)tile[(seg + 2 * e) * 72 + tt] | ((unsigned)tile[(seg + 2 * e + 1) * 72 + tt] << 16);
            *(u32x4*)(Y + (size_t)(t0 + tt) * UYW_ + 256 + c0 + seg) = (u32x4){wv[0], wv[1], wv[2], wv[3]}; }
    }
#pragma unroll 1
    for (size_t idx = (size_t)cblk * 512 + tid; idx < (size_t)T_ * 32; idx += (size_t)G * 512) { const size_t tok = idx >> 5; const int c8 = (int)(idx & 31) * 8, hh = c8 >> 6;
        const float l0 = lse2[tok * 12 + hh], l1 = lse2[tok * 12 + 4 + hh], l2 = lse2[tok * 12 + 8 + hh]; const float mx = fmaxf(l0, fmaxf(l1, l2));
        float w0 = exp2f(l0 - mx), w1 = exp2f(l1 - mx), w2 = exp2f(l2 - mx); const float inv = 1.f / (w0 + w1 + w2); w0 *= inv; w1 *= inv; w2 *= inv;
        const bf16_t* pr = P + tok * PW_ + c8; const u32x4 a = *(const u32x4*)pr, b = *(const u32x4*)(pr + 256), c = *(const u32x4*)(pr + 512);
        const unsigned aw[4] = {a.x, a.y, a.z, a.w}, bw[4] = {b.x, b.y, b.z, b.w}, cw[4] = {c.x, c.y, c.z, c.w}; unsigned o[4];
#pragma unroll
        for (int e = 0; e < 4; ++e) { const float lo = w0 * __uint_as_float(aw[e] << 16) + w1 * __uint_as_float(bw[e] << 16) + w2 * __uint_as_float(cw[e] << 16);
            const float hi = w0 * __uint_as_float(aw[e] & 0xffff0000u) + w1 * __uint_as_float(bw[e] & 0xffff0000u) + w2 * __uint_as_float(cw[e] & 0xffff0000u); o[e] = pg8::cvt_pk_bf16(lo, hi); }
        *(u32x4*)(Y + tok * UYW_ + c8) = (u32x4){o[0], o[1], o[2], o[3]}; }
    __syncthreads();
}
DEV void filt_phase(LAS unsigned char* lds, const float* __restrict__ h2, const float* __restrict__ w3, const float* __restrict__ log_decay, bf16_t* __restrict__ Gr, int G, int cblk, int wv) {
    int wv_ = wv, ln_; asm volatile("v_mbcnt_lo_u32_b32 %1, -1, 0\n\tv_mbcnt_hi_u32_b32 %1, -1, %1" : "+s"(wv_), "=v"(ln_)); const int tid = (wv_ << 6) | ln_, lane = ln_;
    LAS float* hrow = (LAS float*)lds;
    LAS float* w3s = (LAS float*)(lds + 512 * 68 * 4);
    LAS float* dec = w3s + 1024;
    LAS float* red = dec + 16;
#pragma unroll 1
    for (int item = cblk; item < 256; item += G) { const int l = item >> 7, o = (item >> 6) & 1, cg = item & 63; const int colf0 = o * 512 + cg * 8;
        __syncthreads();
        for (int i = tid; i < 1024; i += 512) { const int jj = i >> 4, c16 = i & 15; const int col = (c16 < 8) ? colf0 + c16 : 1024 + colf0 + (c16 - 8); w3s[i] = w3[((size_t)l * 64 + jj) * 2048 + col]; }
        if (tid < 16) { const int col = (tid < 8) ? colf0 + tid : 1024 + colf0 + (tid - 8); dec[tid] = __expf(log_decay[l * 2048 + col]); }
        float vals[4][16];
#pragma unroll
        for (int ch = 0; ch < 4; ++ch) {
            __syncthreads();
            { const float* src = h2 + ((size_t)l * 2048 + ch * 512) * 64;
#pragma unroll 4
                for (int k = 0; k < 16; ++k) { const int idx = tid + 512 * k; const int row = idx >> 4, c4 = idx & 15; *(LAS f32x4*)(hrow + row * 68 + c4 * 4) = *(const f32x4*)(src + (size_t)idx * 4); } }
            __syncthreads();
            float acc[16];
#pragma unroll
            for (int c = 0; c < 16; ++c) acc[c] = 0.f;
#pragma unroll 2
            for (int j4 = 0; j4 < 16; ++j4) { const f32x4 hv = *(const LAS f32x4*)(hrow + tid * 68 + j4 * 4); const float hh4[4] = {hv.x, hv.y, hv.z, hv.w};
#pragma unroll
                for (int e = 0; e < 4; ++e) { const LAS f32x4* wr = (const LAS f32x4*)(w3s + (j4 * 4 + e) * 16); const f32x4 w0 = wr[0], w1 = wr[1], w2 = wr[2], w3v = wr[3];
                    acc[0] += hh4[e] * w0.x; acc[1] += hh4[e] * w0.y; acc[2] += hh4[e] * w0.z; acc[3] += hh4[e] * w0.w; acc[4] += hh4[e] * w1.x; acc[5] += hh4[e] * w1.y; acc[6] += hh4[e] * w1.z; acc[7] += hh4[e] * w1.w;
                    acc[8] += hh4[e] * w2.x; acc[9] += hh4[e] * w2.y; acc[10] += hh4[e] * w2.z; acc[11] += hh4[e] * w2.w; acc[12] += hh4[e] * w3v.x; acc[13] += hh4[e] * w3v.y; acc[14] += hh4[e] * w3v.z; acc[15] += hh4[e] * w3v.w; } }
            const float tn = (float)(ch * 512 + tid) * (1.f / 2047.f);
#pragma unroll
            for (int c = 0; c < 16; ++c) vals[ch][c] = acc[c] * __expf(-tn * dec[c]);
        }
        float ss[8];
#pragma unroll
        for (int c = 0; c < 8; ++c) { float a = 0.f;
#pragma unroll
            for (int ch = 0; ch < 4; ++ch) { a += vals[ch][c] * vals[ch][c]; if (ch > 0 || tid > 0) a += vals[ch][8 + c] * vals[ch][8 + c]; }
            ss[c] = peer::wave_sum(a, lane); }
        if (lane == 0) {
#pragma unroll
            for (int c = 0; c < 8; ++c) red[wv_ * 8 + c] = ss[c]; }
        __syncthreads();
        float scale[8];
#pragma unroll
        for (int c = 0; c < 8; ++c) { float a = 0.f;
#pragma unroll
            for (int g8 = 0; g8 < 8; ++g8) a += red[g8 * 8 + c];
            scale[c] = rsqrtf(a + 1e-12f); }
#pragma unroll
        for (int c = 0; c < 8; ++c) { bf16_t* gp = Gr + (((size_t)l * 2 + o) * 512 + cg * 8 + c) * 4096;
#pragma unroll
            for (int ch = 0; ch < 4; ++ch) { const int t = ch * 512 + tid; gp[2047 - t] = f2bf(vals[ch][c] * scale[c]); if (t > 0) gp[2047 + t] = f2bf(vals[ch][8 + c] * scale[c]); }
            if (tid == 0) gp[4095] = 0; }
    }
    __syncthreads();
}
DEV void modulate_phase(const float* __restrict__ x, const float* __restrict__ ada0, bf16_t* UY, float* __restrict__ su, int G, int cblk, int wv) {
    int wv_ = wv, ln_; asm volatile("v_mbcnt_lo_u32_b32 %1, -1, 0\n\tv_mbcnt_hi_u32_b32 %1, -1, %1" : "+s"(wv_), "=v"(ln_)); const int lane = ln_, w = wv_; const int d0 = 16 * lane;
#pragma unroll 1
    for (int tok0 = cblk * 8 + w; tok0 < T_; tok0 += 4 * G * 8) { float4 xv[4][4];
#pragma unroll
        for (int tt = 0; tt < 4; ++tt) { const int tk = tok0 + tt * G * 8; const float* xr = x + (size_t)(tk < T_ ? tk : tok0) * 1024 + d0;
#pragma unroll
            for (int j = 0; j < 4; ++j) xv[tt][j] = *(const float4*)(xr + 4 * j); }
#pragma unroll
        for (int tt = 0; tt < 4; ++tt) { const int tok = tok0 + tt * G * 8; const float* a = ada0 + (size_t)((tok < T_ ? tok : tok0) >> 11) * 6144; float u[16]; float um = 0.f;
#pragma unroll
            for (int j = 0; j < 16; j += 4) { const float4 xq = xv[tt][j >> 2], sc = *(const float4*)(a + 1024 + d0 + j), sh = *(const float4*)(a + d0 + j);
                u[j] = xq.x * (1.f + sc.x) + sh.x; u[j + 1] = xq.y * (1.f + sc.y) + sh.y; u[j + 2] = xq.z * (1.f + sc.z) + sh.z; u[j + 3] = xq.w * (1.f + sc.w) + sh.w;
                um = fmaxf(um, fmaxf(fmaxf(fabsf(u[j]), fabsf(u[j + 1])), fmaxf(fabsf(u[j + 2]), fabsf(u[j + 3])))); }
            um = peer::wave_max(um, lane); const float qs = (um > 0.f) ? 127.f / um : 0.f; unsigned o[4];
#pragma unroll
            for (int e = 0; e < 4; ++e) { o[e] = 0u;
#pragma unroll
                for (int j = 0; j < 4; ++j) o[e] |= ((unsigned)(int)rintf(u[4 * e + j] * qs) & 0xffu) << (8 * j); }
            if (tok < T_) { *(u32x4*)((unsigned char*)(UY + (size_t)tok * UYW_) + d0) = (u32x4){o[0], o[1], o[2], o[3]};
                if (lane == 0) su[tok] = um * (1.f / 127.f); } } }
}
DEV void lnmod_phase(bf16_t* hx, const float* __restrict__ ada_l, const float* __restrict__ g, const float* __restrict__ bta, bf16_t* UY, int G, int cblk, int wv) {
    int wv_ = wv, ln_; asm volatile("v_mbcnt_lo_u32_b32 %1, -1, 0\n\tv_mbcnt_hi_u32_b32 %1, -1, %1" : "+s"(wv_), "=v"(ln_)); const int lane = ln_, w = wv_; const int d0 = 16 * lane;
#pragma unroll 1
    for (int tok0 = cblk * 8 + w; tok0 < T_; tok0 += 2 * G * 8) { u32x4 q[2][2]; const int tok1 = tok0 + G * 8; const bool two = tok1 < T_;
        q[0][0] = *(const u32x4*)(hx + (size_t)tok0 * 1024 + d0); q[0][1] = *(const u32x4*)(hx + (size_t)tok0 * 1024 + d0 + 8);
        q[1][0] = q[0][0]; q[1][1] = q[0][1]; if (two) { q[1][0] = *(const u32x4*)(hx + (size_t)tok1 * 1024 + d0); q[1][1] = *(const u32x4*)(hx + (size_t)tok1 * 1024 + d0 + 8); }
#pragma unroll
        for (int t = 0; t < 2; ++t) { const int tok = t ? tok1 : tok0; float hv[16]; float s = 0.f;
#pragma unroll
            for (int j = 0; j < 2; ++j) { const u32x4 v = q[t][j]; hv[8 * j] = __uint_as_float(v.x << 16); hv[8 * j + 1] = __uint_as_float(v.x & 0xffff0000u); hv[8 * j + 2] = __uint_as_float(v.y << 16); hv[8 * j + 3] = __uint_as_float(v.y & 0xffff0000u);
                hv[8 * j + 4] = __uint_as_float(v.z << 16); hv[8 * j + 5] = __uint_as_float(v.z & 0xffff0000u); hv[8 * j + 6] = __uint_as_float(v.w << 16); hv[8 * j + 7] = __uint_as_float(v.w & 0xffff0000u); }
#pragma unroll
            for (int j = 0; j < 16; j += 4) s += (hv[j] + hv[j + 1]) + (hv[j + 2] + hv[j + 3]);
            const float mu = peer::wave_sum(s, lane) * (1.f / 1024.f); float qq = 0.f;
#pragma unroll
            for (int j = 0; j < 16; ++j) { const float dd = hv[j] - mu; qq += dd * dd; }
            const float rstd = rsqrtf(peer::wave_sum(qq, lane) * (1.f / 1024.f) + LN_EPS_);
            const float* a = ada_l + (size_t)(tok >> 11) * 6144; float y[16], uu[16];
#pragma unroll
            for (int j = 0; j < 16; j += 4) { const float4 gg = *(const float4*)(g + d0 + j), bb = *(const float4*)(bta + d0 + j), sc = *(const float4*)(a + 4096 + d0 + j), sh = *(const float4*)(a + 3072 + d0 + j);
                y[j] = (hv[j] - mu) * rstd * gg.x + bb.x; y[j + 1] = (hv[j + 1] - mu) * rstd * gg.y + bb.y; y[j + 2] = (hv[j + 2] - mu) * rstd * gg.z + bb.z; y[j + 3] = (hv[j + 3] - mu) * rstd * gg.w + bb.w;
                uu[j] = y[j] * (1.f + sc.x) + sh.x; uu[j + 1] = y[j + 1] * (1.f + sc.y) + sh.y; uu[j + 2] = y[j + 2] * (1.f + sc.z) + sh.z; uu[j + 3] = y[j + 3] * (1.f + sc.w) + sh.w; }
            if (t == 0 || two) { u32x4 q0, q1, p0, p1;
                q0.x = pg8::cvt_pk_bf16(y[0], y[1]); q0.y = pg8::cvt_pk_bf16(y[2], y[3]); q0.z = pg8::cvt_pk_bf16(y[4], y[5]); q0.w = pg8::cvt_pk_bf16(y[6], y[7]);
                q1.x = pg8::cvt_pk_bf16(y[8], y[9]); q1.y = pg8::cvt_pk_bf16(y[10], y[11]); q1.z = pg8::cvt_pk_bf16(y[12], y[13]); q1.w = pg8::cvt_pk_bf16(y[14], y[15]);
                p0.x = pg8::cvt_pk_bf16(uu[0], uu[1]); p0.y = pg8::cvt_pk_bf16(uu[2], uu[3]); p0.z = pg8::cvt_pk_bf16(uu[4], uu[5]); p0.w = pg8::cvt_pk_bf16(uu[6], uu[7]);
                p1.x = pg8::cvt_pk_bf16(uu[8], uu[9]); p1.y = pg8::cvt_pk_bf16(uu[10], uu[11]); p1.z = pg8::cvt_pk_bf16(uu[12], uu[13]); p1.w = pg8::cvt_pk_bf16(uu[14], uu[15]);
                bf16_t* xo = hx + (size_t)tok * 1024 + d0; *(u32x4*)xo = q0; *(u32x4*)(xo + 8) = q1; bf16_t* up = UY + (size_t)tok * UYW_ + d0; *(u32x4*)up = p0; *(u32x4*)(up + 8) = p1; } }
    }
}
}

struct Params {
    const float *x, *c, *w_ada, *b_ada, *w_in, *conv_w, *conv_b, *hy_w1, *hy_b1, *hy_w2, *hy_b2, *hy_w3, *hy_freq, *hy_ld, *hy_bias, *attn_sink, *wba, *wbb, *wbc, *w_out, *ln_g, *ln_b,
        *peer_wq, *peer_keys, *peer_u, *peer_v;
    float* out; char* ws;
};
constexpr int LDS_PHASE = 148480;
constexpr int LDS_BYTES = LDS_PHASE + 16;
constexpr size_t OFF_BAR = OFF_LSE + 1792 * 1024;

#define RUN(nvb, call) do { const int wv = wave_s; int wv_ = wv, ln_; asm volatile("v_mbcnt_lo_u32_b32 %1, -1, 0\n\tv_mbcnt_hi_u32_b32 %1, -1, %1" : "+s"(wv_), "=v"(ln_)); int tid_ = (wv_ << 6) | ln_; const int t = tid_ & 255, sub = tid_ >> 8; unsigned char* sm = lds + sub * 16384; \
        for (int vb = (int)blockIdx.x * 2 + sub; vb < (nvb); vb += (int)gridDim.x * 2) { call; __syncthreads(); } } while (0)
#define GSYNC_CG() do { __builtin_amdgcn_sched_barrier(0); grid.sync(); __builtin_amdgcn_sched_barrier(0); } while (0)
#define GSYNC() do { __builtin_amdgcn_sched_barrier(0); xb::xcd_barrier(xbar, wave_s); __builtin_amdgcn_sched_barrier(0); } while (0)

__global__ void __launch_bounds__(512, 2) mega(Params p) {
    extern __shared__ __attribute__((aligned(16))) unsigned char lds[];
    cg::grid_group grid = cg::this_grid();
    LAS unsigned char* ldsl = (LAS unsigned char*)lds;
    const int G = gridDim.x, cblk = blockIdx.x;
    const int wave_s = __builtin_amdgcn_readfirstlane((int)threadIdx.x >> 6);
    float* out = p.out; (void)out;
    if (threadIdx.x < 4) ((LAS unsigned*)(ldsl + LDS_PHASE))[threadIdx.x] = 0u;
    __syncthreads();
    const xb::XcdBarrier xbar = xb::xcd_barrier_post((unsigned*)(p.ws + OFF_BAR), (volatile LAS unsigned*)(ldsl + LDS_PHASE));
    {
    char* ws = p.ws;
    float* ada = (float*)(ws + OFF_ADA); float2* rope = (float2*)(ws + OFF_ROPE); bf16_t* Gr = (bf16_t*)(ws + OFF_GR); float* lse2 = (float*)(ws + OFF_LSE);
    unsigned char* WinT8 = (unsigned char*)(ws + OFF_WINT); unsigned char* WmT8 = (unsigned char*)(ws + OFF_WMT); float* su = (float*)(ws + OFF_LSE + 1536 * 1024); float* winv = (float*)(ws + OFF_LSE + 1664 * 1024);     bf16_t* WoutT = (bf16_t*)(ws + OFF_WOUTT); bf16_t* WqT = (bf16_t*)(ws + OFF_WQT);
    bf16_t* UY = (bf16_t*)(ws + OFF_UY); bf16_t* Y = UY + 1024; bf16_t* P = (bf16_t*)(ws + OFF_P); bf16_t* hyT = (bf16_t*)(ws + OFF_HYT);
    bf16_t* merged = (bf16_t*)(ws + OFF_P); bf16_t* gtmp = (bf16_t*)(ws + OFF_P + 64 * MB_); bf16_t* Q2 = (bf16_t*)(ws + OFF_P); bf16_t* x1b = (bf16_t*)(ws + OFF_P + 128 * MB_);
    int* eidx = (int*)(ws + OFF_HYT); float* egate = (float*)(ws + OFF_HYT + 16 * MB_); unsigned char* U8 = (unsigned char*)(ws + OFF_HYT + 32 * MB_); unsigned char* V4 = (unsigned char*)(ws + OFF_HYT + 48 * MB_); float* sinv = (float*)(ws + OFF_HYT + 64 * MB_);
    float* h2 = (float*)(ws + OFF_P);
    (void)lse2; (void)P; (void)hyT; (void)merged; (void)gtmp; (void)Q2; (void)x1b; (void)eidx; (void)egate; (void)U8; (void)V4; (void)sinv; (void)Y;

    misc::ada_phase(ldsl, p.c, p.w_ada, p.b_ada, ada, G, cblk, wave_s);
    RUN(256, nb_rope(vb, t, sm, rope));
    RUN(1024, nb_filt_h2(vb, t, sm, p.hy_w1, p.hy_b1, p.hy_w2, p.hy_b2, p.hy_freq, h2));
    winprep_phase(ldsl, p.w_in, WinT8, WmT8, winv, G, cblk, wave_s);
    { const WPrep wq{p.w_in, p.wba, p.wbb, p.wbc, p.w_out, p.peer_wq, WinT8, WmT8, WoutT, WqT}; RUN(2176, nb_wprep(vb, t, sm, wq)); }
    GSYNC();
    misc::filt_phase(ldsl, h2, p.hy_w3, p.hy_ld, Gr, G, cblk, wave_s);
    misc::modulate_phase(p.x, ada, UY, su, G, cblk, wave_s);
    GSYNC();
    }
#pragma unroll 1
    for (int l = 0; l < 2; ++l) {
        size_t zoff = 0; asm volatile("" : "+s"(zoff));
        char* ws = p.ws + zoff; float* out = p.out + zoff;
        int Gl = gridDim.x, cl = blockIdx.x; asm volatile("" : "+s"(Gl), "+s"(cl));
        float* ada = (float*)(ws + OFF_ADA); float2* rope = (float2*)(ws + OFF_ROPE); bf16_t* Gr = (bf16_t*)(ws + OFF_GR); float* lse2 = (float*)(ws + OFF_LSE);
        unsigned char* WinT8 = (unsigned char*)(ws + OFF_WINT); unsigned char* WmT8 = (unsigned char*)(ws + OFF_WMT); float* su = (float*)(ws + OFF_LSE + 1536 * 1024); float* winv = (float*)(ws + OFF_LSE + 1664 * 1024);     bf16_t* WoutT = (bf16_t*)(ws + OFF_WOUTT); bf16_t* WqT = (bf16_t*)(ws + OFF_WQT);
        bf16_t* UY = (bf16_t*)(ws + OFF_UY); bf16_t* Y = UY + 1024; bf16_t* P = (bf16_t*)(ws + OFF_P); bf16_t* hyT = (bf16_t*)(ws + OFF_HYT);
        bf16_t* merged = (bf16_t*)(ws + OFF_P); bf16_t* gtmp = (bf16_t*)(ws + OFF_P + 64 * MB_); bf16_t* Q2 = (bf16_t*)(ws + OFF_P); bf16_t* x1b = (bf16_t*)(ws + OFF_P + 128 * MB_);
        int* eidx = (int*)(ws + OFF_HYT); float* egate = (float*)(ws + OFF_HYT + 16 * MB_); unsigned char* U8 = (unsigned char*)(ws + OFF_HYT + 32 * MB_); unsigned char* V4 = (unsigned char*)(ws + OFF_HYT + 48 * MB_); float* sinv = (float*)(ws + OFF_HYT + 64 * MB_);
        const float* ada_l = ada + (size_t)l * 16 * 6144;
        const unsigned char* WinT8_l = WinT8 + (size_t)l * 4608 * 1024;
        {
            const pg8::PlainSched S1{UY, (const bf16_t*)WinT8_l, UYW_, 512, 128, 12, 8, Gl, cl, 0, 1 << 30}; const pg8::EpiP E1{P, rope, su, winv + (size_t)l * 7680};
            pg8::gemm_phase<pg8::EpiP, pg8::PlainSched, true, true, 1>(ldsl, UYW_, 512, S1, E1, wave_s);
            const pg8::PlainSched S2{(const bf16_t*)(WinT8_l + (size_t)3072 * 1024), UY, 512, UYW_, 6, 128, 8, Gl, cl, 0, 1 << 30}; const pg8::EpiHyT8 E2{hyT, su, winv + (size_t)l * 7680 + 3072};
            pg8::gemm_phase<pg8::EpiHyT8, pg8::PlainSched, true, true, 1>(ldsl, 512, UYW_, S2, E2, wave_s);
        }
        GSYNC();
        at::attn_phase(ldsl, P, lse2, Y, p.attn_sink + l * 8, Gl, cl, wave_s);
        hy::hyena_phase(ldsl, hyT, Gr + (size_t)l * 2 * 512 * 4096, p.conv_w + (size_t)l * 3 * 1536, p.conv_b + (size_t)l * 1536, p.hy_bias + (size_t)l * 1024, Gl, cl, wave_s);
        GSYNC();
        misc::yprep_phase(ldsl, hyT, P, lse2, Y, Gl, cl, wave_s);
        GSYNC();
        {
            const unsigned char* WmT8_l = WmT8 + (size_t)l * 1024 * (WMW_ * 2);
            static_assert(OFF_P + 192 * MB_ == OFF_HYT, "gate buffers");
            const pg8::GateSched Sg{UY, WmT8_l, Gl, cl}; const pg8::EpiGate Eg{gtmp, su, winv + (size_t)l * 7680 + 4608};
            pg8::gemm_phase<pg8::EpiGate, pg8::GateSched, true, true, 1>(ldsl, UYW_, WMW_, Sg, Eg, wave_s);
            const pg8::Branch3Sched Sb{UY, WmT8_l, Gl, cl}; const pg8::EpiBranch3 Eb{gtmp, merged};
            pg8::gemm_phase<pg8::EpiBranch3, pg8::Branch3Sched, true, true, 0>(ldsl, UYW_, WMW_, Sb, Eb, wave_s);
        }
        GSYNC();
        {
            const pg8::PlainSched S{merged, WoutT + (size_t)l * 1024 * 1024, 1024, 1024, 128, 4, 16, Gl, cl, 0, 1 << 30}; const pg8::EpiH E{(l == 0) ? p.x : (const float*)nullptr, (const bf16_t*)out, x1b, ada_l};
            pg8::gemm_phase(ldsl, 1024, 1024, S, E, wave_s);
        }
        RUN(8192, peer::nb_quant_tables(vb, t, p.peer_u + (size_t)l * 16384 * 1024, p.peer_v + (size_t)l * 16384 * 1024, U8, V4, sinv));
        GSYNC();
        misc::lnmod_phase(x1b, ada_l, p.ln_g + (size_t)(l * 2 + 0) * 1024, p.ln_b + (size_t)(l * 2 + 0) * 1024, UY, Gl, cl, wave_s);
        GSYNC();
        {
            const pg8::PlainSched S{UY, WqT + (size_t)l * 2048 * 1024, UYW_, 1024, 128, 8, 16, Gl, cl, 0, 1 << 30}; const pg8::EpiBf E{Q2, 2048, 0};
            pg8::gemm_phase(ldsl, UYW_, 1024, S, E, wave_s);
        }
        GSYNC();
        tk::topk_phase(ldsl, Q2, p.peer_keys + (size_t)l * 8 * 2 * 128 * 128, eidx, egate, Gl, cl, wave_s);
        GSYNC();
        peer::peer_phase(ldsl, x1b, out, (l == 0) ? (bf16_t*)out : (bf16_t*)nullptr, ada_l, eidx, egate, U8, V4, sinv, p.ln_g + (size_t)(l * 2 + 1) * 1024, p.ln_b + (size_t)(l * 2 + 1) * 1024,
                         (l == 0) ? ada + (size_t)16 * 6144 : (const float*)nullptr, UY, su, Gl, cl, wave_s);
        if (l == 0) GSYNC();
    }
}

extern "C" void kernel_launch(void* const* d_in, const int* in_sizes, int n_in, void* d_out, int out_size, void* d_ws, size_t ws_size, hipStream_t stream) {
    static int grid = 0;
    if (grid == 0) {
        if (ws_size < WS_NEED || n_in != 26) { fprintf(stderr, "kernel_launch: workspace %zu < %zu or n_in %d != 26\n", ws_size, (size_t)WS_NEED, n_in); grid = -1; return; }
        int dev = 0, cus = 0, per_cu = 0;
        (void)hipGetDevice(&dev); (void)hipDeviceGetAttribute(&cus, hipDeviceAttributeMultiprocessorCount, dev);
        (void)hipFuncSetAttribute((const void*)mega, hipFuncAttributeMaxDynamicSharedMemorySize, LDS_BYTES);
        (void)hipOccupancyMaxActiveBlocksPerMultiprocessor(&per_cu, (const void*)mega, 512, LDS_BYTES);
        if (per_cu < 1) { fprintf(stderr, "kernel_launch: occupancy query says %d blocks per CU\n", per_cu); grid = -1; return; }
        if (cus != 256) { fprintf(stderr, "kernel_launch: built for a 256-CU device (work partitions and the XCD barrier assume 256 workgroups), found %d CUs\n", cus); grid = -1; return; }
        grid = cus;
    }
    if (grid < 0) return;
    Params p{};
    const float** pp = (const float**)&p;
    for (int i = 0; i < 26; ++i) pp[i] = (const float*)d_in[i];
    p.out = (float*)d_out; p.ws = (char*)d_ws;
    (void)hipMemsetAsync((char*)d_ws + OFF_BAR, 0, 16384, stream);
    void* args[] = {&p};
    hipError_t e = hipLaunchCooperativeKernel((const void*)mega, dim3(grid), dim3(512), args, LDS_BYTES, stream);
    if (e != hipSuccess) fprintf(stderr, "cooperative launch failed: %s (grid %d)\n", hipGetErrorString(e), grid);
}
```

```cpp
#include <hip/hip_runtime.h>
#include <hip/hip_cooperative_groups.h>
namespace cg = cooperative_groups;
#include <stdint.h>
#include <stdio.h>

#define DEV __device__ __forceinline__
typedef unsigned short bf16_t;

constexpr int D_ = 1024, B_ = 16, S_ = 2048, T_ = B_ * S_;
constexpr float ALPHA_ = 1.41421356237309515f;
constexpr float LOG2E_ = 1.4426950408889634f;
constexpr float QSCALE_ = 0.125f * 1.4426950408889634f;
constexpr float LN_EPS_ = 1e-5f;
constexpr int PW_ = 3072;
constexpr int UYW_ = 2304;
constexpr int WMW_ = 2816;
constexpr size_t GSTRIDE_ = (size_t)32 * 1024 * 1024;

constexpr size_t MB_ = 1024 * 1024;
constexpr size_t OFF_ADA = 0, OFF_ROPE = 1 * MB_, OFF_GR = 2 * MB_, OFF_LSE = 18 * MB_, OFF_WINT = 20 * MB_, OFF_WMT = 50 * MB_,
                 OFF_WOUTT = 68 * MB_, OFF_WQT = 72 * MB_, OFF_KEYS = 80 * MB_, OFF_UY = 82 * MB_, OFF_P = 226 * MB_, OFF_HYT = 418 * MB_,
                 WS_NEED = 514 * MB_;

DEV int xor_i(int v, int off, int lane) { return __builtin_amdgcn_ds_bpermute((lane ^ off) << 2, v); }
DEV float xor_f(float v, int off, int lane) { return __int_as_float(__builtin_amdgcn_ds_bpermute((lane ^ off) << 2, __float_as_int(v))); }
DEV float bf2f(bf16_t v) { return __uint_as_float(((unsigned)v) << 16); }
DEV bf16_t f2bf(float f) { unsigned u = __float_as_uint(f); u += 0x7FFFu + ((u >> 16) & 1u); return (bf16_t)(u >> 16); }

DEV void nb_rope(int vb, int t, unsigned char* sm, float2* __restrict__ rope) {
    const int idx = vb * 256 + t; const int s = idx >> 5, i = idx & 31;
    const float inv = powf(10000.f, -(float)i / 32.f); const float ang = (float)s * inv;
    rope[idx] = make_float2(cosf(ang), sinf(ang));
}

DEV void nb_filt_h2(int vb, int t, unsigned char* sm, const float* __restrict__ w1, const float* __restrict__ b1, const float* __restrict__ w2, const float* __restrict__ b2,
                                                const float* __restrict__ freq, float* __restrict__ h2) {
    const int grp = t >> 6, j = t & 63; const int lt = vb * 4 + grp; const int l = lt / 2048, tt = lt % 2048;
    float* z = (float*)sm + grp * 128; float* h1 = z + 64;
    if (j < 33) {
        const float idx = (float)tt, tn = idx / 2047.f, w = 6.283185307179586f * idx / 2048.f;
        if (j == 0) z[0] = tn;
        else { const int k = (j <= 16) ? (j - 1) : (j - 17); const float band = 1e-4f + (float)k * ((15.f - 1e-4f) / 15.f); const float ang = w * band;
            z[j] = (j <= 16) ? cosf(ang) : -sinf(ang); }
    }
    __syncthreads();
    float a = b1[l * 64 + j];
    for (int e = 0; e < 33; ++e) a += z[e] * w1[(l * 33 + e) * 64 + j];
    h1[j] = sinf(freq[(l * 2 + 0) * 64 + j] * a);
    __syncthreads();
    float a2 = b2[l * 64 + j];
    for (int i = 0; i < 64; ++i) a2 += h1[i] * w2[(l * 64 + i) * 64 + j];
    h2[((size_t)l * 2048 + tt) * 64 + j] = sinf(freq[(l * 2 + 1) * 64 + j] * a2);
}

DEV void filt_h2_phase(__attribute__((address_space(3))) unsigned char* lds, const float* __restrict__ w1, const float* __restrict__ b1, const float* __restrict__ w2, const float* __restrict__ b2,
                       const float* __restrict__ freq, float* __restrict__ h2, int G, int cblk, int wv) {
    int wv_ = wv, ln_; asm volatile("v_mbcnt_lo_u32_b32 %1, -1, 0\n\tv_mbcnt_hi_u32_b32 %1, -1, %1" : "+s"(wv_), "=v"(ln_)); const int j = ln_, grp = wv_, tid = (wv_ << 6) | ln_;
    typedef float f4_ __attribute__((ext_vector_type(4)));
    __attribute__((address_space(3))) float* W2 = (__attribute__((address_space(3))) float*)lds;
    __attribute__((address_space(3))) float* W1 = W2 + 4096;
    __attribute__((address_space(3))) float* zz = W1 + 33 * 64 + grp * 128;
    const int per = 4096 / G, p0 = cblk * per, l = p0 / 2048;
    __syncthreads();
    for (int i = tid; i < 1024; i += 512) *(__attribute__((address_space(3))) f4_*)(W2 + 4 * i) = *(const f4_*)(w2 + (size_t)l * 4096 + 4 * i);
    for (int i = tid; i < 528; i += 512) *(__attribute__((address_space(3))) f4_*)(W1 + 4 * i) = *(const f4_*)(w1 + (size_t)l * 2112 + 4 * i);
    const float b1v = b1[l * 64 + j], b2v = b2[l * 64 + j], f0 = freq[(l * 2 + 0) * 64 + j], f1 = freq[(l * 2 + 1) * 64 + j];
    __syncthreads();
#pragma unroll 1
    for (int pp = grp; pp < per; pp += 8) { const int tt = (p0 + pp) % 2048;
        if (j < 33) {
            const float idx = (float)tt, tn = idx / 2047.f, w = 6.283185307179586f * idx / 2048.f;
            if (j == 0) zz[0] = tn;
            else { const int k = (j <= 16) ? (j - 1) : (j - 17); const float band = 1e-4f + (float)k * ((15.f - 1e-4f) / 15.f); const float ang = w * band;
                zz[j] = (j <= 16) ? cosf(ang) : -sinf(ang); }
        }
        asm volatile("s_waitcnt lgkmcnt(0)" ::: "memory");
        float a = b1v;
#pragma unroll
        for (int e = 0; e < 33; ++e) a += zz[e] * W1[e * 64 + j];
        zz[64 + j] = sinf(f0 * a);
        asm volatile("s_waitcnt lgkmcnt(0)" ::: "memory");
        float a2 = b2v;
#pragma unroll 16
        for (int i = 0; i < 64; ++i) a2 += zz[64 + i] * W2[i * 64 + j];
        h2[((size_t)l * 2048 + tt) * 64 + j] = sinf(f1 * a2);
        asm volatile("s_waitcnt lgkmcnt(0)" ::: "memory");
    }
    __syncthreads();
}

#define LAS __attribute__((address_space(3)))
typedef short bf16x8 __attribute__((ext_vector_type(8)));
typedef float f32x4 __attribute__((ext_vector_type(4)));
typedef float f32x2 __attribute__((ext_vector_type(2)));
typedef unsigned u32x4 __attribute__((ext_vector_type(4)));
typedef unsigned u32x2 __attribute__((ext_vector_type(2)));
typedef int i32x8 __attribute__((ext_vector_type(8)));
typedef _Float16 h2 __attribute__((ext_vector_type(2)));
typedef int i32x4 __attribute__((ext_vector_type(4)));
namespace pg8 {
constexpr int BM = 256, BK = 64, HALF = 128, HTB = HALF * BK * 2, STAGE_BYTES = 8 * HTB, NXCD = 8, WGM = 8;
DEV int lds_byte(int r, int c) { const int st = (r >> 4) * 2 + (c >> 5), rr = r & 15, cc = c & 31, ob = rr * 64 + cc * 2; return st * 1024 + (ob ^ (((ob >> 9) & 1) << 5)); }
DEV void stage_rc(int b, int& R, int& C) { const int st = b / 1024, sb = b % 1024, swz = sb ^ (((sb >> 9) & 1) << 5); R = (st >> 1) * 16 + swz / 64; C = (st & 1) * 32 + (swz % 64) / 2; }
DEV int perm32(int rho) { const int n = rho >> 4, i = rho & 15; return 8 * (i >> 2) + 4 * n + (i & 3); }
typedef __bf16 bf16x2_t __attribute__((ext_vector_type(2)));
DEV unsigned cvt_pk_bf16(float lo, float hi) { return __builtin_bit_cast(unsigned, __builtin_convertvector((f32x2){lo, hi}, bf16x2_t)); }

struct Unit { int pm, pn, tag, nt; const char* a; const char* b; };
DEV void tile_of(int L, int nM, int nN, int& pm, int& pn) {
    const int nwg = nM * nN; int wgid = L; { const int q = nwg / NXCD, r = nwg % NXCD, xcd = wgid % NXCD, off = wgid / NXCD; wgid = (xcd < r ? xcd * (q + 1) : r * (q + 1) + (xcd - r) * q) + off; }
    const int nig = WGM * nN, gid = wgid / nig, fm = gid * WGM, gsz = (nM - fm) < WGM ? (nM - fm) : WGM;
    pm = fm + ((wgid % nig) % gsz); pn = (wgid % nig) / gsz;
}
struct PlainSched { const bf16_t* A; const bf16_t* Bt; int lda, ldb, nM, nN, nt, G, c, first, count;
    DEV bool next(int i, Unit& u) const { if (i >= count) return false; const long L = (long)(first + i) * G + c; if (L >= (long)nM * nN) return false; tile_of((int)L, nM, nN, u.pm, u.pn); u.tag = 0; u.nt = nt;
        u.a = (const char*)(A + (size_t)u.pm * BM * lda); u.b = (const char*)(Bt + (size_t)u.pn * BM * ldb); return true; } };

template <class Epi, class Sched, bool SP2 = true, bool ALIGN_EPI = true, int I8 = 0>
DEV void gemm_phase(LAS unsigned char* lds, const int lda, const int ldb, const Sched& S, const Epi& E, const int wv) {
    int wv_ = wv, ln_; asm volatile("v_mbcnt_lo_u32_b32 %1, -1, 0\n\tv_mbcnt_hi_u32_b32 %1, -1, %1" : "+s"(wv_), "=v"(ln_)); int tid_ = (wv_ << 6) | ln_;
    const int tid = tid_, wid = __builtin_amdgcn_readfirstlane(tid >> 6), lane = tid & 63, wr = wid >> 2, wc = wid & 3, fr = lane & 15, fq = lane >> 4;
    unsigned voffA[2], voffB[2];
#pragma unroll
    for (int i = 0; i < 2; ++i) { int R, C; stage_rc(tid * 16 + i * 8192, R, C); const int Rb = Epi::PERM ? ((R & ~31) + perm32(R & 31)) : R;
        voffA[i] = (unsigned)(R * lda + C) * 2u; voffB[i] = (unsigned)(Rb * ldb + C) * 2u; }
    const size_t kstep = (size_t)(BK * 2);
    const size_t hstepA = (size_t)HALF * lda * 2, hstepB = (size_t)HALF * ldb * 2;
    const unsigned ldsw = (unsigned)wid * 1024u;
    const int aoff = lds_byte(wr * 64 + fr, fq * 8), boff = lds_byte(wc * 32 + fr, fq * 8);
#define PG8_SA(b, h) (((b) * 2 + (h)) * HTB)
#define PG8_SB(b, h) ((4 + (b) * 2 + (h)) * HTB)
#define PG8_STAGE(bufoff, gbase, voff) do { _Pragma("unroll") for (int _i = 0; _i < 2; ++_i) \
        __builtin_amdgcn_global_load_lds((const unsigned*)((const char*)(gbase) + (voff)[_i]), (LAS unsigned*)(lds + (bufoff) + ldsw + _i * 8192), 16, 0, 0); } while (0)
#define PG8_LDA(dst, b, h) do { _Pragma("unroll") for (int m = 0; m < 4; ++m) _Pragma("unroll") for (int k = 0; k < 2; ++k) dst[m][k] = *(const LAS bf16x8*)(lds + PG8_SA(b, h) + aoff + m * 2048 + k * 1024); } while (0)
#define PG8_LDB(dst, b, h) do { _Pragma("unroll") for (int n = 0; n < 2; ++n) _Pragma("unroll") for (int k = 0; k < 2; ++k) dst[n][k] = *(const LAS bf16x8*)(lds + PG8_SB(b, h) + boff + n * 2048 + k * 1024); } while (0)
#define PG8_MMA(ai, bj, At, Bt) do { __builtin_amdgcn_s_setprio(1); \
        if (I8 == 1) { _Pragma("unroll") for (int m = 0; m < 4; ++m) _Pragma("unroll") for (int n = 0; n < 2; ++n) _Pragma("unroll") for (int k = 0; k < 2; ++k) \
            acc[ai][bj][m][n] = __builtin_bit_cast(f32x4, __builtin_amdgcn_mfma_i32_16x16x64_i8(__builtin_bit_cast(i32x4, Bt[n][k]), __builtin_bit_cast(i32x4, At[m][k]), __builtin_bit_cast(i32x4, acc[ai][bj][m][n]), 0, 0, 0)); } \
        else { _Pragma("unroll") for (int m = 0; m < 4; ++m) _Pragma("unroll") for (int n = 0; n < 2; ++n) _Pragma("unroll") for (int k = 0; k < 2; ++k) \
            acc[ai][bj][m][n] = __builtin_amdgcn_mfma_f32_16x16x32_bf16(Bt[n][k], At[m][k], acc[ai][bj][m][n], 0, 0, 0); } __builtin_amdgcn_s_setprio(0); } while (0)
#define PG8_WAIT_V(n) asm volatile("s_waitcnt vmcnt(" #n ")" ::: "memory")
#define PG8_WAIT_L(n) asm volatile("s_waitcnt lgkmcnt(" #n ")" ::: "memory")
#define PG8_BAR __builtin_amdgcn_s_barrier()
#define PG8_SCHED __builtin_amdgcn_sched_barrier(0)
    Unit cur, nxt; int ui = 0;
    if (!S.next(0, cur)) return;
    f32x4 acc[2][2][4][2];
#pragma unroll
    for (int a = 0; a < 2; ++a)
#pragma unroll
        for (int b = 0; b < 2; ++b)
#pragma unroll
            for (int m = 0; m < 4; ++m)
#pragma unroll
                for (int n = 0; n < 2; ++n) acc[a][b][m][n] = (f32x4){0.f, 0.f, 0.f, 0.f};
    bf16x8 At[4][2], B0[2][2], B1[2][2];
    const char* cA = cur.a; const char* cB = cur.b;
    if constexpr (SP2) {
        PG8_STAGE(PG8_SB(0, 0), cB, voffB); PG8_STAGE(PG8_SB(0, 1), cB + hstepB, voffB); PG8_STAGE(PG8_SA(0, 0), cA, voffA); PG8_STAGE(PG8_SA(0, 1), cA + hstepA, voffA);
        if (wr == 1) PG8_BAR;
        PG8_WAIT_V(2); PG8_BAR;
        PG8_STAGE(PG8_SB(1, 0), cB + kstep, voffB); PG8_STAGE(PG8_SA(1, 0), cA + kstep, voffA); PG8_STAGE(PG8_SB(1, 1), cB + hstepB + kstep, voffB);
        PG8_WAIT_V(6); PG8_BAR;
    } else {
    PG8_STAGE(PG8_SB(0, 0), cB, voffB); PG8_STAGE(PG8_SA(0, 0), cA, voffA); PG8_STAGE(PG8_SB(0, 1), cB + hstepB, voffB); PG8_STAGE(PG8_SA(0, 1), cA + hstepA, voffA);
    if (wr == 1) PG8_BAR;
    PG8_WAIT_V(4); PG8_BAR;
    PG8_STAGE(PG8_SB(1, 0), cB + kstep, voffB); PG8_STAGE(PG8_SA(1, 0), cA + kstep, voffA); PG8_STAGE(PG8_SB(1, 1), cB + hstepB + kstep, voffB);
    PG8_WAIT_V(6); PG8_BAR;
    }
    for (;;) {
        const bool has_next = S.next(ui + 1, nxt);
        const char* nA = has_next ? nxt.a : cA; const char* nB = has_next ? nxt.b : cB;
        const int nt = cur.nt;
        for (int t = 0; t < nt; t += 2) {
            const bool last = (t == nt - 2);
            const char* a1 = cA + (size_t)(t + 1) * kstep;
            const char* a2 = last ? nA : cA + (size_t)(t + 2) * kstep; const char* b2 = last ? nB : cB + (size_t)(t + 2) * kstep;
            const char* a3 = a2 + kstep; const char* b3 = b2 + kstep;
            if constexpr (SP2) {
            PG8_LDB(B0, 0, 0); PG8_LDB(B1, 0, 1); PG8_SCHED; PG8_LDA(At, 0, 0); PG8_STAGE(PG8_SA(1, 1), a1 + hstepA, voffA);
            PG8_WAIT_V(8); PG8_WAIT_L(0); PG8_BAR; PG8_MMA(0, 0, At, B0); PG8_MMA(0, 1, At, B1); PG8_BAR; PG8_SCHED;
            PG8_LDA(At, 0, 1); PG8_STAGE(PG8_SB(0, 0), b2, voffB); PG8_STAGE(PG8_SB(0, 1), b2 + hstepB, voffB); PG8_STAGE(PG8_SA(0, 0), a2, voffA);
            PG8_WAIT_V(8); PG8_WAIT_L(0); PG8_BAR; PG8_MMA(1, 0, At, B0); PG8_MMA(1, 1, At, B1); PG8_BAR; PG8_SCHED;
            PG8_LDB(B0, 1, 0); PG8_LDB(B1, 1, 1); PG8_SCHED; PG8_LDA(At, 1, 0); PG8_STAGE(PG8_SA(0, 1), a2 + hstepA, voffA);
            PG8_WAIT_V(8); PG8_WAIT_L(0); PG8_BAR; PG8_MMA(0, 0, At, B0); PG8_MMA(0, 1, At, B1); PG8_BAR; PG8_SCHED;
            PG8_LDA(At, 1, 1); PG8_STAGE(PG8_SB(1, 0), b3, voffB); PG8_STAGE(PG8_SB(1, 1), b3 + hstepB, voffB); PG8_STAGE(PG8_SA(1, 0), a3, voffA);
            PG8_WAIT_V(8); PG8_WAIT_L(0); PG8_BAR; PG8_MMA(1, 0, At, B0); PG8_MMA(1, 1, At, B1); PG8_BAR; PG8_SCHED;
            } else {
            PG8_LDB(B0, 0, 0); PG8_SCHED; PG8_LDA(At, 0, 0); PG8_STAGE(PG8_SA(1, 1), a1 + hstepA, voffA);
            PG8_WAIT_L(8); PG8_BAR; PG8_WAIT_L(0); PG8_MMA(0, 0, At, B0); PG8_BAR; PG8_SCHED;
            PG8_LDB(B1, 0, 1); PG8_STAGE(PG8_SB(0, 0), b2, voffB);
            PG8_BAR; PG8_WAIT_L(0); PG8_MMA(0, 1, At, B1); PG8_BAR;
            PG8_LDA(At, 0, 1); PG8_STAGE(PG8_SA(0, 0), a2, voffA);
            PG8_BAR; PG8_WAIT_L(0); PG8_MMA(1, 0, At, B0); PG8_BAR; PG8_SCHED;
            PG8_STAGE(PG8_SB(0, 1), b2 + hstepB, voffB);
            PG8_WAIT_V(6); PG8_BAR; PG8_MMA(1, 1, At, B1); PG8_BAR;
            PG8_LDB(B0, 1, 0); PG8_SCHED; PG8_LDA(At, 1, 0); PG8_STAGE(PG8_SA(0, 1), a2 + hstepA, voffA);
            PG8_WAIT_L(8); PG8_BAR; PG8_WAIT_L(0); PG8_MMA(0, 0, At, B0); PG8_BAR; PG8_SCHED;
            PG8_LDB(B1, 1, 1); PG8_STAGE(PG8_SB(1, 0), b3, voffB);
            PG8_BAR; PG8_WAIT_L(0); PG8_MMA(0, 1, At, B1); PG8_BAR;
            PG8_LDA(At, 1, 1); PG8_STAGE(PG8_SA(1, 0), a3, voffA);
            PG8_BAR; PG8_WAIT_L(0); PG8_MMA(1, 0, At, B0); PG8_BAR; PG8_SCHED;
            PG8_STAGE(PG8_SB(1, 1), b3 + hstepB, voffB);
            PG8_WAIT_V(6); PG8_BAR; PG8_MMA(1, 1, At, B1); PG8_BAR;
            }
        }
        if constexpr (ALIGN_EPI) { if (wr == 0) PG8_BAR; }
        if constexpr (!Epi::AFTER_DRAIN) E(acc, cur, wr, wc, fr, fq);
        if (!has_next) break;
        if constexpr (!Epi::INPLACE)
#pragma unroll
        for (int a = 0; a < 2; ++a)
#pragma unroll
            for (int b = 0; b < 2; ++b)
#pragma unroll
                for (int m = 0; m < 4; ++m)
#pragma unroll
                    for (int n = 0; n < 2; ++n) acc[a][b][m][n] = (f32x4){0.f, 0.f, 0.f, 0.f};
        cur = nxt; cA = nA; cB = nB; ++ui;
        if constexpr (ALIGN_EPI) { if (wr == 1) PG8_BAR; }
    }
    PG8_WAIT_V(0);
    if constexpr (!ALIGN_EPI) { if (wr == 0) PG8_BAR; }
    PG8_BAR;
#undef PG8_SA
#undef PG8_SB
#undef PG8_STAGE
#undef PG8_LDA
#undef PG8_LDB
#undef PG8_MMA
#undef PG8_WAIT_V
#undef PG8_WAIT_L
#undef PG8_BAR
#undef PG8_SCHED
}
struct EpiBf { static constexpr bool PERM = true, AFTER_DRAIN = false, INPLACE = false; bf16_t* O; int ldc; int pad;
    DEV void operator()(const f32x4 (&acc)[2][2][4][2], const Unit& u, int wr, int wc, int fr, int fq) const {
        const int row0 = u.pm * BM + wr * 64 + fr, col0 = u.pn * BM + wc * 32 + 8 * fq;
#pragma unroll
        for (int ai = 0; ai < 2; ++ai)
#pragma unroll
            for (int m = 0; m < 4; ++m) { bf16_t* rowp = O + (size_t)(row0 + ai * HALF + m * 16) * ldc + col0;
#pragma unroll
                for (int bj = 0; bj < 2; ++bj) { const f32x4 v0 = acc[ai][bj][m][0], v1 = acc[ai][bj][m][1];
                    u32x4 w; w.x = cvt_pk_bf16(v0[0], v0[1]); w.y = cvt_pk_bf16(v0[2], v0[3]); w.z = cvt_pk_bf16(v1[0], v1[1]); w.w = cvt_pk_bf16(v1[2], v1[3]);
                    *(u32x4*)(rowp + bj * HALF) = w; } }
    } };
struct EpiHyT8 { static constexpr bool PERM = true, AFTER_DRAIN = false, INPLACE = false; bf16_t* O; const float* su; const float* wi;
    DEV void operator()(const f32x4 (&acc)[2][2][4][2], const Unit& u, int wr, int wc, int fr, int fq) const {
        const int row0 = u.pm * BM + wr * 64 + fr, col0 = u.pn * BM + wc * 32 + 8 * fq;
        f32x4 cs[2][2];
#pragma unroll
        for (int bj = 0; bj < 2; ++bj)
#pragma unroll
            for (int h = 0; h < 2; ++h) cs[bj][h] = *(const f32x4*)(su + col0 + bj * HALF + 4 * h);
#pragma unroll
        for (int ai = 0; ai < 2; ++ai)
#pragma unroll
            for (int m = 0; m < 4; ++m) { bf16_t* rowp = O + (size_t)(row0 + ai * HALF + m * 16) * T_ + col0; const float wr_ = wi[row0 + ai * HALF + m * 16];
#pragma unroll
                for (int bj = 0; bj < 2; ++bj) { const i32x4 i0 = __builtin_bit_cast(i32x4, acc[ai][bj][m][0]), i1 = __builtin_bit_cast(i32x4, acc[ai][bj][m][1]);
                    const f32x4 v0 = (f32x4){(float)i0[0], (float)i0[1], (float)i0[2], (float)i0[3]} * (cs[bj][0] * wr_), v1 = (f32x4){(float)i1[0], (float)i1[1], (float)i1[2], (float)i1[3]} * (cs[bj][1] * wr_);
                    u32x4 w; w.x = cvt_pk_bf16(v0[0], v0[1]); w.y = cvt_pk_bf16(v0[2], v0[3]); w.z = cvt_pk_bf16(v1[0], v1[1]); w.w = cvt_pk_bf16(v1[2], v1[3]);
                    *(u32x4*)(rowp + bj * HALF) = w; } }
    } };
struct EpiP { static constexpr bool PERM = true, AFTER_DRAIN = false, INPLACE = false; bf16_t* P; const float2* rope; const float* su; const float* wi;
    DEV void operator()(const f32x4 (&acc)[2][2][4][2], const Unit& u, int wr, int wc, int fr, int fq) const {
        const int row0 = u.pm * BM + wr * 64 + fr, col0 = u.pn * BM + wc * 32 + 8 * fq; const int g = (wc & 1) * 4 + fq; const int pn = u.pn;
        const bool qs = (pn < 3) || (pn == 9) || (pn == 10);
        const f32x4 w00 = *(const f32x4*)(wi + col0), w01 = *(const f32x4*)(wi + col0 + 4), w10 = *(const f32x4*)(wi + col0 + HALF), w11 = *(const f32x4*)(wi + col0 + HALF + 4);
#pragma unroll
        for (int ai = 0; ai < 2; ++ai)
#pragma unroll
            for (int m = 0; m < 4; ++m) { const int row = row0 + ai * HALF + m * 16; bf16_t* rowp = P + (size_t)row * PW_ + col0; const float rsc = su[row];
                const float4* rp = (const float4*)(rope + (size_t)(row & 2047) * 32 + 4 * g); const float4 cs0 = rp[0], cs1 = rp[1];
                const float cc[4] = {cs0.x, cs0.z, cs1.x, cs1.z}, ss[4] = {cs0.y, cs0.w, cs1.y, cs1.w};
#pragma unroll
                for (int bj = 0; bj < 2; ++bj) { f32x4 v0, v1; { const i32x4 i0 = __builtin_bit_cast(i32x4, acc[ai][bj][m][0]), i1 = __builtin_bit_cast(i32x4, acc[ai][bj][m][1]);
                        v0 = (f32x4){(float)i0[0], (float)i0[1], (float)i0[2], (float)i0[3]} * ((bj ? w10 : w00) * rsc); v1 = (f32x4){(float)i1[0], (float)i1[1], (float)i1[2], (float)i1[3]} * ((bj ? w11 : w01) * rsc); }
                    const bool rp_ = (pn < 6) || (pn == 9) || (pn == 10) || (pn == 11 && bj == 0);
                    if (rp_) {
#pragma unroll
                        for (int j = 0; j < 4; ++j) { const float x1 = v0[j], x2 = v1[j]; float o1 = x1 * cc[j] - x2 * ss[j], o2 = x2 * cc[j] + x1 * ss[j];
                            if (qs) { o1 *= QSCALE_; o2 *= QSCALE_; } v0[j] = o1; v1[j] = o2; } }
                    u32x4 w; w.x = cvt_pk_bf16(v0[0], v0[1]); w.y = cvt_pk_bf16(v0[2], v0[3]); w.z = cvt_pk_bf16(v1[0], v1[1]); w.w = cvt_pk_bf16(v1[2], v1[3]);
                    *(u32x4*)(rowp + bj * HALF) = w; } }
    } };
struct EpiGate { static constexpr bool PERM = true, AFTER_DRAIN = false, INPLACE = false; bf16_t* g; const float* su; const float* wi;
    DEV void operator()(const f32x4 (&acc)[2][2][4][2], const Unit& u, int wr, int wc, int fr, int fq) const {
        bf16_t* gt = g + (size_t)(u.pn >> 2) * GSTRIDE_;
        const int row0 = u.pm * BM + wr * 64 + fr, col0 = (u.pn & 3) * BM + wc * 32 + 8 * fq;
        const float* wp_ = wi + u.pn * BM + wc * 32 + 8 * fq; const f32x4 w00 = *(const f32x4*)wp_, w01 = *(const f32x4*)(wp_ + 4), w10 = *(const f32x4*)(wp_ + HALF), w11 = *(const f32x4*)(wp_ + HALF + 4);
#pragma unroll
        for (int ai = 0; ai < 2; ++ai)
#pragma unroll
            for (int m = 0; m < 4; ++m) { const size_t ro = (size_t)(row0 + ai * HALF + m * 16) * 1024 + col0; const float rsc = su[row0 + ai * HALF + m * 16];
#pragma unroll
                for (int bj = 0; bj < 2; ++bj) { const i32x4 i0 = __builtin_bit_cast(i32x4, acc[ai][bj][m][0]), i1 = __builtin_bit_cast(i32x4, acc[ai][bj][m][1]); f32x4 v0, v1;
#pragma unroll
                    for (int j = 0; j < 4; ++j) { v0[j] = fmaxf(__builtin_amdgcn_rcpf(1.f + __expf(-(float)i0[j] * (rsc * (bj ? w10 : w00)[j]))), 1e-30f); v1[j] = fmaxf(__builtin_amdgcn_rcpf(1.f + __expf(-(float)i1[j] * (rsc * (bj ? w11 : w01)[j]))), 1e-30f); }
                    u32x4 w; w.x = cvt_pk_bf16(v0[0], v0[1]); w.y = cvt_pk_bf16(v0[2], v0[3]); w.z = cvt_pk_bf16(v1[0], v1[1]); w.w = cvt_pk_bf16(v1[2], v1[3]);
                    *(u32x4*)(gt + ro + bj * HALF) = w; } }
    } };
struct EpiBranch3 { static constexpr bool PERM = true, AFTER_DRAIN = false, INPLACE = true; const bf16_t* g; bf16_t* merged;
    DEV static void unpack8(const u32x4 q, float (&f)[8]) { f[0] = __uint_as_float(q.x << 16); f[1] = __uint_as_float(q.x & 0xffff0000u); f[2] = __uint_as_float(q.y << 16); f[3] = __uint_as_float(q.y & 0xffff0000u);
        f[4] = __uint_as_float(q.z << 16); f[5] = __uint_as_float(q.z & 0xffff0000u); f[6] = __uint_as_float(q.w << 16); f[7] = __uint_as_float(q.w & 0xffff0000u); }
    DEV void operator()(f32x4 (&acc)[2][2][4][2], const Unit& u, int wr, int wc, int fr, int fq) const {
        const int row0 = u.pm * BM + wr * 64 + fr, col0 = u.pn * BM + wc * 32 + 8 * fq; const int tag = u.tag;
        const bool fin = (tag == 2); const float keepf = fin ? 0.f : 1.f; const bf16_t* gn = g + (size_t)tag * GSTRIDE_; const bf16_t* gd = gn + GSTRIDE_;
#pragma unroll
        for (int ah = 0; ah < 4; ++ah) { const int ai = ah >> 1, m0 = (ah & 1) * 2; u32x4 nq[2][2], dq[2][2];
#pragma unroll
            for (int mm = 0; mm < 2; ++mm)
#pragma unroll
                for (int bj = 0; bj < 2; ++bj) { const size_t o = (size_t)(row0 + ai * HALF + (m0 + mm) * 16) * 1024 + col0 + bj * HALF; nq[mm][bj] = *(const u32x4*)(gn + o);
                    dq[mm][bj] = (u32x4){0x3f803f80u, 0x3f803f80u, 0x3f803f80u, 0x3f803f80u}; if (!fin) dq[mm][bj] = *(const u32x4*)(gd + o); }
            asm volatile("" ::: "memory");
#pragma unroll
            for (int mm = 0; mm < 2; ++mm)
#pragma unroll
                for (int bj = 0; bj < 2; ++bj) { const int m = m0 + mm; const size_t o = (size_t)(row0 + ai * HALF + m * 16) * 1024 + col0 + bj * HALF; float nn[8], dd[8]; unpack8(nq[mm][bj], nn); unpack8(dq[mm][bj], dd);
                    const f32x4 s0 = (f32x4){nn[0] * __builtin_amdgcn_rcpf(dd[0]), nn[1] * __builtin_amdgcn_rcpf(dd[1]), nn[2] * __builtin_amdgcn_rcpf(dd[2]), nn[3] * __builtin_amdgcn_rcpf(dd[3])};
                    const f32x4 s1 = (f32x4){nn[4] * __builtin_amdgcn_rcpf(dd[4]), nn[5] * __builtin_amdgcn_rcpf(dd[5]), nn[6] * __builtin_amdgcn_rcpf(dd[6]), nn[7] * __builtin_amdgcn_rcpf(dd[7])};
                    const f32x4 r0 = acc[ai][bj][m][0] * s0, r1 = acc[ai][bj][m][1] * s1;
                    if (fin) { u32x4 w; w.x = cvt_pk_bf16(r0[0], r0[1]); w.y = cvt_pk_bf16(r0[2], r0[3]); w.z = cvt_pk_bf16(r1[0], r1[1]); w.w = cvt_pk_bf16(r1[2], r1[3]); *(u32x4*)(merged + o) = w; }
                    acc[ai][bj][m][0] = r0 * keepf; acc[ai][bj][m][1] = r1 * keepf; asm volatile("" : "+v"(acc[ai][bj][m][0]), "+v"(acc[ai][bj][m][1])); }
            asm volatile("" ::: "memory"); }
    } };
struct EpiH { static constexpr bool PERM = true, AFTER_DRAIN = false, INPLACE = false; const float* xin; const bf16_t* xin16; bf16_t* hout; const float* ada_b;
    DEV void operator()(const f32x4 (&acc)[2][2][4][2], const Unit& u, int wr, int wc, int fr, int fq) const {
        const int row0 = u.pm * BM + wr * 64 + fr, col0 = u.pn * BM + wc * 32 + 8 * fq; const float* ab = ada_b + (size_t)(u.pm >> 3) * 6144 + 2048 + col0;
        const f32x4 g00 = *(const f32x4*)ab, g01 = *(const f32x4*)(ab + 4), g10 = *(const f32x4*)(ab + HALF), g11 = *(const f32x4*)(ab + HALF + 4);
        if (xin) {
#pragma unroll
            for (int ah = 0; ah < 4; ++ah) { const int ai = ah >> 1, m0 = (ah & 1) * 2; f32x4 xa[2][2][2];
#pragma unroll
                for (int mm = 0; mm < 2; ++mm)
#pragma unroll
                    for (int bj = 0; bj < 2; ++bj) { const float* xp = xin + (size_t)(row0 + ai * HALF + (m0 + mm) * 16) * 1024 + col0 + bj * HALF; xa[mm][bj][0] = *(const f32x4*)xp; xa[mm][bj][1] = *(const f32x4*)(xp + 4); }
                asm volatile("" ::: "memory");
#pragma unroll
                for (int mm = 0; mm < 2; ++mm)
#pragma unroll
                    for (int bj = 0; bj < 2; ++bj) { const int m = m0 + mm; const f32x4 h0 = ALPHA_ * xa[mm][bj][0] + (bj ? g10 : g00) * acc[ai][bj][m][0], h1 = ALPHA_ * xa[mm][bj][1] + (bj ? g11 : g01) * acc[ai][bj][m][1];
                        u32x4 w; w.x = cvt_pk_bf16(h0[0], h0[1]); w.y = cvt_pk_bf16(h0[2], h0[3]); w.z = cvt_pk_bf16(h1[0], h1[1]); w.w = cvt_pk_bf16(h1[2], h1[3]);
                        *(u32x4*)(hout + (size_t)(row0 + ai * HALF + m * 16) * 1024 + col0 + bj * HALF) = w; }
                asm volatile("" ::: "memory"); }
        } else {
#pragma unroll
            for (int ai = 0; ai < 2; ++ai) { u32x4 xq[4][2];
#pragma unroll
                for (int m = 0; m < 4; ++m)
#pragma unroll
                    for (int bj = 0; bj < 2; ++bj) xq[m][bj] = *(const u32x4*)(xin16 + (size_t)(row0 + ai * HALF + m * 16) * 1024 + col0 + bj * HALF);
                asm volatile("" ::: "memory");
#pragma unroll
                for (int m = 0; m < 4; ++m)
#pragma unroll
                    for (int bj = 0; bj < 2; ++bj) { const u32x4 q = xq[m][bj];
                        const f32x4 x0 = (f32x4){__uint_as_float(q.x << 16), __uint_as_float(q.x & 0xffff0000u), __uint_as_float(q.y << 16), __uint_as_float(q.y & 0xffff0000u)}, x1 = (f32x4){__uint_as_float(q.z << 16), __uint_as_float(q.z & 0xffff0000u), __uint_as_float(q.w << 16), __uint_as_float(q.w & 0xffff0000u)};
                        const f32x4 h0 = ALPHA_ * x0 + (bj ? g10 : g00) * acc[ai][bj][m][0], h1 = ALPHA_ * x1 + (bj ? g11 : g01) * acc[ai][bj][m][1];
                        u32x4 w; w.x = cvt_pk_bf16(h0[0], h0[1]); w.y = cvt_pk_bf16(h0[2], h0[3]); w.z = cvt_pk_bf16(h1[0], h1[1]); w.w = cvt_pk_bf16(h1[2], h1[3]);
                        *(u32x4*)(hout + (size_t)(row0 + ai * HALF + m * 16) * 1024 + col0 + bj * HALF) = w; }
                asm volatile("" ::: "memory"); }
        }
    } };
struct GateSched { const bf16_t* UY; const unsigned char* WmT8; int G, c;
    DEV bool next(int i, Unit& u) const { const long L = (long)i * G + c; if (L >= 128 * 12) return false; tile_of((int)L, 128, 12, u.pm, u.pn); u.tag = 0; u.nt = 8;
        u.a = (const char*)(UY + (size_t)u.pm * BM * UYW_); u.b = (const char*)(WmT8 + (size_t)(u.pn & 3) * BM * (WMW_ * 2)) + (u.pn >> 2) * 1024; return true; } };
struct Branch3Sched { const bf16_t* UY; const unsigned char* WmT8; int G, c;
    DEV bool next(int i, Unit& u) const { const int ti = i / 3, ps = i - ti * 3; const long L = (long)ti * G + c; if (L >= 128 * 4) return false; tile_of((int)L, 128, 4, u.pm, u.pn); u.tag = ps;
        const int koff = ps == 0 ? 0 : (ps == 1 ? 256 : 768); u.nt = ps == 0 ? 4 : 8;
        u.a = (const char*)(UY + (size_t)u.pm * BM * UYW_) + (1024 + koff) * 2; u.b = (const char*)(WmT8 + (size_t)u.pn * BM * (WMW_ * 2)) + 3072 + koff * 2; return true; } };
}

DEV int win_orig_col(int n) {
    if (n >= 3072) return n < 4608 ? (n - 3072 + 2304) : n;
    const int head = n >> 6, p = n & 63; const bool rp = (head < 24) || (head >= 36 && head < 46);
    const int d = rp ? ((p & 4) ? 32 + 4 * (p >> 3) + (p & 3) : 4 * (p >> 3) + (p & 3)) : p;
    return ((n < 2304) ? head * 64 : 3840 + (head - 36) * 64) + d;
}
struct WPrep { const float *w_in, *wba, *wbb, *wbc, *w_out, *peer_wq; unsigned char *WinT8, *WmT8; bf16_t *WoutT, *WqT; };
DEV void nb_wprep(int vb, int t, unsigned char* sm, const WPrep& q) {
    const int l = vb / 1088; int r = vb - l * 1088 + 1920; const float* W; int ldw; bf16_t* Wt = nullptr; unsigned char* W8 = nullptr; int ldt = 0, ld8 = 0, koff = 0, ntk = 16, mode = 0, nsub = 0;
    if (false) {}
    else if (r < 1984) { r -= 1920; W = q.wba + (size_t)l * 256 * 1024; ldw = 1024; Wt = (bf16_t*)(q.WmT8 + (size_t)l * 1024 * (WMW_ * 2) + 3072); ldt = WMW_; koff = 0; ntk = 4; }
    else if (r < 2112) { r -= 1984; W = q.wbb + (size_t)l * 512 * 1024; ldw = 1024; Wt = (bf16_t*)(q.WmT8 + (size_t)l * 1024 * (WMW_ * 2) + 3072); ldt = WMW_; koff = 256; ntk = 8; }
    else if (r < 2240) { r -= 2112; W = q.wbc + (size_t)l * 512 * 1024; ldw = 1024; Wt = (bf16_t*)(q.WmT8 + (size_t)l * 1024 * (WMW_ * 2) + 3072); ldt = WMW_; koff = 768; ntk = 8; }
    else if (r < 2496) { r -= 2240; W = q.w_out + (size_t)l * 1024 * 1024; ldw = 1024; Wt = q.WoutT + (size_t)l * 1024 * 1024; ldt = 1024; }
    else { r -= 2496; W = q.peer_wq + (size_t)l * 1024 * 2048; ldw = 2048; Wt = q.WqT + (size_t)l * 2048 * 1024; ldt = 1024; }
    const int n0 = (r / ntk) * 64, k0 = (r % ntk) * 64; const int c0 = mode ? (win_orig_col(n0) & ~63) : n0;
    bf16_t* tile = (bf16_t*)sm;
    { const int kk = t >> 2, cs = (t & 3) * 16; const float* src = W + (size_t)(k0 + kk) * ldw + c0 + cs;
#pragma unroll
        for (int i = 0; i < 16; i += 4) { const float4 v = *(const float4*)(src + i); tile[kk * 66 + cs + i] = f2bf(v.x); tile[kk * 66 + cs + i + 1] = f2bf(v.y); tile[kk * 66 + cs + i + 2] = f2bf(v.z); tile[kk * 66 + cs + i + 3] = f2bf(v.w); } }
    __syncthreads();
    (void)W8; (void)ld8;
    { const int nn = t >> 2, ks = (t & 3) * 16; const int dl = mode ? (win_orig_col(n0 + nn) - c0) : nn; bf16_t* dst = Wt + (size_t)(n0 + nn - nsub) * ldt + koff + k0 + ks;
        unsigned w[8];
#pragma unroll
        for (int i = 0; i < 8; ++i) w[i] = (unsigned)tile[(ks + 2 * i) * 66 + dl] | ((unsigned)tile[(ks + 2 * i + 1) * 66 + dl] << 16);
        *(u32x4*)dst = (u32x4){w[0], w[1], w[2], w[3]}; *(u32x4*)(dst + 8) = (u32x4){w[4], w[5], w[6], w[7]}; }
}

DEV void winprep_phase(LAS unsigned char* lds, const float* __restrict__ w_in, unsigned char* WinT8, unsigned char* WmT8, float* __restrict__ winv, int G, int cblk, int wv) {
    int wv_ = wv, ln_; asm volatile("v_mbcnt_lo_u32_b32 %1, -1, 0\n\tv_mbcnt_hi_u32_b32 %1, -1, %1" : "+s"(wv_), "=v"(ln_)); const int tid = (wv_ << 6) | ln_, lane = ln_;
    LAS bf16_t* tt = (LAS bf16_t*)lds;
#pragma unroll 1
    for (int item = cblk; item < 240; item += G) { const int l = item / 120, nt = item - l * 120, n0 = nt * 64; const int c0 = win_orig_col(n0) & ~63;
        const bool rp = (nt < 24) || (nt >= 36 && nt < 46);
        const float* W = w_in + (size_t)l * 1024 * 7680 + c0;
        __syncthreads();
        { const int r0 = tid >> 4, cs = (tid & 15) * 4; int nn4[4];
#pragma unroll
            for (int e = 0; e < 4; ++e) { const int d = cs + e; nn4[e] = rp ? ((d < 32) ? 8 * (d >> 2) + (d & 3) : 8 * ((d - 32) >> 2) + 4 + (d & 3)) : d; }
#pragma unroll 1
            for (int i = 0; i < 32; i += 16) { float4 v[16];
#pragma unroll
                for (int j = 0; j < 16; ++j) v[j] = *(const float4*)(W + (size_t)(r0 + 32 * (i + j)) * 7680 + cs);
#pragma unroll
                for (int j = 0; j < 16; ++j) { const int r = r0 + 32 * (i + j); tt[nn4[0] * 1032 + r] = f2bf(v[j].x); tt[nn4[1] * 1032 + r] = f2bf(v[j].y); tt[nn4[2] * 1032 + r] = f2bf(v[j].z); tt[nn4[3] * 1032 + r] = f2bf(v[j].w); } } }
        __syncthreads();
        { const int nn = tid >> 3, kq = tid & 7; const LAS bf16_t* row = tt + nn * 1032; float mx = 0.f;
#pragma unroll 4
            for (int j = 0; j < 16; ++j) { const u32x4 q = *(const LAS u32x4*)(row + 8 * (kq + 8 * j));
                mx = fmaxf(mx, fmaxf(fmaxf(fabsf(__uint_as_float(q.x << 16)), fabsf(__uint_as_float(q.x & 0xffff0000u))), fmaxf(fabsf(__uint_as_float(q.y << 16)), fabsf(__uint_as_float(q.y & 0xffff0000u)))));
                mx = fmaxf(mx, fmaxf(fmaxf(fabsf(__uint_as_float(q.z << 16)), fabsf(__uint_as_float(q.z & 0xffff0000u))), fmaxf(fabsf(__uint_as_float(q.w << 16)), fabsf(__uint_as_float(q.w & 0xffff0000u))))); }
            mx = fmaxf(mx, xor_f(mx, 1, lane)); mx = fmaxf(mx, xor_f(mx, 2, lane)); mx = fmaxf(mx, xor_f(mx, 4, lane));
            const float qs = (mx > 0.f) ? 127.f / mx : 0.f;
            unsigned char* dst8;
            if (nt < 72) dst8 = WinT8 + (size_t)l * 4608 * 1024 + (size_t)(n0 + nn) * 1024;
            else { const int br = (nt - 72) >> 4; dst8 = WmT8 + (size_t)l * 1024 * (WMW_ * 2) + br * 1024 + (size_t)(n0 + nn - 4608 - br * 1024) * (WMW_ * 2); }
#pragma unroll 2
            for (int c = 0; c < 8; ++c) { const int ks = 16 * (kq + 8 * c); const u32x4 qa = *(const LAS u32x4*)(row + ks), qb = *(const LAS u32x4*)(row + ks + 8);
                const unsigned wsrc[8] = {qa.x, qa.y, qa.z, qa.w, qb.x, qb.y, qb.z, qb.w}; unsigned w8[4];
#pragma unroll
                for (int i = 0; i < 4; ++i) { const int q0 = (int)rintf(__uint_as_float(wsrc[2 * i] << 16) * qs), q1 = (int)rintf(__uint_as_float(wsrc[2 * i] & 0xffff0000u) * qs),
                                                        q2 = (int)rintf(__uint_as_float(wsrc[2 * i + 1] << 16) * qs), q3 = (int)rintf(__uint_as_float(wsrc[2 * i + 1] & 0xffff0000u) * qs);
                    w8[i] = ((unsigned)q0 & 0xffu) | (((unsigned)q1 & 0xffu) << 8) | (((unsigned)q2 & 0xffu) << 16) | (((unsigned)q3 & 0xffu) << 24); }
                *(u32x4*)(dst8 + ks) = (u32x4){w8[0], w8[1], w8[2], w8[3]}; }
            if (kq == 0) winv[(size_t)l * 7680 + n0 + nn] = mx * (1.f / 127.f); }
    }
    __syncthreads();
}

namespace hy {
constexpr int ZS = 2064;
constexpr int G0_OFF = 0, G1_OFF = 8192, Z0_OFF = 16384, Z1_OFF = Z0_OFF + 16 * ZS * 2, LDS_END = Z1_OFF + 16 * ZS * 2;
DEV bf16x8 load_frag(LAS const unsigned char* lane_base, int d) {
    const LAS unsigned* p = (const LAS unsigned*)(lane_base + 32 * d); u32x4 w; w.x = p[0]; w.y = p[1]; w.z = p[2]; w.w = p[3];
    return __builtin_bit_cast(bf16x8, w);
}
DEV void load_filter(LAS unsigned char* lds, const bf16_t* g, int tid) {
    const u32x4 c = *(const u32x4*)(g + tid * 8); const unsigned nx = (tid < 511) ? (unsigned)g[tid * 8 + 8] : 0u;
    *(LAS u32x4*)(lds + G0_OFF + tid * 16) = c;
    u32x4 s; s.x = (c.x >> 16) | (c.y << 16); s.y = (c.y >> 16) | (c.z << 16); s.z = (c.z >> 16) | (c.w << 16); s.w = (c.w >> 16) | (nx << 16);
    *(LAS u32x4*)(lds + G1_OFF + tid * 16) = s;
}
DEV float bflo(unsigned w) { return __uint_as_float(w << 16); }
DEV float bfhi(unsigned w) { return __uint_as_float(w & 0xffff0000u); }
DEV void conv_rows(LAS const unsigned char* lds, int zoff, int w, int lane, f32x4 (&D)[16]) {
    const int r = lane & 15, q = lane >> 4;
    LAS const unsigned char* abase = lds + ((r & 1) ? (G0_OFF + 2 * (8 * q - r + 2047)) : (G1_OFF + 2 * (8 * q - r + 2046)));
    LAS const unsigned char* bbase = lds + zoff + (r * ZS + 8 * q) * 2;
    bf16x8 ring[16];
#pragma unroll
    for (int rb = 0; rb < 16; ++rb) D[rb] = (f32x4){0.f, 0.f, 0.f, 0.f};
#pragma unroll
    for (int rb = 2; rb < 16; ++rb) ring[rb] = load_frag(abase, -16 * w - rb);
#pragma unroll 1
    for (int jb0 = 0; jb0 < 64; jb0 += 8) {
#pragma unroll
        for (int u = 0; u < 8; ++u) { const int jb = jb0 + u;
            ring[(16 - 2 * u) & 15] = load_frag(abase, 2 * jb - 16 * w);
            ring[(17 - 2 * u) & 15] = load_frag(abase, 2 * jb - 16 * w - 1);
            const bf16x8 bf = *(const LAS bf16x8*)(bbase + 64 * jb);
#pragma unroll
            for (int rb = 0; rb < 16; ++rb) D[rb] = __builtin_amdgcn_mfma_f32_16x16x32_bf16(ring[(rb - 2 * u) & 15], bf, D[rb], 0, 0, 0);
        }
    }
}
struct SConvRaw { u32x4 w; };
DEV void sconv4_load(const bf16_t* in, int i, SConvRaw& r) { r.w = *(const u32x4*)(in + i - 2); }
DEV void sconv4_calc(const SConvRaw& r, int i, float w0, float w1, float w2, float cb, float (&o)[4]) {
    const float pm = (i > 0) ? bfhi(r.w.x) : 0.f, pn = (i + 4 < 2048) ? bflo(r.w.w) : 0.f;
    const float x0 = bflo(r.w.y), x1 = bfhi(r.w.y), x2 = bflo(r.w.z), x3 = bfhi(r.w.z);
    o[0] = cb + w0 * pm + w1 * x0 + w2 * x1; o[1] = cb + w0 * x0 + w1 * x1 + w2 * x2; o[2] = cb + w0 * x1 + w1 * x2 + w2 * x3; o[3] = cb + w0 * x2 + w1 * x3 + w2 * pn;
}
DEV void hyena_phase(LAS unsigned char* lds, bf16_t* hyT, const bf16_t* Gr_l, const float* conv_w, const float* conv_b, const float* hy_bias, int G, int cblk, int wv) {
    int wv_ = wv, ln_; asm volatile("v_mbcnt_lo_u32_b32 %1, -1, 0\n\tv_mbcnt_hi_u32_b32 %1, -1, %1" : "+s"(wv_), "=v"(ln_)); int tid_ = (wv_ << 6) | ln_;
    const int tid = tid_, w = __builtin_amdgcn_readfirstlane(tid >> 6), lane = tid & 63, q = lane >> 4, b = lane & 15;
#pragma unroll 1
    for (int c = cblk; c < 512; c += G) {
        __syncthreads();
        load_filter(lds, Gr_l + (size_t)c * 4096, tid);
        { const float w0 = conv_w[c], w1 = conv_w[1536 + c], w2 = conv_w[3072 + c], cb = conv_b[c]; const bf16_t* row = hyT + (size_t)c * T_;
            u32x4 vq[8]; unsigned pmq[8], pnq[8];
#pragma unroll
            for (int k = 0; k < 8; ++k) { const int pos = (k * 512 + tid) * 8; const int s = pos & 2047;
                vq[k] = *(const u32x4*)(row + pos); pmq[k] = row[s > 0 ? pos - 1 : pos]; pnq[k] = row[s + 8 < 2048 ? pos + 8 : pos]; }
            asm volatile("" ::: "memory");
#pragma unroll
            for (int k = 0; k < 8; ++k) { const int pos = (k * 512 + tid) * 8; const int s = pos & 2047, bb = pos >> 11; const u32x4 v = vq[k];
                const float pm = (s > 0) ? __uint_as_float(pmq[k] << 16) : 0.f, pn = (s + 8 < 2048) ? __uint_as_float(pnq[k] << 16) : 0.f;
                const float x[10] = {pm, bflo(v.x), bfhi(v.x), bflo(v.y), bfhi(v.y), bflo(v.z), bfhi(v.z), bflo(v.w), bfhi(v.w), pn};
                float z[8];
#pragma unroll
                for (int e = 0; e < 8; ++e) z[e] = cb + w0 * x[e] + w1 * x[e + 1] + w2 * x[e + 2];
                u32x4 o; o.x = pg8::cvt_pk_bf16(z[0], z[1]); o.y = pg8::cvt_pk_bf16(z[2], z[3]); o.z = pg8::cvt_pk_bf16(z[4], z[5]); o.w = pg8::cvt_pk_bf16(z[6], z[7]);
                *(LAS u32x4*)(lds + Z0_OFF + (bb * ZS + s) * 2) = o; } }
        __syncthreads();
        f32x4 D[16];
        conv_rows(lds, Z0_OFF, w, lane, D);
        { int q_ = q, b_ = b; asm volatile("" : "+v"(q_), "+v"(b_));
          const int q = q_, b = b_; const int xc = 512 + c; const float w0 = conv_w[xc], w1 = conv_w[1536 + xc], w2 = conv_w[3072 + xc], cb = conv_b[xc], bias = hy_bias[c]; const bf16_t* xin = hyT + (size_t)xc * T_ + b * 2048;
#pragma unroll
            for (int rh = 0; rh < 16; rh += 8) { SConvRaw xr[8];
#pragma unroll
            for (int rb = 0; rb < 8; ++rb) sconv4_load(xin, 256 * w + 16 * (rh + rb) + 4 * q, xr[rb]);
            asm volatile("" ::: "memory");
#pragma unroll
            for (int rb = rh; rb < rh + 8; ++rb) { const int i = 256 * w + 16 * rb + 4 * q; float xv[4]; sconv4_calc(xr[rb - rh], i, w0, w1, w2, cb, xv);
                const u32x2 zq = *(const LAS u32x2*)(lds + Z0_OFF + (b * ZS + i) * 2); const float zv[4] = {bflo(zq.x), bfhi(zq.x), bflo(zq.y), bfhi(zq.y)};
                float o[4];
#pragma unroll
                for (int e = 0; e < 4; ++e) o[e] = xv[e] * (D[rb][e] + bias * zv[e]);
                u32x2 pk; pk.x = pg8::cvt_pk_bf16(o[0], o[1]); pk.y = pg8::cvt_pk_bf16(o[2], o[3]);
                *(LAS u32x2*)(lds + Z1_OFF + (b * ZS + i) * 2) = pk; } } }
        __syncthreads();
        load_filter(lds, Gr_l + (size_t)(512 + c) * 4096, tid);
        __syncthreads();
        conv_rows(lds, Z1_OFF, w, lane, D);
        { int q_ = q, b_ = b; asm volatile("" : "+v"(q_), "+v"(b_));
          const int q = q_, b = b_; const int xc = 1024 + c; const float w0 = conv_w[xc], w1 = conv_w[1536 + xc], w2 = conv_w[3072 + xc], cb = conv_b[xc], bias = hy_bias[512 + c]; const bf16_t* xin = hyT + (size_t)xc * T_ + b * 2048;
            bf16_t* yout = hyT + (size_t)c * T_ + b * 2048;
#pragma unroll
            for (int rh = 0; rh < 16; rh += 8) { SConvRaw xr[8];
#pragma unroll
            for (int rb = 0; rb < 8; ++rb) sconv4_load(xin, 256 * w + 16 * (rh + rb) + 4 * q, xr[rb]);
            asm volatile("" ::: "memory");
#pragma unroll
            for (int rp = rh; rp < rh + 8; rp += 2) { u32x2 pk2[2];
#pragma unroll
                for (int t = 0; t < 2; ++t) { const int rb = rp + t; const int i = 256 * w + 16 * rb + 4 * q; float xv[4]; sconv4_calc(xr[rb - rh], i, w0, w1, w2, cb, xv);
                    const u32x2 zq = *(const LAS u32x2*)(lds + Z1_OFF + (b * ZS + i) * 2); const float zv[4] = {bflo(zq.x), bfhi(zq.x), bflo(zq.y), bfhi(zq.y)};
                    float o[4];
#pragma unroll
                    for (int e = 0; e < 4; ++e) o[e] = xv[e] * (D[rb][e] + bias * zv[e]);
                    pk2[t].x = pg8::cvt_pk_bf16(o[0], o[1]); pk2[t].y = pg8::cvt_pk_bf16(o[2], o[3]); }
                const auto sx = __builtin_amdgcn_permlane16_swap(pk2[0].x, pk2[1].x, false, false), sy = __builtin_amdgcn_permlane16_swap(pk2[0].y, pk2[1].y, false, false);
                *(u32x4*)(yout + 256 * w + 16 * (rp + (q & 1)) + 8 * (q >> 1)) = (u32x4){sx[0], sy[0], sx[1], sy[1]}; } } }
    }
    __syncthreads();
}
}

namespace peer {
DEV float wave_sum(float v, int lane) {
#pragma unroll
    for (int off = 32; off > 0; off >>= 1) v += xor_f(v, off, lane);
    return v;
}
DEV float wave_max(float v, int lane) {
#pragma unroll
    for (int off = 32; off > 0; off >>= 1) v = fmaxf(v, xor_f(v, off, lane));
    return v;
}
DEV unsigned pk4_fp8(float a, float b, float c, float d) { int w = __builtin_amdgcn_cvt_pk_fp8_f32(a, b, 0, false); w = __builtin_amdgcn_cvt_pk_fp8_f32(c, d, w, true); return (unsigned)w; }
DEV void quant_phase(const float* __restrict__ pu, const float* __restrict__ pv, unsigned char* __restrict__ U8, unsigned char* __restrict__ V4, float* __restrict__ sinv, int G, int cblk, int wv) {
    int wv_ = wv, ln_; asm volatile("v_mbcnt_lo_u32_b32 %1, -1, 0\n\tv_mbcnt_hi_u32_b32 %1, -1, %1" : "+s"(wv_), "=v"(ln_)); const int lane = ln_, w = wv_;
#pragma unroll 1
    for (int row0 = cblk * 8 + w; row0 < 32768; row0 += 4 * G * 8) { float4 q[4][4];
#pragma unroll
        for (int t = 0; t < 4; ++t) { const int rw = row0 + t * G * 8; const int row = rw < 32768 ? rw : row0; const float* src = (row < 16384) ? pu + (size_t)row * 1024 : pv + (size_t)(row - 16384) * 1024;
#pragma unroll
            for (int j = 0; j < 4; ++j) q[t][j] = *(const float4*)(src + 16 * lane + 4 * j); }
#pragma unroll
        for (int t = 0; t < 4; ++t) { const int row = row0 + t * G * 8; const float4 a = q[t][0], b = q[t][1], c = q[t][2], d = q[t][3];
            float mx = fmaxf(fmaxf(fmaxf(fabsf(a.x), fabsf(a.y)), fmaxf(fabsf(a.z), fabsf(a.w))), fmaxf(fmaxf(fabsf(b.x), fabsf(b.y)), fmaxf(fabsf(b.z), fabsf(b.w))));
            mx = fmaxf(mx, fmaxf(fmaxf(fmaxf(fabsf(c.x), fabsf(c.y)), fmaxf(fabsf(c.z), fabsf(c.w))), fmaxf(fmaxf(fabsf(d.x), fabsf(d.y)), fmaxf(fabsf(d.z), fabsf(d.w)))));
            mx = wave_max(mx, lane);
            const float sc = (mx > 0.f) ? 6.f / mx : 0.f; unsigned w0 = 0u, w1 = 0u;
            w0 = __builtin_amdgcn_cvt_scalef32_pk_fp4_f32(w0, a.x * sc, a.y * sc, 1.0f, 0); w0 = __builtin_amdgcn_cvt_scalef32_pk_fp4_f32(w0, a.z * sc, a.w * sc, 1.0f, 1);
            w0 = __builtin_amdgcn_cvt_scalef32_pk_fp4_f32(w0, b.x * sc, b.y * sc, 1.0f, 2); w0 = __builtin_amdgcn_cvt_scalef32_pk_fp4_f32(w0, b.z * sc, b.w * sc, 1.0f, 3);
            w1 = __builtin_amdgcn_cvt_scalef32_pk_fp4_f32(w1, c.x * sc, c.y * sc, 1.0f, 0); w1 = __builtin_amdgcn_cvt_scalef32_pk_fp4_f32(w1, c.z * sc, c.w * sc, 1.0f, 1);
            w1 = __builtin_amdgcn_cvt_scalef32_pk_fp4_f32(w1, d.x * sc, d.y * sc, 1.0f, 2); w1 = __builtin_amdgcn_cvt_scalef32_pk_fp4_f32(w1, d.z * sc, d.w * sc, 1.0f, 3);
            if (row < 32768) { unsigned char* dst = (row < 16384) ? U8 + (size_t)row * 512 : V4 + (size_t)(row - 16384) * 512;
                *(u32x2*)(dst + 8 * lane) = (u32x2){w0, w1};
                if (lane == 0) sinv[row] = (mx > 0.f) ? mx * (1.f / 6.f) : 0.f; } }
    }
}
DEV void peer_phase(LAS unsigned char* lds, const bf16_t* __restrict__ x1in, float* xout32, bf16_t* xout16, const float* ada_l,
                    const int* __restrict__ eidx, const float* __restrict__ egate, const unsigned char* __restrict__ U8, const unsigned char* __restrict__ V4,
                    const float* __restrict__ sinv, const float* __restrict__ g, const float* __restrict__ bta, const float* ada_next, bf16_t* UY, float* su_next, int G, int cblk, int wv) {
    int wv_ = wv, ln_; asm volatile("v_mbcnt_lo_u32_b32 %1, -1, 0\n\tv_mbcnt_hi_u32_b32 %1, -1, %1" : "+s"(wv_), "=v"(ln_)); int tid_ = (wv_ << 6) | ln_;
    const int tid = tid_, w = __builtin_amdgcn_readfirstlane(tid >> 6), lane = tid & 63;
    LAS unsigned char* urow_l = lds + w * 3072; LAS int* E_l = (LAS int*)(urow_l + 1024); LAS float* W_l = (LAS float*)(urow_l + 1536); LAS float* SU_l = (LAS float*)(urow_l + 2048); LAS float* SV_l = (LAS float*)(urow_l + 2560); LAS float* prm = (LAS float*)(lds + 24576 + 8 * 8448 + 8 * 512);     LAS float* D_l = (LAS float*)(lds + 24576 + 8 * 8448 + w * 512); LAS unsigned char* stage_l = lds + 24576 + w * 8448;
#define PEER_SB __builtin_amdgcn_sched_barrier(0)
#define PEER_ISSUE_U(buf, gi) do { _Pragma("unroll") for (int n2 = 0; n2 < 8; ++n2) { const int e_ = E_l[(gi) * 16 + 2 * n2 + hh]; buf[n2] = *(const u32x4*)(U8 + (size_t)e_ * 512 + 16 * r32); } } while (0)
#define PEER_ISSUE_V(buf, gi) do { _Pragma("unroll") for (int n2 = 0; n2 < 8; ++n2) { const int e_ = E_l[(gi) * 16 + 2 * n2 + hh]; buf[n2] = *(const u32x4*)(V4 + (size_t)e_ * 512 + 16 * r32); } } while (0)
#define PEER_COMP_U(buf) do { _Pragma("unroll") for (int n2 = 0; n2 < 8; ++n2) *(LAS u32x4*)(stage_l + (2 * n2 + hh) * 528 + 16 * r32) = buf[n2]; asm volatile("s_waitcnt lgkmcnt(0)" ::: "memory"); \
        _Pragma("unroll") for (int k2 = 0; k2 < 8; ++k2) { const u32x4 bw = *(const LAS u32x4*)(stage_l + n * 528 + 64 * k2 + 16 * q); const u32x4 alo = *(const LAS u32x4*)(urow_l + 128 * k2 + 16 * q), ahi = *(const LAS u32x4*)(urow_l + 128 * k2 + 64 + 16 * q);     \
            const i32x8 av = (i32x8){(int)alo.x, (int)alo.y, (int)alo.z, (int)alo.w, (int)ahi.x, (int)ahi.y, (int)ahi.z, (int)ahi.w}; const i32x8 bv = (i32x8){(int)bw.x, (int)bw.y, (int)bw.z, (int)bw.w, 0, 0, 0, 0}; \
            if (k2 & 1) acc1 = __builtin_amdgcn_mfma_scale_f32_16x16x128_f8f6f4(av, bv, acc1, 0, 4, 0, 0x7F7F7F7F, 0, 0x7F7F7F7F); else acc = __builtin_amdgcn_mfma_scale_f32_16x16x128_f8f6f4(av, bv, acc, 0  , 4  , 0, 0x7F7F7F7F, 0, 0x7F7F7F7F); } } while (0)
#define PEER_UNPK(wd, base) do { o[(base) / 2 + 0] = __builtin_elementwise_fma(__builtin_bit_cast(h2, __builtin_amdgcn_cvt_scalef32_pk_f16_fp4((wd), 1.0f, 0)), w2, o[(base) / 2 + 0]); o[(base) / 2 + 1] = __builtin_elementwise_fma(__builtin_bit_cast(h2, __builtin_amdgcn_cvt_scalef32_pk_f16_fp4((wd), 1.0f, 1)), w2, o[(base) / 2 + 1]); \
            o[(base) / 2 + 2] = __builtin_elementwise_fma(__builtin_bit_cast(h2, __builtin_amdgcn_cvt_scalef32_pk_f16_fp4((wd), 1.0f, 2)), w2, o[(base) / 2 + 2]); o[(base) / 2 + 3] = __builtin_elementwise_fma(__builtin_bit_cast(h2, __builtin_amdgcn_cvt_scalef32_pk_f16_fp4((wd), 1.0f, 3)), w2, o[(base) / 2 + 3]); } while (0)
#define PEER_COMP_V(buf, gi) do { float wq_[8]; _Pragma("unroll") for (int n2 = 0; n2 < 8; ++n2) wq_[n2] = W_l[(gi) * 16 + 2 * n2 + hh]; \
        _Pragma("unroll") for (int n2 = 0; n2 < 8; ++n2) { const h2 w2 = __builtin_bit_cast(h2, wq_[n2]); const u32x4 v = buf[n2]; \
              \
            asm volatile("" : "+v"(o[0]), "+v"(o[1]), "+v"(o[2]), "+v"(o[3]), "+v"(o[4]), "+v"(o[5]), "+v"(o[6]), "+v"(o[7]), "+v"(o[8]), "+v"(o[9]), "+v"(o[10]), "+v"(o[11]), "+v"(o[12]), "+v"(o[13]), "+v"(o[14]), "+v"(o[15])); \
            PEER_UNPK(v.x, 0); PEER_UNPK(v.y, 8); PEER_UNPK(v.z, 16); PEER_UNPK(v.w, 24); } } while (0)
    int ne0 = 0, ne1 = 0; float ng0 = 0.f, ng1 = 0.f, nsu0 = 0.f, nsu1 = 0.f, nsv0 = 0.f, nsv1 = 0.f; u32x4 nx0 = (u32x4){0u, 0u, 0u, 0u}, nx1 = nx0;
    { const float* ab = ada_l + (size_t)((cblk * (T_ / G)) >> 11) * 6144; const float* anb = ada_next ? ada_next + (size_t)((cblk * (T_ / G)) >> 11) * 6144 : ab;
      for (int i = tid; i < 5 * 256; i += 512) { const int v = i >> 8, c4 = (i & 255) * 4; const float* src = (v == 0) ? ab + 4096 : (v == 1) ? ab + 3072 : (v == 2) ? ab + 5120 : (v == 3) ? anb + 1024 : anb;
          *(LAS f32x4*)(prm + v * 1024 + c4) = *(const f32x4*)(src + c4); }
      __syncthreads(); }
    const int tper = T_ / G, tbeg = cblk * tper, tend = tbeg + tper;
    { const int tok0 = tbeg + w; if (tok0 < tend) { const int dd = 32 * (lane & 31) + 16 * (lane >> 5); nx0 = *(const u32x4*)(x1in + (size_t)tok0 * 1024 + dd); nx1 = *(const u32x4*)(x1in + (size_t)tok0 * 1024 + dd + 8); ne0 = eidx[(size_t)tok0 * 128 + lane]; ne1 = eidx[(size_t)tok0 * 128 + 64 + lane]; ng0 = egate[(size_t)tok0 * 128 + lane]; ng1 = egate[(size_t)tok0 * 128 + 64 + lane];
        nsu0 = sinv[ne0]; nsu1 = sinv[ne1]; nsv0 = sinv[16384 + ne0]; nsv1 = sinv[16384 + ne1]; } }
    float4 ggq[4], bbq[4];
    { const int dd = 32 * (lane & 31) + 16 * (lane >> 5);
#pragma unroll
      for (int j = 0; j < 4; ++j) { ggq[j] = *(const float4*)(g + dd + 4 * j); bbq[j] = *(const float4*)(bta + dd + 4 * j); } }
#pragma unroll 1
    for (int tok = tbeg + w; tok < tend; tok += 8) {
        int lane_o = lane; asm volatile("" : "+v"(lane_o));
        const int q = lane_o >> 4, n = lane_o & 15, r32 = lane_o & 31, hh = lane_o >> 5; int d0 = 32 * r32 + 16 * hh;
        const float* a = ada_l + (size_t)(tok >> 11) * 6144;
        float stinv; float x1[16]; u32x4 bufA[8], bufB[8];
        {
#pragma unroll
            for (int j = 0; j < 16; j += 8) { const u32x4 v = j ? nx1 : nx0;
                x1[j] = __uint_as_float(v.x << 16); x1[j + 1] = __uint_as_float(v.x & 0xffff0000u); x1[j + 2] = __uint_as_float(v.y << 16); x1[j + 3] = __uint_as_float(v.y & 0xffff0000u);
                x1[j + 4] = __uint_as_float(v.z << 16); x1[j + 5] = __uint_as_float(v.z & 0xffff0000u); x1[j + 6] = __uint_as_float(v.w << 16); x1[j + 7] = __uint_as_float(v.w & 0xffff0000u); }
            E_l[lane_o] = ne0; E_l[64 + lane_o] = ne1; W_l[lane_o] = ng0; W_l[64 + lane_o] = ng1;
            SU_l[lane_o] = nsu0; SU_l[64 + lane_o] = nsu1; SV_l[lane_o] = nsv0; SV_l[64 + lane_o] = nsv1;
            asm volatile("s_waitcnt lgkmcnt(0)" ::: "memory");
            PEER_ISSUE_U(bufA, 0); PEER_SB;
            float u[16]; float um = 0.f;
#pragma unroll
            for (int j = 0; j < 16; j += 4) { const f32x4 scv = *(const LAS f32x4*)(prm + d0 + j), shv = *(const LAS f32x4*)(prm + 1024 + d0 + j); const float4 sc = make_float4(scv[0], scv[1], scv[2], scv[3]), sh = make_float4(shv[0], shv[1], shv[2], shv[3]);
                u[j] = x1[j] * (1.f + sc.x) + sh.x; u[j + 1] = x1[j + 1] * (1.f + sc.y) + sh.y; u[j + 2] = x1[j + 2] * (1.f + sc.z) + sh.z; u[j + 3] = x1[j + 3] * (1.f + sc.w) + sh.w;
                um = fmaxf(um, fmaxf(fmaxf(fabsf(u[j]), fabsf(u[j + 1])), fmaxf(fabsf(u[j + 2]), fabsf(u[j + 3])))); }
            um = wave_max(um, lane_o); const float st = (um > 0.f) ? 224.f / um : 1.f; stinv = (um > 0.f) ? um * (1.f / 224.f) : 1.f;
            u32x4 pq; pq.x = pk4_fp8(u[0] * st, u[1] * st, u[2] * st, u[3] * st); pq.y = pk4_fp8(u[4] * st, u[5] * st, u[6] * st, u[7] * st);
            pq.z = pk4_fp8(u[8] * st, u[9] * st, u[10] * st, u[11] * st); pq.w = pk4_fp8(u[12] * st, u[13] * st, u[14] * st, u[15] * st);
            *(LAS u32x4*)(urow_l + d0) = pq; }
        asm volatile("s_waitcnt lgkmcnt(0)" ::: "memory");
        PEER_SB;
#define PEER_FIN_U(gi) do { if (q == 0) D_l[(gi) * 16 + n] = acc[0] + acc1[0]; } while (0)
#pragma unroll 1
        for (int gi = 0; gi < 8; gi += 2) { f32x4 acc = (f32x4){0.f, 0.f, 0.f, 0.f}, acc1 = acc;
            PEER_ISSUE_U(bufB, gi + 1); PEER_SB; PEER_COMP_U(bufA); PEER_FIN_U(gi); PEER_SB;
            if (gi < 6) PEER_ISSUE_U(bufA, gi + 2); else PEER_ISSUE_V(bufA, 0);
            PEER_SB; acc = (f32x4){0.f, 0.f, 0.f, 0.f}; acc1 = acc; PEER_COMP_U(bufB); PEER_FIN_U(gi + 1); PEER_SB; }
        asm volatile("s_waitcnt lgkmcnt(0)" ::: "memory");
#pragma unroll
        for (int t = 0; t < 2; ++t) { const int ix = lane_o + 64 * t; const float ds_ = D_l[ix] * (SU_l[ix] * stinv); const float wv_ = W_l[ix] * 0.5f * ds_ * (1.f + erff(ds_ * 0.70710678118654752f)) * SV_l[ix];
            const _Float16 wh_ = (_Float16)wv_; W_l[ix] = __builtin_bit_cast(float, (h2){wh_, wh_}); }
#undef PEER_FIN_U
        asm volatile("s_waitcnt lgkmcnt(0)" ::: "memory");
        h2 o2[16];
#pragma unroll
        for (int j = 0; j < 16; ++j) o2[j] = (h2){(_Float16)0.f, (_Float16)0.f};
        const int tokn = tok + 8; const bool hasn = tokn < tend;
        if (hasn) { nx0 = *(const u32x4*)(x1in + (size_t)tokn * 1024 + d0); nx1 = *(const u32x4*)(x1in + (size_t)tokn * 1024 + d0 + 8); ne0 = eidx[(size_t)tokn * 128 + lane_o]; ne1 = eidx[(size_t)tokn * 128 + 64 + lane_o]; ng0 = egate[(size_t)tokn * 128 + lane_o]; ng1 = egate[(size_t)tokn * 128 + 64 + lane_o]; }
        PEER_SB;
        { h2 (&o)[16] = o2;
#pragma unroll 1
        for (int gi = 0; gi < 8; gi += 2) {
            PEER_ISSUE_V(bufB, gi + 1); PEER_SB; PEER_COMP_V(bufA, gi); PEER_SB;
            if (gi < 6) PEER_ISSUE_V(bufA, gi + 2);
            if (gi == 2 && hasn) { nsu0 = sinv[ne0]; nsu1 = sinv[ne1]; nsv0 = sinv[16384 + ne0]; nsv1 = sinv[16384 + ne1]; }
            PEER_SB; PEER_COMP_V(bufB, gi + 1); PEER_SB; } }
        asm volatile("" : "+v"(lane_o)); d0 = 32 * (lane_o & 31) + 16 * (lane_o >> 5);
        const unsigned hm = 0u - (unsigned)(lane_o >> 5);
        float o[16];
#pragma unroll
        for (int j = 0; j < 16; ++j) { const float lo_ = (float)o2[j >> 1][j & 1], hi_ = (float)o2[8 + (j >> 1)][j & 1];
            const float keep = __uint_as_float((__float_as_uint(lo_) & ~hm) | (__float_as_uint(hi_) & hm)), send = __uint_as_float((__float_as_uint(hi_) & ~hm) | (__float_as_uint(lo_) & hm));
            o[j] = keep + xor_f(send, 32, lane_o); }
        float hv[16]; float s = 0.f;
        float4 g2q[4];
#pragma unroll
        for (int j = 0; j < 4; ++j) { const f32x4 gv = *(const LAS f32x4*)(prm + 2048 + d0 + 4 * j); g2q[j] = make_float4(gv[0], gv[1], gv[2], gv[3]); }
        asm volatile("" ::: "memory");
#pragma unroll
        for (int j = 0; j < 16; j += 4) { const float4 g2 = g2q[j >> 2];
            hv[j] = ALPHA_ * x1[j] + g2.x * o[j]; hv[j + 1] = ALPHA_ * x1[j + 1] + g2.y * o[j + 1]; hv[j + 2] = ALPHA_ * x1[j + 2] + g2.z * o[j + 2]; hv[j + 3] = ALPHA_ * x1[j + 3] + g2.w * o[j + 3];
            s += (hv[j] + hv[j + 1]) + (hv[j + 2] + hv[j + 3]); }
        const float mu = wave_sum(s, lane_o) * (1.f / 1024.f); float qq = 0.f;
#pragma unroll
        for (int j = 0; j < 16; ++j) { const float dd = hv[j] - mu; qq += dd * dd; }
        const float rstd = rsqrtf(wave_sum(qq, lane_o) * (1.f / 1024.f) + LN_EPS_);
        const float* an = ada_next ? ada_next + (size_t)(tok >> 11) * 6144 : nullptr;
        float y[16];
#pragma unroll
        for (int j = 0; j < 16; j += 4) { const float4 gg = ggq[j >> 2], bb = bbq[j >> 2];
            y[j] = (hv[j] - mu) * rstd * gg.x + bb.x; y[j + 1] = (hv[j + 1] - mu) * rstd * gg.y + bb.y; y[j + 2] = (hv[j + 2] - mu) * rstd * gg.z + bb.z; y[j + 3] = (hv[j + 3] - mu) * rstd * gg.w + bb.w; }
        if (!xout16) {
#pragma unroll
            for (int j = 0; j < 16; j += 4) *(float4*)(xout32 + (size_t)tok * 1024 + d0 + j) = make_float4(y[j], y[j + 1], y[j + 2], y[j + 3]); }
        if (xout16) { u32x4 q0, q1; q0.x = pg8::cvt_pk_bf16(y[0], y[1]); q0.y = pg8::cvt_pk_bf16(y[2], y[3]); q0.z = pg8::cvt_pk_bf16(y[4], y[5]); q0.w = pg8::cvt_pk_bf16(y[6], y[7]);
            q1.x = pg8::cvt_pk_bf16(y[8], y[9]); q1.y = pg8::cvt_pk_bf16(y[10], y[11]); q1.z = pg8::cvt_pk_bf16(y[12], y[13]); q1.w = pg8::cvt_pk_bf16(y[14], y[15]);
            bf16_t* xo = xout16 + (size_t)tok * 1024 + d0; *(u32x4*)xo = q0; *(u32x4*)(xo + 8) = q1; }
        if (an) { float uu[16]; float um = 0.f; float4 scq[4], shq[4];
#pragma unroll
            for (int j = 0; j < 4; ++j) { const f32x4 sv = *(const LAS f32x4*)(prm + 3072 + d0 + 4 * j), hv4 = *(const LAS f32x4*)(prm + 4096 + d0 + 4 * j); scq[j] = make_float4(sv[0], sv[1], sv[2], sv[3]); shq[j] = make_float4(hv4[0], hv4[1], hv4[2], hv4[3]); }
            asm volatile("" ::: "memory");
#pragma unroll
            for (int j = 0; j < 16; j += 4) { const float4 sc = scq[j >> 2], sh = shq[j >> 2];
                uu[j] = y[j] * (1.f + sc.x) + sh.x; uu[j + 1] = y[j + 1] * (1.f + sc.y) + sh.y; uu[j + 2] = y[j + 2] * (1.f + sc.z) + sh.z; uu[j + 3] = y[j + 3] * (1.f + sc.w) + sh.w;
                um = fmaxf(um, fmaxf(fmaxf(fabsf(uu[j]), fabsf(uu[j + 1])), fmaxf(fabsf(uu[j + 2]), fabsf(uu[j + 3])))); }
            um = wave_max(um, lane_o); const float qs = (um > 0.f) ? 127.f / um : 0.f; unsigned o8[4];
#pragma unroll
            for (int e = 0; e < 4; ++e) { o8[e] = 0u;
#pragma unroll
                for (int j = 0; j < 4; ++j) o8[e] |= ((unsigned)(int)rintf(uu[4 * e + j] * qs) & 0xffu) << (8 * j); }
            *(u32x4*)((unsigned char*)(UY + (size_t)tok * UYW_) + d0) = (u32x4){o8[0], o8[1], o8[2], o8[3]};
            if (lane_o == 0) su_next[tok] = um * (1.f / 127.f); }
        asm volatile("s_waitcnt lgkmcnt(0)" ::: "memory");
    }
#undef PEER_SB
#undef PEER_ISSUE_U
#undef PEER_ISSUE_V
#undef PEER_COMP_U
#undef PEER_COMP_V
#undef PEER_UNPK
    __syncthreads();
}
}

namespace tk {
typedef float f32x16 __attribute__((ext_vector_type(16)));
constexpr int KROW = 272;
DEV unsigned sortable(float v) { const unsigned u = __float_as_uint(v); return u ^ ((unsigned)((int)u >> 31) | 0x80000000u); }
DEV float unsortable(unsigned k) { return __uint_as_float(k ^ ((~(unsigned)((int)k >> 31)) | 0x80000000u)); }
DEV unsigned umax_(unsigned a, unsigned b) { return a > b ? a : b; }
DEV unsigned umin_(unsigned a, unsigned b) { return a < b ? a : b; }
#define CE(x, y) { const unsigned hi_ = umax_(a[x], a[y]), lo_ = umin_(a[x], a[y]); a[x] = hi_; a[y] = lo_; }
DEV void sort16(unsigned (&a)[16]) {
    CE(0, 1); CE(3, 2); CE(4, 5); CE(7, 6); CE(8, 9); CE(11, 10); CE(12, 13); CE(15, 14); CE(0, 2); CE(1, 3); CE(6, 4); CE(7, 5); CE(8, 10); CE(9, 11); CE(14, 12); CE(15, 13); CE(0, 1); CE(2, 3); CE(5, 4); CE(7, 6); CE(8, 9); CE(10, 11); CE(13, 12); CE(15, 14); CE(0, 4); CE(1, 5); CE(2, 6); CE(3, 7); CE(12, 8); CE(13, 9); CE(14, 10); CE(15, 11); CE(0, 2); CE(1, 3); CE(4, 6); CE(5, 7); CE(10, 8); CE(11, 9); CE(14, 12); CE(15, 13); CE(0, 1); CE(2, 3); CE(4, 5); CE(6, 7); CE(9, 8); CE(11, 10); CE(13, 12); CE(15, 14); CE(0, 8); CE(1, 9); CE(2, 10); CE(3, 11); CE(4, 12); CE(5, 13); CE(6, 14); CE(7, 15); CE(0, 4); CE(1, 5); CE(2, 6); CE(3, 7); CE(8, 12); CE(9, 13); CE(10, 14); CE(11, 15); CE(0, 2); CE(1, 3); CE(4, 6); CE(5, 7); CE(8, 10); CE(9, 11); CE(12, 14); CE(13, 15); CE(0, 1); CE(2, 3); CE(4, 5); CE(6, 7); CE(8, 9); CE(10, 11); CE(12, 13); CE(14, 15);
}
DEV void bmerge16(unsigned (&a)[16]) {
    CE(0, 8); CE(1, 9); CE(2, 10); CE(3, 11); CE(4, 12); CE(5, 13); CE(6, 14); CE(7, 15); CE(0, 4); CE(1, 5); CE(2, 6); CE(3, 7); CE(8, 12); CE(9, 13); CE(10, 14); CE(11, 15); CE(0, 2); CE(1, 3); CE(4, 6); CE(5, 7); CE(8, 10); CE(9, 11); CE(12, 14); CE(13, 15); CE(0, 1); CE(2, 3); CE(4, 5); CE(6, 7); CE(8, 9); CE(10, 11); CE(12, 13); CE(14, 15);
}
#undef CE
DEV void top_merge(unsigned (&a)[16], const unsigned (&b)[16]) {
#pragma unroll
    for (int i = 0; i < 16; ++i) a[i] = umax_(a[i], b[15 - i]);
    bmerge16(a);
}
DEV void xlane_merge(unsigned (&a)[16], int lane) {
    unsigned b[16];
#pragma unroll
    for (int i = 0; i < 16; ++i) b[i] = (unsigned)xor_i((int)a[i], 32, lane);
    top_merge(a, b);
}
DEV unsigned lookup_idx(unsigned long long lo, unsigned long long hi, int a) { const unsigned long long wv = (a < 8) ? lo : hi; return (unsigned)(wv >> ((a & 7) * 8)) & 127u; }
DEV unsigned blendu(unsigned m, unsigned a, unsigned b) { return (a & ~m) | (b & m); }
DEV float blendf(unsigned m, float a, float b) { return __uint_as_float((__float_as_uint(a) & ~m) | (__float_as_uint(b) & m)); }

DEV void topk_phase(LAS unsigned char* lds, const bf16_t* __restrict__ Q2, const float* __restrict__ keys_l, int* __restrict__ eidx, float* __restrict__ egate, int G, int cblk, int wv) {
    int wv_ = wv, ln_; asm volatile("v_mbcnt_lo_u32_b32 %1, -1, 0\n\tv_mbcnt_hi_u32_b32 %1, -1, %1" : "+s"(wv_), "=v"(ln_)); int tid_ = (wv_ << 6) | ln_;
    const int tid = tid_, w = __builtin_amdgcn_readfirstlane(tid >> 6), lane = tid & 63, tl = lane & 31, hh = lane >> 5;
    asm volatile("" : "+s"(G));
    const bool by_head = (G & 7) == 0;
#pragma unroll 1
    for (int h = 0; h < 8; ++h) {
        if (by_head && h != (cblk & 7)) continue;
        __syncthreads();
        {
            const int r = tid >> 1, c0 = (tid & 1) * 64; const float* src = keys_l + ((size_t)h * 256 + r) * 128 + c0; LAS unsigned char* dst = lds + r * KROW + c0 * 2;
            float4 kq_[16];
#pragma unroll
            for (int j = 0; j < 16; ++j) kq_[j] = *(const float4*)(src + 4 * j);
            asm volatile("" ::: "memory");
#pragma unroll
            for (int j = 0; j < 64; j += 8) { const float4 a = kq_[j >> 2], b = kq_[(j >> 2) + 1];
                u32x4 o; o.x = pg8::cvt_pk_bf16(a.x, a.y); o.y = pg8::cvt_pk_bf16(a.z, a.w); o.z = pg8::cvt_pk_bf16(b.x, b.y); o.w = pg8::cvt_pk_bf16(b.z, b.w); *(LAS u32x4*)(dst + j * 2) = o; }
        }
        __syncthreads();
        const int first = by_head ? (cblk >> 3) * 8 + w : cblk * 8 + w, stride = by_head ? (G >> 3) * 8 : G * 8;
#pragma unroll 1
        for (int blk = first; blk < T_ / 32; blk += stride) {
            const int tok = blk * 32 + tl; const bf16_t* qrow = Q2 + (size_t)tok * 2048 + h * 256 + 8 * hh;
            unsigned L[2][16];
#pragma unroll
            for (int p = 0; p < 2; ++p) {
                bf16x8 bq[8];
#pragma unroll
                for (int ks = 0; ks < 8; ++ks) bq[ks] = *(const bf16x8*)(qrow + p * 128 + 16 * ks);
#pragma unroll
                for (int t = 0; t < 4; ++t) {
                    f32x16 acc;
#pragma unroll
                    for (int e = 0; e < 16; ++e) acc[e] = 0.f;
#pragma unroll
                    for (int ks = 0; ks < 8; ++ks) { const bf16x8 ak = *(const LAS bf16x8*)(lds + (p * 128 + 32 * t + tl) * KROW + (16 * ks + 8 * hh) * 2);
                        acc = __builtin_amdgcn_mfma_f32_32x32x16_bf16(ak, bq[ks], acc, 0, 0, 0); }
                    unsigned K[16];
#pragma unroll
                    for (int e = 0; e < 16; ++e) K[e] = (sortable(acc[e]) & ~127u) | (unsigned)((127 - 32 * t - (e & 3) - 8 * (e >> 2)) - 4 * hh);
                    sort16(K);
                    if (t == 0) {
#pragma unroll
                        for (int e = 0; e < 16; ++e) L[p][e] = K[e];
                    } else top_merge(L[p], K);
                    __builtin_amdgcn_sched_barrier(0);
                }
                xlane_merge(L[p], lane);
                __builtin_amdgcn_sched_barrier(0);
            }
            float f1[16], f2[16];
#pragma unroll
            for (int e = 0; e < 16; ++e) { f1[e] = unsortable(L[0][e] & ~127u); f2[e] = unsortable(L[1][e] & ~127u); }
            unsigned hm = 0u - (unsigned)hh; asm volatile("" : "+v"(hm));
            unsigned C[2][16];
            C[0][0] = (sortable(blendf(hm, f1[0], f1[2]) + blendf(hm, f2[0], f2[1])) & ~255u) | (255u - blendu(hm, 0u, 33u));
            C[0][1] = (sortable(blendf(hm, f1[0], f1[2]) + blendf(hm, f2[1], f2[2])) & ~255u) | (255u - blendu(hm, 1u, 34u));
            C[0][2] = (sortable(blendf(hm, f1[0], f1[2]) + blendf(hm, f2[2], f2[3])) & ~255u) | (255u - blendu(hm, 2u, 35u));
            C[0][3] = (sortable(blendf(hm, f1[0], f1[2]) + blendf(hm, f2[3], f2[4])) & ~255u) | (255u - blendu(hm, 3u, 36u));
            C[0][4] = (sortable(blendf(hm, f1[0], f1[3]) + blendf(hm, f2[4], f2[0])) & ~255u) | (255u - blendu(hm, 4u, 48u));
            C[0][5] = (sortable(blendf(hm, f1[0], f1[3]) + blendf(hm, f2[5], f2[1])) & ~255u) | (255u - blendu(hm, 5u, 49u));
            C[0][6] = (sortable(blendf(hm, f1[0], f1[3]) + blendf(hm, f2[6], f2[2])) & ~255u) | (255u - blendu(hm, 6u, 50u));
            C[0][7] = (sortable(blendf(hm, f1[0], f1[3]) + blendf(hm, f2[7], f2[3])) & ~255u) | (255u - blendu(hm, 7u, 51u));
            C[0][8] = (sortable(blendf(hm, f1[0], f1[4]) + blendf(hm, f2[8], f2[0])) & ~255u) | (255u - blendu(hm, 8u, 64u));
            C[0][9] = (sortable(blendf(hm, f1[0], f1[4]) + blendf(hm, f2[9], f2[1])) & ~255u) | (255u - blendu(hm, 9u, 65u));
            C[0][10] = (sortable(blendf(hm, f1[0], f1[4]) + blendf(hm, f2[10], f2[2])) & ~255u) | (255u - blendu(hm, 10u, 66u));
            C[0][11] = (sortable(blendf(hm, f1[0], f1[5]) + blendf(hm, f2[11], f2[0])) & ~255u) | (255u - blendu(hm, 11u, 80u));
            C[0][12] = (sortable(blendf(hm, f1[0], f1[5]) + blendf(hm, f2[12], f2[1])) & ~255u) | (255u - blendu(hm, 12u, 81u));
            C[0][13] = (sortable(blendf(hm, f1[0], f1[6]) + blendf(hm, f2[13], f2[0])) & ~255u) | (255u - blendu(hm, 13u, 96u));
            C[0][14] = (sortable(blendf(hm, f1[0], f1[6]) + blendf(hm, f2[14], f2[1])) & ~255u) | (255u - blendu(hm, 14u, 97u));
            C[0][15] = (sortable(blendf(hm, f1[0], f1[7]) + blendf(hm, f2[15], f2[0])) & ~255u) | (255u - blendu(hm, 15u, 112u));
            C[1][0] = (sortable(blendf(hm, f1[1], f1[7]) + blendf(hm, f2[0], f2[1])) & ~255u) | (255u - blendu(hm, 16u, 113u));
            C[1][1] = (sortable(blendf(hm, f1[1], f1[8]) + blendf(hm, f2[1], f2[0])) & ~255u) | (255u - blendu(hm, 17u, 128u));
            C[1][2] = (sortable(blendf(hm, f1[1], f1[9]) + blendf(hm, f2[2], f2[0])) & ~255u) | (255u - blendu(hm, 18u, 144u));
            C[1][3] = (sortable(blendf(hm, f1[1], f1[10]) + blendf(hm, f2[3], f2[0])) & ~255u) | (255u - blendu(hm, 19u, 160u));
            C[1][4] = (sortable(blendf(hm, f1[1], f1[11]) + blendf(hm, f2[4], f2[0])) & ~255u) | (255u - blendu(hm, 20u, 176u));
            C[1][5] = (sortable(blendf(hm, f1[1], f1[12]) + blendf(hm, f2[5], f2[0])) & ~255u) | (255u - blendu(hm, 21u, 192u));
            C[1][6] = (sortable(blendf(hm, f1[1], f1[13]) + blendf(hm, f2[6], f2[0])) & ~255u) | (255u - blendu(hm, 22u, 208u));
            C[1][7] = (sortable(blendf(hm, f1[1], f1[14]) + blendf(hm, f2[7], f2[0])) & ~255u) | (255u - blendu(hm, 23u, 224u));
            C[1][8] = (sortable(blendf(hm, f1[2], f1[15]) + blendf(hm, f2[0], f2[0])) & ~255u) | (255u - blendu(hm, 32u, 240u));
            C[1][9] = 0u;
            C[1][10] = 0u;
            C[1][11] = 0u;
            C[1][12] = 0u;
            C[1][13] = 0u;
            C[1][14] = 0u;
            C[1][15] = 0u;
            sort16(C[0]); sort16(C[1]); top_merge(C[0], C[1]); xlane_merge(C[0], lane);
            unsigned long long p1lo = 0ull, p1hi = 0ull, p2lo = 0ull, p2hi = 0ull;
#pragma unroll
            for (int m = 0; m < 8; ++m) { p1lo |= (unsigned long long)(127u - (L[0][m] & 127u)) << (8 * m); p1hi |= (unsigned long long)(127u - (L[0][8 + m] & 127u)) << (8 * m);
                p2lo |= (unsigned long long)(127u - (L[1][m] & 127u)) << (8 * m); p2hi |= (unsigned long long)(127u - (L[1][8 + m] & 127u)) << (8 * m); }
            float val[16]; unsigned ex[16]; float sum = 0.f;
#pragma unroll
            for (int k = 0; k < 16; ++k) { const unsigned flat = 255u - (C[0][k] & 255u); const int a = (int)(flat >> 4), b = (int)(flat & 15u);
                val[k] = unsortable(C[0][k] & ~255u); ex[k] = lookup_idx(p1lo, p1hi, a) * 128u + lookup_idx(p2lo, p2hi, b); }
            const float mx = val[0];
#pragma unroll
            for (int k = 0; k < 16; ++k) { val[k] = __expf(val[k] - mx); sum += val[k]; }
            const float inv = 1.f / sum;
            int eo[8]; float go[8];
#pragma unroll
            for (int k = 0; k < 8; ++k) { eo[k] = (int)blendu(hm, ex[k], ex[8 + k]); go[k] = blendf(hm, val[k], val[8 + k]) * inv; }
            const size_t ob = ((size_t)tok * 8 + h) * 16 + 8 * hh;
            *(int4*)(eidx + ob) = make_int4(eo[0], eo[1], eo[2], eo[3]); *(int4*)(eidx + ob + 4) = make_int4(eo[4], eo[5], eo[6], eo[7]);
            *(float4*)(egate + ob) = make_float4(go[0], go[1], go[2], go[3]); *(float4*)(egate + ob + 4) = make_float4(go[4], go[5], go[6], go[7]);
        }
    }
    __syncthreads();
}
}

namespace at {
typedef float f32x16 __attribute__((ext_vector_type(16)));
constexpr int KROWB = 144, VROWB = 776, K_OFF = 0, V_OFF = 384 * KROWB, LDS_END = V_OFF + 64 * VROWB;
constexpr int N_ITEMS_A = 16 * 12 * 8, N_ITEMS_C = 16 * 2 * 16 * 2;

struct Band { int p_w, ls, R, slot_base; };
template <bool MASK>
DEV void chunk(LAS const unsigned char* lds, const Band& bd, int c, const bf16x8 (&qf)[4], int tl, int hh, int lane, f32x16 (&O)[2], float& m, float& l) {
    const int kp0 = bd.p_w - bd.R + 32 * c;
    if (kp0 + 31 < 0 || kp0 >= bd.ls) return;
    const int s0 = kp0 + bd.slot_base;
    f32x16 S;
#pragma unroll
    for (int e = 0; e < 16; ++e) S[e] = 0.f;
#pragma unroll
    for (int ks = 0; ks < 4; ++ks) { const bf16x8 ak = *(const LAS bf16x8*)(lds + K_OFF + (s0 + tl) * KROWB + (16 * ks + 8 * hh) * 2); S = __builtin_amdgcn_mfma_f32_32x32x16_bf16(ak, qf[ks], S, 0, 0, 0); }
    float cmax = -1e30f;
    if (MASK) {
        const int dbase = (32 * c - bd.R) - tl + 4 * hh;
#pragma unroll
        for (int e = 0; e < 16; ++e) { const int diff = dbase + (e & 3) + 8 * (e >> 2); const bool ok = (diff <= bd.R) && (diff >= -bd.R); S[e] = ok ? S[e] : -1e30f; cmax = fmaxf(cmax, S[e]); }
    } else {
#pragma unroll
        for (int e = 0; e < 16; ++e) cmax = fmaxf(cmax, S[e]);
    }
    cmax = fmaxf(cmax, xor_f(cmax, 32, lane));
    if (__builtin_amdgcn_ballot_w64(cmax - m > 8.0f) != 0ull) { const float mn = fmaxf(m, cmax), alpha = __builtin_amdgcn_exp2f(m - mn); m = mn; l *= alpha;
#pragma unroll
        for (int e = 0; e < 16; ++e) { O[0][e] *= alpha; O[1][e] *= alpha; } }
    float psum = 0.f;
#pragma unroll
    for (int e = 0; e < 16; ++e) { S[e] = __builtin_amdgcn_exp2f(S[e] - m); psum += S[e]; }
    l += psum;
#pragma unroll
    for (int sx = 0; sx < 2; ++sx) {
        u32x4 pw; pw.x = pg8::cvt_pk_bf16(S[8 * sx + 0], S[8 * sx + 1]); pw.y = pg8::cvt_pk_bf16(S[8 * sx + 2], S[8 * sx + 3]); pw.z = pg8::cvt_pk_bf16(S[8 * sx + 4], S[8 * sx + 5]); pw.w = pg8::cvt_pk_bf16(S[8 * sx + 6], S[8 * sx + 7]);
        const bf16x8 pb = __builtin_bit_cast(bf16x8, pw);
#pragma unroll
        for (int dt = 0; dt < 2; ++dt) { LAS const unsigned char* vp = lds + V_OFF + (32 * dt + tl) * VROWB + (s0 + 16 * sx + 4 * hh) * 2;
            const u32x2 lo = *(const LAS u32x2*)vp, hi = *(const LAS u32x2*)(vp + 16); const u32x4 vw = (u32x4){lo.x, lo.y, hi.x, hi.y};
            O[dt] = __builtin_amdgcn_mfma_f32_32x32x16_bf16(__builtin_bit_cast(bf16x8, vw), pb, O[dt], 0, 0, 0); }
    }
}
DEV void attn_phase(LAS unsigned char* lds, bf16_t* P, float* lse2, bf16_t* Y, const float* sink_l, int G, int cblk, int wv) {
    int wv_ = wv, ln_; asm volatile("v_mbcnt_lo_u32_b32 %1, -1, 0\n\tv_mbcnt_hi_u32_b32 %1, -1, %1" : "+s"(wv_), "=v"(ln_)); int tid_ = (wv_ << 6) | ln_;
    const int tid = tid_, w = __builtin_amdgcn_readfirstlane(tid >> 6), lane = tid & 63, tl = lane & 31, hh = lane >> 5;
#pragma unroll 1
    for (int item = cblk; item < N_ITEMS_A + N_ITEMS_C; item += G) {
        int b, dil, ls, r, klo, nsl, R, kcol, vcol, qcol, two = 0, rp = 0, sb = 0, head = 0, isC = 0, nb = 0, qh0 = 0;
        if (item < N_ITEMS_A) { b = item / 96; const int rem = item - b * 96; head = rem >> 3; const int sub = rem & 7, g = head >> 2; R = 64;
            kcol = 768 + head * 64; vcol = 1536 + head * 64; qcol = head * 64;
            if (g == 0) { dil = 1; ls = 2048; r = 0; sb = sub; klo = 256 * sb - 64; nsl = 384; }
            else if (g == 1) { dil = 4; ls = 512; r = sub >> 1; sb = sub & 1; klo = 256 * sb - 64; nsl = 384; }
            else { dil = 16; ls = 128; r = 0; rp = sub; klo = 0; nsl = 256; two = 1; } }
        else { const int it = item - N_ITEMS_A; b = it >> 6; const int rem = it & 63; const int kvh = rem >> 5; nb = (rem & 31) >> 1; const int hp = rem & 1; isC = 1; R = 128;
            dil = 1; ls = 2048; r = 0; klo = 128 * nb - 128; nsl = 384; kcol = 2816 + kvh * 64; vcol = 2944 + kvh * 64; qh0 = kvh * 4 + hp * 2; qcol = 2304 + qh0 * 64; }
        __syncthreads();
        {
            u32x4 kq[3][2], vq[3][2]; unsigned okm[3][2];
#pragma unroll
            for (int it = 0; it < 3; ++it) { const int i2 = tid + 512 * it; const int sp = (i2 >> 3) < (nsl >> 1) ? (i2 >> 3) : (nsl >> 1) - 1, part = i2 & 7;
#pragma unroll
                for (int t = 0; t < 2; ++t) { const int slot = 2 * sp + t; int kpos, rr;
                    if (two) { kpos = slot & 127; rr = 2 * rp + (slot >> 7); } else { kpos = klo + slot; rr = r; }
                    okm[it][t] = (kpos >= 0 && kpos < ls) ? 0xffffffffu : 0u; const int kc = kpos < 0 ? 0 : (kpos < ls ? kpos : ls - 1);
                    const bf16_t* rowp = P + (size_t)(b * 2048 + kc * dil + rr) * PW_; kq[it][t] = *(const u32x4*)(rowp + kcol + part * 8); vq[it][t] = *(const u32x4*)(rowp + vcol + part * 8); } }
            asm volatile("" ::: "memory");
#pragma unroll
            for (int it = 0; it < 3; ++it) { const int i2 = tid + 512 * it; if (i2 < nsl * 4) { const int sp = i2 >> 3, part = i2 & 7; const unsigned m0 = okm[it][0], m1 = okm[it][1];
                *(LAS u32x4*)(lds + K_OFF + (2 * sp) * KROWB + part * 16) = (u32x4){kq[it][0].x & m0, kq[it][0].y & m0, kq[it][0].z & m0, kq[it][0].w & m0};
                *(LAS u32x4*)(lds + K_OFF + (2 * sp + 1) * KROWB + part * 16) = (u32x4){kq[it][1].x & m1, kq[it][1].y & m1, kq[it][1].z & m1, kq[it][1].w & m1};
                const unsigned a0[4] = {vq[it][0].x & m0, vq[it][0].y & m0, vq[it][0].z & m0, vq[it][0].w & m0}, a1[4] = {vq[it][1].x & m1, vq[it][1].y & m1, vq[it][1].z & m1, vq[it][1].w & m1};
                LAS unsigned* vt = (LAS unsigned*)(lds + V_OFF + (part * 8) * VROWB + (2 * sp) * 2);
#pragma unroll
                for (int e = 0; e < 4; ++e) { vt[(2 * e) * (VROWB / 4)] = (a0[e] & 0xffffu) | (a1[e] << 16); vt[(2 * e + 1) * (VROWB / 4)] = (a0[e] >> 16) | (a1[e] & 0xffff0000u); } } }
        }
        __syncthreads();
        Band bd; int qtok, rr = r; bd.ls = ls; bd.R = R;
        if (two) { const int half = w >> 2; bd.p_w = 32 * (w & 3); rr = 2 * rp + half; bd.slot_base = half * 128; }
        else if (isC) { bd.p_w = 128 * nb + 32 * (w & 3); bd.slot_base = -klo; }
        else { bd.p_w = 256 * sb + 32 * w; bd.slot_base = -klo; }
        qtok = b * 2048 + (bd.p_w + tl) * dil + rr;
        const int qc = isC ? (qcol + (w >> 2) * 64) : qcol;
        const bf16_t* qp = P + (size_t)qtok * PW_ + qc + 8 * hh;
        bf16x8 qf[4];
#pragma unroll
        for (int ks = 0; ks < 4; ++ks) qf[ks] = *(const bf16x8*)(qp + 16 * ks);
        f32x16 O[2];
#pragma unroll
        for (int e = 0; e < 16; ++e) { O[0][e] = 0.f; O[1][e] = 0.f; }
        float m = -1e30f, l = 0.f;
        const int nch = R / 16 + 1, cd = R / 32;
        chunk<false>(lds, bd, cd, qf, tl, hh, lane, O, m, l);
        chunk<true>(lds, bd, 0, qf, tl, hh, lane, O, m, l); chunk<true>(lds, bd, nch - 1, qf, tl, hh, lane, O, m, l);
#pragma unroll 1
        for (int c = 1; c < nch - 1; ++c) { if (c != cd) chunk<false>(lds, bd, c, qf, tl, hh, lane, O, m, l); }
        float lt = l + xor_f(l, 32, lane), scale;
        if (isC) { const float sk = sink_l[qh0 + (w >> 2)] * LOG2E_; const float mf = fmaxf(m, sk), corr = exp2f(m - mf); lt = lt * corr + exp2f(sk - mf); scale = corr / lt; }
        else { scale = 1.f / lt; if (hh == 0) lse2[(size_t)qtok * 12 + head] = m + log2f(lt); }
        bf16_t* op = isC ? (Y + (size_t)qtok * UYW_ + 768 + (qh0 + (w >> 2)) * 64) : (P + (size_t)qtok * PW_ + qcol);
#pragma unroll
        for (int dt = 0; dt < 2; ++dt)
#pragma unroll
            for (int gp = 0; gp < 2; ++gp) { const int ge = 2 * gp, go = 2 * gp + 1;
                const unsigned ex = pg8::cvt_pk_bf16(O[dt][4 * ge] * scale, O[dt][4 * ge + 1] * scale), ey = pg8::cvt_pk_bf16(O[dt][4 * ge + 2] * scale, O[dt][4 * ge + 3] * scale);
                const unsigned ox = pg8::cvt_pk_bf16(O[dt][4 * go] * scale, O[dt][4 * go + 1] * scale), oy = pg8::cvt_pk_bf16(O[dt][4 * go + 2] * scale, O[dt][4 * go + 3] * scale);
                const auto sx = __builtin_amdgcn_permlane32_swap(ex, ox, false, false), sy = __builtin_amdgcn_permlane32_swap(ey, oy, false, false);
                *(u32x4*)(op + 32 * dt + 8 * (ge + hh)) = (u32x4){sx[0], sy[0], sx[1], sy[1]}; }
    }
    __syncthreads();
}
}

namespace xb {
constexpr int XB_TMO = 128, XB_TOP = 3328, XB_TOPGEN = 3392, XCD_BAR_WORDS = 3456; constexpr unsigned XB_SPIN_CAP = 1u << 22;
DEV constexpr int XB_XCNT(int j) { return 256 + 64 * j; }
DEV constexpr int XB_XSUB(int j) { return 1280 + 64 * j; }
DEV constexpr int XB_XGEN(int j) { return 2304 + 64 * j; }
DEV unsigned xb_ld(unsigned* p) { return __hip_atomic_load(p, __ATOMIC_RELAXED, __HIP_MEMORY_SCOPE_AGENT); }
DEV unsigned xb_add(unsigned* p, unsigned v) { return __hip_atomic_fetch_add(p, v, __ATOMIC_RELAXED, __HIP_MEMORY_SCOPE_AGENT); }
DEV unsigned xb_xcc_id() { return (unsigned)__builtin_amdgcn_s_getreg((3 << 11) | 20) & 0xFu; }
#define XB_SPIN(cond, bar) do { unsigned _sp = 0; while (cond) { __builtin_amdgcn_s_sleep(1); \
    if ((++_sp & 255u) == 0u) { if (xb_ld(&(bar)[XB_TMO])) break; if (_sp > XB_SPIN_CAP) { atomicAdd(&(bar)[XB_TMO], 1u); break; } } } } while (0)
struct XcdBarrier { unsigned* bar; unsigned x; volatile LAS unsigned* st; };
DEV XcdBarrier xcd_barrier_post(unsigned* bar, volatile LAS unsigned* st) { XcdBarrier b; b.bar = bar; b.x = xb_xcc_id(); b.st = st; if (threadIdx.x == 0) (void)xb_add(&bar[XB_XCNT(b.x)], 1u); return b; }
DEV void xcd_barrier_complete(unsigned* bar, unsigned x, unsigned& nloc, unsigned& nx) {
    const unsigned G = gridDim.x * gridDim.y * gridDim.z; unsigned sum, cnt, mine, sp = 0u;
    for (;;) { sum = 0u; cnt = 0u; mine = 0u;
#pragma unroll
        for (unsigned j = 0; j < 16; ++j) { const unsigned c = xb_ld(&bar[XB_XCNT(j)]); sum += c; cnt += (c > 0u) ? 1u : 0u; mine = (j == x) ? c : mine; }
        if (sum == G) break;
        __builtin_amdgcn_s_sleep(1);
        if ((++sp & 255u) == 0u) { if (xb_ld(&bar[XB_TMO])) break; if (sp > XB_SPIN_CAP) { atomicAdd(&bar[XB_TMO], 1u); break; } } }
    nloc = mine > 0u ? mine : 1u; nx = cnt > 0u ? cnt : 1u;
}
DEV void xcd_barrier(const XcdBarrier& b, int wv) {
    asm volatile("s_waitcnt vmcnt(0)" ::: "memory");
    __syncthreads();
    int ln0_; asm volatile("v_mbcnt_lo_u32_b32 %0, -1, 0\n\tv_mbcnt_hi_u32_b32 %0, -1, %0" : "=v"(ln0_));
    if (wv == 0 && ln0_ == 0) {
        unsigned* bar = b.bar; asm volatile("" : "+s"(bar));
        unsigned bx = xb_xcc_id(); asm volatile("" : "+s"(bx));
        __builtin_amdgcn_s_waitcnt(0);
        unsigned nloc = b.st[0], nx = b.st[1];
        if (nloc == 0u) { xcd_barrier_complete(bar, bx, nloc, nx); b.st[0] = nloc; b.st[1] = nx; }
        const unsigned old = xb_add(&bar[XB_XSUB(bx)], 1u); const unsigned gen = old / nloc;
        if (old + 1u == (gen + 1u) * nloc) {
            __builtin_amdgcn_fence(__ATOMIC_RELEASE, "agent");
            asm volatile("s_waitcnt vmcnt(0)" ::: "memory");
            const unsigned og = xb_add(&bar[XB_TOP], 1u); const unsigned tg = og / nx;
            if (og + 1u == (tg + 1u) * nx) xb_add(&bar[XB_TOPGEN], 1u);
            else XB_SPIN(xb_ld(&bar[XB_TOPGEN]) == tg, bar);
            __builtin_amdgcn_fence(__ATOMIC_ACQUIRE, "agent");
            xb_add(&bar[XB_XGEN(bx)], 1u);
            asm volatile("s_waitcnt vmcnt(0)" ::: "memory");
        } else {
            XB_SPIN(xb_ld(&bar[XB_XGEN(bx)]) == gen, bar);
            __builtin_amdgcn_fence(__ATOMIC_ACQUIRE, "agent");
            asm volatile("s_waitcnt vmcnt(0)" ::: "memory");
        }
    }
    __syncthreads();
}
}

namespace misc {
DEV void ada_phase(LAS unsigned char* lds, const float* __restrict__ c, const float* __restrict__ w_ada, const float* __restrict__ b_ada, float* __restrict__ ada, int G, int cblk, int wv) {
    int wv_ = wv, ln_; asm volatile("v_mbcnt_lo_u32_b32 %1, -1, 0\n\tv_mbcnt_hi_u32_b32 %1, -1, %1" : "+s"(wv_), "=v"(ln_)); int tid_ = (wv_ << 6) | ln_; const int tid = tid_, col = tid & 63, kg = tid >> 6;
    LAS float* cond = (LAS float*)lds;
    LAS float* part = (LAS float*)(lds + 65536);
    for (int i = tid; i < 16384; i += 512) { const float v = c[i]; cond[i] = v / (1.f + __expf(-v)); }
    __syncthreads();
#pragma unroll 1
    for (int item = cblk; item < 192; item += G) { const int l = item / 96, n0 = (item - l * 96) * 64;
        float acc[16];
#pragma unroll
        for (int b = 0; b < 16; ++b) acc[b] = 0.f;
        const float* wp = w_ada + ((size_t)l * 1024 + kg * 128) * 6144 + n0 + col;
#pragma unroll 2
        for (int kk = 0; kk < 128; kk += 8) { float wv[8];
#pragma unroll
            for (int j = 0; j < 8; ++j) wv[j] = wp[(size_t)(kk + j) * 6144];
#pragma unroll
            for (int b = 0; b < 16; ++b) { const f32x4 c0 = *(const LAS f32x4*)(cond + b * 1024 + kg * 128 + kk), c1 = *(const LAS f32x4*)(cond + b * 1024 + kg * 128 + kk + 4);
                acc[b] += (c0[0] * wv[0] + c0[1] * wv[1]) + (c0[2] * wv[2] + c0[3] * wv[3]) + (c1[0] * wv[4] + c1[1] * wv[5]) + (c1[2] * wv[6] + c1[3] * wv[7]); } }
#pragma unroll
        for (int b = 0; b < 16; ++b) part[(kg * 16 + b) * 64 + col] = acc[b];
        __syncthreads();
        for (int o = tid; o < 1024; o += 512) { const int b = o >> 6, cc = o & 63; float sacc = b_ada[l * 6144 + n0 + cc];
#pragma unroll
            for (int g8 = 0; g8 < 8; ++g8) sacc += part[(g8 * 16 + b) * 64 + cc];
            ada[((size_t)l * 16 + b) * 6144 + n0 + cc] = sacc; }
        __syncthreads();
    }
}
DEV void yprep_phase(LAS unsigned char* lds, const bf16_t* __restrict__ hyT, const bf16_t* P, const float* __restrict__ lse2, bf16_t* Y, int G, int cblk, int wv) {
    int wv_ = wv, ln_; asm volatile("v_mbcnt_lo_u32_b32 %1, -1, 0\n\tv_mbcnt_hi_u32_b32 %1, -1, %1" : "+s"(wv_), "=v"(ln_)); int tid_ = (wv_ << 6) | ln_; const int tid = tid_;
    LAS unsigned short* tile = (LAS unsigned short*)lds;
    u32x4 vnx = (u32x4){0u, 0u, 0u, 0u};
    if (cblk < 4096) { const int t0 = (cblk >> 3) * 64, c0 = (cblk & 7) * 64; vnx = *(const u32x4*)(hyT + (size_t)(c0 + (tid >> 3)) * T_ + t0 + (tid & 7) * 8); }
#pragma unroll 1
    for (int it = cblk; it < 4096; it += G) { const int t0 = (it >> 3) * 64, c0 = (it & 7) * 64;
        __syncthreads();
        { const int cc = tid >> 3, seg = (tid & 7) * 8; const u32x4 v = vnx; *(LAS u32x4*)(tile + cc * 72 + seg) = v;
          const int itn = it + G; if (itn < 4096) { const int t0n = (itn >> 3) * 64, c0n = (itn & 7) * 64; vnx = *(const u32x4*)(hyT + (size_t)(c0n + cc) * T_ + t0n + seg); } }
        __syncthreads();
        { const int tt = tid >> 3, seg = (tid & 7) * 8; unsigned wv[4];
#pragma unroll
            for (int e = 0; e < 4; ++e) wv[e] = (unsigned)tile[(seg + 2 * e) * 72 + tt] | ((unsigned)tile[(seg + 2 * e + 1) * 72 + tt] << 16);
            *(u32x4*)(Y + (size_t)(t0 + tt) * UYW_ + 256 + c0 + seg) = (u32x4){wv[0], wv[1], wv[2], wv[3]}; }
    }
#pragma unroll 1
    for (size_t idx = (size_t)cblk * 512 + tid; idx < (size_t)T_ * 32; idx += (size_t)G * 512) { const size_t tok = idx >> 5; const int c8 = (int)(idx & 31) * 8, hh = c8 >> 6;
        const float l0 = lse2[tok * 12 + hh], l1 = lse2[tok * 12 + 4 + hh], l2 = lse2[tok * 12 + 8 + hh]; const float mx = fmaxf(l0, fmaxf(l1, l2));
        float w0 = exp2f(l0 - mx), w1 = exp2f(l1 - mx), w2 = exp2f(l2 - mx); const float inv = 1.f / (w0 + w1 + w2); w0 *= inv; w1 *= inv; w2 *= inv;
        const bf16_t* pr = P + tok * PW_ + c8; const u32x4 a = *(const u32x4*)pr, b = *(const u32x4*)(pr + 256), c = *(const u32x4*)(pr + 512);
        const unsigned aw[4] = {a.x, a.y, a.z, a.w}, bw[4] = {b.x, b.y, b.z, b.w}, cw[4] = {c.x, c.y, c.z, c.w}; unsigned o[4];
#pragma unroll
        for (int e = 0; e < 4; ++e) { const float lo = w0 * __uint_as_float(aw[e] << 16) + w1 * __uint_as_float(bw[e] << 16) + w2 * __uint_as_float(cw[e] << 16);
            const float hi = w0 * __uint_as_float(aw[e] & 0xffff0000u) + w1 * __uint_as_float(bw[e] & 0xffff0000u) + w2 * __uint_as_float(cw[e] & 0xffff0000u); o[e] = pg8::cvt_pk_bf16(lo, hi); }
        *(u32x4*)(Y + tok * UYW_ + c8) = (u32x4){o[0], o[1], o[2], o[3]}; }
    __syncthreads();
}
DEV void filt_phase(LAS unsigned char* lds, const float* __restrict__ h2, const float* __restrict__ w3, const float* __restrict__ log_decay, bf16_t* __restrict__ Gr, int G, int cblk, int wv) {
    int wv_ = wv, ln_; asm volatile("v_mbcnt_lo_u32_b32 %1, -1, 0\n\tv_mbcnt_hi_u32_b32 %1, -1, %1" : "+s"(wv_), "=v"(ln_)); const int tid = (wv_ << 6) | ln_, lane = ln_;
    LAS float* hrow = (LAS float*)lds;
    LAS float* w3s = (LAS float*)(lds + 512 * 68 * 4);
    LAS float* dec = w3s + 1024;
    LAS float* red = dec + 16;
#pragma unroll 1
    for (int item_ = cblk; item_ < 256; item_ += G) { const int item = __builtin_amdgcn_readfirstlane(item_); const int l = item >> 7, o = (item >> 6) & 1, cg = item & 63; const int colf0 = o * 512 + cg * 8;
        __syncthreads();
        if (tid < 16) { const int col = (tid < 8) ? colf0 + tid : 1024 + colf0 + (tid - 8); dec[tid] = __expf(log_decay[l * 2048 + col]); }
        float vals[4][16];
#pragma unroll
        for (int ch = 0; ch < 4; ++ch) {
            __syncthreads();
            { const float* src = h2 + ((size_t)l * 2048 + ch * 512) * 64;
#pragma unroll 4
                for (int k = 0; k < 16; ++k) { const int idx = tid + 512 * k; const int row = idx >> 4, c4 = idx & 15; *(LAS f32x4*)(hrow + row * 68 + c4 * 4) = *(const f32x4*)(src + (size_t)idx * 4); } }
            __syncthreads();
            float acc[16];
#pragma unroll
            for (int c = 0; c < 16; ++c) acc[c] = 0.f;
#pragma unroll 2
            for (int j4 = 0; j4 < 16; ++j4) { const f32x4 hv = *(const LAS f32x4*)(hrow + tid * 68 + j4 * 4); const float hh4[4] = {hv.x, hv.y, hv.z, hv.w};
#pragma unroll
                for (int e = 0; e < 4; ++e) { typedef const __attribute__((address_space(4))) f32x4 cf4_;
                    const cf4_* wg = (const cf4_*)(unsigned long long)(w3 + ((size_t)l * 64 + (j4 * 4 + e)) * 2048 + colf0);
                    const f32x4 w0 = wg[0], w1 = wg[1], w2 = wg[256], w3v = wg[257];
                    acc[0] += hh4[e] * w0.x; acc[1] += hh4[e] * w0.y; acc[2] += hh4[e] * w0.z; acc[3] += hh4[e] * w0.w; acc[4] += hh4[e] * w1.x; acc[5] += hh4[e] * w1.y; acc[6] += hh4[e] * w1.z; acc[7] += hh4[e] * w1.w;
                    acc[8] += hh4[e] * w2.x; acc[9] += hh4[e] * w2.y; acc[10] += hh4[e] * w2.z; acc[11] += hh4[e] * w2.w; acc[12] += hh4[e] * w3v.x; acc[13] += hh4[e] * w3v.y; acc[14] += hh4[e] * w3v.z; acc[15] += hh4[e] * w3v.w; } }
            const float tn = (float)(ch * 512 + tid) * (1.f / 2047.f);
#pragma unroll
            for (int c = 0; c < 16; ++c) vals[ch][c] = acc[c] * __expf(-tn * dec[c]);
        }
        float ss[8];
#pragma unroll
        for (int c = 0; c < 8; ++c) { float a = 0.f;
#pragma unroll
            for (int ch = 0; ch < 4; ++ch) { a += vals[ch][c] * vals[ch][c]; if (ch > 0 || tid > 0) a += vals[ch][8 + c] * vals[ch][8 + c]; }
            ss[c] = peer::wave_sum(a, lane); }
        if (lane == 0) {
#pragma unroll
            for (int c = 0; c < 8; ++c) red[wv_ * 8 + c] = ss[c]; }
        __syncthreads();
        float scale[8];
#pragma unroll
        for (int c = 0; c < 8; ++c) { float a = 0.f;
#pragma unroll
            for (int g8 = 0; g8 < 8; ++g8) a += red[g8 * 8 + c];
            scale[c] = rsqrtf(a + 1e-12f); }
#pragma unroll
        for (int c = 0; c < 8; ++c) { bf16_t* gp = Gr + (((size_t)l * 2 + o) * 512 + cg * 8 + c) * 4096;
#pragma unroll
            for (int ch = 0; ch < 4; ++ch) { const int t = ch * 512 + tid; gp[2047 - t] = f2bf(vals[ch][c] * scale[c]); if (t > 0) gp[2047 + t] = f2bf(vals[ch][8 + c] * scale[c]); }
            if (tid == 0) gp[4095] = 0; }
    }
    __syncthreads();
}
DEV void modulate_phase(const float* __restrict__ x, const float* __restrict__ ada0, bf16_t* UY, float* __restrict__ su, int G, int cblk, int wv) {
    int wv_ = wv, ln_; asm volatile("v_mbcnt_lo_u32_b32 %1, -1, 0\n\tv_mbcnt_hi_u32_b32 %1, -1, %1" : "+s"(wv_), "=v"(ln_)); const int lane = ln_, w = wv_; const int d0 = 16 * lane;
    const int tper = T_ / G, tbeg = cblk * tper, tend = tbeg + tper; const float* a = ada0 + (size_t)(tbeg >> 11) * 6144;
    float4 scq[4], shq[4];
#pragma unroll
    for (int j = 0; j < 4; ++j) { scq[j] = *(const float4*)(a + 1024 + d0 + 4 * j); shq[j] = *(const float4*)(a + d0 + 4 * j); }
#pragma unroll 1
    for (int tok0 = tbeg + w; tok0 < tend; tok0 += 32) { float4 xv[4][4];
#pragma unroll
        for (int tt = 0; tt < 4; ++tt) { const int tk = tok0 + tt * 8; const float* xr = x + (size_t)(tk < tend ? tk : tok0) * 1024 + d0;
#pragma unroll
            for (int j = 0; j < 4; ++j) xv[tt][j] = *(const float4*)(xr + 4 * j); }
#pragma unroll
        for (int tt = 0; tt < 4; ++tt) { const int tok = tok0 + tt * 8; float u[16]; float um = 0.f;
#pragma unroll
            for (int j = 0; j < 16; j += 4) { const float4 xq = xv[tt][j >> 2], sc = scq[j >> 2], sh = shq[j >> 2];
                u[j] = xq.x * (1.f + sc.x) + sh.x; u[j + 1] = xq.y * (1.f + sc.y) + sh.y; u[j + 2] = xq.z * (1.f + sc.z) + sh.z; u[j + 3] = xq.w * (1.f + sc.w) + sh.w;
                um = fmaxf(um, fmaxf(fmaxf(fabsf(u[j]), fabsf(u[j + 1])), fmaxf(fabsf(u[j + 2]), fabsf(u[j + 3])))); }
            um = peer::wave_max(um, lane); const float qs = (um > 0.f) ? 127.f / um : 0.f; unsigned o[4];
#pragma unroll
            for (int e = 0; e < 4; ++e) { o[e] = 0u;
#pragma unroll
                for (int j = 0; j < 4; ++j) o[e] |= ((unsigned)(int)rintf(u[4 * e + j] * qs) & 0xffu) << (8 * j); }
            if (tok < tend) { *(u32x4*)((unsigned char*)(UY + (size_t)tok * UYW_) + d0) = (u32x4){o[0], o[1], o[2], o[3]};
                if (lane == 0) su[tok] = um * (1.f / 127.f); } } }
}
DEV void lnmod_phase(bf16_t* hx, const float* __restrict__ ada_l, const float* __restrict__ g, const float* __restrict__ bta, bf16_t* UY, int G, int cblk, int wv) {
    int wv_ = wv, ln_; asm volatile("v_mbcnt_lo_u32_b32 %1, -1, 0\n\tv_mbcnt_hi_u32_b32 %1, -1, %1" : "+s"(wv_), "=v"(ln_)); const int lane = ln_, w = wv_; const int d0 = 16 * lane;
    const int tper = T_ / G, tbeg = cblk * tper, tend = tbeg + tper; const float* a = ada_l + (size_t)(tbeg >> 11) * 6144;
    float4 ggq[4], bbq[4], scq[4], shq[4];
#pragma unroll
    for (int j = 0; j < 4; ++j) { ggq[j] = *(const float4*)(g + d0 + 4 * j); bbq[j] = *(const float4*)(bta + d0 + 4 * j); scq[j] = *(const float4*)(a + 4096 + d0 + 4 * j); shq[j] = *(const float4*)(a + 3072 + d0 + 4 * j); }
#pragma unroll 1
    for (int tok0 = tbeg + w; tok0 < tend; tok0 += 32) { u32x4 q[4][2];
#pragma unroll
        for (int t = 0; t < 4; ++t) { const int tk = tok0 + 8 * t; const int tc = tk < tend ? tk : tok0; q[t][0] = *(const u32x4*)(hx + (size_t)tc * 1024 + d0); q[t][1] = *(const u32x4*)(hx + (size_t)tc * 1024 + d0 + 8); }
#pragma unroll
        for (int t = 0; t < 4; ++t) { const int tok = tok0 + 8 * t; float hv[16]; float s = 0.f;
#pragma unroll
            for (int j = 0; j < 2; ++j) { const u32x4 v = q[t][j]; hv[8 * j] = __uint_as_float(v.x << 16); hv[8 * j + 1] = __uint_as_float(v.x & 0xffff0000u); hv[8 * j + 2] = __uint_as_float(v.y << 16); hv[8 * j + 3] = __uint_as_float(v.y & 0xffff0000u);
                hv[8 * j + 4] = __uint_as_float(v.z << 16); hv[8 * j + 5] = __uint_as_float(v.z & 0xffff0000u); hv[8 * j + 6] = __uint_as_float(v.w << 16); hv[8 * j + 7] = __uint_as_float(v.w & 0xffff0000u); }
#pragma unroll
            for (int j = 0; j < 16; j += 4) s += (hv[j] + hv[j + 1]) + (hv[j + 2] + hv[j + 3]);
            const float mu = peer::wave_sum(s, lane) * (1.f / 1024.f); float qq = 0.f;
#pragma unroll
            for (int j = 0; j < 16; ++j) { const float dd = hv[j] - mu; qq += dd * dd; }
            const float rstd = rsqrtf(peer::wave_sum(qq, lane) * (1.f / 1024.f) + LN_EPS_);
            float y[16], uu[16];
#pragma unroll
            for (int j = 0; j < 16; j += 4) { const float4 gg = ggq[j >> 2], bb = bbq[j >> 2], sc = scq[j >> 2], sh = shq[j >> 2];
                y[j] = (hv[j] - mu) * rstd * gg.x + bb.x; y[j + 1] = (hv[j + 1] - mu) * rstd * gg.y + bb.y; y[j + 2] = (hv[j + 2] - mu) * rstd * gg.z + bb.z; y[j + 3] = (hv[j + 3] - mu) * rstd * gg.w + bb.w;
                uu[j] = y[j] * (1.f + sc.x) + sh.x; uu[j + 1] = y[j + 1] * (1.f + sc.y) + sh.y; uu[j + 2] = y[j + 2] * (1.f + sc.z) + sh.z; uu[j + 3] = y[j + 3] * (1.f + sc.w) + sh.w; }
            if (tok < tend) { u32x4 q0, q1, p0, p1;
                q0.x = pg8::cvt_pk_bf16(y[0], y[1]); q0.y = pg8::cvt_pk_bf16(y[2], y[3]); q0.z = pg8::cvt_pk_bf16(y[4], y[5]); q0.w = pg8::cvt_pk_bf16(y[6], y[7]);
                q1.x = pg8::cvt_pk_bf16(y[8], y[9]); q1.y = pg8::cvt_pk_bf16(y[10], y[11]); q1.z = pg8::cvt_pk_bf16(y[12], y[13]); q1.w = pg8::cvt_pk_bf16(y[14], y[15]);
                p0.x = pg8::cvt_pk_bf16(uu[0], uu[1]); p0.y = pg8::cvt_pk_bf16(uu[2], uu[3]); p0.z = pg8::cvt_pk_bf16(uu[4], uu[5]); p0.w = pg8::cvt_pk_bf16(uu[6], uu[7]);
                p1.x = pg8::cvt_pk_bf16(uu[8], uu[9]); p1.y = pg8::cvt_pk_bf16(uu[10], uu[11]); p1.z = pg8::cvt_pk_bf16(uu[12], uu[13]); p1.w = pg8::cvt_pk_bf16(uu[14], uu[15]);
                bf16_t* xo = hx + (size_t)tok * 1024 + d0; *(u32x4*)xo = q0; *(u32x4*)(xo + 8) = q1; bf16_t* up = UY + (size_t)tok * UYW_ + d0; *(u32x4*)up = p0; *(u32x4*)(up + 8) = p1; } }
    }
}
}

struct Params {
    const float *x, *c, *w_ada, *b_ada, *w_in, *conv_w, *conv_b, *hy_w1, *hy_b1, *hy_w2, *hy_b2, *hy_w3, *hy_freq, *hy_ld, *hy_bias, *attn_sink, *wba, *wbb, *wbc, *w_out, *ln_g, *ln_b,
        *peer_wq, *peer_keys, *peer_u, *peer_v;
    float* out; char* ws;
};
constexpr int LDS_PHASE = 148480;
constexpr int LDS_BYTES = LDS_PHASE + 16;
constexpr size_t OFF_BAR = OFF_LSE + 1792 * 1024;

#define RUN(nvb, call) do { const int wv = wave_s; int wv_ = wv, ln_; asm volatile("v_mbcnt_lo_u32_b32 %1, -1, 0\n\tv_mbcnt_hi_u32_b32 %1, -1, %1" : "+s"(wv_), "=v"(ln_)); int tid_ = (wv_ << 6) | ln_; const int t = tid_ & 255, sub = tid_ >> 8; unsigned char* sm = lds + sub * 16384; \
        for (int vb = (int)blockIdx.x * 2 + sub; vb < (nvb); vb += (int)gridDim.x * 2) { call; __syncthreads(); } } while (0)
#define GSYNC_CG() do { __builtin_amdgcn_sched_barrier(0); grid.sync(); __builtin_amdgcn_sched_barrier(0); } while (0)
#define GSYNC() do { __builtin_amdgcn_sched_barrier(0); xb::xcd_barrier(xbar, wave_s); __builtin_amdgcn_sched_barrier(0); } while (0)

__global__ void __launch_bounds__(512, 2) mega(Params p) {
    extern __shared__ __attribute__((aligned(16))) unsigned char lds[];
    cg::grid_group grid = cg::this_grid();
    LAS unsigned char* ldsl = (LAS unsigned char*)lds;
    const int G = gridDim.x, cblk = blockIdx.x;
    const int wave_s = __builtin_amdgcn_readfirstlane((int)threadIdx.x >> 6);
    float* out = p.out; (void)out;
    if (threadIdx.x < 4) ((LAS unsigned*)(ldsl + LDS_PHASE))[threadIdx.x] = 0u;
    __syncthreads();
    const xb::XcdBarrier xbar = xb::xcd_barrier_post((unsigned*)(p.ws + OFF_BAR), (volatile LAS unsigned*)(ldsl + LDS_PHASE));
    {
    char* ws = p.ws;
    float* ada = (float*)(ws + OFF_ADA); float2* rope = (float2*)(ws + OFF_ROPE); bf16_t* Gr = (bf16_t*)(ws + OFF_GR); float* lse2 = (float*)(ws + OFF_LSE);
    unsigned char* WinT8 = (unsigned char*)(ws + OFF_WINT); unsigned char* WmT8 = (unsigned char*)(ws + OFF_WMT); float* su = (float*)(ws + OFF_LSE + 1536 * 1024); float* winv = (float*)(ws + OFF_LSE + 1664 * 1024);     bf16_t* WoutT = (bf16_t*)(ws + OFF_WOUTT); bf16_t* WqT = (bf16_t*)(ws + OFF_WQT);
    bf16_t* UY = (bf16_t*)(ws + OFF_UY); bf16_t* Y = UY + 1024; bf16_t* P = (bf16_t*)(ws + OFF_P); bf16_t* hyT = (bf16_t*)(ws + OFF_HYT);
    bf16_t* merged = (bf16_t*)(ws + OFF_P); bf16_t* gtmp = (bf16_t*)(ws + OFF_P + 64 * MB_); bf16_t* Q2 = (bf16_t*)(ws + OFF_P); bf16_t* x1b = (bf16_t*)(ws + OFF_P + 128 * MB_);
    int* eidx = (int*)(ws + OFF_HYT); float* egate = (float*)(ws + OFF_HYT + 16 * MB_); unsigned char* U8 = (unsigned char*)(ws + OFF_HYT + 32 * MB_); unsigned char* V4 = (unsigned char*)(ws + OFF_HYT + 48 * MB_); float* sinv = (float*)(ws + OFF_HYT + 64 * MB_);
    float* h2 = (float*)(ws + OFF_P);
    (void)lse2; (void)P; (void)hyT; (void)merged; (void)gtmp; (void)Q2; (void)x1b; (void)eidx; (void)egate; (void)U8; (void)V4; (void)sinv; (void)Y;

    misc::ada_phase(ldsl, p.c, p.w_ada, p.b_ada, ada, G, cblk, wave_s);
    RUN(256, nb_rope(vb, t, sm, rope));
    filt_h2_phase(ldsl, p.hy_w1, p.hy_b1, p.hy_w2, p.hy_b2, p.hy_freq, h2, G, cblk, wave_s);
    winprep_phase(ldsl, p.w_in, WinT8, WmT8, winv, G, cblk, wave_s);
    {
        const WPrep wq{p.w_in, p.wba, p.wbb, p.wbc, p.w_out, p.peer_wq, WinT8, WmT8, WoutT, WqT};
        const int wv = wave_s; int wv_ = wv, ln_; asm volatile("v_mbcnt_lo_u32_b32 %1, -1, 0\n\tv_mbcnt_hi_u32_b32 %1, -1, %1" : "+s"(wv_), "=v"(ln_)); const int tid_ = (wv_ << 6) | ln_; const int t = tid_ & 255, sub = tid_ >> 8; unsigned char* sm = lds + sub * 16384;
        const int hw = (int)blockIdx.x * 2 + sub;
        if (gridDim.x == 256) {
            if (hw < 384) { for (int vb = hw; vb < 896; vb += 384) { nb_wprep(vb, t, sm, wq); __syncthreads(); } }
            else { for (int vb = 896 + (hw - 384); vb < 2176; vb += 128) { nb_wprep(vb, t, sm, wq); __syncthreads(); } }
        } else { for (int vb = hw; vb < 2176; vb += (int)gridDim.x * 2) { nb_wprep(vb, t, sm, wq); __syncthreads(); } }
    }
    GSYNC();
    misc::filt_phase(ldsl, h2, p.hy_w3, p.hy_ld, Gr, G, cblk, wave_s);
    misc::modulate_phase(p.x, ada, UY, su, G, cblk, wave_s);
    GSYNC();
    }
#pragma unroll 1
    for (int l = 0; l < 2; ++l) {
        size_t zoff = 0; asm volatile("" : "+s"(zoff));
        char* ws = p.ws + zoff; float* out = p.out + zoff;
        int Gl = gridDim.x, cl = blockIdx.x; asm volatile("" : "+s"(Gl), "+s"(cl));
        float* ada = (float*)(ws + OFF_ADA); float2* rope = (float2*)(ws + OFF_ROPE); bf16_t* Gr = (bf16_t*)(ws + OFF_GR); float* lse2 = (float*)(ws + OFF_LSE);
        unsigned char* WinT8 = (unsigned char*)(ws + OFF_WINT); unsigned char* WmT8 = (unsigned char*)(ws + OFF_WMT); float* su = (float*)(ws + OFF_LSE + 1536 * 1024); float* winv = (float*)(ws + OFF_LSE + 1664 * 1024);     bf16_t* WoutT = (bf16_t*)(ws + OFF_WOUTT); bf16_t* WqT = (bf16_t*)(ws + OFF_WQT);
        bf16_t* UY = (bf16_t*)(ws + OFF_UY); bf16_t* Y = UY + 1024; bf16_t* P = (bf16_t*)(ws + OFF_P); bf16_t* hyT = (bf16_t*)(ws + OFF_HYT);
        bf16_t* merged = (bf16_t*)(ws + OFF_P); bf16_t* gtmp = (bf16_t*)(ws + OFF_P + 64 * MB_); bf16_t* Q2 = (bf16_t*)(ws + OFF_P); bf16_t* x1b = (bf16_t*)(ws + OFF_P + 128 * MB_);
        int* eidx = (int*)(ws + OFF_HYT); float* egate = (float*)(ws + OFF_HYT + 16 * MB_); unsigned char* U8 = (unsigned char*)(ws + OFF_HYT + 32 * MB_); unsigned char* V4 = (unsigned char*)(ws + OFF_HYT + 48 * MB_); float* sinv = (float*)(ws + OFF_HYT + 64 * MB_);
        const float* ada_l = ada + (size_t)l * 16 * 6144;
        const unsigned char* WinT8_l = WinT8 + (size_t)l * 4608 * 1024;
        {
            const pg8::PlainSched S1{UY, (const bf16_t*)WinT8_l, UYW_, 512, 128, 12, 8, Gl, cl, 0, 1 << 30}; const pg8::EpiP E1{P, rope, su, winv + (size_t)l * 7680};
            pg8::gemm_phase<pg8::EpiP, pg8::PlainSched, true, true, 1>(ldsl, UYW_, 512, S1, E1, wave_s);
            const pg8::PlainSched S2{(const bf16_t*)(WinT8_l + (size_t)3072 * 1024), UY, 512, UYW_, 6, 128, 8, Gl, cl, 0, 1 << 30}; const pg8::EpiHyT8 E2{hyT, su, winv + (size_t)l * 7680 + 3072};
            pg8::gemm_phase<pg8::EpiHyT8, pg8::PlainSched, true, true, 1>(ldsl, 512, UYW_, S2, E2, wave_s);
        }
        GSYNC();
        at::attn_phase(ldsl, P, lse2, Y, p.attn_sink + l * 8, Gl, cl, wave_s);
        hy::hyena_phase(ldsl, hyT, Gr + (size_t)l * 2 * 512 * 4096, p.conv_w + (size_t)l * 3 * 1536, p.conv_b + (size_t)l * 1536, p.hy_bias + (size_t)l * 1024, Gl, cl, wave_s);
        GSYNC();
        misc::yprep_phase(ldsl, hyT, P, lse2, Y, Gl, cl, wave_s);
        GSYNC();
        {
            const unsigned char* WmT8_l = WmT8 + (size_t)l * 1024 * (WMW_ * 2);
            static_assert(OFF_P + 192 * MB_ == OFF_HYT, "gate buffers");
            const pg8::GateSched Sg{UY, WmT8_l, Gl, cl}; const pg8::EpiGate Eg{gtmp, su, winv + (size_t)l * 7680 + 4608};
            pg8::gemm_phase<pg8::EpiGate, pg8::GateSched, true, true, 1>(ldsl, UYW_, WMW_, Sg, Eg, wave_s);
            const pg8::Branch3Sched Sb{UY, WmT8_l, Gl, cl}; const pg8::EpiBranch3 Eb{gtmp, merged};
            pg8::gemm_phase<pg8::EpiBranch3, pg8::Branch3Sched, true, true, 0>(ldsl, UYW_, WMW_, Sb, Eb, wave_s);
        }
        GSYNC();
        {
            const pg8::PlainSched S{merged, WoutT + (size_t)l * 1024 * 1024, 1024, 1024, 128, 4, 16, Gl, cl, 0, 1 << 30}; const pg8::EpiH E{(l == 0) ? p.x : (const float*)nullptr, (const bf16_t*)out, x1b, ada_l};
            pg8::gemm_phase(ldsl, 1024, 1024, S, E, wave_s);
        }
        peer::quant_phase(p.peer_u + (size_t)l * 16384 * 1024, p.peer_v + (size_t)l * 16384 * 1024, U8, V4, sinv, Gl, cl, wave_s);
        GSYNC();
        misc::lnmod_phase(x1b, ada_l, p.ln_g + (size_t)(l * 2 + 0) * 1024, p.ln_b + (size_t)(l * 2 + 0) * 1024, UY, Gl, cl, wave_s);
        GSYNC();
        {
            const pg8::PlainSched S{UY, WqT + (size_t)l * 2048 * 1024, UYW_, 1024, 128, 8, 16, Gl, cl, 0, 1 << 30}; const pg8::EpiBf E{Q2, 2048, 0};
            pg8::gemm_phase(ldsl, UYW_, 1024, S, E, wave_s);
        }
        GSYNC();
        tk::topk_phase(ldsl, Q2, p.peer_keys + (size_t)l * 8 * 2 * 128 * 128, eidx, egate, Gl, cl, wave_s);
        GSYNC();
        peer::peer_phase(ldsl, x1b, out, (l == 0) ? (bf16_t*)out : (bf16_t*)nullptr, ada_l, eidx, egate, U8, V4, sinv, p.ln_g + (size_t)(l * 2 + 1) * 1024, p.ln_b + (size_t)(l * 2 + 1) * 1024,
                         (l == 0) ? ada + (size_t)16 * 6144 : (const float*)nullptr, UY, su, Gl, cl, wave_s);
        if (l == 0) GSYNC();
    }
}

extern "C" void kernel_launch(void* const* d_in, const int* in_sizes, int n_in, void* d_out, int out_size, void* d_ws, size_t ws_size, hipStream_t stream) {
    static int grid = 0;
    if (grid == 0) {
        if (ws_size < WS_NEED || n_in != 26) { fprintf(stderr, "kernel_launch: workspace %zu < %zu or n_in %d != 26\n", ws_size, (size_t)WS_NEED, n_in); grid = -1; return; }
        int dev = 0, cus = 0, per_cu = 0;
        (void)hipGetDevice(&dev); (void)hipDeviceGetAttribute(&cus, hipDeviceAttributeMultiprocessorCount, dev);
        (void)hipFuncSetAttribute((const void*)mega, hipFuncAttributeMaxDynamicSharedMemorySize, LDS_BYTES);
        (void)hipOccupancyMaxActiveBlocksPerMultiprocessor(&per_cu, (const void*)mega, 512, LDS_BYTES);
        if (per_cu < 1) { fprintf(stderr, "kernel_launch: occupancy query says %d blocks per CU\n", per_cu); grid = -1; return; }
        if (cus != 256) { fprintf(stderr, "kernel_launch: built for a 256-CU device (work partitions and the XCD barrier assume 256 workgroups), found %d CUs\n", cus); grid = -1; return; }
        grid = cus;
    }
    if (grid < 0) return;
    Params p{};
    const float** pp = (const float**)&p;
    for (int i = 0; i < 26; ++i) pp[i] = (const float*)d_in[i];
    p.out = (float*)d_out; p.ws = (char*)d_ws;
    (void)hipMemsetAsync((char*)d_ws + OFF_BAR, 0, 16384, stream);
    void* args[] = {&p};
    hipError_t e = hipLaunchCooperativeKernel((const void*)mega, dim3(grid), dim3(512), args, LDS_BYTES, stream);
    if (e != hipSuccess) fprintf(stderr, "cooperative launch failed: %s (grid %d)\n", hipGetErrorString(e), grid);
}
```
